# Optimizing an MI355X kernel written in HIP

```python
import math
import jax, jax.numpy as jnp
from jax import lax
import numpy as np

D_MODEL = 1024
BATCH = 4
SEQ = 8192
DEPTH = 1

D_MIX = D_MODEL
S5_WIDTH = D_MIX // 2
S5_GROUP = 16
S5_GROUPS = S5_WIDTH // S5_GROUP
S5_STATE = 64
ML_WIDTH = D_MIX - S5_WIDTH
ML_HEADS = 4
ML_HEAD_DIM = ML_WIDTH // ML_HEADS
ML_CHUNK = 64
CONV_WIDTH = 4
D_IN = S5_WIDTH + 4 * ML_WIDTH + 2 * ML_HEADS
N_EXPERTS = 32
TOP_K = 4
D_FF = D_MODEL
SWIGLU_LIMIT = 7.0
SWIGLU_ALPHA = 1.702
MOE_BLOCK = 128
RMS_EPS = 1e-5
LN_EPS = 1e-6

kernel_name = "hymba_s5_mlstm_moe_block"


def rmsnorm(x, g):
    xf = x.astype(jnp.float32)
    y = xf * lax.rsqrt(jnp.mean(xf * xf, axis=-1, keepdims=True) + RMS_EPS)
    return (y * g.astype(jnp.float32)).astype(x.dtype)


def s5_mixer(u, log_dt, a_re, a_im, b_re, b_im, c_re, c_im, d_skip, w_glu, b_glu):
    f32 = jnp.float32
    bsz, seq, _ = u.shape
    uf = u.astype(f32).reshape(bsz, seq, S5_GROUPS, S5_GROUP)
    a = lax.complex(jnp.minimum(a_re.astype(f32), -1e-4), a_im.astype(f32))
    dt = jnp.exp(log_dt.astype(f32))[:, None]
    a_bar = jnp.exp(dt * a)
    b_mat = lax.complex(b_re.astype(f32), b_im.astype(f32))
    b_bar = ((a_bar - 1.0) / a)[..., None] * b_mat
    c_mat = lax.complex(c_re.astype(f32), c_im.astype(f32))
    bu = jnp.einsum('gnp,bsgp->bsgn', b_bar, uf.astype(jnp.complex64))
    a_seq = jnp.broadcast_to(a_bar, (1, seq, S5_GROUPS, S5_STATE))

    def combine(left, right):
        a_l, x_l = left
        a_r, x_r = right
        return a_r * a_l, a_r * x_l + x_r

    _, states = lax.associative_scan(combine, (a_seq, bu), axis=1)
    y = jnp.einsum('gpn,bsgn->bsgp', c_mat, states).real \
        + d_skip.astype(f32).reshape(S5_GROUPS, S5_GROUP) * uf
    y = y.reshape(bsz, seq, S5_WIDTH)
    g = jax.nn.gelu(y)
    out = g * jax.nn.sigmoid(g @ w_glu.astype(f32) + b_glu.astype(f32))
    return out.astype(u.dtype)


def causal_conv(x, w, b):
    seq = x.shape[1]
    xp = jnp.pad(x, ((0, 0), (CONV_WIDTH - 1, 0), (0, 0)))
    out = b
    for j in range(CONV_WIDTH):
        out = out + w[j] * xp[:, j:j + seq]
    return out


def mlstm_chunkwise(q, k, v, i_pre, f_pre):
    bsz, nh, seq, dh = q.shape
    nc = seq // ML_CHUNK
    L = ML_CHUNK

    def to_chunks(t):
        return jnp.moveaxis(t.reshape(bsz, nh, nc, L, *t.shape[3:]), 2, 0)

    qc = to_chunks(q)
    kc = to_chunks(k * (1.0 / math.sqrt(dh)))
    vc = to_chunks(v)
    ic = to_chunks(i_pre)
    lfc = to_chunks(jax.nn.log_sigmoid(f_pre))
    causal = jnp.tril(jnp.ones((L, L), dtype=bool))

    def step(carry, inp):
        c_prev, n_prev, m_prev = carry
        q_c, k_c, v_c, i_c, lf_c = inp
        b = jnp.cumsum(lf_c, axis=-1)
        log_d = jnp.where(causal, b[..., :, None] - b[..., None, :] + i_c[..., None, :], -jnp.inf)
        log_inter = b + m_prev[..., None]
        m = jnp.maximum(log_inter, jnp.max(log_d, axis=-1))
        w_intra = jnp.exp(log_d - m[..., None])
        w_inter = jnp.exp(log_inter - m)
        s = jnp.einsum('bhtd,bhsd->bhts', q_c, k_c) * w_intra
        num = w_inter[..., None] * jnp.einsum('bhtd,bhde->bhte', q_c, c_prev) \
            + jnp.einsum('bhts,bhse->bhte', s, v_c)
        den = w_inter * jnp.einsum('bhtd,bhd->bht', q_c, n_prev) + jnp.sum(s, axis=-1)
        h = num / jnp.maximum(jnp.abs(den), jnp.exp(-m))[..., None]
        b_last = b[..., -1]
        log_w_state = b_last[..., None] - b + i_c
        m_next = jnp.maximum(b_last + m_prev, jnp.max(log_w_state, axis=-1))
        decay = jnp.exp(b_last + m_prev - m_next)
        w_state = jnp.exp(log_w_state - m_next[..., None])
        c_next = decay[..., None, None] * c_prev + jnp.einsum('bhs,bhsd,bhse->bhde', w_state, k_c, v_c)
        n_next = decay[..., None] * n_prev + jnp.einsum('bhs,bhsd->bhd', w_state, k_c)
        return (c_next, n_next, m_next), h

    init = (jnp.zeros((bsz, nh, dh, dh), jnp.float32),
            jnp.zeros((bsz, nh, dh), jnp.float32),
            jnp.zeros((bsz, nh), jnp.float32))
    _, hs = lax.scan(step, init, (qc, kc, vc, ic, lfc))
    return jnp.moveaxis(hs, 0, 2).reshape(bsz, nh, seq, dh)


def mlstm_mixer(q_pre, k_pre, v, o_pre, gate_pre, conv_w, conv_b, b_gates, norm_g):
    f32 = jnp.float32
    bsz, seq, _ = v.shape
    qk = jnp.concatenate([q_pre, k_pre], axis=-1).astype(f32)
    qk = jax.nn.silu(causal_conv(qk, conv_w.astype(f32), conv_b.astype(f32)))
    q, k = jnp.split(qk, 2, axis=-1)

    def heads(t):
        return t.reshape(bsz, seq, ML_HEADS, ML_HEAD_DIM).transpose(0, 2, 1, 3)

    gates = (gate_pre.astype(f32) + b_gates.astype(f32)).transpose(0, 2, 1)
    i_pre, f_pre = gates[:, :ML_HEADS], gates[:, ML_HEADS:]
    h = mlstm_chunkwise(heads(q), heads(k), heads(v.astype(f32)), i_pre, f_pre)
    mu = jnp.mean(h, axis=-1, keepdims=True)
    var = jnp.mean(jnp.square(h - mu), axis=-1, keepdims=True)
    h = (h - mu) * lax.rsqrt(var + LN_EPS)
    h = h.transpose(0, 2, 1, 3).reshape(bsz, seq, ML_WIDTH) * norm_g.astype(f32)
    out = h * jax.nn.sigmoid(o_pre.astype(f32))
    return out.astype(v.dtype)


def moe_ffn(x, w_router, b_router, w_up, b_up, w_down, b_down):
    bsz, seq, d = x.shape
    t = x.reshape(-1, d)
    n_tok = t.shape[0]
    logits = (t @ w_router + b_router).astype(jnp.float32)
    top_vals, top_idx = lax.top_k(logits, TOP_K)
    gate = jax.nn.softmax(top_vals, axis=-1)
    n_assign = n_tok * TOP_K
    flat_e = top_idx.reshape(-1)
    order = jnp.argsort(flat_e)
    sorted_e = flat_e[order]
    sorted_tok = (order // TOP_K).astype(jnp.int32)
    sorted_gate = gate.reshape(-1)[order]
    counts = jnp.bincount(flat_e, length=N_EXPERTS)
    start = jnp.cumsum(counts) - counts
    padded = (counts + MOE_BLOCK - 1) // MOE_BLOCK * MOE_BLOCK
    pad_end = jnp.cumsum(padded)
    pad_start = pad_end - padded
    dest = pad_start[sorted_e] + (jnp.arange(n_assign) - start[sorted_e])
    n_slots = (n_assign + MOE_BLOCK - 1) // MOE_BLOCK * MOE_BLOCK + N_EXPERTS * MOE_BLOCK
    n_blocks = n_slots // MOE_BLOCK
    slot_tok = jnp.zeros((n_slots,), jnp.int32).at[dest].set(sorted_tok)
    block_start = jnp.arange(n_blocks) * MOE_BLOCK
    block_e = jnp.minimum(jnp.sum(pad_end[None, :] <= block_start[:, None], axis=-1), N_EXPERTS - 1)
    xs = t[slot_tok].reshape(n_blocks, MOE_BLOCK, d)

    def expert_block(args):
        xb, e = args
        h = xb @ w_up[e] + b_up[e]
        g = jnp.minimum(h[:, :D_FF], SWIGLU_LIMIT)
        lin = jnp.clip(h[:, D_FF:], -SWIGLU_LIMIT, SWIGLU_LIMIT)
        act = g * jax.nn.sigmoid(SWIGLU_ALPHA * g) * (lin + 1.0)
        return act @ w_down[e] + b_down[e]

    ys = lax.map(expert_block, (xs, block_e)).reshape(n_slots, d)
    y_assign = ys[dest].astype(jnp.float32) * sorted_gate[:, None]
    y = jax.ops.segment_sum(y_assign, sorted_tok, num_segments=n_tok)
    return y.reshape(bsz, seq, d).astype(x.dtype)


def setup_inputs(seed: int = 0) -> dict:
    key = jax.random.key(seed)
    ks = jax.random.split(key, 28)
    nrm = jax.random.normal
    f32 = jnp.float32
    L_ = DEPTH
    x = nrm(ks[0], (BATCH, SEQ, D_MODEL), f32)
    norm_mix_g = 1.0 + 0.01 * nrm(ks[1], (L_, D_MODEL), f32)
    w_in = nrm(ks[2], (L_, D_MODEL, D_IN), f32) * D_MODEL ** -0.5
    s5_log_dt = jax.random.uniform(ks[3], (L_, S5_GROUPS), f32, math.log(1e-3), math.log(1e-1))
    s5_a_re = -0.5 + 0.01 * nrm(ks[4], (L_, S5_GROUPS, S5_STATE), f32)
    s5_a_im = jnp.pi * jnp.arange(S5_STATE, dtype=f32) + 0.01 * nrm(ks[5], (L_, S5_GROUPS, S5_STATE), f32)
    s5_b_re = nrm(ks[6], (L_, S5_GROUPS, S5_STATE, S5_GROUP), f32) * (2 * S5_GROUP) ** -0.5
    s5_b_im = nrm(ks[7], (L_, S5_GROUPS, S5_STATE, S5_GROUP), f32) * (2 * S5_GROUP) ** -0.5
    s5_c_re = nrm(ks[8], (L_, S5_GROUPS, S5_GROUP, S5_STATE), f32) * (2 * S5_STATE) ** -0.5
    s5_c_im = nrm(ks[9], (L_, S5_GROUPS, S5_GROUP, S5_STATE), f32) * (2 * S5_STATE) ** -0.5
    s5_d = nrm(ks[10], (L_, S5_WIDTH), f32)
    s5_w_glu = nrm(ks[11], (L_, S5_WIDTH, S5_WIDTH), f32) * S5_WIDTH ** -0.5
    s5_b_glu = 0.01 * nrm(ks[12], (L_, S5_WIDTH), f32)
    ml_conv_w = nrm(ks[13], (L_, CONV_WIDTH, 2 * ML_WIDTH), f32) * CONV_WIDTH ** -0.5
    ml_conv_b = 0.01 * nrm(ks[14], (L_, 2 * ML_WIDTH), f32)
    ml_b_gates = jnp.concatenate([
        0.1 * nrm(ks[15], (L_, ML_HEADS), f32),
        jnp.linspace(3.0, 6.0, ML_HEADS, dtype=f32) + 0.01 * nrm(ks[16], (L_, ML_HEADS), f32)], axis=-1)
    ml_norm_g = 1.0 + 0.01 * nrm(ks[17], (L_, ML_WIDTH), f32)
    w_out = nrm(ks[18], (L_, D_MIX, D_MODEL), f32) * D_MIX ** -0.5
    norm_ffn_g = 1.0 + 0.01 * nrm(ks[19], (L_, D_MODEL), f32)
    w_router = nrm(ks[20], (L_, D_MODEL, N_EXPERTS), f32) * D_MODEL ** -0.5
    b_router = 0.01 * nrm(ks[21], (L_, N_EXPERTS), f32)
    w_up = nrm(ks[22], (L_, N_EXPERTS, D_MODEL, 2 * D_FF), f32) * D_MODEL ** -0.5
    b_up = 0.01 * nrm(ks[23], (L_, N_EXPERTS, 2 * D_FF), f32)
    w_down = nrm(ks[24], (L_, N_EXPERTS, D_FF, D_MODEL), f32) * D_FF ** -0.5
    b_down = 0.01 * nrm(ks[25], (L_, N_EXPERTS, D_MODEL), f32)
    norm_final_g = 1.0 + 0.01 * nrm(ks[26], (D_MODEL,), f32)
    return {"x": x, "norm_mix_g": norm_mix_g, "w_in": w_in, "s5_log_dt": s5_log_dt,
            "s5_a_re": s5_a_re, "s5_a_im": s5_a_im, "s5_b_re": s5_b_re, "s5_b_im": s5_b_im,
            "s5_c_re": s5_c_re, "s5_c_im": s5_c_im, "s5_d": s5_d, "s5_w_glu": s5_w_glu,
            "s5_b_glu": s5_b_glu, "ml_conv_w": ml_conv_w, "ml_conv_b": ml_conv_b,
            "ml_b_gates": ml_b_gates, "ml_norm_g": ml_norm_g, "w_out": w_out,
            "norm_ffn_g": norm_ffn_g, "w_router": w_router, "b_router": b_router,
            "w_up": w_up, "b_up": b_up, "w_down": w_down, "b_down": b_down,
            "norm_final_g": norm_final_g}


def reference(x, norm_mix_g, w_in, s5_log_dt, s5_a_re, s5_a_im, s5_b_re, s5_b_im, s5_c_re,
              s5_c_im, s5_d, s5_w_glu, s5_b_glu, ml_conv_w, ml_conv_b, ml_b_gates, ml_norm_g,
              w_out, norm_ffn_g, w_router, b_router, w_up, b_up, w_down, b_down, norm_final_g):
    h = x
    o_q = S5_WIDTH
    o_k = o_q + ML_WIDTH
    o_v = o_k + ML_WIDTH
    o_o = o_v + ML_WIDTH
    o_g = o_o + ML_WIDTH
    for l in range(DEPTH):
        hn = rmsnorm(h, norm_mix_g[l])
        proj = hn @ w_in[l]
        y_s5 = s5_mixer(proj[..., :o_q], s5_log_dt[l], s5_a_re[l], s5_a_im[l], s5_b_re[l],
                        s5_b_im[l], s5_c_re[l], s5_c_im[l], s5_d[l], s5_w_glu[l], s5_b_glu[l])
        y_ml = mlstm_mixer(proj[..., o_q:o_k], proj[..., o_k:o_v], proj[..., o_v:o_o],
                           proj[..., o_o:o_g], proj[..., o_g:], ml_conv_w[l], ml_conv_b[l],
                           ml_b_gates[l], ml_norm_g[l])
        mix = jnp.concatenate([y_s5, y_ml], axis=-1)
        h = h + mix @ w_out[l]
        h = h + moe_ffn(rmsnorm(h, norm_ffn_g[l]), w_router[l], b_router[l], w_up[l], b_up[l],
                        w_down[l], b_down[l])
    return rmsnorm(h, norm_final_g)
```

```cpp
#include <hip/hip_runtime.h>
#include <cstdio>
#include <cstdint>

typedef unsigned short bf16;
typedef short bf16x8 __attribute__((ext_vector_type(8)));
typedef float f32x4 __attribute__((ext_vector_type(4)));
typedef unsigned u32x4 __attribute__((ext_vector_type(4)));

constexpr int NB = 4, SEQ = 8192, T = NB * SEQ, D = 1024;
constexpr int DIN = 2568, NPROJ = 2560;
constexpr int O_Q = 512, O_K = 1024, O_V = 1536, O_O = 2048, O_G = 2560;
constexpr int NE = 32, TOPK = 4, FF = 1024;
constexpr int NASSIGN = T * TOPK;
constexpr int MBLK = 128;
constexpr int NSLOTS = NASSIGN + NE * MBLK;
constexpr int NMBLK = NSLOTS / MBLK;

__device__ __forceinline__ float bf2f(bf16 v) { return __uint_as_float(((unsigned)v) << 16); }
__device__ __forceinline__ bf16 f2bf(float f) { unsigned u = __float_as_uint(f); u += 0x7fffu + ((u >> 16) & 1u); return (bf16)(u >> 16); }
__device__ __forceinline__ float wave_sum(float v) {
#pragma unroll
    for (int o = 1; o < 64; o <<= 1) v += __shfl_xor(v, o);
    return v;
}
__device__ __forceinline__ float wave_max(float v) {
#pragma unroll
    for (int o = 1; o < 64; o <<= 1) v = fmaxf(v, __shfl_xor(v, o));
    return v;
}
__device__ __forceinline__ float sigmoidf_(float x) { return 1.f / (1.f + __expf(-x)); }

__global__ __launch_bounds__(256) void k_rms_in(const float* __restrict__ x, const float* __restrict__ g, const float* __restrict__ w_in,
                                                const float* __restrict__ b_gates, bf16* __restrict__ hn, float* __restrict__ gates) {
    const int wave = threadIdx.x >> 6, lane = threadIdx.x & 63;
    const int row = blockIdx.x * 4 + wave;
    const float* xr = x + (size_t)row * D;
    float v[16]; float ss = 0.f;
#pragma unroll
    for (int j = 0; j < 4; ++j) { f32x4 t = *(const f32x4*)(xr + 4 * lane + 256 * j); v[4 * j] = t.x; v[4 * j + 1] = t.y; v[4 * j + 2] = t.z; v[4 * j + 3] = t.w; ss += t.x * t.x + t.y * t.y + t.z * t.z + t.w * t.w; }
    ss = wave_sum(ss);
    const float rstd = rsqrtf(ss * (1.f / D) + 1e-5f);
    float ga[8] = {0, 0, 0, 0, 0, 0, 0, 0};
#pragma unroll
    for (int j = 0; j < 4; ++j)
#pragma unroll
        for (int i = 0; i < 4; ++i) {
            const int k = 4 * lane + 256 * j + i;
            const float y = v[4 * j + i] * rstd * g[k];
            v[4 * j + i] = y;
            const float* wr = w_in + (size_t)k * DIN + O_G;
#pragma unroll
            for (int q = 0; q < 8; ++q) ga[q] += y * wr[q];
        }
#pragma unroll
    for (int j = 0; j < 4; ++j) {
        uint2 o; o.x = (unsigned)f2bf(v[4 * j]) | ((unsigned)f2bf(v[4 * j + 1]) << 16); o.y = (unsigned)f2bf(v[4 * j + 2]) | ((unsigned)f2bf(v[4 * j + 3]) << 16);
        *(uint2*)(hn + (size_t)row * D + 4 * lane + 256 * j) = o;
    }
#pragma unroll
    for (int q = 0; q < 8; ++q) { const float s = wave_sum(ga[q]); if (lane == 0) gates[(size_t)row * 8 + q] = s + b_gates[q]; }
}

template <class AF, class BF, class EF, bool PAIRED>
__global__ __launch_bounds__(256) void k_gemm(AF af, BF bf, EF ef, int K, int nNt) {
    __shared__ __attribute__((aligned(16))) bf16 As[128 * 40];
    __shared__ __attribute__((aligned(16))) bf16 Bs[128 * 40];
    const int mt = blockIdx.x / nNt, nt = blockIdx.x % nNt;
    if (!af.valid(mt)) return;
    const int tid = threadIdx.x, w = tid >> 6, l = tid & 63, fr = l & 15, fq = l >> 4;
    const bf16* arow = af.row(mt, tid >> 1);
    const int akh = (tid & 1) * 16;
    const float* bbase = bf.base(mt); const int ldb = bf.ldb;
    const int bk = tid >> 3, bn0 = (tid & 7) * 16;
    int bcol[16];
#pragma unroll
    for (int j = 0; j < 16; ++j) bcol[j] = bf.col(nt, bn0 + j);
    f32x4 acc[2][8];
#pragma unroll
    for (int m = 0; m < 2; ++m)
#pragma unroll
        for (int n = 0; n < 8; ++n) acc[m][n] = (f32x4){0.f, 0.f, 0.f, 0.f};
    for (int k0 = 0; k0 < K; k0 += 32) {
        const u32x4 a0 = *(const u32x4*)(arow + k0 + akh), a1 = *(const u32x4*)(arow + k0 + akh + 8);
        float bv[16];
#pragma unroll
        for (int j = 0; j < 16; ++j) bv[j] = bcol[j] >= 0 ? bbase[(size_t)(k0 + bk) * ldb + bcol[j]] : 0.f;
        __syncthreads();
        *(u32x4*)(As + (tid >> 1) * 40 + akh) = a0; *(u32x4*)(As + (tid >> 1) * 40 + akh + 8) = a1;
#pragma unroll
        for (int j = 0; j < 16; ++j) Bs[(bn0 + j) * 40 + bk] = f2bf(bv[j]);
        __syncthreads();
        bf16x8 a[2];
#pragma unroll
        for (int m = 0; m < 2; ++m) a[m] = *(const bf16x8*)(As + (32 * w + 16 * m + fr) * 40 + fq * 8);
#pragma unroll
        for (int n = 0; n < 8; ++n) {
            const bf16x8 b = *(const bf16x8*)(Bs + (16 * n + fr) * 40 + fq * 8);
#pragma unroll
            for (int m = 0; m < 2; ++m) acc[m][n] = __builtin_amdgcn_mfma_f32_16x16x32_bf16(a[m], b, acc[m][n], 0, 0, 0);
        }
    }
#pragma unroll
    for (int m = 0; m < 2; ++m)
#pragma unroll
        for (int j = 0; j < 4; ++j) {
            const int rl = 32 * w + 16 * m + fq * 4 + j;
            if (PAIRED) {
#pragma unroll
                for (int n = 0; n < 4; ++n) ef(mt, nt, rl, 16 * n + fr, acc[m][n][j], acc[m][n + 4][j]);
            } else {
#pragma unroll
                for (int n = 0; n < 8; ++n) ef(mt, nt, rl, 16 * n + fr, acc[m][n][j], 0.f);
            }
        }
}

struct ARows { const bf16* A; int lda; int pad; __device__ bool valid(int) const { return true; } __device__ const bf16* row(int mt, int r) const { return A + (size_t)(mt * 128 + r) * lda; } };
struct BPlain { const float* B; int ldb; int N; __device__ const float* base(int) const { return B; } __device__ int col(int nt, int nl) const { const int c = nt * 128 + nl; return c < N ? c : -1; } };

struct EpiProj { bf16* P; __device__ void operator()(int mt, int nt, int rl, int nl, float v, float) const { P[(size_t)(mt * 128 + rl) * NPROJ + nt * 128 + nl] = f2bf(v); } };
struct EpiGlu { const bf16* GY; const float* bglu; bf16* MIX;
    __device__ void operator()(int mt, int nt, int rl, int nl, float v, float) const { const int row = mt * 128 + rl, col = nt * 128 + nl; const float g = bf2f(GY[(size_t)row * 512 + col]);
        MIX[(size_t)row * D + col] = f2bf(g * sigmoidf_(v + bglu[col])); } };
struct EpiOut { const float* x; float* H; __device__ void operator()(int mt, int nt, int rl, int nl, float v, float) const { const size_t i = (size_t)(mt * 128 + rl) * D + nt * 128 + nl; H[i] = x[i] + v; } };

struct AGather { const bf16* X; const int* slot_tok; const int* nblk; __device__ bool valid(int mt) const { return mt < *nblk; }
    __device__ const bf16* row(int mt, int r) const { return X + (size_t)slot_tok[mt * 128 + r] * D; } };
struct ASlots { const bf16* A; const int* nblk; __device__ bool valid(int mt) const { return mt < *nblk; } __device__ const bf16* row(int mt, int r) const { return A + (size_t)(mt * 128 + r) * FF; } };
struct BUp { const float* W; const int* blk_e; int ldb; int pad; __device__ const float* base(int mt) const { return W + (size_t)blk_e[mt] * D * 2 * FF; }
    __device__ int col(int nt, int nl) const { return nl < 64 ? nt * 64 + nl : FF + nt * 64 + (nl - 64); } };
struct BDown { const float* W; const int* blk_e; int ldb; int pad; __device__ const float* base(int mt) const { return W + (size_t)blk_e[mt] * FF * D; } __device__ int col(int nt, int nl) const { return nt * 128 + nl; } };
struct EpiUp { const float* b_up; const int* blk_e; bf16* ACT;
    __device__ void operator()(int mt, int nt, int rl, int nl, float v, float v2) const { const int e = blk_e[mt], j = nt * 64 + nl;
        const float g = fminf(v + b_up[e * 2 * FF + j], 7.f); const float lin = fminf(fmaxf(v2 + b_up[e * 2 * FF + FF + j], -7.f), 7.f);
        ACT[(size_t)(mt * 128 + rl) * FF + j] = f2bf(g * sigmoidf_(1.702f * g) * (lin + 1.f)); } };
struct EpiDown { const float* b_down; const int* blk_e; bf16* YS;
    __device__ void operator()(int mt, int nt, int rl, int nl, float v, float) const { const int e = blk_e[mt], c = nt * 128 + nl; YS[(size_t)(mt * 128 + rl) * D + c] = f2bf(v + b_down[e * D + c]); } };

__device__ __forceinline__ float gelu_tanh(float x) { const float u = 0.7978845608028654f * (x + 0.044715f * x * x * x); return 0.5f * x * (1.f + tanhf(u)); }
__global__ __launch_bounds__(64) void k_s5(const bf16* __restrict__ proj, const float* log_dt, const float* a_re, const float* a_im, const float* b_re, const float* b_im,
                                           const float* c_re, const float* c_im, const float* d_skip, bf16* __restrict__ GY) {
    __shared__ float xre[64 * 65], xim[64 * 65], cre[16 * 64], cim[16 * 64];
    const int b = blockIdx.x >> 5, g = blockIdx.x & 31, n = threadIdx.x;
    const float dt = __expf(log_dt[g]);
    const float are = fminf(a_re[g * 64 + n], -1e-4f), aim = a_im[g * 64 + n];
    const float mag = expf(dt * are); float sn, cs; sincosf(dt * aim, &sn, &cs);
    const float abr = mag * cs, abi = mag * sn;
    const float nr = abr - 1.f, ni = abi, dn = are * are + aim * aim;
    const float cfr = (nr * are + ni * aim) / dn, cfi = (ni * are - nr * aim) / dn;
    float bbr[16], bbi[16];
#pragma unroll
    for (int q = 0; q < 16; ++q) { const float br = b_re[(g * 64 + n) * 16 + q], bi = b_im[(g * 64 + n) * 16 + q]; bbr[q] = cfr * br - cfi * bi; bbi[q] = cfr * bi + cfi * br; }
    for (int p = 0; p < 16; ++p) { cre[p * 64 + n] = c_re[(g * 16 + p) * 64 + n]; cim[p * 64 + n] = c_im[(g * 16 + p) * 64 + n]; }
    float dsk[16];
#pragma unroll
    for (int p = 0; p < 16; ++p) dsk[p] = d_skip[g * 16 + p];
    float sr = 0.f, si = 0.f;
    __syncthreads();
    for (int c = 0; c < SEQ / 64; ++c) {
        for (int s = 0; s < 64; ++s) {
            const bf16* up = proj + (size_t)(b * SEQ + c * 64 + s) * NPROJ + g * 16;
            float bur = 0.f, bui = 0.f;
#pragma unroll
            for (int q = 0; q < 16; ++q) { const float u = bf2f(up[q]); bur += bbr[q] * u; bui += bbi[q] * u; }
            const float nr2 = abr * sr - abi * si + bur, ni2 = abr * si + abi * sr + bui;
            sr = nr2; si = ni2;
            xre[s * 65 + n] = sr; xim[s * 65 + n] = si;
        }
        __syncthreads();
        {
            const int s = n;
            float acc[16];
#pragma unroll
            for (int p = 0; p < 16; ++p) acc[p] = 0.f;
            for (int k = 0; k < 64; ++k) {
                const float xr = xre[s * 65 + k], xi = xim[s * 65 + k];
#pragma unroll
                for (int p = 0; p < 16; ++p) acc[p] += cre[p * 64 + k] * xr - cim[p * 64 + k] * xi;
            }
            const size_t row = (size_t)(b * SEQ + c * 64 + s);
            const bf16* up = proj + row * NPROJ + g * 16;
#pragma unroll
            for (int p = 0; p < 16; ++p) { const float y = acc[p] + dsk[p] * bf2f(up[p]); GY[row * 512 + g * 16 + p] = f2bf(gelu_tanh(y)); }
        }
        __syncthreads();
    }
}

__global__ __launch_bounds__(512) void k_mlstm(const bf16* __restrict__ proj, const float* __restrict__ gates, const float* conv_w, const float* conv_b, float* __restrict__ hraw) {
    __shared__ float sq[128], sk[128], sv[128], spart[4 * 128], sred[2];
    const int b = blockIdx.x >> 2, h = blockIdx.x & 3, tid = threadIdx.x, e = tid & 127, ds = tid >> 7;
    float C[32];
#pragma unroll
    for (int i = 0; i < 32; ++i) C[i] = 0.f;
    float nst = 0.f;
    int ch = 0; float cw0 = 0, cw1 = 0, cw2 = 0, cw3 = 0, cb = 0, x1 = 0, x2 = 0, x3 = 0;
    if (tid < 256) { ch = tid < 128 ? h * 128 + tid : 512 + h * 128 + (tid - 128); cw0 = conv_w[ch]; cw1 = conv_w[1024 + ch]; cw2 = conv_w[2048 + ch]; cw3 = conv_w[3072 + ch]; cb = conv_b[ch]; }
    for (int t = 0; t < SEQ; ++t) {
        const size_t row = (size_t)b * SEQ + t;
        if (tid < 256) {
            const float xv = bf2f(proj[row * NPROJ + O_Q + ch]);
            float val = cb + cw0 * x3 + cw1 * x2 + cw2 * x1 + cw3 * xv;
            x3 = x2; x2 = x1; x1 = xv;
            val = val * sigmoidf_(val);
            if (tid < 128) sq[tid] = val; else sk[tid - 128] = val * 0.08838834764831845f;
        } else if (tid < 384) sv[tid - 256] = bf2f(proj[row * NPROJ + O_V + h * 128 + (tid - 256)]);
        const float ipre = gates[row * 8 + h], fpre = gates[row * 8 + 4 + h];
        const float f = sigmoidf_(fpre), ei = __expf(ipre);
        __syncthreads();
        const float ve = sv[e] * ei; float part = 0.f;
#pragma unroll
        for (int dd = 0; dd < 32; ++dd) { const int d = ds * 32 + dd; C[dd] = f * C[dd] + sk[d] * ve; part += sq[d] * C[dd]; }
        spart[ds * 128 + e] = part;
        if (tid < 128) { nst = f * nst + ei * sk[tid]; const float dp = wave_sum(sq[tid] * nst); if ((tid & 63) == 0) sred[tid >> 6] = dp; }
        __syncthreads();
        if (tid < 128) { const float num = spart[e] + spart[128 + e] + spart[256 + e] + spart[384 + e]; const float den = sred[0] + sred[1];
            hraw[row * 512 + h * 128 + e] = num / fmaxf(fabsf(den), 1.f); }
    }
}
__global__ __launch_bounds__(256) void k_mlstm_post(const float* __restrict__ hraw, const bf16* __restrict__ proj, const float* norm_g, bf16* __restrict__ MIX) {
    const int wave = threadIdx.x >> 6, lane = threadIdx.x & 63;
    const int idx = blockIdx.x * 4 + wave; const int row = idx >> 2, h = idx & 3;
    const float* hp = hraw + (size_t)row * 512 + h * 128 + 2 * lane;
    const float a = hp[0], c = hp[1];
    const float mu = wave_sum(a + c) * (1.f / 128.f);
    const float da = a - mu, dc = c - mu;
    const float var = wave_sum(da * da + dc * dc) * (1.f / 128.f);
    const float rs = rsqrtf(var + 1e-6f);
    const int col = h * 128 + 2 * lane;
    const float o0 = bf2f(proj[(size_t)row * NPROJ + O_O + col]), o1 = bf2f(proj[(size_t)row * NPROJ + O_O + col + 1]);
    MIX[(size_t)row * D + 512 + col] = f2bf(da * rs * norm_g[col] * sigmoidf_(o0));
    MIX[(size_t)row * D + 512 + col + 1] = f2bf(dc * rs * norm_g[col + 1] * sigmoidf_(o1));
}

__global__ __launch_bounds__(256) void k_router(const float* __restrict__ H, const float* __restrict__ g, const float* __restrict__ w_r, const float* __restrict__ b_r,
                                                bf16* __restrict__ hn2, int* __restrict__ topi, float* __restrict__ topg) {
    __shared__ float srow[4][D];
    const int wave = threadIdx.x >> 6, lane = threadIdx.x & 63;
    const int row = blockIdx.x * 4 + wave;
    const float* xr = H + (size_t)row * D;
    float v[16]; float ss = 0.f;
#pragma unroll
    for (int j = 0; j < 4; ++j) { f32x4 t = *(const f32x4*)(xr + 4 * lane + 256 * j); v[4 * j] = t.x; v[4 * j + 1] = t.y; v[4 * j + 2] = t.z; v[4 * j + 3] = t.w; ss += t.x * t.x + t.y * t.y + t.z * t.z + t.w * t.w; }
    ss = wave_sum(ss);
    const float rstd = rsqrtf(ss * (1.f / D) + 1e-5f);
#pragma unroll
    for (int j = 0; j < 4; ++j) {
#pragma unroll
        for (int i = 0; i < 4; ++i) { const int k = 4 * lane + 256 * j + i; v[4 * j + i] = v[4 * j + i] * rstd * g[k]; srow[wave][k] = v[4 * j + i]; }
        uint2 o; o.x = (unsigned)f2bf(v[4 * j]) | ((unsigned)f2bf(v[4 * j + 1]) << 16); o.y = (unsigned)f2bf(v[4 * j + 2]) | ((unsigned)f2bf(v[4 * j + 3]) << 16);
        *(uint2*)(hn2 + (size_t)row * D + 4 * lane + 256 * j) = o;
    }
    __syncthreads();
    const int e = lane & 31, half = lane >> 5;
    float acc = 0.f;
    for (int k = half * 512; k < half * 512 + 512; ++k) acc += srow[wave][k] * w_r[k * NE + e];
    acc += __shfl_xor(acc, 32);
    const float logit = acc + b_r[e];
    int rank = 0;
    for (int j = 0; j < 32; ++j) { const float o = __shfl(logit, j); rank += (o > logit) || (o == logit && j < e); }
    const float lmax = wave_max(logit);
    const bool sel = (rank < 4) && (lane < 32);
    const float ex = sel ? __expf(logit - lmax) : 0.f;
    const float sum = wave_sum(ex);
    if (sel) { topi[(size_t)row * 4 + rank] = e; topg[(size_t)row * 4 + rank] = ex / sum; }
}

__global__ __launch_bounds__(256) void k_count(const int* __restrict__ topi, int* __restrict__ counts) {
    __shared__ int hist[NE];
    if (threadIdx.x < NE) hist[threadIdx.x] = 0;
    __syncthreads();
    const int i = blockIdx.x * 256 + threadIdx.x;
    if (i < NASSIGN) atomicAdd(&hist[topi[i]], 1);
    __syncthreads();
    if (threadIdx.x < NE && hist[threadIdx.x]) atomicAdd(&counts[threadIdx.x], hist[threadIdx.x]);
}
__global__ void k_plan(int* ctl) {
    if (threadIdx.x == 0) {
        int ps = 0;
        for (int e = 0; e < NE; ++e) {
            const int c = ctl[e], nb = (c + MBLK - 1) / MBLK;
            ctl[64 + e] = ps;
            for (int b = 0; b < nb; ++b) ctl[128 + ps / MBLK + b] = e;
            ps += nb * MBLK;
        }
        ctl[96] = ps / MBLK;
    }
}
__global__ __launch_bounds__(256) void k_scatter(const int* __restrict__ topi, int* __restrict__ ctl, int* __restrict__ slot_tok, int* __restrict__ tok_slot) {
    __shared__ int hist[NE], base[NE];
    if (threadIdx.x < NE) hist[threadIdx.x] = 0;
    __syncthreads();
    const int i = blockIdx.x * 256 + threadIdx.x;
    const int e = topi[i];
    const int lp = atomicAdd(&hist[e], 1);
    __syncthreads();
    if (threadIdx.x < NE) base[threadIdx.x] = hist[threadIdx.x] ? atomicAdd(&ctl[32 + threadIdx.x], hist[threadIdx.x]) : 0;
    __syncthreads();
    const int slot = ctl[64 + e] + base[e] + lp;
    slot_tok[slot] = i >> 2; tok_slot[i] = slot;
}

__global__ __launch_bounds__(256) void k_combine(const float* __restrict__ H, const bf16* __restrict__ YS, const int* __restrict__ tok_slot, const float* __restrict__ topg,
                                                 const float* __restrict__ gfin, float* __restrict__ out) {
    const int wave = threadIdx.x >> 6, lane = threadIdx.x & 63;
    const int row = blockIdx.x * 4 + wave;
    float v[16]; float ss = 0.f;
#pragma unroll
    for (int j = 0; j < 4; ++j) { f32x4 t = *(const f32x4*)(H + (size_t)row * D + 4 * lane + 256 * j); v[4 * j] = t.x; v[4 * j + 1] = t.y; v[4 * j + 2] = t.z; v[4 * j + 3] = t.w; }
    for (int k = 0; k < 4; ++k) {
        const int slot = tok_slot[row * 4 + k]; const float gt = topg[row * 4 + k];
#pragma unroll
        for (int j = 0; j < 4; ++j) { const uint2 y = *(const uint2*)(YS + (size_t)slot * D + 4 * lane + 256 * j);
            v[4 * j] += gt * __uint_as_float(y.x << 16); v[4 * j + 1] += gt * __uint_as_float(y.x & 0xffff0000u); v[4 * j + 2] += gt * __uint_as_float(y.y << 16); v[4 * j + 3] += gt * __uint_as_float(y.y & 0xffff0000u); }
    }
#pragma unroll
    for (int i = 0; i < 16; ++i) ss += v[i] * v[i];
    ss = wave_sum(ss);
    const float rstd = rsqrtf(ss * (1.f / D) + 1e-5f);
#pragma unroll
    for (int j = 0; j < 4; ++j) { const f32x4 gg = *(const f32x4*)(gfin + 4 * lane + 256 * j);
        f32x4 o; o.x = v[4 * j] * rstd * gg.x; o.y = v[4 * j + 1] * rstd * gg.y; o.z = v[4 * j + 2] * rstd * gg.z; o.w = v[4 * j + 3] * rstd * gg.w;
        *(f32x4*)(out + (size_t)row * D + 4 * lane + 256 * j) = o; }
}

extern "C" void kernel_launch(void* const* d_in, const int* in_sizes, int n_in, void* d_out, int out_size, void* d_ws, size_t ws_size, hipStream_t stream) {
    const float* x = (const float*)d_in[0]; const float* norm_mix_g = (const float*)d_in[1]; const float* w_in = (const float*)d_in[2];
    const float* s5_log_dt = (const float*)d_in[3]; const float* s5_a_re = (const float*)d_in[4]; const float* s5_a_im = (const float*)d_in[5];
    const float* s5_b_re = (const float*)d_in[6]; const float* s5_b_im = (const float*)d_in[7]; const float* s5_c_re = (const float*)d_in[8]; const float* s5_c_im = (const float*)d_in[9];
    const float* s5_d = (const float*)d_in[10]; const float* s5_w_glu = (const float*)d_in[11]; const float* s5_b_glu = (const float*)d_in[12];
    const float* ml_conv_w = (const float*)d_in[13]; const float* ml_conv_b = (const float*)d_in[14]; const float* ml_b_gates = (const float*)d_in[15]; const float* ml_norm_g = (const float*)d_in[16];
    const float* w_out = (const float*)d_in[17]; const float* norm_ffn_g = (const float*)d_in[18]; const float* w_router = (const float*)d_in[19]; const float* b_router = (const float*)d_in[20];
    const float* w_up = (const float*)d_in[21]; const float* b_up = (const float*)d_in[22]; const float* w_down = (const float*)d_in[23]; const float* b_down = (const float*)d_in[24];
    const float* norm_final_g = (const float*)d_in[25];
    float* out = (float*)d_out;
    unsigned char* ws = (unsigned char*)d_ws;
    constexpr size_t MiB = 1u << 20;
    int* ctl = (int*)(ws);
    float* gates = (float*)(ws + 1 * MiB);
    int* topi = (int*)(ws + 2 * MiB);
    float* topg = (float*)(ws + 3 * MiB);
    int* slot_tok = (int*)(ws + 4 * MiB);
    int* tok_slot = (int*)(ws + 5 * MiB);
    bf16* HN = (bf16*)(ws + 8 * MiB);
    bf16* PROJ = (bf16*)(ws + 72 * MiB);
    bf16* GY = (bf16*)(ws + 232 * MiB);
    bf16* MIX = (bf16*)(ws + 264 * MiB);
    float* HRAW = (float*)(ws + 328 * MiB);
    float* H = (float*)(ws + 392 * MiB);
    bf16* YS = (bf16*)(ws + 520 * MiB);
    bf16* ACT = PROJ;
    (void)in_sizes; (void)n_in; (void)out_size; (void)ws_size;

    (void)hipMemsetAsync(ctl, 0, 1 * MiB, stream);
    (void)hipMemsetAsync(slot_tok, 0, NSLOTS * sizeof(int), stream);
    k_rms_in<<<T / 4, 256, 0, stream>>>(x, norm_mix_g, w_in, ml_b_gates, HN, gates);
    k_gemm<ARows, BPlain, EpiProj, false><<<(T / 128) * (NPROJ / 128), 256, 0, stream>>>(ARows{HN, D, 0}, BPlain{w_in, DIN, NPROJ}, EpiProj{PROJ}, D, NPROJ / 128);
    k_s5<<<NB * 32, 64, 0, stream>>>(PROJ, s5_log_dt, s5_a_re, s5_a_im, s5_b_re, s5_b_im, s5_c_re, s5_c_im, s5_d, GY);
    k_mlstm<<<NB * 4, 512, 0, stream>>>(PROJ, gates, ml_conv_w, ml_conv_b, HRAW);
    k_mlstm_post<<<T * 4 / 4, 256, 0, stream>>>(HRAW, PROJ, ml_norm_g, MIX);
    k_gemm<ARows, BPlain, EpiGlu, false><<<(T / 128) * 4, 256, 0, stream>>>(ARows{GY, 512, 0}, BPlain{s5_w_glu, 512, 512}, EpiGlu{GY, s5_b_glu, MIX}, 512, 4);
    k_gemm<ARows, BPlain, EpiOut, false><<<(T / 128) * 8, 256, 0, stream>>>(ARows{MIX, D, 0}, BPlain{w_out, D, D}, EpiOut{x, H}, D, 8);
    k_router<<<T / 4, 256, 0, stream>>>(H, norm_ffn_g, w_router, b_router, HN, topi, topg);
    k_count<<<NASSIGN / 256, 256, 0, stream>>>(topi, ctl);
    k_plan<<<1, 64, 0, stream>>>(ctl);
    k_scatter<<<NASSIGN / 256, 256, 0, stream>>>(topi, ctl, slot_tok, tok_slot);
    k_gemm<AGather, BUp, EpiUp, true><<<NMBLK * 16, 256, 0, stream>>>(AGather{HN, slot_tok, ctl + 96}, BUp{w_up, ctl + 128, 2 * FF, 0}, EpiUp{b_up, ctl + 128, ACT}, D, 16);
    k_gemm<ASlots, BDown, EpiDown, false><<<NMBLK * 8, 256, 0, stream>>>(ASlots{ACT, ctl + 96}, BDown{w_down, ctl + 128, D, 0}, EpiDown{b_down, ctl + 128, YS}, FF, 8);
    k_combine<<<T / 4, 256, 0, stream>>>(H, YS, tok_slot, topg, norm_final_g, out);
}
```

```cpp
#include <hip/hip_runtime.h>
#include <cstdio>
#include <cstdint>

#define GAS __attribute__((address_space(1)))
#define LAS __attribute__((address_space(3)))
typedef unsigned short bf16;
typedef short bf16x8 __attribute__((ext_vector_type(8)));
typedef float f32x4 __attribute__((ext_vector_type(4)));
typedef float f32x16 __attribute__((ext_vector_type(16)));
typedef unsigned u32x4 __attribute__((ext_vector_type(4)));
typedef GAS unsigned gu32;

constexpr int NB = 4, SEQ = 8192, T = NB * SEQ, D = 1024;
constexpr int DIN = 2568, NPROJ = 2560;
constexpr int O_Q = 512, O_K = 1024, O_V = 1536, O_O = 2048, O_G = 2560;
constexpr int NE = 32, TOPK = 4, FF = 1024;
constexpr int NASSIGN = T * TOPK;
constexpr int MT = 256;
constexpr int NSLOTS = NASSIGN + NE * MT;
constexpr int MAXTILES = NSLOTS / MT;
constexpr int NWAVES = 8, NTHR = 512;

constexpr size_t MiB = 1u << 20;
constexpr size_t WS_CTL = 0, CTL_ZERO_BYTES = 1 * MiB;
constexpr size_t WS_GATES = 1 * MiB;
constexpr size_t WS_TOPI = 2 * MiB;
constexpr size_t WS_TOPG = 3 * MiB;
constexpr size_t WS_SLOTTOK = 4 * MiB;
constexpr size_t WS_TOKSLOT = 5 * MiB;
constexpr size_t WS_CNT = 6 * MiB;
constexpr size_t WS_WIN = 8 * MiB;
constexpr size_t WS_WGLU = 13 * MiB;
constexpr size_t WS_WOUT = 14 * MiB;
constexpr size_t WS_WUP = 16 * MiB;
constexpr size_t WS_WDN = 144 * MiB;
constexpr size_t WS_HN = 208 * MiB;
constexpr size_t WS_PROJ = 272 * MiB;
constexpr size_t WS_GY = 432 * MiB;
constexpr size_t WS_MIX = 464 * MiB;
constexpr size_t WS_HRAW = 528 * MiB;
constexpr size_t WS_ACT = 272 * MiB;
constexpr size_t WS_H = 592 * MiB;
constexpr size_t WS_YS = 720 * MiB;
constexpr size_t WS_END = 992 * MiB;
constexpr int S5K = 1152;
constexpr size_t WS_S5A = 720 * MiB;
constexpr size_t WS_S5BT = 760 * MiB;
constexpr size_t WS_S5BQ = 836 * MiB;
constexpr size_t WS_XLOC = 856 * MiB;
constexpr size_t WS_QH = 866 * MiB;
constexpr size_t WS_KH = 898 * MiB;
constexpr size_t WS_VT = 930 * MiB;
constexpr size_t WS_DC = 962 * MiB;
constexpr size_t WS_CST = 978 * MiB;
constexpr size_t WS_FLOC = 986 * MiB;
constexpr size_t WS_DN = 987 * MiB;
constexpr size_t WS_NST = 988 * MiB;
constexpr size_t WS_SEGS = 989 * MiB;
static_assert(WS_S5A + (size_t)32 * 512 * S5K * 2 <= WS_S5BT && WS_S5BT + (size_t)32 * 1024 * S5K * 2 <= WS_S5BQ && WS_S5BQ + (size_t)32 * 256 * 1024 * 2 <= WS_XLOC && WS_XLOC + (size_t)32 * 512 * 128 * 4 <= WS_END, "s5 map");
static_assert(WS_ACT + (size_t)NSLOTS * FF * 2 <= WS_H && WS_YS + (size_t)NSLOTS * D * 2 <= WS_END, "ws map");
constexpr int CW_BAR = 4096;

constexpr int RING_BYTES = 131072;
constexpr int MISC_OFF = RING_BYTES;
constexpr int IDX_OFF = MISC_OFF + 128;
constexpr int TIL_OFF = IDX_OFF + 2048;
constexpr int LDS_BYTES = 147456;
static_assert(TIL_OFF + 3 * MAXTILES * 4 + 256 <= LDS_BYTES, "LDS map");

#define RLX_AGENT __ATOMIC_RELAXED, __HIP_MEMORY_SCOPE_AGENT
__device__ __forceinline__ float bf2f(bf16 v) { return __uint_as_float(((unsigned)v) << 16); }
__device__ __forceinline__ bf16 f2bf(float f) { unsigned u = __float_as_uint(f); u += 0x7fffu + ((u >> 16) & 1u); return (bf16)(u >> 16); }
__device__ __forceinline__ unsigned pk2(float lo, float hi) { return (unsigned)f2bf(lo) | ((unsigned)f2bf(hi) << 16); }
__device__ __forceinline__ unsigned cvt_pk_bf16(float lo, float hi) { unsigned r; asm volatile("v_cvt_pk_bf16_f32 %0, %1, %2" : "=v"(r) : "v"(lo), "v"(hi)); return r; }
__device__ __forceinline__ float lo_bf(unsigned u) { return __uint_as_float(u << 16); }
__device__ __forceinline__ float hi_bf(unsigned u) { return __uint_as_float(u & 0xffff0000u); }
__device__ __forceinline__ float wave_sum(float v) {
#pragma unroll
    for (int o = 1; o < 64; o <<= 1) v += __shfl_xor(v, o);
    return v;
}
__device__ __forceinline__ float sigmoidf_(float x) { return 1.f / (1.f + __expf(-x)); }
__device__ __forceinline__ float gelu_tanh(float x) { const float u = 1.5957691216057308f * (x + 0.044715f * x * x * x); return x / (1.f + __expf(-u)); }

#define XB_TMO      128
#define XB_XCNT(j)  (256  + 64 * (j))
#define XB_XSUB(j)  (1280 + 64 * (j))
#define XB_XGEN(j)  (2304 + 64 * (j))
#define XB_TOP      3328
#define XB_TOPGEN   3392
#define XCD_BAR_WORDS 3456
#define XB_SPIN_CAP (1u << 18)
__device__ __forceinline__ unsigned xb_ld(unsigned* p)              { return __hip_atomic_load(p, __ATOMIC_RELAXED, __HIP_MEMORY_SCOPE_AGENT); }
__device__ __forceinline__ unsigned xb_add(unsigned* p, unsigned v) { return __hip_atomic_fetch_add(p, v, __ATOMIC_RELAXED, __HIP_MEMORY_SCOPE_AGENT); }
__device__ __forceinline__ unsigned xb_xcc_id() { return (unsigned)__builtin_amdgcn_s_getreg((3 << 11) | 20) & 0xFu; }
#define XB_SPIN(cond, bar) do { unsigned _sp = 0; while (cond) { __builtin_amdgcn_s_sleep(1); \
    if ((++_sp & 255u) == 0u) { if (xb_ld(&(bar)[XB_TMO])) break; if (_sp > XB_SPIN_CAP) { atomicAdd(&(bar)[XB_TMO], 1u); break; } } } } while (0)
struct XcdBarrier { unsigned* bar; unsigned x; volatile LAS unsigned* st; };
__device__ __forceinline__ XcdBarrier xcd_barrier_post(unsigned* bar, volatile LAS unsigned* st) {
    XcdBarrier b; b.bar = bar; b.x = xb_xcc_id(); b.st = st;
    if (threadIdx.x == 0) (void)xb_add(&bar[XB_XCNT(b.x)], 1u);
    return b;
}
__device__ __forceinline__ void xcd_barrier_complete(unsigned* bar, unsigned x, unsigned& nloc, unsigned& nx) {
    const unsigned G = gridDim.x * gridDim.y * gridDim.z;
    unsigned sum, cnt, mine, sp = 0u;
    for (;;) {
        sum = 0u; cnt = 0u; mine = 0u;
#pragma unroll
        for (unsigned j = 0; j < 16; ++j) { const unsigned c = xb_ld(&bar[XB_XCNT(j)]); sum += c; cnt += (c > 0u) ? 1u : 0u; mine = (j == x) ? c : mine; }
        if (sum == G) break;
        __builtin_amdgcn_s_sleep(1);
        if ((++sp & 255u) == 0u) { if (xb_ld(&bar[XB_TMO])) break; if (sp > XB_SPIN_CAP) { atomicAdd(&bar[XB_TMO], 1u); break; } }
    }
    nloc = mine > 0u ? mine : 1u; nx = cnt > 0u ? cnt : 1u;
}
__device__ __forceinline__ void xcd_barrier(const XcdBarrier& b) {
    asm volatile("s_waitcnt vmcnt(0)" ::: "memory");
    __syncthreads();
    if (threadIdx.x == 0) {
        unsigned* bar = b.bar;
        __builtin_amdgcn_s_waitcnt(0);
        unsigned nloc = b.st[0], nx = b.st[1];
        if (nloc == 0u) { xcd_barrier_complete(bar, b.x, nloc, nx); b.st[0] = nloc; b.st[1] = nx; }
        const unsigned old = xb_add(&bar[XB_XSUB(b.x)], 1u);
        const unsigned gen = old / nloc;
        if (old + 1u == (gen + 1u) * nloc) {
            __builtin_amdgcn_fence(__ATOMIC_RELEASE, "agent");
            asm volatile("s_waitcnt vmcnt(0)" ::: "memory");
            const unsigned og = xb_add(&bar[XB_TOP], 1u);
            const unsigned tg = og / nx;
            if (og + 1u == (tg + 1u) * nx) xb_add(&bar[XB_TOPGEN], 1u);
            else XB_SPIN(xb_ld(&bar[XB_TOPGEN]) == tg, bar);
            __builtin_amdgcn_fence(__ATOMIC_ACQUIRE, "agent");
            xb_add(&bar[XB_XGEN(b.x)], 1u);
            asm volatile("s_waitcnt vmcnt(0)" ::: "memory");
        } else {
            XB_SPIN(xb_ld(&bar[XB_XGEN(b.x)]) == gen, bar);
            __builtin_amdgcn_fence(__ATOMIC_ACQUIRE, "agent");
            asm volatile("s_waitcnt vmcnt(0)" ::: "memory");
        }
    }
    __syncthreads();
}

namespace pg {
constexpr int BM = 256, BK = 64, HALF = 128, HTB = HALF * BK * 2, STAGE_BYTES = 8 * HTB, NXCD = 8, WGM = 8;
__host__ __device__ __forceinline__ int lds_byte(int r, int c) { const int st = (r >> 4) * 2 + (c >> 5), rr = r & 15, cc = c & 31, ob = rr * 64 + cc * 2; return st * 1024 + (ob ^ (((ob >> 9) & 1) << 5)); }
__host__ __device__ __forceinline__ void stage_rc(int b, int& R, int& C) { const int st = b / 1024, sb = b % 1024, swz = sb ^ (((sb >> 9) & 1) << 5); R = (st >> 1) * 16 + swz / 64; C = (st & 1) * 32 + (swz % 64) / 2; }
__host__ __device__ __forceinline__ int perm32(int rho) { const int n = rho >> 4, i = rho & 15; return 8 * (i >> 2) + 4 * n + (i & 3); }

struct Unit { const char* A; const char* B; int pm, pn, e, nrows; };

__device__ __forceinline__ bool tile_order(int i, int G, int c, int nM, int nN, int& pm, int& pn) {
    const int nwg = nM * nN; const long L = (long)i * G + c; if (L >= nwg) return false;
    int wgid = (int)L; { const int q = nwg / NXCD, r = nwg % NXCD, xcd = wgid % NXCD, off = wgid / NXCD; wgid = (xcd < r ? xcd * (q + 1) : r * (q + 1) + (xcd - r) * q) + off; }
    const int nig = WGM * nN, gid = wgid / nig, fm = gid * WGM, gsz = (nM - fm) < WGM ? (nM - fm) : WGM;
    pm = fm + ((wgid % nig) % gsz); pn = (wgid % nig) / gsz; return true;
}
struct DenseSched {
    const char* A; const char* Bt; int lda2  , K2  , nM, nN, G, c;
    __device__ __forceinline__ bool next(int i, Unit& u) const { int pm, pn; if (!tile_order(i, G, c, nM, nN, pm, pn)) return false;
        u.A = A + (size_t)pm * 256 * lda2; u.B = Bt + (size_t)pn * 256 * K2; u.pm = pm; u.pn = pn; u.e = 0; u.nrows = 256; return true; }
    __device__ __forceinline__ void prefetch(const Unit&, int) const {}
    __device__ __forceinline__ unsigned aoff(const Unit&, int row, int) const { return (unsigned)row * (unsigned)lda2; }
};

template <class Epi, class Sched, bool ALIGN_EPI>
__device__ __forceinline__ void gemm_phase(LAS unsigned char* lds, const int K, const Sched& S, const Epi& E) {
    const int tid = threadIdx.x, wid = __builtin_amdgcn_readfirstlane(tid >> 6), lane = tid & 63, wr = wid >> 2, wc = wid & 3, fr = lane & 15, fq = lane >> 4;
    const int nt = K / BK;
    unsigned voffA[2][2], voffB[2];
#pragma unroll
    for (int i = 0; i < 2; ++i) { int R, C; stage_rc(tid * 16 + i * 8192, R, C); const int Rb = Epi::PERM ? ((R & ~31) + perm32(R & 31)) : R; voffB[i] = (unsigned)(Rb * K + C) * 2u; }
    const size_t kstep = (size_t)(BK * 2);
    const size_t hstep = (size_t)HALF * K * 2;
    const unsigned ldsw = (unsigned)wid * 1024u;
    const int aoff = lds_byte(wr * 64 + fr, fq * 8), boff = lds_byte(wc * 32 + fr, fq * 8);
#define PG_SA(b, h) (((b) * 2 + (h)) * HTB)
#define PG_SB(b, h) ((4 + (b) * 2 + (h)) * HTB)
#define PG_STAGE(bufoff, gbase, voff) do { _Pragma("unroll") for (int _i = 0; _i < 2; ++_i) \
        __builtin_amdgcn_global_load_lds((const unsigned*)((const char*)(gbase) + (voff)[_i]), (LAS unsigned*)(lds + (bufoff) + ldsw + _i * 8192), 16, 0, 0); } while (0)
#define PG_LDA(dst, b, h) do { _Pragma("unroll") for (int m = 0; m < 4; ++m) _Pragma("unroll") for (int k = 0; k < 2; ++k) dst[m][k] = *(const LAS bf16x8*)(lds + PG_SA(b, h) + aoff + m * 2048 + k * 1024); } while (0)
#define PG_LDB(dst, b, h) do { _Pragma("unroll") for (int n = 0; n < 2; ++n) _Pragma("unroll") for (int k = 0; k < 2; ++k) dst[n][k] = *(const LAS bf16x8*)(lds + PG_SB(b, h) + boff + n * 2048 + k * 1024); } while (0)
#define PG_MMA(ai, bj, At, Bt) do { __builtin_amdgcn_s_setprio(1); _Pragma("unroll") for (int m = 0; m < 4; ++m) _Pragma("unroll") for (int n = 0; n < 2; ++n) _Pragma("unroll") for (int k = 0; k < 2; ++k) \
        acc[ai][bj][m][n] = __builtin_amdgcn_mfma_f32_16x16x32_bf16(Bt[n][k], At[m][k], acc[ai][bj][m][n], 0, 0, 0); __builtin_amdgcn_s_setprio(0); } while (0)
#define PG_WAIT_V(n) asm volatile("s_waitcnt vmcnt(" #n ")" ::: "memory")
#define PG_WAIT_L(n) asm volatile("s_waitcnt lgkmcnt(" #n ")" ::: "memory")
#define PG_BAR __builtin_amdgcn_s_barrier()
#define PG_SCHED __builtin_amdgcn_sched_barrier(0)
#define PG_SET_AOFF(u, ib) do { _Pragma("unroll") for (int _i = 0; _i < 2; ++_i) { int _R, _C; stage_rc(tid * 16 + _i * 8192, _R, _C); \
        voffA[0][_i] = S.aoff(u, _R, ib) + (unsigned)_C * 2u; voffA[1][_i] = S.aoff(u, _R + HALF, ib) + (unsigned)_C * 2u; } } while (0)
    Unit cur, nxt; int ui = 0;
    if (!S.next(0, cur)) return;
    f32x4 acc[2][2][4][2];
#pragma unroll
    for (int a = 0; a < 2; ++a)
#pragma unroll
        for (int b = 0; b < 2; ++b)
#pragma unroll
            for (int m = 0; m < 4; ++m)
#pragma unroll
                for (int n = 0; n < 2; ++n) acc[a][b][m][n] = (f32x4){0.f, 0.f, 0.f, 0.f};
    bf16x8 At[4][2], B0[2][2], B1[2][2];
    const char* cA = cur.A; const char* cB = cur.B;
    S.prefetch(cur, 0);
    PG_WAIT_V(0); __syncthreads();
    PG_SET_AOFF(cur, 0);
    PG_STAGE(PG_SB(0, 0), cB, voffB); PG_STAGE(PG_SB(0, 1), cB + hstep, voffB); PG_STAGE(PG_SA(0, 0), cA, voffA[0]); PG_STAGE(PG_SA(0, 1), cA, voffA[1]);
    if (wr == 1) PG_BAR;
    PG_WAIT_V(2); PG_BAR;
    PG_STAGE(PG_SB(1, 0), cB + kstep, voffB); PG_STAGE(PG_SA(1, 0), cA + kstep, voffA[0]); PG_STAGE(PG_SB(1, 1), cB + hstep + kstep, voffB);
    PG_WAIT_V(6); PG_BAR;
    for (;;) {
        const bool has_next = S.next(ui + 1, nxt);
        const char* nA = has_next ? nxt.A : cA; const char* nB = has_next ? nxt.B : cB;
        if (has_next) S.prefetch(nxt, (ui + 1) & 1);
        for (int t = 0; t < nt; t += 2) {
            const bool last = (t == nt - 2);
            const char* a1 = cA + (size_t)(t + 1) * kstep;
            const char* a2 = last ? nA : cA + (size_t)(t + 2) * kstep; const char* b2 = last ? nB : cB + (size_t)(t + 2) * kstep;
            const char* a3 = a2 + kstep; const char* b3 = b2 + kstep;
            PG_LDB(B0, 0, 0); PG_LDB(B1, 0, 1); PG_SCHED; PG_LDA(At, 0, 0); PG_STAGE(PG_SA(1, 1), a1, voffA[1]);
            PG_WAIT_V(8); PG_WAIT_L(0); PG_BAR; PG_MMA(0, 0, At, B0); PG_MMA(0, 1, At, B1); PG_BAR; PG_SCHED;
            if (last && has_next) PG_SET_AOFF(nxt, (ui + 1) & 1);
            PG_LDA(At, 0, 1); PG_STAGE(PG_SB(0, 0), b2, voffB); PG_STAGE(PG_SB(0, 1), b2 + hstep, voffB); PG_STAGE(PG_SA(0, 0), a2, voffA[0]);
            PG_WAIT_V(8); PG_WAIT_L(0); PG_BAR; PG_MMA(1, 0, At, B0); PG_MMA(1, 1, At, B1); PG_BAR; PG_SCHED;
            PG_LDB(B0, 1, 0); PG_LDB(B1, 1, 1); PG_SCHED; PG_LDA(At, 1, 0); PG_STAGE(PG_SA(0, 1), a2, voffA[1]);
            PG_WAIT_V(8); PG_WAIT_L(0); PG_BAR; PG_MMA(0, 0, At, B0); PG_MMA(0, 1, At, B1); PG_BAR; PG_SCHED;
            PG_LDA(At, 1, 1); PG_STAGE(PG_SB(1, 0), b3, voffB); PG_STAGE(PG_SB(1, 1), b3 + hstep, voffB); PG_STAGE(PG_SA(1, 0), a3, voffA[0]);
            PG_WAIT_V(8); PG_WAIT_L(0); PG_BAR; PG_MMA(1, 0, At, B0); PG_MMA(1, 1, At, B1); PG_BAR; PG_SCHED;
        }
        if constexpr (ALIGN_EPI) { if (wr == 0) PG_BAR; }
        E(acc, cur, wr, wc, fr, fq);
        if (!has_next) break;
#pragma unroll
        for (int a = 0; a < 2; ++a)
#pragma unroll
            for (int b = 0; b < 2; ++b)
#pragma unroll
                for (int m = 0; m < 4; ++m)
#pragma unroll
                    for (int n = 0; n < 2; ++n) acc[a][b][m][n] = (f32x4){0.f, 0.f, 0.f, 0.f};
        cur = nxt; cA = nA; cB = nB; ++ui;
        if constexpr (ALIGN_EPI) { if (wr == 1) PG_BAR; }
    }
    PG_WAIT_V(0);
    if constexpr (!ALIGN_EPI) { if (wr == 0) PG_BAR; }
    PG_BAR;
#undef PG_SA
#undef PG_SB
#undef PG_STAGE
#undef PG_LDA
#undef PG_LDB
#undef PG_MMA
#undef PG_WAIT_V
#undef PG_WAIT_L
#undef PG_BAR
#undef PG_SCHED
#undef PG_SET_AOFF
}

struct EpiProj {
    static constexpr bool PERM = true; bf16* P; bf16* S5A;
    __device__ __forceinline__ void operator()(const f32x4 (&acc)[2][2][4][2], const Unit& u, int wr, int wc, int fr, int fq) const {
        const int row0 = u.pm * BM + wr * 64 + fr, col0 = u.pn * BM + wc * 32 + 8 * fq;
#pragma unroll
        for (int ai = 0; ai < 2; ++ai)
#pragma unroll
            for (int m = 0; m < 4; ++m) { const int row = row0 + ai * HALF + m * 16; bf16* rowp = P + (size_t)row * NPROJ + col0;
                if (u.pn < 2) { const int b = row >> 13, tt = row & 8191; rowp = S5A + ((size_t)b * 128 + (tt >> 6)) * S5K + (tt & 63) * 16 + (col0 & 15) + (size_t)(col0 >> 4) * 512 * S5K - (size_t)0; }
#pragma unroll
                for (int bj = 0; bj < 2; ++bj) { const f32x4 v0 = acc[ai][bj][m][0], v1 = acc[ai][bj][m][1];
                    u32x4 w; w.x = cvt_pk_bf16(v0[0], v0[1]); w.y = cvt_pk_bf16(v0[2], v0[3]); w.z = cvt_pk_bf16(v1[0], v1[1]); w.w = cvt_pk_bf16(v1[2], v1[3]);
                    *(u32x4*)(rowp + (u.pn < 2 ? (size_t)bj * 8 * 512 * S5K : (size_t)bj * HALF)) = w; } }
    }
};
struct EpiXloc {
    static constexpr bool PERM = false; float* X;
    __device__ __forceinline__ void operator()(const f32x4 (&acc)[2][2][4][2], const Unit& u, int wr, int wc, int fr, int fq) const {
        const int row0 = (u.pm & 1) * BM + wr * 64 + fr, col0 = wc * 32 + 4 * fq;
#pragma unroll
        for (int ai = 0; ai < 2; ++ai)
#pragma unroll
            for (int m = 0; m < 4; ++m) { float* rp = X + ((size_t)u.e * 512 + row0 + ai * HALF + m * 16) * 128 + col0;
#pragma unroll
                for (int n = 0; n < 2; ++n) *(f32x4*)(rp + n * 16) = acc[ai][0][m][n]; }
    }
};
struct EpiS5Y {
    static constexpr bool PERM = true; const bf16* S5A; const float* dskip; bf16* GY;
    __device__ __forceinline__ void operator()(const f32x4 (&acc)[2][2][4][2], const Unit& u, int wr, int wc, int fr, int fq) const {
        const int g = u.e, rg0 = (u.pm & 1) * BM + wr * 64 + fr, c0 = u.pn * BM + wc * 32 + 8 * fq;
#pragma unroll
        for (int bj = 0; bj < 2; ++bj) { const int col = c0 + bj * HALF, t = col >> 4, p0 = col & 15;
            const f32x4 d0 = *(const f32x4*)(dskip + g * 16 + p0), d1 = *(const f32x4*)(dskip + g * 16 + p0 + 4);
#pragma unroll
            for (int ai = 0; ai < 2; ++ai)
#pragma unroll
                for (int m = 0; m < 4; ++m) { const int rg = rg0 + ai * HALF + m * 16; const int b = rg >> 7, c = rg & 127;
                    const u32x4 uu = *(const u32x4*)(S5A + ((size_t)g * 512 + rg) * S5K + col);
                    const f32x4 v0 = acc[ai][bj][m][0], v1 = acc[ai][bj][m][1];
                    u32x4 w;
                    w.x = cvt_pk_bf16(gelu_tanh(v0[0] + d0[0] * lo_bf(uu.x)), gelu_tanh(v0[1] + d0[1] * hi_bf(uu.x))); w.y = cvt_pk_bf16(gelu_tanh(v0[2] + d0[2] * lo_bf(uu.y)), gelu_tanh(v0[3] + d0[3] * hi_bf(uu.y)));
                    w.z = cvt_pk_bf16(gelu_tanh(v1[0] + d1[0] * lo_bf(uu.z)), gelu_tanh(v1[1] + d1[1] * hi_bf(uu.z))); w.w = cvt_pk_bf16(gelu_tanh(v1[2] + d1[2] * lo_bf(uu.w)), gelu_tanh(v1[3] + d1[3] * hi_bf(uu.w)));
                    *(u32x4*)(GY + ((size_t)b * SEQ + c * 64 + t) * 512 + g * 16 + p0) = w; } }
    }
};
struct S5Sched {
    const char* A; const char* B; int lda2, K2, brows, nN, G, c;
    __device__ __forceinline__ bool next(int i, Unit& u) const { const int L = i * G + c; if (L >= 64 * nN) return false;
        const int g = L / (2 * nN), r = L % (2 * nN), mh = r / nN, pn = r % nN;
        u.A = A + ((size_t)g * 512 + mh * 256) * lda2; u.B = B + ((size_t)g * brows + pn * 256) * K2; u.pm = g * 2 + mh; u.pn = pn; u.e = g; u.nrows = 256; return true; }
    __device__ __forceinline__ void prefetch(const Unit&, int) const {}
    __device__ __forceinline__ unsigned aoff(const Unit&, int row, int) const { return (unsigned)row * (unsigned)lda2; }
};
struct EpiGlu {
    static constexpr bool PERM = true; const bf16* GY; const float* bglu; bf16* MIX;
    __device__ __forceinline__ void operator()(const f32x4 (&acc)[2][2][4][2], const Unit& u, int wr, int wc, int fr, int fq) const {
        const int row0 = u.pm * BM + wr * 64 + fr, col0 = u.pn * BM + wc * 32 + 8 * fq;
#pragma unroll
        for (int bj = 0; bj < 2; ++bj) { const int col = col0 + bj * HALF;
            const f32x4 b0 = *(const f32x4*)(bglu + col), b1 = *(const f32x4*)(bglu + col + 4);
#pragma unroll
            for (int ai = 0; ai < 2; ++ai)
#pragma unroll
                for (int m = 0; m < 4; ++m) { const size_t row = (size_t)(row0 + ai * HALF + m * 16);
                    const u32x4 g = *(const u32x4*)(GY + row * 512 + col);
                    const f32x4 v0 = acc[ai][bj][m][0] + b0, v1 = acc[ai][bj][m][1] + b1;
                    u32x4 w;
                    w.x = cvt_pk_bf16(lo_bf(g.x) * sigmoidf_(v0[0]), hi_bf(g.x) * sigmoidf_(v0[1])); w.y = cvt_pk_bf16(lo_bf(g.y) * sigmoidf_(v0[2]), hi_bf(g.y) * sigmoidf_(v0[3]));
                    w.z = cvt_pk_bf16(lo_bf(g.z) * sigmoidf_(v1[0]), hi_bf(g.z) * sigmoidf_(v1[1])); w.w = cvt_pk_bf16(lo_bf(g.w) * sigmoidf_(v1[2]), hi_bf(g.w) * sigmoidf_(v1[3]));
                    *(u32x4*)(MIX + row * D + col) = w; } }
    }
};
struct EpiOut {
    static constexpr bool PERM = false; const float* x; float* H;
    __device__ __forceinline__ void operator()(const f32x4 (&acc)[2][2][4][2], const Unit& u, int wr, int wc, int fr, int fq) const {
        const int row0 = u.pm * BM + wr * 64 + fr, col0 = u.pn * BM + wc * 32 + 4 * fq;
#pragma unroll
        for (int ai = 0; ai < 2; ++ai)
#pragma unroll
            for (int m = 0; m < 4; ++m) { const size_t ro = (size_t)(row0 + ai * HALF + m * 16) * D + col0;
#pragma unroll
                for (int bj = 0; bj < 2; ++bj)
#pragma unroll
                    for (int n = 0; n < 2; ++n) *(f32x4*)(H + ro + bj * HALF + n * 16) = *(const f32x4*)(x + ro + bj * HALF + n * 16) + acc[ai][bj][m][n]; }
    }
};
struct EpiUp {
    static constexpr bool PERM = true; const float* b_up; bf16* ACT;
    __device__ __forceinline__ void operator()(const f32x4 (&acc)[2][2][4][2], const Unit& u, int wr, int wc, int fr, int fq) const {
        const int row0 = u.pm * BM + wr * 64 + fr, j0 = u.pn * HALF + wc * 32 + 8 * fq;
        const float* bg = b_up + (size_t)u.e * 2 * FF + j0;
        const f32x4 g0 = *(const f32x4*)bg, g1 = *(const f32x4*)(bg + 4), l0 = *(const f32x4*)(bg + FF), l1 = *(const f32x4*)(bg + FF + 4);
#pragma unroll
        for (int ai = 0; ai < 2; ++ai)
#pragma unroll
            for (int m = 0; m < 4; ++m) {
                float o[8];
#pragma unroll
                for (int n = 0; n < 2; ++n)
#pragma unroll
                    for (int q = 0; q < 4; ++q) { const float g = fminf(acc[ai][0][m][n][q] + (n ? g1[q] : g0[q]), 7.f); const float li = fminf(fmaxf(acc[ai][1][m][n][q] + (n ? l1[q] : l0[q]), -7.f), 7.f);
                        o[n * 4 + q] = g * sigmoidf_(1.702f * g) * (li + 1.f); }
                u32x4 w; w.x = cvt_pk_bf16(o[0], o[1]); w.y = cvt_pk_bf16(o[2], o[3]); w.z = cvt_pk_bf16(o[4], o[5]); w.w = cvt_pk_bf16(o[6], o[7]);
                *(u32x4*)(ACT + (size_t)(row0 + ai * HALF + m * 16) * FF + j0) = w; }
    }
};
struct EpiDown {
    static constexpr bool PERM = true; const float* b_down; bf16* YS;
    __device__ __forceinline__ void operator()(const f32x4 (&acc)[2][2][4][2], const Unit& u, int wr, int wc, int fr, int fq) const {
        const int row0 = u.pm * BM + wr * 64 + fr, col0 = u.pn * BM + wc * 32 + 8 * fq;
#pragma unroll
        for (int bj = 0; bj < 2; ++bj) { const int col = col0 + bj * HALF;
            const f32x4 b0 = *(const f32x4*)(b_down + (size_t)u.e * D + col), b1 = *(const f32x4*)(b_down + (size_t)u.e * D + col + 4);
#pragma unroll
            for (int ai = 0; ai < 2; ++ai)
#pragma unroll
                for (int m = 0; m < 4; ++m) { const f32x4 v0 = acc[ai][bj][m][0] + b0, v1 = acc[ai][bj][m][1] + b1;
                    u32x4 w; w.x = cvt_pk_bf16(v0[0], v0[1]); w.y = cvt_pk_bf16(v0[2], v0[3]); w.z = cvt_pk_bf16(v1[0], v1[1]); w.w = cvt_pk_bf16(v1[2], v1[3]);
                    *(u32x4*)(YS + (size_t)(row0 + ai * HALF + m * 16) * D + col) = w; } }
    }
};
}

struct MoeSched {
    const char* A; const char* W; const int* slot_tok; LAS int* til; LAS int* idx; int lda2, K2, nN, wrows  , G, c, gather;
    __device__ __forceinline__ bool next(int i, pg::Unit& u) const {
        const int nM = til[2 * MAXTILES]; int pm, pn; if (!pg::tile_order(i, G, c, nM, nN, pm, pn)) return false;
        const int e = til[pm]; u.pm = pm; u.pn = pn; u.e = e; u.nrows = til[MAXTILES + pm];
        u.A = gather ? A : A + (size_t)pm * 256 * lda2; u.B = W + ((size_t)e * wrows + (size_t)pn * 256) * K2; return true; }
    __device__ __forceinline__ void prefetch(const pg::Unit& u, int ib) const {
        if (gather && threadIdx.x < 256) { const int r = threadIdx.x; const int s = u.pm * 256 + (r < u.nrows ? r : u.nrows - 1);
            __builtin_amdgcn_global_load_lds((const unsigned*)(slot_tok + s), (LAS unsigned*)(idx + ib * 256 + (threadIdx.x & ~63)), 4, 0, 0); } }
    __device__ __forceinline__ unsigned aoff(const pg::Unit&, int row, int ib) const { return gather ? (unsigned)idx[ib * 256 + row] * (unsigned)lda2 : (unsigned)row * (unsigned)lda2; }
};

struct Frame {
    LAS unsigned char* lds; volatile LAS unsigned* MISC; gu32* ctl; int tid, lane, wave, vcu, G;
};
#define LDS_WAIT() asm volatile("s_waitcnt lgkmcnt(0)" ::: "memory")

template <class RowMap>
__device__ __forceinline__ void transpose_item(const float* W, int ldw, int K, int nblk, bf16* WT, LAS float* scr, int item, int lane, RowMap rowmap) {
    const int kb = item / nblk, nb = item % nblk, k0 = 64 * kb, n0 = 32 * nb;
#pragma unroll 8
    for (int i = 0; i < 32; ++i) { const int kk = 2 * i + (lane >> 5); scr[kk * 33 + (lane & 31)] = W[(size_t)(k0 + kk) * ldw + n0 + (lane & 31)]; }
    LDS_WAIT(); asm volatile("" ::: "memory");
    const int c = lane & 7; const int r0 = rowmap(n0);
#pragma unroll
    for (int j = 0; j < 4; ++j) { const int n = (lane >> 3) + 8 * j; const LAS float* s = scr + (8 * c) * 33 + n;
        u32x4 o; o.x = pk2(s[0 * 33], s[1 * 33]); o.y = pk2(s[2 * 33], s[3 * 33]); o.z = pk2(s[4 * 33], s[5 * 33]); o.w = pk2(s[6 * 33], s[7 * 33]);
        *(u32x4*)(WT + (size_t)(r0 + n) * K + k0 + 8 * c) = o; }
    LDS_WAIT(); asm volatile("" ::: "memory");
}
struct RowId { __device__ __forceinline__ int operator()(int n0) const { return n0; } };
struct RowUp { __device__ __forceinline__ int operator()(int n0) const { return n0 < FF ? (n0 >> 7) * 256 + (n0 & 127) : ((n0 - FF) >> 7) * 256 + 128 + ((n0 - FF) & 127); } };

struct Args { const float* in[26]; float* out; unsigned char* ws; int ph_lo, ph_hi, li, pad; };

__global__ void __launch_bounds__(NTHR, 2) fwd(Args args) {
    extern __shared__ __attribute__((aligned(16))) unsigned char lds_raw[];
    Frame F;
    F.lds = (LAS unsigned char*)lds_raw;
    F.MISC = (volatile LAS unsigned*)(F.lds + MISC_OFF);
    F.tid = threadIdx.x; F.lane = F.tid & 63; F.wave = __builtin_amdgcn_readfirstlane(F.tid >> 6);
    F.G = gridDim.x; { const int bx = blockIdx.x; F.vcu = (F.G % 8 == 0) ? (bx % 8) * (F.G / 8) + bx / 8 : bx; }
    unsigned char* ws = args.ws;
    F.ctl = (gu32*)(ws + WS_CTL);
    if (F.tid < 32) ((LAS unsigned*)(F.lds + MISC_OFF))[F.tid] = 0u;
    __syncthreads();
    XcdBarrier bar = xcd_barrier_post((unsigned*)(F.ctl + CW_BAR) + args.li * XCD_BAR_WORDS, F.MISC + 8);
    const int lo = args.ph_lo, hi = args.ph_hi;
#define IN(k) (lo <= (k) && (k) < hi)
#define BOTH(k) (IN(k) && IN((k) + 1))
#define GRID_BAR() xcd_barrier(bar)
    const float* x = args.in[0];
    bf16* WIN = (bf16*)(ws + WS_WIN); bf16* WGLU = (bf16*)(ws + WS_WGLU); bf16* WOUT = (bf16*)(ws + WS_WOUT); bf16* WUP = (bf16*)(ws + WS_WUP); bf16* WDN = (bf16*)(ws + WS_WDN);
    bf16* HN = (bf16*)(ws + WS_HN); bf16* PROJ = (bf16*)(ws + WS_PROJ); bf16* GY = (bf16*)(ws + WS_GY); bf16* MIX = (bf16*)(ws + WS_MIX);
    float* H = (float*)(ws + WS_H); bf16* ACT = (bf16*)(ws + WS_ACT); bf16* YS = (bf16*)(ws + WS_YS);
    float* gates = (float*)(ws + WS_GATES); int* topi = (int*)(ws + WS_TOPI); float* topg = (float*)(ws + WS_TOPG);
    int* slot_tok = (int*)(ws + WS_SLOTTOK); int* tok_slot = (int*)(ws + WS_TOKSLOT); int* CNT = (int*)(ws + WS_CNT); int* ecnt = CNT + 16384;
    bf16* S5A = (bf16*)(ws + WS_S5A); bf16* S5BT = (bf16*)(ws + WS_S5BT); bf16* S5BQ = (bf16*)(ws + WS_S5BQ); float* XLOC = (float*)(ws + WS_XLOC);
    bf16* QH = (bf16*)(ws + WS_QH); bf16* KH = (bf16*)(ws + WS_KH); bf16* VT = (bf16*)(ws + WS_VT); float* DC = (float*)(ws + WS_DC); bf16* CST = (bf16*)(ws + WS_CST);
    float* FLOC = (float*)(ws + WS_FLOC); float* DN = (float*)(ws + WS_DN); float* NST = (float*)(ws + WS_NST); float* SEGS = (float*)(ws + WS_SEGS);
    const int gw = F.vcu * NWAVES + F.wave, NGW = F.G * NWAVES;

    if (IN(0)) {
        LAS float* scr = (LAS float*)(F.lds + F.wave * 16384);
        constexpr int I_IN = (D / 64) * (NPROJ / 32), I_GLU = (512 / 64) * (512 / 32), I_OUT = (D / 64) * (D / 32), I_UP = (D / 64) * (2 * FF / 32), I_DN = (FF / 64) * (D / 32);
        constexpr int NITEMS = I_IN + I_GLU + I_OUT + NE * I_UP + NE * I_DN;
        for (int it = gw; it < NITEMS; it += NGW) {
            int r = it;
            if (r < I_IN) { transpose_item(args.in[2], DIN, D, NPROJ / 32, WIN, scr, r, F.lane, RowId()); continue; } r -= I_IN;
            if (r < I_GLU) { transpose_item(args.in[11], 512, 512, 512 / 32, WGLU, scr, r, F.lane, RowId()); continue; } r -= I_GLU;
            if (r < I_OUT) { transpose_item(args.in[17], D, D, D / 32, WOUT, scr, r, F.lane, RowId()); continue; } r -= I_OUT;
            if (r < NE * I_UP) { const int e = r / I_UP; transpose_item(args.in[21] + (size_t)e * D * 2 * FF, 2 * FF, D, 2 * FF / 32, WUP + (size_t)e * 2 * FF * D, scr, r % I_UP, F.lane, RowUp()); continue; } r -= NE * I_UP;
            { const int e = r / I_DN; transpose_item(args.in[23] + (size_t)e * FF * D, D, FF, D / 32, WDN + (size_t)e * D * FF, scr, r % I_DN, F.lane, RowId()); }
        }
        const float* g = args.in[1]; const float* w_in = args.in[2]; const float* b_gates = args.in[15];
        for (int row = gw; row < T; row += NGW) {
            const float* xr = x + (size_t)row * D;
            float v[16]; float ss = 0.f;
#pragma unroll
            for (int j = 0; j < 4; ++j) { const f32x4 t = *(const f32x4*)(xr + 4 * F.lane + 256 * j); v[4 * j] = t.x; v[4 * j + 1] = t.y; v[4 * j + 2] = t.z; v[4 * j + 3] = t.w; ss += t.x * t.x + t.y * t.y + t.z * t.z + t.w * t.w; }
            ss = wave_sum(ss);
            const float rstd = rsqrtf(ss * (1.f / D) + 1e-5f);
            float ga[8] = {0, 0, 0, 0, 0, 0, 0, 0};
#pragma unroll
            for (int j = 0; j < 4; ++j) {
                const f32x4 gg = *(const f32x4*)(g + 4 * F.lane + 256 * j);
#pragma unroll
                for (int i = 0; i < 4; ++i) { const int k = 4 * F.lane + 256 * j + i; const float y = v[4 * j + i] * rstd * gg[i]; v[4 * j + i] = y;
                    const f32x4 w0 = *(const f32x4*)(w_in + (size_t)k * DIN + O_G), w1 = *(const f32x4*)(w_in + (size_t)k * DIN + O_G + 4);
                    ga[0] += y * w0.x; ga[1] += y * w0.y; ga[2] += y * w0.z; ga[3] += y * w0.w; ga[4] += y * w1.x; ga[5] += y * w1.y; ga[6] += y * w1.z; ga[7] += y * w1.w; }
                uint2 o; o.x = pk2(v[4 * j], v[4 * j + 1]); o.y = pk2(v[4 * j + 2], v[4 * j + 3]);
                *(uint2*)(HN + (size_t)row * D + 4 * F.lane + 256 * j) = o;
            }
#pragma unroll
            for (int q = 0; q < 8; ++q) { const float s = wave_sum(ga[q]); if (F.lane == 0) gates[(size_t)row * 8 + q] = s + b_gates[q]; }
        }
        __syncthreads();
        for (int un = F.vcu; un < 256; un += F.G) {
            const int g = un >> 3, j = un & 7;
            LAS float* Ere = (LAS float*)F.lds; LAS float* Eim = Ere + 65 * 64;
            LAS float* Bbr = Eim + 65 * 64; LAS float* Bbi = Bbr + 1024;
            LAS float* Cr = Bbi + 1024; LAS float* Ci = Cr + 1024;
            LAS float* Kt = Ci + 1024;
            const float dt = __expf(args.in[3][g]);
            if (F.tid < 64) { const int n = F.tid;
                const float are = fminf(args.in[4][g * 64 + n], -1e-4f), aim = args.in[5][g * 64 + n];
                const float mag = expf(dt * are); float sn, cs; sincosf(dt * aim, &sn, &cs);
                const float nr = mag * cs - 1.f, ni = mag * sn, dn = are * are + aim * aim;
                const float cfr = (nr * are + ni * aim) / dn, cfi = (ni * are - nr * aim) / dn;
                for (int q = 0; q < 16; ++q) { const float br = args.in[6][(g * 64 + n) * 16 + q], bi = args.in[7][(g * 64 + n) * 16 + q]; Bbr[n * 16 + q] = cfr * br - cfi * bi; Bbi[n * 16 + q] = cfr * bi + cfi * br; }
            }
            for (int i = F.tid; i < 1024; i += NTHR) { Cr[i] = args.in[8][g * 1024 + i]; Ci[i] = args.in[9][g * 1024 + i]; }
            for (int i = F.tid; i < 65 * 64; i += NTHR) { const int tau = i >> 6, n = i & 63;
                const float are = fminf(args.in[4][g * 64 + n], -1e-4f), aim = args.in[5][g * 64 + n];
                const float mag = expf((float)tau * dt * are); float sn, cs; sincosf((float)tau * dt * aim, &sn, &cs); Ere[i] = mag * cs; Eim[i] = mag * sn; }
            __syncthreads();
            for (int pr = F.tid; pr < 1024; pr += NTHR) { const int tau = pr >> 4, p = pr & 15;
                float acc[16];
#pragma unroll
                for (int q = 0; q < 16; ++q) acc[q] = 0.f;
                for (int n = 0; n < 64; ++n) { const float cr = Cr[p * 64 + n], ci = Ci[p * 64 + n], er = Ere[tau * 64 + n], ei = Eim[tau * 64 + n];
                    const float xr = cr * er - ci * ei, xi = cr * ei + ci * er;
#pragma unroll
                    for (int q = 0; q < 16; ++q) acc[q] += xr * Bbr[n * 16 + q] - xi * Bbi[n * 16 + q]; }
#pragma unroll
                for (int q = 0; q < 16; ++q) Kt[tau * 256 + p * 16 + q] = acc[q];
            }
            __syncthreads();
            for (int ch = F.tid; ch < 128 * 144; ch += NTHR) {
                const int rl = ch / 144, c8 = ch % 144, t = 8 * j + (rl >> 4), p = rl & 15, col = c8 * 8;
                float v[8];
                if (col < 1024) { const int sidx = col >> 4, q0 = col & 15;
#pragma unroll
                    for (int i = 0; i < 8; ++i) v[i] = sidx <= t ? Kt[(t - sidx) * 256 + p * 16 + q0 + i] : 0.f;
                } else { const int jj = (col - 1024) & 63, im = (col - 1024) >> 6;
#pragma unroll
                    for (int i = 0; i < 8; ++i) { const int n = jj + i; const float cr = Cr[p * 64 + n], ci = Ci[p * 64 + n], er = Ere[(t + 1) * 64 + n], ei = Eim[(t + 1) * 64 + n];
                        v[i] = im ? -(cr * ei + ci * er) : (cr * er - ci * ei); } }
                u32x4 o; o.x = pk2(v[0], v[1]); o.y = pk2(v[2], v[3]); o.z = pk2(v[4], v[5]); o.w = pk2(v[6], v[7]);
                *(u32x4*)(S5BT + ((size_t)g * 1024 + 128 * j + rl) * S5K + col) = o;
            }
            for (int ch = F.tid; ch < 32 * 128; ch += NTHR) {
                const int rl = ch >> 7, c8 = ch & 127, r = 32 * j + rl, n = r & 63, im = (r >> 6) & 1, col = c8 * 8, sidx = col >> 4, q0 = col & 15;
                const float er = Ere[(63 - sidx) * 64 + n], ei = Eim[(63 - sidx) * 64 + n];
                float v[8];
#pragma unroll
                for (int i = 0; i < 8; ++i) { const float br = Bbr[n * 16 + q0 + i], bi = Bbi[n * 16 + q0 + i]; v[i] = im ? (er * bi + ei * br) : (er * br - ei * bi); }
                u32x4 o; o.x = pk2(v[0], v[1]); o.y = pk2(v[2], v[3]); o.z = pk2(v[4], v[5]); o.w = pk2(v[6], v[7]);
                *(u32x4*)(S5BQ + ((size_t)g * 256 + r) * 1024 + col) = o;
            }
            __syncthreads();
        }
        if (BOTH(0)) GRID_BAR();
    }
    if (IN(1)) {
        pg::DenseSched S{(const char*)HN, (const char*)WIN, D * 2, D * 2, T / 256, NPROJ / 256, F.G, (int)blockIdx.x};
        pg::EpiProj E{PROJ, S5A};
        pg::gemm_phase<pg::EpiProj, pg::DenseSched, true>(F.lds, D, S, E);
        if (BOTH(1)) GRID_BAR();
    }
    if (IN(2)) {
        pg::S5Sched S{(const char*)S5A, (const char*)S5BQ, S5K * 2, 1024 * 2, 256, 1, F.G, F.vcu};
        pg::EpiXloc E{XLOC};
        pg::gemm_phase<pg::EpiXloc, pg::S5Sched, true>(F.lds, 1024, S, E);
    }
    if (IN(3)) {
        typedef short s16x4 __attribute__((ext_vector_type(4)));
        LAS float* wsl = (LAS float*)F.lds;
        LAS float* red = wsl + 512;
        LAS float* dnl = red + 32;
        LAS bf16* RQ = (LAS bf16*)(F.lds + 4096);
        LAS bf16* RK = RQ + 67 * 136;
        LAS bf16* RV = RK + 67 * 136;
        LAS bf16* KN = RV + 64 * 136;
        LAS bf16* KTl = KN + 64 * 136;
        LAS bf16* VTl = KTl + 128 * 72;
        const float* cw = args.in[13]; const float* cbias = args.in[14];
        for (int un = blockIdx.x; un < 256; un += F.G) {
            const int bh = un >> 4, seg = un & 15, b = bh >> 2, hd = bh & 3, t0 = seg * 512; const size_t row0 = (size_t)b * SEQ + t0;
            float Fl, Aval;
            {
                const float ipre = gates[(row0 + F.tid) * 8 + hd], fpre = gates[(row0 + F.tid) * 8 + 4 + hd];
                const float lf = fminf(fpre, 0.f) - log1pf(__expf(-fabsf(fpre)));
                float sc = lf;
#pragma unroll
                for (int o = 1; o < 64; o <<= 1) { const float tv = __shfl_up(sc, o); if (F.lane >= o) sc += tv; }
                if (F.lane == 63) red[F.wave] = sc;
                __syncthreads();
                float base = 0.f;
                for (int w2 = 0; w2 < F.wave; ++w2) base += red[w2];
                Fl = sc + base; Aval = ipre - Fl;
                float mx = Aval;
#pragma unroll
                for (int o = 1; o < 64; o <<= 1) mx = fmaxf(mx, __shfl_xor(mx, o));
                if (F.lane == 0) red[8 + F.wave] = mx;
                __syncthreads();
                float Amax = red[8];
                for (int w2 = 1; w2 < 8; ++w2) Amax = fmaxf(Amax, red[8 + w2]);
                wsl[F.tid] = __expf(Aval - Amax);
                FLOC[(size_t)bh * SEQ + t0 + F.tid] = Fl;
                if (F.tid == 511) { SEGS[un * 4 + 0] = Fl; SEGS[un * 4 + 1] = Amax; }
                if (F.tid < 256) dnl[F.tid] = 0.f;
            }
            f32x16 dacc[2];
#pragma unroll
            for (int i = 0; i < 2; ++i)
#pragma unroll
                for (int q = 0; q < 16; ++q) dacc[i][q] = 0.f;
            const int cch = F.tid & 127, isk = (F.tid >> 7) & 1, thalf = F.tid >> 8;
            const int gch = isk * 512 + hd * 128 + cch;
            const float cw0 = cw[gch], cw1 = cw[1024 + gch], cw2 = cw[2048 + gch], cw3 = cw[3072 + gch], cb = cbias[gch];
            float dnacc = 0.f;
            for (int sb = 0; sb < 8; ++sb) {
                const int ts = t0 + sb * 64;
                __syncthreads();
                for (int ch = F.tid; ch < 2 * 67 * 16 + 64 * 16; ch += NTHR) {
                    if (ch < 2 * 67 * 16) { const int which = ch / (67 * 16), r = (ch % (67 * 16)) >> 4, c16 = ch & 15; const int tk = ts - 3 + r;
                        u32x4 v = (u32x4){0u, 0u, 0u, 0u};
                        if (tk >= 0) v = *(const u32x4*)(PROJ + ((size_t)b * SEQ + tk) * NPROJ + (which ? O_K : O_Q) + hd * 128 + c16 * 8);
                        *(LAS u32x4*)((which ? RK : RQ) + r * 136 + c16 * 8) = v;
                    } else { const int c2 = ch - 2 * 67 * 16, r = c2 >> 4, c16 = c2 & 15;
                        *(LAS u32x4*)(RV + r * 136 + c16 * 8) = *(const u32x4*)(PROJ + ((size_t)b * SEQ + ts + r) * NPROJ + O_V + hd * 128 + c16 * 8); }
                }
                __syncthreads();
                {
                    LAS bf16* raw = isk ? RK : RQ; const int s0 = thalf * 32;
                    float x3 = bf2f(raw[(s0 + 0) * 136 + cch]), x2 = bf2f(raw[(s0 + 1) * 136 + cch]), x1 = bf2f(raw[(s0 + 2) * 136 + cch]);
                    for (int sidx = s0; sidx < s0 + 32; ++sidx) {
                        const float xv = bf2f(raw[(sidx + 3) * 136 + cch]);
                        float val = cb + cw0 * x3 + cw1 * x2 + cw2 * x1 + cw3 * xv;
                        x3 = x2; x2 = x1; x1 = xv;
                        val = val * sigmoidf_(val);
                        if (isk) { val *= 0.08838834764831845f * wsl[sb * 64 + sidx]; dnacc += val; const bf16 kb = f2bf(val); KN[sidx * 136 + cch] = kb; KH[((size_t)bh * SEQ + ts + sidx) * 128 + cch] = kb; }
                        else QH[((size_t)bh * SEQ + ts + sidx) * 128 + cch] = f2bf(val);
                    }
                }
                __syncthreads();
                {
                    const int c = F.tid & 127, sq = F.tid >> 7;
#pragma unroll
                    for (int half = 0; half < 2; ++half) { const int sA = sq * 16 + half * 8;
                        u32x4 kk, vv;
                        kk.x = (unsigned)KN[(sA + 0) * 136 + c] | ((unsigned)KN[(sA + 1) * 136 + c] << 16); kk.y = (unsigned)KN[(sA + 2) * 136 + c] | ((unsigned)KN[(sA + 3) * 136 + c] << 16);
                        kk.z = (unsigned)KN[(sA + 4) * 136 + c] | ((unsigned)KN[(sA + 5) * 136 + c] << 16); kk.w = (unsigned)KN[(sA + 6) * 136 + c] | ((unsigned)KN[(sA + 7) * 136 + c] << 16);
                        vv.x = (unsigned)RV[(sA + 0) * 136 + c] | ((unsigned)RV[(sA + 1) * 136 + c] << 16); vv.y = (unsigned)RV[(sA + 2) * 136 + c] | ((unsigned)RV[(sA + 3) * 136 + c] << 16);
                        vv.z = (unsigned)RV[(sA + 4) * 136 + c] | ((unsigned)RV[(sA + 5) * 136 + c] << 16); vv.w = (unsigned)RV[(sA + 6) * 136 + c] | ((unsigned)RV[(sA + 7) * 136 + c] << 16);
                        *(LAS u32x4*)(KTl + c * 72 + sA) = kk; *(LAS u32x4*)(VTl + c * 72 + sA) = vv; }
                }
                __syncthreads();
                {
                    const int e = F.tid >> 2, part = F.tid & 3;
                    const u32x4 v0 = *(const LAS u32x4*)(VTl + e * 72 + part * 16), v1 = *(const LAS u32x4*)(VTl + e * 72 + part * 16 + 8);
                    bf16* dst = VT + ((size_t)bh * 128 + e) * SEQ + ts + part * 16;
                    *(u32x4*)dst = v0; *(u32x4*)(dst + 8) = v1;
                    const int eb = F.wave >> 1, db0 = (F.wave & 1) * 2, r = F.lane & 31, hh = F.lane >> 5;
#pragma unroll
                    for (int ks = 0; ks < 4; ++ks) {
                        const bf16x8 a = *(const LAS bf16x8*)(VTl + (eb * 32 + r) * 72 + ks * 16 + hh * 8);
                        const bf16x8 b0 = *(const LAS bf16x8*)(KTl + (db0 * 32 + r) * 72 + ks * 16 + hh * 8), b1 = *(const LAS bf16x8*)(KTl + ((db0 + 1) * 32 + r) * 72 + ks * 16 + hh * 8);
                        dacc[0] = __builtin_amdgcn_mfma_f32_32x32x16_bf16(a, b0, dacc[0], 0, 0, 0);
                        dacc[1] = __builtin_amdgcn_mfma_f32_32x32x16_bf16(a, b1, dacc[1], 0, 0, 0);
                    }
                }
            }
            if (isk) dnl[thalf * 128 + cch] = dnacc;
            {
                const int eb = F.wave >> 1, db0 = (F.wave & 1) * 2, r = F.lane & 31, hh = F.lane >> 5;
#pragma unroll
                for (int i = 0; i < 2; ++i)
#pragma unroll
                    for (int q = 0; q < 16; ++q) DC[((size_t)un * 128 + eb * 32 + (q & 3) + 8 * (q >> 2) + 4 * hh) * 128 + (db0 + i) * 32 + r] = dacc[i][q];
            }
            __syncthreads();
            if (F.tid < 128) DN[un * 128 + F.tid] = dnl[F.tid] + dnl[128 + F.tid];
            __syncthreads();
        }
        if (BOTH(3)) GRID_BAR();
    }
    if (IN(4)) {
        LAS float* agr = (LAS float*)F.lds; LAS float* agi = agr + 512;
        for (int un = blockIdx.x; un < 128; un += F.G) {
            const int b = un >> 5, g = un & 31, n = F.tid & 63, seg = F.tid >> 6;
            const float dt = __expf(args.in[3][g]);
            const float are = fminf(args.in[4][g * 64 + n], -1e-4f), aim = args.in[5][g * 64 + n];
            float ar, ai, Ar, Ai;
            { const float mag = expf(64.f * dt * are); float sn, cs; sincosf(64.f * dt * aim, &sn, &cs); ar = mag * cs; ai = mag * sn; }
            { const float mag = expf(1024.f * dt * are); float sn, cs; sincosf(1024.f * dt * aim, &sn, &cs); Ar = mag * cs; Ai = mag * sn; }
            const size_t row0 = (size_t)g * 512 + b * 128 + seg * 16;
            float xr[16], xi[16];
#pragma unroll
            for (int jj = 0; jj < 16; ++jj) { xr[jj] = XLOC[(row0 + jj) * 128 + n]; xi[jj] = XLOC[(row0 + jj) * 128 + 64 + n]; }
            float sr = 0.f, si = 0.f;
#pragma unroll
            for (int jj = 0; jj < 16; ++jj) { const float tr = ar * sr - ai * si + xr[jj], ti = ar * si + ai * sr + xi[jj]; sr = tr; si = ti; }
            agr[seg * 64 + n] = sr; agi[seg * 64 + n] = si;
            __syncthreads();
            float cr = 0.f, ci = 0.f;
            for (int s2 = 0; s2 < seg; ++s2) { const float tr = Ar * cr - Ai * ci + agr[s2 * 64 + n], ti = Ar * ci + Ai * cr + agi[s2 * 64 + n]; cr = tr; ci = ti; }
#pragma unroll
            for (int jj = 0; jj < 16; ++jj) {
                S5A[(row0 + jj) * S5K + 1024 + n] = f2bf(cr); S5A[(row0 + jj) * S5K + 1088 + n] = f2bf(ci);
                const float tr = ar * cr - ai * ci + xr[jj], ti = ar * ci + ai * cr + xi[jj]; cr = tr; ci = ti; }
            __syncthreads();
        }
        for (int un = blockIdx.x; un < 256; un += F.G) {
            const int bh = un >> 4, slice = un & 15;
            float dc0[16], dc1[16];
#pragma unroll
            for (int j = 0; j < 16; ++j) { dc0[j] = DC[((size_t)(bh * 16 + j)) * 16384 + slice * 1024 + F.tid]; dc1[j] = DC[((size_t)(bh * 16 + j)) * 16384 + slice * 1024 + 512 + F.tid]; }
            float dn[16];
            const bool nrole = (slice == 0 && F.tid < 128);
#pragma unroll
            for (int j = 0; j < 16; ++j) dn[j] = nrole ? DN[(bh * 16 + j) * 128 + F.tid] : 0.f;
            float m = 0.f, C0 = 0.f, C1 = 0.f, nn = 0.f;
#pragma unroll
            for (int j = 0; j < 16; ++j) {
                const float Fend = SEGS[(bh * 16 + j) * 4 + 0], Amax = SEGS[(bh * 16 + j) * 4 + 1];
                const float R = fmaxf(m, Amax), c1 = __expf(m - R), c2 = __expf(Amax - R);
                CST[((size_t)(bh * 16 + j)) * 16384 + slice * 1024 + F.tid] = f2bf(c1 * C0); CST[((size_t)(bh * 16 + j)) * 16384 + slice * 1024 + 512 + F.tid] = f2bf(c1 * C1);
                if (nrole) NST[(bh * 16 + j) * 128 + F.tid] = c1 * nn;
                if (slice == 0 && F.tid == 0) { SEGS[(bh * 16 + j) * 4 + 2] = R; SEGS[(bh * 16 + j) * 4 + 3] = c2; }
                C0 = c1 * C0 + c2 * dc0[j]; C1 = c1 * C1 + c2 * dc1[j]; nn = c1 * nn + c2 * dn[j]; m = Fend + R;
            }
        }
        if (BOTH(4)) GRID_BAR();
    }
    if (IN(5)) {
        pg::S5Sched S{(const char*)S5A, (const char*)S5BT, S5K * 2, S5K * 2, 1024, 4, F.G, F.vcu};
        pg::EpiS5Y E{S5A, args.in[10], GY};
        pg::gemm_phase<pg::EpiS5Y, pg::S5Sched, true>(F.lds, S5K, S, E);
        if (BOTH(5)) GRID_BAR();
    }
    if (IN(6)) {
        typedef short s16x4 __attribute__((ext_vector_type(4)));
        LAS bf16* Kl = (LAS bf16*)F.lds;
        LAS bf16* Vl = Kl + 2 * 64 * 136;
        LAS bf16* Cl = Vl + 2 * 128 * 72;
        LAS float* nl = (LAS float*)(Cl + 128 * 136);
        LAS float* fll = nl + 128;
        LAS float* gl = fll + 512;
        const float* ng = args.in[16];
        for (int un = blockIdx.x; un < 256; un += F.G) {
            int tid6 = F.tid; asm volatile("" : "+v"(tid6));
            const int lane6 = tid6 & 63;
            const int bh = un >> 4, seg = un & 15, b = bh >> 2, hd = bh & 3, t0 = seg * 512;
            const float R = SEGS[un * 4 + 2], c2 = SEGS[un * 4 + 3];
            __syncthreads();
            for (int ch = tid6; ch < 2048; ch += NTHR) { const int r = ch >> 4, c16 = ch & 15; *(LAS u32x4*)(Cl + r * 136 + c16 * 8) = *(const u32x4*)(CST + (size_t)un * 16384 + r * 128 + c16 * 8); }
            if (tid6 < 128) { nl[tid6] = NST[un * 128 + tid6]; gl[tid6] = ng[hd * 128 + tid6]; }
            fll[tid6] = FLOC[(size_t)bh * SEQ + t0 + tid6];
            const int r = lane6 & 31, hh = lane6 >> 5;
            for (int pass = 0; pass < 2; ++pass) {
                const int qb = pass == 0 ? F.wave : 15 - F.wave, jmax = qb >> 1, npj = pass == 0 ? 4 : 8;
                bf16x8 Q[8];
                { const bf16* qp = QH + ((size_t)bh * SEQ + t0 + qb * 32 + r) * 128 + hh * 8;
#pragma unroll
                  for (int ks = 0; ks < 8; ++ks) Q[ks] = *(const bf16x8*)(qp + ks * 16); }
                u32x4 pk0, pk1, pv0, pv1;
                { const int kr = tid6 >> 4, kc = tid6 & 15; const bf16* kp = KH + ((size_t)bh * SEQ + t0) * 128; pk0 = *(const u32x4*)(kp + kr * 128 + kc * 8); pk1 = *(const u32x4*)(kp + (kr + 32) * 128 + kc * 8);
                  const int vr = tid6 >> 3, vc = tid6 & 7; const bf16* vp = VT + (size_t)bh * 128 * SEQ + t0; pv0 = *(const u32x4*)(vp + (size_t)vr * SEQ + vc * 8); pv1 = *(const u32x4*)(vp + (size_t)(vr + 64) * SEQ + vc * 8); }
                f32x16 acc[4];
#pragma unroll
                for (int eb = 0; eb < 4; ++eb)
#pragma unroll
                    for (int q = 0; q < 16; ++q) acc[eb][q] = 0.f;
                __syncthreads();
#pragma unroll
                for (int eb = 0; eb < 4; ++eb) {
#pragma unroll
                    for (int ks = 0; ks < 8; ++ks) { const bf16x8 a = *(const LAS bf16x8*)(Cl + (eb * 32 + r) * 136 + ks * 16 + hh * 8); acc[eb] = __builtin_amdgcn_mfma_f32_32x32x16_bf16(a, Q[ks], acc[eb], 0, 0, 0); }
                    __builtin_amdgcn_sched_barrier(0);
                }
                float den = 0.f;
#pragma unroll
                for (int ks = 0; ks < 8; ++ks) {
#pragma unroll
                    for (int jj = 0; jj < 8; ++jj) den += nl[ks * 16 + hh * 8 + jj] * bf2f((bf16)Q[ks][jj]);
                    __builtin_amdgcn_sched_barrier(0);
                }
                float dsum = 0.f;
                for (int j = 0; j < npj; ++j) {
                    LAS bf16* Kb = Kl + (j & 1) * 64 * 136; LAS bf16* Vb = Vl + (j & 1) * 128 * 72;
                    { const int kr = tid6 >> 4, kc = tid6 & 15; *(LAS u32x4*)(Kb + kr * 136 + kc * 8) = pk0; *(LAS u32x4*)(Kb + (kr + 32) * 136 + kc * 8) = pk1;
                      const int vr = tid6 >> 3, vc = tid6 & 7; *(LAS u32x4*)(Vb + vr * 72 + vc * 8) = pv0; *(LAS u32x4*)(Vb + (vr + 64) * 72 + vc * 8) = pv1; }
                    if (j + 1 < npj) { const int kr = tid6 >> 4, kc = tid6 & 15; const bf16* kp = KH + ((size_t)bh * SEQ + t0 + (j + 1) * 64) * 128; pk0 = *(const u32x4*)(kp + kr * 128 + kc * 8); pk1 = *(const u32x4*)(kp + (kr + 32) * 128 + kc * 8);
                        const int vr = tid6 >> 3, vc = tid6 & 7; const bf16* vp = VT + (size_t)bh * 128 * SEQ + t0 + (j + 1) * 64; pv0 = *(const u32x4*)(vp + (size_t)vr * SEQ + vc * 8); pv1 = *(const u32x4*)(vp + (size_t)(vr + 64) * SEQ + vc * 8); }
                    __syncthreads();
                    if (j <= jmax) {
                        const bool diag = (j == jmax); const int tq = qb * 32 + r;
#pragma unroll
                        for (int sb = 0; sb < 2; ++sb) {
                            f32x16 st;
#pragma unroll
                            for (int q = 0; q < 16; ++q) st[q] = 0.f;
#pragma unroll
                            for (int ks = 0; ks < 8; ++ks) { const bf16x8 a = *(const LAS bf16x8*)(Kb + (sb * 32 + r) * 136 + ks * 16 + hh * 8); st = __builtin_amdgcn_mfma_f32_32x32x16_bf16(a, Q[ks], st, 0, 0, 0); }
                            bf16x8 pb[2];
#pragma unroll
                            for (int sp = 0; sp < 2; ++sp) {
                                float pv[8];
#pragma unroll
                                for (int jj = 0; jj < 8; ++jj) { const int q = 8 * sp + jj; const int sidx = j * 64 + sb * 32 + (q & 3) + 8 * (q >> 2) + 4 * hh;
                                    float p = st[q] * c2; if (diag && sidx > tq) p = 0.f; pv[jj] = p; dsum += p; }
                                u32x4 w; w.x = cvt_pk_bf16(pv[0], pv[1]); w.y = cvt_pk_bf16(pv[2], pv[3]); w.z = cvt_pk_bf16(pv[4], pv[5]); w.w = cvt_pk_bf16(pv[6], pv[7]);
                                pb[sp] = __builtin_bit_cast(bf16x8, w);
                            }
#pragma unroll
                            for (int eb = 0; eb < 4; ++eb)
#pragma unroll
                                for (int sp = 0; sp < 2; ++sp) {
                                    const int so = sb * 32 + 16 * sp + 4 * hh;
                                    const s16x4 lo = *(const LAS s16x4*)(Vb + (eb * 32 + r) * 72 + so), hi = *(const LAS s16x4*)(Vb + (eb * 32 + r) * 72 + so + 8);
                                    const bf16x8 a = __builtin_shufflevector(lo, hi, 0, 1, 2, 3, 4, 5, 6, 7);
                                    acc[eb] = __builtin_amdgcn_mfma_f32_32x32x16_bf16(a, pb[sp], acc[eb], 0, 0, 0);
                                }
                            __builtin_amdgcn_sched_barrier(0);
                        }
                    }
                }
                den += dsum; den += __shfl_xor(den, 32);
                const float flo = __expf(-fll[qb * 32 + r] - R);
                const float inv = 1.f / fmaxf(fabsf(den), flo);
                float s1 = 0.f;
#pragma unroll
                for (int eb = 0; eb < 4; ++eb)
#pragma unroll
                    for (int q = 0; q < 16; ++q) { acc[eb][q] *= inv; s1 += acc[eb][q]; }
                s1 += __shfl_xor(s1, 32);
                const float mu = s1 * (1.f / 128.f);
                float s2 = 0.f;
#pragma unroll
                for (int eb = 0; eb < 4; ++eb)
#pragma unroll
                    for (int q = 0; q < 16; ++q) { const float dlt = acc[eb][q] - mu; s2 += dlt * dlt; }
                s2 += __shfl_xor(s2, 32);
                const float rstd = rsqrtf(s2 * (1.f / 128.f) + 1e-6f);
                const size_t row = (size_t)b * SEQ + t0 + qb * 32 + r;
#pragma unroll
                for (int eb = 0; eb < 4; ++eb)
#pragma unroll
                    for (int g4 = 0; g4 < 4; ++g4) {
                        const int e0 = eb * 32 + 8 * g4 + 4 * hh;
                        const uint2 ov = *(const uint2*)(PROJ + row * NPROJ + O_O + hd * 128 + e0);
                        const float o0 = (acc[eb][4 * g4 + 0] - mu) * rstd * gl[e0 + 0] * sigmoidf_(lo_bf(ov.x)), o1 = (acc[eb][4 * g4 + 1] - mu) * rstd * gl[e0 + 1] * sigmoidf_(hi_bf(ov.x));
                        const float o2 = (acc[eb][4 * g4 + 2] - mu) * rstd * gl[e0 + 2] * sigmoidf_(lo_bf(ov.y)), o3 = (acc[eb][4 * g4 + 3] - mu) * rstd * gl[e0 + 3] * sigmoidf_(hi_bf(ov.y));
                        uint2 w; w.x = cvt_pk_bf16(o0, o1); w.y = cvt_pk_bf16(o2, o3);
                        *(uint2*)(MIX + row * D + 512 + hd * 128 + e0) = w;
                        __builtin_amdgcn_sched_barrier(0);
                    }
            }
        }
    }
    if (IN(7)) {
        pg::DenseSched S{(const char*)GY, (const char*)WGLU, 512 * 2, 512 * 2, T / 256, 2, F.G, (int)blockIdx.x};
        pg::EpiGlu E{GY, args.in[12], MIX};
        pg::gemm_phase<pg::EpiGlu, pg::DenseSched, true>(F.lds, 512, S, E);
        if (BOTH(7)) GRID_BAR();
    }
    if (IN(8)) {
        pg::DenseSched S{(const char*)MIX, (const char*)WOUT, D * 2, D * 2, T / 256, D / 256, F.G, (int)blockIdx.x};
        pg::EpiOut E{x, H};
        pg::gemm_phase<pg::EpiOut, pg::DenseSched, true>(F.lds, D, S, E);
        if (BOTH(8)) GRID_BAR();
    }
    if (IN(9)) {
        const float* gf = args.in[18]; const float* w_r = args.in[19]; const float* b_r = args.in[20];
        LAS float* rs = (LAS float*)(F.lds);
        LAS float* part = (LAS float*)(F.lds + 1024);
        LAS int* hist = (LAS int*)(F.lds + 1024 + 2 * 128 * 33 * 4);
        for (int tb = blockIdx.x; tb < T / 128; tb += F.G) {
            const int row0 = tb * 128;
            if (F.tid < 32) hist[F.tid] = 0;
            for (int rr = 0; rr < 16; ++rr) {
                const int r = F.wave * 16 + rr; const float* hr = H + (size_t)(row0 + r) * D;
                f32x4 v[4]; float ss = 0.f;
#pragma unroll
                for (int j = 0; j < 4; ++j) { v[j] = *(const f32x4*)(hr + 4 * F.lane + 256 * j); ss += v[j].x * v[j].x + v[j].y * v[j].y + v[j].z * v[j].z + v[j].w * v[j].w; }
                ss = wave_sum(ss);
                const float rstd = rsqrtf(ss * (1.f / D) + 1e-5f);
                if (F.lane == 0) rs[r] = rstd;
#pragma unroll
                for (int j = 0; j < 4; ++j) { const f32x4 gg = *(const f32x4*)(gf + 4 * F.lane + 256 * j);
                    uint2 o; o.x = pk2(v[j].x * rstd * gg.x, v[j].y * rstd * gg.y); o.y = pk2(v[j].z * rstd * gg.z, v[j].w * rstd * gg.w);
                    *(uint2*)(HN + (size_t)(row0 + r) * D + 4 * F.lane + 256 * j) = o; }
            }
            {
                const int rg = F.wave & 3, kh = F.wave >> 2, i = F.lane & 31, hh = F.lane >> 5;
                f32x16 acc;
#pragma unroll
                for (int q = 0; q < 16; ++q) acc[q] = 0.f;
                const float* hp = H + (size_t)(row0 + rg * 32 + i) * D + kh * 512 + 4 * hh;
                for (int k0 = 0; k0 < 512; k0 += 8) {
                    const f32x4 a4 = *(const f32x4*)(hp + k0);
                    const int kb = kh * 512 + k0 + 4 * hh;
                    const f32x4 g4 = *(const f32x4*)(gf + kb);
                    const float b0 = w_r[(size_t)(kb + 0) * NE + i] * g4.x, b1 = w_r[(size_t)(kb + 1) * NE + i] * g4.y, b2 = w_r[(size_t)(kb + 2) * NE + i] * g4.z, b3 = w_r[(size_t)(kb + 3) * NE + i] * g4.w;
                    acc = __builtin_amdgcn_mfma_f32_32x32x2f32(a4.x, b0, acc, 0, 0, 0);
                    acc = __builtin_amdgcn_mfma_f32_32x32x2f32(a4.y, b1, acc, 0, 0, 0);
                    acc = __builtin_amdgcn_mfma_f32_32x32x2f32(a4.z, b2, acc, 0, 0, 0);
                    acc = __builtin_amdgcn_mfma_f32_32x32x2f32(a4.w, b3, acc, 0, 0, 0);
                }
#pragma unroll
                for (int q = 0; q < 16; ++q) { const int r = rg * 32 + (q & 3) + 8 * (q >> 2) + 4 * hh; part[(kh * 128 + r) * 33 + i] = acc[q]; }
            }
            __syncthreads();
            if (F.tid < 128) {
                const int r = F.tid; const float rstd = rs[r];
                float best[4]; int bi[4];
                for (int e = 0; e < 32; ++e) part[r * 33 + e] = (part[r * 33 + e] + part[(128 + r) * 33 + e]) * rstd + b_r[e];
#pragma unroll
                for (int k = 0; k < 4; ++k) {
                    float bv = -INFINITY; int be = 0;
                    for (int e = 0; e < 32; ++e) { const float l = part[r * 33 + e]; if (l > bv) { bv = l; be = e; } }
                    best[k] = bv; bi[k] = be; part[r * 33 + be] = -INFINITY;
                }
                const float e1 = __expf(best[1] - best[0]), e2 = __expf(best[2] - best[0]), e3 = __expf(best[3] - best[0]);
                const float inv = 1.f / (1.f + e1 + e2 + e3);
                *(int4*)(topi + (size_t)(row0 + r) * 4) = make_int4(bi[0], bi[1], bi[2], bi[3]);
                *(f32x4*)(topg + (size_t)(row0 + r) * 4) = (f32x4){inv, e1 * inv, e2 * inv, e3 * inv};
#pragma unroll
                for (int k = 0; k < 4; ++k) __hip_atomic_fetch_add(&hist[bi[k]], 1, __ATOMIC_RELAXED, __HIP_MEMORY_SCOPE_WORKGROUP);
            }
            __syncthreads();
            if (F.tid < 32) CNT[tb * 32 + F.tid] = hist[F.tid];
            __syncthreads();
        }
        if (BOTH(9)) GRID_BAR();
    }
    if (IN(10)) {
        LAS int* sb = (LAS int*)(F.lds);
        for (int tb = blockIdx.x; tb < T / 128; tb += F.G) {
            const int e = F.tid & 31, pt = F.tid >> 5;
            int sbef = 0, stot = 0;
            for (int w = pt * 16; w < pt * 16 + 16; ++w) { const int c = __hip_atomic_load(CNT + w * 32 + e, RLX_AGENT); stot += c; if (w < tb) sbef += c; }
            sb[pt * 32 + e] = sbef; sb[512 + pt * 32 + e] = stot;
            __syncthreads();
            if (F.tid < 32) { int b = 0, t = 0; for (int p = 0; p < 16; ++p) { b += sb[p * 32 + F.tid]; t += sb[512 + p * 32 + F.tid]; } sb[1024 + F.tid] = b; sb[1056 + F.tid] = t; sb[1120 + F.tid] = 0; }
            __syncthreads();
            if (F.tid == 0) { int ps = 0; for (int q = 0; q < 32; ++q) { sb[1088 + q] = ps; ps += ((sb[1056 + q] + MT - 1) / MT) * MT; } }
            __syncthreads();
            if (tb == 0 && F.tid < 32) ecnt[F.tid] = sb[1056 + F.tid];
            {
                const int a = tb * 512 + F.tid; const int ex = topi[a];
                const int lp = __hip_atomic_fetch_add(&sb[1120 + ex], 1, __ATOMIC_RELAXED, __HIP_MEMORY_SCOPE_WORKGROUP);
                const int slot = sb[1088 + ex] + sb[1024 + ex] + lp;
                slot_tok[slot] = a >> 2; tok_slot[a] = slot;
            }
            __syncthreads();
        }
        if (BOTH(10)) GRID_BAR();
    }
    if (IN(11) || IN(12)) {
        LAS int* til = (LAS int*)(F.lds + TIL_OFF);
        if (F.tid == 0) { int nt = 0; for (int e = 0; e < NE; ++e) { const int c = __hip_atomic_load(ecnt + e, RLX_AGENT); for (int r = 0; r < c; r += MT) { til[nt] = e; til[MAXTILES + nt] = (c - r) < MT ? (c - r) : MT; ++nt; } } til[2 * MAXTILES] = nt; }
        __syncthreads();
        if (IN(11)) {
            MoeSched S{(const char*)HN, (const char*)WUP, slot_tok, til, (LAS int*)(F.lds + IDX_OFF), D * 2, D * 2, 8, 2 * FF, F.G, (int)blockIdx.x, 1};
            pg::EpiUp E{args.in[22], ACT};
            pg::gemm_phase<pg::EpiUp, MoeSched, true>(F.lds, D, S, E);
            if (BOTH(11)) GRID_BAR();
        }
        if (IN(12)) {
            MoeSched S{(const char*)ACT, (const char*)WDN, slot_tok, til, (LAS int*)(F.lds + IDX_OFF), FF * 2, FF * 2, 4, D, F.G, (int)blockIdx.x, 0};
            pg::EpiDown E{args.in[24], YS};
            pg::gemm_phase<pg::EpiDown, MoeSched, true>(F.lds, FF, S, E);
            if (BOTH(12)) GRID_BAR();
        }
    }
    if (IN(13)) {
        const float* gfin = args.in[25]; float* out = args.out;
        for (int row = gw; row < T; row += NGW) {
            f32x4 v[4];
#pragma unroll
            for (int j = 0; j < 4; ++j) v[j] = *(const f32x4*)(H + (size_t)row * D + 4 * F.lane + 256 * j);
            const int4 sl = *(const int4*)(tok_slot + (size_t)row * 4); const f32x4 gt = *(const f32x4*)(topg + (size_t)row * 4);
#pragma unroll
            for (int k = 0; k < 4; ++k) {
                const int s = k == 0 ? sl.x : k == 1 ? sl.y : k == 2 ? sl.z : sl.w;
#pragma unroll
                for (int j = 0; j < 4; ++j) { const uint2 y = *(const uint2*)(YS + (size_t)s * D + 4 * F.lane + 256 * j);
                    v[j].x += gt[k] * lo_bf(y.x); v[j].y += gt[k] * hi_bf(y.x); v[j].z += gt[k] * lo_bf(y.y); v[j].w += gt[k] * hi_bf(y.y); }
            }
            float ss = 0.f;
#pragma unroll
            for (int j = 0; j < 4; ++j) ss += v[j].x * v[j].x + v[j].y * v[j].y + v[j].z * v[j].z + v[j].w * v[j].w;
            ss = wave_sum(ss);
            const float rstd = rsqrtf(ss * (1.f / D) + 1e-5f);
#pragma unroll
            for (int j = 0; j < 4; ++j) { const f32x4 gg = *(const f32x4*)(gfin + 4 * F.lane + 256 * j); *(f32x4*)(out + (size_t)row * D + 4 * F.lane + 256 * j) = v[j] * rstd * gg; }
        }
    }
#undef IN
#undef BOTH
}

__global__ __launch_bounds__(64) void k_s5(const bf16* __restrict__ proj, const float* log_dt, const float* a_re, const float* a_im, const float* b_re, const float* b_im,
                                           const float* c_re, const float* c_im, const float* d_skip, bf16* __restrict__ GY) {
    __shared__ float xre[64 * 65], xim[64 * 65], cre[16 * 64], cim[16 * 64];
    const int b = blockIdx.x >> 5, g = blockIdx.x & 31, n = threadIdx.x;
    const float dt = __expf(log_dt[g]);
    const float are = fminf(a_re[g * 64 + n], -1e-4f), aim = a_im[g * 64 + n];
    const float mag = expf(dt * are); float sn, cs; sincosf(dt * aim, &sn, &cs);
    const float abr = mag * cs, abi = mag * sn;
    const float nr = abr - 1.f, ni = abi, dn = are * are + aim * aim;
    const float cfr = (nr * are + ni * aim) / dn, cfi = (ni * are - nr * aim) / dn;
    float bbr[16], bbi[16];
#pragma unroll
    for (int q = 0; q < 16; ++q) { const float br = b_re[(g * 64 + n) * 16 + q], bi = b_im[(g * 64 + n) * 16 + q]; bbr[q] = cfr * br - cfi * bi; bbi[q] = cfr * bi + cfi * br; }
    for (int p = 0; p < 16; ++p) { cre[p * 64 + n] = c_re[(g * 16 + p) * 64 + n]; cim[p * 64 + n] = c_im[(g * 16 + p) * 64 + n]; }
    float dsk[16];
#pragma unroll
    for (int p = 0; p < 16; ++p) dsk[p] = d_skip[g * 16 + p];
    float sr = 0.f, si = 0.f;
    __syncthreads();
    for (int c = 0; c < SEQ / 64; ++c) {
        for (int s = 0; s < 64; ++s) {
            const bf16* up = proj + (size_t)(b * SEQ + c * 64 + s) * NPROJ + g * 16;
            float bur = 0.f, bui = 0.f;
#pragma unroll
            for (int q = 0; q < 16; ++q) { const float u = bf2f(up[q]); bur += bbr[q] * u; bui += bbi[q] * u; }
            const float nr2 = abr * sr - abi * si + bur, ni2 = abr * si + abi * sr + bui;
            sr = nr2; si = ni2;
            xre[s * 65 + n] = sr; xim[s * 65 + n] = si;
        }
        __syncthreads();
        {
            const int s = n;
            float acc[16];
#pragma unroll
            for (int p = 0; p < 16; ++p) acc[p] = 0.f;
            for (int k = 0; k < 64; ++k) {
                const float xr = xre[s * 65 + k], xi = xim[s * 65 + k];
#pragma unroll
                for (int p = 0; p < 16; ++p) acc[p] += cre[p * 64 + k] * xr - cim[p * 64 + k] * xi;
            }
            const size_t row = (size_t)(b * SEQ + c * 64 + s);
            const bf16* up = proj + row * NPROJ + g * 16;
#pragma unroll
            for (int p = 0; p < 16; ++p) { const float y = acc[p] + dsk[p] * bf2f(up[p]); GY[row * 512 + g * 16 + p] = f2bf(gelu_tanh(y)); }
        }
        __syncthreads();
    }
}
__global__ __launch_bounds__(512) void k_mlstm(const bf16* __restrict__ proj, const float* __restrict__ gates, const float* conv_w, const float* conv_b, float* __restrict__ hraw) {
    __shared__ float sq[128], sk[128], sv[128], spart[4 * 128], sred[2];
    const int b = blockIdx.x >> 2, h = blockIdx.x & 3, tid = threadIdx.x, e = tid & 127, ds = tid >> 7;
    float C[32];
#pragma unroll
    for (int i = 0; i < 32; ++i) C[i] = 0.f;
    float nst = 0.f;
    int ch = 0; float cw0 = 0, cw1 = 0, cw2 = 0, cw3 = 0, cb = 0, x1 = 0, x2 = 0, x3 = 0;
    if (tid < 256) { ch = tid < 128 ? h * 128 + tid : 512 + h * 128 + (tid - 128); cw0 = conv_w[ch]; cw1 = conv_w[1024 + ch]; cw2 = conv_w[2048 + ch]; cw3 = conv_w[3072 + ch]; cb = conv_b[ch]; }
    for (int t = 0; t < SEQ; ++t) {
        const size_t row = (size_t)b * SEQ + t;
        if (tid < 256) {
            const float xv = bf2f(proj[row * NPROJ + O_Q + ch]);
            float val = cb + cw0 * x3 + cw1 * x2 + cw2 * x1 + cw3 * xv;
            x3 = x2; x2 = x1; x1 = xv;
            val = val * sigmoidf_(val);
            if (tid < 128) sq[tid] = val; else sk[tid - 128] = val * 0.08838834764831845f;
        } else if (tid < 384) sv[tid - 256] = bf2f(proj[row * NPROJ + O_V + h * 128 + (tid - 256)]);
        const float ipre = gates[row * 8 + h], fpre = gates[row * 8 + 4 + h];
        const float f = sigmoidf_(fpre), ei = __expf(ipre);
        __syncthreads();
        const float ve = sv[e] * ei; float part = 0.f;
#pragma unroll
        for (int dd = 0; dd < 32; ++dd) { const int d = ds * 32 + dd; C[dd] = f * C[dd] + sk[d] * ve; part += sq[d] * C[dd]; }
        spart[ds * 128 + e] = part;
        if (tid < 128) { nst = f * nst + ei * sk[tid]; const float dp = wave_sum(sq[tid] * nst); if ((tid & 63) == 0) sred[tid >> 6] = dp; }
        __syncthreads();
        if (tid < 128) { const float num = spart[e] + spart[128 + e] + spart[256 + e] + spart[384 + e]; const float den = sred[0] + sred[1];
            hraw[row * 512 + h * 128 + e] = num / fmaxf(fabsf(den), 1.f); }
    }
}
__global__ __launch_bounds__(256) void k_mlstm_post(const float* __restrict__ hraw, const bf16* __restrict__ proj, const float* norm_g, bf16* __restrict__ MIX) {
    const int wave = threadIdx.x >> 6, lane = threadIdx.x & 63;
    const int idx = blockIdx.x * 4 + wave; const int row = idx >> 2, h = idx & 3;
    const float* hp = hraw + (size_t)row * 512 + h * 128 + 2 * lane;
    const float a = hp[0], c = hp[1];
    const float mu = wave_sum(a + c) * (1.f / 128.f);
    const float da = a - mu, dc = c - mu;
    const float var = wave_sum(da * da + dc * dc) * (1.f / 128.f);
    const float rs = rsqrtf(var + 1e-6f);
    const int col = h * 128 + 2 * lane;
    const float o0 = bf2f(proj[(size_t)row * NPROJ + O_O + col]), o1 = bf2f(proj[(size_t)row * NPROJ + O_O + col + 1]);
    MIX[(size_t)row * D + 512 + col] = f2bf(da * rs * norm_g[col] * sigmoidf_(o0));
    MIX[(size_t)row * D + 512 + col + 1] = f2bf(dc * rs * norm_g[col + 1] * sigmoidf_(o1));
}

extern "C" void kernel_launch(void* const* d_in, const int* in_sizes, int n_in, void* d_out, int out_size, void* d_ws, size_t ws_size, hipStream_t stream) {
    static int grid = 0;
    if (grid == 0) {
        int dev = 0, cus = 0, per_cu = 0;
        if (n_in != 26 || ws_size < WS_END) { fprintf(stderr, "kernel_launch: unexpected n_in %d / ws %zu\n", n_in, ws_size); grid = -1; return; }
        if (hipGetDevice(&dev) != hipSuccess || hipDeviceGetAttribute(&cus, hipDeviceAttributeMultiprocessorCount, dev) != hipSuccess) { grid = -1; return; }
        if (hipFuncSetAttribute((const void*)fwd, hipFuncAttributeMaxDynamicSharedMemorySize, LDS_BYTES) != hipSuccess) { fprintf(stderr, "kernel_launch: hipFuncSetAttribute failed\n"); grid = -1; return; }
        if (hipOccupancyMaxActiveBlocksPerMultiprocessor(&per_cu, (const void*)fwd, NTHR, LDS_BYTES) != hipSuccess || per_cu < 1) fprintf(stderr, "kernel_launch: occupancy query reports %d\n", per_cu);
        (void)hipGetLastError();
        grid = cus;
    }
    if (grid < 0) return;
    (void)in_sizes; (void)out_size;
    unsigned char* ws = (unsigned char*)d_ws;
    (void)hipMemsetAsync(ws + WS_CTL, 0, CTL_ZERO_BYTES, stream);
    Args a{};
    for (int i = 0; i < 26; ++i) a.in[i] = (const float*)d_in[i];
    a.out = (float*)d_out; a.ws = ws;
    a.ph_lo = 0; a.ph_hi = 14; a.li = 0; a.pad = 0;
    hipLaunchKernelGGL(fwd, dim3(grid), dim3(NTHR), LDS_BYTES, stream, a);
}
```

```cpp
#include <hip/hip_runtime.h>
#include <cstdio>
#include <cstdint>

#define GAS __attribute__((address_space(1)))
#define LAS __attribute__((address_space(3)))
typedef unsigned short bf16;
typedef short bf16x8 __attribute__((ext_vector_type(8)));
typedef float f32x4 __attribute__((ext_vector_type(4)));
typedef float f32x16 __attribute__((ext_vector_type(16)));
typedef unsigned u32x4 __attribute__((ext_vector_type(4)));
typedef unsigned u32x2 __attribute__((ext_vector_type(2)));
typedef GAS unsigned gu32;

#define PROBE_LO -1
#define PROBE_HI -1
#define PROBE_PAD 0
constexpr int NB = 4, SEQ = 8192, T = NB * SEQ, D = 1024;
constexpr int DIN = 2568, NPROJ = 2560;
constexpr int O_Q = 512, O_K = 1024, O_V = 1536, O_O = 2048, O_G = 2560;
constexpr int NE = 32, TOPK = 4, FF = 1024;
constexpr int NASSIGN = T * TOPK;
constexpr int MT = 256;
constexpr int NSLOTS = NASSIGN + NE * MT;
constexpr int MAXTILES = NSLOTS / MT;
constexpr int NWAVES = 8, NTHR = 512;

constexpr size_t MiB = 1u << 20;
constexpr size_t WS_CTL = 0, CTL_ZERO_BYTES = 1 * MiB;
constexpr size_t WS_GATES = 1 * MiB;
constexpr size_t WS_TOPI = 2 * MiB;
constexpr size_t WS_TOPG = 3 * MiB;
constexpr size_t WS_SLOTTOK = 4 * MiB;
constexpr size_t WS_TOKSLOT = 5 * MiB;
constexpr size_t WS_CNT = 6 * MiB;
constexpr size_t WS_WIN = 8 * MiB;
constexpr size_t WS_WGLU = 13 * MiB;
constexpr size_t WS_WOUT = 14 * MiB;
constexpr size_t WS_WUP = 16 * MiB;
constexpr size_t WS_WDN = 144 * MiB;
constexpr size_t WS_HN = 208 * MiB;
constexpr size_t WS_PROJ = 272 * MiB;
constexpr size_t WS_GY = 432 * MiB;
constexpr size_t WS_MIX = 464 * MiB;
constexpr size_t WS_HRAW = 528 * MiB;
constexpr size_t WS_ACT = 272 * MiB;
constexpr size_t WS_H = 592 * MiB;
constexpr size_t WS_YS = 720 * MiB;
constexpr size_t WS_END = 992 * MiB;
constexpr int S5K = 1152;
constexpr size_t WS_S5A = 720 * MiB;
constexpr size_t WS_S5BT = 760 * MiB;
constexpr size_t WS_S5BQ = 836 * MiB;
constexpr size_t WS_XLOC = 856 * MiB;
constexpr size_t WS_QH = 866 * MiB;
constexpr size_t WS_KH = 898 * MiB;
constexpr size_t WS_VT = 930 * MiB;
constexpr size_t WS_DC = 962 * MiB;
constexpr size_t WS_CST = 978 * MiB;
constexpr size_t WS_FLOC = 986 * MiB;
constexpr size_t WS_DN = 987 * MiB;
constexpr size_t WS_NST = 988 * MiB;
constexpr size_t WS_SEGS = 989 * MiB;
constexpr size_t WS_KTAB = 990 * MiB;
static_assert(WS_S5A + (size_t)32 * 512 * S5K * 2 <= WS_S5BT && WS_S5BT + (size_t)32 * 1024 * S5K * 2 <= WS_S5BQ && WS_S5BQ + (size_t)32 * 256 * 1024 * 2 <= WS_XLOC && WS_XLOC + (size_t)32 * 512 * 128 * 4 <= WS_END, "s5 map");
static_assert(WS_ACT + (size_t)NSLOTS * FF * 2 <= WS_H && WS_YS + (size_t)NSLOTS * D * 2 <= WS_END, "ws map");
constexpr int CW_BAR = 4096;

constexpr int RING_BYTES = 131072;
constexpr int MISC_OFF = RING_BYTES;
constexpr int IDX_OFF = MISC_OFF + 128;
constexpr int TIL_OFF = IDX_OFF + 2048;
constexpr int LDS_BYTES = 147456;
static_assert(TIL_OFF + 3 * MAXTILES * 4 + 256 <= LDS_BYTES, "LDS map");

#define RLX_AGENT __ATOMIC_RELAXED, __HIP_MEMORY_SCOPE_AGENT
__device__ __forceinline__ float bf2f(bf16 v) { return __uint_as_float(((unsigned)v) << 16); }
__device__ __forceinline__ bf16 f2bf(float f) { unsigned u = __float_as_uint(f); u += 0x7fffu + ((u >> 16) & 1u); return (bf16)(u >> 16); }
__device__ __forceinline__ unsigned pk2(float lo, float hi) { return (unsigned)f2bf(lo) | ((unsigned)f2bf(hi) << 16); }
__device__ __forceinline__ unsigned cvt_pk_bf16(float lo, float hi) { unsigned r; asm volatile("v_cvt_pk_bf16_f32 %0, %1, %2" : "=v"(r) : "v"(lo), "v"(hi)); return r; }
__device__ __forceinline__ float lo_bf(unsigned u) { return __uint_as_float(u << 16); }
__device__ __forceinline__ float hi_bf(unsigned u) { return __uint_as_float(u & 0xffff0000u); }
__device__ __forceinline__ float wave_sum(float v) {
#pragma unroll
    for (int o = 1; o < 64; o <<= 1) v += __shfl_xor(v, o);
    return v;
}
__device__ __forceinline__ float sigmoidf_(float x) { return 1.f / (1.f + __expf(-x)); }
__device__ __forceinline__ float gelu_tanh(float x) { const float u = 1.5957691216057308f * (x + 0.044715f * x * x * x); return x / (1.f + __expf(-u)); }

#define XB_TMO      128
#define XB_XCNT(j)  (256  + 64 * (j))
#define XB_XSUB(j)  (1280 + 64 * (j))
#define XB_XGEN(j)  (2304 + 64 * (j))
#define XB_TOP      3328
#define XB_TOPGEN   3392
#define XCD_BAR_WORDS 3456
#define XB_SPIN_CAP (1u << 18)
__device__ __forceinline__ unsigned xb_ld(unsigned* p)              { return __hip_atomic_load(p, __ATOMIC_RELAXED, __HIP_MEMORY_SCOPE_AGENT); }
__device__ __forceinline__ unsigned xb_add(unsigned* p, unsigned v) { return __hip_atomic_fetch_add(p, v, __ATOMIC_RELAXED, __HIP_MEMORY_SCOPE_AGENT); }
__device__ __forceinline__ unsigned xb_xcc_id() { return (unsigned)__builtin_amdgcn_s_getreg((3 << 11) | 20) & 0xFu; }
#define XB_SPIN(cond, bar) do { unsigned _sp = 0; while (cond) { __builtin_amdgcn_s_sleep(1); \
    if ((++_sp & 255u) == 0u) { if (xb_ld(&(bar)[XB_TMO])) break; if (_sp > XB_SPIN_CAP) { atomicAdd(&(bar)[XB_TMO], 1u); break; } } } } while (0)
struct XcdBarrier { unsigned* bar; unsigned x; volatile LAS unsigned* st; };
__device__ __forceinline__ XcdBarrier xcd_barrier_post(unsigned* bar, volatile LAS unsigned* st) {
    XcdBarrier b; b.bar = bar; b.x = xb_xcc_id(); b.st = st;
    if (threadIdx.x == 0) (void)xb_add(&bar[XB_XCNT(b.x)], 1u);
    return b;
}
__device__ __forceinline__ void xcd_barrier_complete(unsigned* bar, unsigned x, unsigned& nloc, unsigned& nx) {
    const unsigned G = gridDim.x * gridDim.y * gridDim.z;
    unsigned sum, cnt, mine, sp = 0u;
    for (;;) {
        sum = 0u; cnt = 0u; mine = 0u;
#pragma unroll
        for (unsigned j = 0; j < 16; ++j) { const unsigned c = xb_ld(&bar[XB_XCNT(j)]); sum += c; cnt += (c > 0u) ? 1u : 0u; mine = (j == x) ? c : mine; }
        if (sum == G) break;
        __builtin_amdgcn_s_sleep(1);
        if ((++sp & 255u) == 0u) { if (xb_ld(&bar[XB_TMO])) break; if (sp > XB_SPIN_CAP) { atomicAdd(&bar[XB_TMO], 1u); break; } }
    }
    nloc = mine > 0u ? mine : 1u; nx = cnt > 0u ? cnt : 1u;
}
__device__ __forceinline__ void xcd_barrier(const XcdBarrier& b) {
    asm volatile("s_waitcnt vmcnt(0)" ::: "memory");
    __syncthreads();
    if (threadIdx.x == 0) {
        unsigned* bar = b.bar;
        __builtin_amdgcn_s_waitcnt(0);
        unsigned nloc = b.st[0], nx = b.st[1];
        if (nloc == 0u) { xcd_barrier_complete(bar, b.x, nloc, nx); b.st[0] = nloc; b.st[1] = nx; }
        const unsigned old = xb_add(&bar[XB_XSUB(b.x)], 1u);
        const unsigned gen = old / nloc;
        if (old + 1u == (gen + 1u) * nloc) {
            __builtin_amdgcn_fence(__ATOMIC_RELEASE, "agent");
            asm volatile("s_waitcnt vmcnt(0)" ::: "memory");
            const unsigned og = xb_add(&bar[XB_TOP], 1u);
            const unsigned tg = og / nx;
            if (og + 1u == (tg + 1u) * nx) xb_add(&bar[XB_TOPGEN], 1u);
            else XB_SPIN(xb_ld(&bar[XB_TOPGEN]) == tg, bar);
            __builtin_amdgcn_fence(__ATOMIC_ACQUIRE, "agent");
            xb_add(&bar[XB_XGEN(b.x)], 1u);
            asm volatile("s_waitcnt vmcnt(0)" ::: "memory");
        } else {
            XB_SPIN(xb_ld(&bar[XB_XGEN(b.x)]) == gen, bar);
            __builtin_amdgcn_fence(__ATOMIC_ACQUIRE, "agent");
            asm volatile("s_waitcnt vmcnt(0)" ::: "memory");
        }
    }
    __syncthreads();
}

namespace pg {
constexpr int BM = 256, BK = 64, HALF = 128, HTB = HALF * BK * 2, STAGE_BYTES = 8 * HTB, NXCD = 8, WGM = 8;
__host__ __device__ __forceinline__ int lds_byte(int r, int c) { const int st = (r >> 4) * 2 + (c >> 5), rr = r & 15, cc = c & 31, ob = rr * 64 + cc * 2; return st * 1024 + (ob ^ (((ob >> 9) & 1) << 5)); }
__host__ __device__ __forceinline__ void stage_rc(int b, int& R, int& C) { const int st = b / 1024, sb = b % 1024, swz = sb ^ (((sb >> 9) & 1) << 5); R = (st >> 1) * 16 + swz / 64; C = (st & 1) * 32 + (swz % 64) / 2; }
__host__ __device__ __forceinline__ int perm32(int rho) { const int n = rho >> 4, i = rho & 15; return 8 * (i >> 2) + 4 * n + (i & 3); }

struct Unit { const char* A; const char* B; int pm, pn, e, nrows; };

__device__ __forceinline__ bool tile_order(int i, int G, int c, int nM, int nN, int& pm, int& pn) {
    const int nwg = nM * nN; const long L = (long)i * G + c; if (L >= nwg) return false;
    int wgid = (int)L; { const int q = nwg / NXCD, r = nwg % NXCD, xcd = wgid % NXCD, off = wgid / NXCD; wgid = (xcd < r ? xcd * (q + 1) : r * (q + 1) + (xcd - r) * q) + off; }
    const int nig = WGM * nN, gid = wgid / nig, fm = gid * WGM, gsz = (nM - fm) < WGM ? (nM - fm) : WGM;
    pm = fm + ((wgid % nig) % gsz); pn = (wgid % nig) / gsz; return true;
}
struct DenseSched {
    const char* A; const char* Bt; int lda2  , K2  , nM, nN, G, c;
    __device__ __forceinline__ bool next(int i, Unit& u) const { int pm, pn; if (!tile_order(i, G, c, nM, nN, pm, pn)) return false;
        u.A = A + (size_t)pm * 256 * lda2; u.B = Bt + (size_t)pn * 256 * K2; u.pm = pm; u.pn = pn; u.e = 0; u.nrows = 256; return true; }
    __device__ __forceinline__ void prefetch(const Unit&, int) const {}
    __device__ __forceinline__ unsigned aoff(const Unit&, int row, int) const { return (unsigned)row * (unsigned)lda2; }
};

template <class Epi, class Sched, bool ALIGN_EPI>
__device__ __forceinline__ void gemm_phase(LAS unsigned char* lds, const int K, const Sched& S, const Epi& E) {
    const int tid = threadIdx.x, wid = __builtin_amdgcn_readfirstlane(tid >> 6), lane = tid & 63, wr = wid >> 2, wc = wid & 3, fr = lane & 15, fq = lane >> 4;
    const int nt = K / BK;
    unsigned voffA[2][2], voffB[2];
#pragma unroll
    for (int i = 0; i < 2; ++i) { int R, C; stage_rc(tid * 16 + i * 8192, R, C); const int Rb = Epi::PERM ? ((R & ~31) + perm32(R & 31)) : R; voffB[i] = (unsigned)(Rb * K + C) * 2u; }
    const size_t kstep = (size_t)(BK * 2);
    const size_t hstep = (size_t)HALF * K * 2;
    const unsigned ldsw = (unsigned)wid * 1024u;
    const int aoff = lds_byte(wr * 64 + fr, fq * 8), boff = lds_byte(wc * 32 + fr, fq * 8);
#define PG_SA(b, h) (((b) * 2 + (h)) * HTB)
#define PG_SB(b, h) ((4 + (b) * 2 + (h)) * HTB)
#define PG_STAGE(bufoff, gbase, voff) do { _Pragma("unroll") for (int _i = 0; _i < 2; ++_i) \
        __builtin_amdgcn_global_load_lds((const unsigned*)((const char*)(gbase) + (voff)[_i]), (LAS unsigned*)(lds + (bufoff) + ldsw + _i * 8192), 16, 0, 0); } while (0)
#define PG_LDA(dst, b, h) do { _Pragma("unroll") for (int m = 0; m < 4; ++m) _Pragma("unroll") for (int k = 0; k < 2; ++k) dst[m][k] = *(const LAS bf16x8*)(lds + PG_SA(b, h) + aoff + m * 2048 + k * 1024); } while (0)
#define PG_LDB(dst, b, h) do { _Pragma("unroll") for (int n = 0; n < 2; ++n) _Pragma("unroll") for (int k = 0; k < 2; ++k) dst[n][k] = *(const LAS bf16x8*)(lds + PG_SB(b, h) + boff + n * 2048 + k * 1024); } while (0)
#define PG_MMA(ai, bj, At, Bt) do { __builtin_amdgcn_s_setprio(1); _Pragma("unroll") for (int m = 0; m < 4; ++m) _Pragma("unroll") for (int n = 0; n < 2; ++n) _Pragma("unroll") for (int k = 0; k < 2; ++k) \
        acc[ai][bj][m][n] = __builtin_amdgcn_mfma_f32_16x16x32_bf16(Bt[n][k], At[m][k], acc[ai][bj][m][n], 0, 0, 0); __builtin_amdgcn_s_setprio(0); } while (0)
#define PG_WAIT_V(n) asm volatile("s_waitcnt vmcnt(" #n ")" ::: "memory")
#define PG_WAIT_L(n) asm volatile("s_waitcnt lgkmcnt(" #n ")" ::: "memory")
#define PG_BAR __builtin_amdgcn_s_barrier()
#define PG_SCHED __builtin_amdgcn_sched_barrier(0)
#define PG_SET_AOFF(u, ib) do { _Pragma("unroll") for (int _i = 0; _i < 2; ++_i) { int _R, _C; stage_rc(tid * 16 + _i * 8192, _R, _C); \
        voffA[0][_i] = S.aoff(u, _R, ib) + (unsigned)_C * 2u; voffA[1][_i] = S.aoff(u, _R + HALF, ib) + (unsigned)_C * 2u; } } while (0)
    Unit cur, nxt; int ui = 0;
    if (!S.next(0, cur)) return;
    f32x4 acc[2][2][4][2];
#pragma unroll
    for (int a = 0; a < 2; ++a)
#pragma unroll
        for (int b = 0; b < 2; ++b)
#pragma unroll
            for (int m = 0; m < 4; ++m)
#pragma unroll
                for (int n = 0; n < 2; ++n) acc[a][b][m][n] = (f32x4){0.f, 0.f, 0.f, 0.f};
    bf16x8 At[4][2], B0[2][2], B1[2][2];
    const char* cA = cur.A; const char* cB = cur.B;
    S.prefetch(cur, 0);
    PG_WAIT_V(0); __syncthreads();
    PG_SET_AOFF(cur, 0);
    PG_STAGE(PG_SB(0, 0), cB, voffB); PG_STAGE(PG_SB(0, 1), cB + hstep, voffB); PG_STAGE(PG_SA(0, 0), cA, voffA[0]); PG_STAGE(PG_SA(0, 1), cA, voffA[1]);
    if (wr == 1) PG_BAR;
    PG_WAIT_V(2); PG_BAR;
    PG_STAGE(PG_SB(1, 0), cB + kstep, voffB); PG_STAGE(PG_SA(1, 0), cA + kstep, voffA[0]); PG_STAGE(PG_SB(1, 1), cB + hstep + kstep, voffB);
    PG_WAIT_V(6); PG_BAR;
    for (;;) {
        const bool has_next = S.next(ui + 1, nxt);
        const char* nA = has_next ? nxt.A : cA; const char* nB = has_next ? nxt.B : cB;
        if (has_next) S.prefetch(nxt, (ui + 1) & 1);
        for (int t = 0; t < nt; t += 2) {
            const bool last = (t == nt - 2);
            const char* a1 = cA + (size_t)(t + 1) * kstep;
            const char* a2 = last ? nA : cA + (size_t)(t + 2) * kstep; const char* b2 = last ? nB : cB + (size_t)(t + 2) * kstep;
            const char* a3 = a2 + kstep; const char* b3 = b2 + kstep;
            PG_LDB(B0, 0, 0); PG_LDB(B1, 0, 1); PG_SCHED; PG_LDA(At, 0, 0); PG_STAGE(PG_SA(1, 1), a1, voffA[1]);
            PG_WAIT_V(8); PG_WAIT_L(0); PG_BAR; PG_MMA(0, 0, At, B0); PG_MMA(0, 1, At, B1); PG_BAR; PG_SCHED;
            if (last && has_next) PG_SET_AOFF(nxt, (ui + 1) & 1);
            PG_LDA(At, 0, 1); PG_STAGE(PG_SB(0, 0), b2, voffB); PG_STAGE(PG_SB(0, 1), b2 + hstep, voffB); PG_STAGE(PG_SA(0, 0), a2, voffA[0]);
            PG_WAIT_V(8); PG_WAIT_L(0); PG_BAR; PG_MMA(1, 0, At, B0); PG_MMA(1, 1, At, B1); PG_BAR; PG_SCHED;
            PG_LDB(B0, 1, 0); PG_LDB(B1, 1, 1); PG_SCHED; PG_LDA(At, 1, 0); PG_STAGE(PG_SA(0, 1), a2, voffA[1]);
            PG_WAIT_V(8); PG_WAIT_L(0); PG_BAR; PG_MMA(0, 0, At, B0); PG_MMA(0, 1, At, B1); PG_BAR; PG_SCHED;
            PG_LDA(At, 1, 1); PG_STAGE(PG_SB(1, 0), b3, voffB); PG_STAGE(PG_SB(1, 1), b3 + hstep, voffB); PG_STAGE(PG_SA(1, 0), a3, voffA[0]);
            PG_WAIT_V(8); PG_WAIT_L(0); PG_BAR; PG_MMA(1, 0, At, B0); PG_MMA(1, 1, At, B1); PG_BAR; PG_SCHED;
        }
        if constexpr (ALIGN_EPI) { if (wr == 0) PG_BAR; }
        E(acc, cur, wr, wc, fr, fq);
        if (!has_next) break;
#pragma unroll
        for (int a = 0; a < 2; ++a)
#pragma unroll
            for (int b = 0; b < 2; ++b)
#pragma unroll
                for (int m = 0; m < 4; ++m)
#pragma unroll
                    for (int n = 0; n < 2; ++n) acc[a][b][m][n] = (f32x4){0.f, 0.f, 0.f, 0.f};
        cur = nxt; cA = nA; cB = nB; ++ui;
        if constexpr (ALIGN_EPI) { if (wr == 1) PG_BAR; }
    }
    PG_WAIT_V(0);
    if constexpr (!ALIGN_EPI) { if (wr == 0) PG_BAR; }
    PG_BAR;
#undef PG_SA
#undef PG_SB
#undef PG_STAGE
#undef PG_LDA
#undef PG_LDB
#undef PG_MMA
#undef PG_WAIT_V
#undef PG_WAIT_L
#undef PG_BAR
#undef PG_SCHED
#undef PG_SET_AOFF
}

struct EpiProj {
    static constexpr bool PERM = true; bf16* P; bf16* S5A;
    __device__ __forceinline__ void operator()(const f32x4 (&acc)[2][2][4][2], const Unit& u, int wr, int wc, int fr, int fq) const {
        const int row0 = u.pm * BM + wr * 64 + fr, col0 = u.pn * BM + wc * 32 + 8 * fq;
#pragma unroll
        for (int ai = 0; ai < 2; ++ai)
#pragma unroll
            for (int m = 0; m < 4; ++m) { const int row = row0 + ai * HALF + m * 16; bf16* rowp = P + (size_t)row * NPROJ + col0;
                if (u.pn < 2) { const int b = row >> 13, tt = row & 8191; rowp = S5A + ((size_t)b * 128 + (tt >> 6)) * S5K + (tt & 63) * 16 + (col0 & 15) + (size_t)(col0 >> 4) * 512 * S5K - (size_t)0; }
#pragma unroll
                for (int bj = 0; bj < 2; ++bj) { const f32x4 v0 = acc[ai][bj][m][0], v1 = acc[ai][bj][m][1];
                    u32x4 w; w.x = cvt_pk_bf16(v0[0], v0[1]); w.y = cvt_pk_bf16(v0[2], v0[3]); w.z = cvt_pk_bf16(v1[0], v1[1]); w.w = cvt_pk_bf16(v1[2], v1[3]);
                    *(u32x4*)(rowp + (u.pn < 2 ? (size_t)bj * 8 * 512 * S5K : (size_t)bj * HALF)) = w; } }
    }
};
struct EpiXloc {
    static constexpr bool PERM = false; float* X;
    __device__ __forceinline__ void operator()(const f32x4 (&acc)[2][2][4][2], const Unit& u, int wr, int wc, int fr, int fq) const {
        const int row0 = (u.pm & 1) * BM + wr * 64 + fr, col0 = wc * 32 + 4 * fq;
#pragma unroll
        for (int ai = 0; ai < 2; ++ai)
#pragma unroll
            for (int m = 0; m < 4; ++m) { float* rp = X + ((size_t)u.e * 512 + row0 + ai * HALF + m * 16) * 128 + col0;
#pragma unroll
                for (int n = 0; n < 2; ++n) *(f32x4*)(rp + n * 16) = acc[ai][0][m][n]; }
    }
};
struct EpiS5Y {
    static constexpr bool PERM = true; const bf16* S5A; const float* dskip; bf16* GY;
    __device__ __forceinline__ void operator()(const f32x4 (&acc)[2][2][4][2], const Unit& u, int wr, int wc, int fr, int fq) const {
        const int g = u.e, rg0 = (u.pm & 1) * BM + wr * 64 + fr, c0 = u.pn * BM + wc * 32 + 8 * fq;
#pragma unroll
        for (int bj = 0; bj < 2; ++bj) { const int col = c0 + bj * HALF, t = col >> 4, p0 = col & 15;
            const f32x4 d0 = *(const f32x4*)(dskip + g * 16 + p0), d1 = *(const f32x4*)(dskip + g * 16 + p0 + 4);
#pragma unroll
            for (int ai = 0; ai < 2; ++ai)
#pragma unroll
                for (int m = 0; m < 4; ++m) { const int rg = rg0 + ai * HALF + m * 16; const int b = rg >> 7, c = rg & 127;
                    const u32x4 uu = *(const u32x4*)(S5A + ((size_t)g * 512 + rg) * S5K + col);
                    const f32x4 v0 = acc[ai][bj][m][0], v1 = acc[ai][bj][m][1];
                    u32x4 w;
                    w.x = cvt_pk_bf16(gelu_tanh(v0[0] + d0[0] * lo_bf(uu.x)), gelu_tanh(v0[1] + d0[1] * hi_bf(uu.x))); w.y = cvt_pk_bf16(gelu_tanh(v0[2] + d0[2] * lo_bf(uu.y)), gelu_tanh(v0[3] + d0[3] * hi_bf(uu.y)));
                    w.z = cvt_pk_bf16(gelu_tanh(v1[0] + d1[0] * lo_bf(uu.z)), gelu_tanh(v1[1] + d1[1] * hi_bf(uu.z))); w.w = cvt_pk_bf16(gelu_tanh(v1[2] + d1[2] * lo_bf(uu.w)), gelu_tanh(v1[3] + d1[3] * hi_bf(uu.w)));
                    *(u32x4*)(GY + ((size_t)b * SEQ + c * 64 + t) * 512 + g * 16 + p0) = w; } }
    }
};
struct S5Sched {
    const char* A; const char* B; int lda2, K2, brows, nN, G, c;
    __device__ __forceinline__ bool next(int i, Unit& u) const { const int L = i * G + c; if (L >= 64 * nN) return false;
        const int g = L / (2 * nN), r = L % (2 * nN), mh = r / nN, pn = r % nN;
        u.A = A + ((size_t)g * 512 + mh * 256) * lda2; u.B = B + ((size_t)g * brows + pn * 256) * K2; u.pm = g * 2 + mh; u.pn = pn; u.e = g; u.nrows = 256; return true; }
    __device__ __forceinline__ void prefetch(const Unit&, int) const {}
    __device__ __forceinline__ unsigned aoff(const Unit&, int row, int) const { return (unsigned)row * (unsigned)lda2; }
};
struct EpiGlu {
    static constexpr bool PERM = true; const bf16* GY; const float* bglu; bf16* MIX;
    __device__ __forceinline__ void operator()(const f32x4 (&acc)[2][2][4][2], const Unit& u, int wr, int wc, int fr, int fq) const {
        const int row0 = u.pm * BM + wr * 64 + fr, col0 = u.pn * BM + wc * 32 + 8 * fq;
#pragma unroll
        for (int bj = 0; bj < 2; ++bj) { const int col = col0 + bj * HALF;
            const f32x4 b0 = *(const f32x4*)(bglu + col), b1 = *(const f32x4*)(bglu + col + 4);
#pragma unroll
            for (int ai = 0; ai < 2; ++ai)
#pragma unroll
                for (int m = 0; m < 4; ++m) { const size_t row = (size_t)(row0 + ai * HALF + m * 16);
                    const u32x4 g = *(const u32x4*)(GY + row * 512 + col);
                    const f32x4 v0 = acc[ai][bj][m][0] + b0, v1 = acc[ai][bj][m][1] + b1;
                    u32x4 w;
                    w.x = cvt_pk_bf16(lo_bf(g.x) * sigmoidf_(v0[0]), hi_bf(g.x) * sigmoidf_(v0[1])); w.y = cvt_pk_bf16(lo_bf(g.y) * sigmoidf_(v0[2]), hi_bf(g.y) * sigmoidf_(v0[3]));
                    w.z = cvt_pk_bf16(lo_bf(g.z) * sigmoidf_(v1[0]), hi_bf(g.z) * sigmoidf_(v1[1])); w.w = cvt_pk_bf16(lo_bf(g.w) * sigmoidf_(v1[2]), hi_bf(g.w) * sigmoidf_(v1[3]));
                    *(u32x4*)(MIX + row * D + col) = w; } }
    }
};
struct EpiOut {
    static constexpr bool PERM = false; const float* x; float* H;
    __device__ __forceinline__ void operator()(const f32x4 (&acc)[2][2][4][2], const Unit& u, int wr, int wc, int fr, int fq) const {
        const int row0 = u.pm * BM + wr * 64 + fr, col0 = u.pn * BM + wc * 32 + 4 * fq;
#pragma unroll
        for (int ai = 0; ai < 2; ++ai)
#pragma unroll
            for (int m = 0; m < 4; ++m) { const size_t ro = (size_t)(row0 + ai * HALF + m * 16) * D + col0;
#pragma unroll
                for (int bj = 0; bj < 2; ++bj)
#pragma unroll
                    for (int n = 0; n < 2; ++n) *(f32x4*)(H + ro + bj * HALF + n * 16) = *(const f32x4*)(x + ro + bj * HALF + n * 16) + acc[ai][bj][m][n]; }
    }
};
struct EpiUp {
    static constexpr bool PERM = true; const float* b_up; bf16* ACT;
    __device__ __forceinline__ void operator()(const f32x4 (&acc)[2][2][4][2], const Unit& u, int wr, int wc, int fr, int fq) const {
        const int row0 = u.pm * BM + wr * 64 + fr, j0 = u.pn * HALF + wc * 32 + 8 * fq;
        const float* bg = b_up + (size_t)u.e * 2 * FF + j0;
        const f32x4 g0 = *(const f32x4*)bg, g1 = *(const f32x4*)(bg + 4), l0 = *(const f32x4*)(bg + FF), l1 = *(const f32x4*)(bg + FF + 4);
#pragma unroll
        for (int ai = 0; ai < 2; ++ai)
#pragma unroll
            for (int m = 0; m < 4; ++m) {
                float o[8];
#pragma unroll
                for (int n = 0; n < 2; ++n)
#pragma unroll
                    for (int q = 0; q < 4; ++q) { const float g = fminf(acc[ai][0][m][n][q] + (n ? g1[q] : g0[q]), 7.f); const float li = fminf(fmaxf(acc[ai][1][m][n][q] + (n ? l1[q] : l0[q]), -7.f), 7.f);
                        o[n * 4 + q] = g * sigmoidf_(1.702f * g) * (li + 1.f); }
                u32x4 w; w.x = cvt_pk_bf16(o[0], o[1]); w.y = cvt_pk_bf16(o[2], o[3]); w.z = cvt_pk_bf16(o[4], o[5]); w.w = cvt_pk_bf16(o[6], o[7]);
                *(u32x4*)(ACT + (size_t)(row0 + ai * HALF + m * 16) * FF + j0) = w; }
    }
};
struct EpiDown {
    static constexpr bool PERM = true; const float* b_down; bf16* YS;
    __device__ __forceinline__ void operator()(const f32x4 (&acc)[2][2][4][2], const Unit& u, int wr, int wc, int fr, int fq) const {
        const int row0 = u.pm * BM + wr * 64 + fr, col0 = u.pn * BM + wc * 32 + 8 * fq;
#pragma unroll
        for (int bj = 0; bj < 2; ++bj) { const int col = col0 + bj * HALF;
            const f32x4 b0 = *(const f32x4*)(b_down + (size_t)u.e * D + col), b1 = *(const f32x4*)(b_down + (size_t)u.e * D + col + 4);
#pragma unroll
            for (int ai = 0; ai < 2; ++ai)
#pragma unroll
                for (int m = 0; m < 4; ++m) { const f32x4 v0 = acc[ai][bj][m][0] + b0, v1 = acc[ai][bj][m][1] + b1;
                    u32x4 w; w.x = cvt_pk_bf16(v0[0], v0[1]); w.y = cvt_pk_bf16(v0[2], v0[3]); w.z = cvt_pk_bf16(v1[0], v1[1]); w.w = cvt_pk_bf16(v1[2], v1[3]);
                    *(u32x4*)(YS + (size_t)(row0 + ai * HALF + m * 16) * D + col) = w; } }
    }
};
}

struct MoeSched {
    const char* A; const char* W; const int* slot_tok; LAS int* til; LAS int* idx; int lda2, K2, nN, wrows  , G, c, gather;
    __device__ __forceinline__ bool next(int i, pg::Unit& u) const {
        const int nM = til[2 * MAXTILES]; int pm, pn; if (!pg::tile_order(i, G, c, nM, nN, pm, pn)) return false;
        const int e = til[pm]; u.pm = pm; u.pn = pn; u.e = e; u.nrows = til[MAXTILES + pm];
        u.A = gather ? A : A + (size_t)pm * 256 * lda2; u.B = W + ((size_t)e * wrows + (size_t)pn * 256) * K2; return true; }
    __device__ __forceinline__ void prefetch(const pg::Unit& u, int ib) const {
        if (gather && threadIdx.x < 256) { const int r = threadIdx.x; const int s = u.pm * 256 + (r < u.nrows ? r : u.nrows - 1);
            __builtin_amdgcn_global_load_lds((const unsigned*)(slot_tok + s), (LAS unsigned*)(idx + ib * 256 + (threadIdx.x & ~63)), 4, 0, 0); } }
    __device__ __forceinline__ unsigned aoff(const pg::Unit&, int row, int ib) const { return gather ? (unsigned)idx[ib * 256 + row] * (unsigned)lda2 : (unsigned)row * (unsigned)lda2; }
};

struct Frame {
    LAS unsigned char* lds; volatile LAS unsigned* MISC; gu32* ctl; int tid, lane, wave, vcu, G;
};
#define LDS_WAIT() asm volatile("s_waitcnt lgkmcnt(0)" ::: "memory")

template <class RowMap>
__device__ __forceinline__ void transpose_item(const float* W, int ldw, int K, int nblk, bf16* WT, LAS bf16* scr, int item, int lane, RowMap rowmap) {
    const int kb = item / nblk, nb = item % nblk, k0 = 64 * kb, n0 = 64 * nb;
    const float* src = W + (size_t)(k0 + (lane >> 4)) * ldw + n0 + 4 * (lane & 15);
    f32x4 v[16];
#pragma unroll
    for (int i = 0; i < 16; ++i) v[i] = *(const f32x4*)(src + (size_t)(4 * i) * ldw);
#pragma unroll
    for (int i = 0; i < 16; ++i) { u32x2 o; o.x = pk2(v[i].x, v[i].y); o.y = pk2(v[i].z, v[i].w); *(LAS u32x2*)(scr + ((lane >> 4) + 4 * i) * 68 + 4 * (lane & 15)) = o; }
    LDS_WAIT(); asm volatile("" ::: "memory");
    const int c = lane & 7; const int r0 = rowmap(n0);
#pragma unroll
    for (int jn = 0; jn < 8; ++jn) { const int n = (lane >> 3) + 8 * jn; const LAS bf16* sp = scr + (8 * c) * 68 + n;
        u32x4 o; o.x = (unsigned)sp[0] | ((unsigned)sp[68] << 16); o.y = (unsigned)sp[2 * 68] | ((unsigned)sp[3 * 68] << 16); o.z = (unsigned)sp[4 * 68] | ((unsigned)sp[5 * 68] << 16); o.w = (unsigned)sp[6 * 68] | ((unsigned)sp[7 * 68] << 16);
        *(u32x4*)(WT + (size_t)(r0 + n) * K + k0 + 8 * c) = o; }
    LDS_WAIT(); asm volatile("" ::: "memory");
}
struct RowId { __device__ __forceinline__ int operator()(int n0) const { return n0; } };
struct RowUp { __device__ __forceinline__ int operator()(int n0) const { return n0 < FF ? (n0 >> 7) * 256 + (n0 & 127) : ((n0 - FF) >> 7) * 256 + 128 + ((n0 - FF) & 127); } };

struct Args { const float* in[26]; float* out; unsigned char* ws; int ph_lo, ph_hi, li, pad; };

__global__ void __launch_bounds__(NTHR, 2) fwd(Args args) {
    extern __shared__ __attribute__((aligned(16))) unsigned char lds_raw[];
    Frame F;
    F.lds = (LAS unsigned char*)lds_raw;
    F.MISC = (volatile LAS unsigned*)(F.lds + MISC_OFF);
    F.tid = threadIdx.x; F.lane = F.tid & 63; F.wave = __builtin_amdgcn_readfirstlane(F.tid >> 6);
    F.G = gridDim.x; { const int bx = blockIdx.x; F.vcu = (F.G % 8 == 0) ? (bx % 8) * (F.G / 8) + bx / 8 : bx; }
    unsigned char* ws = args.ws;
    F.ctl = (gu32*)(ws + WS_CTL);
    if (F.tid < 32) ((LAS unsigned*)(F.lds + MISC_OFF))[F.tid] = 0u;
    __syncthreads();
    XcdBarrier bar = xcd_barrier_post((unsigned*)(F.ctl + CW_BAR) + args.li * XCD_BAR_WORDS, F.MISC + 8);
    const int lo = args.ph_lo, hi = args.ph_hi;
#define IN(k) (lo <= (k) && (k) < hi)
#define BOTH(k) (IN(k) && IN((k) + 1))
#define GRID_BAR() xcd_barrier(bar)
    const float* x = args.in[0];
    bf16* WIN = (bf16*)(ws + WS_WIN); bf16* WGLU = (bf16*)(ws + WS_WGLU); bf16* WOUT = (bf16*)(ws + WS_WOUT); bf16* WUP = (bf16*)(ws + WS_WUP); bf16* WDN = (bf16*)(ws + WS_WDN);
    bf16* HN = (bf16*)(ws + WS_HN); bf16* PROJ = (bf16*)(ws + WS_PROJ); bf16* GY = (bf16*)(ws + WS_GY); bf16* MIX = (bf16*)(ws + WS_MIX);
    float* H = (float*)(ws + WS_H); bf16* ACT = (bf16*)(ws + WS_ACT); bf16* YS = (bf16*)(ws + WS_YS);
    float* gates = (float*)(ws + WS_GATES); int* topi = (int*)(ws + WS_TOPI); float* topg = (float*)(ws + WS_TOPG);
    int* slot_tok = (int*)(ws + WS_SLOTTOK); int* tok_slot = (int*)(ws + WS_TOKSLOT); int* CNT = (int*)(ws + WS_CNT); int* ecnt = CNT + 16384;
    bf16* S5A = (bf16*)(ws + WS_S5A); bf16* S5BT = (bf16*)(ws + WS_S5BT); bf16* S5BQ = (bf16*)(ws + WS_S5BQ); float* XLOC = (float*)(ws + WS_XLOC);
    bf16* QH = (bf16*)(ws + WS_QH); bf16* KH = (bf16*)(ws + WS_KH); bf16* VT = (bf16*)(ws + WS_VT); float* DC = (float*)(ws + WS_DC); bf16* CST = (bf16*)(ws + WS_CST);
    float* FLOC = (float*)(ws + WS_FLOC); float* DN = (float*)(ws + WS_DN); float* NST = (float*)(ws + WS_NST); float* SEGS = (float*)(ws + WS_SEGS); float* KTAB = (float*)(ws + WS_KTAB);
    const int gw = F.vcu * NWAVES + F.wave, NGW = F.G * NWAVES;

    if (IN(0)) {
        LAS bf16* scr = (LAS bf16*)(F.lds + F.wave * 16384);
        constexpr int I_IN = (D / 64) * (NPROJ / 64), I_GLU = (512 / 64) * (512 / 64), I_OUT = (D / 64) * (D / 64), I_UP = (D / 64) * (2 * FF / 64), I_DN = (FF / 64) * (D / 64);
        constexpr int NITEMS = I_IN + I_GLU + I_OUT + NE * I_UP + NE * I_DN;
        for (int it = gw; it < NITEMS && !(args.pad & 1); it += NGW) {
            int r = it;
            if (r < I_IN) { transpose_item(args.in[2], DIN, D, NPROJ / 64, WIN, scr, r, F.lane, RowId()); continue; } r -= I_IN;
            if (r < I_GLU) { transpose_item(args.in[11], 512, 512, 512 / 64, WGLU, scr, r, F.lane, RowId()); continue; } r -= I_GLU;
            if (r < I_OUT) { transpose_item(args.in[17], D, D, D / 64, WOUT, scr, r, F.lane, RowId()); continue; } r -= I_OUT;
            if (r < NE * I_UP) { const int e = r / I_UP; transpose_item(args.in[21] + (size_t)e * D * 2 * FF, 2 * FF, D, 2 * FF / 64, WUP + (size_t)e * 2 * FF * D, scr, r % I_UP, F.lane, RowUp()); continue; } r -= NE * I_UP;
            { const int e = r / I_DN; transpose_item(args.in[23] + (size_t)e * FF * D, D, FF, D / 64, WDN + (size_t)e * D * FF, scr, r % I_DN, F.lane, RowId()); }
        }
        {
            const float* g = args.in[1]; const float* w_in = args.in[2]; const float* b_gates = args.in[15];
            float wg[16][8]; f32x4 gg[4];
#pragma unroll
            for (int jq = 0; jq < 4; ++jq) { gg[jq] = *(const f32x4*)(g + 4 * F.lane + 256 * jq);
#pragma unroll
                for (int i = 0; i < 4; ++i) { const int k = 4 * F.lane + 256 * jq + i; const f32x4 w0 = *(const f32x4*)(w_in + (size_t)k * DIN + O_G), w1 = *(const f32x4*)(w_in + (size_t)k * DIN + O_G + 4);
                    wg[4 * jq + i][0] = w0.x; wg[4 * jq + i][1] = w0.y; wg[4 * jq + i][2] = w0.z; wg[4 * jq + i][3] = w0.w; wg[4 * jq + i][4] = w1.x; wg[4 * jq + i][5] = w1.y; wg[4 * jq + i][6] = w1.z; wg[4 * jq + i][7] = w1.w; } }
            float bgv[8];
#pragma unroll
            for (int q = 0; q < 8; ++q) bgv[q] = b_gates[q];
            f32x4 nx[4];
            if (gw < T) {
#pragma unroll
                for (int jq = 0; jq < 4; ++jq) nx[jq] = *(const f32x4*)(x + (size_t)gw * D + 4 * F.lane + 256 * jq); }
            for (int row = gw; row < T && !(args.pad & 2); row += NGW) {
                f32x4 v[4];
#pragma unroll
                for (int jq = 0; jq < 4; ++jq) v[jq] = nx[jq];
                if (row + NGW < T) {
#pragma unroll
                    for (int jq = 0; jq < 4; ++jq) nx[jq] = *(const f32x4*)(x + (size_t)(row + NGW) * D + 4 * F.lane + 256 * jq); }
                float ss = 0.f;
#pragma unroll
                for (int jq = 0; jq < 4; ++jq) ss += v[jq].x * v[jq].x + v[jq].y * v[jq].y + v[jq].z * v[jq].z + v[jq].w * v[jq].w;
                ss = wave_sum(ss);
                const float rstd = rsqrtf(ss * (1.f / D) + 1e-5f);
                float ga[8] = {0, 0, 0, 0, 0, 0, 0, 0};
#pragma unroll
                for (int jq = 0; jq < 4; ++jq) {
                    v[jq] = v[jq] * rstd * gg[jq];
#pragma unroll
                    for (int i = 0; i < 4; ++i)
#pragma unroll
                        for (int q = 0; q < 8; ++q) ga[q] += v[jq][i] * wg[4 * jq + i][q];
                    uint2 o; o.x = pk2(v[jq].x, v[jq].y); o.y = pk2(v[jq].z, v[jq].w);
                    *(uint2*)(HN + (size_t)row * D + 4 * F.lane + 256 * jq) = o;
                }
#pragma unroll
                for (int q = 0; q < 8; ++q) ga[q] = wave_sum(ga[q]);
                if (F.lane == 0) { *(f32x4*)(gates + (size_t)row * 8) = (f32x4){ga[0] + bgv[0], ga[1] + bgv[1], ga[2] + bgv[2], ga[3] + bgv[3]}; *(f32x4*)(gates + (size_t)row * 8 + 4) = (f32x4){ga[4] + bgv[4], ga[5] + bgv[5], ga[6] + bgv[6], ga[7] + bgv[7]}; }
            }
        }
        __syncthreads();
        for (int un = F.vcu; un < 256 && !(args.pad & 4); un += F.G) {
            const int g = un >> 3, j = un & 7;
            LAS float* Ere = (LAS float*)F.lds; LAS float* Eim = Ere + 8 * 64;
            LAS float* Bbr = Eim + 8 * 64; LAS float* Bbi = Bbr + 1024;
            LAS float* Cr = Bbi + 1024; LAS float* Ci = Cr + 1024;
            const float dt = __expf(args.in[3][g]);
            if (F.tid < 64) { const int n = F.tid;
                const float are = fminf(args.in[4][g * 64 + n], -1e-4f), aim = args.in[5][g * 64 + n];
                const float mag = expf(dt * are); float sn, cs; sincosf(dt * aim, &sn, &cs);
                const float nr = mag * cs - 1.f, ni = mag * sn, dn = are * are + aim * aim;
                const float cfr = (nr * are + ni * aim) / dn, cfi = (ni * are - nr * aim) / dn;
                for (int q = 0; q < 16; ++q) { const float br = args.in[6][(g * 64 + n) * 16 + q], bi = args.in[7][(g * 64 + n) * 16 + q]; Bbr[n * 16 + q] = cfr * br - cfi * bi; Bbi[n * 16 + q] = cfr * bi + cfi * br; }
            }
            for (int i = F.tid; i < 1024; i += NTHR) { Cr[i] = args.in[8][g * 1024 + i]; Ci[i] = args.in[9][g * 1024 + i]; }
            { const int tl = F.tid >> 6, n = F.tid & 63; const float tau = (float)(8 * j + tl);
                const float are = fminf(args.in[4][g * 64 + n], -1e-4f), aim = args.in[5][g * 64 + n];
                const float mag = expf(tau * dt * are); float sn, cs; sincosf(tau * dt * aim, &sn, &cs); Ere[F.tid] = mag * cs; Eim[F.tid] = mag * sn; }
            __syncthreads();
            {
                const int tl = F.tid >> 6, p = (F.tid >> 2) & 15, q0 = (F.tid & 3) * 4;
                float a0 = 0.f, a1 = 0.f, a2 = 0.f, a3 = 0.f;
                for (int n = 0; n < 64; ++n) { const float cr = Cr[p * 64 + n], ci = Ci[p * 64 + n], er = Ere[tl * 64 + n], ei = Eim[tl * 64 + n];
                    const float xr = cr * er - ci * ei, xi = cr * ei + ci * er;
                    const f32x4 br = *(const LAS f32x4*)(Bbr + n * 16 + q0), bi = *(const LAS f32x4*)(Bbi + n * 16 + q0);
                    a0 += xr * br.x - xi * bi.x; a1 += xr * br.y - xi * bi.y; a2 += xr * br.z - xi * bi.z; a3 += xr * br.w - xi * bi.w; }
                *(f32x4*)(KTAB + ((size_t)g * 64 + 8 * j + tl) * 256 + p * 16 + q0) = (f32x4){a0, a1, a2, a3};
            }
            const float dtg = dt;
            for (int ch = F.tid; ch < 32 * 128; ch += NTHR) {
                const int rl = ch >> 7, c8 = ch & 127, r = 32 * j + rl, n = r & 63, im = (r >> 6) & 1, col = c8 * 8, sidx = col >> 4, q0 = col & 15;
                const float are = fminf(args.in[4][g * 64 + n], -1e-4f), aim = args.in[5][g * 64 + n]; const float tau = (float)(63 - sidx);
                const float mag = expf(tau * dtg * are); float sn, cs; sincosf(tau * dtg * aim, &sn, &cs); const float er = mag * cs, ei = mag * sn;
                float v[8];
#pragma unroll
                for (int i = 0; i < 8; ++i) { const float br = Bbr[n * 16 + q0 + i], bi = Bbi[n * 16 + q0 + i]; v[i] = im ? (er * bi + ei * br) : (er * br - ei * bi); }
                u32x4 o; o.x = pk2(v[0], v[1]); o.y = pk2(v[2], v[3]); o.z = pk2(v[4], v[5]); o.w = pk2(v[6], v[7]);
                *(u32x4*)(S5BQ + ((size_t)g * 256 + r) * 1024 + col) = o;
            }
            __syncthreads();
        }
        if (BOTH(0)) GRID_BAR();
    }
    if (IN(1)) {
        pg::DenseSched S{(const char*)HN, (const char*)WIN, D * 2, D * 2, T / 256, NPROJ / 256, F.G, (int)blockIdx.x};
        pg::EpiProj E{PROJ, S5A};
        pg::gemm_phase<pg::EpiProj, pg::DenseSched, true>(F.lds, D, S, E);
        if (BOTH(1)) GRID_BAR();
    }
    if (IN(2)) {
        pg::S5Sched S{(const char*)S5A, (const char*)S5BQ, S5K * 2, 1024 * 2, 256, 1, F.G, F.vcu};
        pg::EpiXloc E{XLOC};
        pg::gemm_phase<pg::EpiXloc, pg::S5Sched, true>(F.lds, 1024, S, E);
        {
            const int first = F.G > 64 ? F.vcu - 64 : F.vcu, stride = F.G > 64 ? F.G - 64 : F.G;
            LAS float* Kt = (LAS float*)F.lds;
            LAS float* Ere = Kt + 64 * 256; LAS float* Eim = Ere + 8 * 64;
            LAS float* Cr = Eim + 8 * 64; LAS float* Ci = Cr + 1024;
            for (int un = first; un >= 0 && un < 256; un += stride) {
                const int g = un >> 3, j = un & 7, ntau = 8 * j + 8;
                __syncthreads();
                for (int i = F.tid; i < ntau * 64; i += NTHR) *(LAS f32x4*)(Kt + 4 * i) = *(const f32x4*)(KTAB + (size_t)g * 64 * 256 + 4 * i);
                for (int i = F.tid; i < 1024; i += NTHR) { Cr[i] = args.in[8][g * 1024 + i]; Ci[i] = args.in[9][g * 1024 + i]; }
                { const int tl = F.tid >> 6, n = F.tid & 63; const float tau = (float)(8 * j + tl + 1); const float dt = __expf(args.in[3][g]);
                    const float are = fminf(args.in[4][g * 64 + n], -1e-4f), aim = args.in[5][g * 64 + n];
                    const float mag = expf(tau * dt * are); float sn, cs; sincosf(tau * dt * aim, &sn, &cs); Ere[F.tid] = mag * cs; Eim[F.tid] = mag * sn; }
                __syncthreads();
                for (int ch = F.tid; ch < 128 * 144; ch += NTHR) {
                    const int rl = ch / 144, c8 = ch % 144, tl = rl >> 4, t = 8 * j + tl, p = rl & 15, col = c8 * 8;
                    float v[8];
                    if (col < 1024) { const int sidx = col >> 4, q0 = col & 15;
                        if (sidx <= t) { const f32x4 k0 = *(const LAS f32x4*)(Kt + (t - sidx) * 256 + p * 16 + q0), k1 = *(const LAS f32x4*)(Kt + (t - sidx) * 256 + p * 16 + q0 + 4);
                            v[0] = k0.x; v[1] = k0.y; v[2] = k0.z; v[3] = k0.w; v[4] = k1.x; v[5] = k1.y; v[6] = k1.z; v[7] = k1.w; }
                        else {
#pragma unroll
                            for (int i = 0; i < 8; ++i) v[i] = 0.f; }
                    } else { const int jj = (col - 1024) & 63, im = (col - 1024) >> 6;
#pragma unroll
                        for (int i = 0; i < 8; ++i) { const int n = jj + i; const float cr = Cr[p * 64 + n], ci = Ci[p * 64 + n], er = Ere[tl * 64 + n], ei = Eim[tl * 64 + n];
                            v[i] = im ? -(cr * ei + ci * er) : (cr * er - ci * ei); } }
                    u32x4 o; o.x = pk2(v[0], v[1]); o.y = pk2(v[2], v[3]); o.z = pk2(v[4], v[5]); o.w = pk2(v[6], v[7]);
                    *(u32x4*)(S5BT + ((size_t)g * 1024 + 128 * j + rl) * S5K + col) = o;
                }
            }
            __syncthreads();
        }
    }
    if (IN(3)) {
        typedef short s16x4 __attribute__((ext_vector_type(4)));
        LAS float* wsl = (LAS float*)F.lds;
        LAS float* red = wsl + 512;
        LAS float* dnl = red + 32;
        LAS bf16* RQ = (LAS bf16*)(F.lds + 4096);
        LAS bf16* RK = RQ + 67 * 136;
        LAS bf16* RV = RK + 67 * 136;
        LAS bf16* KN = RV + 64 * 136;
        LAS bf16* KTl = KN + 64 * 136;
        LAS bf16* VTl = KTl + 128 * 72;
        const float* cw = args.in[13]; const float* cbias = args.in[14];
        for (int un = blockIdx.x; un < 256; un += F.G) {
            const int bh = un >> 4, seg = un & 15, b = bh >> 2, hd = bh & 3, t0 = seg * 512; const size_t row0 = (size_t)b * SEQ + t0;
            float Fl, Aval;
            {
                const float ipre = gates[(row0 + F.tid) * 8 + hd], fpre = gates[(row0 + F.tid) * 8 + 4 + hd];
                const float lf = fminf(fpre, 0.f) - log1pf(__expf(-fabsf(fpre)));
                float sc = lf;
#pragma unroll
                for (int o = 1; o < 64; o <<= 1) { const float tv = __shfl_up(sc, o); if (F.lane >= o) sc += tv; }
                if (F.lane == 63) red[F.wave] = sc;
                __syncthreads();
                float base = 0.f;
                for (int w2 = 0; w2 < F.wave; ++w2) base += red[w2];
                Fl = sc + base; Aval = ipre - Fl;
                float mx = Aval;
#pragma unroll
                for (int o = 1; o < 64; o <<= 1) mx = fmaxf(mx, __shfl_xor(mx, o));
                if (F.lane == 0) red[8 + F.wave] = mx;
                __syncthreads();
                float Amax = red[8];
                for (int w2 = 1; w2 < 8; ++w2) Amax = fmaxf(Amax, red[8 + w2]);
                wsl[F.tid] = __expf(Aval - Amax);
                FLOC[(size_t)bh * SEQ + t0 + F.tid] = Fl;
                if (F.tid == 511) { SEGS[un * 4 + 0] = Fl; SEGS[un * 4 + 1] = Amax; }
                if (F.tid < 256) dnl[F.tid] = 0.f;
            }
            f32x16 dacc[2];
#pragma unroll
            for (int i = 0; i < 2; ++i)
#pragma unroll
                for (int q = 0; q < 16; ++q) dacc[i][q] = 0.f;
            const int cch = F.tid & 127, isk = (F.tid >> 7) & 1, thalf = F.tid >> 8;
            const int gch = isk * 512 + hd * 128 + cch;
            const float cw0 = cw[gch], cw1 = cw[1024 + gch], cw2 = cw[2048 + gch], cw3 = cw[3072 + gch], cb = cbias[gch];
            float dnacc = 0.f;
            for (int sb = 0; sb < 8; ++sb) {
                const int ts = t0 + sb * 64;
                __syncthreads();
                for (int ch = F.tid; ch < 2 * 67 * 16 + 64 * 16; ch += NTHR) {
                    if (ch < 2 * 67 * 16) { const int which = ch / (67 * 16), r = (ch % (67 * 16)) >> 4, c16 = ch & 15; const int tk = ts - 3 + r;
                        u32x4 v = (u32x4){0u, 0u, 0u, 0u};
                        if (tk >= 0) v = *(const u32x4*)(PROJ + ((size_t)b * SEQ + tk) * NPROJ + (which ? O_K : O_Q) + hd * 128 + c16 * 8);
                        *(LAS u32x4*)((which ? RK : RQ) + r * 136 + c16 * 8) = v;
                    } else { const int c2 = ch - 2 * 67 * 16, r = c2 >> 4, c16 = c2 & 15;
                        *(LAS u32x4*)(RV + r * 136 + c16 * 8) = *(const u32x4*)(PROJ + ((size_t)b * SEQ + ts + r) * NPROJ + O_V + hd * 128 + c16 * 8); }
                }
                __syncthreads();
                {
                    LAS bf16* raw = isk ? RK : RQ; const int s0 = thalf * 32;
                    float x3 = bf2f(raw[(s0 + 0) * 136 + cch]), x2 = bf2f(raw[(s0 + 1) * 136 + cch]), x1 = bf2f(raw[(s0 + 2) * 136 + cch]);
                    for (int sidx = s0; sidx < s0 + 32; ++sidx) {
                        const float xv = bf2f(raw[(sidx + 3) * 136 + cch]);
                        float val = cb + cw0 * x3 + cw1 * x2 + cw2 * x1 + cw3 * xv;
                        x3 = x2; x2 = x1; x1 = xv;
                        val = val * sigmoidf_(val);
                        if (isk) { val *= 0.08838834764831845f * wsl[sb * 64 + sidx]; dnacc += val; const bf16 kb = f2bf(val); KN[sidx * 136 + cch] = kb; KH[((size_t)bh * SEQ + ts + sidx) * 128 + cch] = kb; }
                        else QH[((size_t)bh * SEQ + ts + sidx) * 128 + cch] = f2bf(val);
                    }
                }
                __syncthreads();
                {
                    const int c = F.tid & 127, sq = F.tid >> 7;
#pragma unroll
                    for (int half = 0; half < 2; ++half) { const int sA = sq * 16 + half * 8;
                        u32x4 kk, vv;
                        kk.x = (unsigned)KN[(sA + 0) * 136 + c] | ((unsigned)KN[(sA + 1) * 136 + c] << 16); kk.y = (unsigned)KN[(sA + 2) * 136 + c] | ((unsigned)KN[(sA + 3) * 136 + c] << 16);
                        kk.z = (unsigned)KN[(sA + 4) * 136 + c] | ((unsigned)KN[(sA + 5) * 136 + c] << 16); kk.w = (unsigned)KN[(sA + 6) * 136 + c] | ((unsigned)KN[(sA + 7) * 136 + c] << 16);
                        vv.x = (unsigned)RV[(sA + 0) * 136 + c] | ((unsigned)RV[(sA + 1) * 136 + c] << 16); vv.y = (unsigned)RV[(sA + 2) * 136 + c] | ((unsigned)RV[(sA + 3) * 136 + c] << 16);
                        vv.z = (unsigned)RV[(sA + 4) * 136 + c] | ((unsigned)RV[(sA + 5) * 136 + c] << 16); vv.w = (unsigned)RV[(sA + 6) * 136 + c] | ((unsigned)RV[(sA + 7) * 136 + c] << 16);
                        *(LAS u32x4*)(KTl + c * 72 + sA) = kk; *(LAS u32x4*)(VTl + c * 72 + sA) = vv; }
                }
                __syncthreads();
                {
                    const int e = F.tid >> 2, part = F.tid & 3;
                    const u32x4 v0 = *(const LAS u32x4*)(VTl + e * 72 + part * 16), v1 = *(const LAS u32x4*)(VTl + e * 72 + part * 16 + 8);
                    bf16* dst = VT + ((size_t)bh * 128 + e) * SEQ + ts + part * 16;
                    *(u32x4*)dst = v0; *(u32x4*)(dst + 8) = v1;
                    const int eb = F.wave >> 1, db0 = (F.wave & 1) * 2, r = F.lane & 31, hh = F.lane >> 5;
#pragma unroll
                    for (int ks = 0; ks < 4; ++ks) {
                        const bf16x8 a = *(const LAS bf16x8*)(VTl + (eb * 32 + r) * 72 + ks * 16 + hh * 8);
                        const bf16x8 b0 = *(const LAS bf16x8*)(KTl + (db0 * 32 + r) * 72 + ks * 16 + hh * 8), b1 = *(const LAS bf16x8*)(KTl + ((db0 + 1) * 32 + r) * 72 + ks * 16 + hh * 8);
                        dacc[0] = __builtin_amdgcn_mfma_f32_32x32x16_bf16(a, b0, dacc[0], 0, 0, 0);
                        dacc[1] = __builtin_amdgcn_mfma_f32_32x32x16_bf16(a, b1, dacc[1], 0, 0, 0);
                    }
                }
            }
            if (isk) dnl[thalf * 128 + cch] = dnacc;
            {
                const int eb = F.wave >> 1, db0 = (F.wave & 1) * 2, r = F.lane & 31, hh = F.lane >> 5;
#pragma unroll
                for (int i = 0; i < 2; ++i)
#pragma unroll
                    for (int q = 0; q < 16; ++q) DC[((size_t)un * 128 + eb * 32 + (q & 3) + 8 * (q >> 2) + 4 * hh) * 128 + (db0 + i) * 32 + r] = dacc[i][q];
            }
            __syncthreads();
            if (F.tid < 128) DN[un * 128 + F.tid] = dnl[F.tid] + dnl[128 + F.tid];
            __syncthreads();
        }
        if (BOTH(3)) GRID_BAR();
    }
    if (IN(4)) {
        LAS float* agr = (LAS float*)F.lds; LAS float* agi = agr + 512;
        for (int un = blockIdx.x; un < 128; un += F.G) {
            const int b = un >> 5, g = un & 31, n = F.tid & 63, seg = F.tid >> 6;
            const float dt = __expf(args.in[3][g]);
            const float are = fminf(args.in[4][g * 64 + n], -1e-4f), aim = args.in[5][g * 64 + n];
            float ar, ai, Ar, Ai;
            { const float mag = expf(64.f * dt * are); float sn, cs; sincosf(64.f * dt * aim, &sn, &cs); ar = mag * cs; ai = mag * sn; }
            { const float mag = expf(1024.f * dt * are); float sn, cs; sincosf(1024.f * dt * aim, &sn, &cs); Ar = mag * cs; Ai = mag * sn; }
            const size_t row0 = (size_t)g * 512 + b * 128 + seg * 16;
            float xr[16], xi[16];
#pragma unroll
            for (int jj = 0; jj < 16; ++jj) { xr[jj] = XLOC[(row0 + jj) * 128 + n]; xi[jj] = XLOC[(row0 + jj) * 128 + 64 + n]; }
            float sr = 0.f, si = 0.f;
#pragma unroll
            for (int jj = 0; jj < 16; ++jj) { const float tr = ar * sr - ai * si + xr[jj], ti = ar * si + ai * sr + xi[jj]; sr = tr; si = ti; }
            agr[seg * 64 + n] = sr; agi[seg * 64 + n] = si;
            __syncthreads();
            float cr = 0.f, ci = 0.f;
            for (int s2 = 0; s2 < seg; ++s2) { const float tr = Ar * cr - Ai * ci + agr[s2 * 64 + n], ti = Ar * ci + Ai * cr + agi[s2 * 64 + n]; cr = tr; ci = ti; }
#pragma unroll
            for (int jj = 0; jj < 16; ++jj) {
                S5A[(row0 + jj) * S5K + 1024 + n] = f2bf(cr); S5A[(row0 + jj) * S5K + 1088 + n] = f2bf(ci);
                const float tr = ar * cr - ai * ci + xr[jj], ti = ar * ci + ai * cr + xi[jj]; cr = tr; ci = ti; }
            __syncthreads();
        }
        for (int un = blockIdx.x; un < 256; un += F.G) {
            const int bh = un >> 4, slice = un & 15;
            float dc0[16], dc1[16];
#pragma unroll
            for (int j = 0; j < 16; ++j) { dc0[j] = DC[((size_t)(bh * 16 + j)) * 16384 + slice * 1024 + F.tid]; dc1[j] = DC[((size_t)(bh * 16 + j)) * 16384 + slice * 1024 + 512 + F.tid]; }
            float dn[16];
            const bool nrole = (slice == 0 && F.tid < 128);
#pragma unroll
            for (int j = 0; j < 16; ++j) dn[j] = nrole ? DN[(bh * 16 + j) * 128 + F.tid] : 0.f;
            float m = 0.f, C0 = 0.f, C1 = 0.f, nn = 0.f;
#pragma unroll
            for (int j = 0; j < 16; ++j) {
                const float Fend = SEGS[(bh * 16 + j) * 4 + 0], Amax = SEGS[(bh * 16 + j) * 4 + 1];
                const float R = fmaxf(m, Amax), c1 = __expf(m - R), c2 = __expf(Amax - R);
                CST[((size_t)(bh * 16 + j)) * 16384 + slice * 1024 + F.tid] = f2bf(c1 * C0); CST[((size_t)(bh * 16 + j)) * 16384 + slice * 1024 + 512 + F.tid] = f2bf(c1 * C1);
                if (nrole) NST[(bh * 16 + j) * 128 + F.tid] = c1 * nn;
                if (slice == 0 && F.tid == 0) { SEGS[(bh * 16 + j) * 4 + 2] = R; SEGS[(bh * 16 + j) * 4 + 3] = c2; }
                C0 = c1 * C0 + c2 * dc0[j]; C1 = c1 * C1 + c2 * dc1[j]; nn = c1 * nn + c2 * dn[j]; m = Fend + R;
            }
        }
        if (BOTH(4)) GRID_BAR();
    }
    if (IN(5)) {
        pg::S5Sched S{(const char*)S5A, (const char*)S5BT, S5K * 2, S5K * 2, 1024, 4, F.G, F.vcu};
        pg::EpiS5Y E{S5A, args.in[10], GY};
        pg::gemm_phase<pg::EpiS5Y, pg::S5Sched, true>(F.lds, S5K, S, E);
        if (BOTH(5)) GRID_BAR();
    }
    if (IN(6)) {
        typedef short s16x4 __attribute__((ext_vector_type(4)));
        LAS bf16* Kl = (LAS bf16*)F.lds;
        LAS bf16* Vl = Kl + 2 * 64 * 136;
        LAS bf16* Cl = Vl + 2 * 128 * 72;
        LAS float* nl = (LAS float*)(Cl + 128 * 136);
        LAS float* fll = nl + 128;
        LAS float* gl = fll + 512;
        const float* ng = args.in[16];
        for (int un = blockIdx.x; un < 256; un += F.G) {
            int tid6 = F.tid; asm volatile("" : "+v"(tid6));
            const int lane6 = tid6 & 63;
            const int bh = un >> 4, seg = un & 15, b = bh >> 2, hd = bh & 3, t0 = seg * 512;
            const float R = SEGS[un * 4 + 2], c2 = SEGS[un * 4 + 3];
            __syncthreads();
            for (int ch = tid6; ch < 2048; ch += NTHR) { const int r = ch >> 4, c16 = ch & 15; *(LAS u32x4*)(Cl + r * 136 + c16 * 8) = *(const u32x4*)(CST + (size_t)un * 16384 + r * 128 + c16 * 8); }
            if (tid6 < 128) { nl[tid6] = NST[un * 128 + tid6]; gl[tid6] = ng[hd * 128 + tid6]; }
            fll[tid6] = FLOC[(size_t)bh * SEQ + t0 + tid6];
            const int r = lane6 & 31, hh = lane6 >> 5;
            for (int pass = 0; pass < 2; ++pass) {
                const int qb = pass == 0 ? F.wave : 15 - F.wave, jmax = qb >> 1, npj = pass == 0 ? 4 : 8;
                bf16x8 Q[8];
                { const bf16* qp = QH + ((size_t)bh * SEQ + t0 + qb * 32 + r) * 128 + hh * 8;
#pragma unroll
                  for (int ks = 0; ks < 8; ++ks) Q[ks] = *(const bf16x8*)(qp + ks * 16); }
                u32x4 pk0, pk1, pv0, pv1;
                { const int kr = tid6 >> 4, kc = tid6 & 15; const bf16* kp = KH + ((size_t)bh * SEQ + t0) * 128; pk0 = *(const u32x4*)(kp + kr * 128 + kc * 8); pk1 = *(const u32x4*)(kp + (kr + 32) * 128 + kc * 8);
                  const int vr = tid6 >> 3, vc = tid6 & 7; const bf16* vp = VT + (size_t)bh * 128 * SEQ + t0; pv0 = *(const u32x4*)(vp + (size_t)vr * SEQ + vc * 8); pv1 = *(const u32x4*)(vp + (size_t)(vr + 64) * SEQ + vc * 8); }
                f32x16 acc[4];
#pragma unroll
                for (int eb = 0; eb < 4; ++eb)
#pragma unroll
                    for (int q = 0; q < 16; ++q) acc[eb][q] = 0.f;
                __syncthreads();
#pragma unroll
                for (int eb = 0; eb < 4; ++eb) {
#pragma unroll
                    for (int ks = 0; ks < 8; ++ks) { const bf16x8 a = *(const LAS bf16x8*)(Cl + (eb * 32 + r) * 136 + ks * 16 + hh * 8); acc[eb] = __builtin_amdgcn_mfma_f32_32x32x16_bf16(a, Q[ks], acc[eb], 0, 0, 0); }
                    __builtin_amdgcn_sched_barrier(0);
                }
                float den = 0.f;
#pragma unroll
                for (int ks = 0; ks < 8; ++ks) {
#pragma unroll
                    for (int jj = 0; jj < 8; ++jj) den += nl[ks * 16 + hh * 8 + jj] * bf2f((bf16)Q[ks][jj]);
                    __builtin_amdgcn_sched_barrier(0);
                }
                float dsum = 0.f;
                for (int j = 0; j < npj; ++j) {
                    LAS bf16* Kb = Kl + (j & 1) * 64 * 136; LAS bf16* Vb = Vl + (j & 1) * 128 * 72;
                    { const int kr = tid6 >> 4, kc = tid6 & 15; *(LAS u32x4*)(Kb + kr * 136 + kc * 8) = pk0; *(LAS u32x4*)(Kb + (kr + 32) * 136 + kc * 8) = pk1;
                      const int vr = tid6 >> 3, vc = tid6 & 7; *(LAS u32x4*)(Vb + vr * 72 + vc * 8) = pv0; *(LAS u32x4*)(Vb + (vr + 64) * 72 + vc * 8) = pv1; }
                    if (j + 1 < npj) { const int kr = tid6 >> 4, kc = tid6 & 15; const bf16* kp = KH + ((size_t)bh * SEQ + t0 + (j + 1) * 64) * 128; pk0 = *(const u32x4*)(kp + kr * 128 + kc * 8); pk1 = *(const u32x4*)(kp + (kr + 32) * 128 + kc * 8);
                        const int vr = tid6 >> 3, vc = tid6 & 7; const bf16* vp = VT + (size_t)bh * 128 * SEQ + t0 + (j + 1) * 64; pv0 = *(const u32x4*)(vp + (size_t)vr * SEQ + vc * 8); pv1 = *(const u32x4*)(vp + (size_t)(vr + 64) * SEQ + vc * 8); }
                    __syncthreads();
                    if (j <= jmax) {
                        const bool diag = (j == jmax); const int tq = qb * 32 + r;
#pragma unroll
                        for (int sb = 0; sb < 2; ++sb) {
                            f32x16 st;
#pragma unroll
                            for (int q = 0; q < 16; ++q) st[q] = 0.f;
#pragma unroll
                            for (int ks = 0; ks < 8; ++ks) { const bf16x8 a = *(const LAS bf16x8*)(Kb + (sb * 32 + r) * 136 + ks * 16 + hh * 8); st = __builtin_amdgcn_mfma_f32_32x32x16_bf16(a, Q[ks], st, 0, 0, 0); }
                            bf16x8 pb[2];
#pragma unroll
                            for (int sp = 0; sp < 2; ++sp) {
                                float pv[8];
#pragma unroll
                                for (int jj = 0; jj < 8; ++jj) { const int q = 8 * sp + jj; const int sidx = j * 64 + sb * 32 + (q & 3) + 8 * (q >> 2) + 4 * hh;
                                    float p = st[q] * c2; if (diag && sidx > tq) p = 0.f; pv[jj] = p; dsum += p; }
                                u32x4 w; w.x = cvt_pk_bf16(pv[0], pv[1]); w.y = cvt_pk_bf16(pv[2], pv[3]); w.z = cvt_pk_bf16(pv[4], pv[5]); w.w = cvt_pk_bf16(pv[6], pv[7]);
                                pb[sp] = __builtin_bit_cast(bf16x8, w);
                            }
#pragma unroll
                            for (int eb = 0; eb < 4; ++eb)
#pragma unroll
                                for (int sp = 0; sp < 2; ++sp) {
                                    const int so = sb * 32 + 16 * sp + 4 * hh;
                                    const s16x4 lo = *(const LAS s16x4*)(Vb + (eb * 32 + r) * 72 + so), hi = *(const LAS s16x4*)(Vb + (eb * 32 + r) * 72 + so + 8);
                                    const bf16x8 a = __builtin_shufflevector(lo, hi, 0, 1, 2, 3, 4, 5, 6, 7);
                                    acc[eb] = __builtin_amdgcn_mfma_f32_32x32x16_bf16(a, pb[sp], acc[eb], 0, 0, 0);
                                }
                            __builtin_amdgcn_sched_barrier(0);
                        }
                    }
                }
                den += dsum; den += __shfl_xor(den, 32);
                const float flo = __expf(-fll[qb * 32 + r] - R);
                const float inv = 1.f / fmaxf(fabsf(den), flo);
                float s1 = 0.f;
#pragma unroll
                for (int eb = 0; eb < 4; ++eb)
#pragma unroll
                    for (int q = 0; q < 16; ++q) { acc[eb][q] *= inv; s1 += acc[eb][q]; }
                s1 += __shfl_xor(s1, 32);
                const float mu = s1 * (1.f / 128.f);
                float s2 = 0.f;
#pragma unroll
                for (int eb = 0; eb < 4; ++eb)
#pragma unroll
                    for (int q = 0; q < 16; ++q) { const float dlt = acc[eb][q] - mu; s2 += dlt * dlt; }
                s2 += __shfl_xor(s2, 32);
                const float rstd = rsqrtf(s2 * (1.f / 128.f) + 1e-6f);
                const size_t row = (size_t)b * SEQ + t0 + qb * 32 + r;
#pragma unroll
                for (int eb = 0; eb < 4; ++eb)
#pragma unroll
                    for (int g4 = 0; g4 < 4; ++g4) {
                        const int e0 = eb * 32 + 8 * g4 + 4 * hh;
                        const uint2 ov = *(const uint2*)(PROJ + row * NPROJ + O_O + hd * 128 + e0);
                        const float o0 = (acc[eb][4 * g4 + 0] - mu) * rstd * gl[e0 + 0] * sigmoidf_(lo_bf(ov.x)), o1 = (acc[eb][4 * g4 + 1] - mu) * rstd * gl[e0 + 1] * sigmoidf_(hi_bf(ov.x));
                        const float o2 = (acc[eb][4 * g4 + 2] - mu) * rstd * gl[e0 + 2] * sigmoidf_(lo_bf(ov.y)), o3 = (acc[eb][4 * g4 + 3] - mu) * rstd * gl[e0 + 3] * sigmoidf_(hi_bf(ov.y));
                        uint2 w; w.x = cvt_pk_bf16(o0, o1); w.y = cvt_pk_bf16(o2, o3);
                        *(uint2*)(MIX + row * D + 512 + hd * 128 + e0) = w;
                        __builtin_amdgcn_sched_barrier(0);
                    }
            }
        }
    }
    if (IN(7)) {
        pg::DenseSched S{(const char*)GY, (const char*)WGLU, 512 * 2, 512 * 2, T / 256, 2, F.G, (int)blockIdx.x};
        pg::EpiGlu E{GY, args.in[12], MIX};
        pg::gemm_phase<pg::EpiGlu, pg::DenseSched, true>(F.lds, 512, S, E);
        if (BOTH(7)) GRID_BAR();
    }
    if (IN(8)) {
        pg::DenseSched S{(const char*)MIX, (const char*)WOUT, D * 2, D * 2, T / 256, D / 256, F.G, (int)blockIdx.x};
        pg::EpiOut E{x, H};
        pg::gemm_phase<pg::EpiOut, pg::DenseSched, true>(F.lds, D, S, E);
        if (BOTH(8)) GRID_BAR();
    }
    if (IN(9)) {
        const float* gf = args.in[18]; const float* w_r = args.in[19]; const float* b_r = args.in[20];
        LAS float* rs = (LAS float*)(F.lds);
        LAS float* part = (LAS float*)(F.lds + 1024);
        LAS int* hist = (LAS int*)(F.lds + 1024 + 2 * 128 * 33 * 4);
        for (int tb = blockIdx.x; tb < T / 128; tb += F.G) {
            const int row0 = tb * 128;
            if (F.tid < 32) hist[F.tid] = 0;
            for (int rr = 0; rr < 16; ++rr) {
                const int r = F.wave * 16 + rr; const float* hr = H + (size_t)(row0 + r) * D;
                f32x4 v[4]; float ss = 0.f;
#pragma unroll
                for (int j = 0; j < 4; ++j) { v[j] = *(const f32x4*)(hr + 4 * F.lane + 256 * j); ss += v[j].x * v[j].x + v[j].y * v[j].y + v[j].z * v[j].z + v[j].w * v[j].w; }
                ss = wave_sum(ss);
                const float rstd = rsqrtf(ss * (1.f / D) + 1e-5f);
                if (F.lane == 0) rs[r] = rstd;
#pragma unroll
                for (int j = 0; j < 4; ++j) { const f32x4 gg = *(const f32x4*)(gf + 4 * F.lane + 256 * j);
                    uint2 o; o.x = pk2(v[j].x * rstd * gg.x, v[j].y * rstd * gg.y); o.y = pk2(v[j].z * rstd * gg.z, v[j].w * rstd * gg.w);
                    *(uint2*)(HN + (size_t)(row0 + r) * D + 4 * F.lane + 256 * j) = o; }
            }
            {
                const int rg = F.wave & 3, kh = F.wave >> 2, i = F.lane & 31, hh = F.lane >> 5;
                f32x16 acc;
#pragma unroll
                for (int q = 0; q < 16; ++q) acc[q] = 0.f;
                const float* hp = H + (size_t)(row0 + rg * 32 + i) * D + kh * 512 + 4 * hh;
                for (int k0 = 0; k0 < 512; k0 += 8) {
                    const f32x4 a4 = *(const f32x4*)(hp + k0);
                    const int kb = kh * 512 + k0 + 4 * hh;
                    const f32x4 g4 = *(const f32x4*)(gf + kb);
                    const float b0 = w_r[(size_t)(kb + 0) * NE + i] * g4.x, b1 = w_r[(size_t)(kb + 1) * NE + i] * g4.y, b2 = w_r[(size_t)(kb + 2) * NE + i] * g4.z, b3 = w_r[(size_t)(kb + 3) * NE + i] * g4.w;
                    acc = __builtin_amdgcn_mfma_f32_32x32x2f32(a4.x, b0, acc, 0, 0, 0);
                    acc = __builtin_amdgcn_mfma_f32_32x32x2f32(a4.y, b1, acc, 0, 0, 0);
                    acc = __builtin_amdgcn_mfma_f32_32x32x2f32(a4.z, b2, acc, 0, 0, 0);
                    acc = __builtin_amdgcn_mfma_f32_32x32x2f32(a4.w, b3, acc, 0, 0, 0);
                }
#pragma unroll
                for (int q = 0; q < 16; ++q) { const int r = rg * 32 + (q & 3) + 8 * (q >> 2) + 4 * hh; part[(kh * 128 + r) * 33 + i] = acc[q]; }
            }
            __syncthreads();
            if (F.tid < 128) {
                const int r = F.tid; const float rstd = rs[r];
                float best[4]; int bi[4];
                for (int e = 0; e < 32; ++e) part[r * 33 + e] = (part[r * 33 + e] + part[(128 + r) * 33 + e]) * rstd + b_r[e];
#pragma unroll
                for (int k = 0; k < 4; ++k) {
                    float bv = -INFINITY; int be = 0;
                    for (int e = 0; e < 32; ++e) { const float l = part[r * 33 + e]; if (l > bv) { bv = l; be = e; } }
                    best[k] = bv; bi[k] = be; part[r * 33 + be] = -INFINITY;
                }
                const float e1 = __expf(best[1] - best[0]), e2 = __expf(best[2] - best[0]), e3 = __expf(best[3] - best[0]);
                const float inv = 1.f / (1.f + e1 + e2 + e3);
                *(int4*)(topi + (size_t)(row0 + r) * 4) = make_int4(bi[0], bi[1], bi[2], bi[3]);
                *(f32x4*)(topg + (size_t)(row0 + r) * 4) = (f32x4){inv, e1 * inv, e2 * inv, e3 * inv};
#pragma unroll
                for (int k = 0; k < 4; ++k) __hip_atomic_fetch_add(&hist[bi[k]], 1, __ATOMIC_RELAXED, __HIP_MEMORY_SCOPE_WORKGROUP);
            }
            __syncthreads();
            if (F.tid < 32) CNT[tb * 32 + F.tid] = hist[F.tid];
            __syncthreads();
        }
        if (BOTH(9)) GRID_BAR();
    }
    if (IN(10)) {
        LAS int* sb = (LAS int*)(F.lds);
        for (int tb = blockIdx.x; tb < T / 128; tb += F.G) {
            const int e = F.tid & 31, pt = F.tid >> 5;
            int sbef = 0, stot = 0;
            for (int w = pt * 16; w < pt * 16 + 16; ++w) { const int c = __hip_atomic_load(CNT + w * 32 + e, RLX_AGENT); stot += c; if (w < tb) sbef += c; }
            sb[pt * 32 + e] = sbef; sb[512 + pt * 32 + e] = stot;
            __syncthreads();
            if (F.tid < 32) { int b = 0, t = 0; for (int p = 0; p < 16; ++p) { b += sb[p * 32 + F.tid]; t += sb[512 + p * 32 + F.tid]; } sb[1024 + F.tid] = b; sb[1056 + F.tid] = t; sb[1120 + F.tid] = 0; }
            __syncthreads();
            if (F.tid == 0) { int ps = 0; for (int q = 0; q < 32; ++q) { sb[1088 + q] = ps; ps += ((sb[1056 + q] + MT - 1) / MT) * MT; } }
            __syncthreads();
            if (tb == 0 && F.tid < 32) ecnt[F.tid] = sb[1056 + F.tid];
            {
                const int a = tb * 512 + F.tid; const int ex = topi[a];
                const int lp = __hip_atomic_fetch_add(&sb[1120 + ex], 1, __ATOMIC_RELAXED, __HIP_MEMORY_SCOPE_WORKGROUP);
                const int slot = sb[1088 + ex] + sb[1024 + ex] + lp;
                slot_tok[slot] = a >> 2; tok_slot[a] = slot;
            }
            __syncthreads();
        }
        if (BOTH(10)) GRID_BAR();
    }
    if (IN(11) || IN(12)) {
        LAS int* til = (LAS int*)(F.lds + TIL_OFF);
        if (F.tid == 0) { int nt = 0; for (int e = 0; e < NE; ++e) { const int c = __hip_atomic_load(ecnt + e, RLX_AGENT); for (int r = 0; r < c; r += MT) { til[nt] = e; til[MAXTILES + nt] = (c - r) < MT ? (c - r) : MT; ++nt; } } til[2 * MAXTILES] = nt; }
        __syncthreads();
        if (IN(11)) {
            MoeSched S{(const char*)HN, (const char*)WUP, slot_tok, til, (LAS int*)(F.lds + IDX_OFF), D * 2, D * 2, 8, 2 * FF, F.G, (int)blockIdx.x, 1};
            pg::EpiUp E{args.in[22], ACT};
            pg::gemm_phase<pg::EpiUp, MoeSched, true>(F.lds, D, S, E);
            if (BOTH(11)) GRID_BAR();
        }
        if (IN(12)) {
            MoeSched S{(const char*)ACT, (const char*)WDN, slot_tok, til, (LAS int*)(F.lds + IDX_OFF), FF * 2, FF * 2, 4, D, F.G, (int)blockIdx.x, 0};
            pg::EpiDown E{args.in[24], YS};
            pg::gemm_phase<pg::EpiDown, MoeSched, true>(F.lds, FF, S, E);
            if (BOTH(12)) GRID_BAR();
        }
    }
    if (IN(13)) {
        const float* gfin = args.in[25]; float* out = args.out;
        for (int row = gw; row < T; row += NGW) {
            f32x4 v[4];
#pragma unroll
            for (int j = 0; j < 4; ++j) v[j] = *(const f32x4*)(H + (size_t)row * D + 4 * F.lane + 256 * j);
            const int4 sl = *(const int4*)(tok_slot + (size_t)row * 4); const f32x4 gt = *(const f32x4*)(topg + (size_t)row * 4);
#pragma unroll
            for (int k = 0; k < 4; ++k) {
                const int s = k == 0 ? sl.x : k == 1 ? sl.y : k == 2 ? sl.z : sl.w;
#pragma unroll
                for (int j = 0; j < 4; ++j) { const uint2 y = *(const uint2*)(YS + (size_t)s * D + 4 * F.lane + 256 * j);
                    v[j].x += gt[k] * lo_bf(y.x); v[j].y += gt[k] * hi_bf(y.x); v[j].z += gt[k] * lo_bf(y.y); v[j].w += gt[k] * hi_bf(y.y); }
            }
            float ss = 0.f;
#pragma unroll
            for (int j = 0; j < 4; ++j) ss += v[j].x * v[j].x + v[j].y * v[j].y + v[j].z * v[j].z + v[j].w * v[j].w;
            ss = wave_sum(ss);
            const float rstd = rsqrtf(ss * (1.f / D) + 1e-5f);
#pragma unroll
            for (int j = 0; j < 4; ++j) { const f32x4 gg = *(const f32x4*)(gfin + 4 * F.lane + 256 * j); *(f32x4*)(out + (size_t)row * D + 4 * F.lane + 256 * j) = v[j] * rstd * gg; }
        }
    }
#undef IN
#undef BOTH
}

extern "C" void kernel_launch(void* const* d_in, const int* in_sizes, int n_in, void* d_out, int out_size, void* d_ws, size_t ws_size, hipStream_t stream) {
    static int grid = 0;
    if (grid == 0) {
        int dev = 0, cus = 0, per_cu = 0;
        if (n_in != 26 || ws_size < WS_END) { fprintf(stderr, "kernel_launch: unexpected n_in %d / ws %zu\n", n_in, ws_size); grid = -1; return; }
        if (hipGetDevice(&dev) != hipSuccess || hipDeviceGetAttribute(&cus, hipDeviceAttributeMultiprocessorCount, dev) != hipSuccess) { grid = -1; return; }
        if (hipFuncSetAttribute((const void*)fwd, hipFuncAttributeMaxDynamicSharedMemorySize, LDS_BYTES) != hipSuccess) { fprintf(stderr, "kernel_launch: hipFuncSetAttribute failed\n"); grid = -1; return; }
        if (hipOccupancyMaxActiveBlocksPerMultiprocessor(&per_cu, (const void*)fwd, NTHR, LDS_BYTES) != hipSuccess || per_cu < 1) fprintf(stderr, "kernel_launch: occupancy query reports %d\n", per_cu);
        (void)hipGetLastError();
        grid = cus;
    }
    if (grid < 0) return;
    (void)in_sizes; (void)out_size;
    unsigned char* ws = (unsigned char*)d_ws;
    (void)hipMemsetAsync(ws + WS_CTL, 0, CTL_ZERO_BYTES, stream);
    Args a{};
    for (int i = 0; i < 26; ++i) a.in[i] = (const float*)d_in[i];
    a.out = (float*)d_out; a.ws = ws;
    a.ph_lo = 0; a.ph_hi = 14; a.li = 0; a.pad = 0;
    hipLaunchKernelGGL(fwd, dim3(grid), dim3(NTHR), LDS_BYTES, stream, a);
#if PROBE_LO >= 0
    a.ph_lo = PROBE_LO; a.ph_hi = PROBE_HI; a.li = 1; a.pad = PROBE_PAD;
    hipLaunchKernelGGL(fwd, dim3(grid), dim3(NTHR), LDS_BYTES, stream, a);
#endif
}
```

```cpp
#include <hip/hip_runtime.h>
#include <cstdio>
#include <cstdint>

#define GAS __attribute__((address_space(1)))
#define LAS __attribute__((address_space(3)))
typedef unsigned short bf16;
typedef short bf16x8 __attribute__((ext_vector_type(8)));
typedef float f32x4 __attribute__((ext_vector_type(4)));
typedef float f32x16 __attribute__((ext_vector_type(16)));
typedef unsigned u32x4 __attribute__((ext_vector_type(4)));
typedef unsigned u32x2 __attribute__((ext_vector_type(2)));
typedef GAS unsigned gu32;

#define PROBE_LO -1
#define PROBE_HI -1
#define PROBE_PAD 0
constexpr int NB = 4, SEQ = 8192, T = NB * SEQ, D = 1024;
constexpr int DIN = 2568, NPROJ = 2560;
constexpr int O_Q = 512, O_K = 1024, O_V = 1536, O_O = 2048, O_G = 2560;
constexpr int NE = 32, TOPK = 4, FF = 1024;
constexpr int NASSIGN = T * TOPK;
constexpr int MT = 256;
constexpr int NSLOTS = NASSIGN + NE * MT;
constexpr int MAXTILES = NSLOTS / MT;
constexpr int NWAVES = 8, NTHR = 512;
constexpr float W8_SCALE = 64.f, W8_INV = 1.f / 64.f;

constexpr size_t MiB = 1u << 20;
constexpr size_t WS_CTL = 0, CTL_ZERO_BYTES = 1 * MiB;
constexpr size_t WS_GATES = 1 * MiB;
constexpr size_t WS_TOPI = 2 * MiB;
constexpr size_t WS_TOPG = 3 * MiB;
constexpr size_t WS_SLOTTOK = 4 * MiB;
constexpr size_t WS_TOKSLOT = 5 * MiB;
constexpr size_t WS_CNT = 6 * MiB;
constexpr size_t WS_WIN = 8 * MiB;
constexpr size_t WS_WGLU = 13 * MiB;
constexpr size_t WS_WOUT = 14 * MiB;
constexpr size_t WS_WUP = 16 * MiB;
constexpr size_t WS_WDN = 144 * MiB;
constexpr size_t WS_HN = 208 * MiB;
constexpr size_t WS_PROJ = 272 * MiB;
constexpr size_t WS_GY = 432 * MiB;
constexpr size_t WS_MIX = 464 * MiB;
constexpr size_t WS_HRAW = 528 * MiB;
constexpr size_t WS_ACT = 272 * MiB;
constexpr size_t WS_H = 592 * MiB;
constexpr size_t WS_YS = 720 * MiB;
constexpr size_t WS_END = 992 * MiB;
constexpr int S5K = 1152;
constexpr size_t WS_S5A = 720 * MiB;
constexpr size_t WS_S5BT = 760 * MiB;
constexpr size_t WS_S5BQ = 836 * MiB;
constexpr size_t WS_XLOC = 856 * MiB;
constexpr size_t WS_QH = 866 * MiB;
constexpr size_t WS_KH = 898 * MiB;
constexpr size_t WS_VT = 930 * MiB;
constexpr size_t WS_DC = 962 * MiB;
constexpr size_t WS_CST = 978 * MiB;
constexpr size_t WS_FLOC = 986 * MiB;
constexpr size_t WS_DN = 987 * MiB;
constexpr size_t WS_NST = 988 * MiB;
constexpr size_t WS_SEGS = 989 * MiB;
constexpr size_t WS_KTAB = 990 * MiB;
static_assert(WS_S5A + (size_t)32 * 512 * S5K * 2 <= WS_S5BT && WS_S5BT + (size_t)32 * 1024 * S5K * 2 <= WS_S5BQ && WS_S5BQ + (size_t)32 * 256 * 1024 * 2 <= WS_XLOC && WS_XLOC + (size_t)32 * 512 * 128 * 4 <= WS_END, "s5 map");
static_assert(WS_ACT + (size_t)NSLOTS * FF * 2 <= WS_H && WS_YS + (size_t)NSLOTS * D * 2 <= WS_END, "ws map");
constexpr int CW_BAR = 4096;

constexpr int RING_BYTES = 131072;
constexpr int MISC_OFF = RING_BYTES;
constexpr int IDX_OFF = MISC_OFF + 128;
constexpr int TIL_OFF = IDX_OFF + 2048;
constexpr int LDS_BYTES = 147456;
static_assert(TIL_OFF + 3 * MAXTILES * 4 + 256 <= LDS_BYTES, "LDS map");

#define RLX_AGENT __ATOMIC_RELAXED, __HIP_MEMORY_SCOPE_AGENT
__device__ __forceinline__ float bf2f(bf16 v) { return __uint_as_float(((unsigned)v) << 16); }
__device__ __forceinline__ bf16 f2bf(float f) { unsigned u = __float_as_uint(f); u += 0x7fffu + ((u >> 16) & 1u); return (bf16)(u >> 16); }
__device__ __forceinline__ unsigned pk2(float lo, float hi) { return (unsigned)f2bf(lo) | ((unsigned)f2bf(hi) << 16); }
__device__ __forceinline__ unsigned cvt_pk_bf16(float lo, float hi) { unsigned r; asm volatile("v_cvt_pk_bf16_f32 %0, %1, %2" : "=v"(r) : "v"(lo), "v"(hi)); return r; }
__device__ __forceinline__ unsigned pk4_fp8(float a, float b, float c, float d) { unsigned w = 0u; w = __builtin_amdgcn_cvt_pk_fp8_f32(a, b, w, false); w = __builtin_amdgcn_cvt_pk_fp8_f32(c, d, w, true); return w; }
__device__ __forceinline__ float lo_bf(unsigned u) { return __uint_as_float(u << 16); }
__device__ __forceinline__ float hi_bf(unsigned u) { return __uint_as_float(u & 0xffff0000u); }
__device__ __forceinline__ float wave_sum(float v) {
#pragma unroll
    for (int o = 1; o < 64; o <<= 1) v += __shfl_xor(v, o);
    return v;
}
__device__ __forceinline__ float sigmoidf_(float x) { return 1.f / (1.f + __expf(-x)); }
__device__ __forceinline__ float gelu_tanh(float x) { const float u = 1.5957691216057308f * (x + 0.044715f * x * x * x); return x / (1.f + __expf(-u)); }

#define XB_TMO      128
#define XB_XCNT(j)  (256  + 64 * (j))
#define XB_XSUB(j)  (1280 + 64 * (j))
#define XB_XGEN(j)  (2304 + 64 * (j))
#define XB_TOP      3328
#define XB_TOPGEN   3392
#define XCD_BAR_WORDS 3456
#define XB_SPIN_CAP (1u << 18)
__device__ __forceinline__ unsigned xb_ld(unsigned* p)              { return __hip_atomic_load(p, __ATOMIC_RELAXED, __HIP_MEMORY_SCOPE_AGENT); }
__device__ __forceinline__ unsigned xb_add(unsigned* p, unsigned v) { return __hip_atomic_fetch_add(p, v, __ATOMIC_RELAXED, __HIP_MEMORY_SCOPE_AGENT); }
__device__ __forceinline__ unsigned xb_xcc_id() { return (unsigned)__builtin_amdgcn_s_getreg((3 << 11) | 20) & 0xFu; }
#define XB_SPIN(cond, bar) do { unsigned _sp = 0; while (cond) { __builtin_amdgcn_s_sleep(1); \
    if ((++_sp & 255u) == 0u) { if (xb_ld(&(bar)[XB_TMO])) break; if (_sp > XB_SPIN_CAP) { atomicAdd(&(bar)[XB_TMO], 1u); break; } } } } while (0)
struct XcdBarrier { unsigned* bar; unsigned x; volatile LAS unsigned* st; };
__device__ __forceinline__ XcdBarrier xcd_barrier_post(unsigned* bar, volatile LAS unsigned* st) {
    XcdBarrier b; b.bar = bar; b.x = xb_xcc_id(); b.st = st;
    if (threadIdx.x == 0) (void)xb_add(&bar[XB_XCNT(b.x)], 1u);
    return b;
}
__device__ __forceinline__ void xcd_barrier_complete(unsigned* bar, unsigned x, unsigned& nloc, unsigned& nx) {
    const unsigned G = gridDim.x * gridDim.y * gridDim.z;
    unsigned sum, cnt, mine, sp = 0u;
    for (;;) {
        sum = 0u; cnt = 0u; mine = 0u;
#pragma unroll
        for (unsigned j = 0; j < 16; ++j) { const unsigned c = xb_ld(&bar[XB_XCNT(j)]); sum += c; cnt += (c > 0u) ? 1u : 0u; mine = (j == x) ? c : mine; }
        if (sum == G) break;
        __builtin_amdgcn_s_sleep(1);
        if ((++sp & 255u) == 0u) { if (xb_ld(&bar[XB_TMO])) break; if (sp > XB_SPIN_CAP) { atomicAdd(&bar[XB_TMO], 1u); break; } }
    }
    nloc = mine > 0u ? mine : 1u; nx = cnt > 0u ? cnt : 1u;
}
__device__ __forceinline__ void xcd_barrier(const XcdBarrier& b) {
    asm volatile("s_waitcnt vmcnt(0)" ::: "memory");
    __syncthreads();
    if (threadIdx.x == 0) {
        unsigned* bar = b.bar;
        __builtin_amdgcn_s_waitcnt(0);
        unsigned nloc = b.st[0], nx = b.st[1];
        if (nloc == 0u) { xcd_barrier_complete(bar, b.x, nloc, nx); b.st[0] = nloc; b.st[1] = nx; }
        const unsigned old = xb_add(&bar[XB_XSUB(b.x)], 1u);
        const unsigned gen = old / nloc;
        if (old + 1u == (gen + 1u) * nloc) {
            __builtin_amdgcn_fence(__ATOMIC_RELEASE, "agent");
            asm volatile("s_waitcnt vmcnt(0)" ::: "memory");
            const unsigned og = xb_add(&bar[XB_TOP], 1u);
            const unsigned tg = og / nx;
            if (og + 1u == (tg + 1u) * nx) xb_add(&bar[XB_TOPGEN], 1u);
            else XB_SPIN(xb_ld(&bar[XB_TOPGEN]) == tg, bar);
            __builtin_amdgcn_fence(__ATOMIC_ACQUIRE, "agent");
            xb_add(&bar[XB_XGEN(b.x)], 1u);
            asm volatile("s_waitcnt vmcnt(0)" ::: "memory");
        } else {
            XB_SPIN(xb_ld(&bar[XB_XGEN(b.x)]) == gen, bar);
            __builtin_amdgcn_fence(__ATOMIC_ACQUIRE, "agent");
            asm volatile("s_waitcnt vmcnt(0)" ::: "memory");
        }
    }
    __syncthreads();
}

namespace pg {
constexpr int BM = 256, BK = 64, HALF = 128, HTB = HALF * BK * 2, STAGE_BYTES = 8 * HTB, NXCD = 8, WGM = 8;
__host__ __device__ __forceinline__ int lds_byte(int r, int c) { const int st = (r >> 4) * 2 + (c >> 5), rr = r & 15, cc = c & 31, ob = rr * 64 + cc * 2; return st * 1024 + (ob ^ (((ob >> 9) & 1) << 5)); }
__host__ __device__ __forceinline__ void stage_rc(int b, int& R, int& C) { const int st = b / 1024, sb = b % 1024, swz = sb ^ (((sb >> 9) & 1) << 5); R = (st >> 1) * 16 + swz / 64; C = (st & 1) * 32 + (swz % 64) / 2; }
__host__ __device__ __forceinline__ int perm32(int rho) { const int n = rho >> 4, i = rho & 15; return 8 * (i >> 2) + 4 * n + (i & 3); }

struct Unit { unsigned A, B; int pm, pn, e, nrows; };
__device__ __forceinline__ __amdgpu_buffer_rsrc_t mkrsrc(const void* p) { return __builtin_amdgcn_make_buffer_rsrc((void*)p, 0, 0x7fffffff, 0x00020000); }

__device__ __forceinline__ bool tile_order(int i, int G, int c, int nM, int nN, int& pm, int& pn) {
    const int nwg = nM * nN; const long L = (long)i * G + c; if (L >= nwg) return false;
    int wgid = (int)L; { const int q = nwg / NXCD, r = nwg % NXCD, xcd = wgid % NXCD, off = wgid / NXCD; wgid = (xcd < r ? xcd * (q + 1) : r * (q + 1) + (xcd - r) * q) + off; }
    const int nig = WGM * nN, gid = wgid / nig, fm = gid * WGM, gsz = (nM - fm) < WGM ? (nM - fm) : WGM;
    pm = fm + ((wgid % nig) % gsz); pn = (wgid % nig) / gsz; return true;
}
struct DenseSched {
    const char* A; const char* Bt; int lda2  , K2  , nM, nN, G, c;
    __device__ __forceinline__ bool next(int i, Unit& u) const { int pm, pn; if (!tile_order(i, G, c, nM, nN, pm, pn)) return false;
        u.A = (unsigned)pm * 256u * (unsigned)lda2; u.B = (unsigned)pn * 256u * (unsigned)K2; u.pm = pm; u.pn = pn; u.e = 0; u.nrows = 256; return true; }
    __device__ __forceinline__ __amdgpu_buffer_rsrc_t rsrcA() const { return mkrsrc(A); }
    __device__ __forceinline__ __amdgpu_buffer_rsrc_t rsrcB() const { return mkrsrc(Bt); }
    __device__ __forceinline__ void prefetch(const Unit&, int) const {}
    __device__ __forceinline__ unsigned aoff(const Unit&, int row, int) const { return (unsigned)row * (unsigned)lda2; }
};

typedef int i32x8 __attribute__((ext_vector_type(8)));
template <class Epi, class Sched, bool ALIGN_EPI, bool FP8 = false>
__device__ __forceinline__ void gemm_phase(LAS unsigned char* lds, const int K, const Sched& S, const Epi& E) {
    const int tid = threadIdx.x, wid = __builtin_amdgcn_readfirstlane(tid >> 6), lane = tid & 63, wr = wid >> 2, wc = wid & 3, fr = lane & 15, fq = lane >> 4;
    const int nt = FP8 ? K / 128 : K / BK;
    unsigned voffA[2][2], voffB[2];
#pragma unroll
    for (int i = 0; i < 1; ++i) { int R, C; if constexpr (FP8) { const int p = tid + 512 * i; R = p >> 3; C = (((p >> 1) & 3) ^ ((R >> 1) & 3)) * 32 + (p & 1) * 16; } else { stage_rc(tid * 16 + i * 8192, R, C); C *= 2; }
        const int Rb = Epi::PERM ? ((R & ~31) + perm32(R & 31)) : R; voffB[i] = (unsigned)(Rb * K * (FP8 ? 1 : 2) + C); }
    const unsigned kstep = (unsigned)(BK * 2);
    const unsigned hstep = (unsigned)HALF * K * (FP8 ? 1 : 2);
    const unsigned b64step = hstep / 2;
    const unsigned ldsw = (unsigned)wid * 1024u;
    const int aoff = FP8 ? (wr * 64 + fr) * 128 + ((fq ^ ((fr >> 1) & 3)) * 32) : lds_byte(wr * 64 + fr, fq * 8);
    const int boff = FP8 ? (wc * 32 + fr) * 128 + ((fq ^ ((fr >> 1) & 3)) * 32) : lds_byte(wc * 32 + fr, fq * 8);
#define PG_SA(b, h) (((b) * 2 + (h)) * HTB)
#define PG_SB(b, h) ((4 + (b) * 2 + (h)) * HTB)
#define PG_STAGE(bufoff, so, voff) do { _Pragma("unroll") for (int _i = 0; _i < 2; ++_i) \
        __builtin_amdgcn_raw_ptr_buffer_load_lds(rA, (LAS void*)(lds + (bufoff) + ldsw + _i * 8192), 16, (int)(voff)[_i], (int)(so), 0, 0); } while (0)
#define PG_STAGEB(bufoff, so) do { _Pragma("unroll") for (int _i = 0; _i < 2; ++_i) \
        __builtin_amdgcn_raw_ptr_buffer_load_lds(rB, (LAS void*)(lds + (bufoff) + ldsw + _i * 8192), 16, (int)voffB[0], (int)((so) + _i * b64step), 0, 0); } while (0)
#define PG_LD8(p, p2) __builtin_bit_cast(i32x8, __builtin_shufflevector(*(const LAS u32x4*)(p), *(const LAS u32x4*)(p2), 0, 1, 2, 3, 4, 5, 6, 7))
#define PG_LDA(dst, b, h) do { if constexpr (FP8) { _Pragma("unroll") for (int m = 0; m < 4; ++m) dst##8[m] = PG_LD8(lds + PG_SA(b, h) + aoff + m * 2048, lds + PG_SA(b, h) + aoff + m * 2048 + 16); } \
        else { _Pragma("unroll") for (int m = 0; m < 4; ++m) _Pragma("unroll") for (int k = 0; k < 2; ++k) dst[m][k] = *(const LAS bf16x8*)(lds + PG_SA(b, h) + aoff + m * 2048 + k * 1024); } } while (0)
#define PG_LDB(dst, b, h) do { if constexpr (FP8) { _Pragma("unroll") for (int n = 0; n < 2; ++n) dst##8[n] = PG_LD8(lds + PG_SB(b, h) + boff + n * 2048, lds + PG_SB(b, h) + boff + n * 2048 + 16); } \
        else { _Pragma("unroll") for (int n = 0; n < 2; ++n) _Pragma("unroll") for (int k = 0; k < 2; ++k) dst[n][k] = *(const LAS bf16x8*)(lds + PG_SB(b, h) + boff + n * 2048 + k * 1024); } } while (0)
#define PG_MMA(ai, bj, At, Bt) do { __builtin_amdgcn_s_setprio(1); if constexpr (FP8) { _Pragma("unroll") for (int m = 0; m < 4; ++m) _Pragma("unroll") for (int n = 0; n < 2; ++n) \
            acc[ai][bj][m][n] = __builtin_amdgcn_mfma_scale_f32_16x16x128_f8f6f4(Bt##8[n], At##8[m], acc[ai][bj][m][n], 0, 0, 0, 0, 0, 0); } \
        else { _Pragma("unroll") for (int m = 0; m < 4; ++m) _Pragma("unroll") for (int n = 0; n < 2; ++n) _Pragma("unroll") for (int k = 0; k < 2; ++k) \
            acc[ai][bj][m][n] = __builtin_amdgcn_mfma_f32_16x16x32_bf16(Bt[n][k], At[m][k], acc[ai][bj][m][n], 0, 0, 0); } __builtin_amdgcn_s_setprio(0); } while (0)
#define PG_WAIT_V(n) asm volatile("s_waitcnt vmcnt(" #n ")" ::: "memory")
#define PG_WAIT_L(n) asm volatile("s_waitcnt lgkmcnt(" #n ")" ::: "memory")
#define PG_BAR __builtin_amdgcn_s_barrier()
#define PG_SCHED __builtin_amdgcn_sched_barrier(0)
#define PG_SET_AOFF(u, ib) do { int _t = threadIdx.x; asm volatile("" : "+v"(_t));     \
        _Pragma("unroll") for (int _i = 0; _i < 2; ++_i) { int _R, _C; if constexpr (FP8) { const int _p = _t + 512 * _i; _R = _p >> 3; _C = (((_p >> 1) & 3) ^ ((_R >> 1) & 3)) * 32 + (_p & 1) * 16; } else { stage_rc(_t * 16 + _i * 8192, _R, _C); _C *= 2; } \
        voffA[0][_i] = S.aoff(u, _R, ib) + (unsigned)_C; voffA[1][_i] = S.aoff(u, _R + HALF, ib) + (unsigned)_C; } } while (0)
    Unit cur, nxt; int ui = 0;
    if (!S.next(0, cur)) return;
    f32x4 acc[2][2][4][2];
#pragma unroll
    for (int a = 0; a < 2; ++a)
#pragma unroll
        for (int b = 0; b < 2; ++b)
#pragma unroll
            for (int m = 0; m < 4; ++m)
#pragma unroll
                for (int n = 0; n < 2; ++n) acc[a][b][m][n] = (f32x4){0.f, 0.f, 0.f, 0.f};
    bf16x8 At[FP8 ? 1 : 4][2], B0[2][2], B1[2][2]; i32x8 At8[FP8 ? 4 : 1], B08[2], B18[2];
    const __amdgpu_buffer_rsrc_t rA = S.rsrcA(), rB = S.rsrcB();
    unsigned cA = cur.A, cB = cur.B;
    S.prefetch(cur, 0);
    PG_WAIT_V(0); __syncthreads();
    PG_SET_AOFF(cur, 0);
    PG_STAGEB(PG_SB(0, 0), cB); PG_STAGEB(PG_SB(0, 1), cB + hstep); PG_STAGE(PG_SA(0, 0), cA, voffA[0]); PG_STAGE(PG_SA(0, 1), cA, voffA[1]);
    if (wr == 1) PG_BAR;
    PG_WAIT_V(2); PG_BAR;
    PG_STAGEB(PG_SB(1, 0), cB + kstep); PG_STAGE(PG_SA(1, 0), cA + kstep, voffA[0]); PG_STAGEB(PG_SB(1, 1), cB + hstep + kstep);
    PG_WAIT_V(6); PG_BAR;
    for (;;) {
        const bool has_next = S.next(ui + 1, nxt);
        const unsigned nA = has_next ? nxt.A : cA, nB = has_next ? nxt.B : cB;
        if (has_next) S.prefetch(nxt, (ui + 1) & 1);
#pragma unroll 1
        for (int t = 0; t < nt; t += 2) {
            const bool last = (t == nt - 2);
            const unsigned a1 = cA + (unsigned)(t + 1) * kstep;
            const unsigned a2 = last ? nA : cA + (unsigned)(t + 2) * kstep, b2 = last ? nB : cB + (unsigned)(t + 2) * kstep;
            const unsigned a3 = a2 + kstep, b3 = b2 + kstep;
            PG_LDB(B0, 0, 0); PG_LDB(B1, 0, 1); PG_SCHED; PG_LDA(At, 0, 0); PG_STAGE(PG_SA(1, 1), a1, voffA[1]);
            PG_WAIT_V(8); PG_WAIT_L(0); PG_BAR; PG_MMA(0, 0, At, B0); PG_MMA(0, 1, At, B1); PG_BAR; PG_SCHED;
            if (last && has_next) PG_SET_AOFF(nxt, (ui + 1) & 1);
            PG_LDA(At, 0, 1); PG_STAGEB(PG_SB(0, 0), b2); PG_STAGEB(PG_SB(0, 1), b2 + hstep); PG_STAGE(PG_SA(0, 0), a2, voffA[0]);
            PG_WAIT_V(8); PG_WAIT_L(0); PG_BAR; PG_MMA(1, 0, At, B0); PG_MMA(1, 1, At, B1); PG_BAR; PG_SCHED;
            PG_LDB(B0, 1, 0); PG_LDB(B1, 1, 1); PG_SCHED; PG_LDA(At, 1, 0); PG_STAGE(PG_SA(0, 1), a2, voffA[1]);
            PG_WAIT_V(8); PG_WAIT_L(0); PG_BAR; PG_MMA(0, 0, At, B0); PG_MMA(0, 1, At, B1); PG_BAR; PG_SCHED;
            PG_LDA(At, 1, 1); PG_STAGEB(PG_SB(1, 0), b3); PG_STAGEB(PG_SB(1, 1), b3 + hstep); PG_STAGE(PG_SA(1, 0), a3, voffA[0]);
            PG_WAIT_V(8); PG_WAIT_L(0); PG_BAR; PG_MMA(1, 0, At, B0); PG_MMA(1, 1, At, B1); PG_BAR; PG_SCHED;
        }
        if constexpr (ALIGN_EPI) { if (wr == 0) PG_BAR; }
        {
            int tz = threadIdx.x; asm volatile("" : "+v"(tz)); const int lz = tz & 63;
            E(acc, cur, (tz >> 6) >> 2, (tz >> 6) & 3, lz & 15, lz >> 4);
        }
        if (!has_next) break;
#pragma unroll
        for (int a = 0; a < 2; ++a)
#pragma unroll
            for (int b = 0; b < 2; ++b)
#pragma unroll
                for (int m = 0; m < 4; ++m)
#pragma unroll
                    for (int n = 0; n < 2; ++n) acc[a][b][m][n] = (f32x4){0.f, 0.f, 0.f, 0.f};
        cur = nxt; cA = nA; cB = nB; ++ui;
        if constexpr (ALIGN_EPI) { if (wr == 1) PG_BAR; }
    }
    PG_WAIT_V(0);
    if constexpr (!ALIGN_EPI) { if (wr == 0) PG_BAR; }
    PG_BAR;
#undef PG_SA
#undef PG_SB
#undef PG_STAGE
#undef PG_STAGEB
#undef PG_LDA
#undef PG_LDB
#undef PG_MMA
#undef PG_LD8
#undef PG_WAIT_V
#undef PG_WAIT_L
#undef PG_BAR
#undef PG_SCHED
#undef PG_SET_AOFF
}

struct EpiProj {
    static constexpr bool PERM = true; bf16* P; bf16* S5A;
    __device__ __forceinline__ void operator()(const f32x4 (&acc)[2][2][4][2], const Unit& u, int wr, int wc, int fr, int fq) const {
        const int row0 = u.pm * BM + wr * 64 + fr, col0 = u.pn * BM + wc * 32 + 8 * fq;
#pragma unroll
        for (int ai = 0; ai < 2; ++ai)
#pragma unroll
            for (int m = 0; m < 4; ++m) { const int row = row0 + ai * HALF + m * 16; bf16* rowp = P + (size_t)row * NPROJ + col0;
                if (u.pn < 2) { const int b = row >> 13, tt = row & 8191; rowp = S5A + ((size_t)b * 128 + (tt >> 6)) * S5K + (tt & 63) * 16 + (col0 & 15) + (size_t)(col0 >> 4) * 512 * S5K - (size_t)0; }
#pragma unroll
                for (int bj = 0; bj < 2; ++bj) { const f32x4 v0 = acc[ai][bj][m][0], v1 = acc[ai][bj][m][1];
                    u32x4 w; w.x = cvt_pk_bf16(v0[0], v0[1]); w.y = cvt_pk_bf16(v0[2], v0[3]); w.z = cvt_pk_bf16(v1[0], v1[1]); w.w = cvt_pk_bf16(v1[2], v1[3]);
                    *(u32x4*)(rowp + (u.pn < 2 ? (size_t)bj * 8 * 512 * S5K : (size_t)bj * HALF)) = w; } }
    }
};
struct EpiXloc {
    static constexpr bool PERM = false; float* X;
    __device__ __forceinline__ void operator()(const f32x4 (&acc)[2][2][4][2], const Unit& u, int wr, int wc, int fr, int fq) const {
        const int row0 = (u.pm & 1) * BM + wr * 64 + fr, col0 = wc * 32 + 4 * fq;
#pragma unroll
        for (int ai = 0; ai < 2; ++ai)
#pragma unroll
            for (int m = 0; m < 4; ++m) { float* rp = X + ((size_t)u.e * 512 + row0 + ai * HALF + m * 16) * 128 + col0;
#pragma unroll
                for (int n = 0; n < 2; ++n) *(f32x4*)(rp + n * 16) = acc[ai][0][m][n]; }
    }
};
struct EpiS5Y {
    static constexpr bool PERM = true; const bf16* S5A; const float* dskip; bf16* GY;
    __device__ __forceinline__ void operator()(const f32x4 (&acc)[2][2][4][2], const Unit& u, int wr, int wc, int fr, int fq) const {
        const int g = u.e, rg0 = (u.pm & 1) * BM + wr * 64 + fr, c0 = u.pn * BM + wc * 32 + 8 * fq;
#pragma unroll
        for (int bj = 0; bj < 2; ++bj) { const int col = c0 + bj * HALF, t = col >> 4, p0 = col & 15;
            const f32x4 d0 = *(const f32x4*)(dskip + g * 16 + p0), d1 = *(const f32x4*)(dskip + g * 16 + p0 + 4);
#pragma unroll
            for (int ai = 0; ai < 2; ++ai)
#pragma unroll
                for (int m = 0; m < 4; ++m) { const int rg = rg0 + ai * HALF + m * 16; const int b = rg >> 7, c = rg & 127;
                    const u32x4 uu = *(const u32x4*)(S5A + ((size_t)g * 512 + rg) * S5K + col);
                    const f32x4 v0 = acc[ai][bj][m][0], v1 = acc[ai][bj][m][1];
                    u32x4 w;
                    w.x = cvt_pk_bf16(gelu_tanh(v0[0] + d0[0] * lo_bf(uu.x)), gelu_tanh(v0[1] + d0[1] * hi_bf(uu.x))); w.y = cvt_pk_bf16(gelu_tanh(v0[2] + d0[2] * lo_bf(uu.y)), gelu_tanh(v0[3] + d0[3] * hi_bf(uu.y)));
                    w.z = cvt_pk_bf16(gelu_tanh(v1[0] + d1[0] * lo_bf(uu.z)), gelu_tanh(v1[1] + d1[1] * hi_bf(uu.z))); w.w = cvt_pk_bf16(gelu_tanh(v1[2] + d1[2] * lo_bf(uu.w)), gelu_tanh(v1[3] + d1[3] * hi_bf(uu.w)));
                    *(u32x4*)(GY + ((size_t)b * SEQ + c * 64 + t) * 512 + g * 16 + p0) = w; } }
    }
};
struct S5Sched {
    const char* A; const char* B; int lda2, K2, brows, nN, G, c;
    __device__ __forceinline__ bool next(int i, Unit& u) const { const int L = i * G + c; if (L >= 64 * nN) return false;
        const int g = L / (2 * nN), r = L % (2 * nN), mh = r / nN, pn = r % nN;
        u.A = ((unsigned)g * 512u + mh * 256u) * (unsigned)lda2; u.B = ((unsigned)g * brows + pn * 256u) * (unsigned)K2; u.pm = g * 2 + mh; u.pn = pn; u.e = g; u.nrows = 256; return true; }
    __device__ __forceinline__ __amdgpu_buffer_rsrc_t rsrcA() const { return mkrsrc(A); }
    __device__ __forceinline__ __amdgpu_buffer_rsrc_t rsrcB() const { return mkrsrc(B); }
    __device__ __forceinline__ void prefetch(const Unit&, int) const {}
    __device__ __forceinline__ unsigned aoff(const Unit&, int row, int) const { return (unsigned)row * (unsigned)lda2; }
};
struct EpiGlu {
    static constexpr bool PERM = true; const bf16* GY; const float* bglu; bf16* MIX;
    __device__ __forceinline__ void operator()(const f32x4 (&acc)[2][2][4][2], const Unit& u, int wr, int wc, int fr, int fq) const {
        const int row0 = u.pm * BM + wr * 64 + fr, col0 = u.pn * BM + wc * 32 + 8 * fq;
#pragma unroll
        for (int bj = 0; bj < 2; ++bj) { const int col = col0 + bj * HALF;
            const f32x4 b0 = *(const f32x4*)(bglu + col), b1 = *(const f32x4*)(bglu + col + 4);
#pragma unroll
            for (int ai = 0; ai < 2; ++ai)
#pragma unroll
                for (int m = 0; m < 4; ++m) { const size_t row = (size_t)(row0 + ai * HALF + m * 16);
                    const u32x4 g = *(const u32x4*)(GY + row * 512 + col);
                    const f32x4 v0 = acc[ai][bj][m][0] + b0, v1 = acc[ai][bj][m][1] + b1;
                    u32x4 w;
                    w.x = cvt_pk_bf16(lo_bf(g.x) * sigmoidf_(v0[0]), hi_bf(g.x) * sigmoidf_(v0[1])); w.y = cvt_pk_bf16(lo_bf(g.y) * sigmoidf_(v0[2]), hi_bf(g.y) * sigmoidf_(v0[3]));
                    w.z = cvt_pk_bf16(lo_bf(g.z) * sigmoidf_(v1[0]), hi_bf(g.z) * sigmoidf_(v1[1])); w.w = cvt_pk_bf16(lo_bf(g.w) * sigmoidf_(v1[2]), hi_bf(g.w) * sigmoidf_(v1[3]));
                    *(u32x4*)(MIX + row * D + col) = w; } }
    }
};
struct EpiOut {
    static constexpr bool PERM = false; const float* x; float* H;
    __device__ __forceinline__ void operator()(const f32x4 (&acc)[2][2][4][2], const Unit& u, int wr, int wc, int fr, int fq) const {
        const int row0 = u.pm * BM + wr * 64 + fr, col0 = u.pn * BM + wc * 32 + 4 * fq;
#pragma unroll
        for (int ai = 0; ai < 2; ++ai)
#pragma unroll
            for (int m = 0; m < 4; ++m) { const size_t ro = (size_t)(row0 + ai * HALF + m * 16) * D + col0;
#pragma unroll
                for (int bj = 0; bj < 2; ++bj)
#pragma unroll
                    for (int n = 0; n < 2; ++n) *(f32x4*)(H + ro + bj * HALF + n * 16) = *(const f32x4*)(x + ro + bj * HALF + n * 16) + acc[ai][bj][m][n]; }
    }
};
struct EpiUp {
    static constexpr bool PERM = true; const float* b_up; unsigned char* ACT;
    __device__ __forceinline__ void operator()(const f32x4 (&acc)[2][2][4][2], const Unit& u, int wr, int wc, int fr, int fq) const {
        const int row0 = u.pm * BM + wr * 64 + fr, j0 = u.pn * HALF + wc * 32 + 8 * fq;
        const float* bg = b_up + (size_t)u.e * 2 * FF + j0;
#pragma unroll
        for (int ai = 0; ai < 2; ++ai)
#pragma unroll
            for (int m = 0; m < 4; ++m) {
                float o[8];
#pragma unroll
                for (int n = 0; n < 2; ++n) { const f32x4 gb = *(const f32x4*)(bg + 4 * n), lb = *(const f32x4*)(bg + FF + 4 * n);
#pragma unroll
                    for (int q = 0; q < 4; ++q) { const float g = fminf(acc[ai][0][m][n][q] * W8_INV + gb[q], 7.f); const float li = fminf(fmaxf(acc[ai][1][m][n][q] * W8_INV + lb[q], -7.f), 7.f);
                        o[n * 4 + q] = g * sigmoidf_(1.702f * g) * (li + 1.f); } }
                u32x2 w; w.x = pk4_fp8(o[0], o[1], o[2], o[3]); w.y = pk4_fp8(o[4], o[5], o[6], o[7]);
                *(u32x2*)(ACT + (size_t)(row0 + ai * HALF + m * 16) * FF + j0) = w; }
    }
};
struct EpiDown {
    static constexpr bool PERM = true; const float* b_down; bf16* YS;
    __device__ __forceinline__ void operator()(const f32x4 (&acc)[2][2][4][2], const Unit& u, int wr, int wc, int fr, int fq) const {
        const int row0 = u.pm * BM + wr * 64 + fr, col0 = u.pn * BM + wc * 32 + 8 * fq;
        const float* bp = b_down + (size_t)u.e * D + col0;
#pragma unroll
        for (int ai = 0; ai < 2; ++ai)
#pragma unroll
            for (int m = 0; m < 4; ++m)
#pragma unroll
                for (int bj = 0; bj < 2; ++bj) { const f32x4 b0 = *(const f32x4*)(bp + bj * HALF), b1 = *(const f32x4*)(bp + bj * HALF + 4);
                    const f32x4 v0 = acc[ai][bj][m][0] * W8_INV + b0, v1 = acc[ai][bj][m][1] * W8_INV + b1;
                    u32x4 w; w.x = cvt_pk_bf16(v0[0], v0[1]); w.y = cvt_pk_bf16(v0[2], v0[3]); w.z = cvt_pk_bf16(v1[0], v1[1]); w.w = cvt_pk_bf16(v1[2], v1[3]);
                    *(u32x4*)(YS + (size_t)(row0 + ai * HALF + m * 16) * D + col0 + bj * HALF) = w; }
    }
};
}

struct MoeSched {
    const char* A; const char* W; const int* slot_tok; LAS int* til; LAS int* idx; int lda2, K2, nN, wrows  , G, c, gather;
    __device__ __forceinline__ bool next(int i, pg::Unit& u) const {
        const int nM = __builtin_amdgcn_readfirstlane(til[2 * MAXTILES]); int pm, pn; if (!pg::tile_order(i, G, c, nM, nN, pm, pn)) return false;
        pm = __builtin_amdgcn_readfirstlane(pm); pn = __builtin_amdgcn_readfirstlane(pn);
        const int e = __builtin_amdgcn_readfirstlane(til[pm]); u.pm = pm; u.pn = pn; u.e = e; u.nrows = __builtin_amdgcn_readfirstlane(til[MAXTILES + pm]);
        u.A = gather ? 0u : (unsigned)pm * 256u * (unsigned)lda2; u.B = ((unsigned)e * wrows + (unsigned)pn * 256u) * (unsigned)K2; return true; }
    __device__ __forceinline__ __amdgpu_buffer_rsrc_t rsrcA() const { return pg::mkrsrc(A); }
    __device__ __forceinline__ __amdgpu_buffer_rsrc_t rsrcB() const { return pg::mkrsrc(W); }
    __device__ __forceinline__ void prefetch(const pg::Unit& u, int ib) const {
        if (gather && threadIdx.x < 256) { const int r = threadIdx.x; const int s = u.pm * 256 + (r < u.nrows ? r : u.nrows - 1);
            __builtin_amdgcn_global_load_lds((const unsigned*)(slot_tok + s), (LAS unsigned*)(idx + ib * 256 + (threadIdx.x & ~63)), 4, 0, 0); } }
    __device__ __forceinline__ unsigned aoff(const pg::Unit&, int row, int ib) const { return gather ? (unsigned)idx[ib * 256 + row] * (unsigned)lda2 : (unsigned)row * (unsigned)lda2; }
};

struct Frame {
    LAS unsigned char* lds; volatile LAS unsigned* MISC; gu32* ctl; int tid, lane, wave, vcu, G;
};
#define LDS_WAIT() asm volatile("s_waitcnt lgkmcnt(0)" ::: "memory")

template <bool F8, class RowMap>
__device__ __forceinline__ void transpose_item(const float* W, int ldw, int K, int nblk, void* WTv, LAS bf16* scr, int item, int lane, RowMap rowmap) {
    const int kb = item / nblk, nb = item % nblk, k0 = 64 * kb, n0 = 64 * nb;
    const float* src = W + (size_t)(k0 + (lane >> 4)) * ldw + n0 + 4 * (lane & 15);
    f32x4 v[16];
#pragma unroll
    for (int i = 0; i < 16; ++i) v[i] = *(const f32x4*)(src + (size_t)(4 * i) * ldw);
#pragma unroll
    for (int i = 0; i < 16; ++i) { u32x2 o; o.x = pk2(v[i].x, v[i].y); o.y = pk2(v[i].z, v[i].w); *(LAS u32x2*)(scr + ((lane >> 4) + 4 * i) * 68 + 4 * (lane & 15)) = o; }
    LDS_WAIT(); asm volatile("" ::: "memory");
    const int c = lane & 7; const int r0 = rowmap(n0);
#pragma unroll
    for (int jn = 0; jn < 8; ++jn) { const int n = (lane >> 3) + 8 * jn; const LAS bf16* sp = scr + (8 * c) * 68 + n;
        if constexpr (F8) { u32x2 o; o.x = pk4_fp8(bf2f(sp[0]) * W8_SCALE, bf2f(sp[68]) * W8_SCALE, bf2f(sp[2 * 68]) * W8_SCALE, bf2f(sp[3 * 68]) * W8_SCALE);
            o.y = pk4_fp8(bf2f(sp[4 * 68]) * W8_SCALE, bf2f(sp[5 * 68]) * W8_SCALE, bf2f(sp[6 * 68]) * W8_SCALE, bf2f(sp[7 * 68]) * W8_SCALE);
            *(u32x2*)((unsigned char*)WTv + (size_t)(r0 + n) * K + k0 + 8 * c) = o; }
        else { u32x4 o; o.x = (unsigned)sp[0] | ((unsigned)sp[68] << 16); o.y = (unsigned)sp[2 * 68] | ((unsigned)sp[3 * 68] << 16); o.z = (unsigned)sp[4 * 68] | ((unsigned)sp[5 * 68] << 16); o.w = (unsigned)sp[6 * 68] | ((unsigned)sp[7 * 68] << 16);
            *(u32x4*)((bf16*)WTv + (size_t)(r0 + n) * K + k0 + 8 * c) = o; } }
    LDS_WAIT(); asm volatile("" ::: "memory");
}
struct RowId { __device__ __forceinline__ int operator()(int n0) const { return n0; } };
struct RowUp { __device__ __forceinline__ int operator()(int n0) const { return n0 < FF ? (n0 >> 7) * 256 + (n0 & 127) : ((n0 - FF) >> 7) * 256 + 128 + ((n0 - FF) & 127); } };

struct Args { const float* in[26]; float* out; unsigned char* ws; int ph_lo, ph_hi, li, pad; };

__global__ void __launch_bounds__(NTHR, 2) fwd(Args args) {
    extern __shared__ __attribute__((aligned(16))) unsigned char lds_raw[];
    Frame F;
    F.lds = (LAS unsigned char*)lds_raw;
    F.MISC = (volatile LAS unsigned*)(F.lds + MISC_OFF);
    F.tid = threadIdx.x; F.lane = F.tid & 63; F.wave = __builtin_amdgcn_readfirstlane(F.tid >> 6);
    F.G = gridDim.x; { const int bx = blockIdx.x; F.vcu = (F.G % 8 == 0) ? (bx % 8) * (F.G / 8) + bx / 8 : bx; }
    unsigned char* ws = args.ws;
    F.ctl = (gu32*)(ws + WS_CTL);
    if (F.tid < 32) ((LAS unsigned*)(F.lds + MISC_OFF))[F.tid] = 0u;
    __syncthreads();
    XcdBarrier bar = xcd_barrier_post((unsigned*)(F.ctl + CW_BAR) + args.li * XCD_BAR_WORDS, F.MISC + 8);
#define INP(i) (*(const float* const volatile*)((const char*)__builtin_amdgcn_kernarg_segment_ptr() + 8 * (i)))
    const int lo = args.ph_lo, hi = args.ph_hi;
#define IN(k) (lo <= (k) && (k) < hi)
#define BOTH(k) (IN(k) && IN((k) + 1))
#define GRID_BAR() xcd_barrier(bar)
    const float* x = args.in[0];
    bf16* WIN = (bf16*)(ws + WS_WIN); bf16* WGLU = (bf16*)(ws + WS_WGLU); bf16* WOUT = (bf16*)(ws + WS_WOUT); unsigned char* WUP8 = ws + WS_WUP; unsigned char* WDN8 = ws + WS_WDN;
    bf16* HN = (bf16*)(ws + WS_HN); bf16* PROJ = (bf16*)(ws + WS_PROJ); bf16* GY = (bf16*)(ws + WS_GY); bf16* MIX = (bf16*)(ws + WS_MIX);
    float* H = (float*)(ws + WS_H); unsigned char* ACT8 = ws + WS_ACT; unsigned char* HN8 = ws + WS_HN; bf16* YS = (bf16*)(ws + WS_YS);
    float* gates = (float*)(ws + WS_GATES); int* topi = (int*)(ws + WS_TOPI); float* topg = (float*)(ws + WS_TOPG);
    int* slot_tok = (int*)(ws + WS_SLOTTOK); int* tok_slot = (int*)(ws + WS_TOKSLOT); int* CNT = (int*)(ws + WS_CNT); int* ecnt = CNT + 16384;
    bf16* S5A = (bf16*)(ws + WS_S5A); bf16* S5BT = (bf16*)(ws + WS_S5BT); bf16* S5BQ = (bf16*)(ws + WS_S5BQ); float* XLOC = (float*)(ws + WS_XLOC);
    bf16* QH = (bf16*)(ws + WS_QH); bf16* KH = (bf16*)(ws + WS_KH); bf16* VT = (bf16*)(ws + WS_VT); float* DC = (float*)(ws + WS_DC); bf16* CST = (bf16*)(ws + WS_CST);
    float* FLOC = (float*)(ws + WS_FLOC); float* DN = (float*)(ws + WS_DN); float* NST = (float*)(ws + WS_NST); float* SEGS = (float*)(ws + WS_SEGS); float* KTAB = (float*)(ws + WS_KTAB);
    const int gw = F.vcu * NWAVES + F.wave, NGW = F.G * NWAVES;

    if (IN(0)) {
        { int tq_ = threadIdx.x; asm volatile("" : "+v"(tq_)); F.tid = tq_; F.lane = tq_ & 63; }
        LAS bf16* scr = (LAS bf16*)(F.lds + F.wave * 16384);
        constexpr int I_IN = (D / 64) * (NPROJ / 64), I_GLU = (512 / 64) * (512 / 64), I_OUT = (D / 64) * (D / 64), I_UP = (D / 64) * (2 * FF / 64), I_DN = (FF / 64) * (D / 64);
        constexpr int NITEMS = I_IN + I_GLU + I_OUT + NE * I_UP + NE * I_DN;
        for (int it = gw; it < NITEMS && !(args.pad & 1); it += NGW) {
            int r = it;
            if (r < I_IN) { transpose_item<false>(args.in[2], DIN, D, NPROJ / 64, WIN, scr, r, F.lane, RowId()); continue; } r -= I_IN;
            if (r < I_GLU) { transpose_item<false>(args.in[11], 512, 512, 512 / 64, WGLU, scr, r, F.lane, RowId()); continue; } r -= I_GLU;
            if (r < I_OUT) { transpose_item<false>(args.in[17], D, D, D / 64, WOUT, scr, r, F.lane, RowId()); continue; } r -= I_OUT;
            if (r < NE * I_UP) { const int e = r / I_UP; transpose_item<true>(args.in[21] + (size_t)e * D * 2 * FF, 2 * FF, D, 2 * FF / 64, WUP8 + (size_t)e * 2 * FF * D, scr, r % I_UP, F.lane, RowUp()); continue; } r -= NE * I_UP;
            { const int e = r / I_DN; transpose_item<true>(args.in[23] + (size_t)e * FF * D, D, FF, D / 64, WDN8 + (size_t)e * D * FF, scr, r % I_DN, F.lane, RowId()); }
        }
        {
            const float* g = args.in[1]; const float* w_in = args.in[2]; const float* b_gates = args.in[15];
            float wg[16][8]; f32x4 gg[4];
#pragma unroll
            for (int jq = 0; jq < 4; ++jq) { gg[jq] = *(const f32x4*)(g + 4 * F.lane + 256 * jq);
#pragma unroll
                for (int i = 0; i < 4; ++i) { const int k = 4 * F.lane + 256 * jq + i; const f32x4 w0 = *(const f32x4*)(w_in + (size_t)k * DIN + O_G), w1 = *(const f32x4*)(w_in + (size_t)k * DIN + O_G + 4);
                    wg[4 * jq + i][0] = w0.x; wg[4 * jq + i][1] = w0.y; wg[4 * jq + i][2] = w0.z; wg[4 * jq + i][3] = w0.w; wg[4 * jq + i][4] = w1.x; wg[4 * jq + i][5] = w1.y; wg[4 * jq + i][6] = w1.z; wg[4 * jq + i][7] = w1.w; } }
            float bgv[8];
#pragma unroll
            for (int q = 0; q < 8; ++q) bgv[q] = b_gates[q];
            f32x4 nx[4];
            if (gw < T) {
#pragma unroll
                for (int jq = 0; jq < 4; ++jq) nx[jq] = *(const f32x4*)(x + (size_t)gw * D + 4 * F.lane + 256 * jq); }
            for (int row = gw; row < T && !(args.pad & 2); row += NGW) {
                f32x4 v[4];
#pragma unroll
                for (int jq = 0; jq < 4; ++jq) v[jq] = nx[jq];
                if (row + NGW < T) {
#pragma unroll
                    for (int jq = 0; jq < 4; ++jq) nx[jq] = *(const f32x4*)(x + (size_t)(row + NGW) * D + 4 * F.lane + 256 * jq); }
                float ss = 0.f;
#pragma unroll
                for (int jq = 0; jq < 4; ++jq) ss += v[jq].x * v[jq].x + v[jq].y * v[jq].y + v[jq].z * v[jq].z + v[jq].w * v[jq].w;
                ss = wave_sum(ss);
                const float rstd = rsqrtf(ss * (1.f / D) + 1e-5f);
                float ga[8] = {0, 0, 0, 0, 0, 0, 0, 0};
#pragma unroll
                for (int jq = 0; jq < 4; ++jq) {
                    v[jq] = v[jq] * rstd * gg[jq];
#pragma unroll
                    for (int i = 0; i < 4; ++i)
#pragma unroll
                        for (int q = 0; q < 8; ++q) ga[q] += v[jq][i] * wg[4 * jq + i][q];
                    uint2 o; o.x = pk2(v[jq].x, v[jq].y); o.y = pk2(v[jq].z, v[jq].w);
                    *(uint2*)(HN + (size_t)row * D + 4 * F.lane + 256 * jq) = o;
                }
#pragma unroll
                for (int q = 0; q < 8; ++q) ga[q] = wave_sum(ga[q]);
                if (F.lane == 0) { *(f32x4*)(gates + (size_t)row * 8) = (f32x4){ga[0] + bgv[0], ga[1] + bgv[1], ga[2] + bgv[2], ga[3] + bgv[3]}; *(f32x4*)(gates + (size_t)row * 8 + 4) = (f32x4){ga[4] + bgv[4], ga[5] + bgv[5], ga[6] + bgv[6], ga[7] + bgv[7]}; }
            }
        }
        __syncthreads();
        for (int un = F.vcu; un < 256 && !(args.pad & 4); un += F.G) {
            const int g = un >> 3, j = un & 7;
            LAS float* Ere = (LAS float*)F.lds; LAS float* Eim = Ere + 8 * 64;
            LAS float* Bbr = Eim + 8 * 64; LAS float* Bbi = Bbr + 1024;
            LAS float* Cr = Bbi + 1024; LAS float* Ci = Cr + 1024;
            const float dt = __expf(args.in[3][g]);
            if (F.tid < 64) { const int n = F.tid;
                const float are = fminf(args.in[4][g * 64 + n], -1e-4f), aim = args.in[5][g * 64 + n];
                const float mag = expf(dt * are); float sn, cs; sincosf(dt * aim, &sn, &cs);
                const float nr = mag * cs - 1.f, ni = mag * sn, dn = are * are + aim * aim;
                const float cfr = (nr * are + ni * aim) / dn, cfi = (ni * are - nr * aim) / dn;
                for (int q = 0; q < 16; ++q) { const float br = args.in[6][(g * 64 + n) * 16 + q], bi = args.in[7][(g * 64 + n) * 16 + q]; Bbr[n * 16 + q] = cfr * br - cfi * bi; Bbi[n * 16 + q] = cfr * bi + cfi * br; }
            }
            for (int i = F.tid; i < 1024; i += NTHR) { Cr[i] = args.in[8][g * 1024 + i]; Ci[i] = args.in[9][g * 1024 + i]; }
            { const int tl = F.tid >> 6, n = F.tid & 63; const float tau = (float)(8 * j + tl);
                const float are = fminf(args.in[4][g * 64 + n], -1e-4f), aim = args.in[5][g * 64 + n];
                const float mag = expf(tau * dt * are); float sn, cs; sincosf(tau * dt * aim, &sn, &cs); Ere[F.tid] = mag * cs; Eim[F.tid] = mag * sn; }
            __syncthreads();
            {
                const int tl = F.tid >> 6, p = (F.tid >> 2) & 15, q0 = (F.tid & 3) * 4;
                float a0 = 0.f, a1 = 0.f, a2 = 0.f, a3 = 0.f;
                for (int n = 0; n < 64; ++n) { const float cr = Cr[p * 64 + n], ci = Ci[p * 64 + n], er = Ere[tl * 64 + n], ei = Eim[tl * 64 + n];
                    const float xr = cr * er - ci * ei, xi = cr * ei + ci * er;
                    const f32x4 br = *(const LAS f32x4*)(Bbr + n * 16 + q0), bi = *(const LAS f32x4*)(Bbi + n * 16 + q0);
                    a0 += xr * br.x - xi * bi.x; a1 += xr * br.y - xi * bi.y; a2 += xr * br.z - xi * bi.z; a3 += xr * br.w - xi * bi.w; }
                *(f32x4*)(KTAB + ((size_t)g * 64 + 8 * j + tl) * 256 + p * 16 + q0) = (f32x4){a0, a1, a2, a3};
            }
            const float dtg = dt;
            for (int ch = F.tid; ch < 32 * 128; ch += NTHR) {
                const int rl = ch >> 7, c8 = ch & 127, r = 32 * j + rl, n = r & 63, im = (r >> 6) & 1, col = c8 * 8, sidx = col >> 4, q0 = col & 15;
                const float are = fminf(args.in[4][g * 64 + n], -1e-4f), aim = args.in[5][g * 64 + n]; const float tau = (float)(63 - sidx);
                const float mag = expf(tau * dtg * are); float sn, cs; sincosf(tau * dtg * aim, &sn, &cs); const float er = mag * cs, ei = mag * sn;
                float v[8];
#pragma unroll
                for (int i = 0; i < 8; ++i) { const float br = Bbr[n * 16 + q0 + i], bi = Bbi[n * 16 + q0 + i]; v[i] = im ? (er * bi + ei * br) : (er * br - ei * bi); }
                u32x4 o; o.x = pk2(v[0], v[1]); o.y = pk2(v[2], v[3]); o.z = pk2(v[4], v[5]); o.w = pk2(v[6], v[7]);
                *(u32x4*)(S5BQ + ((size_t)g * 256 + r) * 1024 + col) = o;
            }
            __syncthreads();
        }
        if (BOTH(0)) GRID_BAR();
    }
    if (IN(1)) {
        { int tq_ = threadIdx.x; asm volatile("" : "+v"(tq_)); F.tid = tq_; F.lane = tq_ & 63; }
        pg::DenseSched S{(const char*)HN, (const char*)WIN, D * 2, D * 2, T / 256, NPROJ / 256, F.G, (int)blockIdx.x};
        pg::EpiProj E{PROJ, S5A};
        pg::gemm_phase<pg::EpiProj, pg::DenseSched, true>(F.lds, D, S, E);
        if (BOTH(1)) GRID_BAR();
    }
    if (IN(2)) {
        { int tq_ = threadIdx.x; asm volatile("" : "+v"(tq_)); F.tid = tq_; F.lane = tq_ & 63; }
        pg::S5Sched S{(const char*)S5A, (const char*)S5BQ, S5K * 2, 1024 * 2, 256, 1, F.G, F.vcu};
        pg::EpiXloc E{XLOC};
        pg::gemm_phase<pg::EpiXloc, pg::S5Sched, true>(F.lds, 1024, S, E);
        {
            const int first = F.G > 64 ? F.vcu - 64 : F.vcu, stride = F.G > 64 ? F.G - 64 : F.G;
            LAS float* Kt = (LAS float*)F.lds;
            LAS float* Ere = Kt + 64 * 256; LAS float* Eim = Ere + 8 * 64;
            LAS float* Cr = Eim + 8 * 64; LAS float* Ci = Cr + 1024;
            for (int un = first; un >= 0 && un < 256; un += stride) {
                const int g = un >> 3, j = un & 7, ntau = 8 * j + 8;
                __syncthreads();
                for (int i = F.tid; i < ntau * 64; i += NTHR) *(LAS f32x4*)(Kt + 4 * i) = *(const f32x4*)(KTAB + (size_t)g * 64 * 256 + 4 * i);
                for (int i = F.tid; i < 1024; i += NTHR) { Cr[i] = args.in[8][g * 1024 + i]; Ci[i] = args.in[9][g * 1024 + i]; }
                { const int tl = F.tid >> 6, n = F.tid & 63; const float tau = (float)(8 * j + tl + 1); const float dt = __expf(args.in[3][g]);
                    const float are = fminf(args.in[4][g * 64 + n], -1e-4f), aim = args.in[5][g * 64 + n];
                    const float mag = expf(tau * dt * are); float sn, cs; sincosf(tau * dt * aim, &sn, &cs); Ere[F.tid] = mag * cs; Eim[F.tid] = mag * sn; }
                __syncthreads();
                for (int ch = F.tid; ch < 128 * 144; ch += NTHR) {
                    const int rl = ch / 144, c8 = ch % 144, tl = rl >> 4, t = 8 * j + tl, p = rl & 15, col = c8 * 8;
                    float v[8];
                    if (col < 1024) { const int sidx = col >> 4, q0 = col & 15;
                        if (sidx <= t) { const f32x4 k0 = *(const LAS f32x4*)(Kt + (t - sidx) * 256 + p * 16 + q0), k1 = *(const LAS f32x4*)(Kt + (t - sidx) * 256 + p * 16 + q0 + 4);
                            v[0] = k0.x; v[1] = k0.y; v[2] = k0.z; v[3] = k0.w; v[4] = k1.x; v[5] = k1.y; v[6] = k1.z; v[7] = k1.w; }
                        else {
#pragma unroll
                            for (int i = 0; i < 8; ++i) v[i] = 0.f; }
                    } else { const int jj = (col - 1024) & 63, im = (col - 1024) >> 6;
#pragma unroll
                        for (int i = 0; i < 8; ++i) { const int n = jj + i; const float cr = Cr[p * 64 + n], ci = Ci[p * 64 + n], er = Ere[tl * 64 + n], ei = Eim[tl * 64 + n];
                            v[i] = im ? -(cr * ei + ci * er) : (cr * er - ci * ei); } }
                    u32x4 o; o.x = pk2(v[0], v[1]); o.y = pk2(v[2], v[3]); o.z = pk2(v[4], v[5]); o.w = pk2(v[6], v[7]);
                    *(u32x4*)(S5BT + ((size_t)g * 1024 + 128 * j + rl) * S5K + col) = o;
                }
            }
            __syncthreads();
        }
    }
    if (IN(3)) {
        { int tq_ = threadIdx.x; asm volatile("" : "+v"(tq_)); F.tid = tq_; F.lane = tq_ & 63; }
        typedef short s16x4 __attribute__((ext_vector_type(4)));
        LAS float* wsl = (LAS float*)F.lds;
        LAS float* red = wsl + 512;
        LAS float* dnl = red + 32;
        LAS bf16* RQ = (LAS bf16*)(F.lds + 4096);
        LAS bf16* RK = RQ + 67 * 136;
        LAS bf16* RV = RK + 67 * 136;
        LAS bf16* KN = RV + 64 * 136;
        LAS bf16* KTl = KN + 64 * 136;
        LAS bf16* VTl = KTl + 128 * 72;
        const float* cw = args.in[13]; const float* cbias = args.in[14];
        for (int un = blockIdx.x; un < 256; un += F.G) {
            const int bh = un >> 4, seg = un & 15, b = bh >> 2, hd = bh & 3, t0 = seg * 512; const size_t row0 = (size_t)b * SEQ + t0;
            float Fl, Aval;
            {
                const float ipre = gates[(row0 + F.tid) * 8 + hd], fpre = gates[(row0 + F.tid) * 8 + 4 + hd];
                const float lf = fminf(fpre, 0.f) - log1pf(__expf(-fabsf(fpre)));
                float sc = lf;
#pragma unroll
                for (int o = 1; o < 64; o <<= 1) { const float tv = __shfl_up(sc, o); if (F.lane >= o) sc += tv; }
                if (F.lane == 63) red[F.wave] = sc;
                __syncthreads();
                float base = 0.f;
                for (int w2 = 0; w2 < F.wave; ++w2) base += red[w2];
                Fl = sc + base; Aval = ipre - Fl;
                float mx = Aval;
#pragma unroll
                for (int o = 1; o < 64; o <<= 1) mx = fmaxf(mx, __shfl_xor(mx, o));
                if (F.lane == 0) red[8 + F.wave] = mx;
                __syncthreads();
                float Amax = red[8];
                for (int w2 = 1; w2 < 8; ++w2) Amax = fmaxf(Amax, red[8 + w2]);
                wsl[F.tid] = __expf(Aval - Amax);
                FLOC[(size_t)bh * SEQ + t0 + F.tid] = Fl;
                if (F.tid == 511) { SEGS[un * 4 + 0] = Fl; SEGS[un * 4 + 1] = Amax; }
                if (F.tid < 256) dnl[F.tid] = 0.f;
            }
            f32x16 dacc[2];
#pragma unroll
            for (int i = 0; i < 2; ++i)
#pragma unroll
                for (int q = 0; q < 16; ++q) dacc[i][q] = 0.f;
            const int cch = F.tid & 127, isk = (F.tid >> 7) & 1, thalf = F.tid >> 8;
            const int gch = isk * 512 + hd * 128 + cch;
            const float cw0 = cw[gch], cw1 = cw[1024 + gch], cw2 = cw[2048 + gch], cw3 = cw[3072 + gch], cb = cbias[gch];
            float dnacc = 0.f;
            u32x4 rt[7];
#define ML_RAW_LOAD(tsv) do { _Pragma("unroll") for (int ii = 0; ii < 7; ++ii) { const int ch = F.tid + NTHR * ii; u32x4 v = (u32x4){0u, 0u, 0u, 0u}; \
                if (ch < 2 * 67 * 16) { const int which = ch / (67 * 16), r = (ch % (67 * 16)) >> 4, c16 = ch & 15; const int tk = (tsv) - 3 + r; \
                    if (tk >= 0) v = *(const u32x4*)(PROJ + ((size_t)b * SEQ + tk) * NPROJ + (which ? O_K : O_Q) + hd * 128 + c16 * 8); } \
                else if (ch < 2 * 67 * 16 + 64 * 16) { const int c2 = ch - 2 * 67 * 16, r = c2 >> 4, c16 = c2 & 15; v = *(const u32x4*)(PROJ + ((size_t)b * SEQ + (tsv) + r) * NPROJ + O_V + hd * 128 + c16 * 8); } \
                rt[ii] = v; } } while (0)
            ML_RAW_LOAD(t0);
            for (int sb = 0; sb < 8; ++sb) {
                const int ts = t0 + sb * 64;
                __syncthreads();
#pragma unroll
                for (int ii = 0; ii < 7; ++ii) { const int ch = F.tid + NTHR * ii;
                    if (ch < 2 * 67 * 16) { const int which = ch / (67 * 16), r = (ch % (67 * 16)) >> 4, c16 = ch & 15; *(LAS u32x4*)((which ? RK : RQ) + r * 136 + c16 * 8) = rt[ii]; }
                    else if (ch < 2 * 67 * 16 + 64 * 16) { const int c2 = ch - 2 * 67 * 16, r = c2 >> 4, c16 = c2 & 15; *(LAS u32x4*)(RV + r * 136 + c16 * 8) = rt[ii]; } }
                if (sb < 7) ML_RAW_LOAD(ts + 64);
                __syncthreads();
                {
                    LAS bf16* raw = isk ? RK : RQ; const int s0 = thalf * 32;
                    float x3 = bf2f(raw[(s0 + 0) * 136 + cch]), x2 = bf2f(raw[(s0 + 1) * 136 + cch]), x1 = bf2f(raw[(s0 + 2) * 136 + cch]);
                    for (int sidx = s0; sidx < s0 + 32; ++sidx) {
                        const float xv = bf2f(raw[(sidx + 3) * 136 + cch]);
                        float val = cb + cw0 * x3 + cw1 * x2 + cw2 * x1 + cw3 * xv;
                        x3 = x2; x2 = x1; x1 = xv;
                        val = val * sigmoidf_(val);
                        if (isk) { val *= 0.08838834764831845f * wsl[sb * 64 + sidx]; dnacc += val; const bf16 kb = f2bf(val); KN[sidx * 136 + cch] = kb; KH[((size_t)bh * SEQ + ts + sidx) * 128 + cch] = kb; }
                        else QH[((size_t)bh * SEQ + ts + sidx) * 128 + cch] = f2bf(val);
                    }
                }
                __syncthreads();
                {
                    const int c = F.tid & 127, sq = F.tid >> 7;
#pragma unroll
                    for (int half = 0; half < 2; ++half) { const int sA = sq * 16 + half * 8;
                        u32x4 kk, vv;
                        kk.x = (unsigned)KN[(sA + 0) * 136 + c] | ((unsigned)KN[(sA + 1) * 136 + c] << 16); kk.y = (unsigned)KN[(sA + 2) * 136 + c] | ((unsigned)KN[(sA + 3) * 136 + c] << 16);
                        kk.z = (unsigned)KN[(sA + 4) * 136 + c] | ((unsigned)KN[(sA + 5) * 136 + c] << 16); kk.w = (unsigned)KN[(sA + 6) * 136 + c] | ((unsigned)KN[(sA + 7) * 136 + c] << 16);
                        vv.x = (unsigned)RV[(sA + 0) * 136 + c] | ((unsigned)RV[(sA + 1) * 136 + c] << 16); vv.y = (unsigned)RV[(sA + 2) * 136 + c] | ((unsigned)RV[(sA + 3) * 136 + c] << 16);
                        vv.z = (unsigned)RV[(sA + 4) * 136 + c] | ((unsigned)RV[(sA + 5) * 136 + c] << 16); vv.w = (unsigned)RV[(sA + 6) * 136 + c] | ((unsigned)RV[(sA + 7) * 136 + c] << 16);
                        *(LAS u32x4*)(KTl + c * 72 + sA) = kk; *(LAS u32x4*)(VTl + c * 72 + sA) = vv; }
                }
                __syncthreads();
                {
                    const int e = F.tid >> 2, part = F.tid & 3;
                    const u32x4 v0 = *(const LAS u32x4*)(VTl + e * 72 + part * 16), v1 = *(const LAS u32x4*)(VTl + e * 72 + part * 16 + 8);
                    bf16* dst = VT + ((size_t)bh * 128 + e) * SEQ + ts + part * 16;
                    *(u32x4*)dst = v0; *(u32x4*)(dst + 8) = v1;
                    const int eb = F.wave >> 1, db0 = (F.wave & 1) * 2, r = F.lane & 31, hh = F.lane >> 5;
#pragma unroll
                    for (int ks = 0; ks < 4; ++ks) {
                        const bf16x8 a = *(const LAS bf16x8*)(VTl + (eb * 32 + r) * 72 + ks * 16 + hh * 8);
                        const bf16x8 b0 = *(const LAS bf16x8*)(KTl + (db0 * 32 + r) * 72 + ks * 16 + hh * 8), b1 = *(const LAS bf16x8*)(KTl + ((db0 + 1) * 32 + r) * 72 + ks * 16 + hh * 8);
                        dacc[0] = __builtin_amdgcn_mfma_f32_32x32x16_bf16(a, b0, dacc[0], 0, 0, 0);
                        dacc[1] = __builtin_amdgcn_mfma_f32_32x32x16_bf16(a, b1, dacc[1], 0, 0, 0);
                    }
                }
            }
#undef ML_RAW_LOAD
            if (isk) dnl[thalf * 128 + cch] = dnacc;
            {
                const int eb = F.wave >> 1, db0 = (F.wave & 1) * 2, r = F.lane & 31, hh = F.lane >> 5;
#pragma unroll
                for (int i = 0; i < 2; ++i)
#pragma unroll
                    for (int q = 0; q < 16; ++q) DC[((size_t)un * 128 + eb * 32 + (q & 3) + 8 * (q >> 2) + 4 * hh) * 128 + (db0 + i) * 32 + r] = dacc[i][q];
            }
            __syncthreads();
            if (F.tid < 128) DN[un * 128 + F.tid] = dnl[F.tid] + dnl[128 + F.tid];
            __syncthreads();
        }
        if (BOTH(3)) GRID_BAR();
    }
    if (IN(4)) {
        { int tq_ = threadIdx.x; asm volatile("" : "+v"(tq_)); F.tid = tq_; F.lane = tq_ & 63; }
        LAS float* agr = (LAS float*)F.lds; LAS float* agi = agr + 512;
        for (int un = blockIdx.x; un < 128; un += F.G) {
            const int b = un >> 5, g = un & 31, n = F.tid & 63, seg = F.tid >> 6;
            const float dt = __expf(args.in[3][g]);
            const float are = fminf(args.in[4][g * 64 + n], -1e-4f), aim = args.in[5][g * 64 + n];
            float ar, ai, Ar, Ai;
            { const float mag = expf(64.f * dt * are); float sn, cs; sincosf(64.f * dt * aim, &sn, &cs); ar = mag * cs; ai = mag * sn; }
            { const float mag = expf(1024.f * dt * are); float sn, cs; sincosf(1024.f * dt * aim, &sn, &cs); Ar = mag * cs; Ai = mag * sn; }
            const size_t row0 = (size_t)g * 512 + b * 128 + seg * 16;
            float xr[16], xi[16];
#pragma unroll
            for (int jj = 0; jj < 16; ++jj) { xr[jj] = XLOC[(row0 + jj) * 128 + n]; xi[jj] = XLOC[(row0 + jj) * 128 + 64 + n]; }
            float sr = 0.f, si = 0.f;
#pragma unroll
            for (int jj = 0; jj < 16; ++jj) { const float tr = ar * sr - ai * si + xr[jj], ti = ar * si + ai * sr + xi[jj]; sr = tr; si = ti; }
            agr[seg * 64 + n] = sr; agi[seg * 64 + n] = si;
            __syncthreads();
            float cr = 0.f, ci = 0.f;
            for (int s2 = 0; s2 < seg; ++s2) { const float tr = Ar * cr - Ai * ci + agr[s2 * 64 + n], ti = Ar * ci + Ai * cr + agi[s2 * 64 + n]; cr = tr; ci = ti; }
#pragma unroll
            for (int jj = 0; jj < 16; ++jj) {
                S5A[(row0 + jj) * S5K + 1024 + n] = f2bf(cr); S5A[(row0 + jj) * S5K + 1088 + n] = f2bf(ci);
                const float tr = ar * cr - ai * ci + xr[jj], ti = ar * ci + ai * cr + xi[jj]; cr = tr; ci = ti; }
            __syncthreads();
        }
        for (int un = blockIdx.x; un < 256; un += F.G) {
            const int bh = un >> 4, slice = un & 15;
            float dc0[16], dc1[16];
#pragma unroll
            for (int j = 0; j < 16; ++j) { dc0[j] = DC[((size_t)(bh * 16 + j)) * 16384 + slice * 1024 + F.tid]; dc1[j] = DC[((size_t)(bh * 16 + j)) * 16384 + slice * 1024 + 512 + F.tid]; }
            float dn[16];
            const bool nrole = (slice == 0 && F.tid < 128);
#pragma unroll
            for (int j = 0; j < 16; ++j) dn[j] = nrole ? DN[(bh * 16 + j) * 128 + F.tid] : 0.f;
            float m = 0.f, C0 = 0.f, C1 = 0.f, nn = 0.f;
#pragma unroll
            for (int j = 0; j < 16; ++j) {
                const float Fend = SEGS[(bh * 16 + j) * 4 + 0], Amax = SEGS[(bh * 16 + j) * 4 + 1];
                const float R = fmaxf(m, Amax), c1 = __expf(m - R), c2 = __expf(Amax - R);
                CST[((size_t)(bh * 16 + j)) * 16384 + slice * 1024 + F.tid] = f2bf(c1 * C0); CST[((size_t)(bh * 16 + j)) * 16384 + slice * 1024 + 512 + F.tid] = f2bf(c1 * C1);
                if (nrole) NST[(bh * 16 + j) * 128 + F.tid] = c1 * nn;
                if (slice == 0 && F.tid == 0) { SEGS[(bh * 16 + j) * 4 + 2] = R; SEGS[(bh * 16 + j) * 4 + 3] = c2; }
                C0 = c1 * C0 + c2 * dc0[j]; C1 = c1 * C1 + c2 * dc1[j]; nn = c1 * nn + c2 * dn[j]; m = Fend + R;
            }
        }
        if (BOTH(4)) GRID_BAR();
    }
    if (IN(5)) {
        { int tq_ = threadIdx.x; asm volatile("" : "+v"(tq_)); F.tid = tq_; F.lane = tq_ & 63; }
        pg::S5Sched S{(const char*)S5A, (const char*)S5BT, S5K * 2, S5K * 2, 1024, 4, F.G, F.vcu};
        pg::EpiS5Y E{S5A, args.in[10], GY};
        pg::gemm_phase<pg::EpiS5Y, pg::S5Sched, true>(F.lds, S5K, S, E);
        if (BOTH(5)) GRID_BAR();
    }
    if (IN(6)) {
        { int tq_ = threadIdx.x; asm volatile("" : "+v"(tq_)); F.tid = tq_; F.lane = tq_ & 63; }
        typedef short s16x4 __attribute__((ext_vector_type(4)));
        LAS bf16* Kl = (LAS bf16*)F.lds;
        LAS bf16* Vl = Kl + 2 * 64 * 136;
        LAS bf16* Cl = Vl + 2 * 128 * 72;
        LAS float* nl = (LAS float*)(Cl + 128 * 136);
        LAS float* fll = nl + 128;
        LAS float* gl = fll + 512;
        const float* ng = args.in[16];
        for (int un = blockIdx.x; un < 256; un += F.G) {
            int tid6 = F.tid; asm volatile("" : "+v"(tid6));
            const int lane6 = tid6 & 63;
            const int bh = un >> 4, seg = un & 15, b = bh >> 2, hd = bh & 3, t0 = seg * 512;
            const float R = SEGS[un * 4 + 2], c2 = SEGS[un * 4 + 3];
            __syncthreads();
            for (int ch = tid6; ch < 2048; ch += NTHR) { const int r = ch >> 4, c16 = ch & 15; *(LAS u32x4*)(Cl + r * 136 + c16 * 8) = *(const u32x4*)(CST + (size_t)un * 16384 + r * 128 + c16 * 8); }
            if (tid6 < 128) { nl[tid6] = NST[un * 128 + tid6]; gl[tid6] = ng[hd * 128 + tid6]; }
            fll[tid6] = FLOC[(size_t)bh * SEQ + t0 + tid6];
            const int r = lane6 & 31, hh = lane6 >> 5;
            for (int pass = 0; pass < 2; ++pass) {
                const int qb = pass == 0 ? F.wave : 15 - F.wave, jmax = qb >> 1, npj = pass == 0 ? 4 : 8;
                bf16x8 Q[8];
                { const bf16* qp = QH + ((size_t)bh * SEQ + t0 + qb * 32 + r) * 128 + hh * 8;
#pragma unroll
                  for (int ks = 0; ks < 8; ++ks) Q[ks] = *(const bf16x8*)(qp + ks * 16); }
                u32x4 pk0, pk1, pv0, pv1;
                { const int kr = tid6 >> 4, kc = tid6 & 15; const bf16* kp = KH + ((size_t)bh * SEQ + t0) * 128; pk0 = *(const u32x4*)(kp + kr * 128 + kc * 8); pk1 = *(const u32x4*)(kp + (kr + 32) * 128 + kc * 8);
                  const int vr = tid6 >> 3, vc = tid6 & 7; const bf16* vp = VT + (size_t)bh * 128 * SEQ + t0; pv0 = *(const u32x4*)(vp + (size_t)vr * SEQ + vc * 8); pv1 = *(const u32x4*)(vp + (size_t)(vr + 64) * SEQ + vc * 8); }
                f32x16 acc[4];
#pragma unroll
                for (int eb = 0; eb < 4; ++eb)
#pragma unroll
                    for (int q = 0; q < 16; ++q) acc[eb][q] = 0.f;
                __syncthreads();
#pragma unroll
                for (int eb = 0; eb < 4; ++eb) {
#pragma unroll
                    for (int ks = 0; ks < 8; ++ks) { const bf16x8 a = *(const LAS bf16x8*)(Cl + (eb * 32 + r) * 136 + ks * 16 + hh * 8); acc[eb] = __builtin_amdgcn_mfma_f32_32x32x16_bf16(a, Q[ks], acc[eb], 0, 0, 0); }
                    __builtin_amdgcn_sched_barrier(0);
                }
                float den = 0.f;
#pragma unroll
                for (int ks = 0; ks < 8; ++ks) {
#pragma unroll
                    for (int jj = 0; jj < 8; ++jj) den += nl[ks * 16 + hh * 8 + jj] * bf2f((bf16)Q[ks][jj]);
                    __builtin_amdgcn_sched_barrier(0);
                }
                float dsum = 0.f;
                for (int j = 0; j < npj; ++j) {
                    LAS bf16* Kb = Kl + (j & 1) * 64 * 136; LAS bf16* Vb = Vl + (j & 1) * 128 * 72;
                    { const int kr = tid6 >> 4, kc = tid6 & 15; *(LAS u32x4*)(Kb + kr * 136 + kc * 8) = pk0; *(LAS u32x4*)(Kb + (kr + 32) * 136 + kc * 8) = pk1;
                      const int vr = tid6 >> 3, vc = tid6 & 7; *(LAS u32x4*)(Vb + vr * 72 + vc * 8) = pv0; *(LAS u32x4*)(Vb + (vr + 64) * 72 + vc * 8) = pv1; }
                    if (j + 1 < npj) { const int kr = tid6 >> 4, kc = tid6 & 15; const bf16* kp = KH + ((size_t)bh * SEQ + t0 + (j + 1) * 64) * 128; pk0 = *(const u32x4*)(kp + kr * 128 + kc * 8); pk1 = *(const u32x4*)(kp + (kr + 32) * 128 + kc * 8);
                        const int vr = tid6 >> 3, vc = tid6 & 7; const bf16* vp = VT + (size_t)bh * 128 * SEQ + t0 + (j + 1) * 64; pv0 = *(const u32x4*)(vp + (size_t)vr * SEQ + vc * 8); pv1 = *(const u32x4*)(vp + (size_t)(vr + 64) * SEQ + vc * 8); }
                    __syncthreads();
                    if (j <= jmax) {
                        const bool diag = (j == jmax); const int tq = qb * 32 + r;
#pragma unroll
                        for (int sb = 0; sb < 2; ++sb) {
                            f32x16 st;
#pragma unroll
                            for (int q = 0; q < 16; ++q) st[q] = 0.f;
#pragma unroll
                            for (int ks = 0; ks < 8; ++ks) { const bf16x8 a = *(const LAS bf16x8*)(Kb + (sb * 32 + r) * 136 + ks * 16 + hh * 8); st = __builtin_amdgcn_mfma_f32_32x32x16_bf16(a, Q[ks], st, 0, 0, 0); }
                            bf16x8 pb[2];
#pragma unroll
                            for (int sp = 0; sp < 2; ++sp) {
                                float pv[8];
#pragma unroll
                                for (int jj = 0; jj < 8; ++jj) { const int q = 8 * sp + jj; const int sidx = j * 64 + sb * 32 + (q & 3) + 8 * (q >> 2) + 4 * hh;
                                    float p = st[q] * c2; if (diag && sidx > tq) p = 0.f; pv[jj] = p; dsum += p; }
                                u32x4 w; w.x = cvt_pk_bf16(pv[0], pv[1]); w.y = cvt_pk_bf16(pv[2], pv[3]); w.z = cvt_pk_bf16(pv[4], pv[5]); w.w = cvt_pk_bf16(pv[6], pv[7]);
                                pb[sp] = __builtin_bit_cast(bf16x8, w);
                            }
#pragma unroll
                            for (int eb = 0; eb < 4; ++eb)
#pragma unroll
                                for (int sp = 0; sp < 2; ++sp) {
                                    const int so = sb * 32 + 16 * sp + 4 * hh;
                                    const s16x4 lo = *(const LAS s16x4*)(Vb + (eb * 32 + r) * 72 + so), hi = *(const LAS s16x4*)(Vb + (eb * 32 + r) * 72 + so + 8);
                                    const bf16x8 a = __builtin_shufflevector(lo, hi, 0, 1, 2, 3, 4, 5, 6, 7);
                                    acc[eb] = __builtin_amdgcn_mfma_f32_32x32x16_bf16(a, pb[sp], acc[eb], 0, 0, 0);
                                }
                            __builtin_amdgcn_sched_barrier(0);
                        }
                    }
                }
                den += dsum; den += __shfl_xor(den, 32);
                const float flo = __expf(-fll[qb * 32 + r] - R);
                const float inv = 1.f / fmaxf(fabsf(den), flo);
                float s1 = 0.f;
#pragma unroll
                for (int eb = 0; eb < 4; ++eb)
#pragma unroll
                    for (int q = 0; q < 16; ++q) { acc[eb][q] *= inv; s1 += acc[eb][q]; }
                s1 += __shfl_xor(s1, 32);
                const float mu = s1 * (1.f / 128.f);
                float s2 = 0.f;
#pragma unroll
                for (int eb = 0; eb < 4; ++eb)
#pragma unroll
                    for (int q = 0; q < 16; ++q) { const float dlt = acc[eb][q] - mu; s2 += dlt * dlt; }
                s2 += __shfl_xor(s2, 32);
                const float rstd = rsqrtf(s2 * (1.f / 128.f) + 1e-6f);
                const size_t row = (size_t)b * SEQ + t0 + qb * 32 + r;
#pragma unroll
                for (int eb = 0; eb < 4; ++eb)
#pragma unroll
                    for (int g4 = 0; g4 < 4; ++g4) {
                        const int e0 = eb * 32 + 8 * g4 + 4 * hh;
                        const uint2 ov = *(const uint2*)(PROJ + row * NPROJ + O_O + hd * 128 + e0);
                        const float o0 = (acc[eb][4 * g4 + 0] - mu) * rstd * gl[e0 + 0] * sigmoidf_(lo_bf(ov.x)), o1 = (acc[eb][4 * g4 + 1] - mu) * rstd * gl[e0 + 1] * sigmoidf_(hi_bf(ov.x));
                        const float o2 = (acc[eb][4 * g4 + 2] - mu) * rstd * gl[e0 + 2] * sigmoidf_(lo_bf(ov.y)), o3 = (acc[eb][4 * g4 + 3] - mu) * rstd * gl[e0 + 3] * sigmoidf_(hi_bf(ov.y));
                        uint2 w; w.x = cvt_pk_bf16(o0, o1); w.y = cvt_pk_bf16(o2, o3);
                        *(uint2*)(MIX + row * D + 512 + hd * 128 + e0) = w;
                        __builtin_amdgcn_sched_barrier(0);
                    }
            }
        }
    }
    if (IN(7)) {
        { int tq_ = threadIdx.x; asm volatile("" : "+v"(tq_)); F.tid = tq_; F.lane = tq_ & 63; }
        pg::DenseSched S{(const char*)GY, (const char*)WGLU, 512 * 2, 512 * 2, T / 256, 2, F.G, (int)blockIdx.x};
        pg::EpiGlu E{GY, args.in[12], MIX};
        pg::gemm_phase<pg::EpiGlu, pg::DenseSched, true>(F.lds, 512, S, E);
        if (BOTH(7)) GRID_BAR();
    }
    if (IN(8)) {
        { int tq_ = threadIdx.x; asm volatile("" : "+v"(tq_)); F.tid = tq_; F.lane = tq_ & 63; }
        pg::DenseSched S{(const char*)MIX, (const char*)WOUT, D * 2, D * 2, T / 256, D / 256, F.G, (int)blockIdx.x};
        pg::EpiOut E{x, H};
        pg::gemm_phase<pg::EpiOut, pg::DenseSched, true>(F.lds, D, S, E);
        if (BOTH(8)) GRID_BAR();
    }
    if (IN(9)) {
        { int tq_ = threadIdx.x; asm volatile("" : "+v"(tq_)); F.tid = tq_; F.lane = tq_ & 63; }
        const float* gf = args.in[18]; const float* w_r = args.in[19]; const float* b_r = args.in[20];
        LAS float* rs = (LAS float*)(F.lds);
        LAS float* part = (LAS float*)(F.lds + 1024);
        LAS int* hist = (LAS int*)(F.lds + 1024 + 2 * 128 * 33 * 4);
        for (int tb = blockIdx.x; tb < T / 128; tb += F.G) {
            const int row0 = tb * 128;
            if (F.tid < 32) hist[F.tid] = 0;
            {
                f32x4 gg[4];
#pragma unroll
                for (int jq = 0; jq < 4; ++jq) gg[jq] = *(const f32x4*)(gf + 4 * F.lane + 256 * jq);
                f32x4 nx[4];
#pragma unroll
                for (int jq = 0; jq < 4; ++jq) nx[jq] = *(const f32x4*)(H + (size_t)(row0 + F.wave * 16) * D + 4 * F.lane + 256 * jq);
                for (int rr = 0; rr < 16; ++rr) {
                    const int r = F.wave * 16 + rr;
                    f32x4 v[4];
#pragma unroll
                    for (int jq = 0; jq < 4; ++jq) v[jq] = nx[jq];
                    if (rr < 15) {
#pragma unroll
                        for (int jq = 0; jq < 4; ++jq) nx[jq] = *(const f32x4*)(H + (size_t)(row0 + r + 1) * D + 4 * F.lane + 256 * jq); }
                    float ss = 0.f;
#pragma unroll
                    for (int jq = 0; jq < 4; ++jq) ss += v[jq].x * v[jq].x + v[jq].y * v[jq].y + v[jq].z * v[jq].z + v[jq].w * v[jq].w;
                    ss = wave_sum(ss);
                    const float rstd = rsqrtf(ss * (1.f / D) + 1e-5f);
                    if (F.lane == 0) rs[r] = rstd;
#pragma unroll
                    for (int jq = 0; jq < 4; ++jq) *(unsigned*)(HN8 + (size_t)(row0 + r) * D + 4 * F.lane + 256 * jq) = pk4_fp8(v[jq].x * rstd * gg[jq].x, v[jq].y * rstd * gg[jq].y, v[jq].z * rstd * gg[jq].z, v[jq].w * rstd * gg[jq].w);
                }
            }
            {
                const int rg = F.wave & 3, kh = F.wave >> 2, i = F.lane & 31, hh = F.lane >> 5;
                f32x16 acc;
#pragma unroll
                for (int q = 0; q < 16; ++q) acc[q] = 0.f;
                const float* hp = H + (size_t)(row0 + rg * 32 + i) * D + kh * 512 + 4 * hh;
                const float* wp = w_r + (size_t)(kh * 512 + 4 * hh) * NE + i; const float* gp = gf + kh * 512 + 4 * hh;
                f32x4 a0[4], g0[4], a1[4], g1[4]; f32x4 w0[4], w1[4];
#pragma unroll
                for (int u = 0; u < 4; ++u) { a0[u] = *(const f32x4*)(hp + 8 * u); g0[u] = *(const f32x4*)(gp + 8 * u);
                    w0[u] = (f32x4){wp[(size_t)(8 * u + 0) * NE], wp[(size_t)(8 * u + 1) * NE], wp[(size_t)(8 * u + 2) * NE], wp[(size_t)(8 * u + 3) * NE]}; }
                for (int k0 = 0; k0 < 512; k0 += 64) {
#pragma unroll
                    for (int u = 0; u < 4; ++u) { const int kk = k0 + 32 + 8 * u; a1[u] = *(const f32x4*)(hp + kk); g1[u] = *(const f32x4*)(gp + kk);
                        w1[u] = (f32x4){wp[(size_t)(kk + 0) * NE], wp[(size_t)(kk + 1) * NE], wp[(size_t)(kk + 2) * NE], wp[(size_t)(kk + 3) * NE]}; }
#pragma unroll
                    for (int u = 0; u < 4; ++u) { const f32x4 bb = w0[u] * g0[u];
                        acc = __builtin_amdgcn_mfma_f32_32x32x2f32(a0[u].x, bb.x, acc, 0, 0, 0); acc = __builtin_amdgcn_mfma_f32_32x32x2f32(a0[u].y, bb.y, acc, 0, 0, 0);
                        acc = __builtin_amdgcn_mfma_f32_32x32x2f32(a0[u].z, bb.z, acc, 0, 0, 0); acc = __builtin_amdgcn_mfma_f32_32x32x2f32(a0[u].w, bb.w, acc, 0, 0, 0); }
                    if (k0 + 64 < 512) {
#pragma unroll
                        for (int u = 0; u < 4; ++u) { const int kk = k0 + 64 + 8 * u; a0[u] = *(const f32x4*)(hp + kk); g0[u] = *(const f32x4*)(gp + kk);
                            w0[u] = (f32x4){wp[(size_t)(kk + 0) * NE], wp[(size_t)(kk + 1) * NE], wp[(size_t)(kk + 2) * NE], wp[(size_t)(kk + 3) * NE]}; } }
#pragma unroll
                    for (int u = 0; u < 4; ++u) { const f32x4 bb = w1[u] * g1[u];
                        acc = __builtin_amdgcn_mfma_f32_32x32x2f32(a1[u].x, bb.x, acc, 0, 0, 0); acc = __builtin_amdgcn_mfma_f32_32x32x2f32(a1[u].y, bb.y, acc, 0, 0, 0);
                        acc = __builtin_amdgcn_mfma_f32_32x32x2f32(a1[u].z, bb.z, acc, 0, 0, 0); acc = __builtin_amdgcn_mfma_f32_32x32x2f32(a1[u].w, bb.w, acc, 0, 0, 0); }
                }
#pragma unroll
                for (int q = 0; q < 16; ++q) { const int r = rg * 32 + (q & 3) + 8 * (q >> 2) + 4 * hh; part[(kh * 128 + r) * 33 + i] = acc[q]; }
            }
            __syncthreads();
            if (F.tid < 128) {
                const int r = F.tid; const float rstd = rs[r];
                float best[4]; int bi[4];
                for (int e = 0; e < 32; ++e) part[r * 33 + e] = (part[r * 33 + e] + part[(128 + r) * 33 + e]) * rstd + b_r[e];
#pragma unroll
                for (int k = 0; k < 4; ++k) {
                    float bv = -INFINITY; int be = 0;
                    for (int e = 0; e < 32; ++e) { const float l = part[r * 33 + e]; if (l > bv) { bv = l; be = e; } }
                    best[k] = bv; bi[k] = be; part[r * 33 + be] = -INFINITY;
                }
                const float e1 = __expf(best[1] - best[0]), e2 = __expf(best[2] - best[0]), e3 = __expf(best[3] - best[0]);
                const float inv = 1.f / (1.f + e1 + e2 + e3);
                *(int4*)(topi + (size_t)(row0 + r) * 4) = make_int4(bi[0], bi[1], bi[2], bi[3]);
                *(f32x4*)(topg + (size_t)(row0 + r) * 4) = (f32x4){inv, e1 * inv, e2 * inv, e3 * inv};
#pragma unroll
                for (int k = 0; k < 4; ++k) __hip_atomic_fetch_add(&hist[bi[k]], 1, __ATOMIC_RELAXED, __HIP_MEMORY_SCOPE_WORKGROUP);
            }
            __syncthreads();
            if (F.tid < 32) CNT[tb * 32 + F.tid] = hist[F.tid];
            __syncthreads();
        }
        if (BOTH(9)) GRID_BAR();
    }
    if (IN(10)) {
        { int tq_ = threadIdx.x; asm volatile("" : "+v"(tq_)); F.tid = tq_; F.lane = tq_ & 63; }
        LAS int* sb = (LAS int*)(F.lds);
        for (int tb = blockIdx.x; tb < T / 128; tb += F.G) {
            const int e = F.tid & 31, pt = F.tid >> 5;
            int sbef = 0, stot = 0;
            for (int w = pt * 16; w < pt * 16 + 16; ++w) { const int c = __hip_atomic_load(CNT + w * 32 + e, RLX_AGENT); stot += c; if (w < tb) sbef += c; }
            sb[pt * 32 + e] = sbef; sb[512 + pt * 32 + e] = stot;
            __syncthreads();
            if (F.tid < 32) { int b = 0, t = 0; for (int p = 0; p < 16; ++p) { b += sb[p * 32 + F.tid]; t += sb[512 + p * 32 + F.tid]; } sb[1024 + F.tid] = b; sb[1056 + F.tid] = t; sb[1120 + F.tid] = 0; }
            __syncthreads();
            if (F.tid == 0) { int ps = 0; for (int q = 0; q < 32; ++q) { sb[1088 + q] = ps; ps += ((sb[1056 + q] + MT - 1) / MT) * MT; } }
            __syncthreads();
            if (tb == 0 && F.tid < 32) ecnt[F.tid] = sb[1056 + F.tid];
            {
                const int a = tb * 512 + F.tid; const int ex = topi[a];
                const int lp = __hip_atomic_fetch_add(&sb[1120 + ex], 1, __ATOMIC_RELAXED, __HIP_MEMORY_SCOPE_WORKGROUP);
                const int slot = sb[1088 + ex] + sb[1024 + ex] + lp;
                slot_tok[slot] = a >> 2; tok_slot[a] = slot;
            }
            __syncthreads();
        }
        if (BOTH(10)) GRID_BAR();
    }
    if (IN(11) || IN(12)) {
        { int tq_ = threadIdx.x; asm volatile("" : "+v"(tq_)); F.tid = tq_; F.lane = tq_ & 63; }
        LAS int* til = (LAS int*)(F.lds + TIL_OFF);
        if (F.tid == 0) { int nt = 0; for (int e = 0; e < NE; ++e) { const int c = __hip_atomic_load(ecnt + e, RLX_AGENT); for (int r = 0; r < c; r += MT) { til[nt] = e; til[MAXTILES + nt] = (c - r) < MT ? (c - r) : MT; ++nt; } } til[2 * MAXTILES] = nt; }
        __syncthreads();
        if (IN(11)) {
            MoeSched S{(const char*)HN8, (const char*)WUP8, slot_tok, til, (LAS int*)(F.lds + IDX_OFF), D, D, 8, 2 * FF, F.G, (int)blockIdx.x, 1};
            pg::EpiUp E{args.in[22], ACT8};
            pg::gemm_phase<pg::EpiUp, MoeSched, true, true>(F.lds, D, S, E);
            if (BOTH(11)) GRID_BAR();
        }
        if (IN(12)) {
            MoeSched S{(const char*)ACT8, (const char*)WDN8, slot_tok, til, (LAS int*)(F.lds + IDX_OFF), FF, FF, 4, D, F.G, (int)blockIdx.x, 0};
            pg::EpiDown E{args.in[24], YS};
            pg::gemm_phase<pg::EpiDown, MoeSched, true, true>(F.lds, FF, S, E);
            if (BOTH(12)) GRID_BAR();
        }
    }
    if (IN(13)) {
        { int tq_ = threadIdx.x; asm volatile("" : "+v"(tq_)); F.tid = tq_; F.lane = tq_ & 63; }
        const float* gfin = args.in[25]; float* out = args.out;
        for (int row = gw; row < T; row += NGW) {
            f32x4 v[4];
#pragma unroll
            for (int j = 0; j < 4; ++j) v[j] = *(const f32x4*)(H + (size_t)row * D + 4 * F.lane + 256 * j);
            const int4 sl = *(const int4*)(tok_slot + (size_t)row * 4); const f32x4 gt = *(const f32x4*)(topg + (size_t)row * 4);
#pragma unroll
            for (int k = 0; k < 4; ++k) {
                const int s = k == 0 ? sl.x : k == 1 ? sl.y : k == 2 ? sl.z : sl.w;
#pragma unroll
                for (int j = 0; j < 4; ++j) { const uint2 y = *(const uint2*)(YS + (size_t)s * D + 4 * F.lane + 256 * j);
                    v[j].x += gt[k] * lo_bf(y.x); v[j].y += gt[k] * hi_bf(y.x); v[j].z += gt[k] * lo_bf(y.y); v[j].w += gt[k] * hi_bf(y.y); }
            }
            float ss = 0.f;
#pragma unroll
            for (int j = 0; j < 4; ++j) ss += v[j].x * v[j].x + v[j].y * v[j].y + v[j].z * v[j].z + v[j].w * v[j].w;
            ss = wave_sum(ss);
            const float rstd = rsqrtf(ss * (1.f / D) + 1e-5f);
#pragma unroll
            for (int j = 0; j < 4; ++j) { const f32x4 gg = *(const f32x4*)(gfin + 4 * F.lane + 256 * j); *(f32x4*)(out + (size_t)row * D + 4 * F.lane + 256 * j) = v[j] * rstd * gg; }
        }
    }
#undef IN
#undef BOTH
}

extern "C" void kernel_launch(void* const* d_in, const int* in_sizes, int n_in, void* d_out, int out_size, void* d_ws, size_t ws_size, hipStream_t stream) {
    static int grid = 0;
    if (grid == 0) {
        int dev = 0, cus = 0, per_cu = 0;
        if (n_in != 26 || ws_size < WS_END) { fprintf(stderr, "kernel_launch: unexpected n_in %d / ws %zu\n", n_in, ws_size); grid = -1; return; }
        if (hipGetDevice(&dev) != hipSuccess || hipDeviceGetAttribute(&cus, hipDeviceAttributeMultiprocessorCount, dev) != hipSuccess) { grid = -1; return; }
        if (hipFuncSetAttribute((const void*)fwd, hipFuncAttributeMaxDynamicSharedMemorySize, LDS_BYTES) != hipSuccess) { fprintf(stderr, "kernel_launch: hipFuncSetAttribute failed\n"); grid = -1; return; }
        if (hipOccupancyMaxActiveBlocksPerMultiprocessor(&per_cu, (const void*)fwd, NTHR, LDS_BYTES) != hipSuccess || per_cu < 1) fprintf(stderr, "kernel_launch: occupancy query reports %d\n", per_cu);
        (void)hipGetLastError();
        grid = cus;
    }
    if (grid < 0) return;
    (void)in_sizes; (void)out_size;
    unsigned char* ws = (unsigned char*)d_ws;
    (void)hipMemsetAsync(ws + WS_CTL, 0, CTL_ZERO_BYTES, stream);
    Args a{};
    for (int i = 0; i < 26; ++i) a.in[i] = (const float*)d_in[i];
    a.out = (float*)d_out; a.ws = ws;
    a.ph_lo = 0; a.ph_hi = 14; a.li = 0; a.pad = 0;
    hipLaunchKernelGGL(fwd, dim3(grid), dim3(NTHR), LDS_BYTES, stream, a);
#if PROBE_LO >= 0
    a.ph_lo = PROBE_LO; a.ph_hi = PROBE_HI; a.li = 1; a.pad = PROBE_PAD;
    hipLaunchKernelGGL(fwd, dim3(grid), dim3(NTHR), LDS_BYTES, stream, a);
#endif
}
```

```cpp
#include <hip/hip_runtime.h>
#include <cstdio>
#include <cstdint>

#define GAS __attribute__((address_space(1)))
#define LAS __attribute__((address_space(3)))
typedef unsigned short bf16;
typedef short bf16x8 __attribute__((ext_vector_type(8)));
typedef float f32x4 __attribute__((ext_vector_type(4)));
typedef float f32x16 __attribute__((ext_vector_type(16)));
typedef unsigned u32x4 __attribute__((ext_vector_type(4)));
typedef unsigned u32x2 __attribute__((ext_vector_type(2)));
typedef GAS unsigned gu32;

#define PROBE_LO -1
#define PROBE_HI -1
#define PROBE_PAD 0
constexpr int NB = 4, SEQ = 8192, T = NB * SEQ, D = 1024;
constexpr int DIN = 2568, NPROJ = 2560;
constexpr int O_Q = 512, O_K = 1024, O_V = 1536, O_O = 2048, O_G = 2560;
constexpr int NE = 32, TOPK = 4, FF = 1024;
constexpr int NASSIGN = T * TOPK;
constexpr int MT = 256;
constexpr int NSLOTS = NASSIGN + NE * MT;
constexpr int MAXTILES = NSLOTS / MT;
constexpr int NWAVES = 8, NTHR = 512;
constexpr float W8_SCALE = 64.f, W8_INV = 1.f / 64.f;

constexpr size_t MiB = 1u << 20;
constexpr size_t WS_CTL = 0, CTL_ZERO_BYTES = 1 * MiB;
constexpr size_t WS_GATES = 1 * MiB;
constexpr size_t WS_TOPI = 2 * MiB;
constexpr size_t WS_TOPG = 3 * MiB;
constexpr size_t WS_SLOTTOK = 4 * MiB;
constexpr size_t WS_TOKSLOT = 5 * MiB;
constexpr size_t WS_CNT = 6 * MiB;
constexpr size_t WS_WIN = 8 * MiB;
constexpr size_t WS_WGLU = 13 * MiB;
constexpr size_t WS_WOUT = 14 * MiB;
constexpr size_t WS_WUP = 16 * MiB;
constexpr size_t WS_WDN = 144 * MiB;
constexpr size_t WS_HN = 208 * MiB;
constexpr size_t WS_PROJ = 272 * MiB;
constexpr size_t WS_GY = 432 * MiB;
constexpr size_t WS_MIX = 464 * MiB;
constexpr size_t WS_HRAW = 528 * MiB;
constexpr size_t WS_ACT = 272 * MiB;
constexpr size_t WS_H = 592 * MiB;
constexpr size_t WS_YS = 720 * MiB;
constexpr size_t WS_END = 992 * MiB;
constexpr int S5K = 1152;
constexpr size_t WS_S5A = 720 * MiB;
constexpr size_t WS_S5BT = 760 * MiB;
constexpr size_t WS_S5BQ = 836 * MiB;
constexpr size_t WS_XLOC = 856 * MiB;
constexpr size_t WS_QH = 866 * MiB;
constexpr size_t WS_KH = 898 * MiB;
constexpr size_t WS_VT = 930 * MiB;
constexpr size_t WS_DC = 962 * MiB;
constexpr size_t WS_CST = 978 * MiB;
constexpr size_t WS_FLOC = 986 * MiB;
constexpr size_t WS_DN = 987 * MiB;
constexpr size_t WS_NST = 988 * MiB;
constexpr size_t WS_SEGS = 989 * MiB;
constexpr size_t WS_KTAB = 990 * MiB;
static_assert(WS_S5A + (size_t)32 * 512 * S5K * 2 <= WS_S5BT && WS_S5BT + (size_t)32 * 1024 * S5K * 2 <= WS_S5BQ && WS_S5BQ + (size_t)32 * 256 * 1024 * 2 <= WS_XLOC && WS_XLOC + (size_t)32 * 512 * 128 * 4 <= WS_END, "s5 map");
static_assert(WS_ACT + (size_t)NSLOTS * FF * 2 <= WS_H && WS_YS + (size_t)NSLOTS * D * 2 <= WS_END, "ws map");
constexpr int CW_BAR = 4096;

constexpr int RING_BYTES = 131072;
constexpr int MISC_OFF = RING_BYTES;
constexpr int IDX_OFF = MISC_OFF + 128;
constexpr int TIL_OFF = IDX_OFF + 2048;
constexpr int BIAS_OFF = TIL_OFF + 3 * MAXTILES * 4 + 256;
constexpr int LDS_BYTES = 147456;
static_assert(BIAS_OFF + 3 * 1024 <= LDS_BYTES && (BIAS_OFF & 15) == 0, "LDS map");

#define RLX_AGENT __ATOMIC_RELAXED, __HIP_MEMORY_SCOPE_AGENT
__device__ __forceinline__ float bf2f(bf16 v) { return __uint_as_float(((unsigned)v) << 16); }
__device__ __forceinline__ bf16 f2bf(float f) { unsigned u = __float_as_uint(f); u += 0x7fffu + ((u >> 16) & 1u); return (bf16)(u >> 16); }
__device__ __forceinline__ unsigned pk2(float lo, float hi) { return (unsigned)f2bf(lo) | ((unsigned)f2bf(hi) << 16); }
__device__ __forceinline__ unsigned cvt_pk_bf16(float lo, float hi) { unsigned r; asm volatile("v_cvt_pk_bf16_f32 %0, %1, %2" : "=v"(r) : "v"(lo), "v"(hi)); return r; }
__device__ __forceinline__ unsigned pk4_fp8(float a, float b, float c, float d) { unsigned w = 0u; w = __builtin_amdgcn_cvt_pk_fp8_f32(a, b, w, false); w = __builtin_amdgcn_cvt_pk_fp8_f32(c, d, w, true); return w; }
__device__ __forceinline__ float lo_bf(unsigned u) { return __uint_as_float(u << 16); }
__device__ __forceinline__ float hi_bf(unsigned u) { return __uint_as_float(u & 0xffff0000u); }
__device__ __forceinline__ float wave_sum(float v) {
#pragma unroll
    for (int o = 1; o < 64; o <<= 1) v += __shfl_xor(v, o);
    return v;
}
__device__ __forceinline__ float sigmoidf_(float x) { return __builtin_amdgcn_rcpf(1.f + __builtin_amdgcn_exp2f(-1.4426950408889634f * x)); }
__device__ __forceinline__ float gelu_tanh(float x) { const float u = 1.5957691216057308f * (x + 0.044715f * x * x * x); return x * __builtin_amdgcn_rcpf(1.f + __builtin_amdgcn_exp2f(-1.4426950408889634f * u)); }

#define XB_TMO      128
#define XB_XCNT(j)  (256  + 64 * (j))
#define XB_XSUB(j)  (1280 + 64 * (j))
#define XB_XGEN(j)  (2304 + 64 * (j))
#define XB_TOP      3328
#define XB_TOPGEN   3392
#define XCD_BAR_WORDS 3456
#define XB_SPIN_CAP (1u << 18)
__device__ __forceinline__ unsigned xb_ld(unsigned* p)              { return __hip_atomic_load(p, __ATOMIC_RELAXED, __HIP_MEMORY_SCOPE_AGENT); }
__device__ __forceinline__ unsigned xb_add(unsigned* p, unsigned v) { return __hip_atomic_fetch_add(p, v, __ATOMIC_RELAXED, __HIP_MEMORY_SCOPE_AGENT); }
__device__ __forceinline__ unsigned xb_xcc_id() { return (unsigned)__builtin_amdgcn_s_getreg((3 << 11) | 20) & 0xFu; }
#define XB_SPIN(cond, bar) do { unsigned _sp = 0; while (cond) { __builtin_amdgcn_s_sleep(1); \
    if ((++_sp & 255u) == 0u) { if (xb_ld(&(bar)[XB_TMO])) break; if (_sp > XB_SPIN_CAP) { atomicAdd(&(bar)[XB_TMO], 1u); break; } } } } while (0)
struct XcdBarrier { unsigned* bar; unsigned x; volatile LAS unsigned* st; };
__device__ __forceinline__ XcdBarrier xcd_barrier_post(unsigned* bar, volatile LAS unsigned* st) {
    XcdBarrier b; b.bar = bar; b.x = xb_xcc_id(); b.st = st;
    if (threadIdx.x == 0) (void)xb_add(&bar[XB_XCNT(b.x)], 1u);
    return b;
}
__device__ __forceinline__ void xcd_barrier_complete(unsigned* bar, unsigned x, unsigned& nloc, unsigned& nx) {
    const unsigned G = gridDim.x * gridDim.y * gridDim.z;
    unsigned sum, cnt, mine, sp = 0u;
    for (;;) {
        sum = 0u; cnt = 0u; mine = 0u;
#pragma unroll
        for (unsigned j = 0; j < 16; ++j) { const unsigned c = xb_ld(&bar[XB_XCNT(j)]); sum += c; cnt += (c > 0u) ? 1u : 0u; mine = (j == x) ? c : mine; }
        if (sum == G) break;
        __builtin_amdgcn_s_sleep(1);
        if ((++sp & 255u) == 0u) { if (xb_ld(&bar[XB_TMO])) break; if (sp > XB_SPIN_CAP) { atomicAdd(&bar[XB_TMO], 1u); break; } }
    }
    nloc = mine > 0u ? mine : 1u; nx = cnt > 0u ? cnt : 1u;
}
__device__ __forceinline__ void xcd_barrier(const XcdBarrier& b) {
    asm volatile("s_waitcnt vmcnt(0)" ::: "memory");
    __syncthreads();
    if (threadIdx.x == 0) {
        unsigned* bar = b.bar;
        __builtin_amdgcn_s_waitcnt(0);
        unsigned nloc = b.st[0], nx = b.st[1];
        if (nloc == 0u) { xcd_barrier_complete(bar, b.x, nloc, nx); b.st[0] = nloc; b.st[1] = nx; }
        const unsigned old = xb_add(&bar[XB_XSUB(b.x)], 1u);
        const unsigned gen = old / nloc;
        if (old + 1u == (gen + 1u) * nloc) {
            __builtin_amdgcn_fence(__ATOMIC_RELEASE, "agent");
            asm volatile("s_waitcnt vmcnt(0)" ::: "memory");
            const unsigned og = xb_add(&bar[XB_TOP], 1u);
            const unsigned tg = og / nx;
            if (og + 1u == (tg + 1u) * nx) xb_add(&bar[XB_TOPGEN], 1u);
            else XB_SPIN(xb_ld(&bar[XB_TOPGEN]) == tg, bar);
            __builtin_amdgcn_fence(__ATOMIC_ACQUIRE, "agent");
            xb_add(&bar[XB_XGEN(b.x)], 1u);
            asm volatile("s_waitcnt vmcnt(0)" ::: "memory");
        } else {
            XB_SPIN(xb_ld(&bar[XB_XGEN(b.x)]) == gen, bar);
            __builtin_amdgcn_fence(__ATOMIC_ACQUIRE, "agent");
            asm volatile("s_waitcnt vmcnt(0)" ::: "memory");
        }
    }
    __syncthreads();
}

namespace pg {
constexpr int BM = 256, BK = 64, HALF = 128, HTB = HALF * BK * 2, STAGE_BYTES = 8 * HTB, NXCD = 8, WGM = 8;
__host__ __device__ __forceinline__ int lds_byte(int r, int c) { const int st = (r >> 4) * 2 + (c >> 5), rr = r & 15, cc = c & 31, ob = rr * 64 + cc * 2; return st * 1024 + (ob ^ (((ob >> 9) & 1) << 5)); }
__host__ __device__ __forceinline__ void stage_rc(int b, int& R, int& C) { const int st = b / 1024, sb = b % 1024, swz = sb ^ (((sb >> 9) & 1) << 5); R = (st >> 1) * 16 + swz / 64; C = (st & 1) * 32 + (swz % 64) / 2; }
__host__ __device__ __forceinline__ int perm32(int rho) { const int n = rho >> 4, i = rho & 15; return 8 * (i >> 2) + 4 * n + (i & 3); }

struct Unit { unsigned A, B; int pm, pn, e, nrows; };
__device__ __forceinline__ __amdgpu_buffer_rsrc_t mkrsrc(const void* p) { return __builtin_amdgcn_make_buffer_rsrc((void*)p, 0, 0x7fffffff, 0x00020000); }

__device__ __forceinline__ bool tile_order(int i, int G, int c, int nM, int nN, int& pm, int& pn) {
    const int nwg = nM * nN; const long L = (long)i * G + c; if (L >= nwg) return false;
    int wgid = (int)L; { const int q = nwg / NXCD, r = nwg % NXCD, xcd = wgid % NXCD, off = wgid / NXCD; wgid = (xcd < r ? xcd * (q + 1) : r * (q + 1) + (xcd - r) * q) + off; }
    const int nig = WGM * nN, gid = wgid / nig, fm = gid * WGM, gsz = (nM - fm) < WGM ? (nM - fm) : WGM;
    pm = fm + ((wgid % nig) % gsz); pn = (wgid % nig) / gsz; return true;
}
struct DenseSched {
    const char* A; const char* Bt; int lda2  , K2  , nM, nN, G, c;
    __device__ __forceinline__ bool next(int i, Unit& u) const { int pm, pn; if (!tile_order(i, G, c, nM, nN, pm, pn)) return false;
        u.A = (unsigned)pm * 256u * (unsigned)lda2; u.B = (unsigned)pn * 256u * (unsigned)K2; u.pm = pm; u.pn = pn; u.e = 0; u.nrows = 256; return true; }
    __device__ __forceinline__ __amdgpu_buffer_rsrc_t rsrcA() const { return mkrsrc(A); }
    __device__ __forceinline__ __amdgpu_buffer_rsrc_t rsrcB() const { return mkrsrc(Bt); }
    __device__ __forceinline__ void prefetch(const Unit&, int, int) const {}
    __device__ __forceinline__ unsigned aoff(const Unit&, int row, int) const { return (unsigned)row * (unsigned)lda2; }
};

typedef int i32x8 __attribute__((ext_vector_type(8)));
template <class Epi, class Sched, bool ALIGN_EPI, bool FP8 = false>
__device__ __forceinline__ void gemm_phase(LAS unsigned char* lds, const int K, const Sched& S, const Epi& E) {
    const int tid = threadIdx.x, wid = __builtin_amdgcn_readfirstlane(tid >> 6), lane = tid & 63, wr = wid >> 2, wc = wid & 3, fr = lane & 15, fq = lane >> 4;
    const int nt = FP8 ? K / 128 : K / BK;
    unsigned voffA[2][2], voffB[2];
#pragma unroll
    for (int i = 0; i < 1; ++i) { int R, C; if constexpr (FP8) { const int p = tid + 512 * i; R = p >> 3; C = (((p >> 1) & 3) ^ ((R >> 1) & 3)) * 32 + (p & 1) * 16; } else { stage_rc(tid * 16 + i * 8192, R, C); C *= 2; }
        const int Rb = Epi::PERM ? ((R & ~31) + perm32(R & 31)) : R; voffB[i] = (unsigned)(Rb * K * (FP8 ? 1 : 2) + C); }
    const unsigned kstep = (unsigned)(BK * 2);
    const unsigned hstep = (unsigned)HALF * K * (FP8 ? 1 : 2);
    const unsigned b64step = hstep / 2;
    const unsigned ldsw = (unsigned)wid * 1024u;
    const int aoff = FP8 ? (wr * 64 + fr) * 128 + ((fq ^ ((fr >> 1) & 3)) * 32) : lds_byte(wr * 64 + fr, fq * 8);
    const int boff = FP8 ? (wc * 32 + fr) * 128 + ((fq ^ ((fr >> 1) & 3)) * 32) : lds_byte(wc * 32 + fr, fq * 8);
#define PG_SA(b, h) (((b) * 2 + (h)) * HTB)
#define PG_SB(b, h) ((4 + (b) * 2 + (h)) * HTB)
#define PG_STAGE(bufoff, so, voff) do { _Pragma("unroll") for (int _i = 0; _i < 2; ++_i) \
        __builtin_amdgcn_raw_ptr_buffer_load_lds(rA, (LAS void*)(lds + (bufoff) + ldsw + _i * 8192), 16, (int)(voff)[_i], (int)(so), 0, 0); } while (0)
#define PG_STAGEB(bufoff, so) do { _Pragma("unroll") for (int _i = 0; _i < 2; ++_i) \
        __builtin_amdgcn_raw_ptr_buffer_load_lds(rB, (LAS void*)(lds + (bufoff) + ldsw + _i * 8192), 16, (int)voffB[0], (int)((so) + _i * b64step), 0, 0); } while (0)
#define PG_LD8(p, p2) __builtin_bit_cast(i32x8, __builtin_shufflevector(*(const LAS u32x4*)(p), *(const LAS u32x4*)(p2), 0, 1, 2, 3, 4, 5, 6, 7))
#define PG_LDA(dst, b, h) do { if constexpr (FP8) { _Pragma("unroll") for (int m = 0; m < 4; ++m) dst##8[m] = PG_LD8(lds + PG_SA(b, h) + aoff + m * 2048, lds + PG_SA(b, h) + aoff + m * 2048 + 16); } \
        else { _Pragma("unroll") for (int m = 0; m < 4; ++m) _Pragma("unroll") for (int k = 0; k < 2; ++k) dst[m][k] = *(const LAS bf16x8*)(lds + PG_SA(b, h) + aoff + m * 2048 + k * 1024); } } while (0)
#define PG_LDB(dst, b, h) do { if constexpr (FP8) { _Pragma("unroll") for (int n = 0; n < 2; ++n) dst##8[n] = PG_LD8(lds + PG_SB(b, h) + boff + n * 2048, lds + PG_SB(b, h) + boff + n * 2048 + 16); } \
        else { _Pragma("unroll") for (int n = 0; n < 2; ++n) _Pragma("unroll") for (int k = 0; k < 2; ++k) dst[n][k] = *(const LAS bf16x8*)(lds + PG_SB(b, h) + boff + n * 2048 + k * 1024); } } while (0)
#define PG_MMA(ai, bj, At, Bt) do { __builtin_amdgcn_s_setprio(1); if constexpr (FP8) { _Pragma("unroll") for (int m = 0; m < 4; ++m) _Pragma("unroll") for (int n = 0; n < 2; ++n) \
            acc[ai][bj][m][n] = __builtin_amdgcn_mfma_scale_f32_16x16x128_f8f6f4(Bt##8[n], At##8[m], acc[ai][bj][m][n], 0, 0, 0, 0, 0, 0); } \
        else { _Pragma("unroll") for (int m = 0; m < 4; ++m) _Pragma("unroll") for (int n = 0; n < 2; ++n) _Pragma("unroll") for (int k = 0; k < 2; ++k) \
            acc[ai][bj][m][n] = __builtin_amdgcn_mfma_f32_16x16x32_bf16(Bt[n][k], At[m][k], acc[ai][bj][m][n], 0, 0, 0); } __builtin_amdgcn_s_setprio(0); } while (0)
#define PG_WAIT_V(n) asm volatile("s_waitcnt vmcnt(" #n ")" ::: "memory")
#define PG_WAIT_L(n) asm volatile("s_waitcnt lgkmcnt(" #n ")" ::: "memory")
#define PG_BAR __builtin_amdgcn_s_barrier()
#define PG_SCHED __builtin_amdgcn_sched_barrier(0)
#define PG_SET_AOFF(u, ib) do { int _t = threadIdx.x; asm volatile("" : "+v"(_t));     \
        _Pragma("unroll") for (int _i = 0; _i < 2; ++_i) { int _R, _C; if constexpr (FP8) { const int _p = _t + 512 * _i; _R = _p >> 3; _C = (((_p >> 1) & 3) ^ ((_R >> 1) & 3)) * 32 + (_p & 1) * 16; } else { stage_rc(_t * 16 + _i * 8192, _R, _C); _C *= 2; } \
        voffA[0][_i] = S.aoff(u, _R, ib) + (unsigned)_C; voffA[1][_i] = S.aoff(u, _R + HALF, ib) + (unsigned)_C; } } while (0)
    Unit cur, nxt; int ui = 0;
    if (!S.next(0, cur)) return;
    f32x4 acc[2][2][4][2];
#pragma unroll
    for (int a = 0; a < 2; ++a)
#pragma unroll
        for (int b = 0; b < 2; ++b)
#pragma unroll
            for (int m = 0; m < 4; ++m)
#pragma unroll
                for (int n = 0; n < 2; ++n) acc[a][b][m][n] = (f32x4){0.f, 0.f, 0.f, 0.f};
    bf16x8 At[FP8 ? 1 : 4][2], B0[2][2], B1[2][2]; i32x8 At8[FP8 ? 4 : 1], B08[2], B18[2];
    const __amdgpu_buffer_rsrc_t rA = S.rsrcA(), rB = S.rsrcB();
    unsigned cA = cur.A, cB = cur.B;
    S.prefetch(cur, 0, 0);
    PG_WAIT_V(0); __syncthreads();
    PG_SET_AOFF(cur, 0);
    PG_STAGEB(PG_SB(0, 0), cB); PG_STAGEB(PG_SB(0, 1), cB + hstep); PG_STAGE(PG_SA(0, 0), cA, voffA[0]); PG_STAGE(PG_SA(0, 1), cA, voffA[1]);
    if (wr == 1) PG_BAR;
    PG_WAIT_V(2); PG_BAR;
    PG_STAGEB(PG_SB(1, 0), cB + kstep); PG_STAGE(PG_SA(1, 0), cA + kstep, voffA[0]); PG_STAGEB(PG_SB(1, 1), cB + hstep + kstep);
    PG_WAIT_V(6); PG_BAR;
    for (;;) {
        const bool has_next = S.next(ui + 1, nxt);
        const unsigned nA = has_next ? nxt.A : cA, nB = has_next ? nxt.B : cB;
        if (has_next) S.prefetch(nxt, (ui + 1) & 1, (ui + 1) % 3);
#pragma unroll 1
        for (int t = 0; t < nt; t += 2) {
            const bool last = (t == nt - 2);
            const unsigned a1 = cA + (unsigned)(t + 1) * kstep;
            const unsigned a2 = last ? nA : cA + (unsigned)(t + 2) * kstep, b2 = last ? nB : cB + (unsigned)(t + 2) * kstep;
            const unsigned a3 = a2 + kstep, b3 = b2 + kstep;
            PG_LDB(B0, 0, 0); PG_LDB(B1, 0, 1); PG_SCHED; PG_LDA(At, 0, 0); PG_STAGE(PG_SA(1, 1), a1, voffA[1]);
            PG_WAIT_V(8); PG_WAIT_L(0); PG_BAR; PG_MMA(0, 0, At, B0); PG_MMA(0, 1, At, B1); PG_BAR; PG_SCHED;
            if (last && has_next) PG_SET_AOFF(nxt, (ui + 1) & 1);
            PG_LDA(At, 0, 1); PG_STAGEB(PG_SB(0, 0), b2); PG_STAGEB(PG_SB(0, 1), b2 + hstep); PG_STAGE(PG_SA(0, 0), a2, voffA[0]);
            PG_WAIT_V(8); PG_WAIT_L(0); PG_BAR; PG_MMA(1, 0, At, B0); PG_MMA(1, 1, At, B1); PG_BAR; PG_SCHED;
            PG_LDB(B0, 1, 0); PG_LDB(B1, 1, 1); PG_SCHED; PG_LDA(At, 1, 0); PG_STAGE(PG_SA(0, 1), a2, voffA[1]);
            PG_WAIT_V(8); PG_WAIT_L(0); PG_BAR; PG_MMA(0, 0, At, B0); PG_MMA(0, 1, At, B1); PG_BAR; PG_SCHED;
            PG_LDA(At, 1, 1); PG_STAGEB(PG_SB(1, 0), b3); PG_STAGEB(PG_SB(1, 1), b3 + hstep); PG_STAGE(PG_SA(1, 0), a3, voffA[0]);
            PG_WAIT_V(8); PG_WAIT_L(0); PG_BAR; PG_MMA(1, 0, At, B0); PG_MMA(1, 1, At, B1); PG_BAR; PG_SCHED;
        }
        if constexpr (ALIGN_EPI) { if (wr == 0) PG_BAR; }
        {
            int tz = threadIdx.x; asm volatile("" : "+v"(tz)); const int lz = tz & 63;
            E(acc, cur, ui % 3, (tz >> 6) >> 2, (tz >> 6) & 3, lz & 15, lz >> 4);
        }
        if (!has_next) break;
#pragma unroll
        for (int a = 0; a < 2; ++a)
#pragma unroll
            for (int b = 0; b < 2; ++b)
#pragma unroll
                for (int m = 0; m < 4; ++m)
#pragma unroll
                    for (int n = 0; n < 2; ++n) acc[a][b][m][n] = (f32x4){0.f, 0.f, 0.f, 0.f};
        cur = nxt; cA = nA; cB = nB; ++ui;
        if constexpr (ALIGN_EPI) { if (wr == 1) PG_BAR; }
    }
    PG_WAIT_V(0);
    if constexpr (!ALIGN_EPI) { if (wr == 0) PG_BAR; }
    PG_BAR;
#undef PG_SA
#undef PG_SB
#undef PG_STAGE
#undef PG_STAGEB
#undef PG_LDA
#undef PG_LDB
#undef PG_MMA
#undef PG_LD8
#undef PG_WAIT_V
#undef PG_WAIT_L
#undef PG_BAR
#undef PG_SCHED
#undef PG_SET_AOFF
}

struct EpiProj {
    static constexpr bool PERM = true; bf16* P; bf16* S5A;
    __device__ __forceinline__ void operator()(const f32x4 (&acc)[2][2][4][2], const Unit& u, int bb, int wr, int wc, int fr, int fq) const {
        const int row0 = u.pm * BM + wr * 64 + fr, col0 = u.pn * BM + wc * 32 + 8 * fq;
#pragma unroll
        for (int ai = 0; ai < 2; ++ai)
#pragma unroll
            for (int m = 0; m < 4; ++m) { const int row = row0 + ai * HALF + m * 16; bf16* rowp = P + (size_t)row * NPROJ + col0;
                if (u.pn < 2) { const int b = row >> 13, tt = row & 8191; rowp = S5A + ((size_t)b * 128 + (tt >> 6)) * S5K + (tt & 63) * 16 + (col0 & 15) + (size_t)(col0 >> 4) * 512 * S5K - (size_t)0; }
#pragma unroll
                for (int bj = 0; bj < 2; ++bj) { const f32x4 v0 = acc[ai][bj][m][0], v1 = acc[ai][bj][m][1];
                    u32x4 w; w.x = cvt_pk_bf16(v0[0], v0[1]); w.y = cvt_pk_bf16(v0[2], v0[3]); w.z = cvt_pk_bf16(v1[0], v1[1]); w.w = cvt_pk_bf16(v1[2], v1[3]);
                    *(u32x4*)(rowp + (u.pn < 2 ? (size_t)bj * 8 * 512 * S5K : (size_t)bj * HALF)) = w; } }
    }
};
struct EpiXloc {
    static constexpr bool PERM = false; float* X;
    __device__ __forceinline__ void operator()(const f32x4 (&acc)[2][2][4][2], const Unit& u, int bb, int wr, int wc, int fr, int fq) const {
        const int row0 = (u.pm & 1) * BM + wr * 64 + fr, col0 = wc * 32 + 4 * fq;
#pragma unroll
        for (int ai = 0; ai < 2; ++ai)
#pragma unroll
            for (int m = 0; m < 4; ++m) { float* rp = X + ((size_t)u.e * 512 + row0 + ai * HALF + m * 16) * 128 + col0;
#pragma unroll
                for (int n = 0; n < 2; ++n) *(f32x4*)(rp + n * 16) = acc[ai][0][m][n]; }
    }
};
struct EpiS5Y {
    static constexpr bool PERM = true; const bf16* S5A; const float* dskip; bf16* GY;
    __device__ __forceinline__ void operator()(const f32x4 (&acc)[2][2][4][2], const Unit& u, int bb, int wr, int wc, int fr, int fq) const {
        const int g = u.e, rg0 = (u.pm & 1) * BM + wr * 64 + fr, c0 = u.pn * BM + wc * 32 + 8 * fq;
#pragma unroll
        for (int bj = 0; bj < 2; ++bj) { const int col = c0 + bj * HALF, t = col >> 4, p0 = col & 15;
            const f32x4 d0 = *(const f32x4*)(dskip + g * 16 + p0), d1 = *(const f32x4*)(dskip + g * 16 + p0 + 4);
#pragma unroll
            for (int ai = 0; ai < 2; ++ai)
#pragma unroll
                for (int m = 0; m < 4; ++m) { const int rg = rg0 + ai * HALF + m * 16; const int b = rg >> 7, c = rg & 127;
                    const u32x4 uu = *(const u32x4*)(S5A + ((size_t)g * 512 + rg) * S5K + col);
                    const f32x4 v0 = acc[ai][bj][m][0], v1 = acc[ai][bj][m][1];
                    u32x4 w;
                    w.x = cvt_pk_bf16(gelu_tanh(v0[0] + d0[0] * lo_bf(uu.x)), gelu_tanh(v0[1] + d0[1] * hi_bf(uu.x))); w.y = cvt_pk_bf16(gelu_tanh(v0[2] + d0[2] * lo_bf(uu.y)), gelu_tanh(v0[3] + d0[3] * hi_bf(uu.y)));
                    w.z = cvt_pk_bf16(gelu_tanh(v1[0] + d1[0] * lo_bf(uu.z)), gelu_tanh(v1[1] + d1[1] * hi_bf(uu.z))); w.w = cvt_pk_bf16(gelu_tanh(v1[2] + d1[2] * lo_bf(uu.w)), gelu_tanh(v1[3] + d1[3] * hi_bf(uu.w)));
                    *(u32x4*)(GY + ((size_t)b * SEQ + c * 64 + t) * 512 + g * 16 + p0) = w; } }
    }
};
struct S5Sched {
    const char* A; const char* B; int lda2, K2, brows, nN, G, c;
    __device__ __forceinline__ bool next(int i, Unit& u) const { const int L = i * G + c; if (L >= 64 * nN) return false;
        const int g = L / (2 * nN), r = L % (2 * nN), mh = r / nN, pn = r % nN;
        u.A = ((unsigned)g * 512u + mh * 256u) * (unsigned)lda2; u.B = ((unsigned)g * brows + pn * 256u) * (unsigned)K2; u.pm = g * 2 + mh; u.pn = pn; u.e = g; u.nrows = 256; return true; }
    __device__ __forceinline__ __amdgpu_buffer_rsrc_t rsrcA() const { return mkrsrc(A); }
    __device__ __forceinline__ __amdgpu_buffer_rsrc_t rsrcB() const { return mkrsrc(B); }
    __device__ __forceinline__ void prefetch(const Unit&, int, int) const {}
    __device__ __forceinline__ unsigned aoff(const Unit&, int row, int) const { return (unsigned)row * (unsigned)lda2; }
};
struct EpiGlu {
    static constexpr bool PERM = true; const bf16* GY; const float* bglu; bf16* MIX;
    __device__ __forceinline__ void operator()(const f32x4 (&acc)[2][2][4][2], const Unit& u, int bb, int wr, int wc, int fr, int fq) const {
        const int row0 = u.pm * BM + wr * 64 + fr, col0 = u.pn * BM + wc * 32 + 8 * fq;
#pragma unroll
        for (int bj = 0; bj < 2; ++bj) { const int col = col0 + bj * HALF;
            const f32x4 b0 = *(const f32x4*)(bglu + col), b1 = *(const f32x4*)(bglu + col + 4);
#pragma unroll
            for (int ai = 0; ai < 2; ++ai)
#pragma unroll
                for (int m = 0; m < 4; ++m) { const size_t row = (size_t)(row0 + ai * HALF + m * 16);
                    const u32x4 g = *(const u32x4*)(GY + row * 512 + col);
                    const f32x4 v0 = acc[ai][bj][m][0] + b0, v1 = acc[ai][bj][m][1] + b1;
                    u32x4 w;
                    w.x = cvt_pk_bf16(lo_bf(g.x) * sigmoidf_(v0[0]), hi_bf(g.x) * sigmoidf_(v0[1])); w.y = cvt_pk_bf16(lo_bf(g.y) * sigmoidf_(v0[2]), hi_bf(g.y) * sigmoidf_(v0[3]));
                    w.z = cvt_pk_bf16(lo_bf(g.z) * sigmoidf_(v1[0]), hi_bf(g.z) * sigmoidf_(v1[1])); w.w = cvt_pk_bf16(lo_bf(g.w) * sigmoidf_(v1[2]), hi_bf(g.w) * sigmoidf_(v1[3]));
                    *(u32x4*)(MIX + row * D + col) = w; } }
    }
};
struct EpiOut {
    static constexpr bool PERM = false; const float* x; float* H;
    __device__ __forceinline__ void operator()(const f32x4 (&acc)[2][2][4][2], const Unit& u, int bb, int wr, int wc, int fr, int fq) const {
        const int row0 = u.pm * BM + wr * 64 + fr, col0 = u.pn * BM + wc * 32 + 4 * fq;
#pragma unroll
        for (int ai = 0; ai < 2; ++ai)
#pragma unroll
            for (int m = 0; m < 4; ++m) { const size_t ro = (size_t)(row0 + ai * HALF + m * 16) * D + col0;
#pragma unroll
                for (int bj = 0; bj < 2; ++bj)
#pragma unroll
                    for (int n = 0; n < 2; ++n) *(f32x4*)(H + ro + bj * HALF + n * 16) = *(const f32x4*)(x + ro + bj * HALF + n * 16) + acc[ai][bj][m][n]; }
    }
};
struct EpiUp {
    static constexpr bool PERM = true; const LAS float* bl; unsigned char* ACT;
    __device__ __forceinline__ void operator()(const f32x4 (&acc)[2][2][4][2], const Unit& u, int bb, int wr, int wc, int fr, int fq) const {
        const int row0 = u.pm * BM + wr * 64 + fr, j0 = u.pn * HALF + wc * 32 + 8 * fq;
        const LAS float* bg = bl + bb * 256 + wc * 32 + 8 * fq;
#pragma unroll
        for (int ai = 0; ai < 2; ++ai)
#pragma unroll
            for (int m = 0; m < 4; ++m) {
                float o[8];
#pragma unroll
                for (int n = 0; n < 2; ++n) { const f32x4 gb = *(const LAS f32x4*)(bg + 4 * n), lb = *(const LAS f32x4*)(bg + 128 + 4 * n);
#pragma unroll
                    for (int q = 0; q < 4; ++q) { const float g = fminf(acc[ai][0][m][n][q] * W8_INV + gb[q], 7.f); const float li = fminf(fmaxf(acc[ai][1][m][n][q] * W8_INV + lb[q], -7.f), 7.f);
                        o[n * 4 + q] = g * sigmoidf_(1.702f * g) * (li + 1.f); } }
                u32x2 w; w.x = pk4_fp8(o[0], o[1], o[2], o[3]); w.y = pk4_fp8(o[4], o[5], o[6], o[7]);
                *(u32x2*)(ACT + (size_t)(row0 + ai * HALF + m * 16) * FF + j0) = w; }
    }
};
struct EpiDown {
    static constexpr bool PERM = true; const LAS float* bl; unsigned char* YS;
    __device__ __forceinline__ void operator()(const f32x4 (&acc)[2][2][4][2], const Unit& u, int bb, int wr, int wc, int fr, int fq) const {
        const int row0 = u.pm * BM + wr * 64 + fr, col0 = u.pn * BM + wc * 32 + 8 * fq;
        const LAS float* bp = bl + bb * 256 + wc * 32 + 8 * fq;
#pragma unroll
        for (int ai = 0; ai < 2; ++ai)
#pragma unroll
            for (int m = 0; m < 4; ++m)
#pragma unroll
                for (int bj = 0; bj < 2; ++bj) { const f32x4 b0 = *(const LAS f32x4*)(bp + bj * HALF), b1 = *(const LAS f32x4*)(bp + bj * HALF + 4);
                    const f32x4 v0 = acc[ai][bj][m][0] * W8_INV + b0, v1 = acc[ai][bj][m][1] * W8_INV + b1;
                    u32x2 w; w.x = pk4_fp8(v0[0], v0[1], v0[2], v0[3]); w.y = pk4_fp8(v1[0], v1[1], v1[2], v1[3]);
                    *(u32x2*)(YS + (size_t)(row0 + ai * HALF + m * 16) * D + col0 + bj * HALF) = w; }
    }
};
}

struct MoeSched {
    const char* A; const char* W; const int* slot_tok; const float* bias; LAS int* til; LAS int* idx; LAS float* bl; int lda2, K2, nN, wrows  , G, c, gather;
    __device__ __forceinline__ bool next(int i, pg::Unit& u) const {
        const int nM = __builtin_amdgcn_readfirstlane(til[2 * MAXTILES]); int pm, pn; if (!pg::tile_order(i, G, c, nM, nN, pm, pn)) return false;
        pm = __builtin_amdgcn_readfirstlane(pm); pn = __builtin_amdgcn_readfirstlane(pn);
        const int e = __builtin_amdgcn_readfirstlane(til[pm]); u.pm = pm; u.pn = pn; u.e = e; u.nrows = __builtin_amdgcn_readfirstlane(til[MAXTILES + pm]);
        u.A = gather ? 0u : (unsigned)pm * 256u * (unsigned)lda2; u.B = ((unsigned)e * wrows + (unsigned)pn * 256u) * (unsigned)K2; return true; }
    __device__ __forceinline__ __amdgpu_buffer_rsrc_t rsrcA() const { return pg::mkrsrc(A); }
    __device__ __forceinline__ __amdgpu_buffer_rsrc_t rsrcB() const { return pg::mkrsrc(W); }
    __device__ __forceinline__ void prefetch(const pg::Unit& u, int ib, int bb) const {
        if (threadIdx.x >= 256 && threadIdx.x < 320) {
            const int l = threadIdx.x - 256;
            const float* src = gather ? bias + (size_t)u.e * 2 * FF + (l < 32 ? u.pn * 128 + 4 * l : FF + u.pn * 128 + 4 * (l - 32)) : bias + (size_t)u.e * D + u.pn * 256 + 4 * l;
            __builtin_amdgcn_global_load_lds((const unsigned*)src, (LAS unsigned*)(bl + bb * 256), 16, 0, 0); }
        if (gather && threadIdx.x < 256) { const int r = threadIdx.x; const int s = u.pm * 256 + (r < u.nrows ? r : u.nrows - 1);
            __builtin_amdgcn_global_load_lds((const unsigned*)(slot_tok + s), (LAS unsigned*)(idx + ib * 256 + (threadIdx.x & ~63)), 4, 0, 0); } }
    __device__ __forceinline__ unsigned aoff(const pg::Unit&, int row, int ib) const { return gather ? (unsigned)idx[ib * 256 + row] * (unsigned)lda2 : (unsigned)row * (unsigned)lda2; }
};

struct Frame {
    LAS unsigned char* lds; volatile LAS unsigned* MISC; gu32* ctl; int tid, lane, wave, vcu, G;
};
#define LDS_WAIT() asm volatile("s_waitcnt lgkmcnt(0)" ::: "memory")

template <bool F8, class RowMap>
__device__ __forceinline__ void transpose_item(const float* W, int ldw, int K, int nblk, void* WTv, LAS bf16* scr, int item, int lane, RowMap rowmap) {
    const int kb = item / nblk, nb = item % nblk, k0 = 64 * kb, n0 = 64 * nb;
    const float* src = W + (size_t)(k0 + (lane >> 4)) * ldw + n0 + 4 * (lane & 15);
    f32x4 v[16];
#pragma unroll
    for (int i = 0; i < 16; ++i) v[i] = *(const f32x4*)(src + (size_t)(4 * i) * ldw);
#pragma unroll
    for (int i = 0; i < 16; ++i) { u32x2 o; o.x = pk2(v[i].x, v[i].y); o.y = pk2(v[i].z, v[i].w); *(LAS u32x2*)(scr + ((lane >> 4) + 4 * i) * 68 + 4 * (lane & 15)) = o; }
    LDS_WAIT(); asm volatile("" ::: "memory");
    const int c = lane & 7; const int r0 = rowmap(n0);
#pragma unroll
    for (int jn = 0; jn < 8; ++jn) { const int n = (lane >> 3) + 8 * jn; const LAS bf16* sp = scr + (8 * c) * 68 + n;
        if constexpr (F8) { u32x2 o; o.x = pk4_fp8(bf2f(sp[0]) * W8_SCALE, bf2f(sp[68]) * W8_SCALE, bf2f(sp[2 * 68]) * W8_SCALE, bf2f(sp[3 * 68]) * W8_SCALE);
            o.y = pk4_fp8(bf2f(sp[4 * 68]) * W8_SCALE, bf2f(sp[5 * 68]) * W8_SCALE, bf2f(sp[6 * 68]) * W8_SCALE, bf2f(sp[7 * 68]) * W8_SCALE);
            *(u32x2*)((unsigned char*)WTv + (size_t)(r0 + n) * K + k0 + 8 * c) = o; }
        else { u32x4 o; o.x = (unsigned)sp[0] | ((unsigned)sp[68] << 16); o.y = (unsigned)sp[2 * 68] | ((unsigned)sp[3 * 68] << 16); o.z = (unsigned)sp[4 * 68] | ((unsigned)sp[5 * 68] << 16); o.w = (unsigned)sp[6 * 68] | ((unsigned)sp[7 * 68] << 16);
            *(u32x4*)((bf16*)WTv + (size_t)(r0 + n) * K + k0 + 8 * c) = o; } }
    LDS_WAIT(); asm volatile("" ::: "memory");
}
struct RowId { __device__ __forceinline__ int operator()(int n0) const { return n0; } };
struct RowUp { __device__ __forceinline__ int operator()(int n0) const { return n0 < FF ? (n0 >> 7) * 256 + (n0 & 127) : ((n0 - FF) >> 7) * 256 + 128 + ((n0 - FF) & 127); } };

struct Args { const float* in[26]; float* out; unsigned char* ws; int ph_lo, ph_hi, li, pad; };

__global__ void __launch_bounds__(NTHR, 2) fwd(Args args) {
    extern __shared__ __attribute__((aligned(16))) unsigned char lds_raw[];
    Frame F;
    F.lds = (LAS unsigned char*)lds_raw;
    F.MISC = (volatile LAS unsigned*)(F.lds + MISC_OFF);
    F.tid = threadIdx.x; F.lane = F.tid & 63; F.wave = __builtin_amdgcn_readfirstlane(F.tid >> 6);
    F.G = gridDim.x; { const int bx = blockIdx.x; F.vcu = (F.G % 8 == 0) ? (bx % 8) * (F.G / 8) + bx / 8 : bx; }
    unsigned char* ws = args.ws;
    F.ctl = (gu32*)(ws + WS_CTL);
    if (F.tid < 32) ((LAS unsigned*)(F.lds + MISC_OFF))[F.tid] = 0u;
    __syncthreads();
    XcdBarrier bar = xcd_barrier_post((unsigned*)(F.ctl + CW_BAR) + args.li * XCD_BAR_WORDS, F.MISC + 8);
#define INP(i) (*(const float* const volatile*)((const char*)__builtin_amdgcn_kernarg_segment_ptr() + 8 * (i)))
    const int lo = args.ph_lo, hi = args.ph_hi;
#define IN(k) (lo <= (k) && (k) < hi)
#define BOTH(k) (IN(k) && IN((k) + 1))
#define GRID_BAR() xcd_barrier(bar)
    const float* x = args.in[0];
    bf16* WIN = (bf16*)(ws + WS_WIN); bf16* WGLU = (bf16*)(ws + WS_WGLU); bf16* WOUT = (bf16*)(ws + WS_WOUT); unsigned char* WUP8 = ws + WS_WUP; unsigned char* WDN8 = ws + WS_WDN;
    bf16* HN = (bf16*)(ws + WS_HN); bf16* PROJ = (bf16*)(ws + WS_PROJ); bf16* GY = (bf16*)(ws + WS_GY); bf16* MIX = (bf16*)(ws + WS_MIX);
    float* H = (float*)(ws + WS_H); unsigned char* ACT8 = ws + WS_ACT; unsigned char* HN8 = ws + WS_HN; unsigned char* YS = ws + WS_YS;
    float* gates = (float*)(ws + WS_GATES); int* topi = (int*)(ws + WS_TOPI); float* topg = (float*)(ws + WS_TOPG);
    int* slot_tok = (int*)(ws + WS_SLOTTOK); int* tok_slot = (int*)(ws + WS_TOKSLOT); int* CNT = (int*)(ws + WS_CNT); int* ecnt = CNT + 16384;
    bf16* S5A = (bf16*)(ws + WS_S5A); bf16* S5BT = (bf16*)(ws + WS_S5BT); bf16* S5BQ = (bf16*)(ws + WS_S5BQ); float* XLOC = (float*)(ws + WS_XLOC);
    bf16* QH = (bf16*)(ws + WS_QH); bf16* KH = (bf16*)(ws + WS_KH); bf16* VT = (bf16*)(ws + WS_VT); float* DC = (float*)(ws + WS_DC); bf16* CST = (bf16*)(ws + WS_CST);
    float* FLOC = (float*)(ws + WS_FLOC); float* DN = (float*)(ws + WS_DN); float* NST = (float*)(ws + WS_NST); float* SEGS = (float*)(ws + WS_SEGS); float* KTAB = (float*)(ws + WS_KTAB);
    const int gw = F.vcu * NWAVES + F.wave, NGW = F.G * NWAVES;

    if (IN(0)) {
        { int tq_ = threadIdx.x; asm volatile("" : "+v"(tq_)); F.tid = tq_; F.lane = tq_ & 63; }
        LAS bf16* scr = (LAS bf16*)(F.lds + F.wave * 16384);
        constexpr int I_IN = (D / 64) * (NPROJ / 64), I_GLU = (512 / 64) * (512 / 64), I_OUT = (D / 64) * (D / 64), I_UP = (D / 64) * (2 * FF / 64), I_DN = (FF / 64) * (D / 64);
        constexpr int NITEMS = I_IN + I_GLU + I_OUT + NE * I_UP + NE * I_DN;
        for (int it = gw; it < NITEMS && !(args.pad & 1); it += NGW) {
            int r = it;
            if (r < I_IN) { transpose_item<false>(args.in[2], DIN, D, NPROJ / 64, WIN, scr, r, F.lane, RowId()); continue; } r -= I_IN;
            if (r < I_GLU) { transpose_item<false>(args.in[11], 512, 512, 512 / 64, WGLU, scr, r, F.lane, RowId()); continue; } r -= I_GLU;
            if (r < I_OUT) { transpose_item<false>(args.in[17], D, D, D / 64, WOUT, scr, r, F.lane, RowId()); continue; } r -= I_OUT;
            if (r < NE * I_UP) { const int e = r / I_UP; transpose_item<true>(args.in[21] + (size_t)e * D * 2 * FF, 2 * FF, D, 2 * FF / 64, WUP8 + (size_t)e * 2 * FF * D, scr, r % I_UP, F.lane, RowUp()); continue; } r -= NE * I_UP;
            { const int e = r / I_DN; transpose_item<true>(args.in[23] + (size_t)e * FF * D, D, FF, D / 64, WDN8 + (size_t)e * D * FF, scr, r % I_DN, F.lane, RowId()); }
        }
        {
            const float* g = args.in[1]; const float* w_in = args.in[2]; const float* b_gates = args.in[15];
            float wg[16][8]; f32x4 gg[4];
#pragma unroll
            for (int jq = 0; jq < 4; ++jq) { gg[jq] = *(const f32x4*)(g + 4 * F.lane + 256 * jq);
#pragma unroll
                for (int i = 0; i < 4; ++i) { const int k = 4 * F.lane + 256 * jq + i; const f32x4 w0 = *(const f32x4*)(w_in + (size_t)k * DIN + O_G), w1 = *(const f32x4*)(w_in + (size_t)k * DIN + O_G + 4);
                    wg[4 * jq + i][0] = w0.x; wg[4 * jq + i][1] = w0.y; wg[4 * jq + i][2] = w0.z; wg[4 * jq + i][3] = w0.w; wg[4 * jq + i][4] = w1.x; wg[4 * jq + i][5] = w1.y; wg[4 * jq + i][6] = w1.z; wg[4 * jq + i][7] = w1.w; } }
            float bgv[8];
#pragma unroll
            for (int q = 0; q < 8; ++q) bgv[q] = b_gates[q];
            f32x4 nx[4];
            if (gw < T) {
#pragma unroll
                for (int jq = 0; jq < 4; ++jq) nx[jq] = *(const f32x4*)(x + (size_t)gw * D + 4 * F.lane + 256 * jq); }
            for (int row = gw; row < T && !(args.pad & 2); row += NGW) {
                f32x4 v[4];
#pragma unroll
                for (int jq = 0; jq < 4; ++jq) v[jq] = nx[jq];
                if (row + NGW < T) {
#pragma unroll
                    for (int jq = 0; jq < 4; ++jq) nx[jq] = *(const f32x4*)(x + (size_t)(row + NGW) * D + 4 * F.lane + 256 * jq); }
                float ss = 0.f;
#pragma unroll
                for (int jq = 0; jq < 4; ++jq) ss += v[jq].x * v[jq].x + v[jq].y * v[jq].y + v[jq].z * v[jq].z + v[jq].w * v[jq].w;
                ss = wave_sum(ss);
                const float rstd = rsqrtf(ss * (1.f / D) + 1e-5f);
                float ga[8] = {0, 0, 0, 0, 0, 0, 0, 0};
#pragma unroll
                for (int jq = 0; jq < 4; ++jq) {
                    v[jq] = v[jq] * rstd * gg[jq];
#pragma unroll
                    for (int i = 0; i < 4; ++i)
#pragma unroll
                        for (int q = 0; q < 8; ++q) ga[q] += v[jq][i] * wg[4 * jq + i][q];
                    uint2 o; o.x = pk2(v[jq].x, v[jq].y); o.y = pk2(v[jq].z, v[jq].w);
                    *(uint2*)(HN + (size_t)row * D + 4 * F.lane + 256 * jq) = o;
                }
#pragma unroll
                for (int q = 0; q < 8; ++q) ga[q] = wave_sum(ga[q]);
                if (F.lane == 0) { *(f32x4*)(gates + (size_t)row * 8) = (f32x4){ga[0] + bgv[0], ga[1] + bgv[1], ga[2] + bgv[2], ga[3] + bgv[3]}; *(f32x4*)(gates + (size_t)row * 8 + 4) = (f32x4){ga[4] + bgv[4], ga[5] + bgv[5], ga[6] + bgv[6], ga[7] + bgv[7]}; }
            }
        }
        __syncthreads();
        for (int un = F.vcu; un < 256 && !(args.pad & 4); un += F.G) {
            const int g = un >> 3, j = un & 7;
            LAS float* Ere = (LAS float*)F.lds; LAS float* Eim = Ere + 8 * 64;
            LAS float* Bbr = Eim + 8 * 64; LAS float* Bbi = Bbr + 1024;
            LAS float* Cr = Bbi + 1024; LAS float* Ci = Cr + 1024;
            const float dt = __expf(args.in[3][g]);
            if (F.tid < 64) { const int n = F.tid;
                const float are = fminf(args.in[4][g * 64 + n], -1e-4f), aim = args.in[5][g * 64 + n];
                const float mag = expf(dt * are); float sn, cs; sincosf(dt * aim, &sn, &cs);
                const float nr = mag * cs - 1.f, ni = mag * sn, dn = are * are + aim * aim;
                const float cfr = (nr * are + ni * aim) / dn, cfi = (ni * are - nr * aim) / dn;
                for (int q = 0; q < 16; ++q) { const float br = args.in[6][(g * 64 + n) * 16 + q], bi = args.in[7][(g * 64 + n) * 16 + q]; Bbr[n * 16 + q] = cfr * br - cfi * bi; Bbi[n * 16 + q] = cfr * bi + cfi * br; }
            }
            for (int i = F.tid; i < 1024; i += NTHR) { Cr[i] = args.in[8][g * 1024 + i]; Ci[i] = args.in[9][g * 1024 + i]; }
            { const int tl = F.tid >> 6, n = F.tid & 63; const float tau = (float)(8 * j + tl);
                const float are = fminf(args.in[4][g * 64 + n], -1e-4f), aim = args.in[5][g * 64 + n];
                const float mag = expf(tau * dt * are); float sn, cs; sincosf(tau * dt * aim, &sn, &cs); Ere[F.tid] = mag * cs; Eim[F.tid] = mag * sn; }
            __syncthreads();
            {
                const int tl = F.tid >> 6, p = (F.tid >> 2) & 15, q0 = (F.tid & 3) * 4;
                float a0 = 0.f, a1 = 0.f, a2 = 0.f, a3 = 0.f;
                for (int n = 0; n < 64; ++n) { const float cr = Cr[p * 64 + n], ci = Ci[p * 64 + n], er = Ere[tl * 64 + n], ei = Eim[tl * 64 + n];
                    const float xr = cr * er - ci * ei, xi = cr * ei + ci * er;
                    const f32x4 br = *(const LAS f32x4*)(Bbr + n * 16 + q0), bi = *(const LAS f32x4*)(Bbi + n * 16 + q0);
                    a0 += xr * br.x - xi * bi.x; a1 += xr * br.y - xi * bi.y; a2 += xr * br.z - xi * bi.z; a3 += xr * br.w - xi * bi.w; }
                *(f32x4*)(KTAB + ((size_t)g * 64 + 8 * j + tl) * 256 + p * 16 + q0) = (f32x4){a0, a1, a2, a3};
            }
            const float dtg = dt;
            for (int ch = F.tid; ch < 32 * 128; ch += NTHR) {
                const int rl = ch >> 7, c8 = ch & 127, r = 32 * j + rl, n = r & 63, im = (r >> 6) & 1, col = c8 * 8, sidx = col >> 4, q0 = col & 15;
                const float are = fminf(args.in[4][g * 64 + n], -1e-4f), aim = args.in[5][g * 64 + n]; const float tau = (float)(63 - sidx);
                const float mag = expf(tau * dtg * are); float sn, cs; sincosf(tau * dtg * aim, &sn, &cs); const float er = mag * cs, ei = mag * sn;
                float v[8];
#pragma unroll
                for (int i = 0; i < 8; ++i) { const float br = Bbr[n * 16 + q0 + i], bi = Bbi[n * 16 + q0 + i]; v[i] = im ? (er * bi + ei * br) : (er * br - ei * bi); }
                u32x4 o; o.x = pk2(v[0], v[1]); o.y = pk2(v[2], v[3]); o.z = pk2(v[4], v[5]); o.w = pk2(v[6], v[7]);
                *(u32x4*)(S5BQ + ((size_t)g * 256 + r) * 1024 + col) = o;
            }
            __syncthreads();
        }
        if (BOTH(0)) GRID_BAR();
    }
    if (IN(1)) {
        { int tq_ = threadIdx.x; asm volatile("" : "+v"(tq_)); F.tid = tq_; F.lane = tq_ & 63; }
        pg::DenseSched S{(const char*)HN, (const char*)WIN, D * 2, D * 2, T / 256, NPROJ / 256, F.G, (int)blockIdx.x};
        pg::EpiProj E{PROJ, S5A};
        pg::gemm_phase<pg::EpiProj, pg::DenseSched, true>(F.lds, D, S, E);
        if (BOTH(1)) GRID_BAR();
    }
    if (IN(2)) {
        { int tq_ = threadIdx.x; asm volatile("" : "+v"(tq_)); F.tid = tq_; F.lane = tq_ & 63; }
        pg::S5Sched S{(const char*)S5A, (const char*)S5BQ, S5K * 2, 1024 * 2, 256, 1, F.G, F.vcu};
        pg::EpiXloc E{XLOC};
        pg::gemm_phase<pg::EpiXloc, pg::S5Sched, true>(F.lds, 1024, S, E);
        {
            const int first = F.G > 64 ? F.vcu - 64 : F.vcu, stride = F.G > 64 ? F.G - 64 : F.G;
            LAS float* Kt = (LAS float*)F.lds;
            LAS float* Ere = Kt + 64 * 256; LAS float* Eim = Ere + 8 * 64;
            LAS float* Cr = Eim + 8 * 64; LAS float* Ci = Cr + 1024;
            for (int un = first; un >= 0 && un < 256; un += stride) {
                const int g = un >> 3, j = un & 7, ntau = 8 * j + 8;
                __syncthreads();
                for (int i = F.tid; i < ntau * 64; i += NTHR) *(LAS f32x4*)(Kt + 4 * i) = *(const f32x4*)(KTAB + (size_t)g * 64 * 256 + 4 * i);
                for (int i = F.tid; i < 1024; i += NTHR) { Cr[i] = args.in[8][g * 1024 + i]; Ci[i] = args.in[9][g * 1024 + i]; }
                { const int tl = F.tid >> 6, n = F.tid & 63; const float tau = (float)(8 * j + tl + 1); const float dt = __expf(args.in[3][g]);
                    const float are = fminf(args.in[4][g * 64 + n], -1e-4f), aim = args.in[5][g * 64 + n];
                    const float mag = expf(tau * dt * are); float sn, cs; sincosf(tau * dt * aim, &sn, &cs); Ere[F.tid] = mag * cs; Eim[F.tid] = mag * sn; }
                __syncthreads();
                for (int ch = F.tid; ch < 128 * 144; ch += NTHR) {
                    const int rl = ch / 144, c8 = ch % 144, tl = rl >> 4, t = 8 * j + tl, p = rl & 15, col = c8 * 8;
                    float v[8];
                    if (col < 1024) { const int sidx = col >> 4, q0 = col & 15;
                        if (sidx <= t) { const f32x4 k0 = *(const LAS f32x4*)(Kt + (t - sidx) * 256 + p * 16 + q0), k1 = *(const LAS f32x4*)(Kt + (t - sidx) * 256 + p * 16 + q0 + 4);
                            v[0] = k0.x; v[1] = k0.y; v[2] = k0.z; v[3] = k0.w; v[4] = k1.x; v[5] = k1.y; v[6] = k1.z; v[7] = k1.w; }
                        else {
#pragma unroll
                            for (int i = 0; i < 8; ++i) v[i] = 0.f; }
                    } else { const int jj = (col - 1024) & 63, im = (col - 1024) >> 6;
#pragma unroll
                        for (int i = 0; i < 8; ++i) { const int n = jj + i; const float cr = Cr[p * 64 + n], ci = Ci[p * 64 + n], er = Ere[tl * 64 + n], ei = Eim[tl * 64 + n];
                            v[i] = im ? -(cr * ei + ci * er) : (cr * er - ci * ei); } }
                    u32x4 o; o.x = pk2(v[0], v[1]); o.y = pk2(v[2], v[3]); o.z = pk2(v[4], v[5]); o.w = pk2(v[6], v[7]);
                    *(u32x4*)(S5BT + ((size_t)g * 1024 + 128 * j + rl) * S5K + col) = o;
                }
            }
            __syncthreads();
        }
    }
    if (IN(3)) {
        { int tq_ = threadIdx.x; asm volatile("" : "+v"(tq_)); F.tid = tq_; F.lane = tq_ & 63; }
        typedef short s16x4 __attribute__((ext_vector_type(4)));
        LAS float* wsl = (LAS float*)F.lds;
        LAS float* red = wsl + 512;
        LAS float* dnl = red + 32;
        LAS bf16* RQ = (LAS bf16*)(F.lds + 4096);
        LAS bf16* RK = RQ + 67 * 136;
        LAS bf16* RV = RK + 67 * 136;
        LAS bf16* KN = RV + 64 * 136;
        LAS bf16* KTl = KN + 64 * 136;
        LAS bf16* VTl = KTl + 128 * 72;
        const float* cw = args.in[13]; const float* cbias = args.in[14];
        for (int un = blockIdx.x; un < 256; un += F.G) {
            const int bh = un >> 4, seg = un & 15, b = bh >> 2, hd = bh & 3, t0 = seg * 512; const size_t row0 = (size_t)b * SEQ + t0;
            float Fl, Aval;
            {
                const float ipre = gates[(row0 + F.tid) * 8 + hd], fpre = gates[(row0 + F.tid) * 8 + 4 + hd];
                const float lf = fminf(fpre, 0.f) - log1pf(__expf(-fabsf(fpre)));
                float sc = lf;
#pragma unroll
                for (int o = 1; o < 64; o <<= 1) { const float tv = __shfl_up(sc, o); if (F.lane >= o) sc += tv; }
                if (F.lane == 63) red[F.wave] = sc;
                __syncthreads();
                float base = 0.f;
                for (int w2 = 0; w2 < F.wave; ++w2) base += red[w2];
                Fl = sc + base; Aval = ipre - Fl;
                float mx = Aval;
#pragma unroll
                for (int o = 1; o < 64; o <<= 1) mx = fmaxf(mx, __shfl_xor(mx, o));
                if (F.lane == 0) red[8 + F.wave] = mx;
                __syncthreads();
                float Amax = red[8];
                for (int w2 = 1; w2 < 8; ++w2) Amax = fmaxf(Amax, red[8 + w2]);
                wsl[F.tid] = __expf(Aval - Amax);
                FLOC[(size_t)bh * SEQ + t0 + F.tid] = Fl;
                if (F.tid == 511) { SEGS[un * 4 + 0] = Fl; SEGS[un * 4 + 1] = Amax; }
                if (F.tid < 256) dnl[F.tid] = 0.f;
            }
            f32x16 dacc[2];
#pragma unroll
            for (int i = 0; i < 2; ++i)
#pragma unroll
                for (int q = 0; q < 16; ++q) dacc[i][q] = 0.f;
            const int cch = F.tid & 127, isk = (F.tid >> 7) & 1, thalf = F.tid >> 8;
            const int gch = isk * 512 + hd * 128 + cch;
            const float cw0 = cw[gch], cw1 = cw[1024 + gch], cw2 = cw[2048 + gch], cw3 = cw[3072 + gch], cb = cbias[gch];
            float dnacc = 0.f;
            u32x4 rt[7];
#define ML_RAW_LOAD(tsv) do { _Pragma("unroll") for (int ii = 0; ii < 7; ++ii) { const int ch = F.tid + NTHR * ii; u32x4 v = (u32x4){0u, 0u, 0u, 0u}; \
                if (ch < 2 * 67 * 16) { const int which = ch / (67 * 16), r = (ch % (67 * 16)) >> 4, c16 = ch & 15; const int tk = (tsv) - 3 + r; \
                    if (tk >= 0) v = *(const u32x4*)(PROJ + ((size_t)b * SEQ + tk) * NPROJ + (which ? O_K : O_Q) + hd * 128 + c16 * 8); } \
                else if (ch < 2 * 67 * 16 + 64 * 16) { const int c2 = ch - 2 * 67 * 16, r = c2 >> 4, c16 = c2 & 15; v = *(const u32x4*)(PROJ + ((size_t)b * SEQ + (tsv) + r) * NPROJ + O_V + hd * 128 + c16 * 8); } \
                rt[ii] = v; } } while (0)
            ML_RAW_LOAD(t0);
            for (int sb = 0; sb < 8; ++sb) {
                const int ts = t0 + sb * 64;
                __syncthreads();
#pragma unroll
                for (int ii = 0; ii < 7; ++ii) { const int ch = F.tid + NTHR * ii;
                    if (ch < 2 * 67 * 16) { const int which = ch / (67 * 16), r = (ch % (67 * 16)) >> 4, c16 = ch & 15; *(LAS u32x4*)((which ? RK : RQ) + r * 136 + c16 * 8) = rt[ii]; }
                    else if (ch < 2 * 67 * 16 + 64 * 16) { const int c2 = ch - 2 * 67 * 16, r = c2 >> 4, c16 = c2 & 15; *(LAS u32x4*)(RV + r * 136 + c16 * 8) = rt[ii]; } }
                if (sb < 7) ML_RAW_LOAD(ts + 64);
                __syncthreads();
                {
                    LAS bf16* raw = isk ? RK : RQ; const int s0 = thalf * 32;
                    float x3 = bf2f(raw[(s0 + 0) * 136 + cch]), x2 = bf2f(raw[(s0 + 1) * 136 + cch]), x1 = bf2f(raw[(s0 + 2) * 136 + cch]);
                    for (int sidx = s0; sidx < s0 + 32; ++sidx) {
                        const float xv = bf2f(raw[(sidx + 3) * 136 + cch]);
                        float val = cb + cw0 * x3 + cw1 * x2 + cw2 * x1 + cw3 * xv;
                        x3 = x2; x2 = x1; x1 = xv;
                        val = val * sigmoidf_(val);
                        if (isk) { val *= 0.08838834764831845f * wsl[sb * 64 + sidx]; dnacc += val; const bf16 kb = f2bf(val); KN[sidx * 136 + cch] = kb; KH[((size_t)bh * SEQ + ts + sidx) * 128 + cch] = kb; }
                        else QH[((size_t)bh * SEQ + ts + sidx) * 128 + cch] = f2bf(val);
                    }
                }
                __syncthreads();
                {
                    const int c = F.tid & 127, sq = F.tid >> 7;
#pragma unroll
                    for (int half = 0; half < 2; ++half) { const int sA = sq * 16 + half * 8;
                        u32x4 kk, vv;
                        kk.x = (unsigned)KN[(sA + 0) * 136 + c] | ((unsigned)KN[(sA + 1) * 136 + c] << 16); kk.y = (unsigned)KN[(sA + 2) * 136 + c] | ((unsigned)KN[(sA + 3) * 136 + c] << 16);
                        kk.z = (unsigned)KN[(sA + 4) * 136 + c] | ((unsigned)KN[(sA + 5) * 136 + c] << 16); kk.w = (unsigned)KN[(sA + 6) * 136 + c] | ((unsigned)KN[(sA + 7) * 136 + c] << 16);
                        vv.x = (unsigned)RV[(sA + 0) * 136 + c] | ((unsigned)RV[(sA + 1) * 136 + c] << 16); vv.y = (unsigned)RV[(sA + 2) * 136 + c] | ((unsigned)RV[(sA + 3) * 136 + c] << 16);
                        vv.z = (unsigned)RV[(sA + 4) * 136 + c] | ((unsigned)RV[(sA + 5) * 136 + c] << 16); vv.w = (unsigned)RV[(sA + 6) * 136 + c] | ((unsigned)RV[(sA + 7) * 136 + c] << 16);
                        *(LAS u32x4*)(KTl + c * 72 + sA) = kk; *(LAS u32x4*)(VTl + c * 72 + sA) = vv; }
                }
                __syncthreads();
                {
                    const int e = F.tid >> 2, part = F.tid & 3;
                    const u32x4 v0 = *(const LAS u32x4*)(VTl + e * 72 + part * 16), v1 = *(const LAS u32x4*)(VTl + e * 72 + part * 16 + 8);
                    bf16* dst = VT + ((size_t)bh * 128 + e) * SEQ + ts + part * 16;
                    *(u32x4*)dst = v0; *(u32x4*)(dst + 8) = v1;
                    const int eb = F.wave >> 1, db0 = (F.wave & 1) * 2, r = F.lane & 31, hh = F.lane >> 5;
#pragma unroll
                    for (int ks = 0; ks < 4; ++ks) {
                        const bf16x8 a = *(const LAS bf16x8*)(VTl + (eb * 32 + r) * 72 + ks * 16 + hh * 8);
                        const bf16x8 b0 = *(const LAS bf16x8*)(KTl + (db0 * 32 + r) * 72 + ks * 16 + hh * 8), b1 = *(const LAS bf16x8*)(KTl + ((db0 + 1) * 32 + r) * 72 + ks * 16 + hh * 8);
                        dacc[0] = __builtin_amdgcn_mfma_f32_32x32x16_bf16(a, b0, dacc[0], 0, 0, 0);
                        dacc[1] = __builtin_amdgcn_mfma_f32_32x32x16_bf16(a, b1, dacc[1], 0, 0, 0);
                    }
                }
            }
#undef ML_RAW_LOAD
            if (isk) dnl[thalf * 128 + cch] = dnacc;
            {
                const int eb = F.wave >> 1, db0 = (F.wave & 1) * 2, r = F.lane & 31, hh = F.lane >> 5;
#pragma unroll
                for (int i = 0; i < 2; ++i)
#pragma unroll
                    for (int q = 0; q < 16; ++q) DC[((size_t)un * 128 + eb * 32 + (q & 3) + 8 * (q >> 2) + 4 * hh) * 128 + (db0 + i) * 32 + r] = dacc[i][q];
            }
            __syncthreads();
            if (F.tid < 128) DN[un * 128 + F.tid] = dnl[F.tid] + dnl[128 + F.tid];
            __syncthreads();
        }
        if (BOTH(3)) GRID_BAR();
    }
    if (IN(4)) {
        { int tq_ = threadIdx.x; asm volatile("" : "+v"(tq_)); F.tid = tq_; F.lane = tq_ & 63; }
        LAS float* agr = (LAS float*)F.lds; LAS float* agi = agr + 512;
        for (int un = blockIdx.x; un < 128; un += F.G) {
            const int b = un >> 5, g = un & 31, n = F.tid & 63, seg = F.tid >> 6;
            const float dt = __expf(args.in[3][g]);
            const float are = fminf(args.in[4][g * 64 + n], -1e-4f), aim = args.in[5][g * 64 + n];
            float ar, ai, Ar, Ai;
            { const float mag = expf(64.f * dt * are); float sn, cs; sincosf(64.f * dt * aim, &sn, &cs); ar = mag * cs; ai = mag * sn; }
            { const float mag = expf(1024.f * dt * are); float sn, cs; sincosf(1024.f * dt * aim, &sn, &cs); Ar = mag * cs; Ai = mag * sn; }
            const size_t row0 = (size_t)g * 512 + b * 128 + seg * 16;
            float xr[16], xi[16];
#pragma unroll
            for (int jj = 0; jj < 16; ++jj) { xr[jj] = XLOC[(row0 + jj) * 128 + n]; xi[jj] = XLOC[(row0 + jj) * 128 + 64 + n]; }
            float sr = 0.f, si = 0.f;
#pragma unroll
            for (int jj = 0; jj < 16; ++jj) { const float tr = ar * sr - ai * si + xr[jj], ti = ar * si + ai * sr + xi[jj]; sr = tr; si = ti; }
            agr[seg * 64 + n] = sr; agi[seg * 64 + n] = si;
            __syncthreads();
            float cr = 0.f, ci = 0.f;
            for (int s2 = 0; s2 < seg; ++s2) { const float tr = Ar * cr - Ai * ci + agr[s2 * 64 + n], ti = Ar * ci + Ai * cr + agi[s2 * 64 + n]; cr = tr; ci = ti; }
#pragma unroll
            for (int jj = 0; jj < 16; ++jj) {
                S5A[(row0 + jj) * S5K + 1024 + n] = f2bf(cr); S5A[(row0 + jj) * S5K + 1088 + n] = f2bf(ci);
                const float tr = ar * cr - ai * ci + xr[jj], ti = ar * ci + ai * cr + xi[jj]; cr = tr; ci = ti; }
            __syncthreads();
        }
        for (int un = blockIdx.x; un < 256; un += F.G) {
            const int bh = un >> 4, slice = un & 15;
            float dc0[16], dc1[16];
#pragma unroll
            for (int j = 0; j < 16; ++j) { dc0[j] = DC[((size_t)(bh * 16 + j)) * 16384 + slice * 1024 + F.tid]; dc1[j] = DC[((size_t)(bh * 16 + j)) * 16384 + slice * 1024 + 512 + F.tid]; }
            float dn[16];
            const bool nrole = (slice == 0 && F.tid < 128);
#pragma unroll
            for (int j = 0; j < 16; ++j) dn[j] = nrole ? DN[(bh * 16 + j) * 128 + F.tid] : 0.f;
            float m = 0.f, C0 = 0.f, C1 = 0.f, nn = 0.f;
#pragma unroll
            for (int j = 0; j < 16; ++j) {
                const float Fend = SEGS[(bh * 16 + j) * 4 + 0], Amax = SEGS[(bh * 16 + j) * 4 + 1];
                const float R = fmaxf(m, Amax), c1 = __expf(m - R), c2 = __expf(Amax - R);
                CST[((size_t)(bh * 16 + j)) * 16384 + slice * 1024 + F.tid] = f2bf(c1 * C0); CST[((size_t)(bh * 16 + j)) * 16384 + slice * 1024 + 512 + F.tid] = f2bf(c1 * C1);
                if (nrole) NST[(bh * 16 + j) * 128 + F.tid] = c1 * nn;
                if (slice == 0 && F.tid == 0) { SEGS[(bh * 16 + j) * 4 + 2] = R; SEGS[(bh * 16 + j) * 4 + 3] = c2; }
                C0 = c1 * C0 + c2 * dc0[j]; C1 = c1 * C1 + c2 * dc1[j]; nn = c1 * nn + c2 * dn[j]; m = Fend + R;
            }
        }
        if (BOTH(4)) GRID_BAR();
    }
    if (IN(5)) {
        { int tq_ = threadIdx.x; asm volatile("" : "+v"(tq_)); F.tid = tq_; F.lane = tq_ & 63; }
        pg::S5Sched S{(const char*)S5A, (const char*)S5BT, S5K * 2, S5K * 2, 1024, 4, F.G, F.vcu};
        pg::EpiS5Y E{S5A, args.in[10], GY};
        pg::gemm_phase<pg::EpiS5Y, pg::S5Sched, true>(F.lds, S5K, S, E);
        if (BOTH(5)) GRID_BAR();
    }
    if (IN(6)) {
        { int tq_ = threadIdx.x; asm volatile("" : "+v"(tq_)); F.tid = tq_; F.lane = tq_ & 63; }
        typedef short s16x4 __attribute__((ext_vector_type(4)));
        LAS bf16* Kl = (LAS bf16*)F.lds;
        LAS bf16* Vl = Kl + 2 * 64 * 136;
        LAS bf16* Cl = Vl + 2 * 128 * 72;
        LAS float* nl = (LAS float*)(Cl + 128 * 136);
        LAS float* fll = nl + 128;
        LAS float* gl = fll + 512;
        const float* ng = args.in[16];
        for (int un = blockIdx.x; un < 256; un += F.G) {
            int tid6 = F.tid; asm volatile("" : "+v"(tid6));
            const int lane6 = tid6 & 63;
            const int bh = un >> 4, seg = un & 15, b = bh >> 2, hd = bh & 3, t0 = seg * 512;
            const float R = SEGS[un * 4 + 2], c2 = SEGS[un * 4 + 3];
            __syncthreads();
            for (int ch = tid6; ch < 2048; ch += NTHR) { const int r = ch >> 4, c16 = ch & 15; *(LAS u32x4*)(Cl + r * 136 + c16 * 8) = *(const u32x4*)(CST + (size_t)un * 16384 + r * 128 + c16 * 8); }
            if (tid6 < 128) { nl[tid6] = NST[un * 128 + tid6]; gl[tid6] = ng[hd * 128 + tid6]; }
            fll[tid6] = FLOC[(size_t)bh * SEQ + t0 + tid6];
            const int r = lane6 & 31, hh = lane6 >> 5;
            for (int pass = 0; pass < 2; ++pass) {
                const int qb = pass == 0 ? F.wave : 15 - F.wave, jmax = qb >> 1, npj = pass == 0 ? 4 : 8;
                bf16x8 Q[8];
                { const bf16* qp = QH + ((size_t)bh * SEQ + t0 + qb * 32 + r) * 128 + hh * 8;
#pragma unroll
                  for (int ks = 0; ks < 8; ++ks) Q[ks] = *(const bf16x8*)(qp + ks * 16); }
                u32x4 pk0, pk1, pv0, pv1;
                { const int kr = tid6 >> 4, kc = tid6 & 15; const bf16* kp = KH + ((size_t)bh * SEQ + t0) * 128; pk0 = *(const u32x4*)(kp + kr * 128 + kc * 8); pk1 = *(const u32x4*)(kp + (kr + 32) * 128 + kc * 8);
                  const int vr = tid6 >> 3, vc = tid6 & 7; const bf16* vp = VT + (size_t)bh * 128 * SEQ + t0; pv0 = *(const u32x4*)(vp + (size_t)vr * SEQ + vc * 8); pv1 = *(const u32x4*)(vp + (size_t)(vr + 64) * SEQ + vc * 8); }
                f32x16 acc[4];
#pragma unroll
                for (int eb = 0; eb < 4; ++eb)
#pragma unroll
                    for (int q = 0; q < 16; ++q) acc[eb][q] = 0.f;
                __syncthreads();
#pragma unroll
                for (int eb = 0; eb < 4; ++eb) {
#pragma unroll
                    for (int ks = 0; ks < 8; ++ks) { const bf16x8 a = *(const LAS bf16x8*)(Cl + (eb * 32 + r) * 136 + ks * 16 + hh * 8); acc[eb] = __builtin_amdgcn_mfma_f32_32x32x16_bf16(a, Q[ks], acc[eb], 0, 0, 0); }
                    __builtin_amdgcn_sched_barrier(0);
                }
                float den = 0.f;
#pragma unroll
                for (int ks = 0; ks < 8; ++ks) {
#pragma unroll
                    for (int jj = 0; jj < 8; ++jj) den += nl[ks * 16 + hh * 8 + jj] * bf2f((bf16)Q[ks][jj]);
                    __builtin_amdgcn_sched_barrier(0);
                }
                float dsum = 0.f;
                for (int j = 0; j < npj; ++j) {
                    LAS bf16* Kb = Kl + (j & 1) * 64 * 136; LAS bf16* Vb = Vl + (j & 1) * 128 * 72;
                    { const int kr = tid6 >> 4, kc = tid6 & 15; *(LAS u32x4*)(Kb + kr * 136 + kc * 8) = pk0; *(LAS u32x4*)(Kb + (kr + 32) * 136 + kc * 8) = pk1;
                      const int vr = tid6 >> 3, vc = tid6 & 7; *(LAS u32x4*)(Vb + vr * 72 + vc * 8) = pv0; *(LAS u32x4*)(Vb + (vr + 64) * 72 + vc * 8) = pv1; }
                    if (j + 1 < npj) { const int kr = tid6 >> 4, kc = tid6 & 15; const bf16* kp = KH + ((size_t)bh * SEQ + t0 + (j + 1) * 64) * 128; pk0 = *(const u32x4*)(kp + kr * 128 + kc * 8); pk1 = *(const u32x4*)(kp + (kr + 32) * 128 + kc * 8);
                        const int vr = tid6 >> 3, vc = tid6 & 7; const bf16* vp = VT + (size_t)bh * 128 * SEQ + t0 + (j + 1) * 64; pv0 = *(const u32x4*)(vp + (size_t)vr * SEQ + vc * 8); pv1 = *(const u32x4*)(vp + (size_t)(vr + 64) * SEQ + vc * 8); }
                    __syncthreads();
                    if (j <= jmax) {
                        const bool diag = (j == jmax); const int tq = qb * 32 + r;
#pragma unroll
                        for (int sb = 0; sb < 2; ++sb) {
                            f32x16 st;
#pragma unroll
                            for (int q = 0; q < 16; ++q) st[q] = 0.f;
#pragma unroll
                            for (int ks = 0; ks < 8; ++ks) { const bf16x8 a = *(const LAS bf16x8*)(Kb + (sb * 32 + r) * 136 + ks * 16 + hh * 8); st = __builtin_amdgcn_mfma_f32_32x32x16_bf16(a, Q[ks], st, 0, 0, 0); }
                            bf16x8 pb[2];
#pragma unroll
                            for (int sp = 0; sp < 2; ++sp) {
                                float pv[8];
#pragma unroll
                                for (int jj = 0; jj < 8; ++jj) { const int q = 8 * sp + jj; const int sidx = j * 64 + sb * 32 + (q & 3) + 8 * (q >> 2) + 4 * hh;
                                    float p = st[q] * c2; if (diag && sidx > tq) p = 0.f; pv[jj] = p; dsum += p; }
                                u32x4 w; w.x = cvt_pk_bf16(pv[0], pv[1]); w.y = cvt_pk_bf16(pv[2], pv[3]); w.z = cvt_pk_bf16(pv[4], pv[5]); w.w = cvt_pk_bf16(pv[6], pv[7]);
                                pb[sp] = __builtin_bit_cast(bf16x8, w);
                            }
#pragma unroll
                            for (int eb = 0; eb < 4; ++eb)
#pragma unroll
                                for (int sp = 0; sp < 2; ++sp) {
                                    const int so = sb * 32 + 16 * sp + 4 * hh;
                                    const s16x4 lo = *(const LAS s16x4*)(Vb + (eb * 32 + r) * 72 + so), hi = *(const LAS s16x4*)(Vb + (eb * 32 + r) * 72 + so + 8);
                                    const bf16x8 a = __builtin_shufflevector(lo, hi, 0, 1, 2, 3, 4, 5, 6, 7);
                                    acc[eb] = __builtin_amdgcn_mfma_f32_32x32x16_bf16(a, pb[sp], acc[eb], 0, 0, 0);
                                }
                            __builtin_amdgcn_sched_barrier(0);
                        }
                    }
                }
                den += dsum; den += __shfl_xor(den, 32);
                const float flo = __expf(-fll[qb * 32 + r] - R);
                const float inv = 1.f / fmaxf(fabsf(den), flo);
                float s1 = 0.f;
#pragma unroll
                for (int eb = 0; eb < 4; ++eb)
#pragma unroll
                    for (int q = 0; q < 16; ++q) { acc[eb][q] *= inv; s1 += acc[eb][q]; }
                s1 += __shfl_xor(s1, 32);
                const float mu = s1 * (1.f / 128.f);
                float s2 = 0.f;
#pragma unroll
                for (int eb = 0; eb < 4; ++eb)
#pragma unroll
                    for (int q = 0; q < 16; ++q) { const float dlt = acc[eb][q] - mu; s2 += dlt * dlt; }
                s2 += __shfl_xor(s2, 32);
                const float rstd = rsqrtf(s2 * (1.f / 128.f) + 1e-6f);
                const size_t row = (size_t)b * SEQ + t0 + qb * 32 + r;
                uint2 ovv[16];
#pragma unroll
                for (int eb = 0; eb < 4; ++eb)
#pragma unroll
                    for (int g4 = 0; g4 < 4; ++g4) ovv[eb * 4 + g4] = *(const uint2*)(PROJ + row * NPROJ + O_O + hd * 128 + eb * 32 + 8 * g4 + 4 * hh);
#pragma unroll
                for (int eb = 0; eb < 4; ++eb)
#pragma unroll
                    for (int g4 = 0; g4 < 4; ++g4) {
                        const int e0 = eb * 32 + 8 * g4 + 4 * hh;
                        const uint2 ov = ovv[eb * 4 + g4];
                        const f32x4 gg = *(const LAS f32x4*)(gl + e0);
                        const float o0 = (acc[eb][4 * g4 + 0] - mu) * rstd * gg.x * sigmoidf_(lo_bf(ov.x)), o1 = (acc[eb][4 * g4 + 1] - mu) * rstd * gg.y * sigmoidf_(hi_bf(ov.x));
                        const float o2 = (acc[eb][4 * g4 + 2] - mu) * rstd * gg.z * sigmoidf_(lo_bf(ov.y)), o3 = (acc[eb][4 * g4 + 3] - mu) * rstd * gg.w * sigmoidf_(hi_bf(ov.y));
                        uint2 w; w.x = cvt_pk_bf16(o0, o1); w.y = cvt_pk_bf16(o2, o3);
                        *(uint2*)(MIX + row * D + 512 + hd * 128 + e0) = w;
                    }
            }
        }
    }
    if (IN(7)) {
        { int tq_ = threadIdx.x; asm volatile("" : "+v"(tq_)); F.tid = tq_; F.lane = tq_ & 63; }
        pg::DenseSched S{(const char*)GY, (const char*)WGLU, 512 * 2, 512 * 2, T / 256, 2, F.G, (int)blockIdx.x};
        pg::EpiGlu E{GY, args.in[12], MIX};
        pg::gemm_phase<pg::EpiGlu, pg::DenseSched, true>(F.lds, 512, S, E);
        if (BOTH(7)) GRID_BAR();
    }
    if (IN(8)) {
        { int tq_ = threadIdx.x; asm volatile("" : "+v"(tq_)); F.tid = tq_; F.lane = tq_ & 63; }
        pg::DenseSched S{(const char*)MIX, (const char*)WOUT, D * 2, D * 2, T / 256, D / 256, F.G, (int)blockIdx.x};
        pg::EpiOut E{x, H};
        pg::gemm_phase<pg::EpiOut, pg::DenseSched, true>(F.lds, D, S, E);
        if (BOTH(8)) GRID_BAR();
    }
    if (IN(9)) {
        { int tq_ = threadIdx.x; asm volatile("" : "+v"(tq_)); F.tid = tq_; F.lane = tq_ & 63; }
        const float* gf = args.in[18]; const float* w_r = args.in[19]; const float* b_r = args.in[20];
        LAS float* rs = (LAS float*)(F.lds);
        LAS float* part = (LAS float*)(F.lds + 1024);
        LAS int* hist = (LAS int*)(F.lds + 1024 + 2 * 128 * 33 * 4);
        for (int tb = blockIdx.x; tb < T / 128; tb += F.G) {
            const int row0 = tb * 128;
            if (F.tid < 32) hist[F.tid] = 0;
            {
                f32x4 gg[4];
#pragma unroll
                for (int jq = 0; jq < 4; ++jq) gg[jq] = *(const f32x4*)(gf + 4 * F.lane + 256 * jq);
                f32x4 nx[4];
#pragma unroll
                for (int jq = 0; jq < 4; ++jq) nx[jq] = *(const f32x4*)(H + (size_t)(row0 + F.wave * 16) * D + 4 * F.lane + 256 * jq);
                for (int rr = 0; rr < 16; ++rr) {
                    const int r = F.wave * 16 + rr;
                    f32x4 v[4];
#pragma unroll
                    for (int jq = 0; jq < 4; ++jq) v[jq] = nx[jq];
                    if (rr < 15) {
#pragma unroll
                        for (int jq = 0; jq < 4; ++jq) nx[jq] = *(const f32x4*)(H + (size_t)(row0 + r + 1) * D + 4 * F.lane + 256 * jq); }
                    float ss = 0.f;
#pragma unroll
                    for (int jq = 0; jq < 4; ++jq) ss += v[jq].x * v[jq].x + v[jq].y * v[jq].y + v[jq].z * v[jq].z + v[jq].w * v[jq].w;
                    ss = wave_sum(ss);
                    const float rstd = rsqrtf(ss * (1.f / D) + 1e-5f);
                    if (F.lane == 0) rs[r] = rstd;
#pragma unroll
                    for (int jq = 0; jq < 4; ++jq) *(unsigned*)(HN8 + (size_t)(row0 + r) * D + 4 * F.lane + 256 * jq) = pk4_fp8(v[jq].x * rstd * gg[jq].x, v[jq].y * rstd * gg[jq].y, v[jq].z * rstd * gg[jq].z, v[jq].w * rstd * gg[jq].w);
                }
            }
            {
                const int rg = F.wave & 3, kh = F.wave >> 2, i = F.lane & 31, hh = F.lane >> 5;
                f32x16 acc;
#pragma unroll
                for (int q = 0; q < 16; ++q) acc[q] = 0.f;
                const float* hp = H + (size_t)(row0 + rg * 32 + i) * D + kh * 512 + 4 * hh;
                const float* wp = w_r + (size_t)(kh * 512 + 4 * hh) * NE + i; const float* gp = gf + kh * 512 + 4 * hh;
                f32x4 a0[4], g0[4], a1[4], g1[4]; f32x4 w0[4], w1[4];
#pragma unroll
                for (int u = 0; u < 4; ++u) { a0[u] = *(const f32x4*)(hp + 8 * u); g0[u] = *(const f32x4*)(gp + 8 * u);
                    w0[u] = (f32x4){wp[(size_t)(8 * u + 0) * NE], wp[(size_t)(8 * u + 1) * NE], wp[(size_t)(8 * u + 2) * NE], wp[(size_t)(8 * u + 3) * NE]}; }
                for (int k0 = 0; k0 < 512; k0 += 64) {
#pragma unroll
                    for (int u = 0; u < 4; ++u) { const int kk = k0 + 32 + 8 * u; a1[u] = *(const f32x4*)(hp + kk); g1[u] = *(const f32x4*)(gp + kk);
                        w1[u] = (f32x4){wp[(size_t)(kk + 0) * NE], wp[(size_t)(kk + 1) * NE], wp[(size_t)(kk + 2) * NE], wp[(size_t)(kk + 3) * NE]}; }
#pragma unroll
                    for (int u = 0; u < 4; ++u) { const f32x4 bb = w0[u] * g0[u];
                        acc = __builtin_amdgcn_mfma_f32_32x32x2f32(a0[u].x, bb.x, acc, 0, 0, 0); acc = __builtin_amdgcn_mfma_f32_32x32x2f32(a0[u].y, bb.y, acc, 0, 0, 0);
                        acc = __builtin_amdgcn_mfma_f32_32x32x2f32(a0[u].z, bb.z, acc, 0, 0, 0); acc = __builtin_amdgcn_mfma_f32_32x32x2f32(a0[u].w, bb.w, acc, 0, 0, 0); }
                    if (k0 + 64 < 512) {
#pragma unroll
                        for (int u = 0; u < 4; ++u) { const int kk = k0 + 64 + 8 * u; a0[u] = *(const f32x4*)(hp + kk); g0[u] = *(const f32x4*)(gp + kk);
                            w0[u] = (f32x4){wp[(size_t)(kk + 0) * NE], wp[(size_t)(kk + 1) * NE], wp[(size_t)(kk + 2) * NE], wp[(size_t)(kk + 3) * NE]}; } }
#pragma unroll
                    for (int u = 0; u < 4; ++u) { const f32x4 bb = w1[u] * g1[u];
                        acc = __builtin_amdgcn_mfma_f32_32x32x2f32(a1[u].x, bb.x, acc, 0, 0, 0); acc = __builtin_amdgcn_mfma_f32_32x32x2f32(a1[u].y, bb.y, acc, 0, 0, 0);
                        acc = __builtin_amdgcn_mfma_f32_32x32x2f32(a1[u].z, bb.z, acc, 0, 0, 0); acc = __builtin_amdgcn_mfma_f32_32x32x2f32(a1[u].w, bb.w, acc, 0, 0, 0); }
                }
#pragma unroll
                for (int q = 0; q < 16; ++q) { const int r = rg * 32 + (q & 3) + 8 * (q >> 2) + 4 * hh; part[(kh * 128 + r) * 33 + i] = acc[q]; }
            }
            __syncthreads();
            if (F.tid < 128) {
                const int r = F.tid; const float rstd = rs[r];
                float best[4]; int bi[4];
                for (int e = 0; e < 32; ++e) part[r * 33 + e] = (part[r * 33 + e] + part[(128 + r) * 33 + e]) * rstd + b_r[e];
#pragma unroll
                for (int k = 0; k < 4; ++k) {
                    float bv = -INFINITY; int be = 0;
                    for (int e = 0; e < 32; ++e) { const float l = part[r * 33 + e]; if (l > bv) { bv = l; be = e; } }
                    best[k] = bv; bi[k] = be; part[r * 33 + be] = -INFINITY;
                }
                const float e1 = __expf(best[1] - best[0]), e2 = __expf(best[2] - best[0]), e3 = __expf(best[3] - best[0]);
                const float inv = 1.f / (1.f + e1 + e2 + e3);
                *(int4*)(topi + (size_t)(row0 + r) * 4) = make_int4(bi[0], bi[1], bi[2], bi[3]);
                *(f32x4*)(topg + (size_t)(row0 + r) * 4) = (f32x4){inv, e1 * inv, e2 * inv, e3 * inv};
#pragma unroll
                for (int k = 0; k < 4; ++k) __hip_atomic_fetch_add(&hist[bi[k]], 1, __ATOMIC_RELAXED, __HIP_MEMORY_SCOPE_WORKGROUP);
            }
            __syncthreads();
            if (F.tid < 32) CNT[tb * 32 + F.tid] = hist[F.tid];
            __syncthreads();
        }
        if (BOTH(9)) GRID_BAR();
    }
    if (IN(10)) {
        { int tq_ = threadIdx.x; asm volatile("" : "+v"(tq_)); F.tid = tq_; F.lane = tq_ & 63; }
        LAS int* sb = (LAS int*)(F.lds);
        for (int tb = blockIdx.x; tb < T / 128; tb += F.G) {
            const int e = F.tid & 31, pt = F.tid >> 5;
            int sbef = 0, stot = 0;
            for (int w = pt * 16; w < pt * 16 + 16; ++w) { const int c = __hip_atomic_load(CNT + w * 32 + e, RLX_AGENT); stot += c; if (w < tb) sbef += c; }
            sb[pt * 32 + e] = sbef; sb[512 + pt * 32 + e] = stot;
            __syncthreads();
            if (F.tid < 32) { int b = 0, t = 0; for (int p = 0; p < 16; ++p) { b += sb[p * 32 + F.tid]; t += sb[512 + p * 32 + F.tid]; } sb[1024 + F.tid] = b; sb[1056 + F.tid] = t; sb[1120 + F.tid] = 0; }
            __syncthreads();
            if (F.tid == 0) { int ps = 0; for (int q = 0; q < 32; ++q) { sb[1088 + q] = ps; ps += ((sb[1056 + q] + MT - 1) / MT) * MT; } }
            __syncthreads();
            if (tb == 0 && F.tid < 32) ecnt[F.tid] = sb[1056 + F.tid];
            {
                const int a = tb * 512 + F.tid; const int ex = topi[a];
                const int lp = __hip_atomic_fetch_add(&sb[1120 + ex], 1, __ATOMIC_RELAXED, __HIP_MEMORY_SCOPE_WORKGROUP);
                const int slot = sb[1088 + ex] + sb[1024 + ex] + lp;
                slot_tok[slot] = a >> 2; tok_slot[a] = slot;
            }
            __syncthreads();
        }
        if (BOTH(10)) GRID_BAR();
    }
    if (IN(11) || IN(12)) {
        { int tq_ = threadIdx.x; asm volatile("" : "+v"(tq_)); F.tid = tq_; F.lane = tq_ & 63; }
        LAS int* til = (LAS int*)(F.lds + TIL_OFF);
        if (F.tid == 0) { int nt = 0; for (int e = 0; e < NE; ++e) { const int c = __hip_atomic_load(ecnt + e, RLX_AGENT); for (int r = 0; r < c; r += MT) { til[nt] = e; til[MAXTILES + nt] = (c - r) < MT ? (c - r) : MT; ++nt; } } til[2 * MAXTILES] = nt; }
        __syncthreads();
        if (IN(11)) {
            MoeSched S{(const char*)HN8, (const char*)WUP8, slot_tok, args.in[22], til, (LAS int*)(F.lds + IDX_OFF), (LAS float*)(F.lds + BIAS_OFF), D, D, 8, 2 * FF, F.G, (int)blockIdx.x, 1};
            pg::EpiUp E{(const LAS float*)(F.lds + BIAS_OFF), ACT8};
            pg::gemm_phase<pg::EpiUp, MoeSched, true, true>(F.lds, D, S, E);
            if (BOTH(11)) GRID_BAR();
        }
        if (IN(12)) {
            MoeSched S{(const char*)ACT8, (const char*)WDN8, slot_tok, args.in[24], til, (LAS int*)(F.lds + IDX_OFF), (LAS float*)(F.lds + BIAS_OFF), FF, FF, 4, D, F.G, (int)blockIdx.x, 0};
            pg::EpiDown E{(const LAS float*)(F.lds + BIAS_OFF), YS};
            pg::gemm_phase<pg::EpiDown, MoeSched, true, true>(F.lds, FF, S, E);
            if (BOTH(12)) GRID_BAR();
        }
    }
    if (IN(13)) {
        { int tq_ = threadIdx.x; asm volatile("" : "+v"(tq_)); F.tid = tq_; F.lane = tq_ & 63; }
        const float* gfin = args.in[25]; float* out = args.out;
        for (int row = gw; row < T; row += NGW) {
            f32x4 v[4];
#pragma unroll
            for (int j = 0; j < 4; ++j) v[j] = *(const f32x4*)(H + (size_t)row * D + 4 * F.lane + 256 * j);
            const int4 sl = *(const int4*)(tok_slot + (size_t)row * 4); const f32x4 gt = *(const f32x4*)(topg + (size_t)row * 4);
#pragma unroll
            for (int k = 0; k < 4; ++k) {
                const int s = k == 0 ? sl.x : k == 1 ? sl.y : k == 2 ? sl.z : sl.w;
#pragma unroll
                for (int j = 0; j < 4; ++j) { const unsigned y = *(const unsigned*)(YS + (size_t)s * D + 4 * F.lane + 256 * j);
                    typedef float f32x2_ __attribute__((ext_vector_type(2)));
                    const f32x2_ ylo = __builtin_amdgcn_cvt_pk_f32_fp8(y, false), yhi = __builtin_amdgcn_cvt_pk_f32_fp8(y, true);
                    v[j].x += gt[k] * ylo.x; v[j].y += gt[k] * ylo.y; v[j].z += gt[k] * yhi.x; v[j].w += gt[k] * yhi.y; }
            }
            float ss = 0.f;
#pragma unroll
            for (int j = 0; j < 4; ++j) ss += v[j].x * v[j].x + v[j].y * v[j].y + v[j].z * v[j].z + v[j].w * v[j].w;
            ss = wave_sum(ss);
            const float rstd = rsqrtf(ss * (1.f / D) + 1e-5f);
#pragma unroll
            for (int j = 0; j < 4; ++j) { const f32x4 gg = *(const f32x4*)(gfin + 4 * F.lane + 256 * j); *(f32x4*)(out + (size_t)row * D + 4 * F.lane + 256 * j) = v[j] * rstd * gg; }
        }
    }
#undef IN
#undef BOTH
}

extern "C" void kernel_launch(void* const* d_in, const int* in_sizes, int n_in, void* d_out, int out_size, void* d_ws, size_t ws_size, hipStream_t stream) {
    static int grid = 0;
    if (grid == 0) {
        int dev = 0, cus = 0, per_cu = 0;
        if (n_in != 26 || ws_size < WS_END) { fprintf(stderr, "kernel_launch: unexpected n_in %d / ws %zu\n", n_in, ws_size); grid = -1; return; }
        if (hipGetDevice(&dev) != hipSuccess || hipDeviceGetAttribute(&cus, hipDeviceAttributeMultiprocessorCount, dev) != hipSuccess) { grid = -1; return; }
        if (hipFuncSetAttribute((const void*)fwd, hipFuncAttributeMaxDynamicSharedMemorySize, LDS_BYTES) != hipSuccess) { fprintf(stderr, "kernel_launch: hipFuncSetAttribute failed\n"); grid = -1; return; }
        if (hipOccupancyMaxActiveBlocksPerMultiprocessor(&per_cu, (const void*)fwd, NTHR, LDS_BYTES) != hipSuccess || per_cu < 1) fprintf(stderr, "kernel_launch: occupancy query reports %d\n", per_cu);
        (void)hipGetLastError();
        grid = cus;
    }
    if (grid < 0) return;
    (void)in_sizes; (void)out_size;
    unsigned char* ws = (unsigned char*)d_ws;
    (void)hipMemsetAsync(ws + WS_CTL, 0, CTL_ZERO_BYTES, stream);
    Args a{};
    for (int i = 0; i < 26; ++i) a.in[i] = (const float*)d_in[i];
    a.out = (float*)d_out; a.ws = ws;
    a.ph_lo = 0; a.ph_hi = 14; a.li = 0; a.pad = 0;
    hipLaunchKernelGGL(fwd, dim3(grid), dim3(NTHR), LDS_BYTES, stream, a);
#if PROBE_LO >= 0
    a.ph_lo = PROBE_LO; a.ph_hi = PROBE_HI; a.li = 1; a.pad = PROBE_PAD;
    hipLaunchKernelGGL(fwd, dim3(grid), dim3(NTHR), LDS_BYTES, stream, a);
#endif
}
```

```cpp
#include <hip/hip_runtime.h>
#include <cstdio>
#include <cstdint>

#define GAS __attribute__((address_space(1)))
#define LAS __attribute__((address_space(3)))
typedef unsigned short bf16;
typedef short bf16x8 __attribute__((ext_vector_type(8)));
typedef float f32x4 __attribute__((ext_vector_type(4)));
typedef float f32x16 __attribute__((ext_vector_type(16)));
typedef unsigned u32x4 __attribute__((ext_vector_type(4)));
typedef unsigned u32x2 __attribute__((ext_vector_type(2)));
typedef GAS unsigned gu32;

#define PROBE_LO -1
#define PROBE_HI -1
#define PROBE_PAD 0
constexpr int NB = 4, SEQ = 8192, T = NB * SEQ, D = 1024;
constexpr int DIN = 2568, NPROJ = 2560;
constexpr int O_Q = 512, O_K = 1024, O_V = 1536, O_O = 2048, O_G = 2560;
constexpr int NE = 32, TOPK = 4, FF = 1024;
constexpr int NASSIGN = T * TOPK;
constexpr int MT = 256;
constexpr int NSLOTS = NASSIGN + NE * MT;
constexpr int MAXTILES = NSLOTS / MT;
constexpr int NWAVES = 8, NTHR = 512;
constexpr float W8_SCALE = 64.f, W8_INV = 1.f / 64.f;

constexpr size_t MiB = 1u << 20;
constexpr size_t WS_CTL = 0, CTL_ZERO_BYTES = 1 * MiB;
constexpr size_t WS_GATES = 1 * MiB;
constexpr size_t WS_TOPI = 2 * MiB;
constexpr size_t WS_TOPG = 3 * MiB;
constexpr size_t WS_SLOTTOK = 4 * MiB;
constexpr size_t WS_TOKSLOT = 5 * MiB;
constexpr size_t WS_CNT = 6 * MiB;
constexpr size_t WS_WIN = 8 * MiB;
constexpr size_t WS_WGLU = 13 * MiB;
constexpr size_t WS_WOUT = 14 * MiB;
constexpr size_t WS_WUP = 16 * MiB;
constexpr size_t WS_WDN = 144 * MiB;
constexpr size_t WS_HN = 208 * MiB;
constexpr size_t WS_PROJ = 272 * MiB;
constexpr size_t WS_GY = 432 * MiB;
constexpr size_t WS_MIX = 464 * MiB;
constexpr size_t WS_HRAW = 528 * MiB;
constexpr size_t WS_ACT = 272 * MiB;
constexpr size_t WS_H = 592 * MiB;
constexpr size_t WS_YS = 720 * MiB;
constexpr size_t WS_END = 992 * MiB;
constexpr int S5K = 1152;
constexpr size_t WS_S5A = 720 * MiB;
constexpr size_t WS_S5BT = 760 * MiB;
constexpr size_t WS_S5BQ = 836 * MiB;
constexpr size_t WS_XLOC = 856 * MiB;
constexpr size_t WS_QH = 866 * MiB;
constexpr size_t WS_KH = 898 * MiB;
constexpr size_t WS_VT = 930 * MiB;
constexpr size_t WS_DC = 962 * MiB;
constexpr size_t WS_CST = 978 * MiB;
constexpr size_t WS_FLOC = 986 * MiB;
constexpr size_t WS_DN = 987 * MiB;
constexpr size_t WS_NST = 988 * MiB;
constexpr size_t WS_SEGS = 989 * MiB;
constexpr size_t WS_KTAB = 990 * MiB;
static_assert(WS_S5A + (size_t)32 * 512 * S5K * 2 <= WS_S5BT && WS_S5BT + (size_t)32 * 1024 * S5K * 2 <= WS_S5BQ && WS_S5BQ + (size_t)32 * 256 * 1024 * 2 <= WS_XLOC && WS_XLOC + (size_t)32 * 512 * 128 * 4 <= WS_END, "s5 map");
static_assert(WS_ACT + (size_t)NSLOTS * FF * 2 <= WS_H && WS_YS + (size_t)NSLOTS * D * 2 <= WS_END, "ws map");
constexpr int CW_BAR = 4096;

constexpr int RING_BYTES = 131072;
constexpr int MISC_OFF = RING_BYTES;
constexpr int IDX_OFF = MISC_OFF + 128;
constexpr int TIL_OFF = IDX_OFF + 2048;
constexpr int BIAS_OFF = TIL_OFF + 3 * MAXTILES * 4 + 256;
constexpr int LDS_BYTES = 147456;
static_assert(BIAS_OFF + 3 * 1024 <= LDS_BYTES && (BIAS_OFF & 15) == 0, "LDS map");

#define RLX_AGENT __ATOMIC_RELAXED, __HIP_MEMORY_SCOPE_AGENT
__device__ __forceinline__ float bf2f(bf16 v) { return __uint_as_float(((unsigned)v) << 16); }
__device__ __forceinline__ bf16 f2bf(float f) { unsigned u = __float_as_uint(f); u += 0x7fffu + ((u >> 16) & 1u); return (bf16)(u >> 16); }
__device__ __forceinline__ unsigned pk2(float lo, float hi) { return (unsigned)f2bf(lo) | ((unsigned)f2bf(hi) << 16); }
__device__ __forceinline__ unsigned cvt_pk_bf16(float lo, float hi) { unsigned r; asm volatile("v_cvt_pk_bf16_f32 %0, %1, %2" : "=v"(r) : "v"(lo), "v"(hi)); return r; }
__device__ __forceinline__ unsigned pk4_fp8(float a, float b, float c, float d) { unsigned w = 0u; w = __builtin_amdgcn_cvt_pk_fp8_f32(a, b, w, false); w = __builtin_amdgcn_cvt_pk_fp8_f32(c, d, w, true); return w; }
__device__ __forceinline__ float lo_bf(unsigned u) { return __uint_as_float(u << 16); }
__device__ __forceinline__ float hi_bf(unsigned u) { return __uint_as_float(u & 0xffff0000u); }
__device__ __forceinline__ f32x4 ldbf4(const bf16* p) { const uint2 u = *(const uint2*)p; return (f32x4){lo_bf(u.x), hi_bf(u.x), lo_bf(u.y), hi_bf(u.y)}; }
__device__ __forceinline__ float wave_sum(float v) {
#pragma unroll
    for (int o = 1; o < 64; o <<= 1) v += __shfl_xor(v, o);
    return v;
}
__device__ __forceinline__ float sigmoidf_(float x) { return __builtin_amdgcn_rcpf(1.f + __builtin_amdgcn_exp2f(-1.4426950408889634f * x)); }
__device__ __forceinline__ void fcis(float x, float* sn, float* cs) { const float C = 0.15915494309189535f; const float rev = x * C; const float err = fmaf(x, C, -rev); const float fr = (rev - rintf(rev)) + err; *sn = __builtin_amdgcn_sinf(fr); *cs = __builtin_amdgcn_cosf(fr); }
__device__ __forceinline__ float gelu_tanh(float x) { const float u = 1.5957691216057308f * (x + 0.044715f * x * x * x); return x * __builtin_amdgcn_rcpf(1.f + __builtin_amdgcn_exp2f(-1.4426950408889634f * u)); }

#define XB_TMO      128
#define XB_XCNT(j)  (256  + 64 * (j))
#define XB_XSUB(j)  (1280 + 64 * (j))
#define XB_XGEN(j)  (2304 + 64 * (j))
#define XB_TOP      3328
#define XB_TOPGEN   3392
#define XCD_BAR_WORDS 3456
#define XB_SPIN_CAP (1u << 18)
__device__ __forceinline__ unsigned xb_ld(unsigned* p)              { return __hip_atomic_load(p, __ATOMIC_RELAXED, __HIP_MEMORY_SCOPE_AGENT); }
__device__ __forceinline__ unsigned xb_add(unsigned* p, unsigned v) { return __hip_atomic_fetch_add(p, v, __ATOMIC_RELAXED, __HIP_MEMORY_SCOPE_AGENT); }
__device__ __forceinline__ unsigned xb_xcc_id() { return (unsigned)__builtin_amdgcn_s_getreg((3 << 11) | 20) & 0xFu; }
#define XB_SPIN(cond, bar) do { unsigned _sp = 0; while (cond) { __builtin_amdgcn_s_sleep(1); \
    if ((++_sp & 255u) == 0u) { if (xb_ld(&(bar)[XB_TMO])) break; if (_sp > XB_SPIN_CAP) { atomicAdd(&(bar)[XB_TMO], 1u); break; } } } } while (0)
struct XcdBarrier { unsigned* bar; unsigned x; volatile LAS unsigned* st; };
__device__ __forceinline__ XcdBarrier xcd_barrier_post(unsigned* bar, volatile LAS unsigned* st) {
    XcdBarrier b; b.bar = bar; b.x = xb_xcc_id(); b.st = st;
    if (threadIdx.x == 0) (void)xb_add(&bar[XB_XCNT(b.x)], 1u);
    return b;
}
__device__ __forceinline__ void xcd_barrier_complete(unsigned* bar, unsigned x, unsigned& nloc, unsigned& nx) {
    const unsigned G = gridDim.x * gridDim.y * gridDim.z;
    unsigned sum, cnt, mine, sp = 0u;
    for (;;) {
        sum = 0u; cnt = 0u; mine = 0u;
#pragma unroll
        for (unsigned j = 0; j < 16; ++j) { const unsigned c = xb_ld(&bar[XB_XCNT(j)]); sum += c; cnt += (c > 0u) ? 1u : 0u; mine = (j == x) ? c : mine; }
        if (sum == G) break;
        __builtin_amdgcn_s_sleep(1);
        if ((++sp & 255u) == 0u) { if (xb_ld(&bar[XB_TMO])) break; if (sp > XB_SPIN_CAP) { atomicAdd(&bar[XB_TMO], 1u); break; } }
    }
    nloc = mine > 0u ? mine : 1u; nx = cnt > 0u ? cnt : 1u;
}
__device__ __forceinline__ void xcd_barrier(const XcdBarrier& b) {
    asm volatile("s_waitcnt vmcnt(0)" ::: "memory");
    __syncthreads();
    if (threadIdx.x == 0) {
        unsigned* bar = b.bar;
        __builtin_amdgcn_s_waitcnt(0);
        unsigned nloc = b.st[0], nx = b.st[1];
        if (nloc == 0u) { xcd_barrier_complete(bar, b.x, nloc, nx); b.st[0] = nloc; b.st[1] = nx; }
        const unsigned old = xb_add(&bar[XB_XSUB(b.x)], 1u);
        const unsigned gen = old / nloc;
        if (old + 1u == (gen + 1u) * nloc) {
            __builtin_amdgcn_fence(__ATOMIC_RELEASE, "agent");
            asm volatile("s_waitcnt vmcnt(0)" ::: "memory");
            const unsigned og = xb_add(&bar[XB_TOP], 1u);
            const unsigned tg = og / nx;
            if (og + 1u == (tg + 1u) * nx) xb_add(&bar[XB_TOPGEN], 1u);
            else XB_SPIN(xb_ld(&bar[XB_TOPGEN]) == tg, bar);
            __builtin_amdgcn_fence(__ATOMIC_ACQUIRE, "agent");
            xb_add(&bar[XB_XGEN(b.x)], 1u);
            asm volatile("s_waitcnt vmcnt(0)" ::: "memory");
        } else {
            XB_SPIN(xb_ld(&bar[XB_XGEN(b.x)]) == gen, bar);
            __builtin_amdgcn_fence(__ATOMIC_ACQUIRE, "agent");
            asm volatile("s_waitcnt vmcnt(0)" ::: "memory");
        }
    }
    __syncthreads();
}

namespace pg {
constexpr int BM = 256, BK = 64, HALF = 128, HTB = HALF * BK * 2, STAGE_BYTES = 8 * HTB, NXCD = 8, WGM = 8;
__host__ __device__ __forceinline__ int lds_byte(int r, int c) { const int st = (r >> 4) * 2 + (c >> 5), rr = r & 15, cc = c & 31, ob = rr * 64 + cc * 2; return st * 1024 + (ob ^ (((ob >> 9) & 1) << 5)); }
__host__ __device__ __forceinline__ void stage_rc(int b, int& R, int& C) { const int st = b / 1024, sb = b % 1024, swz = sb ^ (((sb >> 9) & 1) << 5); R = (st >> 1) * 16 + swz / 64; C = (st & 1) * 32 + (swz % 64) / 2; }
__host__ __device__ __forceinline__ int perm32(int rho) { const int n = rho >> 4, i = rho & 15; return 8 * (i >> 2) + 4 * n + (i & 3); }

struct Unit { unsigned A, B; int pm, pn, e, nrows; };
__device__ __forceinline__ __amdgpu_buffer_rsrc_t mkrsrc(const void* p) { return __builtin_amdgcn_make_buffer_rsrc((void*)p, 0, 0x7fffffff, 0x00020000); }

__device__ __forceinline__ bool tile_order(int i, int G, int c, int nM, int nN, int& pm, int& pn) {
    const int nwg = nM * nN; const long L = (long)i * G + c; if (L >= nwg) return false;
    int wgid = (int)L; { const int q = nwg / NXCD, r = nwg % NXCD, xcd = wgid % NXCD, off = wgid / NXCD; wgid = (xcd < r ? xcd * (q + 1) : r * (q + 1) + (xcd - r) * q) + off; }
    const int nig = WGM * nN, gid = wgid / nig, fm = gid * WGM, gsz = (nM - fm) < WGM ? (nM - fm) : WGM;
    pm = fm + ((wgid % nig) % gsz); pn = (wgid % nig) / gsz; return true;
}
struct DenseSched {
    const char* A; const char* Bt; int lda2  , K2  , nM, nN, G, c;
    __device__ __forceinline__ bool next(int i, Unit& u) const { int pm, pn; if (!tile_order(i, G, c, nM, nN, pm, pn)) return false;
        u.A = (unsigned)pm * 256u * (unsigned)lda2; u.B = (unsigned)pn * 256u * (unsigned)K2; u.pm = pm; u.pn = pn; u.e = 0; u.nrows = 256; return true; }
    __device__ __forceinline__ __amdgpu_buffer_rsrc_t rsrcA() const { return mkrsrc(A); }
    __device__ __forceinline__ __amdgpu_buffer_rsrc_t rsrcB() const { return mkrsrc(Bt); }
    __device__ __forceinline__ void prefetch(const Unit&, int, int) const {}
    __device__ __forceinline__ unsigned aoff(const Unit&, int row, int) const { return (unsigned)row * (unsigned)lda2; }
};

typedef int i32x8 __attribute__((ext_vector_type(8)));
template <class Epi, class Sched, bool ALIGN_EPI, bool FP8 = false>
__device__ __forceinline__ void gemm_phase(LAS unsigned char* lds, const int K, const Sched& S, const Epi& E) {
    const int tid = threadIdx.x, wid = __builtin_amdgcn_readfirstlane(tid >> 6), lane = tid & 63, wr = wid >> 2, wc = wid & 3, fr = lane & 15, fq = lane >> 4;
    const int nt = FP8 ? K / 128 : K / BK;
    unsigned voffA[2][2], voffB[2];
#pragma unroll
    for (int i = 0; i < 1; ++i) { int R, C; if constexpr (FP8) { const int p = tid + 512 * i; R = p >> 3; C = (((p >> 1) & 3) ^ ((R >> 1) & 3)) * 32 + (p & 1) * 16; } else { stage_rc(tid * 16 + i * 8192, R, C); C *= 2; }
        const int Rb = Epi::PERM ? ((R & ~31) + perm32(R & 31)) : R; voffB[i] = (unsigned)(Rb * K * (FP8 ? 1 : 2) + C); }
    const unsigned kstep = (unsigned)(BK * 2);
    const unsigned hstep = (unsigned)HALF * K * (FP8 ? 1 : 2);
    const unsigned b64step = hstep / 2;
    const unsigned ldsw = (unsigned)wid * 1024u;
    const int aoff = FP8 ? (wr * 64 + fr) * 128 + ((fq ^ ((fr >> 1) & 3)) * 32) : lds_byte(wr * 64 + fr, fq * 8);
    const int boff = FP8 ? (wc * 32 + fr) * 128 + ((fq ^ ((fr >> 1) & 3)) * 32) : lds_byte(wc * 32 + fr, fq * 8);
#define PG_SA(b, h) (((b) * 2 + (h)) * HTB)
#define PG_SB(b, h) ((4 + (b) * 2 + (h)) * HTB)
#define PG_STAGE(bufoff, so, voff) do { _Pragma("unroll") for (int _i = 0; _i < 2; ++_i) \
        __builtin_amdgcn_raw_ptr_buffer_load_lds(rA, (LAS void*)(lds + (bufoff) + ldsw + _i * 8192), 16, (int)(voff)[_i], (int)(so), 0, 0); } while (0)
#define PG_STAGEB(bufoff, so) do { _Pragma("unroll") for (int _i = 0; _i < 2; ++_i) \
        __builtin_amdgcn_raw_ptr_buffer_load_lds(rB, (LAS void*)(lds + (bufoff) + ldsw + _i * 8192), 16, (int)voffB[0], (int)((so) + _i * b64step), 0, 0); } while (0)
#define PG_LD8(p, p2) __builtin_bit_cast(i32x8, __builtin_shufflevector(*(const LAS u32x4*)(p), *(const LAS u32x4*)(p2), 0, 1, 2, 3, 4, 5, 6, 7))
#define PG_LDA(dst, b, h) do { if constexpr (FP8) { _Pragma("unroll") for (int m = 0; m < 4; ++m) dst##8[m] = PG_LD8(lds + PG_SA(b, h) + aoff + m * 2048, lds + PG_SA(b, h) + aoff + m * 2048 + 16); } \
        else { _Pragma("unroll") for (int m = 0; m < 4; ++m) _Pragma("unroll") for (int k = 0; k < 2; ++k) dst[m][k] = *(const LAS bf16x8*)(lds + PG_SA(b, h) + aoff + m * 2048 + k * 1024); } } while (0)
#define PG_LDB(dst, b, h) do { if constexpr (FP8) { _Pragma("unroll") for (int n = 0; n < 2; ++n) dst##8[n] = PG_LD8(lds + PG_SB(b, h) + boff + n * 2048, lds + PG_SB(b, h) + boff + n * 2048 + 16); } \
        else { _Pragma("unroll") for (int n = 0; n < 2; ++n) _Pragma("unroll") for (int k = 0; k < 2; ++k) dst[n][k] = *(const LAS bf16x8*)(lds + PG_SB(b, h) + boff + n * 2048 + k * 1024); } } while (0)
#define PG_MMA(ai, bj, At, Bt) do { __builtin_amdgcn_s_setprio(1); if constexpr (FP8) { _Pragma("unroll") for (int m = 0; m < 4; ++m) _Pragma("unroll") for (int n = 0; n < 2; ++n) \
            acc[ai][bj][m][n] = __builtin_amdgcn_mfma_scale_f32_16x16x128_f8f6f4(Bt##8[n], At##8[m], acc[ai][bj][m][n], 0, 0, 0, 0, 0, 0); } \
        else { _Pragma("unroll") for (int m = 0; m < 4; ++m) _Pragma("unroll") for (int n = 0; n < 2; ++n) _Pragma("unroll") for (int k = 0; k < 2; ++k) \
            acc[ai][bj][m][n] = __builtin_amdgcn_mfma_f32_16x16x32_bf16(Bt[n][k], At[m][k], acc[ai][bj][m][n], 0, 0, 0); } __builtin_amdgcn_s_setprio(0); } while (0)
#define PG_WAIT_V(n) asm volatile("s_waitcnt vmcnt(" #n ")" ::: "memory")
#define PG_WAIT_L(n) asm volatile("s_waitcnt lgkmcnt(" #n ")" ::: "memory")
#define PG_BAR __builtin_amdgcn_s_barrier()
#define PG_SCHED __builtin_amdgcn_sched_barrier(0)
#define PG_SET_AOFF(u, ib) do { int _t = threadIdx.x; asm volatile("" : "+v"(_t));     \
        _Pragma("unroll") for (int _i = 0; _i < 2; ++_i) { int _R, _C; if constexpr (FP8) { const int _p = _t + 512 * _i; _R = _p >> 3; _C = (((_p >> 1) & 3) ^ ((_R >> 1) & 3)) * 32 + (_p & 1) * 16; } else { stage_rc(_t * 16 + _i * 8192, _R, _C); _C *= 2; } \
        voffA[0][_i] = S.aoff(u, _R, ib) + (unsigned)_C; voffA[1][_i] = S.aoff(u, _R + HALF, ib) + (unsigned)_C; } } while (0)
    Unit cur, nxt; int ui = 0;
    if (!S.next(0, cur)) return;
    f32x4 acc[2][2][4][2];
#pragma unroll
    for (int a = 0; a < 2; ++a)
#pragma unroll
        for (int b = 0; b < 2; ++b)
#pragma unroll
            for (int m = 0; m < 4; ++m)
#pragma unroll
                for (int n = 0; n < 2; ++n) acc[a][b][m][n] = (f32x4){0.f, 0.f, 0.f, 0.f};
    bf16x8 At[FP8 ? 1 : 4][2], B0[2][2], B1[2][2]; i32x8 At8[FP8 ? 4 : 1], B08[2], B18[2];
    const __amdgpu_buffer_rsrc_t rA = S.rsrcA(), rB = S.rsrcB();
    unsigned cA = cur.A, cB = cur.B;
    S.prefetch(cur, 0, 0);
    PG_WAIT_V(0); __syncthreads();
    PG_SET_AOFF(cur, 0);
    PG_STAGEB(PG_SB(0, 0), cB); PG_STAGEB(PG_SB(0, 1), cB + hstep); PG_STAGE(PG_SA(0, 0), cA, voffA[0]); PG_STAGE(PG_SA(0, 1), cA, voffA[1]);
    if (wr == 1) PG_BAR;
    PG_WAIT_V(2); PG_BAR;
    PG_STAGEB(PG_SB(1, 0), cB + kstep); PG_STAGE(PG_SA(1, 0), cA + kstep, voffA[0]); PG_STAGEB(PG_SB(1, 1), cB + hstep + kstep);
    PG_WAIT_V(6); PG_BAR;
    for (;;) {
        const bool has_next = S.next(ui + 1, nxt);
        const unsigned nA = has_next ? nxt.A : cA, nB = has_next ? nxt.B : cB;
        if (has_next) S.prefetch(nxt, (ui + 1) & 1, (ui + 1) % 3);
#pragma unroll 1
        for (int t = 0; t < nt; t += 2) {
            const bool last = (t == nt - 2);
            const unsigned a1 = cA + (unsigned)(t + 1) * kstep;
            const unsigned a2 = last ? nA : cA + (unsigned)(t + 2) * kstep, b2 = last ? nB : cB + (unsigned)(t + 2) * kstep;
            const unsigned a3 = a2 + kstep, b3 = b2 + kstep;
            PG_LDB(B0, 0, 0); PG_LDB(B1, 0, 1); PG_SCHED; PG_LDA(At, 0, 0); PG_STAGE(PG_SA(1, 1), a1, voffA[1]);
            PG_WAIT_V(8); PG_WAIT_L(0); PG_BAR; PG_MMA(0, 0, At, B0); PG_MMA(0, 1, At, B1); PG_BAR; PG_SCHED;
            if (last && has_next) PG_SET_AOFF(nxt, (ui + 1) & 1);
            PG_LDA(At, 0, 1); PG_STAGEB(PG_SB(0, 0), b2); PG_STAGEB(PG_SB(0, 1), b2 + hstep); PG_STAGE(PG_SA(0, 0), a2, voffA[0]);
            PG_WAIT_V(8); PG_WAIT_L(0); PG_BAR; PG_MMA(1, 0, At, B0); PG_MMA(1, 1, At, B1); PG_BAR; PG_SCHED;
            PG_LDB(B0, 1, 0); PG_LDB(B1, 1, 1); PG_SCHED; PG_LDA(At, 1, 0); PG_STAGE(PG_SA(0, 1), a2, voffA[1]);
            PG_WAIT_V(8); PG_WAIT_L(0); PG_BAR; PG_MMA(0, 0, At, B0); PG_MMA(0, 1, At, B1); PG_BAR; PG_SCHED;
            PG_LDA(At, 1, 1); PG_STAGEB(PG_SB(1, 0), b3); PG_STAGEB(PG_SB(1, 1), b3 + hstep); PG_STAGE(PG_SA(1, 0), a3, voffA[0]);
            PG_WAIT_V(8); PG_WAIT_L(0); PG_BAR; PG_MMA(1, 0, At, B0); PG_MMA(1, 1, At, B1); PG_BAR; PG_SCHED;
        }
        if constexpr (ALIGN_EPI) { if (wr == 0) PG_BAR; }
        {
            int tz = threadIdx.x; asm volatile("" : "+v"(tz)); const int lz = tz & 63;
            E(acc, cur, ui % 3, (tz >> 6) >> 2, (tz >> 6) & 3, lz & 15, lz >> 4);
        }
        if (!has_next) break;
#pragma unroll
        for (int a = 0; a < 2; ++a)
#pragma unroll
            for (int b = 0; b < 2; ++b)
#pragma unroll
                for (int m = 0; m < 4; ++m)
#pragma unroll
                    for (int n = 0; n < 2; ++n) acc[a][b][m][n] = (f32x4){0.f, 0.f, 0.f, 0.f};
        cur = nxt; cA = nA; cB = nB; ++ui;
        if constexpr (ALIGN_EPI) { if (wr == 1) PG_BAR; }
    }
    PG_WAIT_V(0);
    if constexpr (!ALIGN_EPI) { if (wr == 0) PG_BAR; }
    PG_BAR;
#undef PG_SA
#undef PG_SB
#undef PG_STAGE
#undef PG_STAGEB
#undef PG_LDA
#undef PG_LDB
#undef PG_MMA
#undef PG_LD8
#undef PG_WAIT_V
#undef PG_WAIT_L
#undef PG_BAR
#undef PG_SCHED
#undef PG_SET_AOFF
}

struct EpiProj {
    static constexpr bool PERM = true; bf16* P; bf16* S5A;
    __device__ __forceinline__ void operator()(const f32x4 (&acc)[2][2][4][2], const Unit& u, int bb, int wr, int wc, int fr, int fq) const {
        const int row0 = u.pm * BM + wr * 64 + fr, col0 = u.pn * BM + wc * 32 + 8 * fq;
#pragma unroll
        for (int ai = 0; ai < 2; ++ai)
#pragma unroll
            for (int m = 0; m < 4; ++m) { const int row = row0 + ai * HALF + m * 16; bf16* rowp = P + (size_t)row * NPROJ + col0;
                if (u.pn < 2) { const int b = row >> 13, tt = row & 8191; rowp = S5A + ((size_t)b * 128 + (tt >> 6)) * S5K + (tt & 63) * 16 + (col0 & 15) + (size_t)(col0 >> 4) * 512 * S5K - (size_t)0; }
#pragma unroll
                for (int bj = 0; bj < 2; ++bj) { const f32x4 v0 = acc[ai][bj][m][0], v1 = acc[ai][bj][m][1];
                    u32x4 w; w.x = cvt_pk_bf16(v0[0], v0[1]); w.y = cvt_pk_bf16(v0[2], v0[3]); w.z = cvt_pk_bf16(v1[0], v1[1]); w.w = cvt_pk_bf16(v1[2], v1[3]);
                    *(u32x4*)(rowp + (u.pn < 2 ? (size_t)bj * 8 * 512 * S5K : (size_t)bj * HALF)) = w; } }
    }
};
struct EpiXloc {
    static constexpr bool PERM = false; float* X;
    __device__ __forceinline__ void operator()(const f32x4 (&acc)[2][2][4][2], const Unit& u, int bb, int wr, int wc, int fr, int fq) const {
        const int row0 = (u.pm & 1) * BM + wr * 64 + fr, col0 = wc * 32 + 4 * fq;
#pragma unroll
        for (int ai = 0; ai < 2; ++ai)
#pragma unroll
            for (int m = 0; m < 4; ++m) { float* rp = X + ((size_t)u.e * 512 + row0 + ai * HALF + m * 16) * 128 + col0;
#pragma unroll
                for (int n = 0; n < 2; ++n) *(f32x4*)(rp + n * 16) = acc[ai][0][m][n]; }
    }
};
struct EpiS5Y {
    static constexpr bool PERM = true; const bf16* S5A; const float* dskip; bf16* GY;
    __device__ __forceinline__ void operator()(const f32x4 (&acc)[2][2][4][2], const Unit& u, int bb, int wr, int wc, int fr, int fq) const {
        const int g = u.e, rg0 = (u.pm & 1) * BM + wr * 64 + fr, c0 = u.pn * BM + wc * 32 + 8 * fq;
#pragma unroll
        for (int bj = 0; bj < 2; ++bj) { const int col = c0 + bj * HALF, t = col >> 4, p0 = col & 15;
            const f32x4 d0 = *(const f32x4*)(dskip + g * 16 + p0), d1 = *(const f32x4*)(dskip + g * 16 + p0 + 4);
#pragma unroll
            for (int ai = 0; ai < 2; ++ai)
#pragma unroll
                for (int m = 0; m < 4; ++m) { const int rg = rg0 + ai * HALF + m * 16; const int b = rg >> 7, c = rg & 127;
                    const u32x4 uu = *(const u32x4*)(S5A + ((size_t)g * 512 + rg) * S5K + col);
                    const f32x4 v0 = acc[ai][bj][m][0], v1 = acc[ai][bj][m][1];
                    u32x4 w;
                    w.x = cvt_pk_bf16(gelu_tanh(v0[0] + d0[0] * lo_bf(uu.x)), gelu_tanh(v0[1] + d0[1] * hi_bf(uu.x))); w.y = cvt_pk_bf16(gelu_tanh(v0[2] + d0[2] * lo_bf(uu.y)), gelu_tanh(v0[3] + d0[3] * hi_bf(uu.y)));
                    w.z = cvt_pk_bf16(gelu_tanh(v1[0] + d1[0] * lo_bf(uu.z)), gelu_tanh(v1[1] + d1[1] * hi_bf(uu.z))); w.w = cvt_pk_bf16(gelu_tanh(v1[2] + d1[2] * lo_bf(uu.w)), gelu_tanh(v1[3] + d1[3] * hi_bf(uu.w)));
                    *(u32x4*)(GY + ((size_t)b * SEQ + c * 64 + t) * 512 + g * 16 + p0) = w; } }
    }
};
struct S5Sched {
    const char* A; const char* B; int lda2, K2, brows, nN, G, c;
    __device__ __forceinline__ bool next(int i, Unit& u) const { const int L = i * G + c; if (L >= 64 * nN) return false;
        const int g = L / (2 * nN), r = L % (2 * nN), mh = r / nN, pn = r % nN;
        u.A = ((unsigned)g * 512u + mh * 256u) * (unsigned)lda2; u.B = ((unsigned)g * brows + pn * 256u) * (unsigned)K2; u.pm = g * 2 + mh; u.pn = pn; u.e = g; u.nrows = 256; return true; }
    __device__ __forceinline__ __amdgpu_buffer_rsrc_t rsrcA() const { return mkrsrc(A); }
    __device__ __forceinline__ __amdgpu_buffer_rsrc_t rsrcB() const { return mkrsrc(B); }
    __device__ __forceinline__ void prefetch(const Unit&, int, int) const {}
    __device__ __forceinline__ unsigned aoff(const Unit&, int row, int) const { return (unsigned)row * (unsigned)lda2; }
};
struct EpiGlu {
    static constexpr bool PERM = true; const bf16* GY; const float* bglu; bf16* MIX;
    __device__ __forceinline__ void operator()(const f32x4 (&acc)[2][2][4][2], const Unit& u, int bb, int wr, int wc, int fr, int fq) const {
        const int row0 = u.pm * BM + wr * 64 + fr, col0 = u.pn * BM + wc * 32 + 8 * fq;
#pragma unroll
        for (int bj = 0; bj < 2; ++bj) { const int col = col0 + bj * HALF;
            const f32x4 b0 = *(const f32x4*)(bglu + col), b1 = *(const f32x4*)(bglu + col + 4);
#pragma unroll
            for (int ai = 0; ai < 2; ++ai)
#pragma unroll
                for (int m = 0; m < 4; ++m) { const size_t row = (size_t)(row0 + ai * HALF + m * 16);
                    const u32x4 g = *(const u32x4*)(GY + row * 512 + col);
                    const f32x4 v0 = acc[ai][bj][m][0] + b0, v1 = acc[ai][bj][m][1] + b1;
                    u32x4 w;
                    w.x = cvt_pk_bf16(lo_bf(g.x) * sigmoidf_(v0[0]), hi_bf(g.x) * sigmoidf_(v0[1])); w.y = cvt_pk_bf16(lo_bf(g.y) * sigmoidf_(v0[2]), hi_bf(g.y) * sigmoidf_(v0[3]));
                    w.z = cvt_pk_bf16(lo_bf(g.z) * sigmoidf_(v1[0]), hi_bf(g.z) * sigmoidf_(v1[1])); w.w = cvt_pk_bf16(lo_bf(g.w) * sigmoidf_(v1[2]), hi_bf(g.w) * sigmoidf_(v1[3]));
                    *(u32x4*)(MIX + row * D + col) = w; } }
    }
};
struct EpiOut {
    static constexpr bool PERM = true; const float* x; bf16* H;
    __device__ __forceinline__ void operator()(const f32x4 (&acc)[2][2][4][2], const Unit& u, int bb, int wr, int wc, int fr, int fq) const {
        const int row0 = u.pm * BM + wr * 64 + fr, col0 = u.pn * BM + wc * 32 + 8 * fq;
#pragma unroll
        for (int ai = 0; ai < 2; ++ai)
#pragma unroll
            for (int m = 0; m < 4; ++m) { const size_t ro = (size_t)(row0 + ai * HALF + m * 16) * D + col0;
#pragma unroll
                for (int bj = 0; bj < 2; ++bj) { const f32x4 v0 = __builtin_nontemporal_load((const f32x4*)(x + ro + bj * HALF)) + acc[ai][bj][m][0], v1 = __builtin_nontemporal_load((const f32x4*)(x + ro + bj * HALF + 4)) + acc[ai][bj][m][1];
                    u32x4 w; w.x = cvt_pk_bf16(v0[0], v0[1]); w.y = cvt_pk_bf16(v0[2], v0[3]); w.z = cvt_pk_bf16(v1[0], v1[1]); w.w = cvt_pk_bf16(v1[2], v1[3]);
                    *(u32x4*)(H + ro + bj * HALF) = w; } }
    }
};
struct EpiUp {
    static constexpr bool PERM = true; const LAS float* bl; unsigned char* ACT;
    __device__ __forceinline__ void operator()(const f32x4 (&acc)[2][2][4][2], const Unit& u, int bb, int wr, int wc, int fr, int fq) const {
        const int row0 = u.pm * BM + wr * 64 + fr, j0 = u.pn * HALF + wc * 32 + 8 * fq;
        const LAS float* bg = bl + bb * 256 + wc * 32 + 8 * fq;
#pragma unroll
        for (int ai = 0; ai < 2; ++ai)
#pragma unroll
            for (int m = 0; m < 4; ++m) {
                float o[8];
#pragma unroll
                for (int n = 0; n < 2; ++n) { const f32x4 gb = *(const LAS f32x4*)(bg + 4 * n), lb = *(const LAS f32x4*)(bg + 128 + 4 * n);
#pragma unroll
                    for (int q = 0; q < 4; ++q) { const float g = fminf(acc[ai][0][m][n][q] * W8_INV + gb[q], 7.f); const float li = fminf(fmaxf(acc[ai][1][m][n][q] * W8_INV + lb[q], -7.f), 7.f);
                        o[n * 4 + q] = g * sigmoidf_(1.702f * g) * (li + 1.f); } }
                u32x2 w; w.x = pk4_fp8(o[0], o[1], o[2], o[3]); w.y = pk4_fp8(o[4], o[5], o[6], o[7]);
                *(u32x2*)(ACT + (size_t)(row0 + ai * HALF + m * 16) * FF + j0) = w; }
    }
};
struct EpiDown {
    static constexpr bool PERM = true; const LAS float* bl; unsigned char* YS;
    __device__ __forceinline__ void operator()(const f32x4 (&acc)[2][2][4][2], const Unit& u, int bb, int wr, int wc, int fr, int fq) const {
        const int row0 = u.pm * BM + wr * 64 + fr, col0 = u.pn * BM + wc * 32 + 8 * fq;
        const LAS float* bp = bl + bb * 256 + wc * 32 + 8 * fq;
#pragma unroll
        for (int ai = 0; ai < 2; ++ai)
#pragma unroll
            for (int m = 0; m < 4; ++m)
#pragma unroll
                for (int bj = 0; bj < 2; ++bj) { const f32x4 b0 = *(const LAS f32x4*)(bp + bj * HALF), b1 = *(const LAS f32x4*)(bp + bj * HALF + 4);
                    const f32x4 v0 = acc[ai][bj][m][0] * W8_INV + b0, v1 = acc[ai][bj][m][1] * W8_INV + b1;
                    u32x2 w; w.x = pk4_fp8(v0[0], v0[1], v0[2], v0[3]); w.y = pk4_fp8(v1[0], v1[1], v1[2], v1[3]);
                    *(u32x2*)(YS + (size_t)(row0 + ai * HALF + m * 16) * D + col0 + bj * HALF) = w; }
    }
};
}

struct MoeSched {
    const char* A; const char* W; const int* slot_tok; const float* bias; LAS int* til; LAS int* idx; LAS float* bl; int lda2, K2, nN, wrows  , G, c, gather;
    __device__ __forceinline__ bool next(int i, pg::Unit& u) const {
        const int nM = __builtin_amdgcn_readfirstlane(til[2 * MAXTILES]); int pm, pn; if (!pg::tile_order(i, G, c, nM, nN, pm, pn)) return false;
        pm = __builtin_amdgcn_readfirstlane(pm); pn = __builtin_amdgcn_readfirstlane(pn);
        const int e = __builtin_amdgcn_readfirstlane(til[pm]); u.pm = pm; u.pn = pn; u.e = e; u.nrows = __builtin_amdgcn_readfirstlane(til[MAXTILES + pm]);
        u.A = gather ? 0u : (unsigned)pm * 256u * (unsigned)lda2; u.B = ((unsigned)e * wrows + (unsigned)pn * 256u) * (unsigned)K2; return true; }
    __device__ __forceinline__ __amdgpu_buffer_rsrc_t rsrcA() const { return pg::mkrsrc(A); }
    __device__ __forceinline__ __amdgpu_buffer_rsrc_t rsrcB() const { return pg::mkrsrc(W); }
    __device__ __forceinline__ void prefetch(const pg::Unit& u, int ib, int bb) const {
        if (threadIdx.x >= 256 && threadIdx.x < 320) {
            const int l = threadIdx.x - 256;
            const float* src = gather ? bias + (size_t)u.e * 2 * FF + (l < 32 ? u.pn * 128 + 4 * l : FF + u.pn * 128 + 4 * (l - 32)) : bias + (size_t)u.e * D + u.pn * 256 + 4 * l;
            __builtin_amdgcn_global_load_lds((const unsigned*)src, (LAS unsigned*)(bl + bb * 256), 16, 0, 0); }
        if (gather && threadIdx.x < 256) { const int r = threadIdx.x; const int s = u.pm * 256 + (r < u.nrows ? r : u.nrows - 1);
            __builtin_amdgcn_global_load_lds((const unsigned*)(slot_tok + s), (LAS unsigned*)(idx + ib * 256 + (threadIdx.x & ~63)), 4, 0, 0); } }
    __device__ __forceinline__ unsigned aoff(const pg::Unit&, int row, int ib) const { return gather ? (unsigned)idx[ib * 256 + row] * (unsigned)lda2 : (unsigned)row * (unsigned)lda2; }
};

struct Frame {
    LAS unsigned char* lds; volatile LAS unsigned* MISC; gu32* ctl; int tid, lane, wave, vcu, G;
};
#define LDS_WAIT() asm volatile("s_waitcnt lgkmcnt(0)" ::: "memory")

template <bool F8, class RowMap>
__device__ __forceinline__ void transpose_item(const float* W, int ldw, int K, int nblk, void* WTv, LAS bf16* scr, int item, int lane, RowMap rowmap) {
    const int kb = item / nblk, nb = item % nblk, k0 = 64 * kb, n0 = 64 * nb;
    const float* src = W + (size_t)(k0 + (lane >> 4)) * ldw + n0 + 4 * (lane & 15);
    f32x4 v[16];
#pragma unroll
    for (int i = 0; i < 16; ++i) v[i] = __builtin_nontemporal_load((const f32x4*)(src + (size_t)(4 * i) * ldw));
#pragma unroll
    for (int i = 0; i < 16; ++i) { u32x2 o; o.x = pk2(v[i].x, v[i].y); o.y = pk2(v[i].z, v[i].w); *(LAS u32x2*)(scr + ((lane >> 4) + 4 * i) * 68 + 4 * (lane & 15)) = o; }
    LDS_WAIT(); asm volatile("" ::: "memory");
    const int c = lane & 7; const int r0 = rowmap(n0);
#pragma unroll
    for (int jn = 0; jn < 8; ++jn) { const int n = (lane >> 3) + 8 * jn; const LAS bf16* sp = scr + (8 * c) * 68 + n;
        if constexpr (F8) { u32x2 o; o.x = pk4_fp8(bf2f(sp[0]) * W8_SCALE, bf2f(sp[68]) * W8_SCALE, bf2f(sp[2 * 68]) * W8_SCALE, bf2f(sp[3 * 68]) * W8_SCALE);
            o.y = pk4_fp8(bf2f(sp[4 * 68]) * W8_SCALE, bf2f(sp[5 * 68]) * W8_SCALE, bf2f(sp[6 * 68]) * W8_SCALE, bf2f(sp[7 * 68]) * W8_SCALE);
            __builtin_nontemporal_store(o, (u32x2*)((unsigned char*)WTv + (size_t)(r0 + n) * K + k0 + 8 * c)); }
        else { u32x4 o; o.x = (unsigned)sp[0] | ((unsigned)sp[68] << 16); o.y = (unsigned)sp[2 * 68] | ((unsigned)sp[3 * 68] << 16); o.z = (unsigned)sp[4 * 68] | ((unsigned)sp[5 * 68] << 16); o.w = (unsigned)sp[6 * 68] | ((unsigned)sp[7 * 68] << 16);
            *(u32x4*)((bf16*)WTv + (size_t)(r0 + n) * K + k0 + 8 * c) = o; } }
    LDS_WAIT(); asm volatile("" ::: "memory");
}
struct RowId { __device__ __forceinline__ int operator()(int n0) const { return n0; } };
struct RowUp { __device__ __forceinline__ int operator()(int n0) const { return n0 < FF ? (n0 >> 7) * 256 + (n0 & 127) : ((n0 - FF) >> 7) * 256 + 128 + ((n0 - FF) & 127); } };

struct Args { const float* in[26]; float* out; unsigned char* ws; int ph_lo, ph_hi, li, pad; };

__global__ void __launch_bounds__(NTHR, 2) fwd(Args args) {
    extern __shared__ __attribute__((aligned(16))) unsigned char lds_raw[];
    Frame F;
    F.lds = (LAS unsigned char*)lds_raw;
    F.MISC = (volatile LAS unsigned*)(F.lds + MISC_OFF);
    F.tid = threadIdx.x; F.lane = F.tid & 63; F.wave = __builtin_amdgcn_readfirstlane(F.tid >> 6);
    F.G = gridDim.x; { const int bx = blockIdx.x; F.vcu = (F.G % 8 == 0) ? (bx % 8) * (F.G / 8) + bx / 8 : bx; }
    unsigned char* ws = args.ws;
    F.ctl = (gu32*)(ws + WS_CTL);
    if (F.tid < 32) ((LAS unsigned*)(F.lds + MISC_OFF))[F.tid] = 0u;
    __syncthreads();
    XcdBarrier bar = xcd_barrier_post((unsigned*)(F.ctl + CW_BAR) + args.li * XCD_BAR_WORDS, F.MISC + 8);
#define INP(i) (*(const float* const volatile*)((const char*)__builtin_amdgcn_kernarg_segment_ptr() + 8 * (i)))
    const int lo = args.ph_lo, hi = args.ph_hi;
#define IN(k) (lo <= (k) && (k) < hi)
#define BOTH(k) (IN(k) && IN((k) + 1))
#define GRID_BAR() xcd_barrier(bar)
    const float* x = args.in[0];
    bf16* WIN = (bf16*)(ws + WS_WIN); bf16* WGLU = (bf16*)(ws + WS_WGLU); bf16* WOUT = (bf16*)(ws + WS_WOUT); unsigned char* WUP8 = ws + WS_WUP; unsigned char* WDN8 = ws + WS_WDN;
    bf16* HN = (bf16*)(ws + WS_HN); bf16* PROJ = (bf16*)(ws + WS_PROJ); bf16* GY = (bf16*)(ws + WS_GY); bf16* MIX = (bf16*)(ws + WS_MIX);
    bf16* H = (bf16*)(ws + WS_H); unsigned char* ACT8 = ws + WS_ACT; unsigned char* HN8 = ws + WS_HN; unsigned char* YS = ws + WS_YS;
    float* gates = (float*)(ws + WS_GATES); int* topi = (int*)(ws + WS_TOPI); float* topg = (float*)(ws + WS_TOPG);
    int* slot_tok = (int*)(ws + WS_SLOTTOK); int* tok_slot = (int*)(ws + WS_TOKSLOT); int* CNT = (int*)(ws + WS_CNT); int* ecnt = CNT + 16384;
    bf16* S5A = (bf16*)(ws + WS_S5A); bf16* S5BT = (bf16*)(ws + WS_S5BT); bf16* S5BQ = (bf16*)(ws + WS_S5BQ); float* XLOC = (float*)(ws + WS_XLOC);
    bf16* QH = (bf16*)(ws + WS_QH); bf16* KH = (bf16*)(ws + WS_KH); bf16* VT = (bf16*)(ws + WS_VT); float* DC = (float*)(ws + WS_DC); bf16* CST = (bf16*)(ws + WS_CST);
    float* FLOC = (float*)(ws + WS_FLOC); float* DN = (float*)(ws + WS_DN); float* NST = (float*)(ws + WS_NST); float* SEGS = (float*)(ws + WS_SEGS); float* KTAB = (float*)(ws + WS_KTAB);
    const int gw = F.vcu * NWAVES + F.wave, NGW = F.G * NWAVES;

    if (IN(0)) {
        { int tq_ = threadIdx.x; asm volatile("" : "+v"(tq_)); F.tid = tq_; F.lane = tq_ & 63; }
        LAS bf16* scr = (LAS bf16*)(F.lds + F.wave * 16384);
        constexpr int I_IN = (D / 64) * (NPROJ / 64), I_GLU = (512 / 64) * (512 / 64), I_OUT = (D / 64) * (D / 64), I_UP = (D / 64) * (2 * FF / 64), I_DN = (FF / 64) * (D / 64);
        constexpr int NITEMS = I_IN + I_GLU + I_OUT + NE * I_UP + NE * I_DN;
        for (int it = gw; it < NITEMS && !(args.pad & 1); it += NGW) {
            int r = it;
            if (r < I_IN) { transpose_item<false>(args.in[2], DIN, D, NPROJ / 64, WIN, scr, r, F.lane, RowId()); continue; } r -= I_IN;
            if (r < I_GLU) { transpose_item<false>(args.in[11], 512, 512, 512 / 64, WGLU, scr, r, F.lane, RowId()); continue; } r -= I_GLU;
            if (r < I_OUT) { transpose_item<false>(args.in[17], D, D, D / 64, WOUT, scr, r, F.lane, RowId()); continue; } r -= I_OUT;
            if (r < NE * I_UP) { const int e = r / I_UP; transpose_item<true>(args.in[21] + (size_t)e * D * 2 * FF, 2 * FF, D, 2 * FF / 64, WUP8 + (size_t)e * 2 * FF * D, scr, r % I_UP, F.lane, RowUp()); continue; } r -= NE * I_UP;
            { const int e = r / I_DN; transpose_item<true>(args.in[23] + (size_t)e * FF * D, D, FF, D / 64, WDN8 + (size_t)e * D * FF, scr, r % I_DN, F.lane, RowId()); }
        }
        {
            const float* g = args.in[1]; const float* w_in = args.in[2]; const float* b_gates = args.in[15];
            float wg[16][8]; f32x4 gg[4];
#pragma unroll
            for (int jq = 0; jq < 4; ++jq) { gg[jq] = *(const f32x4*)(g + 4 * F.lane + 256 * jq);
#pragma unroll
                for (int i = 0; i < 4; ++i) { const int k = 4 * F.lane + 256 * jq + i; const f32x4 w0 = *(const f32x4*)(w_in + (size_t)k * DIN + O_G), w1 = *(const f32x4*)(w_in + (size_t)k * DIN + O_G + 4);
                    wg[4 * jq + i][0] = w0.x; wg[4 * jq + i][1] = w0.y; wg[4 * jq + i][2] = w0.z; wg[4 * jq + i][3] = w0.w; wg[4 * jq + i][4] = w1.x; wg[4 * jq + i][5] = w1.y; wg[4 * jq + i][6] = w1.z; wg[4 * jq + i][7] = w1.w; } }
            float bgv[8];
#pragma unroll
            for (int q = 0; q < 8; ++q) bgv[q] = b_gates[q];
            f32x4 nx[4];
            if (gw < T) {
#pragma unroll
                for (int jq = 0; jq < 4; ++jq) nx[jq] = __builtin_nontemporal_load((const f32x4*)(x + (size_t)gw * D + 4 * F.lane + 256 * jq)); }
            for (int row = gw; row < T && !(args.pad & 2); row += NGW) {
                f32x4 v[4];
#pragma unroll
                for (int jq = 0; jq < 4; ++jq) v[jq] = nx[jq];
                if (row + NGW < T) {
#pragma unroll
                    for (int jq = 0; jq < 4; ++jq) nx[jq] = __builtin_nontemporal_load((const f32x4*)(x + (size_t)(row + NGW) * D + 4 * F.lane + 256 * jq)); }
                float ss = 0.f;
#pragma unroll
                for (int jq = 0; jq < 4; ++jq) ss += v[jq].x * v[jq].x + v[jq].y * v[jq].y + v[jq].z * v[jq].z + v[jq].w * v[jq].w;
                ss = wave_sum(ss);
                const float rstd = rsqrtf(ss * (1.f / D) + 1e-5f);
                float ga[8] = {0, 0, 0, 0, 0, 0, 0, 0};
#pragma unroll
                for (int jq = 0; jq < 4; ++jq) {
                    v[jq] = v[jq] * rstd * gg[jq];
#pragma unroll
                    for (int i = 0; i < 4; ++i)
#pragma unroll
                        for (int q = 0; q < 8; ++q) ga[q] += v[jq][i] * wg[4 * jq + i][q];
                    uint2 o; o.x = pk2(v[jq].x, v[jq].y); o.y = pk2(v[jq].z, v[jq].w);
                    *(uint2*)(HN + (size_t)row * D + 4 * F.lane + 256 * jq) = o;
                }
#pragma unroll
                for (int q = 0; q < 8; ++q) ga[q] = wave_sum(ga[q]);
                if (F.lane == 0) { *(f32x4*)(gates + (size_t)row * 8) = (f32x4){ga[0] + bgv[0], ga[1] + bgv[1], ga[2] + bgv[2], ga[3] + bgv[3]}; *(f32x4*)(gates + (size_t)row * 8 + 4) = (f32x4){ga[4] + bgv[4], ga[5] + bgv[5], ga[6] + bgv[6], ga[7] + bgv[7]}; }
            }
        }
        __syncthreads();
        for (int un = F.vcu; un < 256 && !(args.pad & 4); un += F.G) {
            const int g = un >> 3, j = un & 7;
            LAS float* Ere = (LAS float*)F.lds; LAS float* Eim = Ere + 8 * 64;
            LAS float* Bbr = Eim + 8 * 64; LAS float* Bbi = Bbr + 1024;
            LAS float* Cr = Bbi + 1024; LAS float* Ci = Cr + 1024;
            const float dt = __expf(args.in[3][g]);
            if (F.tid < 64) { const int n = F.tid;
                const float are = fminf(args.in[4][g * 64 + n], -1e-4f), aim = args.in[5][g * 64 + n];
                const float mag = __expf(dt * are); float sn, cs; fcis(dt * aim, &sn, &cs);
                const float nr = mag * cs - 1.f, ni = mag * sn, dn = are * are + aim * aim;
                const float cfr = (nr * are + ni * aim) / dn, cfi = (ni * are - nr * aim) / dn;
                for (int q = 0; q < 16; ++q) { const float br = args.in[6][(g * 64 + n) * 16 + q], bi = args.in[7][(g * 64 + n) * 16 + q]; Bbr[n * 16 + q] = cfr * br - cfi * bi; Bbi[n * 16 + q] = cfr * bi + cfi * br; }
            }
            for (int i = F.tid; i < 1024; i += NTHR) { Cr[i] = args.in[8][g * 1024 + i]; Ci[i] = args.in[9][g * 1024 + i]; }
            { const int tl = F.tid >> 6, n = F.tid & 63; const float tau = (float)(8 * j + tl);
                const float are = fminf(args.in[4][g * 64 + n], -1e-4f), aim = args.in[5][g * 64 + n];
                const float mag = __expf(tau * dt * are); float sn, cs; fcis(tau * dt * aim, &sn, &cs); Ere[F.tid] = mag * cs; Eim[F.tid] = mag * sn; }
            __syncthreads();
            {
                const int tl = F.tid >> 6, p = (F.tid >> 2) & 15, q0 = (F.tid & 3) * 4;
                float a0 = 0.f, a1 = 0.f, a2 = 0.f, a3 = 0.f;
                for (int n = 0; n < 64; ++n) { const float cr = Cr[p * 64 + n], ci = Ci[p * 64 + n], er = Ere[tl * 64 + n], ei = Eim[tl * 64 + n];
                    const float xr = cr * er - ci * ei, xi = cr * ei + ci * er;
                    const f32x4 br = *(const LAS f32x4*)(Bbr + n * 16 + q0), bi = *(const LAS f32x4*)(Bbi + n * 16 + q0);
                    a0 += xr * br.x - xi * bi.x; a1 += xr * br.y - xi * bi.y; a2 += xr * br.z - xi * bi.z; a3 += xr * br.w - xi * bi.w; }
                *(f32x4*)(KTAB + ((size_t)g * 64 + 8 * j + tl) * 256 + p * 16 + q0) = (f32x4){a0, a1, a2, a3};
            }
            __syncthreads();
            LAS float* E6r = Ci + 1024; LAS float* E6i = E6r + 2048;
            for (int i = F.tid; i < 2048; i += NTHR) { const int tau = i >> 5, n = 32 * (j & 1) + (i & 31);
                const float are = fminf(args.in[4][g * 64 + n], -1e-4f), aim = args.in[5][g * 64 + n];
                const float mag = __expf((float)tau * dt * are); float sn, cs; fcis((float)tau * dt * aim, &sn, &cs); E6r[i] = mag * cs; E6i[i] = mag * sn; }
            __syncthreads();
            for (int ch = F.tid; ch < 32 * 128; ch += NTHR) {
                const int rl = ch >> 7, c8 = ch & 127, r = 32 * j + rl, n = r & 63, im = (r >> 6) & 1, col = c8 * 8, sidx = col >> 4, q0 = col & 15;
                const float er = E6r[(63 - sidx) * 32 + (n & 31)], ei = E6i[(63 - sidx) * 32 + (n & 31)];
                float v[8];
#pragma unroll
                for (int i = 0; i < 8; ++i) { const float br = Bbr[n * 16 + q0 + i], bi = Bbi[n * 16 + q0 + i]; v[i] = im ? (er * bi + ei * br) : (er * br - ei * bi); }
                u32x4 o; o.x = pk2(v[0], v[1]); o.y = pk2(v[2], v[3]); o.z = pk2(v[4], v[5]); o.w = pk2(v[6], v[7]);
                *(u32x4*)(S5BQ + ((size_t)g * 256 + r) * 1024 + col) = o;
            }
            __syncthreads();
        }
        if (BOTH(0)) GRID_BAR();
    }
    if (IN(1)) {
        { int tq_ = threadIdx.x; asm volatile("" : "+v"(tq_)); F.tid = tq_; F.lane = tq_ & 63; }
        pg::DenseSched S{(const char*)HN, (const char*)WIN, D * 2, D * 2, T / 256, NPROJ / 256, F.G, (int)blockIdx.x};
        pg::EpiProj E{PROJ, S5A};
        pg::gemm_phase<pg::EpiProj, pg::DenseSched, true>(F.lds, D, S, E);
        if (BOTH(1)) GRID_BAR();
    }
    if (IN(2)) {
        { int tq_ = threadIdx.x; asm volatile("" : "+v"(tq_)); F.tid = tq_; F.lane = tq_ & 63; }
        pg::S5Sched S{(const char*)S5A, (const char*)S5BQ, S5K * 2, 1024 * 2, 256, 1, F.G, F.vcu};
        pg::EpiXloc E{XLOC};
        pg::gemm_phase<pg::EpiXloc, pg::S5Sched, true>(F.lds, 1024, S, E);
        {
            const int first = F.G > 64 ? F.vcu - 64 : F.vcu, stride = F.G > 64 ? F.G - 64 : F.G;
            LAS float* Kt = (LAS float*)F.lds;
            LAS float* Ere = Kt + 64 * 256; LAS float* Eim = Ere + 8 * 64;
            LAS float* Cr = Eim + 8 * 64; LAS float* Ci = Cr + 1024;
            for (int un = first; un >= 0 && un < 256; un += stride) {
                const int g = un >> 3, j = un & 7, ntau = 8 * j + 8;
                __syncthreads();
                for (int i = F.tid; i < ntau * 64; i += NTHR) *(LAS f32x4*)(Kt + 4 * i) = *(const f32x4*)(KTAB + (size_t)g * 64 * 256 + 4 * i);
                for (int i = F.tid; i < 1024; i += NTHR) { Cr[i] = args.in[8][g * 1024 + i]; Ci[i] = args.in[9][g * 1024 + i]; }
                { const int tl = F.tid >> 6, n = F.tid & 63; const float tau = (float)(8 * j + tl + 1); const float dt = __expf(args.in[3][g]);
                    const float are = fminf(args.in[4][g * 64 + n], -1e-4f), aim = args.in[5][g * 64 + n];
                    const float mag = __expf(tau * dt * are); float sn, cs; fcis(tau * dt * aim, &sn, &cs); Ere[F.tid] = mag * cs; Eim[F.tid] = mag * sn; }
                __syncthreads();
                for (int ch = F.tid; ch < 128 * 144; ch += NTHR) {
                    const int rl = ch / 144, c8 = ch % 144, tl = rl >> 4, t = 8 * j + tl, p = rl & 15, col = c8 * 8;
                    float v[8];
                    if (col < 1024) { const int sidx = col >> 4, q0 = col & 15;
                        if (sidx <= t) { const f32x4 k0 = *(const LAS f32x4*)(Kt + (t - sidx) * 256 + p * 16 + q0), k1 = *(const LAS f32x4*)(Kt + (t - sidx) * 256 + p * 16 + q0 + 4);
                            v[0] = k0.x; v[1] = k0.y; v[2] = k0.z; v[3] = k0.w; v[4] = k1.x; v[5] = k1.y; v[6] = k1.z; v[7] = k1.w; }
                        else {
#pragma unroll
                            for (int i = 0; i < 8; ++i) v[i] = 0.f; }
                    } else { const int jj = (col - 1024) & 63, im = (col - 1024) >> 6;
#pragma unroll
                        for (int i = 0; i < 8; ++i) { const int n = jj + i; const float cr = Cr[p * 64 + n], ci = Ci[p * 64 + n], er = Ere[tl * 64 + n], ei = Eim[tl * 64 + n];
                            v[i] = im ? -(cr * ei + ci * er) : (cr * er - ci * ei); } }
                    u32x4 o; o.x = pk2(v[0], v[1]); o.y = pk2(v[2], v[3]); o.z = pk2(v[4], v[5]); o.w = pk2(v[6], v[7]);
                    *(u32x4*)(S5BT + ((size_t)g * 1024 + 128 * j + rl) * S5K + col) = o;
                }
            }
            __syncthreads();
        }
    }
    if (IN(3)) {
        { int tq_ = threadIdx.x; asm volatile("" : "+v"(tq_)); F.tid = tq_; F.lane = tq_ & 63; }
        typedef short s16x4 __attribute__((ext_vector_type(4)));
        LAS float* wsl = (LAS float*)F.lds;
        LAS float* red = wsl + 512;
        LAS float* dnl = red + 32;
        LAS bf16* RQ = (LAS bf16*)(F.lds + 4352);
        LAS bf16* RK = RQ + 67 * 136;
        LAS bf16* RV = RK + 67 * 136;
        LAS bf16* KN = RK + 3 * 136;
        LAS bf16* KTl = RV + 64 * 136;
        LAS bf16* VTl = KTl + 128 * 72;
        const float* cw = args.in[13]; const float* cbias = args.in[14];
        for (int un = blockIdx.x; un < 256; un += F.G) {
            const int bh = un >> 4, seg = un & 15, b = bh >> 2, hd = bh & 3, t0 = seg * 512; const size_t row0 = (size_t)b * SEQ + t0;
            float Fl, Aval;
            {
                const float ipre = gates[(row0 + F.tid) * 8 + hd], fpre = gates[(row0 + F.tid) * 8 + 4 + hd];
                const float lf = fminf(fpre, 0.f) - log1pf(__expf(-fabsf(fpre)));
                float sc = lf;
#pragma unroll
                for (int o = 1; o < 64; o <<= 1) { const float tv = __shfl_up(sc, o); if (F.lane >= o) sc += tv; }
                if (F.lane == 63) red[F.wave] = sc;
                __syncthreads();
                float base = 0.f;
                for (int w2 = 0; w2 < F.wave; ++w2) base += red[w2];
                Fl = sc + base; Aval = ipre - Fl;
                float mx = Aval;
#pragma unroll
                for (int o = 1; o < 64; o <<= 1) mx = fmaxf(mx, __shfl_xor(mx, o));
                if (F.lane == 0) red[8 + F.wave] = mx;
                __syncthreads();
                float Amax = red[8];
                for (int w2 = 1; w2 < 8; ++w2) Amax = fmaxf(Amax, red[8 + w2]);
                wsl[F.tid] = __expf(Aval - Amax);
                FLOC[(size_t)bh * SEQ + t0 + F.tid] = Fl;
                if (F.tid == 511) { SEGS[un * 4 + 0] = Fl; SEGS[un * 4 + 1] = Amax; }
            }
            f32x16 dacc[2];
#pragma unroll
            for (int i = 0; i < 2; ++i)
#pragma unroll
                for (int q = 0; q < 16; ++q) dacc[i][q] = 0.f;
            const int cp = F.tid & 127, isk = cp >> 6, c2 = (cp & 63) * 2, tqr = F.tid >> 7;
            const int gch = isk * 512 + hd * 128 + c2;
            const float cw0a = cw[gch], cw1a = cw[1024 + gch], cw2a = cw[2048 + gch], cw3a = cw[3072 + gch], cba = cbias[gch];
            const float cw0b = cw[gch + 1], cw1b = cw[1024 + gch + 1], cw2b = cw[2048 + gch + 1], cw3b = cw[3072 + gch + 1], cbb = cbias[gch + 1];
            float dnacc0 = 0.f, dnacc1 = 0.f;
            u32x4 rt[7];
#define ML_RAW_LOAD(tsv) do { _Pragma("unroll") for (int ii = 0; ii < 7; ++ii) { const int ch = F.tid + NTHR * ii; u32x4 v = (u32x4){0u, 0u, 0u, 0u}; \
                if (ch < 2 * 67 * 16) { const int which = ch / (67 * 16), r = (ch % (67 * 16)) >> 4, c16 = ch & 15; const int tk = (tsv) - 3 + r; \
                    if (tk >= 0) v = *(const u32x4*)(PROJ + ((size_t)b * SEQ + tk) * NPROJ + (which ? O_K : O_Q) + hd * 128 + c16 * 8); } \
                else if (ch < 2 * 67 * 16 + 64 * 16) { const int c2 = ch - 2 * 67 * 16, r = c2 >> 4, c16 = c2 & 15; v = *(const u32x4*)(PROJ + ((size_t)b * SEQ + (tsv) + r) * NPROJ + O_V + hd * 128 + c16 * 8); } \
                rt[ii] = v; } } while (0)
            ML_RAW_LOAD(t0);
            for (int sb = 0; sb < 8; ++sb) {
                const int ts = t0 + sb * 64;
                __syncthreads();
#pragma unroll
                for (int ii = 0; ii < 7; ++ii) { const int ch = F.tid + NTHR * ii;
                    if (ch < 2 * 67 * 16) { const int which = ch / (67 * 16), r = (ch % (67 * 16)) >> 4, c16 = ch & 15; *(LAS u32x4*)((which ? RK : RQ) + r * 136 + c16 * 8) = rt[ii]; }
                    else if (ch < 2 * 67 * 16 + 64 * 16) { const int c2 = ch - 2 * 67 * 16, r = c2 >> 4, c16 = c2 & 15; *(LAS u32x4*)(RV + r * 136 + c16 * 8) = rt[ii]; } }
                if (sb < 7) ML_RAW_LOAD(ts + 64);
                __syncthreads();
                {
                    LAS unsigned* raw = (LAS unsigned*)(isk ? RK : RQ) + c2 / 2; const int s0 = tqr * 16;
                    const unsigned h0 = raw[(s0 + 0) * 68], h1 = raw[(s0 + 1) * 68], h2 = raw[(s0 + 2) * 68];
                    float x3a = lo_bf(h0), x3b = hi_bf(h0), x2a = lo_bf(h1), x2b = hi_bf(h1), x1a = lo_bf(h2), x1b = hi_bf(h2);
                    __syncthreads();
#pragma unroll 4
                    for (int sidx = s0; sidx < s0 + 16; ++sidx) {
                        const unsigned xw = raw[(sidx + 3) * 68]; const float xa = lo_bf(xw), xb = hi_bf(xw);
                        float va = cba + cw0a * x3a + cw1a * x2a + cw2a * x1a + cw3a * xa, vb = cbb + cw0b * x3b + cw1b * x2b + cw2b * x1b + cw3b * xb;
                        x3a = x2a; x2a = x1a; x1a = xa; x3b = x2b; x2b = x1b; x1b = xb;
                        va *= sigmoidf_(va); vb *= sigmoidf_(vb);
                        if (isk) { const float wk = 0.08838834764831845f * wsl[sb * 64 + sidx]; va *= wk; vb *= wk; dnacc0 += va; dnacc1 += vb; }
                        raw[(sidx + 3) * 68] = cvt_pk_bf16(va, vb);
                    }
                }
                __syncthreads();
#pragma unroll
                for (int ii = 0; ii < 2; ++ii) { const int ch = F.tid + NTHR * ii, r = ch >> 4, c16 = ch & 15;
                    *(u32x4*)(QH + ((size_t)bh * SEQ + ts + r) * 128 + c16 * 8) = *(const LAS u32x4*)(RQ + (r + 3) * 136 + c16 * 8);
                    *(u32x4*)(KH + ((size_t)bh * SEQ + ts + r) * 128 + c16 * 8) = *(const LAS u32x4*)(RK + (r + 3) * 136 + c16 * 8); }
                {
                    const int c = F.tid & 127, sq = F.tid >> 7;
#pragma unroll
                    for (int half = 0; half < 2; ++half) { const int sA = sq * 16 + half * 8;
                        u32x4 kk, vv;
                        kk.x = (unsigned)KN[(sA + 0) * 136 + c] | ((unsigned)KN[(sA + 1) * 136 + c] << 16); kk.y = (unsigned)KN[(sA + 2) * 136 + c] | ((unsigned)KN[(sA + 3) * 136 + c] << 16);
                        kk.z = (unsigned)KN[(sA + 4) * 136 + c] | ((unsigned)KN[(sA + 5) * 136 + c] << 16); kk.w = (unsigned)KN[(sA + 6) * 136 + c] | ((unsigned)KN[(sA + 7) * 136 + c] << 16);
                        vv.x = (unsigned)RV[(sA + 0) * 136 + c] | ((unsigned)RV[(sA + 1) * 136 + c] << 16); vv.y = (unsigned)RV[(sA + 2) * 136 + c] | ((unsigned)RV[(sA + 3) * 136 + c] << 16);
                        vv.z = (unsigned)RV[(sA + 4) * 136 + c] | ((unsigned)RV[(sA + 5) * 136 + c] << 16); vv.w = (unsigned)RV[(sA + 6) * 136 + c] | ((unsigned)RV[(sA + 7) * 136 + c] << 16);
                        *(LAS u32x4*)(KTl + c * 72 + sA) = kk; *(LAS u32x4*)(VTl + c * 72 + sA) = vv; }
                }
                __syncthreads();
                {
                    const int e = F.tid >> 2, part = F.tid & 3;
                    const u32x4 v0 = *(const LAS u32x4*)(VTl + e * 72 + part * 16), v1 = *(const LAS u32x4*)(VTl + e * 72 + part * 16 + 8);
                    bf16* dst = VT + ((size_t)bh * 128 + e) * SEQ + ts + part * 16;
                    *(u32x4*)dst = v0; *(u32x4*)(dst + 8) = v1;
                    const int eb = F.wave >> 1, db0 = (F.wave & 1) * 2, r = F.lane & 31, hh = F.lane >> 5;
#pragma unroll
                    for (int ks = 0; ks < 4; ++ks) {
                        const bf16x8 a = *(const LAS bf16x8*)(VTl + (eb * 32 + r) * 72 + ks * 16 + hh * 8);
                        const bf16x8 b0 = *(const LAS bf16x8*)(KTl + (db0 * 32 + r) * 72 + ks * 16 + hh * 8), b1 = *(const LAS bf16x8*)(KTl + ((db0 + 1) * 32 + r) * 72 + ks * 16 + hh * 8);
                        dacc[0] = __builtin_amdgcn_mfma_f32_32x32x16_bf16(a, b0, dacc[0], 0, 0, 0);
                        dacc[1] = __builtin_amdgcn_mfma_f32_32x32x16_bf16(a, b1, dacc[1], 0, 0, 0);
                    }
                }
            }
#undef ML_RAW_LOAD
            if (isk) { dnl[tqr * 128 + c2] = dnacc0; dnl[tqr * 128 + c2 + 1] = dnacc1; }
            {
                const int eb = F.wave >> 1, db0 = (F.wave & 1) * 2, r = F.lane & 31, hh = F.lane >> 5;
#pragma unroll
                for (int i = 0; i < 2; ++i)
#pragma unroll
                    for (int q = 0; q < 16; ++q) DC[((size_t)un * 128 + eb * 32 + (q & 3) + 8 * (q >> 2) + 4 * hh) * 128 + (db0 + i) * 32 + r] = dacc[i][q];
            }
            __syncthreads();
            if (F.tid < 128) DN[un * 128 + F.tid] = (dnl[F.tid] + dnl[128 + F.tid]) + (dnl[256 + F.tid] + dnl[384 + F.tid]);
            __syncthreads();
        }
        if (BOTH(3)) GRID_BAR();
    }
    if (IN(4)) {
        { int tq_ = threadIdx.x; asm volatile("" : "+v"(tq_)); F.tid = tq_; F.lane = tq_ & 63; }
        LAS float* agr = (LAS float*)F.lds; LAS float* agi = agr + 512;
        for (int un = blockIdx.x; un < 128; un += F.G) {
            const int b = un >> 5, g = un & 31, n = F.tid & 63, seg = F.tid >> 6;
            const float dt = __expf(args.in[3][g]);
            const float are = fminf(args.in[4][g * 64 + n], -1e-4f), aim = args.in[5][g * 64 + n];
            float ar, ai, Ar, Ai;
            { const float mag = __expf(64.f * dt * are); float sn, cs; fcis(64.f * dt * aim, &sn, &cs); ar = mag * cs; ai = mag * sn; }
            { const float mag = __expf(1024.f * dt * are); float sn, cs; fcis(1024.f * dt * aim, &sn, &cs); Ar = mag * cs; Ai = mag * sn; }
            const size_t row0 = (size_t)g * 512 + b * 128 + seg * 16;
            float xr[16], xi[16];
#pragma unroll
            for (int jj = 0; jj < 16; ++jj) { xr[jj] = XLOC[(row0 + jj) * 128 + n]; xi[jj] = XLOC[(row0 + jj) * 128 + 64 + n]; }
            float sr = 0.f, si = 0.f;
#pragma unroll
            for (int jj = 0; jj < 16; ++jj) { const float tr = ar * sr - ai * si + xr[jj], ti = ar * si + ai * sr + xi[jj]; sr = tr; si = ti; }
            agr[seg * 64 + n] = sr; agi[seg * 64 + n] = si;
            __syncthreads();
            float cr = 0.f, ci = 0.f;
            for (int s2 = 0; s2 < seg; ++s2) { const float tr = Ar * cr - Ai * ci + agr[s2 * 64 + n], ti = Ar * ci + Ai * cr + agi[s2 * 64 + n]; cr = tr; ci = ti; }
#pragma unroll
            for (int jj = 0; jj < 16; ++jj) {
                S5A[(row0 + jj) * S5K + 1024 + n] = f2bf(cr); S5A[(row0 + jj) * S5K + 1088 + n] = f2bf(ci);
                const float tr = ar * cr - ai * ci + xr[jj], ti = ar * ci + ai * cr + xi[jj]; cr = tr; ci = ti; }
            __syncthreads();
        }
        for (int un = blockIdx.x; un < 256; un += F.G) {
            const int bh = un >> 4, slice = un & 15;
            float dc0[16], dc1[16];
#pragma unroll
            for (int j = 0; j < 16; ++j) { dc0[j] = DC[((size_t)(bh * 16 + j)) * 16384 + slice * 1024 + F.tid]; dc1[j] = DC[((size_t)(bh * 16 + j)) * 16384 + slice * 1024 + 512 + F.tid]; }
            float dn[16];
            const bool nrole = (slice == 0 && F.tid < 128);
#pragma unroll
            for (int j = 0; j < 16; ++j) dn[j] = nrole ? DN[(bh * 16 + j) * 128 + F.tid] : 0.f;
            float m = 0.f, C0 = 0.f, C1 = 0.f, nn = 0.f;
#pragma unroll
            for (int j = 0; j < 16; ++j) {
                const float Fend = SEGS[(bh * 16 + j) * 4 + 0], Amax = SEGS[(bh * 16 + j) * 4 + 1];
                const float R = fmaxf(m, Amax), c1 = __expf(m - R), c2 = __expf(Amax - R);
                CST[((size_t)(bh * 16 + j)) * 16384 + slice * 1024 + F.tid] = f2bf(c1 * C0); CST[((size_t)(bh * 16 + j)) * 16384 + slice * 1024 + 512 + F.tid] = f2bf(c1 * C1);
                if (nrole) NST[(bh * 16 + j) * 128 + F.tid] = c1 * nn;
                if (slice == 0 && F.tid == 0) { SEGS[(bh * 16 + j) * 4 + 2] = R; SEGS[(bh * 16 + j) * 4 + 3] = c2; }
                C0 = c1 * C0 + c2 * dc0[j]; C1 = c1 * C1 + c2 * dc1[j]; nn = c1 * nn + c2 * dn[j]; m = Fend + R;
            }
        }
        if (BOTH(4)) GRID_BAR();
    }
    if (IN(5)) {
        { int tq_ = threadIdx.x; asm volatile("" : "+v"(tq_)); F.tid = tq_; F.lane = tq_ & 63; }
        pg::S5Sched S{(const char*)S5A, (const char*)S5BT, S5K * 2, S5K * 2, 1024, 4, F.G, F.vcu};
        pg::EpiS5Y E{S5A, args.in[10], GY};
        pg::gemm_phase<pg::EpiS5Y, pg::S5Sched, true>(F.lds, S5K, S, E);
        if (BOTH(5)) GRID_BAR();
    }
    if (IN(6)) {
        { int tq_ = threadIdx.x; asm volatile("" : "+v"(tq_)); F.tid = tq_; F.lane = tq_ & 63; }
        typedef short s16x4 __attribute__((ext_vector_type(4)));
        LAS bf16* Kl = (LAS bf16*)F.lds;
        LAS bf16* Vl = Kl + 2 * 64 * 136;
        LAS bf16* Cl = Vl + 2 * 128 * 72;
        LAS float* nl = (LAS float*)(Cl + 128 * 136);
        LAS float* fll = nl + 128;
        LAS float* gl = fll + 512;
        const float* ng = args.in[16];
        for (int un = blockIdx.x; un < 256; un += F.G) {
            int tid6 = F.tid; asm volatile("" : "+v"(tid6));
            const int lane6 = tid6 & 63;
            const int bh = un >> 4, seg = un & 15, b = bh >> 2, hd = bh & 3, t0 = seg * 512;
            const float R = SEGS[un * 4 + 2], c2 = SEGS[un * 4 + 3];
            __syncthreads();
            for (int ch = tid6; ch < 2048; ch += NTHR) { const int r = ch >> 4, c16 = ch & 15; *(LAS u32x4*)(Cl + r * 136 + c16 * 8) = *(const u32x4*)(CST + (size_t)un * 16384 + r * 128 + c16 * 8); }
            if (tid6 < 128) { nl[tid6] = NST[un * 128 + tid6]; gl[tid6] = ng[hd * 128 + tid6]; }
            fll[tid6] = FLOC[(size_t)bh * SEQ + t0 + tid6];
            const int r = lane6 & 31, hh = lane6 >> 5;
            for (int pass = 0; pass < 2; ++pass) {
                const int qb = pass == 0 ? F.wave : 15 - F.wave, jmax = qb >> 1, npj = pass == 0 ? 4 : 8;
                bf16x8 Q[8];
                { const bf16* qp = QH + ((size_t)bh * SEQ + t0 + qb * 32 + r) * 128 + hh * 8;
#pragma unroll
                  for (int ks = 0; ks < 8; ++ks) Q[ks] = *(const bf16x8*)(qp + ks * 16); }
                u32x4 pk0, pk1, pv0, pv1;
                { const int kr = tid6 >> 4, kc = tid6 & 15; const bf16* kp = KH + ((size_t)bh * SEQ + t0) * 128; pk0 = *(const u32x4*)(kp + kr * 128 + kc * 8); pk1 = *(const u32x4*)(kp + (kr + 32) * 128 + kc * 8);
                  const int vr = tid6 >> 3, vc = tid6 & 7; const bf16* vp = VT + (size_t)bh * 128 * SEQ + t0; pv0 = *(const u32x4*)(vp + (size_t)vr * SEQ + vc * 8); pv1 = *(const u32x4*)(vp + (size_t)(vr + 64) * SEQ + vc * 8); }
                f32x16 acc[4];
#pragma unroll
                for (int eb = 0; eb < 4; ++eb)
#pragma unroll
                    for (int q = 0; q < 16; ++q) acc[eb][q] = 0.f;
                __syncthreads();
#pragma unroll
                for (int eb = 0; eb < 4; ++eb) {
#pragma unroll
                    for (int ks = 0; ks < 8; ++ks) { const bf16x8 a = *(const LAS bf16x8*)(Cl + (eb * 32 + r) * 136 + ks * 16 + hh * 8); acc[eb] = __builtin_amdgcn_mfma_f32_32x32x16_bf16(a, Q[ks], acc[eb], 0, 0, 0); }
                    __builtin_amdgcn_sched_barrier(0);
                }
                float den = 0.f;
#pragma unroll
                for (int ks = 0; ks < 8; ++ks) {
#pragma unroll
                    for (int jj = 0; jj < 8; ++jj) den += nl[ks * 16 + hh * 8 + jj] * bf2f((bf16)Q[ks][jj]);
                    __builtin_amdgcn_sched_barrier(0);
                }
                float dsum = 0.f;
                for (int j = 0; j < npj; ++j) {
                    LAS bf16* Kb = Kl + (j & 1) * 64 * 136; LAS bf16* Vb = Vl + (j & 1) * 128 * 72;
                    { const int kr = tid6 >> 4, kc = tid6 & 15; *(LAS u32x4*)(Kb + kr * 136 + kc * 8) = pk0; *(LAS u32x4*)(Kb + (kr + 32) * 136 + kc * 8) = pk1;
                      const int vr = tid6 >> 3, vc = tid6 & 7; *(LAS u32x4*)(Vb + vr * 72 + vc * 8) = pv0; *(LAS u32x4*)(Vb + (vr + 64) * 72 + vc * 8) = pv1; }
                    if (j + 1 < npj) { const int kr = tid6 >> 4, kc = tid6 & 15; const bf16* kp = KH + ((size_t)bh * SEQ + t0 + (j + 1) * 64) * 128; pk0 = *(const u32x4*)(kp + kr * 128 + kc * 8); pk1 = *(const u32x4*)(kp + (kr + 32) * 128 + kc * 8);
                        const int vr = tid6 >> 3, vc = tid6 & 7; const bf16* vp = VT + (size_t)bh * 128 * SEQ + t0 + (j + 1) * 64; pv0 = *(const u32x4*)(vp + (size_t)vr * SEQ + vc * 8); pv1 = *(const u32x4*)(vp + (size_t)(vr + 64) * SEQ + vc * 8); }
                    __syncthreads();
                    if (j <= jmax) {
                        const bool diag = (j == jmax); const int tq = qb * 32 + r;
#pragma unroll
                        for (int sb = 0; sb < 2; ++sb) {
                            f32x16 st;
#pragma unroll
                            for (int q = 0; q < 16; ++q) st[q] = 0.f;
#pragma unroll
                            for (int ks = 0; ks < 8; ++ks) { const bf16x8 a = *(const LAS bf16x8*)(Kb + (sb * 32 + r) * 136 + ks * 16 + hh * 8); st = __builtin_amdgcn_mfma_f32_32x32x16_bf16(a, Q[ks], st, 0, 0, 0); }
                            bf16x8 pb[2];
#pragma unroll
                            for (int sp = 0; sp < 2; ++sp) {
                                float pv[8];
#pragma unroll
                                for (int jj = 0; jj < 8; ++jj) { const int q = 8 * sp + jj; const int sidx = j * 64 + sb * 32 + (q & 3) + 8 * (q >> 2) + 4 * hh;
                                    float p = st[q] * c2; if (diag && sidx > tq) p = 0.f; pv[jj] = p; dsum += p; }
                                u32x4 w; w.x = cvt_pk_bf16(pv[0], pv[1]); w.y = cvt_pk_bf16(pv[2], pv[3]); w.z = cvt_pk_bf16(pv[4], pv[5]); w.w = cvt_pk_bf16(pv[6], pv[7]);
                                pb[sp] = __builtin_bit_cast(bf16x8, w);
                            }
#pragma unroll
                            for (int eb = 0; eb < 4; ++eb)
#pragma unroll
                                for (int sp = 0; sp < 2; ++sp) {
                                    const int so = sb * 32 + 16 * sp + 4 * hh;
                                    const s16x4 lo = *(const LAS s16x4*)(Vb + (eb * 32 + r) * 72 + so), hi = *(const LAS s16x4*)(Vb + (eb * 32 + r) * 72 + so + 8);
                                    const bf16x8 a = __builtin_shufflevector(lo, hi, 0, 1, 2, 3, 4, 5, 6, 7);
                                    acc[eb] = __builtin_amdgcn_mfma_f32_32x32x16_bf16(a, pb[sp], acc[eb], 0, 0, 0);
                                }
                            __builtin_amdgcn_sched_barrier(0);
                        }
                    }
                }
                den += dsum; den += __shfl_xor(den, 32);
                const float flo = __expf(-fll[qb * 32 + r] - R);
                const float inv = 1.f / fmaxf(fabsf(den), flo);
                float s1 = 0.f;
#pragma unroll
                for (int eb = 0; eb < 4; ++eb)
#pragma unroll
                    for (int q = 0; q < 16; ++q) { acc[eb][q] *= inv; s1 += acc[eb][q]; }
                s1 += __shfl_xor(s1, 32);
                const float mu = s1 * (1.f / 128.f);
                float s2 = 0.f;
#pragma unroll
                for (int eb = 0; eb < 4; ++eb)
#pragma unroll
                    for (int q = 0; q < 16; ++q) { const float dlt = acc[eb][q] - mu; s2 += dlt * dlt; }
                s2 += __shfl_xor(s2, 32);
                const float rstd = rsqrtf(s2 * (1.f / 128.f) + 1e-6f);
                const size_t row = (size_t)b * SEQ + t0 + qb * 32 + r;
                uint2 ovv[16];
#pragma unroll
                for (int eb = 0; eb < 4; ++eb)
#pragma unroll
                    for (int g4 = 0; g4 < 4; ++g4) ovv[eb * 4 + g4] = *(const uint2*)(PROJ + row * NPROJ + O_O + hd * 128 + eb * 32 + 8 * g4 + 4 * hh);
#pragma unroll
                for (int eb = 0; eb < 4; ++eb)
#pragma unroll
                    for (int g4 = 0; g4 < 4; ++g4) {
                        const int e0 = eb * 32 + 8 * g4 + 4 * hh;
                        const uint2 ov = ovv[eb * 4 + g4];
                        const f32x4 gg = *(const LAS f32x4*)(gl + e0);
                        const float o0 = (acc[eb][4 * g4 + 0] - mu) * rstd * gg.x * sigmoidf_(lo_bf(ov.x)), o1 = (acc[eb][4 * g4 + 1] - mu) * rstd * gg.y * sigmoidf_(hi_bf(ov.x));
                        const float o2 = (acc[eb][4 * g4 + 2] - mu) * rstd * gg.z * sigmoidf_(lo_bf(ov.y)), o3 = (acc[eb][4 * g4 + 3] - mu) * rstd * gg.w * sigmoidf_(hi_bf(ov.y));
                        uint2 w; w.x = cvt_pk_bf16(o0, o1); w.y = cvt_pk_bf16(o2, o3);
                        *(uint2*)(MIX + row * D + 512 + hd * 128 + e0) = w;
                    }
            }
        }
    }
    if (IN(7)) {
        { int tq_ = threadIdx.x; asm volatile("" : "+v"(tq_)); F.tid = tq_; F.lane = tq_ & 63; }
        pg::DenseSched S{(const char*)GY, (const char*)WGLU, 512 * 2, 512 * 2, T / 256, 2, F.G, (int)blockIdx.x};
        pg::EpiGlu E{GY, args.in[12], MIX};
        pg::gemm_phase<pg::EpiGlu, pg::DenseSched, true>(F.lds, 512, S, E);
        if (BOTH(7)) GRID_BAR();
    }
    if (IN(8)) {
        { int tq_ = threadIdx.x; asm volatile("" : "+v"(tq_)); F.tid = tq_; F.lane = tq_ & 63; }
        pg::DenseSched S{(const char*)MIX, (const char*)WOUT, D * 2, D * 2, T / 256, D / 256, F.G, (int)blockIdx.x};
        pg::EpiOut E{x, H};
        pg::gemm_phase<pg::EpiOut, pg::DenseSched, true>(F.lds, D, S, E);
        if (BOTH(8)) GRID_BAR();
    }
    if (IN(9)) {
        { int tq_ = threadIdx.x; asm volatile("" : "+v"(tq_)); F.tid = tq_; F.lane = tq_ & 63; }
        const float* gf = args.in[18]; const float* w_r = args.in[19]; const float* b_r = args.in[20];
        LAS float* rs = (LAS float*)(F.lds);
        LAS float* part = (LAS float*)(F.lds + 1024);
        LAS int* hist = (LAS int*)(F.lds + 1024 + 2 * 128 * 33 * 4);
        for (int tb = blockIdx.x; tb < T / 128; tb += F.G) {
            const int row0 = tb * 128;
            if (F.tid < 32) hist[F.tid] = 0;
            {
                f32x4 gg[4];
#pragma unroll
                for (int jq = 0; jq < 4; ++jq) gg[jq] = *(const f32x4*)(gf + 4 * F.lane + 256 * jq);
                f32x4 nx[4];
#pragma unroll
                for (int jq = 0; jq < 4; ++jq) nx[jq] = ldbf4(H + (size_t)(row0 + F.wave * 16) * D + 4 * F.lane + 256 * jq);
                for (int rr = 0; rr < 16; ++rr) {
                    const int r = F.wave * 16 + rr;
                    f32x4 v[4];
#pragma unroll
                    for (int jq = 0; jq < 4; ++jq) v[jq] = nx[jq];
                    if (rr < 15) {
#pragma unroll
                        for (int jq = 0; jq < 4; ++jq) nx[jq] = ldbf4(H + (size_t)(row0 + r + 1) * D + 4 * F.lane + 256 * jq); }
                    float ss = 0.f;
#pragma unroll
                    for (int jq = 0; jq < 4; ++jq) ss += v[jq].x * v[jq].x + v[jq].y * v[jq].y + v[jq].z * v[jq].z + v[jq].w * v[jq].w;
                    ss = wave_sum(ss);
                    const float rstd = rsqrtf(ss * (1.f / D) + 1e-5f);
                    if (F.lane == 0) rs[r] = rstd;
#pragma unroll
                    for (int jq = 0; jq < 4; ++jq) *(unsigned*)(HN8 + (size_t)(row0 + r) * D + 4 * F.lane + 256 * jq) = pk4_fp8(v[jq].x * rstd * gg[jq].x, v[jq].y * rstd * gg[jq].y, v[jq].z * rstd * gg[jq].z, v[jq].w * rstd * gg[jq].w);
                }
            }
            {
                const int rg = F.wave & 3, kh = F.wave >> 2, i = F.lane & 31, hh = F.lane >> 5;
                f32x16 acc;
#pragma unroll
                for (int q = 0; q < 16; ++q) acc[q] = 0.f;
                const bf16* hp = H + (size_t)(row0 + rg * 32 + i) * D + kh * 512 + 4 * hh;
                const float* wp = w_r + (size_t)(kh * 512 + 4 * hh) * NE + i; const float* gp = gf + kh * 512 + 4 * hh;
                f32x4 a0[4], g0[4], a1[4], g1[4]; f32x4 w0[4], w1[4];
#pragma unroll
                for (int u = 0; u < 4; ++u) { a0[u] = ldbf4(hp + 8 * u); g0[u] = *(const f32x4*)(gp + 8 * u);
                    w0[u] = (f32x4){wp[(size_t)(8 * u + 0) * NE], wp[(size_t)(8 * u + 1) * NE], wp[(size_t)(8 * u + 2) * NE], wp[(size_t)(8 * u + 3) * NE]}; }
                for (int k0 = 0; k0 < 512; k0 += 64) {
#pragma unroll
                    for (int u = 0; u < 4; ++u) { const int kk = k0 + 32 + 8 * u; a1[u] = ldbf4(hp + kk); g1[u] = *(const f32x4*)(gp + kk);
                        w1[u] = (f32x4){wp[(size_t)(kk + 0) * NE], wp[(size_t)(kk + 1) * NE], wp[(size_t)(kk + 2) * NE], wp[(size_t)(kk + 3) * NE]}; }
#pragma unroll
                    for (int u = 0; u < 4; ++u) { const f32x4 bb = w0[u] * g0[u];
                        acc = __builtin_amdgcn_mfma_f32_32x32x2f32(a0[u].x, bb.x, acc, 0, 0, 0); acc = __builtin_amdgcn_mfma_f32_32x32x2f32(a0[u].y, bb.y, acc, 0, 0, 0);
                        acc = __builtin_amdgcn_mfma_f32_32x32x2f32(a0[u].z, bb.z, acc, 0, 0, 0); acc = __builtin_amdgcn_mfma_f32_32x32x2f32(a0[u].w, bb.w, acc, 0, 0, 0); }
                    if (k0 + 64 < 512) {
#pragma unroll
                        for (int u = 0; u < 4; ++u) { const int kk = k0 + 64 + 8 * u; a0[u] = ldbf4(hp + kk); g0[u] = *(const f32x4*)(gp + kk);
                            w0[u] = (f32x4){wp[(size_t)(kk + 0) * NE], wp[(size_t)(kk + 1) * NE], wp[(size_t)(kk + 2) * NE], wp[(size_t)(kk + 3) * NE]}; } }
#pragma unroll
                    for (int u = 0; u < 4; ++u) { const f32x4 bb = w1[u] * g1[u];
                        acc = __builtin_amdgcn_mfma_f32_32x32x2f32(a1[u].x, bb.x, acc, 0, 0, 0); acc = __builtin_amdgcn_mfma_f32_32x32x2f32(a1[u].y, bb.y, acc, 0, 0, 0);
                        acc = __builtin_amdgcn_mfma_f32_32x32x2f32(a1[u].z, bb.z, acc, 0, 0, 0); acc = __builtin_amdgcn_mfma_f32_32x32x2f32(a1[u].w, bb.w, acc, 0, 0, 0); }
                }
#pragma unroll
                for (int q = 0; q < 16; ++q) { const int r = rg * 32 + (q & 3) + 8 * (q >> 2) + 4 * hh; part[(kh * 128 + r) * 33 + i] = acc[q]; }
            }
            __syncthreads();
            if (F.tid < 128) {
                const int r = F.tid; const float rstd = rs[r];
                float best[4]; int bi[4];
                for (int e = 0; e < 32; ++e) part[r * 33 + e] = (part[r * 33 + e] + part[(128 + r) * 33 + e]) * rstd + b_r[e];
#pragma unroll
                for (int k = 0; k < 4; ++k) {
                    float bv = -INFINITY; int be = 0;
                    for (int e = 0; e < 32; ++e) { const float l = part[r * 33 + e]; if (l > bv) { bv = l; be = e; } }
                    best[k] = bv; bi[k] = be; part[r * 33 + be] = -INFINITY;
                }
                const float e1 = __expf(best[1] - best[0]), e2 = __expf(best[2] - best[0]), e3 = __expf(best[3] - best[0]);
                const float inv = 1.f / (1.f + e1 + e2 + e3);
                *(int4*)(topi + (size_t)(row0 + r) * 4) = make_int4(bi[0], bi[1], bi[2], bi[3]);
                *(f32x4*)(topg + (size_t)(row0 + r) * 4) = (f32x4){inv, e1 * inv, e2 * inv, e3 * inv};
#pragma unroll
                for (int k = 0; k < 4; ++k) __hip_atomic_fetch_add(&hist[bi[k]], 1, __ATOMIC_RELAXED, __HIP_MEMORY_SCOPE_WORKGROUP);
            }
            __syncthreads();
            if (F.tid < 32) CNT[tb * 32 + F.tid] = hist[F.tid];
            __syncthreads();
        }
        if (BOTH(9)) GRID_BAR();
    }
    if (IN(10)) {
        { int tq_ = threadIdx.x; asm volatile("" : "+v"(tq_)); F.tid = tq_; F.lane = tq_ & 63; }
        LAS int* sb = (LAS int*)(F.lds);
        for (int tb = blockIdx.x; tb < T / 128; tb += F.G) {
            const int e = F.tid & 31, pt = F.tid >> 5;
            int sbef = 0, stot = 0;
            for (int w = pt * 16; w < pt * 16 + 16; ++w) { const int c = __hip_atomic_load(CNT + w * 32 + e, RLX_AGENT); stot += c; if (w < tb) sbef += c; }
            sb[pt * 32 + e] = sbef; sb[512 + pt * 32 + e] = stot;
            __syncthreads();
            if (F.tid < 32) { int b = 0, t = 0; for (int p = 0; p < 16; ++p) { b += sb[p * 32 + F.tid]; t += sb[512 + p * 32 + F.tid]; } sb[1024 + F.tid] = b; sb[1056 + F.tid] = t; sb[1120 + F.tid] = 0; }
            __syncthreads();
            if (F.tid == 0) { int ps = 0; for (int q = 0; q < 32; ++q) { sb[1088 + q] = ps; ps += ((sb[1056 + q] + MT - 1) / MT) * MT; } }
            __syncthreads();
            if (tb == 0 && F.tid < 32) ecnt[F.tid] = sb[1056 + F.tid];
            {
                const int a = tb * 512 + F.tid; const int ex = topi[a];
                const int lp = __hip_atomic_fetch_add(&sb[1120 + ex], 1, __ATOMIC_RELAXED, __HIP_MEMORY_SCOPE_WORKGROUP);
                const int slot = sb[1088 + ex] + sb[1024 + ex] + lp;
                slot_tok[slot] = a >> 2; tok_slot[a] = slot;
            }
            __syncthreads();
        }
        if (BOTH(10)) GRID_BAR();
    }
    if (IN(11) || IN(12)) {
        { int tq_ = threadIdx.x; asm volatile("" : "+v"(tq_)); F.tid = tq_; F.lane = tq_ & 63; }
        LAS int* til = (LAS int*)(F.lds + TIL_OFF);
        if (F.tid == 0) { int nt = 0; for (int e = 0; e < NE; ++e) { const int c = __hip_atomic_load(ecnt + e, RLX_AGENT); for (int r = 0; r < c; r += MT) { til[nt] = e; til[MAXTILES + nt] = (c - r) < MT ? (c - r) : MT; ++nt; } } til[2 * MAXTILES] = nt; }
        __syncthreads();
        if (IN(11)) {
            MoeSched S{(const char*)HN8, (const char*)WUP8, slot_tok, args.in[22], til, (LAS int*)(F.lds + IDX_OFF), (LAS float*)(F.lds + BIAS_OFF), D, D, 8, 2 * FF, F.G, (int)blockIdx.x, 1};
            pg::EpiUp E{(const LAS float*)(F.lds + BIAS_OFF), ACT8};
            pg::gemm_phase<pg::EpiUp, MoeSched, true, true>(F.lds, D, S, E);
            if (BOTH(11)) GRID_BAR();
        }
        if (IN(12)) {
            MoeSched S{(const char*)ACT8, (const char*)WDN8, slot_tok, args.in[24], til, (LAS int*)(F.lds + IDX_OFF), (LAS float*)(F.lds + BIAS_OFF), FF, FF, 4, D, F.G, (int)blockIdx.x, 0};
            pg::EpiDown E{(const LAS float*)(F.lds + BIAS_OFF), YS};
            pg::gemm_phase<pg::EpiDown, MoeSched, true, true>(F.lds, FF, S, E);
            if (BOTH(12)) GRID_BAR();
        }
    }
    if (IN(13)) {
        { int tq_ = threadIdx.x; asm volatile("" : "+v"(tq_)); F.tid = tq_; F.lane = tq_ & 63; }
        const float* gfin = args.in[25]; float* out = args.out;
        for (int row = gw; row < T; row += NGW) {
            f32x4 v[4];
#pragma unroll
            for (int j = 0; j < 4; ++j) v[j] = ldbf4(H + (size_t)row * D + 4 * F.lane + 256 * j);
            const int4 sl = *(const int4*)(tok_slot + (size_t)row * 4); const f32x4 gt = *(const f32x4*)(topg + (size_t)row * 4);
#pragma unroll
            for (int k = 0; k < 4; ++k) {
                const int s = k == 0 ? sl.x : k == 1 ? sl.y : k == 2 ? sl.z : sl.w;
#pragma unroll
                for (int j = 0; j < 4; ++j) { const unsigned y = *(const unsigned*)(YS + (size_t)s * D + 4 * F.lane + 256 * j);
                    typedef float f32x2_ __attribute__((ext_vector_type(2)));
                    const f32x2_ ylo = __builtin_amdgcn_cvt_pk_f32_fp8(y, false), yhi = __builtin_amdgcn_cvt_pk_f32_fp8(y, true);
                    v[j].x += gt[k] * ylo.x; v[j].y += gt[k] * ylo.y; v[j].z += gt[k] * yhi.x; v[j].w += gt[k] * yhi.y; }
            }
            float ss = 0.f;
#pragma unroll
            for (int j = 0; j < 4; ++j) ss += v[j].x * v[j].x + v[j].y * v[j].y + v[j].z * v[j].z + v[j].w * v[j].w;
            ss = wave_sum(ss);
            const float rstd = rsqrtf(ss * (1.f / D) + 1e-5f);
#pragma unroll
            for (int j = 0; j < 4; ++j) { const f32x4 gg = *(const f32x4*)(gfin + 4 * F.lane + 256 * j); __builtin_nontemporal_store(v[j] * rstd * gg, (f32x4*)(out + (size_t)row * D + 4 * F.lane + 256 * j)); }
        }
    }
#undef IN
#undef BOTH
}

extern "C" void kernel_launch(void* const* d_in, const int* in_sizes, int n_in, void* d_out, int out_size, void* d_ws, size_t ws_size, hipStream_t stream) {
    static int grid = 0;
    if (grid == 0) {
        int dev = 0, cus = 0, per_cu = 0;
        if (n_in != 26 || ws_size < WS_END) { fprintf(stderr, "kernel_launch: unexpected n_in %d / ws %zu\n", n_in, ws_size); grid = -1; return; }
        if (hipGetDevice(&dev) != hipSuccess || hipDeviceGetAttribute(&cus, hipDeviceAttributeMultiprocessorCount, dev) != hipSuccess) { grid = -1; return; }
        if (hipFuncSetAttribute((const void*)fwd, hipFuncAttributeMaxDynamicSharedMemorySize, LDS_BYTES) != hipSuccess) { fprintf(stderr, "kernel_launch: hipFuncSetAttribute failed\n"); grid = -1; return; }
        if (hipOccupancyMaxActiveBlocksPerMultiprocessor(&per_cu, (const void*)fwd, NTHR, LDS_BYTES) != hipSuccess || per_cu < 1) fprintf(stderr, "kernel_launch: occupancy query reports %d\n", per_cu);
        (void)hipGetLastError();
        grid = cus;
    }
    if (grid < 0) return;
    (void)in_sizes; (void)out_size;
    unsigned char* ws = (unsigned char*)d_ws;
    (void)hipMemsetAsync(ws + WS_CTL, 0, CTL_ZERO_BYTES, stream);
    Args a{};
    for (int i = 0; i < 26; ++i) a.in[i] = (const float*)d_in[i];
    a.out = (float*)d_out; a.ws = ws;
    a.ph_lo = 0; a.ph_hi = 14; a.li = 0; a.pad = 0;
    hipLaunchKernelGGL(fwd, dim3(grid), dim3(NTHR), LDS_BYTES, stream, a);
#if PROBE_LO >= 0
    a.ph_lo = PROBE_LO; a.ph_hi = PROBE_HI; a.li = 1; a.pad = PROBE_PAD;
    hipLaunchKernelGGL(fwd, dim3(grid), dim3(NTHR), LDS_BYTES, stream, a);
#endif
}
```

```cpp
#include <hip/hip_runtime.h>
#include <cstdio>
#include <cstdint>

#define GAS __attribute__((address_space(1)))
#define LAS __attribute__((address_space(3)))
typedef unsigned short bf16;
typedef short bf16x8 __attribute__((ext_vector_type(8)));
typedef float f32x4 __attribute__((ext_vector_type(4)));
typedef float f32x16 __attribute__((ext_vector_type(16)));
typedef unsigned u32x4 __attribute__((ext_vector_type(4)));
typedef unsigned u32x2 __attribute__((ext_vector_type(2)));
typedef GAS unsigned gu32;

#define PROBE_LO -1
#define PROBE_HI -1
#define PROBE_PAD 0
constexpr int NB = 4, SEQ = 8192, T = NB * SEQ, D = 1024;
constexpr int DIN = 2568, NPROJ = 2560;
constexpr int O_Q = 512, O_K = 1024, O_V = 1536, O_O = 2048, O_G = 2560;
constexpr int NE = 32, TOPK = 4, FF = 1024;
constexpr int NASSIGN = T * TOPK;
constexpr int MT = 256;
constexpr int NSLOTS = NASSIGN + NE * MT;
constexpr int MAXTILES = NSLOTS / MT;
constexpr int NWAVES = 8, NTHR = 512;
constexpr float W8_SCALE = 64.f, W8_INV = 1.f / 64.f;

constexpr size_t MiB = 1u << 20;
constexpr size_t WS_CTL = 0, CTL_ZERO_BYTES = 1 * MiB;
constexpr size_t WS_GATES = 1 * MiB;
constexpr size_t WS_TOPI = 2 * MiB;
constexpr size_t WS_TOPG = 3 * MiB;
constexpr size_t WS_SLOTTOK = 4 * MiB;
constexpr size_t WS_TOKSLOT = 5 * MiB;
constexpr size_t WS_CNT = 6 * MiB;
constexpr size_t WS_WIN = 8 * MiB;
constexpr size_t WS_WGLU = 13 * MiB;
constexpr size_t WS_WOUT = 14 * MiB;
constexpr size_t WS_WUP = 16 * MiB;
constexpr size_t WS_WDN = 144 * MiB;
constexpr size_t WS_HN = 208 * MiB;
constexpr size_t WS_PROJ = 272 * MiB;
constexpr size_t WS_GY = 432 * MiB;
constexpr size_t WS_MIX = 464 * MiB;
constexpr size_t WS_HRAW = 528 * MiB;
constexpr size_t WS_ACT = 272 * MiB;
constexpr size_t WS_H = 592 * MiB;
constexpr size_t WS_YS = 720 * MiB;
constexpr size_t WS_END = 992 * MiB;
constexpr int S5L = 32, S5KIN = S5L * 16, S5K = S5KIN + 128;
constexpr int S5NCH = SEQ / S5L, S5ROWS = NB * S5NCH;
constexpr size_t WS_S5A = 720 * MiB;
constexpr size_t WS_S5BT = 760 * MiB;
constexpr size_t WS_S5BQ = 836 * MiB;
constexpr size_t WS_XLOC = 790 * MiB;
constexpr size_t WS_QH = 866 * MiB;
constexpr size_t WS_KH = 898 * MiB;
constexpr size_t WS_VT = 930 * MiB;
constexpr size_t WS_DC = 962 * MiB;
constexpr size_t WS_CST = 978 * MiB;
constexpr size_t WS_FLOC = 986 * MiB;
constexpr size_t WS_DN = 987 * MiB;
constexpr size_t WS_NST = 988 * MiB;
constexpr size_t WS_SEGS = 989 * MiB;
constexpr size_t WS_KTAB = 990 * MiB;
static_assert(WS_S5A + (size_t)32 * S5ROWS * S5K * 2 <= WS_S5BT && WS_S5BT + (size_t)32 * S5KIN * S5K * 2 <= WS_XLOC && WS_XLOC + (size_t)32 * S5ROWS * 128 * 4 <= WS_S5BQ && WS_S5BQ + (size_t)32 * 256 * S5KIN * 2 <= WS_QH, "s5 map");
static_assert(WS_ACT + (size_t)NSLOTS * FF * 2 <= WS_H && WS_YS + (size_t)NSLOTS * D * 2 <= WS_END, "ws map");
constexpr int CW_BAR = 4096;

constexpr int RING_BYTES = 131072;
constexpr int MISC_OFF = RING_BYTES;
constexpr int IDX_OFF = MISC_OFF + 128;
constexpr int TIL_OFF = IDX_OFF + 2048;
constexpr int BIAS_OFF = TIL_OFF + 3 * MAXTILES * 4 + 256;
constexpr int LDS_BYTES = 147456;
static_assert(BIAS_OFF + 3 * 1024 <= LDS_BYTES && (BIAS_OFF & 15) == 0, "LDS map");

#define RLX_AGENT __ATOMIC_RELAXED, __HIP_MEMORY_SCOPE_AGENT
__device__ __forceinline__ float bf2f(bf16 v) { return __uint_as_float(((unsigned)v) << 16); }
__device__ __forceinline__ bf16 f2bf(float f) { unsigned u = __float_as_uint(f); u += 0x7fffu + ((u >> 16) & 1u); return (bf16)(u >> 16); }
__device__ __forceinline__ unsigned pk2(float lo, float hi) { return (unsigned)f2bf(lo) | ((unsigned)f2bf(hi) << 16); }
__device__ __forceinline__ unsigned cvt_pk_bf16(float lo, float hi) { unsigned r; asm volatile("v_cvt_pk_bf16_f32 %0, %1, %2" : "=v"(r) : "v"(lo), "v"(hi)); return r; }
__device__ __forceinline__ unsigned pk4_fp8(float a, float b, float c, float d) { unsigned w = 0u; w = __builtin_amdgcn_cvt_pk_fp8_f32(a, b, w, false); w = __builtin_amdgcn_cvt_pk_fp8_f32(c, d, w, true); return w; }
__device__ __forceinline__ float lo_bf(unsigned u) { return __uint_as_float(u << 16); }
__device__ __forceinline__ float hi_bf(unsigned u) { return __uint_as_float(u & 0xffff0000u); }
__device__ __forceinline__ f32x4 ldbf4(const bf16* p) { const uint2 u = *(const uint2*)p; return (f32x4){lo_bf(u.x), hi_bf(u.x), lo_bf(u.y), hi_bf(u.y)}; }
__device__ __forceinline__ float wave_sum(float v) {
#pragma unroll
    for (int o = 1; o < 64; o <<= 1) v += __shfl_xor(v, o);
    return v;
}
__device__ __forceinline__ float sigmoidf_(float x) { return __builtin_amdgcn_rcpf(1.f + __builtin_amdgcn_exp2f(-1.4426950408889634f * x)); }
__device__ __forceinline__ void fcis(float x, float* sn, float* cs) { const float C = 0.15915494309189535f; const float rev = x * C; const float err = fmaf(x, C, -rev); const float fr = (rev - rintf(rev)) + err; *sn = __builtin_amdgcn_sinf(fr); *cs = __builtin_amdgcn_cosf(fr); }
__device__ __forceinline__ float gelu_tanh(float x) { const float u = 1.5957691216057308f * (x + 0.044715f * x * x * x); return x * __builtin_amdgcn_rcpf(1.f + __builtin_amdgcn_exp2f(-1.4426950408889634f * u)); }

#define XB_TMO      128
#define XB_XCNT(j)  (256  + 64 * (j))
#define XB_XSUB(j)  (1280 + 64 * (j))
#define XB_XGEN(j)  (2304 + 64 * (j))
#define XB_TOP      3328
#define XB_TOPGEN   3392
#define XCD_BAR_WORDS 3456
#define XB_SPIN_CAP (1u << 18)
__device__ __forceinline__ unsigned xb_ld(unsigned* p)              { return __hip_atomic_load(p, __ATOMIC_RELAXED, __HIP_MEMORY_SCOPE_AGENT); }
__device__ __forceinline__ unsigned xb_add(unsigned* p, unsigned v) { return __hip_atomic_fetch_add(p, v, __ATOMIC_RELAXED, __HIP_MEMORY_SCOPE_AGENT); }
__device__ __forceinline__ unsigned xb_xcc_id() { return (unsigned)__builtin_amdgcn_s_getreg((3 << 11) | 20) & 0xFu; }
#define XB_SPIN(cond, bar) do { unsigned _sp = 0; while (cond) { __builtin_amdgcn_s_sleep(1); \
    if ((++_sp & 255u) == 0u) { if (xb_ld(&(bar)[XB_TMO])) break; if (_sp > XB_SPIN_CAP) { atomicAdd(&(bar)[XB_TMO], 1u); break; } } } } while (0)
struct XcdBarrier { unsigned* bar; unsigned x; volatile LAS unsigned* st; };
__device__ __forceinline__ XcdBarrier xcd_barrier_post(unsigned* bar, volatile LAS unsigned* st) {
    XcdBarrier b; b.bar = bar; b.x = xb_xcc_id(); b.st = st;
    if (threadIdx.x == 0) (void)xb_add(&bar[XB_XCNT(b.x)], 1u);
    return b;
}
__device__ __forceinline__ void xcd_barrier_complete(unsigned* bar, unsigned x, unsigned& nloc, unsigned& nx) {
    const unsigned G = gridDim.x * gridDim.y * gridDim.z;
    unsigned sum, cnt, mine, sp = 0u;
    for (;;) {
        sum = 0u; cnt = 0u; mine = 0u;
#pragma unroll
        for (unsigned j = 0; j < 16; ++j) { const unsigned c = xb_ld(&bar[XB_XCNT(j)]); sum += c; cnt += (c > 0u) ? 1u : 0u; mine = (j == x) ? c : mine; }
        if (sum == G) break;
        __builtin_amdgcn_s_sleep(1);
        if ((++sp & 255u) == 0u) { if (xb_ld(&bar[XB_TMO])) break; if (sp > XB_SPIN_CAP) { atomicAdd(&bar[XB_TMO], 1u); break; } }
    }
    nloc = mine > 0u ? mine : 1u; nx = cnt > 0u ? cnt : 1u;
}
__device__ __forceinline__ void xcd_barrier(const XcdBarrier& b) {
    asm volatile("s_waitcnt vmcnt(0)" ::: "memory");
    __syncthreads();
    if (threadIdx.x == 0) {
        unsigned* bar = b.bar;
        __builtin_amdgcn_s_waitcnt(0);
        unsigned nloc = b.st[0], nx = b.st[1];
        if (nloc == 0u) { xcd_barrier_complete(bar, b.x, nloc, nx); b.st[0] = nloc; b.st[1] = nx; }
        const unsigned old = xb_add(&bar[XB_XSUB(b.x)], 1u);
        const unsigned gen = old / nloc;
        if (old + 1u == (gen + 1u) * nloc) {
            __builtin_amdgcn_fence(__ATOMIC_RELEASE, "agent");
            asm volatile("s_waitcnt vmcnt(0)" ::: "memory");
            const unsigned og = xb_add(&bar[XB_TOP], 1u);
            const unsigned tg = og / nx;
            if (og + 1u == (tg + 1u) * nx) xb_add(&bar[XB_TOPGEN], 1u);
            else XB_SPIN(xb_ld(&bar[XB_TOPGEN]) == tg, bar);
            __builtin_amdgcn_fence(__ATOMIC_ACQUIRE, "agent");
            xb_add(&bar[XB_XGEN(b.x)], 1u);
            asm volatile("s_waitcnt vmcnt(0)" ::: "memory");
        } else {
            XB_SPIN(xb_ld(&bar[XB_XGEN(b.x)]) == gen, bar);
            __builtin_amdgcn_fence(__ATOMIC_ACQUIRE, "agent");
            asm volatile("s_waitcnt vmcnt(0)" ::: "memory");
        }
    }
    __syncthreads();
}

namespace pg {
constexpr int BM = 256, BK = 64, HALF = 128, HTB = HALF * BK * 2, STAGE_BYTES = 8 * HTB, NXCD = 8, WGM = 4;
__host__ __device__ __forceinline__ int lds_byte(int r, int c) { const int st = (r >> 4) * 2 + (c >> 5), rr = r & 15, cc = c & 31, ob = rr * 64 + cc * 2; return st * 1024 + (ob ^ (((ob >> 9) & 1) << 5)); }
__host__ __device__ __forceinline__ void stage_rc(int b, int& R, int& C) { const int st = b / 1024, sb = b % 1024, swz = sb ^ (((sb >> 9) & 1) << 5); R = (st >> 1) * 16 + swz / 64; C = (st & 1) * 32 + (swz % 64) / 2; }
__host__ __device__ __forceinline__ int perm32(int rho) { const int n = rho >> 4, i = rho & 15; return 8 * (i >> 2) + 4 * n + (i & 3); }

struct Unit { unsigned A, B; int pm, pn, e, nrows; };
__device__ __forceinline__ __amdgpu_buffer_rsrc_t mkrsrc(const void* p) { return __builtin_amdgcn_make_buffer_rsrc((void*)p, 0, 0x7fffffff, 0x00020000); }

__device__ __forceinline__ bool tile_order(int i, int G, int c, int nM, int nN, int& pm, int& pn) {
    const int nwg = nM * nN; const long L = (long)i * G + c; if (L >= nwg) return false;
    int wgid = (int)L; { const int q = nwg / NXCD, r = nwg % NXCD, xcd = wgid % NXCD, off = wgid / NXCD; wgid = (xcd < r ? xcd * (q + 1) : r * (q + 1) + (xcd - r) * q) + off; }
    const int nig = WGM * nN, gid = wgid / nig, fm = gid * WGM, gsz = (nM - fm) < WGM ? (nM - fm) : WGM;
    pm = fm + ((wgid % nig) % gsz); pn = (wgid % nig) / gsz; return true;
}
struct DenseSched {
    const char* A; const char* Bt; int lda2  , K2  , nM, nN, G, c;
    __device__ __forceinline__ bool next(int i, Unit& u) const { int pm, pn; if (!tile_order(i, G, c, nM, nN, pm, pn)) return false;
        u.A = (unsigned)pm * 256u * (unsigned)lda2; u.B = (unsigned)pn * 256u * (unsigned)K2; u.pm = pm; u.pn = pn; u.e = 0; u.nrows = 256; return true; }
    __device__ __forceinline__ __amdgpu_buffer_rsrc_t rsrcA() const { return mkrsrc(A); }
    __device__ __forceinline__ __amdgpu_buffer_rsrc_t rsrcB() const { return mkrsrc(Bt); }
    __device__ __forceinline__ void prefetch(const Unit&, int, int) const {}
    __device__ __forceinline__ unsigned aoff(const Unit&, int row, int) const { return (unsigned)row * (unsigned)lda2; }
};

typedef int i32x8 __attribute__((ext_vector_type(8)));
template <class Epi, class Sched, bool ALIGN_EPI, bool FP8 = false>
__device__ __forceinline__ void gemm_phase(LAS unsigned char* lds, const int K, const Sched& S, const Epi& E) {
    const int tid = threadIdx.x, wid = __builtin_amdgcn_readfirstlane(tid >> 6), lane = tid & 63, wr = wid >> 2, wc = wid & 3, fr = lane & 15, fq = lane >> 4;
    const int nt = FP8 ? K / 128 : K / BK;
    unsigned voffA[2][2], voffB[2];
#pragma unroll
    for (int i = 0; i < 1; ++i) { int R, C; if constexpr (FP8) { const int p = tid + 512 * i; R = p >> 3; C = (((p >> 1) & 3) ^ ((R >> 1) & 3)) * 32 + (p & 1) * 16; } else { stage_rc(tid * 16 + i * 8192, R, C); C *= 2; }
        const int Rb = Epi::PERM ? ((R & ~31) + perm32(R & 31)) : R; voffB[i] = (unsigned)(Rb * K * (FP8 ? 1 : 2) + C); }
    const unsigned kstep = (unsigned)(BK * 2);
    const unsigned hstep = (unsigned)HALF * K * (FP8 ? 1 : 2);
    const unsigned b64step = hstep / 2;
    const unsigned ldsw = (unsigned)wid * 1024u;
    const int aoff = FP8 ? (wr * 64 + fr) * 128 + ((fq ^ ((fr >> 1) & 3)) * 32) : lds_byte(wr * 64 + fr, fq * 8);
    const int boff = FP8 ? (wc * 32 + fr) * 128 + ((fq ^ ((fr >> 1) & 3)) * 32) : lds_byte(wc * 32 + fr, fq * 8);
#define PG_SA(b, h) (((b) * 2 + (h)) * HTB)
#define PG_SB(b, h) ((4 + (b) * 2 + (h)) * HTB)
#define PG_STAGE(bufoff, so, voff) do { _Pragma("unroll") for (int _i = 0; _i < 2; ++_i) \
        __builtin_amdgcn_raw_ptr_buffer_load_lds(rA, (LAS void*)(lds + (bufoff) + ldsw + _i * 8192), 16, (int)(voff)[_i], (int)(so), 0, 0); } while (0)
#define PG_STAGEB(bufoff, so) do { _Pragma("unroll") for (int _i = 0; _i < 2; ++_i) \
        __builtin_amdgcn_raw_ptr_buffer_load_lds(rB, (LAS void*)(lds + (bufoff) + ldsw + _i * 8192), 16, (int)voffB[0], (int)((so) + _i * b64step), 0, 0); } while (0)
#define PG_LD8(p, p2) __builtin_bit_cast(i32x8, __builtin_shufflevector(*(const LAS u32x4*)(p), *(const LAS u32x4*)(p2), 0, 1, 2, 3, 4, 5, 6, 7))
#define PG_LDA(dst, b, h) do { if constexpr (FP8) { _Pragma("unroll") for (int m = 0; m < 4; ++m) dst##8[m] = PG_LD8(lds + PG_SA(b, h) + aoff + m * 2048, lds + PG_SA(b, h) + aoff + m * 2048 + 16); } \
        else { _Pragma("unroll") for (int m = 0; m < 4; ++m) _Pragma("unroll") for (int k = 0; k < 2; ++k) dst[m][k] = *(const LAS bf16x8*)(lds + PG_SA(b, h) + aoff + m * 2048 + k * 1024); } } while (0)
#define PG_LDB(dst, b, h) do { if constexpr (FP8) { _Pragma("unroll") for (int n = 0; n < 2; ++n) dst##8[n] = PG_LD8(lds + PG_SB(b, h) + boff + n * 2048, lds + PG_SB(b, h) + boff + n * 2048 + 16); } \
        else { _Pragma("unroll") for (int n = 0; n < 2; ++n) _Pragma("unroll") for (int k = 0; k < 2; ++k) dst[n][k] = *(const LAS bf16x8*)(lds + PG_SB(b, h) + boff + n * 2048 + k * 1024); } } while (0)
#define PG_MMA(ai, bj, At, Bt) do { __builtin_amdgcn_s_setprio(1); if constexpr (FP8) { _Pragma("unroll") for (int m = 0; m < 4; ++m) _Pragma("unroll") for (int n = 0; n < 2; ++n) \
            acc[ai][bj][m][n] = __builtin_amdgcn_mfma_scale_f32_16x16x128_f8f6f4(Bt##8[n], At##8[m], acc[ai][bj][m][n], 0, 0, 0, 0, 0, 0); } \
        else { _Pragma("unroll") for (int m = 0; m < 4; ++m) _Pragma("unroll") for (int n = 0; n < 2; ++n) _Pragma("unroll") for (int k = 0; k < 2; ++k) \
            acc[ai][bj][m][n] = __builtin_amdgcn_mfma_f32_16x16x32_bf16(Bt[n][k], At[m][k], acc[ai][bj][m][n], 0, 0, 0); } __builtin_amdgcn_s_setprio(0); } while (0)
#define PG_WAIT_V(n) asm volatile("s_waitcnt vmcnt(" #n ")" ::: "memory")
#define PG_WAIT_L(n) asm volatile("s_waitcnt lgkmcnt(" #n ")" ::: "memory")
#define PG_BAR __builtin_amdgcn_s_barrier()
#define PG_SCHED __builtin_amdgcn_sched_barrier(0)
#define PG_SET_AOFF(u, ib) do { int _t = threadIdx.x; asm volatile("" : "+v"(_t));     \
        _Pragma("unroll") for (int _i = 0; _i < 2; ++_i) { int _R, _C; if constexpr (FP8) { const int _p = _t + 512 * _i; _R = _p >> 3; _C = (((_p >> 1) & 3) ^ ((_R >> 1) & 3)) * 32 + (_p & 1) * 16; } else { stage_rc(_t * 16 + _i * 8192, _R, _C); _C *= 2; } \
        voffA[0][_i] = S.aoff(u, _R, ib) + (unsigned)_C; voffA[1][_i] = S.aoff(u, _R + HALF, ib) + (unsigned)_C; } } while (0)
    Unit cur, nxt; int ui = 0;
    if (!S.next(0, cur)) return;
    f32x4 acc[2][2][4][2];
#pragma unroll
    for (int a = 0; a < 2; ++a)
#pragma unroll
        for (int b = 0; b < 2; ++b)
#pragma unroll
            for (int m = 0; m < 4; ++m)
#pragma unroll
                for (int n = 0; n < 2; ++n) acc[a][b][m][n] = (f32x4){0.f, 0.f, 0.f, 0.f};
    bf16x8 At[FP8 ? 1 : 4][2], B0[2][2], B1[2][2]; i32x8 At8[FP8 ? 4 : 1], B08[2], B18[2];
    const __amdgpu_buffer_rsrc_t rA = S.rsrcA(), rB = S.rsrcB();
    unsigned cA = cur.A, cB = cur.B;
    S.prefetch(cur, 0, 0);
    PG_WAIT_V(0); __syncthreads();
    PG_SET_AOFF(cur, 0);
    PG_STAGEB(PG_SB(0, 0), cB); PG_STAGEB(PG_SB(0, 1), cB + hstep); PG_STAGE(PG_SA(0, 0), cA, voffA[0]); PG_STAGE(PG_SA(0, 1), cA, voffA[1]);
    if (wr == 1) PG_BAR;
    PG_WAIT_V(2); PG_BAR;
    PG_STAGEB(PG_SB(1, 0), cB + kstep); PG_STAGE(PG_SA(1, 0), cA + kstep, voffA[0]); PG_STAGEB(PG_SB(1, 1), cB + hstep + kstep);
    PG_WAIT_V(6); PG_BAR;
    for (;;) {
        const bool has_next = S.next(ui + 1, nxt);
        const unsigned nA = has_next ? nxt.A : cA, nB = has_next ? nxt.B : cB;
        if (has_next) S.prefetch(nxt, (ui + 1) & 1, (ui + 1) % 3);
#pragma unroll 1
        for (int t = 0; t < nt; t += 2) {
            const bool last = (t == nt - 2);
            const unsigned a1 = cA + (unsigned)(t + 1) * kstep;
            const unsigned a2 = last ? nA : cA + (unsigned)(t + 2) * kstep, b2 = last ? nB : cB + (unsigned)(t + 2) * kstep;
            const unsigned a3 = a2 + kstep, b3 = b2 + kstep;
            PG_LDB(B0, 0, 0); PG_LDB(B1, 0, 1); PG_SCHED; PG_LDA(At, 0, 0); PG_STAGE(PG_SA(1, 1), a1, voffA[1]);
            PG_WAIT_V(8); PG_WAIT_L(0); PG_BAR; PG_MMA(0, 0, At, B0); PG_MMA(0, 1, At, B1); PG_BAR; PG_SCHED;
            if (last && has_next) PG_SET_AOFF(nxt, (ui + 1) & 1);
            PG_LDA(At, 0, 1); PG_STAGEB(PG_SB(0, 0), b2); PG_STAGEB(PG_SB(0, 1), b2 + hstep); PG_STAGE(PG_SA(0, 0), a2, voffA[0]);
            PG_WAIT_V(8); PG_WAIT_L(0); PG_BAR; PG_MMA(1, 0, At, B0); PG_MMA(1, 1, At, B1); PG_BAR; PG_SCHED;
            PG_LDB(B0, 1, 0); PG_LDB(B1, 1, 1); PG_SCHED; PG_LDA(At, 1, 0); PG_STAGE(PG_SA(0, 1), a2, voffA[1]);
            PG_WAIT_V(8); PG_WAIT_L(0); PG_BAR; PG_MMA(0, 0, At, B0); PG_MMA(0, 1, At, B1); PG_BAR; PG_SCHED;
            PG_LDA(At, 1, 1); PG_STAGEB(PG_SB(1, 0), b3); PG_STAGEB(PG_SB(1, 1), b3 + hstep); PG_STAGE(PG_SA(1, 0), a3, voffA[0]);
            PG_WAIT_V(8); PG_WAIT_L(0); PG_BAR; PG_MMA(1, 0, At, B0); PG_MMA(1, 1, At, B1); PG_BAR; PG_SCHED;
        }
        if constexpr (ALIGN_EPI) { if (wr == 0) PG_BAR; }
        {
            int tz = threadIdx.x; asm volatile("" : "+v"(tz)); const int lz = tz & 63;
            E(acc, cur, ui % 3, (tz >> 6) >> 2, (tz >> 6) & 3, lz & 15, lz >> 4);
        }
        if (!has_next) break;
#pragma unroll
        for (int a = 0; a < 2; ++a)
#pragma unroll
            for (int b = 0; b < 2; ++b)
#pragma unroll
                for (int m = 0; m < 4; ++m)
#pragma unroll
                    for (int n = 0; n < 2; ++n) acc[a][b][m][n] = (f32x4){0.f, 0.f, 0.f, 0.f};
        cur = nxt; cA = nA; cB = nB; ++ui;
        if constexpr (ALIGN_EPI) { if (wr == 1) PG_BAR; }
    }
    PG_WAIT_V(0);
    if constexpr (!ALIGN_EPI) { if (wr == 0) PG_BAR; }
    PG_BAR;
#undef PG_SA
#undef PG_SB
#undef PG_STAGE
#undef PG_STAGEB
#undef PG_LDA
#undef PG_LDB
#undef PG_MMA
#undef PG_LD8
#undef PG_WAIT_V
#undef PG_WAIT_L
#undef PG_BAR
#undef PG_SCHED
#undef PG_SET_AOFF
}

struct EpiProj {
    static constexpr bool PERM = true; bf16* P; bf16* S5A;
    __device__ __forceinline__ void operator()(const f32x4 (&acc)[2][2][4][2], const Unit& u, int bb, int wr, int wc, int fr, int fq) const {
        const int row0 = u.pm * BM + wr * 64 + fr, col0 = u.pn * BM + wc * 32 + 8 * fq;
#pragma unroll
        for (int ai = 0; ai < 2; ++ai)
#pragma unroll
            for (int m = 0; m < 4; ++m) { const int row = row0 + ai * HALF + m * 16; bf16* rowp = P + (size_t)row * NPROJ + col0;
                if (u.pn < 2) { const int b = row >> 13, tt = row & 8191; rowp = S5A + ((size_t)b * S5NCH + (tt / S5L)) * S5K + (tt % S5L) * 16 + (col0 & 15) + (size_t)(col0 >> 4) * S5ROWS * S5K; }
#pragma unroll
                for (int bj = 0; bj < 2; ++bj) { const f32x4 v0 = acc[ai][bj][m][0], v1 = acc[ai][bj][m][1];
                    u32x4 w; w.x = cvt_pk_bf16(v0[0], v0[1]); w.y = cvt_pk_bf16(v0[2], v0[3]); w.z = cvt_pk_bf16(v1[0], v1[1]); w.w = cvt_pk_bf16(v1[2], v1[3]);
                    *(u32x4*)(rowp + (u.pn < 2 ? (size_t)bj * 8 * S5ROWS * S5K : (size_t)bj * HALF)) = w; } }
    }
};
struct EpiXloc {
    static constexpr bool PERM = false; float* X;
    __device__ __forceinline__ void operator()(const f32x4 (&acc)[2][2][4][2], const Unit& u, int bb, int wr, int wc, int fr, int fq) const {
        const int row0 = (u.pm & 3) * BM + wr * 64 + fr, col0 = wc * 32 + 4 * fq;
#pragma unroll
        for (int ai = 0; ai < 2; ++ai)
#pragma unroll
            for (int m = 0; m < 4; ++m) { float* rp = X + ((size_t)u.e * S5ROWS + row0 + ai * HALF + m * 16) * 128 + col0;
#pragma unroll
                for (int n = 0; n < 2; ++n) *(f32x4*)(rp + n * 16) = acc[ai][0][m][n]; }
    }
};
struct EpiS5Y {
    static constexpr bool PERM = true; const bf16* S5A; const float* dskip; bf16* GY;
    __device__ __forceinline__ void operator()(const f32x4 (&acc)[2][2][4][2], const Unit& u, int bb, int wr, int wc, int fr, int fq) const {
        const int g = u.e, rg0 = (u.pm & 3) * BM + wr * 64 + fr, c0 = u.pn * BM + wc * 32 + 8 * fq;
#pragma unroll
        for (int bj = 0; bj < 2; ++bj) { const int col = c0 + bj * HALF, t = col >> 4, p0 = col & 15;
            const f32x4 d0 = *(const f32x4*)(dskip + g * 16 + p0), d1 = *(const f32x4*)(dskip + g * 16 + p0 + 4);
#pragma unroll
            for (int ai = 0; ai < 2; ++ai)
#pragma unroll
                for (int m = 0; m < 4; ++m) { const int rg = rg0 + ai * HALF + m * 16; const int b = rg / S5NCH, c = rg % S5NCH;
                    const u32x4 uu = *(const u32x4*)(S5A + ((size_t)g * S5ROWS + rg) * S5K + col);
                    const f32x4 v0 = acc[ai][bj][m][0], v1 = acc[ai][bj][m][1];
                    u32x4 w;
                    w.x = cvt_pk_bf16(gelu_tanh(v0[0] + d0[0] * lo_bf(uu.x)), gelu_tanh(v0[1] + d0[1] * hi_bf(uu.x))); w.y = cvt_pk_bf16(gelu_tanh(v0[2] + d0[2] * lo_bf(uu.y)), gelu_tanh(v0[3] + d0[3] * hi_bf(uu.y)));
                    w.z = cvt_pk_bf16(gelu_tanh(v1[0] + d1[0] * lo_bf(uu.z)), gelu_tanh(v1[1] + d1[1] * hi_bf(uu.z))); w.w = cvt_pk_bf16(gelu_tanh(v1[2] + d1[2] * lo_bf(uu.w)), gelu_tanh(v1[3] + d1[3] * hi_bf(uu.w)));
                    *(u32x4*)(GY + ((size_t)b * SEQ + c * S5L + t) * 512 + g * 16 + p0) = w; } }
    }
};
struct S5Sched {
    const char* A; const char* B; int lda2, K2, brows, nN, G, c;
    __device__ __forceinline__ bool next(int i, Unit& u) const { const int L = i * G + c; if (L >= 128 * nN) return false;
        const int g = L / (4 * nN), r = L % (4 * nN), mh = r / nN, pn = r % nN;
        u.A = ((unsigned)g * S5ROWS + mh * 256u) * (unsigned)lda2; u.B = ((unsigned)g * brows + pn * 256u) * (unsigned)K2; u.pm = g * 4 + mh; u.pn = pn; u.e = g; u.nrows = 256; return true; }
    __device__ __forceinline__ __amdgpu_buffer_rsrc_t rsrcA() const { return mkrsrc(A); }
    __device__ __forceinline__ __amdgpu_buffer_rsrc_t rsrcB() const { return mkrsrc(B); }
    __device__ __forceinline__ void prefetch(const Unit&, int, int) const {}
    __device__ __forceinline__ unsigned aoff(const Unit&, int row, int) const { return (unsigned)row * (unsigned)lda2; }
};
struct EpiGlu {
    static constexpr bool PERM = true; const bf16* GY; const float* bglu; bf16* MIX;
    __device__ __forceinline__ void operator()(const f32x4 (&acc)[2][2][4][2], const Unit& u, int bb, int wr, int wc, int fr, int fq) const {
        const int row0 = u.pm * BM + wr * 64 + fr, col0 = u.pn * BM + wc * 32 + 8 * fq;
#pragma unroll
        for (int bj = 0; bj < 2; ++bj) { const int col = col0 + bj * HALF;
            const f32x4 b0 = *(const f32x4*)(bglu + col), b1 = *(const f32x4*)(bglu + col + 4);
#pragma unroll
            for (int ai = 0; ai < 2; ++ai)
#pragma unroll
                for (int m = 0; m < 4; ++m) { const size_t row = (size_t)(row0 + ai * HALF + m * 16);
                    const u32x4 g = *(const u32x4*)(GY + row * 512 + col);
                    const f32x4 v0 = acc[ai][bj][m][0] + b0, v1 = acc[ai][bj][m][1] + b1;
                    u32x4 w;
                    w.x = cvt_pk_bf16(lo_bf(g.x) * sigmoidf_(v0[0]), hi_bf(g.x) * sigmoidf_(v0[1])); w.y = cvt_pk_bf16(lo_bf(g.y) * sigmoidf_(v0[2]), hi_bf(g.y) * sigmoidf_(v0[3]));
                    w.z = cvt_pk_bf16(lo_bf(g.z) * sigmoidf_(v1[0]), hi_bf(g.z) * sigmoidf_(v1[1])); w.w = cvt_pk_bf16(lo_bf(g.w) * sigmoidf_(v1[2]), hi_bf(g.w) * sigmoidf_(v1[3]));
                    *(u32x4*)(MIX + row * D + col) = w; } }
    }
};
struct EpiOut {
    static constexpr bool PERM = true; const float* x; bf16* H;
    __device__ __forceinline__ void operator()(const f32x4 (&acc)[2][2][4][2], const Unit& u, int bb, int wr, int wc, int fr, int fq) const {
        const int row0 = u.pm * BM + wr * 64 + fr, col0 = u.pn * BM + wc * 32 + 8 * fq;
#pragma unroll
        for (int ai = 0; ai < 2; ++ai)
#pragma unroll
            for (int m = 0; m < 4; ++m) { const size_t ro = (size_t)(row0 + ai * HALF + m * 16) * D + col0;
#pragma unroll
                for (int bj = 0; bj < 2; ++bj) { const f32x4 v0 = __builtin_nontemporal_load((const f32x4*)(x + ro + bj * HALF)) + acc[ai][bj][m][0], v1 = __builtin_nontemporal_load((const f32x4*)(x + ro + bj * HALF + 4)) + acc[ai][bj][m][1];
                    u32x4 w; w.x = cvt_pk_bf16(v0[0], v0[1]); w.y = cvt_pk_bf16(v0[2], v0[3]); w.z = cvt_pk_bf16(v1[0], v1[1]); w.w = cvt_pk_bf16(v1[2], v1[3]);
                    *(u32x4*)(H + ro + bj * HALF) = w; } }
    }
};
struct EpiUp {
    static constexpr bool PERM = true; const LAS float* bl; unsigned char* ACT;
    __device__ __forceinline__ void operator()(const f32x4 (&acc)[2][2][4][2], const Unit& u, int bb, int wr, int wc, int fr, int fq) const {
        const int row0 = u.pm * BM + wr * 64 + fr, j0 = u.pn * HALF + wc * 32 + 8 * fq;
        const LAS float* bg = bl + bb * 256 + wc * 32 + 8 * fq;
#pragma unroll
        for (int ai = 0; ai < 2; ++ai)
#pragma unroll
            for (int m = 0; m < 4; ++m) {
                float o[8];
#pragma unroll
                for (int n = 0; n < 2; ++n) { const f32x4 gb = *(const LAS f32x4*)(bg + 4 * n), lb = *(const LAS f32x4*)(bg + 128 + 4 * n);
#pragma unroll
                    for (int q = 0; q < 4; ++q) { const float g = fminf(acc[ai][0][m][n][q] * W8_INV + gb[q], 7.f); const float li = fminf(fmaxf(acc[ai][1][m][n][q] * W8_INV + lb[q], -7.f), 7.f);
                        o[n * 4 + q] = g * sigmoidf_(1.702f * g) * (li + 1.f); } }
                u32x2 w; w.x = pk4_fp8(o[0], o[1], o[2], o[3]); w.y = pk4_fp8(o[4], o[5], o[6], o[7]);
                *(u32x2*)(ACT + (size_t)(row0 + ai * HALF + m * 16) * FF + j0) = w; }
    }
};
struct EpiDown {
    static constexpr bool PERM = true; const LAS float* bl; unsigned char* YS;
    __device__ __forceinline__ void operator()(const f32x4 (&acc)[2][2][4][2], const Unit& u, int bb, int wr, int wc, int fr, int fq) const {
        const int row0 = u.pm * BM + wr * 64 + fr, col0 = u.pn * BM + wc * 32 + 8 * fq;
        const LAS float* bp = bl + bb * 256 + wc * 32 + 8 * fq;
#pragma unroll
        for (int ai = 0; ai < 2; ++ai)
#pragma unroll
            for (int m = 0; m < 4; ++m)
#pragma unroll
                for (int bj = 0; bj < 2; ++bj) { const f32x4 b0 = *(const LAS f32x4*)(bp + bj * HALF), b1 = *(const LAS f32x4*)(bp + bj * HALF + 4);
                    const f32x4 v0 = acc[ai][bj][m][0] * W8_INV + b0, v1 = acc[ai][bj][m][1] * W8_INV + b1;
                    u32x2 w; w.x = pk4_fp8(v0[0], v0[1], v0[2], v0[3]); w.y = pk4_fp8(v1[0], v1[1], v1[2], v1[3]);
                    *(u32x2*)(YS + (size_t)(row0 + ai * HALF + m * 16) * D + col0 + bj * HALF) = w; }
    }
};
}

struct MoeSched {
    const char* A; const char* W; const int* slot_tok; const float* bias; LAS int* til; LAS int* idx; LAS float* bl; int lda2, K2, nN, wrows  , G, c, gather;
    __device__ __forceinline__ bool next(int i, pg::Unit& u) const {
        const int nM = __builtin_amdgcn_readfirstlane(til[2 * MAXTILES]); int pm, pn; if (!pg::tile_order(i, G, c, nM, nN, pm, pn)) return false;
        pm = __builtin_amdgcn_readfirstlane(pm); pn = __builtin_amdgcn_readfirstlane(pn);
        const int e = __builtin_amdgcn_readfirstlane(til[pm]); u.pm = pm; u.pn = pn; u.e = e; u.nrows = __builtin_amdgcn_readfirstlane(til[MAXTILES + pm]);
        u.A = gather ? 0u : (unsigned)pm * 256u * (unsigned)lda2; u.B = ((unsigned)e * wrows + (unsigned)pn * 256u) * (unsigned)K2; return true; }
    __device__ __forceinline__ __amdgpu_buffer_rsrc_t rsrcA() const { return pg::mkrsrc(A); }
    __device__ __forceinline__ __amdgpu_buffer_rsrc_t rsrcB() const { return pg::mkrsrc(W); }
    __device__ __forceinline__ void prefetch(const pg::Unit& u, int ib, int bb) const {
        if (threadIdx.x >= 256 && threadIdx.x < 320) {
            const int l = threadIdx.x - 256;
            const float* src = gather ? bias + (size_t)u.e * 2 * FF + (l < 32 ? u.pn * 128 + 4 * l : FF + u.pn * 128 + 4 * (l - 32)) : bias + (size_t)u.e * D + u.pn * 256 + 4 * l;
            __builtin_amdgcn_global_load_lds((const unsigned*)src, (LAS unsigned*)(bl + bb * 256), 16, 0, 0); }
        if (gather && threadIdx.x < 256) { const int r = threadIdx.x; const int s = u.pm * 256 + (r < u.nrows ? r : u.nrows - 1);
            __builtin_amdgcn_global_load_lds((const unsigned*)(slot_tok + s), (LAS unsigned*)(idx + ib * 256 + (threadIdx.x & ~63)), 4, 0, 0); } }
    __device__ __forceinline__ unsigned aoff(const pg::Unit&, int row, int ib) const { return gather ? (unsigned)idx[ib * 256 + row] * (unsigned)lda2 : (unsigned)row * (unsigned)lda2; }
};

struct Frame {
    LAS unsigned char* lds; volatile LAS unsigned* MISC; gu32* ctl; int tid, lane, wave, vcu, G;
};
#define LDS_WAIT() asm volatile("s_waitcnt lgkmcnt(0)" ::: "memory")

template <bool F8, class RowMap>
__device__ __forceinline__ void transpose_item(const float* W, int ldw, int K, int nblk, void* WTv, LAS bf16* scr, int item, int lane, RowMap rowmap) {
    const int kb = item / nblk, nb = item % nblk, k0 = 64 * kb, n0 = 64 * nb;
    const float* src = W + (size_t)(k0 + (lane >> 4)) * ldw + n0 + 4 * (lane & 15);
    f32x4 v[16];
#pragma unroll
    for (int i = 0; i < 16; ++i) v[i] = __builtin_nontemporal_load((const f32x4*)(src + (size_t)(4 * i) * ldw));
#pragma unroll
    for (int i = 0; i < 16; ++i) { u32x2 o; o.x = pk2(v[i].x, v[i].y); o.y = pk2(v[i].z, v[i].w); *(LAS u32x2*)(scr + ((lane >> 4) + 4 * i) * 68 + 4 * (lane & 15)) = o; }
    LDS_WAIT(); asm volatile("" ::: "memory");
    const int c = lane & 7; const int r0 = rowmap(n0);
#pragma unroll
    for (int jn = 0; jn < 8; ++jn) { const int n = (lane >> 3) + 8 * jn; const LAS bf16* sp = scr + (8 * c) * 68 + n;
        if constexpr (F8) { u32x2 o; o.x = pk4_fp8(bf2f(sp[0]) * W8_SCALE, bf2f(sp[68]) * W8_SCALE, bf2f(sp[2 * 68]) * W8_SCALE, bf2f(sp[3 * 68]) * W8_SCALE);
            o.y = pk4_fp8(bf2f(sp[4 * 68]) * W8_SCALE, bf2f(sp[5 * 68]) * W8_SCALE, bf2f(sp[6 * 68]) * W8_SCALE, bf2f(sp[7 * 68]) * W8_SCALE);
            __builtin_nontemporal_store(o, (u32x2*)((unsigned char*)WTv + (size_t)(r0 + n) * K + k0 + 8 * c)); }
        else { u32x4 o; o.x = (unsigned)sp[0] | ((unsigned)sp[68] << 16); o.y = (unsigned)sp[2 * 68] | ((unsigned)sp[3 * 68] << 16); o.z = (unsigned)sp[4 * 68] | ((unsigned)sp[5 * 68] << 16); o.w = (unsigned)sp[6 * 68] | ((unsigned)sp[7 * 68] << 16);
            *(u32x4*)((bf16*)WTv + (size_t)(r0 + n) * K + k0 + 8 * c) = o; } }
    LDS_WAIT(); asm volatile("" ::: "memory");
}
struct RowId { __device__ __forceinline__ int operator()(int n0) const { return n0; } };
struct RowUp { __device__ __forceinline__ int operator()(int n0) const { return n0 < FF ? (n0 >> 7) * 256 + (n0 & 127) : ((n0 - FF) >> 7) * 256 + 128 + ((n0 - FF) & 127); } };

struct Args { const float* in[26]; float* out; unsigned char* ws; int ph_lo, ph_hi, li, pad; };

__global__ void __launch_bounds__(NTHR, 2) fwd(Args args) {
    extern __shared__ __attribute__((aligned(16))) unsigned char lds_raw[];
    Frame F;
    F.lds = (LAS unsigned char*)lds_raw;
    F.MISC = (volatile LAS unsigned*)(F.lds + MISC_OFF);
    F.tid = threadIdx.x; F.lane = F.tid & 63; F.wave = __builtin_amdgcn_readfirstlane(F.tid >> 6);
    F.G = gridDim.x; { const int bx = blockIdx.x; F.vcu = (F.G % 8 == 0) ? (bx % 8) * (F.G / 8) + bx / 8 : bx; }
    unsigned char* ws = args.ws;
    F.ctl = (gu32*)(ws + WS_CTL);
    if (F.tid < 32) ((LAS unsigned*)(F.lds + MISC_OFF))[F.tid] = 0u;
    __syncthreads();
    XcdBarrier bar = xcd_barrier_post((unsigned*)(F.ctl + CW_BAR) + args.li * XCD_BAR_WORDS, F.MISC + 8);
#define INP(i) (*(const float* const volatile*)((const char*)__builtin_amdgcn_kernarg_segment_ptr() + 8 * (i)))
    const int lo = args.ph_lo, hi = args.ph_hi;
#define IN(k) (lo <= (k) && (k) < hi)
#define BOTH(k) (IN(k) && IN((k) + 1))
#define GRID_BAR() xcd_barrier(bar)
    const float* x = args.in[0];
    bf16* WIN = (bf16*)(ws + WS_WIN); bf16* WGLU = (bf16*)(ws + WS_WGLU); bf16* WOUT = (bf16*)(ws + WS_WOUT); unsigned char* WUP8 = ws + WS_WUP; unsigned char* WDN8 = ws + WS_WDN;
    bf16* HN = (bf16*)(ws + WS_HN); bf16* PROJ = (bf16*)(ws + WS_PROJ); bf16* GY = (bf16*)(ws + WS_GY); bf16* MIX = (bf16*)(ws + WS_MIX);
    bf16* H = (bf16*)(ws + WS_H); unsigned char* ACT8 = ws + WS_ACT; unsigned char* HN8 = ws + WS_HN; unsigned char* YS = ws + WS_YS;
    float* gates = (float*)(ws + WS_GATES); int* topi = (int*)(ws + WS_TOPI); float* topg = (float*)(ws + WS_TOPG);
    int* slot_tok = (int*)(ws + WS_SLOTTOK); int* tok_slot = (int*)(ws + WS_TOKSLOT); int* CNT = (int*)(ws + WS_CNT); int* ecnt = CNT + 16384;
    bf16* S5A = (bf16*)(ws + WS_S5A); bf16* S5BT = (bf16*)(ws + WS_S5BT); bf16* S5BQ = (bf16*)(ws + WS_S5BQ); float* XLOC = (float*)(ws + WS_XLOC);
    bf16* QH = (bf16*)(ws + WS_QH); bf16* KH = (bf16*)(ws + WS_KH); bf16* VT = (bf16*)(ws + WS_VT); float* DC = (float*)(ws + WS_DC); bf16* CST = (bf16*)(ws + WS_CST);
    float* FLOC = (float*)(ws + WS_FLOC); float* DN = (float*)(ws + WS_DN); float* NST = (float*)(ws + WS_NST); float* SEGS = (float*)(ws + WS_SEGS); float* KTAB = (float*)(ws + WS_KTAB);
    const int gw = F.vcu * NWAVES + F.wave, NGW = F.G * NWAVES;

    if (IN(0)) {
        { int tq_ = threadIdx.x; asm volatile("" : "+v"(tq_)); F.tid = tq_; F.lane = tq_ & 63; }
        LAS bf16* scr = (LAS bf16*)(F.lds + F.wave * 16384);
        constexpr int I_IN = (D / 64) * (NPROJ / 64), I_GLU = (512 / 64) * (512 / 64), I_OUT = (D / 64) * (D / 64), I_UP = (D / 64) * (2 * FF / 64), I_DN = (FF / 64) * (D / 64);
        constexpr int NITEMS = I_IN + I_GLU + I_OUT + NE * I_UP + NE * I_DN;
        for (int it = gw; it < NITEMS && !(args.pad & 1); it += NGW) {
            int r = it;
            if (r < I_IN) { transpose_item<false>(args.in[2], DIN, D, NPROJ / 64, WIN, scr, r, F.lane, RowId()); continue; } r -= I_IN;
            if (r < I_GLU) { transpose_item<false>(args.in[11], 512, 512, 512 / 64, WGLU, scr, r, F.lane, RowId()); continue; } r -= I_GLU;
            if (r < I_OUT) { transpose_item<false>(args.in[17], D, D, D / 64, WOUT, scr, r, F.lane, RowId()); continue; } r -= I_OUT;
            if (r < NE * I_UP) { const int e = r / I_UP; transpose_item<true>(args.in[21] + (size_t)e * D * 2 * FF, 2 * FF, D, 2 * FF / 64, WUP8 + (size_t)e * 2 * FF * D, scr, r % I_UP, F.lane, RowUp()); continue; } r -= NE * I_UP;
            { const int e = r / I_DN; transpose_item<true>(args.in[23] + (size_t)e * FF * D, D, FF, D / 64, WDN8 + (size_t)e * D * FF, scr, r % I_DN, F.lane, RowId()); }
        }
        {
            const float* g = args.in[1]; const float* w_in = args.in[2]; const float* b_gates = args.in[15];
            float wg[16][8]; f32x4 gg[4];
#pragma unroll
            for (int jq = 0; jq < 4; ++jq) { gg[jq] = *(const f32x4*)(g + 4 * F.lane + 256 * jq);
#pragma unroll
                for (int i = 0; i < 4; ++i) { const int k = 4 * F.lane + 256 * jq + i; const f32x4 w0 = *(const f32x4*)(w_in + (size_t)k * DIN + O_G), w1 = *(const f32x4*)(w_in + (size_t)k * DIN + O_G + 4);
                    wg[4 * jq + i][0] = w0.x; wg[4 * jq + i][1] = w0.y; wg[4 * jq + i][2] = w0.z; wg[4 * jq + i][3] = w0.w; wg[4 * jq + i][4] = w1.x; wg[4 * jq + i][5] = w1.y; wg[4 * jq + i][6] = w1.z; wg[4 * jq + i][7] = w1.w; } }
            float bgv[8];
#pragma unroll
            for (int q = 0; q < 8; ++q) bgv[q] = b_gates[q];
            f32x4 nx[4];
            if (gw < T) {
#pragma unroll
                for (int jq = 0; jq < 4; ++jq) nx[jq] = __builtin_nontemporal_load((const f32x4*)(x + (size_t)gw * D + 4 * F.lane + 256 * jq)); }
            for (int row = gw; row < T && !(args.pad & 2); row += NGW) {
                f32x4 v[4];
#pragma unroll
                for (int jq = 0; jq < 4; ++jq) v[jq] = nx[jq];
                if (row + NGW < T) {
#pragma unroll
                    for (int jq = 0; jq < 4; ++jq) nx[jq] = __builtin_nontemporal_load((const f32x4*)(x + (size_t)(row + NGW) * D + 4 * F.lane + 256 * jq)); }
                float ss = 0.f;
#pragma unroll
                for (int jq = 0; jq < 4; ++jq) ss += v[jq].x * v[jq].x + v[jq].y * v[jq].y + v[jq].z * v[jq].z + v[jq].w * v[jq].w;
                ss = wave_sum(ss);
                const float rstd = rsqrtf(ss * (1.f / D) + 1e-5f);
                float ga[8] = {0, 0, 0, 0, 0, 0, 0, 0};
#pragma unroll
                for (int jq = 0; jq < 4; ++jq) {
                    v[jq] = v[jq] * rstd * gg[jq];
#pragma unroll
                    for (int i = 0; i < 4; ++i)
#pragma unroll
                        for (int q = 0; q < 8; ++q) ga[q] += v[jq][i] * wg[4 * jq + i][q];
                    uint2 o; o.x = pk2(v[jq].x, v[jq].y); o.y = pk2(v[jq].z, v[jq].w);
                    *(uint2*)(HN + (size_t)row * D + 4 * F.lane + 256 * jq) = o;
                }
#pragma unroll
                for (int q = 0; q < 8; ++q) ga[q] = wave_sum(ga[q]);
                if (F.lane == 0) { *(f32x4*)(gates + (size_t)row * 8) = (f32x4){ga[0] + bgv[0], ga[1] + bgv[1], ga[2] + bgv[2], ga[3] + bgv[3]}; *(f32x4*)(gates + (size_t)row * 8 + 4) = (f32x4){ga[4] + bgv[4], ga[5] + bgv[5], ga[6] + bgv[6], ga[7] + bgv[7]}; }
            }
        }
        __syncthreads();
        for (int un = F.vcu; un < 256 && !(args.pad & 4); un += F.G) {
            const int g = un >> 3, j = un & 7;
            LAS float* Ere = (LAS float*)F.lds; LAS float* Eim = Ere + 4 * 64;
            LAS float* Bbr = Eim + 4 * 64; LAS float* Bbi = Bbr + 1024;
            LAS float* Cr = Bbi + 1024; LAS float* Ci = Cr + 1024;
            LAS float* E6r = Ci + 1024; LAS float* E6i = E6r + 1024;
            const float dt = __expf(args.in[3][g]);
            if (F.tid < 64) { const int n = F.tid;
                const float are = fminf(args.in[4][g * 64 + n], -1e-4f), aim = args.in[5][g * 64 + n];
                const float mag = __expf(dt * are); float sn, cs; fcis(dt * aim, &sn, &cs);
                const float nr = mag * cs - 1.f, ni = mag * sn, dn = are * are + aim * aim;
                const float cfr = (nr * are + ni * aim) / dn, cfi = (ni * are - nr * aim) / dn;
                for (int q = 0; q < 16; ++q) { const float br = args.in[6][(g * 64 + n) * 16 + q], bi = args.in[7][(g * 64 + n) * 16 + q]; Bbr[n * 16 + q] = cfr * br - cfi * bi; Bbi[n * 16 + q] = cfr * bi + cfi * br; }
            }
            for (int i = F.tid; i < 1024; i += NTHR) { Cr[i] = args.in[8][g * 1024 + i]; Ci[i] = args.in[9][g * 1024 + i]; }
            if (F.tid < 256) { const int tl = F.tid >> 6, n = F.tid & 63; const float tau = (float)(4 * j + tl);
                const float are = fminf(args.in[4][g * 64 + n], -1e-4f), aim = args.in[5][g * 64 + n];
                const float mag = __expf(tau * dt * are); float sn, cs; fcis(tau * dt * aim, &sn, &cs); Ere[F.tid] = mag * cs; Eim[F.tid] = mag * sn; }
            for (int i = F.tid; i < 1024; i += NTHR) { const int tau = i >> 5, n = 32 * (j & 1) + (i & 31);
                const float are = fminf(args.in[4][g * 64 + n], -1e-4f), aim = args.in[5][g * 64 + n];
                const float mag = __expf((float)tau * dt * are); float sn, cs; fcis((float)tau * dt * aim, &sn, &cs); E6r[i] = mag * cs; E6i[i] = mag * sn; }
            __syncthreads();
            {
                const int tl = F.tid >> 7, p = (F.tid >> 3) & 15, q0 = (F.tid & 7) * 2;
                float a0 = 0.f, a1 = 0.f;
                for (int n = 0; n < 64; ++n) { const float cr = Cr[p * 64 + n], ci = Ci[p * 64 + n], er = Ere[tl * 64 + n], ei = Eim[tl * 64 + n];
                    const float xr = cr * er - ci * ei, xi = cr * ei + ci * er;
                    a0 += xr * Bbr[n * 16 + q0] - xi * Bbi[n * 16 + q0]; a1 += xr * Bbr[n * 16 + q0 + 1] - xi * Bbi[n * 16 + q0 + 1]; }
                KTAB[((size_t)g * S5L + 4 * j + tl) * 256 + p * 16 + q0] = a0; KTAB[((size_t)g * S5L + 4 * j + tl) * 256 + p * 16 + q0 + 1] = a1;
            }
            for (int ch = F.tid; ch < 32 * (S5KIN / 8); ch += NTHR) {
                const int rl = ch / (S5KIN / 8), c8 = ch % (S5KIN / 8), r = 32 * j + rl, n = r & 63, im = (r >> 6) & 1, col = c8 * 8, sidx = col >> 4, q0 = col & 15;
                const float er = E6r[(S5L - 1 - sidx) * 32 + (n & 31)], ei = E6i[(S5L - 1 - sidx) * 32 + (n & 31)];
                float v[8];
#pragma unroll
                for (int i = 0; i < 8; ++i) { const float br = Bbr[n * 16 + q0 + i], bi = Bbi[n * 16 + q0 + i]; v[i] = im ? (er * bi + ei * br) : (er * br - ei * bi); }
                u32x4 o; o.x = pk2(v[0], v[1]); o.y = pk2(v[2], v[3]); o.z = pk2(v[4], v[5]); o.w = pk2(v[6], v[7]);
                *(u32x4*)(S5BQ + ((size_t)g * 256 + r) * S5KIN + col) = o;
            }
            __syncthreads();
        }
        if (BOTH(0)) GRID_BAR();
    }
    if (IN(1)) {
        { int tq_ = threadIdx.x; asm volatile("" : "+v"(tq_)); F.tid = tq_; F.lane = tq_ & 63; }
        pg::DenseSched S{(const char*)HN, (const char*)WIN, D * 2, D * 2, T / 256, NPROJ / 256, F.G, (int)blockIdx.x};
        pg::EpiProj E{PROJ, S5A};
        pg::gemm_phase<pg::EpiProj, pg::DenseSched, true>(F.lds, D, S, E);
        if (BOTH(1)) GRID_BAR();
    }
    if (IN(2)) {
        { int tq_ = threadIdx.x; asm volatile("" : "+v"(tq_)); F.tid = tq_; F.lane = tq_ & 63; }
        pg::S5Sched S{(const char*)S5A, (const char*)S5BQ, S5K * 2, S5KIN * 2, 256, 1, F.G, F.vcu};
        pg::EpiXloc E{XLOC};
        pg::gemm_phase<pg::EpiXloc, pg::S5Sched, true>(F.lds, S5KIN, S, E);
        {
            const int first = F.G > 128 ? F.vcu - 128 : F.vcu, stride = F.G > 128 ? F.G - 128 : F.G;
            LAS float* Kt = (LAS float*)F.lds;
            LAS float* Ere = Kt + S5L * 256; LAS float* Eim = Ere + 4 * 64;
            LAS float* Cr = Eim + 4 * 64; LAS float* Ci = Cr + 1024;
            for (int un = first; un >= 0 && un < 256; un += stride) {
                const int g = un >> 3, j = un & 7, ntau = 4 * j + 4;
                __syncthreads();
                for (int i = F.tid; i < ntau * 64; i += NTHR) *(LAS f32x4*)(Kt + 4 * i) = *(const f32x4*)(KTAB + (size_t)g * S5L * 256 + 4 * i);
                for (int i = F.tid; i < 1024; i += NTHR) { Cr[i] = args.in[8][g * 1024 + i]; Ci[i] = args.in[9][g * 1024 + i]; }
                if (F.tid < 256) { const int tl = F.tid >> 6, n = F.tid & 63; const float tau = (float)(4 * j + tl + 1); const float dt = __expf(args.in[3][g]);
                    const float are = fminf(args.in[4][g * 64 + n], -1e-4f), aim = args.in[5][g * 64 + n];
                    const float mag = __expf(tau * dt * are); float sn, cs; fcis(tau * dt * aim, &sn, &cs); Ere[F.tid] = mag * cs; Eim[F.tid] = mag * sn; }
                __syncthreads();
                for (int ch = F.tid; ch < 64 * (S5K / 8); ch += NTHR) {
                    const int rl = ch / (S5K / 8), c8 = ch % (S5K / 8), tl = rl >> 4, t = 4 * j + tl, p = rl & 15, col = c8 * 8;
                    float v[8];
                    if (col < S5KIN) { const int sidx = col >> 4, q0 = col & 15;
                        if (sidx <= t) { const f32x4 k0 = *(const LAS f32x4*)(Kt + (t - sidx) * 256 + p * 16 + q0), k1 = *(const LAS f32x4*)(Kt + (t - sidx) * 256 + p * 16 + q0 + 4);
                            v[0] = k0.x; v[1] = k0.y; v[2] = k0.z; v[3] = k0.w; v[4] = k1.x; v[5] = k1.y; v[6] = k1.z; v[7] = k1.w; }
                        else {
#pragma unroll
                            for (int i = 0; i < 8; ++i) v[i] = 0.f; }
                    } else { const int jj = (col - S5KIN) & 63, im = (col - S5KIN) >> 6;
#pragma unroll
                        for (int i = 0; i < 8; ++i) { const int n = jj + i; const float cr = Cr[p * 64 + n], ci = Ci[p * 64 + n], er = Ere[tl * 64 + n], ei = Eim[tl * 64 + n];
                            v[i] = im ? -(cr * ei + ci * er) : (cr * er - ci * ei); } }
                    u32x4 o; o.x = pk2(v[0], v[1]); o.y = pk2(v[2], v[3]); o.z = pk2(v[4], v[5]); o.w = pk2(v[6], v[7]);
                    *(u32x4*)(S5BT + ((size_t)g * S5KIN + 64 * j + rl) * S5K + col) = o;
                }
            }
            __syncthreads();
        }
    }
    if (IN(3)) {
        { int tq_ = threadIdx.x; asm volatile("" : "+v"(tq_)); F.tid = tq_; F.lane = tq_ & 63; }
        typedef short s16x4 __attribute__((ext_vector_type(4)));
        LAS float* wsl = (LAS float*)F.lds;
        LAS float* red = wsl + 512;
        LAS float* dnl = red + 32;
        LAS bf16* RQ = (LAS bf16*)(F.lds + 4352);
        LAS bf16* RK = RQ + 67 * 136;
        LAS bf16* RV = RK + 67 * 136;
        LAS bf16* KN = RK + 3 * 136;
        LAS bf16* KTl = RV + 64 * 136;
        LAS bf16* VTl = KTl + 128 * 72;
        const float* cw = args.in[13]; const float* cbias = args.in[14];
        for (int un = blockIdx.x; un < 256; un += F.G) {
            const int bh = un >> 4, seg = un & 15, b = bh >> 2, hd = bh & 3, t0 = seg * 512; const size_t row0 = (size_t)b * SEQ + t0;
            float Fl, Aval;
            {
                const float ipre = gates[(row0 + F.tid) * 8 + hd], fpre = gates[(row0 + F.tid) * 8 + 4 + hd];
                const float lf = fminf(fpre, 0.f) - log1pf(__expf(-fabsf(fpre)));
                float sc = lf;
#pragma unroll
                for (int o = 1; o < 64; o <<= 1) { const float tv = __shfl_up(sc, o); if (F.lane >= o) sc += tv; }
                if (F.lane == 63) red[F.wave] = sc;
                __syncthreads();
                float base = 0.f;
                for (int w2 = 0; w2 < F.wave; ++w2) base += red[w2];
                Fl = sc + base; Aval = ipre - Fl;
                float mx = Aval;
#pragma unroll
                for (int o = 1; o < 64; o <<= 1) mx = fmaxf(mx, __shfl_xor(mx, o));
                if (F.lane == 0) red[8 + F.wave] = mx;
                __syncthreads();
                float Amax = red[8];
                for (int w2 = 1; w2 < 8; ++w2) Amax = fmaxf(Amax, red[8 + w2]);
                wsl[F.tid] = __expf(Aval - Amax);
                FLOC[(size_t)bh * SEQ + t0 + F.tid] = Fl;
                if (F.tid == 511) { SEGS[un * 4 + 0] = Fl; SEGS[un * 4 + 1] = Amax; }
            }
            f32x16 dacc[2];
#pragma unroll
            for (int i = 0; i < 2; ++i)
#pragma unroll
                for (int q = 0; q < 16; ++q) dacc[i][q] = 0.f;
            const int cp = F.tid & 127, isk = cp >> 6, c2 = (cp & 63) * 2, tqr = F.tid >> 7;
            const int gch = isk * 512 + hd * 128 + c2;
            const float cw0a = cw[gch], cw1a = cw[1024 + gch], cw2a = cw[2048 + gch], cw3a = cw[3072 + gch], cba = cbias[gch];
            const float cw0b = cw[gch + 1], cw1b = cw[1024 + gch + 1], cw2b = cw[2048 + gch + 1], cw3b = cw[3072 + gch + 1], cbb = cbias[gch + 1];
            float dnacc0 = 0.f, dnacc1 = 0.f;
            u32x4 rt[7];
#define ML_RAW_LOAD(tsv) do { _Pragma("unroll") for (int ii = 0; ii < 7; ++ii) { const int ch = F.tid + NTHR * ii; u32x4 v = (u32x4){0u, 0u, 0u, 0u}; \
                if (ch < 2 * 67 * 16) { const int which = ch / (67 * 16), r = (ch % (67 * 16)) >> 4, c16 = ch & 15; const int tk = (tsv) - 3 + r; \
                    if (tk >= 0) v = *(const u32x4*)(PROJ + ((size_t)b * SEQ + tk) * NPROJ + (which ? O_K : O_Q) + hd * 128 + c16 * 8); } \
                else if (ch < 2 * 67 * 16 + 64 * 16) { const int c2 = ch - 2 * 67 * 16, r = c2 >> 4, c16 = c2 & 15; v = *(const u32x4*)(PROJ + ((size_t)b * SEQ + (tsv) + r) * NPROJ + O_V + hd * 128 + c16 * 8); } \
                rt[ii] = v; } } while (0)
            ML_RAW_LOAD(t0);
            for (int sb = 0; sb < 8; ++sb) {
                const int ts = t0 + sb * 64;
                __syncthreads();
#pragma unroll
                for (int ii = 0; ii < 7; ++ii) { const int ch = F.tid + NTHR * ii;
                    if (ch < 2 * 67 * 16) { const int which = ch / (67 * 16), r = (ch % (67 * 16)) >> 4, c16 = ch & 15; *(LAS u32x4*)((which ? RK : RQ) + r * 136 + c16 * 8) = rt[ii]; }
                    else if (ch < 2 * 67 * 16 + 64 * 16) { const int c2 = ch - 2 * 67 * 16, r = c2 >> 4, c16 = c2 & 15; *(LAS u32x4*)(RV + r * 136 + c16 * 8) = rt[ii]; } }
                if (sb < 7) ML_RAW_LOAD(ts + 64);
                __syncthreads();
                {
                    LAS unsigned* raw = (LAS unsigned*)(isk ? RK : RQ) + c2 / 2; const int s0 = tqr * 16;
                    const unsigned h0 = raw[(s0 + 0) * 68], h1 = raw[(s0 + 1) * 68], h2 = raw[(s0 + 2) * 68];
                    float x3a = lo_bf(h0), x3b = hi_bf(h0), x2a = lo_bf(h1), x2b = hi_bf(h1), x1a = lo_bf(h2), x1b = hi_bf(h2);
                    __syncthreads();
#pragma unroll 4
                    for (int sidx = s0; sidx < s0 + 16; ++sidx) {
                        const unsigned xw = raw[(sidx + 3) * 68]; const float xa = lo_bf(xw), xb = hi_bf(xw);
                        float va = cba + cw0a * x3a + cw1a * x2a + cw2a * x1a + cw3a * xa, vb = cbb + cw0b * x3b + cw1b * x2b + cw2b * x1b + cw3b * xb;
                        x3a = x2a; x2a = x1a; x1a = xa; x3b = x2b; x2b = x1b; x1b = xb;
                        va *= sigmoidf_(va); vb *= sigmoidf_(vb);
                        if (isk) { const float wk = 0.08838834764831845f * wsl[sb * 64 + sidx]; va *= wk; vb *= wk; dnacc0 += va; dnacc1 += vb; }
                        raw[(sidx + 3) * 68] = cvt_pk_bf16(va, vb);
                    }
                }
                __syncthreads();
#pragma unroll
                for (int ii = 0; ii < 2; ++ii) { const int ch = F.tid + NTHR * ii, r = ch >> 4, c16 = ch & 15;
                    *(u32x4*)(QH + ((size_t)bh * SEQ + ts + r) * 128 + c16 * 8) = *(const LAS u32x4*)(RQ + (r + 3) * 136 + c16 * 8);
                    *(u32x4*)(KH + ((size_t)bh * SEQ + ts + r) * 128 + c16 * 8) = *(const LAS u32x4*)(RK + (r + 3) * 136 + c16 * 8); }
                {
                    const int c = F.tid & 127, sq = F.tid >> 7;
#pragma unroll
                    for (int half = 0; half < 2; ++half) { const int sA = sq * 16 + half * 8;
                        u32x4 kk, vv;
                        kk.x = (unsigned)KN[(sA + 0) * 136 + c] | ((unsigned)KN[(sA + 1) * 136 + c] << 16); kk.y = (unsigned)KN[(sA + 2) * 136 + c] | ((unsigned)KN[(sA + 3) * 136 + c] << 16);
                        kk.z = (unsigned)KN[(sA + 4) * 136 + c] | ((unsigned)KN[(sA + 5) * 136 + c] << 16); kk.w = (unsigned)KN[(sA + 6) * 136 + c] | ((unsigned)KN[(sA + 7) * 136 + c] << 16);
                        vv.x = (unsigned)RV[(sA + 0) * 136 + c] | ((unsigned)RV[(sA + 1) * 136 + c] << 16); vv.y = (unsigned)RV[(sA + 2) * 136 + c] | ((unsigned)RV[(sA + 3) * 136 + c] << 16);
                        vv.z = (unsigned)RV[(sA + 4) * 136 + c] | ((unsigned)RV[(sA + 5) * 136 + c] << 16); vv.w = (unsigned)RV[(sA + 6) * 136 + c] | ((unsigned)RV[(sA + 7) * 136 + c] << 16);
                        *(LAS u32x4*)(KTl + c * 72 + sA) = kk; *(LAS u32x4*)(VTl + c * 72 + sA) = vv; }
                }
                __syncthreads();
                {
                    const int e = F.tid >> 2, part = F.tid & 3;
                    const u32x4 v0 = *(const LAS u32x4*)(VTl + e * 72 + part * 16), v1 = *(const LAS u32x4*)(VTl + e * 72 + part * 16 + 8);
                    bf16* dst = VT + ((size_t)bh * 128 + e) * SEQ + ts + part * 16;
                    *(u32x4*)dst = v0; *(u32x4*)(dst + 8) = v1;
                    const int eb = F.wave >> 1, db0 = (F.wave & 1) * 2, r = F.lane & 31, hh = F.lane >> 5;
#pragma unroll
                    for (int ks = 0; ks < 4; ++ks) {
                        const bf16x8 a = *(const LAS bf16x8*)(VTl + (eb * 32 + r) * 72 + ks * 16 + hh * 8);
                        const bf16x8 b0 = *(const LAS bf16x8*)(KTl + (db0 * 32 + r) * 72 + ks * 16 + hh * 8), b1 = *(const LAS bf16x8*)(KTl + ((db0 + 1) * 32 + r) * 72 + ks * 16 + hh * 8);
                        dacc[0] = __builtin_amdgcn_mfma_f32_32x32x16_bf16(a, b0, dacc[0], 0, 0, 0);
                        dacc[1] = __builtin_amdgcn_mfma_f32_32x32x16_bf16(a, b1, dacc[1], 0, 0, 0);
                    }
                }
            }
#undef ML_RAW_LOAD
            if (isk) { dnl[tqr * 128 + c2] = dnacc0; dnl[tqr * 128 + c2 + 1] = dnacc1; }
            {
                const int eb = F.wave >> 1, db0 = (F.wave & 1) * 2, r = F.lane & 31, hh = F.lane >> 5;
#pragma unroll
                for (int i = 0; i < 2; ++i)
#pragma unroll
                    for (int q = 0; q < 16; ++q) DC[((size_t)un * 128 + eb * 32 + (q & 3) + 8 * (q >> 2) + 4 * hh) * 128 + (db0 + i) * 32 + r] = dacc[i][q];
            }
            __syncthreads();
            if (F.tid < 128) DN[un * 128 + F.tid] = (dnl[F.tid] + dnl[128 + F.tid]) + (dnl[256 + F.tid] + dnl[384 + F.tid]);
            __syncthreads();
        }
        if (BOTH(3)) GRID_BAR();
    }
    if (IN(4)) {
        { int tq_ = threadIdx.x; asm volatile("" : "+v"(tq_)); F.tid = tq_; F.lane = tq_ & 63; }
        LAS float* agr = (LAS float*)F.lds; LAS float* agi = agr + 512;
        for (int un = blockIdx.x; un < 128; un += F.G) {
            const int b = un >> 5, g = un & 31, n = F.tid & 63, seg = F.tid >> 6;
            const float dt = __expf(args.in[3][g]);
            const float are = fminf(args.in[4][g * 64 + n], -1e-4f), aim = args.in[5][g * 64 + n];
            float ar, ai, Ar, Ai;
            { const float mag = __expf((float)S5L * dt * are); float sn, cs; fcis((float)S5L * dt * aim, &sn, &cs); ar = mag * cs; ai = mag * sn; }
            { const float mag = __expf((float)(S5L * 32) * dt * are); float sn, cs; fcis((float)(S5L * 32) * dt * aim, &sn, &cs); Ar = mag * cs; Ai = mag * sn; }
            const size_t row0 = (size_t)g * S5ROWS + b * S5NCH + seg * 32;
            float xr[32], xi[32];
#pragma unroll
            for (int jj = 0; jj < 32; ++jj) { xr[jj] = XLOC[(row0 + jj) * 128 + n]; xi[jj] = XLOC[(row0 + jj) * 128 + 64 + n]; }
            float sr = 0.f, si = 0.f;
#pragma unroll
            for (int jj = 0; jj < 32; ++jj) { const float tr = ar * sr - ai * si + xr[jj], ti = ar * si + ai * sr + xi[jj]; sr = tr; si = ti; }
            agr[seg * 64 + n] = sr; agi[seg * 64 + n] = si;
            __syncthreads();
            float cr = 0.f, ci = 0.f;
            for (int s2 = 0; s2 < seg; ++s2) { const float tr = Ar * cr - Ai * ci + agr[s2 * 64 + n], ti = Ar * ci + Ai * cr + agi[s2 * 64 + n]; cr = tr; ci = ti; }
#pragma unroll
            for (int jj = 0; jj < 32; ++jj) {
                S5A[(row0 + jj) * S5K + S5KIN + n] = f2bf(cr); S5A[(row0 + jj) * S5K + S5KIN + 64 + n] = f2bf(ci);
                const float tr = ar * cr - ai * ci + xr[jj], ti = ar * ci + ai * cr + xi[jj]; cr = tr; ci = ti; }
            __syncthreads();
        }
        for (int un = blockIdx.x; un < 256; un += F.G) {
            const int bh = un >> 4, slice = un & 15;
            float dc0[16], dc1[16];
#pragma unroll
            for (int j = 0; j < 16; ++j) { dc0[j] = DC[((size_t)(bh * 16 + j)) * 16384 + slice * 1024 + F.tid]; dc1[j] = DC[((size_t)(bh * 16 + j)) * 16384 + slice * 1024 + 512 + F.tid]; }
            float dn[16];
            const bool nrole = (slice == 0 && F.tid < 128);
#pragma unroll
            for (int j = 0; j < 16; ++j) dn[j] = nrole ? DN[(bh * 16 + j) * 128 + F.tid] : 0.f;
            float m = 0.f, C0 = 0.f, C1 = 0.f, nn = 0.f;
#pragma unroll
            for (int j = 0; j < 16; ++j) {
                const float Fend = SEGS[(bh * 16 + j) * 4 + 0], Amax = SEGS[(bh * 16 + j) * 4 + 1];
                const float R = fmaxf(m, Amax), c1 = __expf(m - R), c2 = __expf(Amax - R);
                CST[((size_t)(bh * 16 + j)) * 16384 + slice * 1024 + F.tid] = f2bf(c1 * C0); CST[((size_t)(bh * 16 + j)) * 16384 + slice * 1024 + 512 + F.tid] = f2bf(c1 * C1);
                if (nrole) NST[(bh * 16 + j) * 128 + F.tid] = c1 * nn;
                if (slice == 0 && F.tid == 0) { SEGS[(bh * 16 + j) * 4 + 2] = R; SEGS[(bh * 16 + j) * 4 + 3] = c2; }
                C0 = c1 * C0 + c2 * dc0[j]; C1 = c1 * C1 + c2 * dc1[j]; nn = c1 * nn + c2 * dn[j]; m = Fend + R;
            }
        }
        if (BOTH(4)) GRID_BAR();
    }
    if (IN(5)) {
        { int tq_ = threadIdx.x; asm volatile("" : "+v"(tq_)); F.tid = tq_; F.lane = tq_ & 63; }
        pg::S5Sched S{(const char*)S5A, (const char*)S5BT, S5K * 2, S5K * 2, S5KIN, 2, F.G, F.vcu};
        pg::EpiS5Y E{S5A, args.in[10], GY};
        pg::gemm_phase<pg::EpiS5Y, pg::S5Sched, true>(F.lds, S5K, S, E);
        if (BOTH(5)) GRID_BAR();
    }
    if (IN(6)) {
        { int tq_ = threadIdx.x; asm volatile("" : "+v"(tq_)); F.tid = tq_; F.lane = tq_ & 63; }
        typedef short s16x4 __attribute__((ext_vector_type(4)));
        LAS bf16* Kl = (LAS bf16*)F.lds;
        LAS bf16* Vl = Kl + 2 * 64 * 136;
        LAS bf16* Cl = Vl + 2 * 128 * 72;
        LAS float* nl = (LAS float*)(Cl + 128 * 136);
        LAS float* fll = nl + 128;
        LAS float* gl = fll + 512;
        const float* ng = args.in[16];
        for (int un = blockIdx.x; un < 256; un += F.G) {
            int tid6 = F.tid; asm volatile("" : "+v"(tid6));
            const int lane6 = tid6 & 63;
            const int bh = un >> 4, seg = un & 15, b = bh >> 2, hd = bh & 3, t0 = seg * 512;
            const float R = SEGS[un * 4 + 2], c2 = SEGS[un * 4 + 3];
            __syncthreads();
            for (int ch = tid6; ch < 2048; ch += NTHR) { const int r = ch >> 4, c16 = ch & 15; *(LAS u32x4*)(Cl + r * 136 + c16 * 8) = *(const u32x4*)(CST + (size_t)un * 16384 + r * 128 + c16 * 8); }
            if (tid6 < 128) { nl[tid6] = NST[un * 128 + tid6]; gl[tid6] = ng[hd * 128 + tid6]; }
            fll[tid6] = FLOC[(size_t)bh * SEQ + t0 + tid6];
            const int r = lane6 & 31, hh = lane6 >> 5;
            for (int pass = 0; pass < 2; ++pass) {
                const int qb = pass == 0 ? F.wave : 15 - F.wave, jmax = qb >> 1, npj = pass == 0 ? 4 : 8;
                bf16x8 Q[8];
                { const bf16* qp = QH + ((size_t)bh * SEQ + t0 + qb * 32 + r) * 128 + hh * 8;
#pragma unroll
                  for (int ks = 0; ks < 8; ++ks) Q[ks] = *(const bf16x8*)(qp + ks * 16); }
                u32x4 pk0, pk1, pv0, pv1;
                { const int kr = tid6 >> 4, kc = tid6 & 15; const bf16* kp = KH + ((size_t)bh * SEQ + t0) * 128; pk0 = *(const u32x4*)(kp + kr * 128 + kc * 8); pk1 = *(const u32x4*)(kp + (kr + 32) * 128 + kc * 8);
                  const int vr = tid6 >> 3, vc = tid6 & 7; const bf16* vp = VT + (size_t)bh * 128 * SEQ + t0; pv0 = *(const u32x4*)(vp + (size_t)vr * SEQ + vc * 8); pv1 = *(const u32x4*)(vp + (size_t)(vr + 64) * SEQ + vc * 8); }
                f32x16 acc[4];
#pragma unroll
                for (int eb = 0; eb < 4; ++eb)
#pragma unroll
                    for (int q = 0; q < 16; ++q) acc[eb][q] = 0.f;
                __syncthreads();
#pragma unroll
                for (int eb = 0; eb < 4; ++eb) {
#pragma unroll
                    for (int ks = 0; ks < 8; ++ks) { const bf16x8 a = *(const LAS bf16x8*)(Cl + (eb * 32 + r) * 136 + ks * 16 + hh * 8); acc[eb] = __builtin_amdgcn_mfma_f32_32x32x16_bf16(a, Q[ks], acc[eb], 0, 0, 0); }
                    __builtin_amdgcn_sched_barrier(0);
                }
                float den = 0.f;
#pragma unroll
                for (int ks = 0; ks < 8; ++ks) {
#pragma unroll
                    for (int jj = 0; jj < 8; ++jj) den += nl[ks * 16 + hh * 8 + jj] * bf2f((bf16)Q[ks][jj]);
                    __builtin_amdgcn_sched_barrier(0);
                }
                float dsum = 0.f;
                for (int j = 0; j < npj; ++j) {
                    LAS bf16* Kb = Kl + (j & 1) * 64 * 136; LAS bf16* Vb = Vl + (j & 1) * 128 * 72;
                    { const int kr = tid6 >> 4, kc = tid6 & 15; *(LAS u32x4*)(Kb + kr * 136 + kc * 8) = pk0; *(LAS u32x4*)(Kb + (kr + 32) * 136 + kc * 8) = pk1;
                      const int vr = tid6 >> 3, vc = tid6 & 7; *(LAS u32x4*)(Vb + vr * 72 + vc * 8) = pv0; *(LAS u32x4*)(Vb + (vr + 64) * 72 + vc * 8) = pv1; }
                    if (j + 1 < npj) { const int kr = tid6 >> 4, kc = tid6 & 15; const bf16* kp = KH + ((size_t)bh * SEQ + t0 + (j + 1) * 64) * 128; pk0 = *(const u32x4*)(kp + kr * 128 + kc * 8); pk1 = *(const u32x4*)(kp + (kr + 32) * 128 + kc * 8);
                        const int vr = tid6 >> 3, vc = tid6 & 7; const bf16* vp = VT + (size_t)bh * 128 * SEQ + t0 + (j + 1) * 64; pv0 = *(const u32x4*)(vp + (size_t)vr * SEQ + vc * 8); pv1 = *(const u32x4*)(vp + (size_t)(vr + 64) * SEQ + vc * 8); }
                    __syncthreads();
                    if (j <= jmax) {
                        const bool diag = (j == jmax); const int tq = qb * 32 + r;
#pragma unroll
                        for (int sb = 0; sb < 2; ++sb) {
                            f32x16 st;
#pragma unroll
                            for (int q = 0; q < 16; ++q) st[q] = 0.f;
#pragma unroll
                            for (int ks = 0; ks < 8; ++ks) { const bf16x8 a = *(const LAS bf16x8*)(Kb + (sb * 32 + r) * 136 + ks * 16 + hh * 8); st = __builtin_amdgcn_mfma_f32_32x32x16_bf16(a, Q[ks], st, 0, 0, 0); }
                            bf16x8 pb[2];
#pragma unroll
                            for (int sp = 0; sp < 2; ++sp) {
                                float pv[8];
#pragma unroll
                                for (int jj = 0; jj < 8; ++jj) { const int q = 8 * sp + jj; const int sidx = j * 64 + sb * 32 + (q & 3) + 8 * (q >> 2) + 4 * hh;
                                    float p = st[q] * c2; if (diag && sidx > tq) p = 0.f; pv[jj] = p; dsum += p; }
                                u32x4 w; w.x = cvt_pk_bf16(pv[0], pv[1]); w.y = cvt_pk_bf16(pv[2], pv[3]); w.z = cvt_pk_bf16(pv[4], pv[5]); w.w = cvt_pk_bf16(pv[6], pv[7]);
                                pb[sp] = __builtin_bit_cast(bf16x8, w);
                            }
#pragma unroll
                            for (int eb = 0; eb < 4; ++eb)
#pragma unroll
                                for (int sp = 0; sp < 2; ++sp) {
                                    const int so = sb * 32 + 16 * sp + 4 * hh;
                                    const s16x4 lo = *(const LAS s16x4*)(Vb + (eb * 32 + r) * 72 + so), hi = *(const LAS s16x4*)(Vb + (eb * 32 + r) * 72 + so + 8);
                                    const bf16x8 a = __builtin_shufflevector(lo, hi, 0, 1, 2, 3, 4, 5, 6, 7);
                                    acc[eb] = __builtin_amdgcn_mfma_f32_32x32x16_bf16(a, pb[sp], acc[eb], 0, 0, 0);
                                }
                            __builtin_amdgcn_sched_barrier(0);
                        }
                    }
                }
                den += dsum; den += __shfl_xor(den, 32);
                const float flo = __expf(-fll[qb * 32 + r] - R);
                const float inv = 1.f / fmaxf(fabsf(den), flo);
                float s1 = 0.f;
#pragma unroll
                for (int eb = 0; eb < 4; ++eb)
#pragma unroll
                    for (int q = 0; q < 16; ++q) { acc[eb][q] *= inv; s1 += acc[eb][q]; }
                s1 += __shfl_xor(s1, 32);
                const float mu = s1 * (1.f / 128.f);
                float s2 = 0.f;
#pragma unroll
                for (int eb = 0; eb < 4; ++eb)
#pragma unroll
                    for (int q = 0; q < 16; ++q) { const float dlt = acc[eb][q] - mu; s2 += dlt * dlt; }
                s2 += __shfl_xor(s2, 32);
                const float rstd = rsqrtf(s2 * (1.f / 128.f) + 1e-6f);
                const size_t row = (size_t)b * SEQ + t0 + qb * 32 + r;
                uint2 ovv[16];
#pragma unroll
                for (int eb = 0; eb < 4; ++eb)
#pragma unroll
                    for (int g4 = 0; g4 < 4; ++g4) ovv[eb * 4 + g4] = *(const uint2*)(PROJ + row * NPROJ + O_O + hd * 128 + eb * 32 + 8 * g4 + 4 * hh);
#pragma unroll
                for (int eb = 0; eb < 4; ++eb)
#pragma unroll
                    for (int g4 = 0; g4 < 4; ++g4) {
                        const int e0 = eb * 32 + 8 * g4 + 4 * hh;
                        const uint2 ov = ovv[eb * 4 + g4];
                        const f32x4 gg = *(const LAS f32x4*)(gl + e0);
                        const float o0 = (acc[eb][4 * g4 + 0] - mu) * rstd * gg.x * sigmoidf_(lo_bf(ov.x)), o1 = (acc[eb][4 * g4 + 1] - mu) * rstd * gg.y * sigmoidf_(hi_bf(ov.x));
                        const float o2 = (acc[eb][4 * g4 + 2] - mu) * rstd * gg.z * sigmoidf_(lo_bf(ov.y)), o3 = (acc[eb][4 * g4 + 3] - mu) * rstd * gg.w * sigmoidf_(hi_bf(ov.y));
                        uint2 w; w.x = cvt_pk_bf16(o0, o1); w.y = cvt_pk_bf16(o2, o3);
                        *(uint2*)(MIX + row * D + 512 + hd * 128 + e0) = w;
                    }
            }
        }
    }
    if (IN(7)) {
        { int tq_ = threadIdx.x; asm volatile("" : "+v"(tq_)); F.tid = tq_; F.lane = tq_ & 63; }
        pg::DenseSched S{(const char*)GY, (const char*)WGLU, 512 * 2, 512 * 2, T / 256, 2, F.G, (int)blockIdx.x};
        pg::EpiGlu E{GY, args.in[12], MIX};
        pg::gemm_phase<pg::EpiGlu, pg::DenseSched, true>(F.lds, 512, S, E);
        if (BOTH(7)) GRID_BAR();
    }
    if (IN(8)) {
        { int tq_ = threadIdx.x; asm volatile("" : "+v"(tq_)); F.tid = tq_; F.lane = tq_ & 63; }
        pg::DenseSched S{(const char*)MIX, (const char*)WOUT, D * 2, D * 2, T / 256, D / 256, F.G, (int)blockIdx.x};
        pg::EpiOut E{x, H};
        pg::gemm_phase<pg::EpiOut, pg::DenseSched, true>(F.lds, D, S, E);
        if (BOTH(8)) GRID_BAR();
    }
    if (IN(9)) {
        { int tq_ = threadIdx.x; asm volatile("" : "+v"(tq_)); F.tid = tq_; F.lane = tq_ & 63; }
        const float* gf = args.in[18]; const float* w_r = args.in[19]; const float* b_r = args.in[20];
        LAS float* rs = (LAS float*)(F.lds);
        LAS float* part = (LAS float*)(F.lds + 1024);
        LAS int* hist = (LAS int*)(F.lds + 1024 + 2 * 128 * 33 * 4);
        for (int tb = blockIdx.x; tb < T / 128; tb += F.G) {
            const int row0 = tb * 128;
            if (F.tid < 32) hist[F.tid] = 0;
            {
                f32x4 gg[4];
#pragma unroll
                for (int jq = 0; jq < 4; ++jq) gg[jq] = *(const f32x4*)(gf + 4 * F.lane + 256 * jq);
                f32x4 nx[4];
#pragma unroll
                for (int jq = 0; jq < 4; ++jq) nx[jq] = ldbf4(H + (size_t)(row0 + F.wave * 16) * D + 4 * F.lane + 256 * jq);
                for (int rr = 0; rr < 16; ++rr) {
                    const int r = F.wave * 16 + rr;
                    f32x4 v[4];
#pragma unroll
                    for (int jq = 0; jq < 4; ++jq) v[jq] = nx[jq];
                    if (rr < 15) {
#pragma unroll
                        for (int jq = 0; jq < 4; ++jq) nx[jq] = ldbf4(H + (size_t)(row0 + r + 1) * D + 4 * F.lane + 256 * jq); }
                    float ss = 0.f;
#pragma unroll
                    for (int jq = 0; jq < 4; ++jq) ss += v[jq].x * v[jq].x + v[jq].y * v[jq].y + v[jq].z * v[jq].z + v[jq].w * v[jq].w;
                    ss = wave_sum(ss);
                    const float rstd = rsqrtf(ss * (1.f / D) + 1e-5f);
                    if (F.lane == 0) rs[r] = rstd;
#pragma unroll
                    for (int jq = 0; jq < 4; ++jq) *(unsigned*)(HN8 + (size_t)(row0 + r) * D + 4 * F.lane + 256 * jq) = pk4_fp8(v[jq].x * rstd * gg[jq].x, v[jq].y * rstd * gg[jq].y, v[jq].z * rstd * gg[jq].z, v[jq].w * rstd * gg[jq].w);
                }
            }
            {
                const int rg = F.wave & 3, kh = F.wave >> 2, i = F.lane & 31, hh = F.lane >> 5;
                f32x16 acc;
#pragma unroll
                for (int q = 0; q < 16; ++q) acc[q] = 0.f;
                const bf16* hp = H + (size_t)(row0 + rg * 32 + i) * D + kh * 512 + 4 * hh;
                const float* wp = w_r + (size_t)(kh * 512 + 4 * hh) * NE + i; const float* gp = gf + kh * 512 + 4 * hh;
                f32x4 a0[4], g0[4], a1[4], g1[4]; f32x4 w0[4], w1[4];
#pragma unroll
                for (int u = 0; u < 4; ++u) { a0[u] = ldbf4(hp + 8 * u); g0[u] = *(const f32x4*)(gp + 8 * u);
                    w0[u] = (f32x4){wp[(size_t)(8 * u + 0) * NE], wp[(size_t)(8 * u + 1) * NE], wp[(size_t)(8 * u + 2) * NE], wp[(size_t)(8 * u + 3) * NE]}; }
                for (int k0 = 0; k0 < 512; k0 += 64) {
#pragma unroll
                    for (int u = 0; u < 4; ++u) { const int kk = k0 + 32 + 8 * u; a1[u] = ldbf4(hp + kk); g1[u] = *(const f32x4*)(gp + kk);
                        w1[u] = (f32x4){wp[(size_t)(kk + 0) * NE], wp[(size_t)(kk + 1) * NE], wp[(size_t)(kk + 2) * NE], wp[(size_t)(kk + 3) * NE]}; }
#pragma unroll
                    for (int u = 0; u < 4; ++u) { const f32x4 bb = w0[u] * g0[u];
                        acc = __builtin_amdgcn_mfma_f32_32x32x2f32(a0[u].x, bb.x, acc, 0, 0, 0); acc = __builtin_amdgcn_mfma_f32_32x32x2f32(a0[u].y, bb.y, acc, 0, 0, 0);
                        acc = __builtin_amdgcn_mfma_f32_32x32x2f32(a0[u].z, bb.z, acc, 0, 0, 0); acc = __builtin_amdgcn_mfma_f32_32x32x2f32(a0[u].w, bb.w, acc, 0, 0, 0); }
                    if (k0 + 64 < 512) {
#pragma unroll
                        for (int u = 0; u < 4; ++u) { const int kk = k0 + 64 + 8 * u; a0[u] = ldbf4(hp + kk); g0[u] = *(const f32x4*)(gp + kk);
                            w0[u] = (f32x4){wp[(size_t)(kk + 0) * NE], wp[(size_t)(kk + 1) * NE], wp[(size_t)(kk + 2) * NE], wp[(size_t)(kk + 3) * NE]}; } }
#pragma unroll
                    for (int u = 0; u < 4; ++u) { const f32x4 bb = w1[u] * g1[u];
                        acc = __builtin_amdgcn_mfma_f32_32x32x2f32(a1[u].x, bb.x, acc, 0, 0, 0); acc = __builtin_amdgcn_mfma_f32_32x32x2f32(a1[u].y, bb.y, acc, 0, 0, 0);
                        acc = __builtin_amdgcn_mfma_f32_32x32x2f32(a1[u].z, bb.z, acc, 0, 0, 0); acc = __builtin_amdgcn_mfma_f32_32x32x2f32(a1[u].w, bb.w, acc, 0, 0, 0); }
                }
#pragma unroll
                for (int q = 0; q < 16; ++q) { const int r = rg * 32 + (q & 3) + 8 * (q >> 2) + 4 * hh; part[(kh * 128 + r) * 33 + i] = acc[q]; }
            }
            __syncthreads();
            if (F.tid < 128) {
                const int r = F.tid; const float rstd = rs[r];
                float best[4]; int bi[4];
                for (int e = 0; e < 32; ++e) part[r * 33 + e] = (part[r * 33 + e] + part[(128 + r) * 33 + e]) * rstd + b_r[e];
#pragma unroll
                for (int k = 0; k < 4; ++k) {
                    float bv = -INFINITY; int be = 0;
                    for (int e = 0; e < 32; ++e) { const float l = part[r * 33 + e]; if (l > bv) { bv = l; be = e; } }
                    best[k] = bv; bi[k] = be; part[r * 33 + be] = -INFINITY;
                }
                const float e1 = __expf(best[1] - best[0]), e2 = __expf(best[2] - best[0]), e3 = __expf(best[3] - best[0]);
                const float inv = 1.f / (1.f + e1 + e2 + e3);
                *(int4*)(topi + (size_t)(row0 + r) * 4) = make_int4(bi[0], bi[1], bi[2], bi[3]);
                *(f32x4*)(topg + (size_t)(row0 + r) * 4) = (f32x4){inv, e1 * inv, e2 * inv, e3 * inv};
#pragma unroll
                for (int k = 0; k < 4; ++k) __hip_atomic_fetch_add(&hist[bi[k]], 1, __ATOMIC_RELAXED, __HIP_MEMORY_SCOPE_WORKGROUP);
            }
            __syncthreads();
            if (F.tid < 32) CNT[tb * 32 + F.tid] = hist[F.tid];
            __syncthreads();
        }
        if (BOTH(9)) GRID_BAR();
    }
    if (IN(10)) {
        { int tq_ = threadIdx.x; asm volatile("" : "+v"(tq_)); F.tid = tq_; F.lane = tq_ & 63; }
        LAS int* sb = (LAS int*)(F.lds);
        for (int tb = blockIdx.x; tb < T / 128; tb += F.G) {
            const int e = F.tid & 31, pt = F.tid >> 5;
            int sbef = 0, stot = 0;
            for (int w = pt * 16; w < pt * 16 + 16; ++w) { const int c = __hip_atomic_load(CNT + w * 32 + e, RLX_AGENT); stot += c; if (w < tb) sbef += c; }
            sb[pt * 32 + e] = sbef; sb[512 + pt * 32 + e] = stot;
            __syncthreads();
            if (F.tid < 32) { int b = 0, t = 0; for (int p = 0; p < 16; ++p) { b += sb[p * 32 + F.tid]; t += sb[512 + p * 32 + F.tid]; } sb[1024 + F.tid] = b; sb[1056 + F.tid] = t; sb[1120 + F.tid] = 0; }
            __syncthreads();
            if (F.tid == 0) { int ps = 0; for (int q = 0; q < 32; ++q) { sb[1088 + q] = ps; ps += ((sb[1056 + q] + MT - 1) / MT) * MT; } }
            __syncthreads();
            if (tb == 0 && F.tid < 32) ecnt[F.tid] = sb[1056 + F.tid];
            {
                const int a = tb * 512 + F.tid; const int ex = topi[a];
                const int lp = __hip_atomic_fetch_add(&sb[1120 + ex], 1, __ATOMIC_RELAXED, __HIP_MEMORY_SCOPE_WORKGROUP);
                const int slot = sb[1088 + ex] + sb[1024 + ex] + lp;
                slot_tok[slot] = a >> 2; tok_slot[a] = slot;
            }
            __syncthreads();
        }
        if (BOTH(10)) GRID_BAR();
    }
    if (IN(11) || IN(12)) {
        { int tq_ = threadIdx.x; asm volatile("" : "+v"(tq_)); F.tid = tq_; F.lane = tq_ & 63; }
        LAS int* til = (LAS int*)(F.lds + TIL_OFF);
        if (F.tid == 0) { int nt = 0; for (int e = 0; e < NE; ++e) { const int c = __hip_atomic_load(ecnt + e, RLX_AGENT); for (int r = 0; r < c; r += MT) { til[nt] = e; til[MAXTILES + nt] = (c - r) < MT ? (c - r) : MT; ++nt; } } til[2 * MAXTILES] = nt; }
        __syncthreads();
        if (IN(11)) {
            MoeSched S{(const char*)HN8, (const char*)WUP8, slot_tok, args.in[22], til, (LAS int*)(F.lds + IDX_OFF), (LAS float*)(F.lds + BIAS_OFF), D, D, 8, 2 * FF, F.G, (int)blockIdx.x, 1};
            pg::EpiUp E{(const LAS float*)(F.lds + BIAS_OFF), ACT8};
            pg::gemm_phase<pg::EpiUp, MoeSched, true, true>(F.lds, D, S, E);
            if (BOTH(11)) GRID_BAR();
        }
        if (IN(12)) {
            MoeSched S{(const char*)ACT8, (const char*)WDN8, slot_tok, args.in[24], til, (LAS int*)(F.lds + IDX_OFF), (LAS float*)(F.lds + BIAS_OFF), FF, FF, 4, D, F.G, (int)blockIdx.x, 0};
            pg::EpiDown E{(const LAS float*)(F.lds + BIAS_OFF), YS};
            pg::gemm_phase<pg::EpiDown, MoeSched, true, true>(F.lds, FF, S, E);
            if (BOTH(12)) GRID_BAR();
        }
    }
    if (IN(13)) {
        { int tq_ = threadIdx.x; asm volatile("" : "+v"(tq_)); F.tid = tq_; F.lane = tq_ & 63; }
        const float* gfin = args.in[25]; float* out = args.out;
        for (int row = gw; row < T; row += NGW) {
            f32x4 v[4];
#pragma unroll
            for (int j = 0; j < 4; ++j) v[j] = ldbf4(H + (size_t)row * D + 4 * F.lane + 256 * j);
            const int4 sl = *(const int4*)(tok_slot + (size_t)row * 4); const f32x4 gt = *(const f32x4*)(topg + (size_t)row * 4);
#pragma unroll
            for (int k = 0; k < 4; ++k) {
                const int s = k == 0 ? sl.x : k == 1 ? sl.y : k == 2 ? sl.z : sl.w;
#pragma unroll
                for (int j = 0; j < 4; ++j) { const unsigned y = *(const unsigned*)(YS + (size_t)s * D + 4 * F.lane + 256 * j);
                    typedef float f32x2_ __attribute__((ext_vector_type(2)));
                    const f32x2_ ylo = __builtin_amdgcn_cvt_pk_f32_fp8(y, false), yhi = __builtin_amdgcn_cvt_pk_f32_fp8(y, true);
                    v[j].x += gt[k] * ylo.x; v[j].y += gt[k] * ylo.y; v[j].z += gt[k] * yhi.x; v[j].w += gt[k] * yhi.y; }
            }
            float ss = 0.f;
#pragma unroll
            for (int j = 0; j < 4; ++j) ss += v[j].x * v[j].x + v[j].y * v[j].y + v[j].z * v[j].z + v[j].w * v[j].w;
            ss = wave_sum(ss);
            const float rstd = rsqrtf(ss * (1.f / D) + 1e-5f);
#pragma unroll
            for (int j = 0; j < 4; ++j) { const f32x4 gg = *(const f32x4*)(gfin + 4 * F.lane + 256 * j); __builtin_nontemporal_store(v[j] * rstd * gg, (f32x4*)(out + (size_t)row * D + 4 * F.lane + 256 * j)); }
        }
    }
#undef IN
#undef BOTH
}

extern "C" void kernel_launch(void* const* d_in, const int* in_sizes, int n_in, void* d_out, int out_size, void* d_ws, size_t ws_size, hipStream_t stream) {
    static int grid = 0;
    if (grid == 0) {
        int dev = 0, cus = 0, per_cu = 0;
        if (n_in != 26 || ws_size < WS_END) { fprintf(stderr, "kernel_launch: unexpected n_in %d / ws %zu\n", n_in, ws_size); grid = -1; return; }
        if (hipGetDevice(&dev) != hipSuccess || hipDeviceGetAttribute(&cus, hipDeviceAttributeMultiprocessorCount, dev) != hipSuccess) { grid = -1; return; }
        if (hipFuncSetAttribute((const void*)fwd, hipFuncAttributeMaxDynamicSharedMemorySize, LDS_BYTES) != hipSuccess) { fprintf(stderr, "kernel_launch: hipFuncSetAttribute failed\n"); grid = -1; return; }
        if (hipOccupancyMaxActiveBlocksPerMultiprocessor(&per_cu, (const void*)fwd, NTHR, LDS_BYTES) != hipSuccess || per_cu < 1) fprintf(stderr, "kernel_launch: occupancy query reports %d\n", per_cu);
        (void)hipGetLastError();
        grid = cus;
    }
    if (grid < 0) return;
    (void)in_sizes; (void)out_size;
    unsigned char* ws = (unsigned char*)d_ws;
    (void)hipMemsetAsync(ws + WS_CTL, 0, CTL_ZERO_BYTES, stream);
    Args a{};
    for (int i = 0; i < 26; ++i) a.in[i] = (const float*)d_in[i];
    a.out = (float*)d_out; a.ws = ws;
    a.ph_lo = 0; a.ph_hi = 14; a.li = 0; a.pad = 0;
    hipLaunchKernelGGL(fwd, dim3(grid), dim3(NTHR), LDS_BYTES, stream, a);
#if PROBE_LO >= 0
    a.ph_lo = PROBE_LO; a.ph_hi = PROBE_HI; a.li = 1; a.pad = PROBE_PAD;
    hipLaunchKernelGGL(fwd, dim3(grid), dim3(NTHR), LDS_BYTES, stream, a);
#endif
}
```

```cpp
#include <hip/hip_runtime.h>
#include <cstdio>
#include <cstdint>

#define GAS __attribute__((address_space(1)))
#define LAS __attribute__((address_space(3)))
typedef unsigned short bf16;
typedef short bf16x8 __attribute__((ext_vector_type(8)));
typedef float f32x4 __attribute__((ext_vector_type(4)));
typedef float f32x16 __attribute__((ext_vector_type(16)));
typedef unsigned u32x4 __attribute__((ext_vector_type(4)));
typedef unsigned u32x2 __attribute__((ext_vector_type(2)));
typedef GAS unsigned gu32;

#define PROBE_LO -1
#define PROBE_HI -1
#define PROBE_PAD 0
constexpr int NB = 4, SEQ = 8192, T = NB * SEQ, D = 1024;
constexpr int DIN = 2568, NPROJ = 2560;
constexpr int O_Q = 512, O_K = 1024, O_V = 1536, O_O = 2048, O_G = 2560;
constexpr int NE = 32, TOPK = 4, FF = 1024;
constexpr int NASSIGN = T * TOPK;
constexpr int MT = 256;
constexpr int NSLOTS = NASSIGN + NE * MT;
constexpr int MAXTILES = NSLOTS / MT;
constexpr int NWAVES = 8, NTHR = 512;
constexpr float W8_SCALE = 64.f, W8_INV = 1.f / 64.f;

constexpr size_t MiB = 1u << 20;
constexpr size_t WS_CTL = 0, CTL_ZERO_BYTES = 1 * MiB;
constexpr size_t WS_GATES = 1 * MiB;
constexpr size_t WS_TOPI = 2 * MiB;
constexpr size_t WS_TOPG = 3 * MiB;
constexpr size_t WS_SLOTTOK = 4 * MiB;
constexpr size_t WS_TOKSLOT = 5 * MiB;
constexpr size_t WS_CNT = 6 * MiB;
constexpr size_t WS_WIN = 8 * MiB;
constexpr size_t WS_WGLU = 13 * MiB;
constexpr size_t WS_WOUT = 14 * MiB;
constexpr size_t WS_WUP = 16 * MiB;
constexpr size_t WS_WDN = 144 * MiB;
constexpr size_t WS_HN = 208 * MiB;
constexpr size_t WS_PROJ = 272 * MiB;
constexpr size_t WS_GY = 432 * MiB;
constexpr size_t WS_MIX = 464 * MiB;
constexpr size_t WS_HRAW = 528 * MiB;
constexpr size_t WS_ACT = 272 * MiB;
constexpr size_t WS_H = 592 * MiB;
constexpr size_t WS_YS = 720 * MiB;
constexpr size_t WS_END = 992 * MiB;
constexpr int S5L = 32, S5KIN = S5L * 16, S5K = S5KIN + 128;
constexpr int S5NCH = SEQ / S5L, S5ROWS = NB * S5NCH;
constexpr size_t WS_S5A = 720 * MiB;
constexpr size_t WS_S5BT = 760 * MiB;
constexpr size_t WS_S5BQ = 836 * MiB;
constexpr size_t WS_XLOC = 790 * MiB;
constexpr size_t WS_QH = 866 * MiB;
constexpr size_t WS_KH = 898 * MiB;
constexpr size_t WS_VT = 930 * MiB;
constexpr size_t WS_DC = 962 * MiB;
constexpr size_t WS_CST = 978 * MiB;
constexpr size_t WS_FLOC = 986 * MiB;
constexpr size_t WS_DN = 987 * MiB;
constexpr size_t WS_NST = 988 * MiB;
constexpr size_t WS_SEGS = 989 * MiB;
constexpr size_t WS_KTAB = 990 * MiB;
static_assert(WS_S5A + (size_t)32 * S5ROWS * S5K * 2 <= WS_S5BT && WS_S5BT + (size_t)32 * S5KIN * S5K * 2 <= WS_XLOC && WS_XLOC + (size_t)32 * S5ROWS * 128 * 4 <= WS_S5BQ && WS_S5BQ + (size_t)32 * 256 * S5KIN * 2 <= WS_QH, "s5 map");
static_assert(WS_ACT + (size_t)NSLOTS * FF * 2 <= WS_H && WS_YS + (size_t)NSLOTS * D * 2 <= WS_END, "ws map");
constexpr int CW_QHEAD = 64;
constexpr int CW_BAR = 4096;

constexpr int RING_BYTES = 131072;
constexpr int MISC_OFF = RING_BYTES;
constexpr int IDX_OFF = MISC_OFF + 128;
constexpr int TIL_OFF = IDX_OFF + 2048;
constexpr int BIAS_OFF = TIL_OFF + 3 * MAXTILES * 4 + 256;
constexpr int LDS_BYTES = 147456;
static_assert(BIAS_OFF + 3 * 1024 <= LDS_BYTES && (BIAS_OFF & 15) == 0, "LDS map");

#define RLX_AGENT __ATOMIC_RELAXED, __HIP_MEMORY_SCOPE_AGENT
__device__ __forceinline__ float bf2f(bf16 v) { return __uint_as_float(((unsigned)v) << 16); }
__device__ __forceinline__ bf16 f2bf(float f) { unsigned u = __float_as_uint(f); u += 0x7fffu + ((u >> 16) & 1u); return (bf16)(u >> 16); }
__device__ __forceinline__ unsigned pk2(float lo, float hi) { return (unsigned)f2bf(lo) | ((unsigned)f2bf(hi) << 16); }
__device__ __forceinline__ unsigned cvt_pk_bf16(float lo, float hi) { unsigned r; asm volatile("v_cvt_pk_bf16_f32 %0, %1, %2" : "=v"(r) : "v"(lo), "v"(hi)); return r; }
__device__ __forceinline__ unsigned pk4_fp8(float a, float b, float c, float d) { unsigned w = 0u; w = __builtin_amdgcn_cvt_pk_fp8_f32(a, b, w, false); w = __builtin_amdgcn_cvt_pk_fp8_f32(c, d, w, true); return w; }
__device__ __forceinline__ float lo_bf(unsigned u) { return __uint_as_float(u << 16); }
__device__ __forceinline__ float hi_bf(unsigned u) { return __uint_as_float(u & 0xffff0000u); }
__device__ __forceinline__ f32x4 ldbf4(const bf16* p) { const uint2 u = *(const uint2*)p; return (f32x4){lo_bf(u.x), hi_bf(u.x), lo_bf(u.y), hi_bf(u.y)}; }
__device__ __forceinline__ float wave_sum(float v) {
#pragma unroll
    for (int o = 1; o < 64; o <<= 1) v += __shfl_xor(v, o);
    return v;
}
__device__ __forceinline__ float sigmoidf_(float x) { return __builtin_amdgcn_rcpf(1.f + __builtin_amdgcn_exp2f(-1.4426950408889634f * x)); }
__device__ __forceinline__ void fcis(float x, float* sn, float* cs) { const float C = 0.15915494309189535f; const float rev = x * C; const float err = fmaf(x, C, -rev); const float fr = (rev - rintf(rev)) + err; *sn = __builtin_amdgcn_sinf(fr); *cs = __builtin_amdgcn_cosf(fr); }
__device__ __forceinline__ float gelu_tanh(float x) { const float u = 1.5957691216057308f * (x + 0.044715f * x * x * x); return x * __builtin_amdgcn_rcpf(1.f + __builtin_amdgcn_exp2f(-1.4426950408889634f * u)); }

#define XB_TMO      128
#define XB_XCNT(j)  (256  + 64 * (j))
#define XB_XSUB(j)  (1280 + 64 * (j))
#define XB_XGEN(j)  (2304 + 64 * (j))
#define XB_TOP      3328
#define XB_TOPGEN   3392
#define XCD_BAR_WORDS 3456
#define XB_SPIN_CAP (1u << 18)
__device__ __forceinline__ unsigned xb_ld(unsigned* p)              { return __hip_atomic_load(p, __ATOMIC_RELAXED, __HIP_MEMORY_SCOPE_AGENT); }
__device__ __forceinline__ unsigned xb_add(unsigned* p, unsigned v) { return __hip_atomic_fetch_add(p, v, __ATOMIC_RELAXED, __HIP_MEMORY_SCOPE_AGENT); }
__device__ __forceinline__ unsigned xb_xcc_id() { return (unsigned)__builtin_amdgcn_s_getreg((3 << 11) | 20) & 0xFu; }
#define XB_SPIN(cond, bar) do { unsigned _sp = 0; while (cond) { __builtin_amdgcn_s_sleep(1); \
    if ((++_sp & 255u) == 0u) { if (xb_ld(&(bar)[XB_TMO])) break; if (_sp > XB_SPIN_CAP) { atomicAdd(&(bar)[XB_TMO], 1u); break; } } } } while (0)
struct XcdBarrier { unsigned* bar; unsigned x; volatile LAS unsigned* st; };
__device__ __forceinline__ XcdBarrier xcd_barrier_post(unsigned* bar, volatile LAS unsigned* st) {
    XcdBarrier b; b.bar = bar; b.x = xb_xcc_id(); b.st = st;
    if (threadIdx.x == 0) (void)xb_add(&bar[XB_XCNT(b.x)], 1u);
    return b;
}
__device__ __forceinline__ void xcd_barrier_complete(unsigned* bar, unsigned x, unsigned& nloc, unsigned& nx) {
    const unsigned G = gridDim.x * gridDim.y * gridDim.z;
    unsigned sum, cnt, mine, sp = 0u;
    for (;;) {
        sum = 0u; cnt = 0u; mine = 0u;
#pragma unroll
        for (unsigned j = 0; j < 16; ++j) { const unsigned c = xb_ld(&bar[XB_XCNT(j)]); sum += c; cnt += (c > 0u) ? 1u : 0u; mine = (j == x) ? c : mine; }
        if (sum == G) break;
        __builtin_amdgcn_s_sleep(1);
        if ((++sp & 255u) == 0u) { if (xb_ld(&bar[XB_TMO])) break; if (sp > XB_SPIN_CAP) { atomicAdd(&bar[XB_TMO], 1u); break; } }
    }
    nloc = mine > 0u ? mine : 1u; nx = cnt > 0u ? cnt : 1u;
}
__device__ __forceinline__ void xcd_barrier(const XcdBarrier& b) {
    asm volatile("s_waitcnt vmcnt(0)" ::: "memory");
    __syncthreads();
    if (threadIdx.x == 0) {
        unsigned* bar = b.bar;
        __builtin_amdgcn_s_waitcnt(0);
        unsigned nloc = b.st[0], nx = b.st[1];
        if (nloc == 0u) { xcd_barrier_complete(bar, b.x, nloc, nx); b.st[0] = nloc; b.st[1] = nx; }
        const unsigned old = xb_add(&bar[XB_XSUB(b.x)], 1u);
        const unsigned gen = old / nloc;
        if (old + 1u == (gen + 1u) * nloc) {
            __builtin_amdgcn_fence(__ATOMIC_RELEASE, "agent");
            asm volatile("s_waitcnt vmcnt(0)" ::: "memory");
            const unsigned og = xb_add(&bar[XB_TOP], 1u);
            const unsigned tg = og / nx;
            if (og + 1u == (tg + 1u) * nx) xb_add(&bar[XB_TOPGEN], 1u);
            else XB_SPIN(xb_ld(&bar[XB_TOPGEN]) == tg, bar);
            __builtin_amdgcn_fence(__ATOMIC_ACQUIRE, "agent");
            xb_add(&bar[XB_XGEN(b.x)], 1u);
            asm volatile("s_waitcnt vmcnt(0)" ::: "memory");
        } else {
            XB_SPIN(xb_ld(&bar[XB_XGEN(b.x)]) == gen, bar);
            __builtin_amdgcn_fence(__ATOMIC_ACQUIRE, "agent");
            asm volatile("s_waitcnt vmcnt(0)" ::: "memory");
        }
    }
    __syncthreads();
}

namespace pg {
constexpr int BM = 256, BK = 64, HALF = 128, HTB = HALF * BK * 2, STAGE_BYTES = 8 * HTB, NXCD = 8, WGM = 4;
__host__ __device__ __forceinline__ int lds_byte(int r, int c) { const int st = (r >> 4) * 2 + (c >> 5), rr = r & 15, cc = c & 31, ob = rr * 64 + cc * 2; return st * 1024 + (ob ^ (((ob >> 9) & 1) << 5)); }
__host__ __device__ __forceinline__ void stage_rc(int b, int& R, int& C) { const int st = b / 1024, sb = b % 1024, swz = sb ^ (((sb >> 9) & 1) << 5); R = (st >> 1) * 16 + swz / 64; C = (st & 1) * 32 + (swz % 64) / 2; }
__host__ __device__ __forceinline__ int perm32(int rho) { const int n = rho >> 4, i = rho & 15; return 8 * (i >> 2) + 4 * n + (i & 3); }

struct Unit { unsigned A, B; int pm, pn, e, nrows; };
__device__ __forceinline__ __amdgpu_buffer_rsrc_t mkrsrc(const void* p) { return __builtin_amdgcn_make_buffer_rsrc((void*)p, 0, 0x7fffffff, 0x00020000); }

__device__ __forceinline__ bool tile_order(int i, int G, int c, int nM, int nN, int& pm, int& pn) {
    const int nwg = nM * nN; const long L = (long)i * G + c; if (L >= nwg) return false;
    int wgid = (int)L; { const int q = nwg / NXCD, r = nwg % NXCD, xcd = wgid % NXCD, off = wgid / NXCD; wgid = (xcd < r ? xcd * (q + 1) : r * (q + 1) + (xcd - r) * q) + off; }
    const int nig = WGM * nN, gid = wgid / nig, fm = gid * WGM, gsz = (nM - fm) < WGM ? (nM - fm) : WGM;
    pm = fm + ((wgid % nig) % gsz); pn = (wgid % nig) / gsz; return true;
}
struct DenseSched {
    const char* A; const char* Bt; int lda2  , K2  , nM, nN, G, c;
    __device__ __forceinline__ bool next(int i, Unit& u) const { int pm, pn; if (!tile_order(i, G, c, nM, nN, pm, pn)) return false;
        u.A = (unsigned)pm * 256u * (unsigned)lda2; u.B = (unsigned)pn * 256u * (unsigned)K2; u.pm = pm; u.pn = pn; u.e = 0; u.nrows = 256; return true; }
    __device__ __forceinline__ __amdgpu_buffer_rsrc_t rsrcA() const { return mkrsrc(A); }
    __device__ __forceinline__ __amdgpu_buffer_rsrc_t rsrcB() const { return mkrsrc(Bt); }
    __device__ __forceinline__ void prefetch(const Unit&, int, int) const {}
    __device__ __forceinline__ unsigned aoff(const Unit&, int row, int) const { return (unsigned)row * (unsigned)lda2; }
};

typedef int i32x8 __attribute__((ext_vector_type(8)));
template <class Epi, class Sched, bool ALIGN_EPI, bool FP8 = false>
__device__ __forceinline__ void gemm_phase(LAS unsigned char* lds, const int K, const Sched& S, const Epi& E) {
    const int tid = threadIdx.x, wid = __builtin_amdgcn_readfirstlane(tid >> 6), lane = tid & 63, wr = wid >> 2, wc = wid & 3, fr = lane & 15, fq = lane >> 4;
    const int nt = FP8 ? K / 128 : K / BK;
    unsigned voffA[2][2], voffB[2];
#pragma unroll
    for (int i = 0; i < 1; ++i) { int R, C; if constexpr (FP8) { const int p = tid + 512 * i; R = p >> 3; C = (((p >> 1) & 3) ^ ((R >> 1) & 3)) * 32 + (p & 1) * 16; } else { stage_rc(tid * 16 + i * 8192, R, C); C *= 2; }
        const int Rb = Epi::PERM ? ((R & ~31) + perm32(R & 31)) : R; voffB[i] = (unsigned)(Rb * K * (FP8 ? 1 : 2) + C); }
    const unsigned kstep = (unsigned)(BK * 2);
    const unsigned hstep = (unsigned)HALF * K * (FP8 ? 1 : 2);
    const unsigned b64step = hstep / 2;
    const unsigned ldsw = (unsigned)wid * 1024u;
    const int aoff = FP8 ? (wr * 64 + fr) * 128 + ((fq ^ ((fr >> 1) & 3)) * 32) : lds_byte(wr * 64 + fr, fq * 8);
    const int boff = FP8 ? (wc * 32 + fr) * 128 + ((fq ^ ((fr >> 1) & 3)) * 32) : lds_byte(wc * 32 + fr, fq * 8);
#define PG_SA(b, h) (((b) * 2 + (h)) * HTB)
#define PG_SB(b, h) ((4 + (b) * 2 + (h)) * HTB)
#define PG_STAGE(bufoff, so, voff) do { _Pragma("unroll") for (int _i = 0; _i < 2; ++_i) \
        __builtin_amdgcn_raw_ptr_buffer_load_lds(rA, (LAS void*)(lds + (bufoff) + ldsw + _i * 8192), 16, (int)(voff)[_i], (int)(so), 0, 0); } while (0)
#define PG_STAGEB(bufoff, so) do { _Pragma("unroll") for (int _i = 0; _i < 2; ++_i) \
        __builtin_amdgcn_raw_ptr_buffer_load_lds(rB, (LAS void*)(lds + (bufoff) + ldsw + _i * 8192), 16, (int)voffB[0], (int)((so) + _i * b64step), 0, 0); } while (0)
#define PG_LD8(p, p2) __builtin_bit_cast(i32x8, __builtin_shufflevector(*(const LAS u32x4*)(p), *(const LAS u32x4*)(p2), 0, 1, 2, 3, 4, 5, 6, 7))
#define PG_LDA(dst, b, h) do { if constexpr (FP8) { _Pragma("unroll") for (int m = 0; m < 4; ++m) dst##8[m] = PG_LD8(lds + PG_SA(b, h) + aoff + m * 2048, lds + PG_SA(b, h) + aoff + m * 2048 + 16); } \
        else { _Pragma("unroll") for (int m = 0; m < 4; ++m) _Pragma("unroll") for (int k = 0; k < 2; ++k) dst[m][k] = *(const LAS bf16x8*)(lds + PG_SA(b, h) + aoff + m * 2048 + k * 1024); } } while (0)
#define PG_LDB(dst, b, h) do { if constexpr (FP8) { _Pragma("unroll") for (int n = 0; n < 2; ++n) dst##8[n] = PG_LD8(lds + PG_SB(b, h) + boff + n * 2048, lds + PG_SB(b, h) + boff + n * 2048 + 16); } \
        else { _Pragma("unroll") for (int n = 0; n < 2; ++n) _Pragma("unroll") for (int k = 0; k < 2; ++k) dst[n][k] = *(const LAS bf16x8*)(lds + PG_SB(b, h) + boff + n * 2048 + k * 1024); } } while (0)
#define PG_MMA(ai, bj, At, Bt) do { __builtin_amdgcn_s_setprio(1); if constexpr (FP8) { _Pragma("unroll") for (int m = 0; m < 4; ++m) _Pragma("unroll") for (int n = 0; n < 2; ++n) \
            acc[ai][bj][m][n] = __builtin_amdgcn_mfma_scale_f32_16x16x128_f8f6f4(Bt##8[n], At##8[m], acc[ai][bj][m][n], 0, 0, 0, 0, 0, 0); } \
        else { _Pragma("unroll") for (int m = 0; m < 4; ++m) _Pragma("unroll") for (int n = 0; n < 2; ++n) _Pragma("unroll") for (int k = 0; k < 2; ++k) \
            acc[ai][bj][m][n] = __builtin_amdgcn_mfma_f32_16x16x32_bf16(Bt[n][k], At[m][k], acc[ai][bj][m][n], 0, 0, 0); } __builtin_amdgcn_s_setprio(0); } while (0)
#define PG_WAIT_V(n) asm volatile("s_waitcnt vmcnt(" #n ")" ::: "memory")
#define PG_WAIT_L(n) asm volatile("s_waitcnt lgkmcnt(" #n ")" ::: "memory")
#define PG_BAR __builtin_amdgcn_s_barrier()
#define PG_SCHED __builtin_amdgcn_sched_barrier(0)
#define PG_SET_AOFF(u, ib) do { int _t = threadIdx.x; asm volatile("" : "+v"(_t));     \
        _Pragma("unroll") for (int _i = 0; _i < 2; ++_i) { int _R, _C; if constexpr (FP8) { const int _p = _t + 512 * _i; _R = _p >> 3; _C = (((_p >> 1) & 3) ^ ((_R >> 1) & 3)) * 32 + (_p & 1) * 16; } else { stage_rc(_t * 16 + _i * 8192, _R, _C); _C *= 2; } \
        voffA[0][_i] = S.aoff(u, _R, ib) + (unsigned)_C; voffA[1][_i] = S.aoff(u, _R + HALF, ib) + (unsigned)_C; } } while (0)
    Unit cur, nxt; int ui = 0;
    if (!S.next(0, cur)) return;
    f32x4 acc[2][2][4][2];
#pragma unroll
    for (int a = 0; a < 2; ++a)
#pragma unroll
        for (int b = 0; b < 2; ++b)
#pragma unroll
            for (int m = 0; m < 4; ++m)
#pragma unroll
                for (int n = 0; n < 2; ++n) acc[a][b][m][n] = (f32x4){0.f, 0.f, 0.f, 0.f};
    bf16x8 At[FP8 ? 1 : 4][2], B0[2][2], B1[2][2]; i32x8 At8[FP8 ? 4 : 1], B08[2], B18[2];
    const __amdgpu_buffer_rsrc_t rA = S.rsrcA(), rB = S.rsrcB();
    unsigned cA = cur.A, cB = cur.B;
    S.prefetch(cur, 0, 0);
    PG_WAIT_V(0); __syncthreads();
    PG_SET_AOFF(cur, 0);
    PG_STAGEB(PG_SB(0, 0), cB); PG_STAGEB(PG_SB(0, 1), cB + hstep); PG_STAGE(PG_SA(0, 0), cA, voffA[0]); PG_STAGE(PG_SA(0, 1), cA, voffA[1]);
    if (wr == 1) PG_BAR;
    PG_WAIT_V(2); PG_BAR;
    PG_STAGEB(PG_SB(1, 0), cB + kstep); PG_STAGE(PG_SA(1, 0), cA + kstep, voffA[0]); PG_STAGEB(PG_SB(1, 1), cB + hstep + kstep);
    PG_WAIT_V(6); PG_BAR;
    for (;;) {
        const bool has_next = S.next(ui + 1, nxt);
        const unsigned nA = has_next ? nxt.A : cA, nB = has_next ? nxt.B : cB;
        if (has_next) S.prefetch(nxt, (ui + 1) & 1, (ui + 1) % 3);
#pragma unroll 1
        for (int t = 0; t < nt; t += 2) {
            const bool last = (t == nt - 2);
            const unsigned a1 = cA + (unsigned)(t + 1) * kstep;
            const unsigned a2 = last ? nA : cA + (unsigned)(t + 2) * kstep, b2 = last ? nB : cB + (unsigned)(t + 2) * kstep;
            const unsigned a3 = a2 + kstep, b3 = b2 + kstep;
            PG_LDB(B0, 0, 0); PG_LDB(B1, 0, 1); PG_SCHED; PG_LDA(At, 0, 0); PG_STAGE(PG_SA(1, 1), a1, voffA[1]);
            PG_WAIT_V(8); PG_WAIT_L(0); PG_BAR; PG_MMA(0, 0, At, B0); PG_MMA(0, 1, At, B1); PG_BAR; PG_SCHED;
            if (last && has_next) PG_SET_AOFF(nxt, (ui + 1) & 1);
            PG_LDA(At, 0, 1); PG_STAGEB(PG_SB(0, 0), b2); PG_STAGEB(PG_SB(0, 1), b2 + hstep); PG_STAGE(PG_SA(0, 0), a2, voffA[0]);
            PG_WAIT_V(8); PG_WAIT_L(0); PG_BAR; PG_MMA(1, 0, At, B0); PG_MMA(1, 1, At, B1); PG_BAR; PG_SCHED;
            PG_LDB(B0, 1, 0); PG_LDB(B1, 1, 1); PG_SCHED; PG_LDA(At, 1, 0); PG_STAGE(PG_SA(0, 1), a2, voffA[1]);
            PG_WAIT_V(8); PG_WAIT_L(0); PG_BAR; PG_MMA(0, 0, At, B0); PG_MMA(0, 1, At, B1); PG_BAR; PG_SCHED;
            PG_LDA(At, 1, 1); PG_STAGEB(PG_SB(1, 0), b3); PG_STAGEB(PG_SB(1, 1), b3 + hstep); PG_STAGE(PG_SA(1, 0), a3, voffA[0]);
            PG_WAIT_V(8); PG_WAIT_L(0); PG_BAR; PG_MMA(1, 0, At, B0); PG_MMA(1, 1, At, B1); PG_BAR; PG_SCHED;
        }
        if constexpr (ALIGN_EPI) { if (wr == 0) PG_BAR; }
        {
            int tz = threadIdx.x; asm volatile("" : "+v"(tz)); const int lz = tz & 63;
            E(acc, cur, ui % 3, (tz >> 6) >> 2, (tz >> 6) & 3, lz & 15, lz >> 4);
        }
        if (!has_next) break;
#pragma unroll
        for (int a = 0; a < 2; ++a)
#pragma unroll
            for (int b = 0; b < 2; ++b)
#pragma unroll
                for (int m = 0; m < 4; ++m)
#pragma unroll
                    for (int n = 0; n < 2; ++n) acc[a][b][m][n] = (f32x4){0.f, 0.f, 0.f, 0.f};
        cur = nxt; cA = nA; cB = nB; ++ui;
        if constexpr (ALIGN_EPI) { if (wr == 1) PG_BAR; }
    }
    PG_WAIT_V(0);
    if constexpr (!ALIGN_EPI) { if (wr == 0) PG_BAR; }
    PG_BAR;
#undef PG_SA
#undef PG_SB
#undef PG_STAGE
#undef PG_STAGEB
#undef PG_LDA
#undef PG_LDB
#undef PG_MMA
#undef PG_LD8
#undef PG_WAIT_V
#undef PG_WAIT_L
#undef PG_BAR
#undef PG_SCHED
#undef PG_SET_AOFF
}

struct EpiProj {
    static constexpr bool PERM = true; bf16* P; bf16* S5A;
    __device__ __forceinline__ void operator()(const f32x4 (&acc)[2][2][4][2], const Unit& u, int bb, int wr, int wc, int fr, int fq) const {
        const int row0 = u.pm * BM + wr * 64 + fr, col0 = u.pn * BM + wc * 32 + 8 * fq;
#pragma unroll
        for (int ai = 0; ai < 2; ++ai)
#pragma unroll
            for (int m = 0; m < 4; ++m) { const int row = row0 + ai * HALF + m * 16; bf16* rowp = P + (size_t)row * NPROJ + col0;
                if (u.pn < 2) { const int b = row >> 13, tt = row & 8191; rowp = S5A + ((size_t)b * S5NCH + (tt / S5L)) * S5K + (tt % S5L) * 16 + (col0 & 15) + (size_t)(col0 >> 4) * S5ROWS * S5K; }
#pragma unroll
                for (int bj = 0; bj < 2; ++bj) { const f32x4 v0 = acc[ai][bj][m][0], v1 = acc[ai][bj][m][1];
                    u32x4 w; w.x = cvt_pk_bf16(v0[0], v0[1]); w.y = cvt_pk_bf16(v0[2], v0[3]); w.z = cvt_pk_bf16(v1[0], v1[1]); w.w = cvt_pk_bf16(v1[2], v1[3]);
                    *(u32x4*)(rowp + (u.pn < 2 ? (size_t)bj * 8 * S5ROWS * S5K : (size_t)bj * HALF)) = w; } }
    }
};
struct EpiXloc {
    static constexpr bool PERM = false; float* X;
    __device__ __forceinline__ void operator()(const f32x4 (&acc)[2][2][4][2], const Unit& u, int bb, int wr, int wc, int fr, int fq) const {
        const int row0 = (u.pm & 3) * BM + wr * 64 + fr, col0 = wc * 32 + 4 * fq;
#pragma unroll
        for (int ai = 0; ai < 2; ++ai)
#pragma unroll
            for (int m = 0; m < 4; ++m) { float* rp = X + ((size_t)u.e * S5ROWS + row0 + ai * HALF + m * 16) * 128 + col0;
#pragma unroll
                for (int n = 0; n < 2; ++n) *(f32x4*)(rp + n * 16) = acc[ai][0][m][n]; }
    }
};
struct EpiS5Y {
    static constexpr bool PERM = true; const bf16* S5A; const float* dskip; bf16* GY;
    __device__ __forceinline__ void operator()(const f32x4 (&acc)[2][2][4][2], const Unit& u, int bb, int wr, int wc, int fr, int fq) const {
        const int g = u.e, rg0 = (u.pm & 3) * BM + wr * 64 + fr, c0 = u.pn * BM + wc * 32 + 8 * fq;
#pragma unroll
        for (int bj = 0; bj < 2; ++bj) { const int col = c0 + bj * HALF, t = col >> 4, p0 = col & 15;
            const f32x4 d0 = *(const f32x4*)(dskip + g * 16 + p0), d1 = *(const f32x4*)(dskip + g * 16 + p0 + 4);
#pragma unroll
            for (int ai = 0; ai < 2; ++ai)
#pragma unroll
                for (int m = 0; m < 4; ++m) { const int rg = rg0 + ai * HALF + m * 16; const int b = rg / S5NCH, c = rg % S5NCH;
                    const u32x4 uu = *(const u32x4*)(S5A + ((size_t)g * S5ROWS + rg) * S5K + col);
                    const f32x4 v0 = acc[ai][bj][m][0], v1 = acc[ai][bj][m][1];
                    u32x4 w;
                    w.x = cvt_pk_bf16(gelu_tanh(v0[0] + d0[0] * lo_bf(uu.x)), gelu_tanh(v0[1] + d0[1] * hi_bf(uu.x))); w.y = cvt_pk_bf16(gelu_tanh(v0[2] + d0[2] * lo_bf(uu.y)), gelu_tanh(v0[3] + d0[3] * hi_bf(uu.y)));
                    w.z = cvt_pk_bf16(gelu_tanh(v1[0] + d1[0] * lo_bf(uu.z)), gelu_tanh(v1[1] + d1[1] * hi_bf(uu.z))); w.w = cvt_pk_bf16(gelu_tanh(v1[2] + d1[2] * lo_bf(uu.w)), gelu_tanh(v1[3] + d1[3] * hi_bf(uu.w)));
                    *(u32x4*)(GY + ((size_t)b * SEQ + c * S5L + t) * 512 + g * 16 + p0) = w; } }
    }
};
struct S5Sched {
    const char* A; const char* B; int lda2, K2, brows, nN, G, c;
    __device__ __forceinline__ bool next(int i, Unit& u) const { const int L = i * G + c; if (L >= 128 * nN) return false;
        const int g = L / (4 * nN), r = L % (4 * nN), mh = r / nN, pn = r % nN;
        u.A = ((unsigned)g * S5ROWS + mh * 256u) * (unsigned)lda2; u.B = ((unsigned)g * brows + pn * 256u) * (unsigned)K2; u.pm = g * 4 + mh; u.pn = pn; u.e = g; u.nrows = 256; return true; }
    __device__ __forceinline__ __amdgpu_buffer_rsrc_t rsrcA() const { return mkrsrc(A); }
    __device__ __forceinline__ __amdgpu_buffer_rsrc_t rsrcB() const { return mkrsrc(B); }
    __device__ __forceinline__ void prefetch(const Unit&, int, int) const {}
    __device__ __forceinline__ unsigned aoff(const Unit&, int row, int) const { return (unsigned)row * (unsigned)lda2; }
};
struct EpiGlu {
    static constexpr bool PERM = true; const bf16* GY; const float* bglu; bf16* MIX;
    __device__ __forceinline__ void operator()(const f32x4 (&acc)[2][2][4][2], const Unit& u, int bb, int wr, int wc, int fr, int fq) const {
        const int row0 = u.pm * BM + wr * 64 + fr, col0 = u.pn * BM + wc * 32 + 8 * fq;
#pragma unroll
        for (int bj = 0; bj < 2; ++bj) { const int col = col0 + bj * HALF;
            const f32x4 b0 = *(const f32x4*)(bglu + col), b1 = *(const f32x4*)(bglu + col + 4);
#pragma unroll
            for (int ai = 0; ai < 2; ++ai)
#pragma unroll
                for (int m = 0; m < 4; ++m) { const size_t row = (size_t)(row0 + ai * HALF + m * 16);
                    const u32x4 g = *(const u32x4*)(GY + row * 512 + col);
                    const f32x4 v0 = acc[ai][bj][m][0] + b0, v1 = acc[ai][bj][m][1] + b1;
                    u32x4 w;
                    w.x = cvt_pk_bf16(lo_bf(g.x) * sigmoidf_(v0[0]), hi_bf(g.x) * sigmoidf_(v0[1])); w.y = cvt_pk_bf16(lo_bf(g.y) * sigmoidf_(v0[2]), hi_bf(g.y) * sigmoidf_(v0[3]));
                    w.z = cvt_pk_bf16(lo_bf(g.z) * sigmoidf_(v1[0]), hi_bf(g.z) * sigmoidf_(v1[1])); w.w = cvt_pk_bf16(lo_bf(g.w) * sigmoidf_(v1[2]), hi_bf(g.w) * sigmoidf_(v1[3]));
                    *(u32x4*)(MIX + row * D + col) = w; } }
    }
};
struct EpiOut {
    static constexpr bool PERM = true; const float* x; bf16* H;
    __device__ __forceinline__ void operator()(const f32x4 (&acc)[2][2][4][2], const Unit& u, int bb, int wr, int wc, int fr, int fq) const {
        const int row0 = u.pm * BM + wr * 64 + fr, col0 = u.pn * BM + wc * 32 + 8 * fq;
#pragma unroll
        for (int ai = 0; ai < 2; ++ai)
#pragma unroll
            for (int m = 0; m < 4; ++m) { const size_t ro = (size_t)(row0 + ai * HALF + m * 16) * D + col0;
#pragma unroll
                for (int bj = 0; bj < 2; ++bj) { const f32x4 v0 = __builtin_nontemporal_load((const f32x4*)(x + ro + bj * HALF)) + acc[ai][bj][m][0], v1 = __builtin_nontemporal_load((const f32x4*)(x + ro + bj * HALF + 4)) + acc[ai][bj][m][1];
                    u32x4 w; w.x = cvt_pk_bf16(v0[0], v0[1]); w.y = cvt_pk_bf16(v0[2], v0[3]); w.z = cvt_pk_bf16(v1[0], v1[1]); w.w = cvt_pk_bf16(v1[2], v1[3]);
                    *(u32x4*)(H + ro + bj * HALF) = w; } }
    }
};
struct EpiUp {
    static constexpr bool PERM = true; const LAS float* bl; unsigned char* ACT;
    __device__ __forceinline__ void operator()(const f32x4 (&acc)[2][2][4][2], const Unit& u, int bb, int wr, int wc, int fr, int fq) const {
        const int row0 = u.pm * BM + wr * 64 + fr, j0 = u.pn * HALF + wc * 32 + 8 * fq;
        const LAS float* bg = bl + bb * 256 + wc * 32 + 8 * fq;
#pragma unroll
        for (int ai = 0; ai < 2; ++ai)
#pragma unroll
            for (int m = 0; m < 4; ++m) {
                float o[8];
                typedef float f32x2 __attribute__((ext_vector_type(2)));
#pragma unroll
                for (int n = 0; n < 2; ++n) { const f32x4 gb = *(const LAS f32x4*)(bg + 4 * n), lb = *(const LAS f32x4*)(bg + 128 + 4 * n);
#pragma unroll
                    for (int q = 0; q < 4; q += 2) {
                        f32x2 gv = (f32x2){acc[ai][0][m][n][q], acc[ai][0][m][n][q + 1]} * W8_INV + (f32x2){gb[q], gb[q + 1]};
                        f32x2 lv = (f32x2){acc[ai][1][m][n][q], acc[ai][1][m][n][q + 1]} * W8_INV + ((f32x2){lb[q], lb[q + 1]} + 1.f);
                        gv.x = fminf(gv.x, 7.f); gv.y = fminf(gv.y, 7.f);
                        lv.x = __builtin_amdgcn_fmed3f(lv.x, -6.f, 8.f); lv.y = __builtin_amdgcn_fmed3f(lv.y, -6.f, 8.f);
                        f32x2 tt = gv * (-1.702f * 1.4426950408889634f);
                        tt.x = __builtin_amdgcn_exp2f(tt.x); tt.y = __builtin_amdgcn_exp2f(tt.y);
                        tt = tt + 1.f;
                        tt.x = __builtin_amdgcn_rcpf(tt.x); tt.y = __builtin_amdgcn_rcpf(tt.y);
                        const f32x2 ov = (gv * tt) * lv;
                        o[n * 4 + q] = ov.x; o[n * 4 + q + 1] = ov.y; } }
                u32x2 w; w.x = pk4_fp8(o[0], o[1], o[2], o[3]); w.y = pk4_fp8(o[4], o[5], o[6], o[7]);
                *(u32x2*)(ACT + (size_t)(row0 + ai * HALF + m * 16) * FF + j0) = w; }
    }
};
struct EpiDown {
    static constexpr bool PERM = true; const LAS float* bl; unsigned char* YS;
    __device__ __forceinline__ void operator()(const f32x4 (&acc)[2][2][4][2], const Unit& u, int bb, int wr, int wc, int fr, int fq) const {
        const int row0 = u.pm * BM + wr * 64 + fr, col0 = u.pn * BM + wc * 32 + 8 * fq;
        const LAS float* bp = bl + bb * 256 + wc * 32 + 8 * fq;
#pragma unroll
        for (int ai = 0; ai < 2; ++ai)
#pragma unroll
            for (int m = 0; m < 4; ++m)
#pragma unroll
                for (int bj = 0; bj < 2; ++bj) { const f32x4 b0 = *(const LAS f32x4*)(bp + bj * HALF), b1 = *(const LAS f32x4*)(bp + bj * HALF + 4);
                    const f32x4 v0 = acc[ai][bj][m][0] * W8_INV + b0, v1 = acc[ai][bj][m][1] * W8_INV + b1;
                    u32x2 w; w.x = pk4_fp8(v0[0], v0[1], v0[2], v0[3]); w.y = pk4_fp8(v1[0], v1[1], v1[2], v1[3]);
                    *(u32x2*)(YS + (size_t)(row0 + ai * HALF + m * 16) * D + col0 + bj * HALF) = w; }
    }
};
}

struct MoeSched {
    const char* A; const char* W; const int* slot_tok; const float* bias; LAS int* til; LAS int* idx; LAS float* bl; int lda2, K2, nN, wrows  , G, c, gather;
    __device__ __forceinline__ bool next(int i, pg::Unit& u) const {
        const int nM = __builtin_amdgcn_readfirstlane(til[2 * MAXTILES]); int pm, pn; if (!pg::tile_order(i, G, c, nM, nN, pm, pn)) return false;
        pm = __builtin_amdgcn_readfirstlane(pm); pn = __builtin_amdgcn_readfirstlane(pn);
        const int e = __builtin_amdgcn_readfirstlane(til[pm]); u.pm = pm; u.pn = pn; u.e = e; u.nrows = __builtin_amdgcn_readfirstlane(til[MAXTILES + pm]);
        u.A = gather ? 0u : (unsigned)pm * 256u * (unsigned)lda2; u.B = ((unsigned)e * wrows + (unsigned)pn * 256u) * (unsigned)K2; return true; }
    __device__ __forceinline__ __amdgpu_buffer_rsrc_t rsrcA() const { return pg::mkrsrc(A); }
    __device__ __forceinline__ __amdgpu_buffer_rsrc_t rsrcB() const { return pg::mkrsrc(W); }
    __device__ __forceinline__ void prefetch(const pg::Unit& u, int ib, int bb) const {
        if (threadIdx.x >= 256 && threadIdx.x < 320) {
            const int l = threadIdx.x - 256;
            const float* src = gather ? bias + (size_t)u.e * 2 * FF + (l < 32 ? u.pn * 128 + 4 * l : FF + u.pn * 128 + 4 * (l - 32)) : bias + (size_t)u.e * D + u.pn * 256 + 4 * l;
            __builtin_amdgcn_global_load_lds((const unsigned*)src, (LAS unsigned*)(bl + bb * 256), 16, 0, 0); }
        if (gather && threadIdx.x < 256) { const int r = threadIdx.x; const int s = u.pm * 256 + (r < u.nrows ? r : u.nrows - 1);
            __builtin_amdgcn_global_load_lds((const unsigned*)(slot_tok + s), (LAS unsigned*)(idx + ib * 256 + (threadIdx.x & ~63)), 4, 0, 0); } }
    __device__ __forceinline__ unsigned aoff(const pg::Unit&, int row, int ib) const { return gather ? (unsigned)idx[ib * 256 + row] * (unsigned)lda2 : (unsigned)row * (unsigned)lda2; }
};

struct Frame {
    LAS unsigned char* lds; volatile LAS unsigned* MISC; gu32* ctl; int tid, lane, wave, vcu, G;
};
#define LDS_WAIT() asm volatile("s_waitcnt lgkmcnt(0)" ::: "memory")

template <bool F8, class RowMap>
__device__ __forceinline__ void transpose_item(const float* W, int ldw, int K, int nblk, void* WTv, LAS bf16* scr, int item, int lane, RowMap rowmap) {
    const int kb = item / nblk, nb = item % nblk, k0 = 64 * kb, n0 = 64 * nb;
    const float* src = W + (size_t)(k0 + (lane >> 4)) * ldw + n0 + 4 * (lane & 15);
    f32x4 v[16];
#pragma unroll
    for (int i = 0; i < 16; ++i) v[i] = __builtin_nontemporal_load((const f32x4*)(src + (size_t)(4 * i) * ldw));
#pragma unroll
    for (int i = 0; i < 16; ++i) { u32x2 o; o.x = pk2(v[i].x, v[i].y); o.y = pk2(v[i].z, v[i].w); *(LAS u32x2*)(scr + ((lane >> 4) + 4 * i) * 68 + 4 * (lane & 15)) = o; }
    LDS_WAIT(); asm volatile("" ::: "memory");
    const int c = lane & 7; const int r0 = rowmap(n0);
#pragma unroll
    for (int jn = 0; jn < 8; ++jn) { const int n = (lane >> 3) + 8 * jn; const LAS bf16* sp = scr + (8 * c) * 68 + n;
        if constexpr (F8) { u32x2 o; o.x = pk4_fp8(bf2f(sp[0]) * W8_SCALE, bf2f(sp[68]) * W8_SCALE, bf2f(sp[2 * 68]) * W8_SCALE, bf2f(sp[3 * 68]) * W8_SCALE);
            o.y = pk4_fp8(bf2f(sp[4 * 68]) * W8_SCALE, bf2f(sp[5 * 68]) * W8_SCALE, bf2f(sp[6 * 68]) * W8_SCALE, bf2f(sp[7 * 68]) * W8_SCALE);
            __builtin_nontemporal_store(o, (u32x2*)((unsigned char*)WTv + (size_t)(r0 + n) * K + k0 + 8 * c)); }
        else { u32x4 o; o.x = (unsigned)sp[0] | ((unsigned)sp[68] << 16); o.y = (unsigned)sp[2 * 68] | ((unsigned)sp[3 * 68] << 16); o.z = (unsigned)sp[4 * 68] | ((unsigned)sp[5 * 68] << 16); o.w = (unsigned)sp[6 * 68] | ((unsigned)sp[7 * 68] << 16);
            *(u32x4*)((bf16*)WTv + (size_t)(r0 + n) * K + k0 + 8 * c) = o; } }
    LDS_WAIT(); asm volatile("" ::: "memory");
}
struct RowId { __device__ __forceinline__ int operator()(int n0) const { return n0; } };
struct RowUp { __device__ __forceinline__ int operator()(int n0) const { return n0 < FF ? (n0 >> 7) * 256 + (n0 & 127) : ((n0 - FF) >> 7) * 256 + 128 + ((n0 - FF) & 127); } };

struct Args { const float* in[26]; float* out; unsigned char* ws; int ph_lo, ph_hi, li, pad; };

__global__ void __launch_bounds__(NTHR, 2) fwd(Args args) {
    extern __shared__ __attribute__((aligned(16))) unsigned char lds_raw[];
    Frame F;
    F.lds = (LAS unsigned char*)lds_raw;
    F.MISC = (volatile LAS unsigned*)(F.lds + MISC_OFF);
    F.tid = threadIdx.x; F.lane = F.tid & 63; F.wave = __builtin_amdgcn_readfirstlane(F.tid >> 6);
    F.G = gridDim.x; { const int bx = blockIdx.x; F.vcu = (F.G % 8 == 0) ? (bx % 8) * (F.G / 8) + bx / 8 : bx; }
    unsigned char* ws = args.ws;
    F.ctl = (gu32*)(ws + WS_CTL);
    if (F.tid < 32) ((LAS unsigned*)(F.lds + MISC_OFF))[F.tid] = 0u;
    __syncthreads();
    XcdBarrier bar = xcd_barrier_post((unsigned*)(F.ctl + CW_BAR) + args.li * XCD_BAR_WORDS, F.MISC + 8);
#define INP(i) (*(const float* const volatile*)((const char*)__builtin_amdgcn_kernarg_segment_ptr() + 8 * (i)))
    const int lo = args.ph_lo, hi = args.ph_hi;
#define IN(k) (lo <= (k) && (k) < hi)
#define BOTH(k) (IN(k) && IN((k) + 1))
#define GRID_BAR() xcd_barrier(bar)
    const float* x = args.in[0];
    bf16* WIN = (bf16*)(ws + WS_WIN); bf16* WGLU = (bf16*)(ws + WS_WGLU); bf16* WOUT = (bf16*)(ws + WS_WOUT); unsigned char* WUP8 = ws + WS_WUP; unsigned char* WDN8 = ws + WS_WDN;
    bf16* HN = (bf16*)(ws + WS_HN); bf16* PROJ = (bf16*)(ws + WS_PROJ); bf16* GY = (bf16*)(ws + WS_GY); bf16* MIX = (bf16*)(ws + WS_MIX);
    bf16* H = (bf16*)(ws + WS_H); unsigned char* ACT8 = ws + WS_ACT; unsigned char* HN8 = ws + WS_HN; unsigned char* YS = ws + WS_YS;
    float* gates = (float*)(ws + WS_GATES); int* topi = (int*)(ws + WS_TOPI); float* topg = (float*)(ws + WS_TOPG);
    int* slot_tok = (int*)(ws + WS_SLOTTOK); int* tok_slot = (int*)(ws + WS_TOKSLOT); int* CNT = (int*)(ws + WS_CNT); int* ecnt = CNT + 16384;
    bf16* S5A = (bf16*)(ws + WS_S5A); bf16* S5BT = (bf16*)(ws + WS_S5BT); bf16* S5BQ = (bf16*)(ws + WS_S5BQ); float* XLOC = (float*)(ws + WS_XLOC);
    bf16* QH = (bf16*)(ws + WS_QH); bf16* KH = (bf16*)(ws + WS_KH); bf16* VT = (bf16*)(ws + WS_VT); float* DC = (float*)(ws + WS_DC); bf16* CST = (bf16*)(ws + WS_CST);
    float* FLOC = (float*)(ws + WS_FLOC); float* DN = (float*)(ws + WS_DN); float* NST = (float*)(ws + WS_NST); float* SEGS = (float*)(ws + WS_SEGS); float* KTAB = (float*)(ws + WS_KTAB);
    const int gw = F.vcu * NWAVES + F.wave, NGW = F.G * NWAVES;

    if (IN(0)) {
        { int tq_ = threadIdx.x; asm volatile("" : "+v"(tq_)); F.tid = tq_; F.lane = tq_ & 63; }
        LAS bf16* scr = (LAS bf16*)(F.lds + F.wave * 16384);
        constexpr int I_IN = (D / 64) * (NPROJ / 64), I_GLU = (512 / 64) * (512 / 64), I_OUT = (D / 64) * (D / 64), I_UP = (D / 64) * (2 * FF / 64);
        constexpr int NITEMS = I_IN + I_GLU + I_OUT + NE * I_UP;
        for (int it = gw; it < NITEMS && !(args.pad & 1); it += NGW) {
            int r = it;
            if (r < I_IN) { transpose_item<false>(args.in[2], DIN, D, NPROJ / 64, WIN, scr, r, F.lane, RowId()); continue; } r -= I_IN;
            if (r < I_GLU) { transpose_item<false>(args.in[11], 512, 512, 512 / 64, WGLU, scr, r, F.lane, RowId()); continue; } r -= I_GLU;
            if (r < I_OUT) { transpose_item<false>(args.in[17], D, D, D / 64, WOUT, scr, r, F.lane, RowId()); continue; } r -= I_OUT;
            { const int e = r / I_UP; transpose_item<true>(args.in[21] + (size_t)e * D * 2 * FF, 2 * FF, D, 2 * FF / 64, WUP8 + (size_t)e * 2 * FF * D, scr, r % I_UP, F.lane, RowUp()); }
        }
        {
            const float* g = args.in[1]; const float* w_in = args.in[2]; const float* b_gates = args.in[15];
            float wg[16][8]; f32x4 gg[4];
#pragma unroll
            for (int jq = 0; jq < 4; ++jq) { gg[jq] = *(const f32x4*)(g + 4 * F.lane + 256 * jq);
#pragma unroll
                for (int i = 0; i < 4; ++i) { const int k = 4 * F.lane + 256 * jq + i; const f32x4 w0 = *(const f32x4*)(w_in + (size_t)k * DIN + O_G), w1 = *(const f32x4*)(w_in + (size_t)k * DIN + O_G + 4);
                    wg[4 * jq + i][0] = w0.x; wg[4 * jq + i][1] = w0.y; wg[4 * jq + i][2] = w0.z; wg[4 * jq + i][3] = w0.w; wg[4 * jq + i][4] = w1.x; wg[4 * jq + i][5] = w1.y; wg[4 * jq + i][6] = w1.z; wg[4 * jq + i][7] = w1.w; } }
            float bgv[8];
#pragma unroll
            for (int q = 0; q < 8; ++q) bgv[q] = b_gates[q];
            f32x4 nx[4];
            if (gw < T) {
#pragma unroll
                for (int jq = 0; jq < 4; ++jq) nx[jq] = __builtin_nontemporal_load((const f32x4*)(x + (size_t)gw * D + 4 * F.lane + 256 * jq)); }
            for (int row = gw; row < T && !(args.pad & 2); row += NGW) {
                f32x4 v[4];
#pragma unroll
                for (int jq = 0; jq < 4; ++jq) v[jq] = nx[jq];
                if (row + NGW < T) {
#pragma unroll
                    for (int jq = 0; jq < 4; ++jq) nx[jq] = __builtin_nontemporal_load((const f32x4*)(x + (size_t)(row + NGW) * D + 4 * F.lane + 256 * jq)); }
                float ss = 0.f;
#pragma unroll
                for (int jq = 0; jq < 4; ++jq) ss += v[jq].x * v[jq].x + v[jq].y * v[jq].y + v[jq].z * v[jq].z + v[jq].w * v[jq].w;
                ss = wave_sum(ss);
                const float rstd = rsqrtf(ss * (1.f / D) + 1e-5f);
                float ga[8] = {0, 0, 0, 0, 0, 0, 0, 0};
#pragma unroll
                for (int jq = 0; jq < 4; ++jq) {
                    v[jq] = v[jq] * rstd * gg[jq];
#pragma unroll
                    for (int i = 0; i < 4; ++i)
#pragma unroll
                        for (int q = 0; q < 8; ++q) ga[q] += v[jq][i] * wg[4 * jq + i][q];
                    uint2 o; o.x = pk2(v[jq].x, v[jq].y); o.y = pk2(v[jq].z, v[jq].w);
                    *(uint2*)(HN + (size_t)row * D + 4 * F.lane + 256 * jq) = o;
                }
#pragma unroll
                for (int q = 0; q < 8; ++q) ga[q] = wave_sum(ga[q]);
                if (F.lane == 0) { *(f32x4*)(gates + (size_t)row * 8) = (f32x4){ga[0] + bgv[0], ga[1] + bgv[1], ga[2] + bgv[2], ga[3] + bgv[3]}; *(f32x4*)(gates + (size_t)row * 8 + 4) = (f32x4){ga[4] + bgv[4], ga[5] + bgv[5], ga[6] + bgv[6], ga[7] + bgv[7]}; }
            }
        }
        __syncthreads();
        for (int un = F.vcu; un < 256 && !(args.pad & 4); un += F.G) {
            const int g = un >> 3, j = un & 7;
            LAS float* Ere = (LAS float*)F.lds; LAS float* Eim = Ere + 4 * 64;
            LAS float* Bbr = Eim + 4 * 64; LAS float* Bbi = Bbr + 1024;
            LAS float* Cr = Bbi + 1024; LAS float* Ci = Cr + 1024;
            LAS float* E6r = Ci + 1024; LAS float* E6i = E6r + 1024;
            const float dt = __expf(args.in[3][g]);
            if (F.tid < 64) { const int n = F.tid;
                const float are = fminf(args.in[4][g * 64 + n], -1e-4f), aim = args.in[5][g * 64 + n];
                const float mag = __expf(dt * are); float sn, cs; fcis(dt * aim, &sn, &cs);
                const float nr = mag * cs - 1.f, ni = mag * sn, dn = are * are + aim * aim;
                const float cfr = (nr * are + ni * aim) / dn, cfi = (ni * are - nr * aim) / dn;
                for (int q = 0; q < 16; ++q) { const float br = args.in[6][(g * 64 + n) * 16 + q], bi = args.in[7][(g * 64 + n) * 16 + q]; Bbr[n * 16 + q] = cfr * br - cfi * bi; Bbi[n * 16 + q] = cfr * bi + cfi * br; }
            }
            for (int i = F.tid; i < 1024; i += NTHR) { Cr[i] = args.in[8][g * 1024 + i]; Ci[i] = args.in[9][g * 1024 + i]; }
            if (F.tid < 256) { const int tl = F.tid >> 6, n = F.tid & 63; const float tau = (float)(4 * j + tl);
                const float are = fminf(args.in[4][g * 64 + n], -1e-4f), aim = args.in[5][g * 64 + n];
                const float mag = __expf(tau * dt * are); float sn, cs; fcis(tau * dt * aim, &sn, &cs); Ere[F.tid] = mag * cs; Eim[F.tid] = mag * sn; }
            for (int i = F.tid; i < 1024; i += NTHR) { const int tau = i >> 5, n = 32 * (j & 1) + (i & 31);
                const float are = fminf(args.in[4][g * 64 + n], -1e-4f), aim = args.in[5][g * 64 + n];
                const float mag = __expf((float)tau * dt * are); float sn, cs; fcis((float)tau * dt * aim, &sn, &cs); E6r[i] = mag * cs; E6i[i] = mag * sn; }
            __syncthreads();
            {
                const int tl = F.tid >> 7, p = (F.tid >> 3) & 15, q0 = (F.tid & 7) * 2;
                float a0 = 0.f, a1 = 0.f;
                for (int n = 0; n < 64; ++n) { const float cr = Cr[p * 64 + n], ci = Ci[p * 64 + n], er = Ere[tl * 64 + n], ei = Eim[tl * 64 + n];
                    const float xr = cr * er - ci * ei, xi = cr * ei + ci * er;
                    a0 += xr * Bbr[n * 16 + q0] - xi * Bbi[n * 16 + q0]; a1 += xr * Bbr[n * 16 + q0 + 1] - xi * Bbi[n * 16 + q0 + 1]; }
                KTAB[((size_t)g * S5L + 4 * j + tl) * 256 + p * 16 + q0] = a0; KTAB[((size_t)g * S5L + 4 * j + tl) * 256 + p * 16 + q0 + 1] = a1;
            }
            for (int ch = F.tid; ch < 32 * (S5KIN / 8); ch += NTHR) {
                const int rl = ch / (S5KIN / 8), c8 = ch % (S5KIN / 8), r = 32 * j + rl, n = r & 63, im = (r >> 6) & 1, col = c8 * 8, sidx = col >> 4, q0 = col & 15;
                const float er = E6r[(S5L - 1 - sidx) * 32 + (n & 31)], ei = E6i[(S5L - 1 - sidx) * 32 + (n & 31)];
                float v[8];
#pragma unroll
                for (int i = 0; i < 8; ++i) { const float br = Bbr[n * 16 + q0 + i], bi = Bbi[n * 16 + q0 + i]; v[i] = im ? (er * bi + ei * br) : (er * br - ei * bi); }
                u32x4 o; o.x = pk2(v[0], v[1]); o.y = pk2(v[2], v[3]); o.z = pk2(v[4], v[5]); o.w = pk2(v[6], v[7]);
                *(u32x4*)(S5BQ + ((size_t)g * 256 + r) * S5KIN + col) = o;
            }
            __syncthreads();
        }
        if (BOTH(0)) GRID_BAR();
    }
    if (IN(1)) {
        { int tq_ = threadIdx.x; asm volatile("" : "+v"(tq_)); F.tid = tq_; F.lane = tq_ & 63; }
        pg::DenseSched S{(const char*)HN, (const char*)WIN, D * 2, D * 2, T / 256, NPROJ / 256, F.G, (int)blockIdx.x};
        pg::EpiProj E{PROJ, S5A};
        pg::gemm_phase<pg::EpiProj, pg::DenseSched, true>(F.lds, D, S, E);
        if (BOTH(1)) GRID_BAR();
    }
    if (IN(2)) {
        { int tq_ = threadIdx.x; asm volatile("" : "+v"(tq_)); F.tid = tq_; F.lane = tq_ & 63; }
        pg::S5Sched S{(const char*)S5A, (const char*)S5BQ, S5K * 2, S5KIN * 2, 256, 1, F.G, F.vcu};
        pg::EpiXloc E{XLOC};
        pg::gemm_phase<pg::EpiXloc, pg::S5Sched, true>(F.lds, S5KIN, S, E);
        {
            const int first = F.G > 128 ? F.vcu - 128 : F.vcu, stride = F.G > 128 ? F.G - 128 : F.G;
            LAS float* Kt = (LAS float*)F.lds;
            LAS float* Ere = Kt + S5L * 256; LAS float* Eim = Ere + 4 * 64;
            LAS float* Cr = Eim + 4 * 64; LAS float* Ci = Cr + 1024;
            for (int un = first; un >= 0 && un < 256; un += stride) {
                const int g = un >> 3, j = un & 7, ntau = 4 * j + 4;
                __syncthreads();
                for (int i = F.tid; i < ntau * 64; i += NTHR) *(LAS f32x4*)(Kt + 4 * i) = *(const f32x4*)(KTAB + (size_t)g * S5L * 256 + 4 * i);
                for (int i = F.tid; i < 1024; i += NTHR) { Cr[i] = args.in[8][g * 1024 + i]; Ci[i] = args.in[9][g * 1024 + i]; }
                if (F.tid < 256) { const int tl = F.tid >> 6, n = F.tid & 63; const float tau = (float)(4 * j + tl + 1); const float dt = __expf(args.in[3][g]);
                    const float are = fminf(args.in[4][g * 64 + n], -1e-4f), aim = args.in[5][g * 64 + n];
                    const float mag = __expf(tau * dt * are); float sn, cs; fcis(tau * dt * aim, &sn, &cs); Ere[F.tid] = mag * cs; Eim[F.tid] = mag * sn; }
                __syncthreads();
                for (int ch = F.tid; ch < 64 * (S5K / 8); ch += NTHR) {
                    const int rl = ch / (S5K / 8), c8 = ch % (S5K / 8), tl = rl >> 4, t = 4 * j + tl, p = rl & 15, col = c8 * 8;
                    float v[8];
                    if (col < S5KIN) { const int sidx = col >> 4, q0 = col & 15;
                        if (sidx <= t) { const f32x4 k0 = *(const LAS f32x4*)(Kt + (t - sidx) * 256 + p * 16 + q0), k1 = *(const LAS f32x4*)(Kt + (t - sidx) * 256 + p * 16 + q0 + 4);
                            v[0] = k0.x; v[1] = k0.y; v[2] = k0.z; v[3] = k0.w; v[4] = k1.x; v[5] = k1.y; v[6] = k1.z; v[7] = k1.w; }
                        else {
#pragma unroll
                            for (int i = 0; i < 8; ++i) v[i] = 0.f; }
                    } else { const int jj = (col - S5KIN) & 63, im = (col - S5KIN) >> 6;
#pragma unroll
                        for (int i = 0; i < 8; ++i) { const int n = jj + i; const float cr = Cr[p * 64 + n], ci = Ci[p * 64 + n], er = Ere[tl * 64 + n], ei = Eim[tl * 64 + n];
                            v[i] = im ? -(cr * ei + ci * er) : (cr * er - ci * ei); } }
                    u32x4 o; o.x = pk2(v[0], v[1]); o.y = pk2(v[2], v[3]); o.z = pk2(v[4], v[5]); o.w = pk2(v[6], v[7]);
                    *(u32x4*)(S5BT + ((size_t)g * S5KIN + 64 * j + rl) * S5K + col) = o;
                }
            }
            __syncthreads();
        }
    }
    if (IN(3)) {
        { int tq_ = threadIdx.x; asm volatile("" : "+v"(tq_)); F.tid = tq_; F.lane = tq_ & 63; }
        typedef short s16x4 __attribute__((ext_vector_type(4)));
        LAS float* wsl = (LAS float*)F.lds;
        LAS float* red = wsl + 512;
        LAS float* dnl = red + 32;
        LAS bf16* RQ = (LAS bf16*)(F.lds + 4352);
        LAS bf16* RK = RQ + 67 * 136;
        LAS bf16* RV = RK + 67 * 136;
        LAS bf16* KN = RK + 3 * 136;
        LAS bf16* KTl = RV + 64 * 136;
        LAS bf16* VTl = KTl + 128 * 72;
        const float* cw = args.in[13]; const float* cbias = args.in[14];
        for (int un = blockIdx.x; un < 256; un += F.G) {
            const int bh = un >> 4, seg = un & 15, b = bh >> 2, hd = bh & 3, t0 = seg * 512; const size_t row0 = (size_t)b * SEQ + t0;
            float Fl, Aval;
            {
                const float ipre = gates[(row0 + F.tid) * 8 + hd], fpre = gates[(row0 + F.tid) * 8 + 4 + hd];
                const float lf = fminf(fpre, 0.f) - log1pf(__expf(-fabsf(fpre)));
                float sc = lf;
#pragma unroll
                for (int o = 1; o < 64; o <<= 1) { const float tv = __shfl_up(sc, o); if (F.lane >= o) sc += tv; }
                if (F.lane == 63) red[F.wave] = sc;
                __syncthreads();
                float base = 0.f;
                for (int w2 = 0; w2 < F.wave; ++w2) base += red[w2];
                Fl = sc + base; Aval = ipre - Fl;
                float mx = Aval;
#pragma unroll
                for (int o = 1; o < 64; o <<= 1) mx = fmaxf(mx, __shfl_xor(mx, o));
                if (F.lane == 0) red[8 + F.wave] = mx;
                __syncthreads();
                float Amax = red[8];
                for (int w2 = 1; w2 < 8; ++w2) Amax = fmaxf(Amax, red[8 + w2]);
                wsl[F.tid] = __expf(Aval - Amax);
                FLOC[(size_t)bh * SEQ + t0 + F.tid] = Fl;
                if (F.tid == 511) { SEGS[un * 4 + 0] = Fl; SEGS[un * 4 + 1] = Amax; }
            }
            f32x16 dacc[2];
#pragma unroll
            for (int i = 0; i < 2; ++i)
#pragma unroll
                for (int q = 0; q < 16; ++q) dacc[i][q] = 0.f;
            const int cp = F.tid & 127, isk = cp >> 6, c2 = (cp & 63) * 2, tqr = F.tid >> 7;
            const int gch = isk * 512 + hd * 128 + c2;
            const float cw0a = cw[gch], cw1a = cw[1024 + gch], cw2a = cw[2048 + gch], cw3a = cw[3072 + gch], cba = cbias[gch];
            const float cw0b = cw[gch + 1], cw1b = cw[1024 + gch + 1], cw2b = cw[2048 + gch + 1], cw3b = cw[3072 + gch + 1], cbb = cbias[gch + 1];
            float dnacc0 = 0.f, dnacc1 = 0.f;
            u32x4 rt[7];
#define ML_RAW_LOAD(tsv) do { _Pragma("unroll") for (int ii = 0; ii < 7; ++ii) { const int ch = F.tid + NTHR * ii; u32x4 v = (u32x4){0u, 0u, 0u, 0u}; \
                if (ch < 2 * 67 * 16) { const int which = ch / (67 * 16), r = (ch % (67 * 16)) >> 4, c16 = ch & 15; const int tk = (tsv) - 3 + r; \
                    if (tk >= 0) v = *(const u32x4*)(PROJ + ((size_t)b * SEQ + tk) * NPROJ + (which ? O_K : O_Q) + hd * 128 + c16 * 8); } \
                else if (ch < 2 * 67 * 16 + 64 * 16) { const int c2 = ch - 2 * 67 * 16, r = c2 >> 4, c16 = c2 & 15; v = *(const u32x4*)(PROJ + ((size_t)b * SEQ + (tsv) + r) * NPROJ + O_V + hd * 128 + c16 * 8); } \
                rt[ii] = v; } } while (0)
            ML_RAW_LOAD(t0);
            for (int sb = 0; sb < 8; ++sb) {
                const int ts = t0 + sb * 64;
                __syncthreads();
#pragma unroll
                for (int ii = 0; ii < 7; ++ii) { const int ch = F.tid + NTHR * ii;
                    if (ch < 2 * 67 * 16) { const int which = ch / (67 * 16), r = (ch % (67 * 16)) >> 4, c16 = ch & 15; *(LAS u32x4*)((which ? RK : RQ) + r * 136 + c16 * 8) = rt[ii]; }
                    else if (ch < 2 * 67 * 16 + 64 * 16) { const int c2 = ch - 2 * 67 * 16, r = c2 >> 4, c16 = c2 & 15; *(LAS u32x4*)(RV + r * 136 + c16 * 8) = rt[ii]; } }
                if (sb < 7) ML_RAW_LOAD(ts + 64);
                __syncthreads();
                {
                    LAS unsigned* raw = (LAS unsigned*)(isk ? RK : RQ) + c2 / 2; const int s0 = tqr * 16;
                    const unsigned h0 = raw[(s0 + 0) * 68], h1 = raw[(s0 + 1) * 68], h2 = raw[(s0 + 2) * 68];
                    float x3a = lo_bf(h0), x3b = hi_bf(h0), x2a = lo_bf(h1), x2b = hi_bf(h1), x1a = lo_bf(h2), x1b = hi_bf(h2);
                    __syncthreads();
#pragma unroll 4
                    for (int sidx = s0; sidx < s0 + 16; ++sidx) {
                        const unsigned xw = raw[(sidx + 3) * 68]; const float xa = lo_bf(xw), xb = hi_bf(xw);
                        float va = cba + cw0a * x3a + cw1a * x2a + cw2a * x1a + cw3a * xa, vb = cbb + cw0b * x3b + cw1b * x2b + cw2b * x1b + cw3b * xb;
                        x3a = x2a; x2a = x1a; x1a = xa; x3b = x2b; x2b = x1b; x1b = xb;
                        va *= sigmoidf_(va); vb *= sigmoidf_(vb);
                        if (isk) { const float wk = 0.08838834764831845f * wsl[sb * 64 + sidx]; va *= wk; vb *= wk; dnacc0 += va; dnacc1 += vb; }
                        raw[(sidx + 3) * 68] = cvt_pk_bf16(va, vb);
                    }
                }
                __syncthreads();
#pragma unroll
                for (int ii = 0; ii < 2; ++ii) { const int ch = F.tid + NTHR * ii, r = ch >> 4, c16 = ch & 15;
                    *(u32x4*)(QH + ((size_t)bh * SEQ + ts + r) * 128 + c16 * 8) = *(const LAS u32x4*)(RQ + (r + 3) * 136 + c16 * 8);
                    *(u32x4*)(KH + ((size_t)bh * SEQ + ts + r) * 128 + c16 * 8) = *(const LAS u32x4*)(RK + (r + 3) * 136 + c16 * 8); }
                {
                    const int c = F.tid & 127, sq = F.tid >> 7;
#pragma unroll
                    for (int half = 0; half < 2; ++half) { const int sA = sq * 16 + half * 8;
                        u32x4 kk, vv;
                        kk.x = (unsigned)KN[(sA + 0) * 136 + c] | ((unsigned)KN[(sA + 1) * 136 + c] << 16); kk.y = (unsigned)KN[(sA + 2) * 136 + c] | ((unsigned)KN[(sA + 3) * 136 + c] << 16);
                        kk.z = (unsigned)KN[(sA + 4) * 136 + c] | ((unsigned)KN[(sA + 5) * 136 + c] << 16); kk.w = (unsigned)KN[(sA + 6) * 136 + c] | ((unsigned)KN[(sA + 7) * 136 + c] << 16);
                        vv.x = (unsigned)RV[(sA + 0) * 136 + c] | ((unsigned)RV[(sA + 1) * 136 + c] << 16); vv.y = (unsigned)RV[(sA + 2) * 136 + c] | ((unsigned)RV[(sA + 3) * 136 + c] << 16);
                        vv.z = (unsigned)RV[(sA + 4) * 136 + c] | ((unsigned)RV[(sA + 5) * 136 + c] << 16); vv.w = (unsigned)RV[(sA + 6) * 136 + c] | ((unsigned)RV[(sA + 7) * 136 + c] << 16);
                        *(LAS u32x4*)(KTl + c * 72 + sA) = kk; *(LAS u32x4*)(VTl + c * 72 + sA) = vv; }
                }
                __syncthreads();
                {
                    const int e = F.tid >> 2, part = F.tid & 3;
                    const u32x4 v0 = *(const LAS u32x4*)(VTl + e * 72 + part * 16), v1 = *(const LAS u32x4*)(VTl + e * 72 + part * 16 + 8);
                    bf16* dst = VT + ((size_t)bh * 128 + e) * SEQ + ts + part * 16;
                    *(u32x4*)dst = v0; *(u32x4*)(dst + 8) = v1;
                    const int eb = F.wave >> 1, db0 = (F.wave & 1) * 2, r = F.lane & 31, hh = F.lane >> 5;
#pragma unroll
                    for (int ks = 0; ks < 4; ++ks) {
                        const bf16x8 a = *(const LAS bf16x8*)(VTl + (eb * 32 + r) * 72 + ks * 16 + hh * 8);
                        const bf16x8 b0 = *(const LAS bf16x8*)(KTl + (db0 * 32 + r) * 72 + ks * 16 + hh * 8), b1 = *(const LAS bf16x8*)(KTl + ((db0 + 1) * 32 + r) * 72 + ks * 16 + hh * 8);
                        dacc[0] = __builtin_amdgcn_mfma_f32_32x32x16_bf16(a, b0, dacc[0], 0, 0, 0);
                        dacc[1] = __builtin_amdgcn_mfma_f32_32x32x16_bf16(a, b1, dacc[1], 0, 0, 0);
                    }
                }
            }
#undef ML_RAW_LOAD
            if (isk) { dnl[tqr * 128 + c2] = dnacc0; dnl[tqr * 128 + c2 + 1] = dnacc1; }
            {
                const int eb = F.wave >> 1, db0 = (F.wave & 1) * 2, r = F.lane & 31, hh = F.lane >> 5;
#pragma unroll
                for (int i = 0; i < 2; ++i)
#pragma unroll
                    for (int q = 0; q < 16; ++q) DC[((size_t)un * 128 + eb * 32 + (q & 3) + 8 * (q >> 2) + 4 * hh) * 128 + (db0 + i) * 32 + r] = dacc[i][q];
            }
            __syncthreads();
            if (F.tid < 128) DN[un * 128 + F.tid] = (dnl[F.tid] + dnl[128 + F.tid]) + (dnl[256 + F.tid] + dnl[384 + F.tid]);
            __syncthreads();
        }
        if (BOTH(3)) GRID_BAR();
    }
    if (IN(4)) {
        { int tq_ = threadIdx.x; asm volatile("" : "+v"(tq_)); F.tid = tq_; F.lane = tq_ & 63; }
        LAS float* agr = (LAS float*)F.lds; LAS float* agi = agr + 512;
        for (int un = blockIdx.x; un < 128; un += F.G) {
            const int b = un >> 5, g = un & 31, n = F.tid & 63, seg = F.tid >> 6;
            const float dt = __expf(args.in[3][g]);
            const float are = fminf(args.in[4][g * 64 + n], -1e-4f), aim = args.in[5][g * 64 + n];
            float ar, ai, Ar, Ai;
            { const float mag = __expf((float)S5L * dt * are); float sn, cs; fcis((float)S5L * dt * aim, &sn, &cs); ar = mag * cs; ai = mag * sn; }
            { const float mag = __expf((float)(S5L * 32) * dt * are); float sn, cs; fcis((float)(S5L * 32) * dt * aim, &sn, &cs); Ar = mag * cs; Ai = mag * sn; }
            const size_t row0 = (size_t)g * S5ROWS + b * S5NCH + seg * 32;
            float xr[32], xi[32];
#pragma unroll
            for (int jj = 0; jj < 32; ++jj) { xr[jj] = XLOC[(row0 + jj) * 128 + n]; xi[jj] = XLOC[(row0 + jj) * 128 + 64 + n]; }
            float sr = 0.f, si = 0.f;
#pragma unroll
            for (int jj = 0; jj < 32; ++jj) { const float tr = ar * sr - ai * si + xr[jj], ti = ar * si + ai * sr + xi[jj]; sr = tr; si = ti; }
            agr[seg * 64 + n] = sr; agi[seg * 64 + n] = si;
            __syncthreads();
            float cr = 0.f, ci = 0.f;
            for (int s2 = 0; s2 < seg; ++s2) { const float tr = Ar * cr - Ai * ci + agr[s2 * 64 + n], ti = Ar * ci + Ai * cr + agi[s2 * 64 + n]; cr = tr; ci = ti; }
#pragma unroll
            for (int jj = 0; jj < 32; ++jj) {
                S5A[(row0 + jj) * S5K + S5KIN + n] = f2bf(cr); S5A[(row0 + jj) * S5K + S5KIN + 64 + n] = f2bf(ci);
                const float tr = ar * cr - ai * ci + xr[jj], ti = ar * ci + ai * cr + xi[jj]; cr = tr; ci = ti; }
            __syncthreads();
        }
        for (int un = blockIdx.x; un < 256; un += F.G) {
            const int bh = un >> 4, slice = un & 15;
            float dc0[16], dc1[16];
#pragma unroll
            for (int j = 0; j < 16; ++j) { dc0[j] = DC[((size_t)(bh * 16 + j)) * 16384 + slice * 1024 + F.tid]; dc1[j] = DC[((size_t)(bh * 16 + j)) * 16384 + slice * 1024 + 512 + F.tid]; }
            float dn[16];
            const bool nrole = (slice == 0 && F.tid < 128);
#pragma unroll
            for (int j = 0; j < 16; ++j) dn[j] = nrole ? DN[(bh * 16 + j) * 128 + F.tid] : 0.f;
            float m = 0.f, C0 = 0.f, C1 = 0.f, nn = 0.f;
#pragma unroll
            for (int j = 0; j < 16; ++j) {
                const float Fend = SEGS[(bh * 16 + j) * 4 + 0], Amax = SEGS[(bh * 16 + j) * 4 + 1];
                const float R = fmaxf(m, Amax), c1 = __expf(m - R), c2 = __expf(Amax - R);
                CST[((size_t)(bh * 16 + j)) * 16384 + slice * 1024 + F.tid] = f2bf(c1 * C0); CST[((size_t)(bh * 16 + j)) * 16384 + slice * 1024 + 512 + F.tid] = f2bf(c1 * C1);
                if (nrole) NST[(bh * 16 + j) * 128 + F.tid] = c1 * nn;
                if (slice == 0 && F.tid == 0) { SEGS[(bh * 16 + j) * 4 + 2] = R; SEGS[(bh * 16 + j) * 4 + 3] = c2; }
                C0 = c1 * C0 + c2 * dc0[j]; C1 = c1 * C1 + c2 * dc1[j]; nn = c1 * nn + c2 * dn[j]; m = Fend + R;
            }
        }
        if (BOTH(4)) GRID_BAR();
    }
    if (IN(5)) {
        { int tq_ = threadIdx.x; asm volatile("" : "+v"(tq_)); F.tid = tq_; F.lane = tq_ & 63; }
        pg::S5Sched S{(const char*)S5A, (const char*)S5BT, S5K * 2, S5K * 2, S5KIN, 2, F.G, F.vcu};
        pg::EpiS5Y E{S5A, args.in[10], GY};
        pg::gemm_phase<pg::EpiS5Y, pg::S5Sched, true>(F.lds, S5K, S, E);
        if (BOTH(5)) GRID_BAR();
    }
    if (IN(6)) {
        { int tq_ = threadIdx.x; asm volatile("" : "+v"(tq_)); F.tid = tq_; F.lane = tq_ & 63; }
        typedef short s16x4 __attribute__((ext_vector_type(4)));
        LAS bf16* Kl = (LAS bf16*)F.lds;
        LAS bf16* Vl = Kl + 2 * 64 * 136;
        LAS bf16* Cl = Vl + 2 * 128 * 72;
        LAS float* nl = (LAS float*)(Cl + 128 * 136);
        LAS float* fll = nl + 128;
        LAS float* gl = fll + 512;
        const float* ng = args.in[16];
        for (int un = blockIdx.x; un < 256; un += F.G) {
            int tid6 = F.tid; asm volatile("" : "+v"(tid6));
            const int lane6 = tid6 & 63;
            const int bh = un >> 4, seg = un & 15, b = bh >> 2, hd = bh & 3, t0 = seg * 512;
            const float R = SEGS[un * 4 + 2], c2 = SEGS[un * 4 + 3];
            __syncthreads();
            for (int ch = tid6; ch < 2048; ch += NTHR) { const int r = ch >> 4, c16 = ch & 15; *(LAS u32x4*)(Cl + r * 136 + c16 * 8) = *(const u32x4*)(CST + (size_t)un * 16384 + r * 128 + c16 * 8); }
            if (tid6 < 128) { nl[tid6] = NST[un * 128 + tid6]; gl[tid6] = ng[hd * 128 + tid6]; }
            fll[tid6] = FLOC[(size_t)bh * SEQ + t0 + tid6];
            const int r = lane6 & 31, hh = lane6 >> 5;
            for (int pass = 0; pass < 2; ++pass) {
                const int qb = pass == 0 ? F.wave : 15 - F.wave, jmax = qb >> 1, npj = pass == 0 ? 4 : 8;
                bf16x8 Q[8];
                { const bf16* qp = QH + ((size_t)bh * SEQ + t0 + qb * 32 + r) * 128 + hh * 8;
#pragma unroll
                  for (int ks = 0; ks < 8; ++ks) Q[ks] = *(const bf16x8*)(qp + ks * 16); }
                u32x4 pk0, pk1, pv0, pv1;
                { const int kr = tid6 >> 4, kc = tid6 & 15; const bf16* kp = KH + ((size_t)bh * SEQ + t0) * 128; pk0 = *(const u32x4*)(kp + kr * 128 + kc * 8); pk1 = *(const u32x4*)(kp + (kr + 32) * 128 + kc * 8);
                  const int vr = tid6 >> 3, vc = tid6 & 7; const bf16* vp = VT + (size_t)bh * 128 * SEQ + t0; pv0 = *(const u32x4*)(vp + (size_t)vr * SEQ + vc * 8); pv1 = *(const u32x4*)(vp + (size_t)(vr + 64) * SEQ + vc * 8); }
                f32x16 acc[4];
#pragma unroll
                for (int eb = 0; eb < 4; ++eb)
#pragma unroll
                    for (int q = 0; q < 16; ++q) acc[eb][q] = 0.f;
                __syncthreads();
#pragma unroll
                for (int eb = 0; eb < 4; ++eb) {
#pragma unroll
                    for (int ks = 0; ks < 8; ++ks) { const bf16x8 a = *(const LAS bf16x8*)(Cl + (eb * 32 + r) * 136 + ks * 16 + hh * 8); acc[eb] = __builtin_amdgcn_mfma_f32_32x32x16_bf16(a, Q[ks], acc[eb], 0, 0, 0); }
                    __builtin_amdgcn_sched_barrier(0);
                }
                float den = 0.f;
#pragma unroll
                for (int ks = 0; ks < 8; ++ks) {
#pragma unroll
                    for (int jj = 0; jj < 8; ++jj) den += nl[ks * 16 + hh * 8 + jj] * bf2f((bf16)Q[ks][jj]);
                    __builtin_amdgcn_sched_barrier(0);
                }
                float dsum = 0.f;
                for (int j = 0; j < npj; ++j) {
                    LAS bf16* Kb = Kl + (j & 1) * 64 * 136; LAS bf16* Vb = Vl + (j & 1) * 128 * 72;
                    { const int kr = tid6 >> 4, kc = tid6 & 15; *(LAS u32x4*)(Kb + kr * 136 + kc * 8) = pk0; *(LAS u32x4*)(Kb + (kr + 32) * 136 + kc * 8) = pk1;
                      const int vr = tid6 >> 3, vc = tid6 & 7; *(LAS u32x4*)(Vb + vr * 72 + vc * 8) = pv0; *(LAS u32x4*)(Vb + (vr + 64) * 72 + vc * 8) = pv1; }
                    if (j + 1 < npj) { const int kr = tid6 >> 4, kc = tid6 & 15; const bf16* kp = KH + ((size_t)bh * SEQ + t0 + (j + 1) * 64) * 128; pk0 = *(const u32x4*)(kp + kr * 128 + kc * 8); pk1 = *(const u32x4*)(kp + (kr + 32) * 128 + kc * 8);
                        const int vr = tid6 >> 3, vc = tid6 & 7; const bf16* vp = VT + (size_t)bh * 128 * SEQ + t0 + (j + 1) * 64; pv0 = *(const u32x4*)(vp + (size_t)vr * SEQ + vc * 8); pv1 = *(const u32x4*)(vp + (size_t)(vr + 64) * SEQ + vc * 8); }
                    __syncthreads();
                    if (j <= jmax) {
                        const bool diag = (j == jmax); const int tq = qb * 32 + r;
#pragma unroll
                        for (int sb = 0; sb < 2; ++sb) {
                            f32x16 st;
#pragma unroll
                            for (int q = 0; q < 16; ++q) st[q] = 0.f;
#pragma unroll
                            for (int ks = 0; ks < 8; ++ks) { const bf16x8 a = *(const LAS bf16x8*)(Kb + (sb * 32 + r) * 136 + ks * 16 + hh * 8); st = __builtin_amdgcn_mfma_f32_32x32x16_bf16(a, Q[ks], st, 0, 0, 0); }
                            bf16x8 pb[2];
#pragma unroll
                            for (int sp = 0; sp < 2; ++sp) {
                                float pv[8];
#pragma unroll
                                for (int jj = 0; jj < 8; ++jj) { const int q = 8 * sp + jj; const int sidx = j * 64 + sb * 32 + (q & 3) + 8 * (q >> 2) + 4 * hh;
                                    float p = st[q] * c2; if (diag && sidx > tq) p = 0.f; pv[jj] = p; dsum += p; }
                                u32x4 w; w.x = cvt_pk_bf16(pv[0], pv[1]); w.y = cvt_pk_bf16(pv[2], pv[3]); w.z = cvt_pk_bf16(pv[4], pv[5]); w.w = cvt_pk_bf16(pv[6], pv[7]);
                                pb[sp] = __builtin_bit_cast(bf16x8, w);
                            }
#pragma unroll
                            for (int eb = 0; eb < 4; ++eb)
#pragma unroll
                                for (int sp = 0; sp < 2; ++sp) {
                                    const int so = sb * 32 + 16 * sp + 4 * hh;
                                    const s16x4 lo = *(const LAS s16x4*)(Vb + (eb * 32 + r) * 72 + so), hi = *(const LAS s16x4*)(Vb + (eb * 32 + r) * 72 + so + 8);
                                    const bf16x8 a = __builtin_shufflevector(lo, hi, 0, 1, 2, 3, 4, 5, 6, 7);
                                    acc[eb] = __builtin_amdgcn_mfma_f32_32x32x16_bf16(a, pb[sp], acc[eb], 0, 0, 0);
                                }
                            __builtin_amdgcn_sched_barrier(0);
                        }
                    }
                }
                den += dsum; den += __shfl_xor(den, 32);
                const float flo = __expf(-fll[qb * 32 + r] - R);
                const float inv = 1.f / fmaxf(fabsf(den), flo);
                float s1 = 0.f;
#pragma unroll
                for (int eb = 0; eb < 4; ++eb)
#pragma unroll
                    for (int q = 0; q < 16; ++q) { acc[eb][q] *= inv; s1 += acc[eb][q]; }
                s1 += __shfl_xor(s1, 32);
                const float mu = s1 * (1.f / 128.f);
                float s2 = 0.f;
#pragma unroll
                for (int eb = 0; eb < 4; ++eb)
#pragma unroll
                    for (int q = 0; q < 16; ++q) { const float dlt = acc[eb][q] - mu; s2 += dlt * dlt; }
                s2 += __shfl_xor(s2, 32);
                const float rstd = rsqrtf(s2 * (1.f / 128.f) + 1e-6f);
                const size_t row = (size_t)b * SEQ + t0 + qb * 32 + r;
                uint2 ovv[16];
#pragma unroll
                for (int eb = 0; eb < 4; ++eb)
#pragma unroll
                    for (int g4 = 0; g4 < 4; ++g4) ovv[eb * 4 + g4] = *(const uint2*)(PROJ + row * NPROJ + O_O + hd * 128 + eb * 32 + 8 * g4 + 4 * hh);
#pragma unroll
                for (int eb = 0; eb < 4; ++eb)
#pragma unroll
                    for (int g4 = 0; g4 < 4; ++g4) {
                        const int e0 = eb * 32 + 8 * g4 + 4 * hh;
                        const uint2 ov = ovv[eb * 4 + g4];
                        const f32x4 gg = *(const LAS f32x4*)(gl + e0);
                        const float o0 = (acc[eb][4 * g4 + 0] - mu) * rstd * gg.x * sigmoidf_(lo_bf(ov.x)), o1 = (acc[eb][4 * g4 + 1] - mu) * rstd * gg.y * sigmoidf_(hi_bf(ov.x));
                        const float o2 = (acc[eb][4 * g4 + 2] - mu) * rstd * gg.z * sigmoidf_(lo_bf(ov.y)), o3 = (acc[eb][4 * g4 + 3] - mu) * rstd * gg.w * sigmoidf_(hi_bf(ov.y));
                        uint2 w; w.x = cvt_pk_bf16(o0, o1); w.y = cvt_pk_bf16(o2, o3);
                        *(uint2*)(MIX + row * D + 512 + hd * 128 + e0) = w;
                    }
            }
        }
    }
    if (IN(7)) {
        { int tq_ = threadIdx.x; asm volatile("" : "+v"(tq_)); F.tid = tq_; F.lane = tq_ & 63; }
        pg::DenseSched S{(const char*)GY, (const char*)WGLU, 512 * 2, 512 * 2, T / 256, 2, F.G, (int)blockIdx.x};
        pg::EpiGlu E{GY, args.in[12], MIX};
        pg::gemm_phase<pg::EpiGlu, pg::DenseSched, true>(F.lds, 512, S, E);
        if (BOTH(7)) GRID_BAR();
    }
    if (IN(8)) {
        { int tq_ = threadIdx.x; asm volatile("" : "+v"(tq_)); F.tid = tq_; F.lane = tq_ & 63; }
        pg::DenseSched S{(const char*)MIX, (const char*)WOUT, D * 2, D * 2, T / 256, D / 256, F.G, (int)blockIdx.x};
        pg::EpiOut E{x, H};
        pg::gemm_phase<pg::EpiOut, pg::DenseSched, true>(F.lds, D, S, E);
        if (BOTH(8)) GRID_BAR();
    }
    if (IN(9)) {
        { int tq_ = threadIdx.x; asm volatile("" : "+v"(tq_)); F.tid = tq_; F.lane = tq_ & 63; }
        const float* gf = args.in[18]; const float* w_r = args.in[19]; const float* b_r = args.in[20];
        LAS float* rs = (LAS float*)(F.lds);
        LAS float* part = (LAS float*)(F.lds + 1024);
        LAS int* hist = (LAS int*)(F.lds + 1024 + 2 * 128 * 33 * 4);
        for (int tb = blockIdx.x; tb < T / 128; tb += F.G) {
            const int row0 = tb * 128;
            if (F.tid < 32) hist[F.tid] = 0;
            {
                f32x4 gg[4];
#pragma unroll
                for (int jq = 0; jq < 4; ++jq) gg[jq] = *(const f32x4*)(gf + 4 * F.lane + 256 * jq);
                f32x4 nx[4];
#pragma unroll
                for (int jq = 0; jq < 4; ++jq) nx[jq] = ldbf4(H + (size_t)(row0 + F.wave * 16) * D + 4 * F.lane + 256 * jq);
                for (int rr = 0; rr < 16; ++rr) {
                    const int r = F.wave * 16 + rr;
                    f32x4 v[4];
#pragma unroll
                    for (int jq = 0; jq < 4; ++jq) v[jq] = nx[jq];
                    if (rr < 15) {
#pragma unroll
                        for (int jq = 0; jq < 4; ++jq) nx[jq] = ldbf4(H + (size_t)(row0 + r + 1) * D + 4 * F.lane + 256 * jq); }
                    float ss = 0.f;
#pragma unroll
                    for (int jq = 0; jq < 4; ++jq) ss += v[jq].x * v[jq].x + v[jq].y * v[jq].y + v[jq].z * v[jq].z + v[jq].w * v[jq].w;
                    ss = wave_sum(ss);
                    const float rstd = rsqrtf(ss * (1.f / D) + 1e-5f);
                    if (F.lane == 0) rs[r] = rstd;
#pragma unroll
                    for (int jq = 0; jq < 4; ++jq) *(unsigned*)(HN8 + (size_t)(row0 + r) * D + 4 * F.lane + 256 * jq) = pk4_fp8(v[jq].x * rstd * gg[jq].x, v[jq].y * rstd * gg[jq].y, v[jq].z * rstd * gg[jq].z, v[jq].w * rstd * gg[jq].w);
                }
            }
            {
                const int rg = F.wave & 3, kh = F.wave >> 2, i = F.lane & 31, hh = F.lane >> 5;
                f32x16 acc;
#pragma unroll
                for (int q = 0; q < 16; ++q) acc[q] = 0.f;
                const bf16* hp = H + (size_t)(row0 + rg * 32 + i) * D + kh * 512 + 4 * hh;
                const float* wp = w_r + (size_t)(kh * 512 + 4 * hh) * NE + i; const float* gp = gf + kh * 512 + 4 * hh;
                f32x4 a0[4], g0[4], a1[4], g1[4]; f32x4 w0[4], w1[4];
#pragma unroll
                for (int u = 0; u < 4; ++u) { a0[u] = ldbf4(hp + 8 * u); g0[u] = *(const f32x4*)(gp + 8 * u);
                    w0[u] = (f32x4){wp[(size_t)(8 * u + 0) * NE], wp[(size_t)(8 * u + 1) * NE], wp[(size_t)(8 * u + 2) * NE], wp[(size_t)(8 * u + 3) * NE]}; }
                for (int k0 = 0; k0 < 512; k0 += 64) {
#pragma unroll
                    for (int u = 0; u < 4; ++u) { const int kk = k0 + 32 + 8 * u; a1[u] = ldbf4(hp + kk); g1[u] = *(const f32x4*)(gp + kk);
                        w1[u] = (f32x4){wp[(size_t)(kk + 0) * NE], wp[(size_t)(kk + 1) * NE], wp[(size_t)(kk + 2) * NE], wp[(size_t)(kk + 3) * NE]}; }
#pragma unroll
                    for (int u = 0; u < 4; ++u) { const f32x4 bb = w0[u] * g0[u];
                        acc = __builtin_amdgcn_mfma_f32_32x32x2f32(a0[u].x, bb.x, acc, 0, 0, 0); acc = __builtin_amdgcn_mfma_f32_32x32x2f32(a0[u].y, bb.y, acc, 0, 0, 0);
                        acc = __builtin_amdgcn_mfma_f32_32x32x2f32(a0[u].z, bb.z, acc, 0, 0, 0); acc = __builtin_amdgcn_mfma_f32_32x32x2f32(a0[u].w, bb.w, acc, 0, 0, 0); }
                    if (k0 + 64 < 512) {
#pragma unroll
                        for (int u = 0; u < 4; ++u) { const int kk = k0 + 64 + 8 * u; a0[u] = ldbf4(hp + kk); g0[u] = *(const f32x4*)(gp + kk);
                            w0[u] = (f32x4){wp[(size_t)(kk + 0) * NE], wp[(size_t)(kk + 1) * NE], wp[(size_t)(kk + 2) * NE], wp[(size_t)(kk + 3) * NE]}; } }
#pragma unroll
                    for (int u = 0; u < 4; ++u) { const f32x4 bb = w1[u] * g1[u];
                        acc = __builtin_amdgcn_mfma_f32_32x32x2f32(a1[u].x, bb.x, acc, 0, 0, 0); acc = __builtin_amdgcn_mfma_f32_32x32x2f32(a1[u].y, bb.y, acc, 0, 0, 0);
                        acc = __builtin_amdgcn_mfma_f32_32x32x2f32(a1[u].z, bb.z, acc, 0, 0, 0); acc = __builtin_amdgcn_mfma_f32_32x32x2f32(a1[u].w, bb.w, acc, 0, 0, 0); }
                }
#pragma unroll
                for (int q = 0; q < 16; ++q) { const int r = rg * 32 + (q & 3) + 8 * (q >> 2) + 4 * hh; part[(kh * 128 + r) * 33 + i] = acc[q]; }
            }
            __syncthreads();
            if (F.tid < 128) {
                const int r = F.tid; const float rstd = rs[r];
                float best[4]; int bi[4];
                for (int e = 0; e < 32; ++e) part[r * 33 + e] = (part[r * 33 + e] + part[(128 + r) * 33 + e]) * rstd + b_r[e];
#pragma unroll
                for (int k = 0; k < 4; ++k) {
                    float bv = -INFINITY; int be = 0;
                    for (int e = 0; e < 32; ++e) { const float l = part[r * 33 + e]; if (l > bv) { bv = l; be = e; } }
                    best[k] = bv; bi[k] = be; part[r * 33 + be] = -INFINITY;
                }
                const float e1 = __expf(best[1] - best[0]), e2 = __expf(best[2] - best[0]), e3 = __expf(best[3] - best[0]);
                const float inv = 1.f / (1.f + e1 + e2 + e3);
                *(int4*)(topi + (size_t)(row0 + r) * 4) = make_int4(bi[0], bi[1], bi[2], bi[3]);
                *(f32x4*)(topg + (size_t)(row0 + r) * 4) = (f32x4){inv, e1 * inv, e2 * inv, e3 * inv};
#pragma unroll
                for (int k = 0; k < 4; ++k) __hip_atomic_fetch_add(&hist[bi[k]], 1, __ATOMIC_RELAXED, __HIP_MEMORY_SCOPE_WORKGROUP);
            }
            __syncthreads();
            if (F.tid < 32) CNT[tb * 32 + F.tid] = hist[F.tid];
            __syncthreads();
        }
        if (BOTH(9)) GRID_BAR();
    }
    if (IN(10)) {
        { int tq_ = threadIdx.x; asm volatile("" : "+v"(tq_)); F.tid = tq_; F.lane = tq_ & 63; }
        LAS int* sb = (LAS int*)(F.lds);
        for (int tb = blockIdx.x; tb < T / 128; tb += F.G) {
            const int e = F.tid & 31, pt = F.tid >> 5;
            int sbef = 0, stot = 0;
            for (int w = pt * 16; w < pt * 16 + 16; ++w) { const int c = __hip_atomic_load(CNT + w * 32 + e, RLX_AGENT); stot += c; if (w < tb) sbef += c; }
            sb[pt * 32 + e] = sbef; sb[512 + pt * 32 + e] = stot;
            __syncthreads();
            if (F.tid < 32) { int b = 0, t = 0; for (int p = 0; p < 16; ++p) { b += sb[p * 32 + F.tid]; t += sb[512 + p * 32 + F.tid]; } sb[1024 + F.tid] = b; sb[1056 + F.tid] = t; sb[1120 + F.tid] = 0; }
            __syncthreads();
            if (F.tid == 0) { int ps = 0; for (int q = 0; q < 32; ++q) { sb[1088 + q] = ps; ps += ((sb[1056 + q] + MT - 1) / MT) * MT; } }
            __syncthreads();
            if (tb == 0 && F.tid < 32) ecnt[F.tid] = sb[1056 + F.tid];
            {
                const int a = tb * 512 + F.tid; const int ex = topi[a];
                const int lp = __hip_atomic_fetch_add(&sb[1120 + ex], 1, __ATOMIC_RELAXED, __HIP_MEMORY_SCOPE_WORKGROUP);
                const int slot = sb[1088 + ex] + sb[1024 + ex] + lp;
                slot_tok[slot] = a >> 2; tok_slot[a] = slot;
            }
            __syncthreads();
        }
        if (BOTH(10)) GRID_BAR();
    }
    if (IN(11) || IN(12)) {
        { int tq_ = threadIdx.x; asm volatile("" : "+v"(tq_)); F.tid = tq_; F.lane = tq_ & 63; }
        LAS int* til = (LAS int*)(F.lds + TIL_OFF);
        if (F.tid == 0) { int nt = 0; for (int e = 0; e < NE; ++e) { const int c = __hip_atomic_load(ecnt + e, RLX_AGENT); for (int r = 0; r < c; r += MT) { til[nt] = e; til[MAXTILES + nt] = (c - r) < MT ? (c - r) : MT; ++nt; } } til[2 * MAXTILES] = nt; }
        __syncthreads();
        if (IN(11)) {
            MoeSched S{(const char*)HN8, (const char*)WUP8, slot_tok, args.in[22], til, (LAS int*)(F.lds + IDX_OFF), (LAS float*)(F.lds + BIAS_OFF), D, D, 8, 2 * FF, F.G, (int)blockIdx.x, 1};
            pg::EpiUp E{(const LAS float*)(F.lds + BIAS_OFF), ACT8};
            pg::gemm_phase<pg::EpiUp, MoeSched, true, true>(F.lds, D, S, E);
            {
                constexpr int I_DN = (FF / 64) * (D / 64);
                LAS bf16* scr = (LAS bf16*)(F.lds + F.wave * 16384);
                LAS int* qb = (LAS int*)(F.lds + MISC_OFF + 64);
                for (;;) {
                    __syncthreads();
                    if (F.tid == 0) *qb = (int)__hip_atomic_fetch_add((unsigned*)(F.ctl + CW_QHEAD), 64u, __ATOMIC_RELAXED, __HIP_MEMORY_SCOPE_AGENT);
                    __syncthreads();
                    const int base = __builtin_amdgcn_readfirstlane(*qb);
                    if (base >= NE * I_DN) break;
                    for (int k = 0; k < 8; ++k) { const int it = base + F.wave * 8 + k; if (it >= NE * I_DN) break;
                        const int e = it / I_DN; transpose_item<true>(args.in[23] + (size_t)e * FF * D, D, FF, D / 64, WDN8 + (size_t)e * D * FF, scr, it % I_DN, F.lane, RowId()); }
                }
            }
            if (BOTH(11)) GRID_BAR();
        }
        if (IN(12)) {
            MoeSched S{(const char*)ACT8, (const char*)WDN8, slot_tok, args.in[24], til, (LAS int*)(F.lds + IDX_OFF), (LAS float*)(F.lds + BIAS_OFF), FF, FF, 4, D, F.G, (int)blockIdx.x, 0};
            pg::EpiDown E{(const LAS float*)(F.lds + BIAS_OFF), YS};
            pg::gemm_phase<pg::EpiDown, MoeSched, true, true>(F.lds, FF, S, E);
            if (BOTH(12)) GRID_BAR();
        }
    }
    if (IN(13)) {
        { int tq_ = threadIdx.x; asm volatile("" : "+v"(tq_)); F.tid = tq_; F.lane = tq_ & 63; }
        const float* gfin = args.in[25]; float* out = args.out;
        for (int row = gw; row < T; row += NGW) {
            f32x4 v[4];
#pragma unroll
            for (int j = 0; j < 4; ++j) v[j] = ldbf4(H + (size_t)row * D + 4 * F.lane + 256 * j);
            const int4 sl = *(const int4*)(tok_slot + (size_t)row * 4); const f32x4 gt = *(const f32x4*)(topg + (size_t)row * 4);
#pragma unroll
            for (int k = 0; k < 4; ++k) {
                const int s = k == 0 ? sl.x : k == 1 ? sl.y : k == 2 ? sl.z : sl.w;
#pragma unroll
                for (int j = 0; j < 4; ++j) { const unsigned y = *(const unsigned*)(YS + (size_t)s * D + 4 * F.lane + 256 * j);
                    typedef float f32x2_ __attribute__((ext_vector_type(2)));
                    const f32x2_ ylo = __builtin_amdgcn_cvt_pk_f32_fp8(y, false), yhi = __builtin_amdgcn_cvt_pk_f32_fp8(y, true);
                    v[j].x += gt[k] * ylo.x; v[j].y += gt[k] * ylo.y; v[j].z += gt[k] * yhi.x; v[j].w += gt[k] * yhi.y; }
            }
            float ss = 0.f;
#pragma unroll
            for (int j = 0; j < 4; ++j) ss += v[j].x * v[j].x + v[j].y * v[j].y + v[j].z * v[j].z + v[j].w * v[j].w;
            ss = wave_sum(ss);
            const float rstd = rsqrtf(ss * (1.f / D) + 1e-5f);
#pragma unroll
            for (int j = 0; j < 4; ++j) { const f32x4 gg = *(const f32x4*)(gfin + 4 * F.lane + 256 * j); __builtin_nontemporal_store(v[j] * rstd * gg, (f32x4*)(out + (size_t)row * D + 4 * F.lane + 256 * j)); }
        }
    }
#undef IN
#undef BOTH
}

extern "C" void kernel_launch(void* const* d_in, const int* in_sizes, int n_in, void* d_out, int out_size, void* d_ws, size_t ws_size, hipStream_t stream) {
    static int grid = 0;
    if (grid == 0) {
        int dev = 0, cus = 0, per_cu = 0;
        if (n_in != 26 || ws_size < WS_END) { fprintf(stderr, "kernel_launch: unexpected n_in %d / ws %zu\n", n_in, ws_size); grid = -1; return; }
        if (hipGetDevice(&dev) != hipSuccess || hipDeviceGetAttribute(&cus, hipDeviceAttributeMultiprocessorCount, dev) != hipSuccess) { grid = -1; return; }
        if (hipFuncSetAttribute((const void*)fwd, hipFuncAttributeMaxDynamicSharedMemorySize, LDS_BYTES) != hipSuccess) { fprintf(stderr, "kernel_launch: hipFuncSetAttribute failed\n"); grid = -1; return; }
        if (hipOccupancyMaxActiveBlocksPerMultiprocessor(&per_cu, (const void*)fwd, NTHR, LDS_BYTES) != hipSuccess || per_cu < 1) fprintf(stderr, "kernel_launch: occupancy query reports %d\n", per_cu);
        (void)hipGetLastError();
        grid = cus;
    }
    if (grid < 0) return;
    (void)in_sizes; (void)out_size;
    unsigned char* ws = (unsigned char*)d_ws;
    (void)hipMemsetAsync(ws + WS_CTL, 0, CTL_ZERO_BYTES, stream);
    Args a{};
    for (int i = 0; i < 26; ++i) a.in[i] = (const float*)d_in[i];
    a.out = (float*)d_out; a.ws = ws;
    a.ph_lo = 0; a.ph_hi = 14; a.li = 0; a.pad = 0;
    hipLaunchKernelGGL(fwd, dim3(grid), dim3(NTHR), LDS_BYTES, stream, a);
#if PROBE_LO >= 0
    a.ph_lo = PROBE_LO; a.ph_hi = PROBE_HI; a.li = 1; a.pad = PROBE_PAD;
    hipLaunchKernelGGL(fwd, dim3(grid), dim3(NTHR), LDS_BYTES, stream, a);
#endif
}
```

```cpp
#include <hip/hip_runtime.h>
#include <cstdio>
#include <cstdint>

#define GAS __attribute__((address_space(1)))
#define LAS __attribute__((address_space(3)))
typedef unsigned short bf16;
typedef short bf16x8 __attribute__((ext_vector_type(8)));
typedef float f32x4 __attribute__((ext_vector_type(4)));
typedef float f32x16 __attribute__((ext_vector_type(16)));
typedef unsigned u32x4 __attribute__((ext_vector_type(4)));
typedef unsigned u32x2 __attribute__((ext_vector_type(2)));
typedef GAS unsigned gu32;

#define PROBE_LO -1
#define PROBE_HI -1
#define PROBE_PAD 0
constexpr int NB = 4, SEQ = 8192, T = NB * SEQ, D = 1024;
constexpr int DIN = 2568, NPROJ = 2560;
constexpr int O_Q = 512, O_K = 1024, O_V = 1536, O_O = 2048, O_G = 2560;
constexpr int NE = 32, TOPK = 4, FF = 1024;
constexpr int NASSIGN = T * TOPK;
constexpr int MT = 256;
constexpr int NSLOTS = NASSIGN + NE * MT;
constexpr int MAXTILES = NSLOTS / MT;
constexpr int NWAVES = 8, NTHR = 512;
constexpr float W8_SCALE = 64.f, W8_INV = 1.f / 64.f;

constexpr size_t MiB = 1u << 20;
constexpr size_t WS_CTL = 0, CTL_ZERO_BYTES = 1 * MiB;
constexpr size_t WS_GATES = 1 * MiB;
constexpr size_t WS_TOPI = 2 * MiB;
constexpr size_t WS_TOPG = 3 * MiB;
constexpr size_t WS_SLOTTOK = 4 * MiB;
constexpr size_t WS_TOKSLOT = 5 * MiB;
constexpr size_t WS_CNT = 6 * MiB;
constexpr size_t WS_WIN = 8 * MiB;
constexpr size_t WS_WGLU = 13 * MiB;
constexpr size_t WS_WOUT = 14 * MiB;
constexpr size_t WS_WUP = 16 * MiB;
constexpr size_t WS_WDN = 144 * MiB;
constexpr size_t WS_HN = 208 * MiB;
constexpr size_t WS_PROJ = 272 * MiB;
constexpr size_t WS_GY = 432 * MiB;
constexpr size_t WS_MIX = 464 * MiB;
constexpr size_t WS_HRAW = 528 * MiB;
constexpr size_t WS_ACT = 272 * MiB;
constexpr size_t WS_H = 592 * MiB;
constexpr size_t WS_YS = 720 * MiB;
constexpr size_t WS_END = 992 * MiB;
constexpr int S5L = 32, S5KIN = S5L * 16, S5K = S5KIN + 128;
constexpr int S5NCH = SEQ / S5L, S5ROWS = NB * S5NCH;
constexpr size_t WS_S5A = 720 * MiB;
constexpr size_t WS_S5BT = 760 * MiB;
constexpr size_t WS_S5BQ = 836 * MiB;
constexpr size_t WS_XLOC = 790 * MiB;
constexpr size_t WS_QH = 866 * MiB;
constexpr size_t WS_KH = 898 * MiB;
constexpr size_t WS_VT = 930 * MiB;
constexpr size_t WS_DC = 962 * MiB;
constexpr size_t WS_CST = 978 * MiB;
constexpr size_t WS_FLOC = 986 * MiB;
constexpr size_t WS_DN = 987 * MiB;
constexpr size_t WS_NST = 988 * MiB;
constexpr size_t WS_SEGS = 989 * MiB;
constexpr size_t WS_KTAB = 990 * MiB;
static_assert(WS_S5A + (size_t)32 * S5ROWS * S5K * 2 <= WS_S5BT && WS_S5BT + (size_t)32 * S5KIN * S5K * 2 <= WS_XLOC && WS_XLOC + (size_t)32 * S5ROWS * 128 * 4 <= WS_S5BQ && WS_S5BQ + (size_t)32 * 256 * S5KIN * 2 <= WS_QH, "s5 map");
static_assert(WS_ACT + (size_t)NSLOTS * FF * 2 <= WS_H && WS_YS + (size_t)NSLOTS * D * 2 <= WS_END, "ws map");
constexpr int CW_QHEAD = 64;
constexpr int CW_BAR = 4096;

constexpr int RING_BYTES = 131072;
constexpr int MISC_OFF = RING_BYTES;
constexpr int IDX_OFF = MISC_OFF + 128;
constexpr int TIL_OFF = IDX_OFF + 2048;
constexpr int BIAS_OFF = TIL_OFF + 3 * MAXTILES * 4 + 256;
constexpr int ULIST_OFF = BIAS_OFF + 3 * 1024;
constexpr int LDS_BYTES = 147456;
static_assert(ULIST_OFF + 32 * 16 <= LDS_BYTES && (BIAS_OFF & 15) == 0, "LDS map");

#define RLX_AGENT __ATOMIC_RELAXED, __HIP_MEMORY_SCOPE_AGENT
__device__ __forceinline__ float bf2f(bf16 v) { return __uint_as_float(((unsigned)v) << 16); }
__device__ __forceinline__ bf16 f2bf(float f) { unsigned u = __float_as_uint(f); u += 0x7fffu + ((u >> 16) & 1u); return (bf16)(u >> 16); }
__device__ __forceinline__ unsigned pk2(float lo, float hi) { return (unsigned)f2bf(lo) | ((unsigned)f2bf(hi) << 16); }
__device__ __forceinline__ unsigned cvt_pk_bf16(float lo, float hi) { unsigned r; asm volatile("v_cvt_pk_bf16_f32 %0, %1, %2" : "=v"(r) : "v"(lo), "v"(hi)); return r; }
__device__ __forceinline__ unsigned pk4_fp8(float a, float b, float c, float d) { unsigned w = 0u; w = __builtin_amdgcn_cvt_pk_fp8_f32(a, b, w, false); w = __builtin_amdgcn_cvt_pk_fp8_f32(c, d, w, true); return w; }
__device__ __forceinline__ float lo_bf(unsigned u) { return __uint_as_float(u << 16); }
__device__ __forceinline__ float hi_bf(unsigned u) { return __uint_as_float(u & 0xffff0000u); }
__device__ __forceinline__ f32x4 ldbf4(const bf16* p) { const uint2 u = *(const uint2*)p; return (f32x4){lo_bf(u.x), hi_bf(u.x), lo_bf(u.y), hi_bf(u.y)}; }
__device__ __forceinline__ float wave_sum(float v) {
#pragma unroll
    for (int o = 1; o < 64; o <<= 1) v += __shfl_xor(v, o);
    return v;
}
__device__ __forceinline__ float sigmoidf_(float x) { return __builtin_amdgcn_rcpf(1.f + __builtin_amdgcn_exp2f(-1.4426950408889634f * x)); }
__device__ __forceinline__ void fcis(float x, float* sn, float* cs) { const float C = 0.15915494309189535f; const float rev = x * C; const float err = fmaf(x, C, -rev); const float fr = (rev - rintf(rev)) + err; *sn = __builtin_amdgcn_sinf(fr); *cs = __builtin_amdgcn_cosf(fr); }
__device__ __forceinline__ float gelu_tanh(float x) { const float u = 1.5957691216057308f * (x + 0.044715f * x * x * x); return x * __builtin_amdgcn_rcpf(1.f + __builtin_amdgcn_exp2f(-1.4426950408889634f * u)); }

#define XB_TMO      128
#define XB_XCNT(j)  (256  + 64 * (j))
#define XB_XSUB(j)  (1280 + 64 * (j))
#define XB_XGEN(j)  (2304 + 64 * (j))
#define XB_TOP      3328
#define XB_TOPGEN   3392
#define XCD_BAR_WORDS 3456
#define XB_SPIN_CAP (1u << 18)
__device__ __forceinline__ unsigned xb_ld(unsigned* p)              { return __hip_atomic_load(p, __ATOMIC_RELAXED, __HIP_MEMORY_SCOPE_AGENT); }
__device__ __forceinline__ unsigned xb_add(unsigned* p, unsigned v) { return __hip_atomic_fetch_add(p, v, __ATOMIC_RELAXED, __HIP_MEMORY_SCOPE_AGENT); }
__device__ __forceinline__ unsigned xb_xcc_id() { return (unsigned)__builtin_amdgcn_s_getreg((3 << 11) | 20) & 0xFu; }
#define XB_SPIN(cond, bar) do { unsigned _sp = 0; while (cond) { __builtin_amdgcn_s_sleep(1); \
    if ((++_sp & 255u) == 0u) { if (xb_ld(&(bar)[XB_TMO])) break; if (_sp > XB_SPIN_CAP) { atomicAdd(&(bar)[XB_TMO], 1u); break; } } } } while (0)
struct XcdBarrier { unsigned* bar; unsigned x; volatile LAS unsigned* st; };
__device__ __forceinline__ XcdBarrier xcd_barrier_post(unsigned* bar, volatile LAS unsigned* st) {
    XcdBarrier b; b.bar = bar; b.x = xb_xcc_id(); b.st = st;
    if (threadIdx.x == 0) (void)xb_add(&bar[XB_XCNT(b.x)], 1u);
    return b;
}
__device__ __forceinline__ void xcd_barrier_complete(unsigned* bar, unsigned x, unsigned& nloc, unsigned& nx) {
    const unsigned G = gridDim.x * gridDim.y * gridDim.z;
    unsigned sum, cnt, mine, sp = 0u;
    for (;;) {
        sum = 0u; cnt = 0u; mine = 0u;
#pragma unroll
        for (unsigned j = 0; j < 16; ++j) { const unsigned c = xb_ld(&bar[XB_XCNT(j)]); sum += c; cnt += (c > 0u) ? 1u : 0u; mine = (j == x) ? c : mine; }
        if (sum == G) break;
        __builtin_amdgcn_s_sleep(1);
        if ((++sp & 255u) == 0u) { if (xb_ld(&bar[XB_TMO])) break; if (sp > XB_SPIN_CAP) { atomicAdd(&bar[XB_TMO], 1u); break; } }
    }
    nloc = mine > 0u ? mine : 1u; nx = cnt > 0u ? cnt : 1u;
}
__device__ __forceinline__ void xcd_barrier(const XcdBarrier& b) {
    asm volatile("s_waitcnt vmcnt(0)" ::: "memory");
    __syncthreads();
    if (threadIdx.x == 0) {
        unsigned* bar = b.bar;
        __builtin_amdgcn_s_waitcnt(0);
        unsigned nloc = b.st[0], nx = b.st[1];
        if (nloc == 0u) { xcd_barrier_complete(bar, b.x, nloc, nx); b.st[0] = nloc; b.st[1] = nx; }
        const unsigned old = xb_add(&bar[XB_XSUB(b.x)], 1u);
        const unsigned gen = old / nloc;
        if (old + 1u == (gen + 1u) * nloc) {
            __builtin_amdgcn_fence(__ATOMIC_RELEASE, "agent");
            asm volatile("s_waitcnt vmcnt(0)" ::: "memory");
            const unsigned og = xb_add(&bar[XB_TOP], 1u);
            const unsigned tg = og / nx;
            if (og + 1u == (tg + 1u) * nx) xb_add(&bar[XB_TOPGEN], 1u);
            else XB_SPIN(xb_ld(&bar[XB_TOPGEN]) == tg, bar);
            __builtin_amdgcn_fence(__ATOMIC_ACQUIRE, "agent");
            xb_add(&bar[XB_XGEN(b.x)], 1u);
            asm volatile("s_waitcnt vmcnt(0)" ::: "memory");
        } else {
            XB_SPIN(xb_ld(&bar[XB_XGEN(b.x)]) == gen, bar);
            __builtin_amdgcn_fence(__ATOMIC_ACQUIRE, "agent");
            asm volatile("s_waitcnt vmcnt(0)" ::: "memory");
        }
    }
    __syncthreads();
}

namespace pg {
constexpr int BM = 256, BK = 64, HALF = 128, HTB = HALF * BK * 2, STAGE_BYTES = 8 * HTB, NXCD = 8, WGM = 4;
__host__ __device__ __forceinline__ int lds_byte(int r, int c) { const int st = (r >> 4) * 2 + (c >> 5), rr = r & 15, cc = c & 31, ob = rr * 64 + cc * 2; return st * 1024 + (ob ^ (((ob >> 9) & 1) << 5)); }
__host__ __device__ __forceinline__ void stage_rc(int b, int& R, int& C) { const int st = b / 1024, sb = b % 1024, swz = sb ^ (((sb >> 9) & 1) << 5); R = (st >> 1) * 16 + swz / 64; C = (st & 1) * 32 + (swz % 64) / 2; }
__host__ __device__ __forceinline__ int perm32(int rho) { const int n = rho >> 4, i = rho & 15; return 8 * (i >> 2) + 4 * n + (i & 3); }

struct Unit { unsigned A, B; int pm, pn, e, nrows; };
__device__ __forceinline__ __amdgpu_buffer_rsrc_t mkrsrc(const void* p) { return __builtin_amdgcn_make_buffer_rsrc((void*)p, 0, 0x7fffffff, 0x00020000); }

__device__ __forceinline__ bool tile_order(int i, int G, int c, int nM, int nN, int& pm, int& pn) {
    const int nwg = nM * nN; const long L = (long)i * G + c; if (L >= nwg) return false;
    int wgid = (int)L; { const int q = nwg / NXCD, r = nwg % NXCD, xcd = wgid % NXCD, off = wgid / NXCD; wgid = (xcd < r ? xcd * (q + 1) : r * (q + 1) + (xcd - r) * q) + off; }
    const int nig = WGM * nN, gid = wgid / nig, fm = gid * WGM, gsz = (nM - fm) < WGM ? (nM - fm) : WGM;
    pm = fm + ((wgid % nig) % gsz); pn = (wgid % nig) / gsz; return true;
}
struct DenseSched {
    const char* A; const char* Bt; int lda2  , K2  , nM, nN, G, c;
    __device__ __forceinline__ bool next(int i, Unit& u) const { int pm, pn; if (!tile_order(i, G, c, nM, nN, pm, pn)) return false;
        u.A = (unsigned)pm * 256u * (unsigned)lda2; u.B = (unsigned)pn * 256u * (unsigned)K2; u.pm = pm; u.pn = pn; u.e = 0; u.nrows = 256; return true; }
    __device__ __forceinline__ __amdgpu_buffer_rsrc_t rsrcA() const { return mkrsrc(A); }
    __device__ __forceinline__ __amdgpu_buffer_rsrc_t rsrcB() const { return mkrsrc(Bt); }
    __device__ __forceinline__ void prefetch(const Unit&, int, int) const {}
    __device__ __forceinline__ unsigned aoff(const Unit&, int row, int) const { return (unsigned)row * (unsigned)lda2; }
};

typedef int i32x8 __attribute__((ext_vector_type(8)));
template <class Epi, class Sched, bool ALIGN_EPI, bool FP8 = false>
__device__ __forceinline__ void gemm_phase(LAS unsigned char* lds, const int K, const Sched& S, const Epi& E) {
    const int tid = threadIdx.x, wid = __builtin_amdgcn_readfirstlane(tid >> 6), lane = tid & 63, wr = wid >> 2, wc = wid & 3, fr = lane & 15, fq = lane >> 4;
    const int nt = FP8 ? K / 128 : K / BK;
    unsigned voffA[2][2], voffB[2];
#pragma unroll
    for (int i = 0; i < 1; ++i) { int R, C; if constexpr (FP8) { const int p = tid + 512 * i; R = p >> 3; C = (((p >> 1) & 3) ^ ((R >> 1) & 3)) * 32 + (p & 1) * 16; } else { stage_rc(tid * 16 + i * 8192, R, C); C *= 2; }
        const int Rb = Epi::PERM ? ((R & ~31) + perm32(R & 31)) : R; voffB[i] = (unsigned)(Rb * K * (FP8 ? 1 : 2) + C); }
    const unsigned kstep = (unsigned)(BK * 2);
    const unsigned hstep = (unsigned)HALF * K * (FP8 ? 1 : 2);
    const unsigned b64step = hstep / 2;
    const unsigned ldsw = (unsigned)wid * 1024u;
    const int aoff = FP8 ? (wr * 64 + fr) * 128 + ((fq ^ ((fr >> 1) & 3)) * 32) : lds_byte(wr * 64 + fr, fq * 8);
    const int boff = FP8 ? (wc * 32 + fr) * 128 + ((fq ^ ((fr >> 1) & 3)) * 32) : lds_byte(wc * 32 + fr, fq * 8);
#define PG_SA(b, h) (((b) * 2 + (h)) * HTB)
#define PG_SB(b, h) ((4 + (b) * 2 + (h)) * HTB)
#define PG_STAGE(bufoff, so, voff) do { _Pragma("unroll") for (int _i = 0; _i < 2; ++_i) \
        __builtin_amdgcn_raw_ptr_buffer_load_lds(rA, (LAS void*)(lds + (bufoff) + ldsw + _i * 8192), 16, (int)(voff)[_i], (int)(so), 0, 0); } while (0)
#define PG_STAGEB(bufoff, so) do { _Pragma("unroll") for (int _i = 0; _i < 2; ++_i) \
        __builtin_amdgcn_raw_ptr_buffer_load_lds(rB, (LAS void*)(lds + (bufoff) + ldsw + _i * 8192), 16, (int)voffB[0], (int)((so) + _i * b64step), 0, 0); } while (0)
#define PG_LD8(p, p2) __builtin_bit_cast(i32x8, __builtin_shufflevector(*(const LAS u32x4*)(p), *(const LAS u32x4*)(p2), 0, 1, 2, 3, 4, 5, 6, 7))
#define PG_LDA(dst, b, h) do { if constexpr (FP8) { _Pragma("unroll") for (int m = 0; m < 4; ++m) dst##8[m] = PG_LD8(lds + PG_SA(b, h) + aoff + m * 2048, lds + PG_SA(b, h) + aoff + m * 2048 + 16); } \
        else { _Pragma("unroll") for (int m = 0; m < 4; ++m) _Pragma("unroll") for (int k = 0; k < 2; ++k) dst[m][k] = *(const LAS bf16x8*)(lds + PG_SA(b, h) + aoff + m * 2048 + k * 1024); } } while (0)
#define PG_LDB(dst, b, h) do { if constexpr (FP8) { _Pragma("unroll") for (int n = 0; n < 2; ++n) dst##8[n] = PG_LD8(lds + PG_SB(b, h) + boff + n * 2048, lds + PG_SB(b, h) + boff + n * 2048 + 16); } \
        else { _Pragma("unroll") for (int n = 0; n < 2; ++n) _Pragma("unroll") for (int k = 0; k < 2; ++k) dst[n][k] = *(const LAS bf16x8*)(lds + PG_SB(b, h) + boff + n * 2048 + k * 1024); } } while (0)
#define PG_MMA(ai, bj, At, Bt) do { __builtin_amdgcn_s_setprio(1); if constexpr (FP8) { _Pragma("unroll") for (int m = 0; m < 4; ++m) _Pragma("unroll") for (int n = 0; n < 2; ++n) \
            acc[ai][bj][m][n] = __builtin_amdgcn_mfma_scale_f32_16x16x128_f8f6f4(Bt##8[n], At##8[m], acc[ai][bj][m][n], 0, 0, 0, 0, 0, 0); } \
        else { _Pragma("unroll") for (int m = 0; m < 4; ++m) _Pragma("unroll") for (int n = 0; n < 2; ++n) _Pragma("unroll") for (int k = 0; k < 2; ++k) \
            acc[ai][bj][m][n] = __builtin_amdgcn_mfma_f32_16x16x32_bf16(Bt[n][k], At[m][k], acc[ai][bj][m][n], 0, 0, 0); } __builtin_amdgcn_s_setprio(0); } while (0)
#define PG_WAIT_V(n) asm volatile("s_waitcnt vmcnt(" #n ")" ::: "memory")
#define PG_WAIT_L(n) asm volatile("s_waitcnt lgkmcnt(" #n ")" ::: "memory")
#define PG_BAR __builtin_amdgcn_s_barrier()
#define PG_SCHED __builtin_amdgcn_sched_barrier(0)
#define PG_SET_AOFF(u, ib) do { int _t = threadIdx.x; asm volatile("" : "+v"(_t));     \
        _Pragma("unroll") for (int _i = 0; _i < 2; ++_i) { int _R, _C; if constexpr (FP8) { const int _p = _t + 512 * _i; _R = _p >> 3; _C = (((_p >> 1) & 3) ^ ((_R >> 1) & 3)) * 32 + (_p & 1) * 16; } else { stage_rc(_t * 16 + _i * 8192, _R, _C); _C *= 2; } \
        voffA[0][_i] = S.aoff(u, _R, ib) + (unsigned)_C; voffA[1][_i] = S.aoff(u, _R + HALF, ib) + (unsigned)_C; } } while (0)
    Unit cur, nxt; int ui = 0;
    if (!S.next(0, cur)) return;
    f32x4 acc[2][2][4][2];
#pragma unroll
    for (int a = 0; a < 2; ++a)
#pragma unroll
        for (int b = 0; b < 2; ++b)
#pragma unroll
            for (int m = 0; m < 4; ++m)
#pragma unroll
                for (int n = 0; n < 2; ++n) acc[a][b][m][n] = (f32x4){0.f, 0.f, 0.f, 0.f};
    bf16x8 At[FP8 ? 1 : 4][2], B0[2][2], B1[2][2]; i32x8 At8[FP8 ? 4 : 1], B08[2], B18[2];
    const __amdgpu_buffer_rsrc_t rA = S.rsrcA(), rB = S.rsrcB();
    unsigned cA = cur.A, cB = cur.B;
    S.prefetch(cur, 0, 0);
    PG_WAIT_V(0); __syncthreads();
    PG_SET_AOFF(cur, 0);
    PG_STAGEB(PG_SB(0, 0), cB); PG_STAGEB(PG_SB(0, 1), cB + hstep); PG_STAGE(PG_SA(0, 0), cA, voffA[0]); PG_STAGE(PG_SA(0, 1), cA, voffA[1]);
    if (wr == 1) PG_BAR;
    PG_WAIT_V(2); PG_BAR;
    PG_STAGEB(PG_SB(1, 0), cB + kstep); PG_STAGE(PG_SA(1, 0), cA + kstep, voffA[0]); PG_STAGEB(PG_SB(1, 1), cB + hstep + kstep);
    PG_WAIT_V(6); PG_BAR;
    for (;;) {
        const bool has_next = S.next(ui + 1, nxt);
        const unsigned nA = has_next ? nxt.A : cA, nB = has_next ? nxt.B : cB;
        if (has_next) S.prefetch(nxt, (ui + 1) & 1, (ui + 1) % 3);
#pragma unroll 1
        for (int t = 0; t < nt; t += 2) {
            const bool last = (t == nt - 2);
            const unsigned a1 = cA + (unsigned)(t + 1) * kstep;
            const unsigned a2 = last ? nA : cA + (unsigned)(t + 2) * kstep, b2 = last ? nB : cB + (unsigned)(t + 2) * kstep;
            const unsigned a3 = a2 + kstep, b3 = b2 + kstep;
            PG_LDB(B0, 0, 0); PG_LDB(B1, 0, 1); PG_SCHED; PG_LDA(At, 0, 0); PG_STAGE(PG_SA(1, 1), a1, voffA[1]);
            PG_WAIT_V(8); PG_WAIT_L(0); PG_BAR; PG_MMA(0, 0, At, B0); PG_MMA(0, 1, At, B1); PG_BAR; PG_SCHED;
            if (last && has_next) PG_SET_AOFF(nxt, (ui + 1) & 1);
            PG_LDA(At, 0, 1); PG_STAGEB(PG_SB(0, 0), b2); PG_STAGEB(PG_SB(0, 1), b2 + hstep); PG_STAGE(PG_SA(0, 0), a2, voffA[0]);
            PG_WAIT_V(8); PG_WAIT_L(0); PG_BAR; PG_MMA(1, 0, At, B0); PG_MMA(1, 1, At, B1); PG_BAR; PG_SCHED;
            PG_LDB(B0, 1, 0); PG_LDB(B1, 1, 1); PG_SCHED; PG_LDA(At, 1, 0); PG_STAGE(PG_SA(0, 1), a2, voffA[1]);
            PG_WAIT_V(8); PG_WAIT_L(0); PG_BAR; PG_MMA(0, 0, At, B0); PG_MMA(0, 1, At, B1); PG_BAR; PG_SCHED;
            PG_LDA(At, 1, 1); PG_STAGEB(PG_SB(1, 0), b3); PG_STAGEB(PG_SB(1, 1), b3 + hstep); PG_STAGE(PG_SA(1, 0), a3, voffA[0]);
            PG_WAIT_V(8); PG_WAIT_L(0); PG_BAR; PG_MMA(1, 0, At, B0); PG_MMA(1, 1, At, B1); PG_BAR; PG_SCHED;
        }
        if constexpr (ALIGN_EPI) { if (wr == 0) PG_BAR; }
        {
            int tz = threadIdx.x; asm volatile("" : "+v"(tz)); const int lz = tz & 63;
            E(acc, cur, ui % 3, (tz >> 6) >> 2, (tz >> 6) & 3, lz & 15, lz >> 4);
        }
        if (!has_next) break;
#pragma unroll
        for (int a = 0; a < 2; ++a)
#pragma unroll
            for (int b = 0; b < 2; ++b)
#pragma unroll
                for (int m = 0; m < 4; ++m)
#pragma unroll
                    for (int n = 0; n < 2; ++n) acc[a][b][m][n] = (f32x4){0.f, 0.f, 0.f, 0.f};
        cur = nxt; cA = nA; cB = nB; ++ui;
        if constexpr (ALIGN_EPI) { if (wr == 1) PG_BAR; }
    }
    PG_WAIT_V(0);
    if constexpr (!ALIGN_EPI) { if (wr == 0) PG_BAR; }
    PG_BAR;
#undef PG_SA
#undef PG_SB
#undef PG_STAGE
#undef PG_STAGEB
#undef PG_LDA
#undef PG_LDB
#undef PG_MMA
#undef PG_LD8
#undef PG_WAIT_V
#undef PG_WAIT_L
#undef PG_BAR
#undef PG_SCHED
#undef PG_SET_AOFF
}

struct EpiProj {
    static constexpr bool PERM = true; bf16* P; bf16* S5A;
    __device__ __forceinline__ void operator()(const f32x4 (&acc)[2][2][4][2], const Unit& u, int bb, int wr, int wc, int fr, int fq) const {
        const int row0 = u.pm * BM + wr * 64 + fr, col0 = u.pn * BM + wc * 32 + 8 * fq;
#pragma unroll
        for (int ai = 0; ai < 2; ++ai)
#pragma unroll
            for (int m = 0; m < 4; ++m) { const int row = row0 + ai * HALF + m * 16; bf16* rowp = P + (size_t)row * NPROJ + col0;
                if (u.pn < 2) { const int b = row >> 13, tt = row & 8191; rowp = S5A + ((size_t)b * S5NCH + (tt / S5L)) * S5K + (tt % S5L) * 16 + (col0 & 15) + (size_t)(col0 >> 4) * S5ROWS * S5K; }
#pragma unroll
                for (int bj = 0; bj < 2; ++bj) { const f32x4 v0 = acc[ai][bj][m][0], v1 = acc[ai][bj][m][1];
                    u32x4 w; w.x = cvt_pk_bf16(v0[0], v0[1]); w.y = cvt_pk_bf16(v0[2], v0[3]); w.z = cvt_pk_bf16(v1[0], v1[1]); w.w = cvt_pk_bf16(v1[2], v1[3]);
                    *(u32x4*)(rowp + (u.pn < 2 ? (size_t)bj * 8 * S5ROWS * S5K : (size_t)bj * HALF)) = w; } }
    }
};
struct EpiXloc {
    static constexpr bool PERM = false; float* X;
    __device__ __forceinline__ void operator()(const f32x4 (&acc)[2][2][4][2], const Unit& u, int bb, int wr, int wc, int fr, int fq) const {
        const int row0 = (u.pm & 3) * BM + wr * 64 + fr, col0 = wc * 32 + 4 * fq;
#pragma unroll
        for (int ai = 0; ai < 2; ++ai)
#pragma unroll
            for (int m = 0; m < 4; ++m) { float* rp = X + ((size_t)u.e * S5ROWS + row0 + ai * HALF + m * 16) * 128 + col0;
#pragma unroll
                for (int n = 0; n < 2; ++n) *(f32x4*)(rp + n * 16) = acc[ai][0][m][n]; }
    }
};
struct EpiS5Y {
    static constexpr bool PERM = true; const bf16* S5A; const float* dskip; bf16* GY;
    __device__ __forceinline__ void operator()(const f32x4 (&acc)[2][2][4][2], const Unit& u, int bb, int wr, int wc, int fr, int fq) const {
        const int g = u.e, rg0 = (u.pm & 3) * BM + wr * 64 + fr, c0 = u.pn * BM + wc * 32 + 8 * fq;
#pragma unroll
        for (int bj = 0; bj < 2; ++bj) { const int col = c0 + bj * HALF, t = col >> 4, p0 = col & 15;
            const f32x4 d0 = *(const f32x4*)(dskip + g * 16 + p0), d1 = *(const f32x4*)(dskip + g * 16 + p0 + 4);
#pragma unroll
            for (int ai = 0; ai < 2; ++ai)
#pragma unroll
                for (int m = 0; m < 4; ++m) { const int rg = rg0 + ai * HALF + m * 16; const int b = rg / S5NCH, c = rg % S5NCH;
                    const u32x4 uu = *(const u32x4*)(S5A + ((size_t)g * S5ROWS + rg) * S5K + col);
                    const f32x4 v0 = acc[ai][bj][m][0], v1 = acc[ai][bj][m][1];
                    u32x4 w;
                    w.x = cvt_pk_bf16(gelu_tanh(v0[0] + d0[0] * lo_bf(uu.x)), gelu_tanh(v0[1] + d0[1] * hi_bf(uu.x))); w.y = cvt_pk_bf16(gelu_tanh(v0[2] + d0[2] * lo_bf(uu.y)), gelu_tanh(v0[3] + d0[3] * hi_bf(uu.y)));
                    w.z = cvt_pk_bf16(gelu_tanh(v1[0] + d1[0] * lo_bf(uu.z)), gelu_tanh(v1[1] + d1[1] * hi_bf(uu.z))); w.w = cvt_pk_bf16(gelu_tanh(v1[2] + d1[2] * lo_bf(uu.w)), gelu_tanh(v1[3] + d1[3] * hi_bf(uu.w)));
                    *(u32x4*)(GY + ((size_t)b * SEQ + c * S5L + t) * 512 + g * 16 + p0) = w; } }
    }
};
struct S5Sched {
    const char* A; const char* B; int lda2, K2, brows, nN, G, c;
    __device__ __forceinline__ bool next(int i, Unit& u) const { const int L = i * G + c; if (L >= 128 * nN) return false;
        const int g = L / (4 * nN), r = L % (4 * nN), mh = r / nN, pn = r % nN;
        u.A = ((unsigned)g * S5ROWS + mh * 256u) * (unsigned)lda2; u.B = ((unsigned)g * brows + pn * 256u) * (unsigned)K2; u.pm = g * 4 + mh; u.pn = pn; u.e = g; u.nrows = 256; return true; }
    __device__ __forceinline__ __amdgpu_buffer_rsrc_t rsrcA() const { return mkrsrc(A); }
    __device__ __forceinline__ __amdgpu_buffer_rsrc_t rsrcB() const { return mkrsrc(B); }
    __device__ __forceinline__ void prefetch(const Unit&, int, int) const {}
    __device__ __forceinline__ unsigned aoff(const Unit&, int row, int) const { return (unsigned)row * (unsigned)lda2; }
};
struct EpiGlu {
    static constexpr bool PERM = true; const bf16* GY; const float* bglu; bf16* MIX;
    __device__ __forceinline__ void operator()(const f32x4 (&acc)[2][2][4][2], const Unit& u, int bb, int wr, int wc, int fr, int fq) const {
        const int row0 = u.pm * BM + wr * 64 + fr, col0 = u.pn * BM + wc * 32 + 8 * fq;
#pragma unroll
        for (int bj = 0; bj < 2; ++bj) { const int col = col0 + bj * HALF;
            const f32x4 b0 = *(const f32x4*)(bglu + col), b1 = *(const f32x4*)(bglu + col + 4);
#pragma unroll
            for (int ai = 0; ai < 2; ++ai)
#pragma unroll
                for (int m = 0; m < 4; ++m) { const size_t row = (size_t)(row0 + ai * HALF + m * 16);
                    const u32x4 g = *(const u32x4*)(GY + row * 512 + col);
                    const f32x4 v0 = acc[ai][bj][m][0] + b0, v1 = acc[ai][bj][m][1] + b1;
                    u32x4 w;
                    w.x = cvt_pk_bf16(lo_bf(g.x) * sigmoidf_(v0[0]), hi_bf(g.x) * sigmoidf_(v0[1])); w.y = cvt_pk_bf16(lo_bf(g.y) * sigmoidf_(v0[2]), hi_bf(g.y) * sigmoidf_(v0[3]));
                    w.z = cvt_pk_bf16(lo_bf(g.z) * sigmoidf_(v1[0]), hi_bf(g.z) * sigmoidf_(v1[1])); w.w = cvt_pk_bf16(lo_bf(g.w) * sigmoidf_(v1[2]), hi_bf(g.w) * sigmoidf_(v1[3]));
                    *(u32x4*)(MIX + row * D + col) = w; } }
    }
};
struct EpiOut {
    static constexpr bool PERM = true; const float* x; bf16* H;
    __device__ __forceinline__ void operator()(const f32x4 (&acc)[2][2][4][2], const Unit& u, int bb, int wr, int wc, int fr, int fq) const {
        const int row0 = u.pm * BM + wr * 64 + fr, col0 = u.pn * BM + wc * 32 + 8 * fq;
#pragma unroll
        for (int ai = 0; ai < 2; ++ai)
#pragma unroll
            for (int m = 0; m < 4; ++m) { const size_t ro = (size_t)(row0 + ai * HALF + m * 16) * D + col0;
#pragma unroll
                for (int bj = 0; bj < 2; ++bj) { const f32x4 v0 = __builtin_nontemporal_load((const f32x4*)(x + ro + bj * HALF)) + acc[ai][bj][m][0], v1 = __builtin_nontemporal_load((const f32x4*)(x + ro + bj * HALF + 4)) + acc[ai][bj][m][1];
                    u32x4 w; w.x = cvt_pk_bf16(v0[0], v0[1]); w.y = cvt_pk_bf16(v0[2], v0[3]); w.z = cvt_pk_bf16(v1[0], v1[1]); w.w = cvt_pk_bf16(v1[2], v1[3]);
                    *(u32x4*)(H + ro + bj * HALF) = w; } }
    }
};
struct EpiUp {
    static constexpr bool PERM = true; const LAS float* bl; unsigned char* ACT;
    __device__ __forceinline__ void operator()(const f32x4 (&acc)[2][2][4][2], const Unit& u, int bb, int wr, int wc, int fr, int fq) const {
        const int row0 = u.pm * BM + wr * 64 + fr, j0 = u.pn * HALF + wc * 32 + 8 * fq;
        const LAS float* bg = bl + bb * 256 + wc * 32 + 8 * fq;
#pragma unroll
        for (int ai = 0; ai < 2; ++ai)
#pragma unroll
            for (int m = 0; m < 4; ++m) {
                float o[8];
                typedef float f32x2 __attribute__((ext_vector_type(2)));
#pragma unroll
                for (int n = 0; n < 2; ++n) { const f32x4 gb = *(const LAS f32x4*)(bg + 4 * n), lb = *(const LAS f32x4*)(bg + 128 + 4 * n);
#pragma unroll
                    for (int q = 0; q < 4; q += 2) {
                        f32x2 gv = (f32x2){acc[ai][0][m][n][q], acc[ai][0][m][n][q + 1]} * W8_INV + (f32x2){gb[q], gb[q + 1]};
                        f32x2 lv = (f32x2){acc[ai][1][m][n][q], acc[ai][1][m][n][q + 1]} * W8_INV + ((f32x2){lb[q], lb[q + 1]} + 1.f);
                        gv.x = fminf(gv.x, 7.f); gv.y = fminf(gv.y, 7.f);
                        lv.x = __builtin_amdgcn_fmed3f(lv.x, -6.f, 8.f); lv.y = __builtin_amdgcn_fmed3f(lv.y, -6.f, 8.f);
                        f32x2 tt = gv * (-1.702f * 1.4426950408889634f);
                        tt.x = __builtin_amdgcn_exp2f(tt.x); tt.y = __builtin_amdgcn_exp2f(tt.y);
                        tt = tt + 1.f;
                        tt.x = __builtin_amdgcn_rcpf(tt.x); tt.y = __builtin_amdgcn_rcpf(tt.y);
                        const f32x2 ov = (gv * tt) * lv;
                        o[n * 4 + q] = ov.x; o[n * 4 + q + 1] = ov.y; } }
                u32x2 w; w.x = pk4_fp8(o[0], o[1], o[2], o[3]); w.y = pk4_fp8(o[4], o[5], o[6], o[7]);
                *(u32x2*)(ACT + (size_t)(row0 + ai * HALF + m * 16) * FF + j0) = w; }
    }
};
struct EpiDown {
    static constexpr bool PERM = true; const LAS float* bl; unsigned char* YS;
    __device__ __forceinline__ void operator()(const f32x4 (&acc)[2][2][4][2], const Unit& u, int bb, int wr, int wc, int fr, int fq) const {
        const int row0 = u.pm * BM + wr * 64 + fr, col0 = u.pn * BM + wc * 32 + 8 * fq;
        const LAS float* bp = bl + bb * 256 + wc * 32 + 8 * fq;
#pragma unroll
        for (int ai = 0; ai < 2; ++ai)
#pragma unroll
            for (int m = 0; m < 4; ++m)
#pragma unroll
                for (int bj = 0; bj < 2; ++bj) { const f32x4 b0 = *(const LAS f32x4*)(bp + bj * HALF), b1 = *(const LAS f32x4*)(bp + bj * HALF + 4);
                    const f32x4 v0 = acc[ai][bj][m][0] * W8_INV + b0, v1 = acc[ai][bj][m][1] * W8_INV + b1;
                    u32x2 w; w.x = pk4_fp8(v0[0], v0[1], v0[2], v0[3]); w.y = pk4_fp8(v1[0], v1[1], v1[2], v1[3]);
                    *(u32x2*)(YS + (size_t)(row0 + ai * HALF + m * 16) * D + col0 + bj * HALF) = w; }
    }
};
}

struct MoeSched {
    const char* A; const char* W; const int* slot_tok; const float* bias; LAS int* til; LAS int* idx; LAS float* bl; int lda2, K2, nN, wrows  , G, c, gather;
    __device__ __forceinline__ void build_list(LAS int* ul) const {
        const int i = threadIdx.x;
        if (i < 32) { const int nM = til[2 * MAXTILES]; int pm = -1, pn = 0, e = 0, nr = 0;
            if (pg::tile_order(i, G, c, nM, nN, pm, pn)) { e = til[pm]; nr = til[MAXTILES + pm]; } else pm = -1;
            ul[i * 4 + 0] = pm; ul[i * 4 + 1] = pn; ul[i * 4 + 2] = e; ul[i * 4 + 3] = nr; }
    }
    __device__ __forceinline__ bool next(int i, pg::Unit& u) const {
        const LAS int* ul = (const LAS int*)((const LAS char*)til - TIL_OFF + ULIST_OFF);
        if (i >= 32) return false;
        const int pm = __builtin_amdgcn_readfirstlane(ul[i * 4 + 0]); if (pm < 0) return false;
        const int pn = __builtin_amdgcn_readfirstlane(ul[i * 4 + 1]), e = __builtin_amdgcn_readfirstlane(ul[i * 4 + 2]);
        u.pm = pm; u.pn = pn; u.e = e; u.nrows = __builtin_amdgcn_readfirstlane(ul[i * 4 + 3]);
        u.A = gather ? 0u : (unsigned)pm * 256u * (unsigned)lda2; u.B = ((unsigned)e * wrows + (unsigned)pn * 256u) * (unsigned)K2; return true; }
    __device__ __forceinline__ __amdgpu_buffer_rsrc_t rsrcA() const { return pg::mkrsrc(A); }
    __device__ __forceinline__ __amdgpu_buffer_rsrc_t rsrcB() const { return pg::mkrsrc(W); }
    __device__ __forceinline__ void prefetch(const pg::Unit& u, int ib, int bb) const {
        if (threadIdx.x >= 256 && threadIdx.x < 320) {
            const int l = threadIdx.x - 256;
            const float* src = gather ? bias + (size_t)u.e * 2 * FF + (l < 32 ? u.pn * 128 + 4 * l : FF + u.pn * 128 + 4 * (l - 32)) : bias + (size_t)u.e * D + u.pn * 256 + 4 * l;
            __builtin_amdgcn_global_load_lds((const unsigned*)src, (LAS unsigned*)(bl + bb * 256), 16, 0, 0); }
        if (gather && threadIdx.x < 256) { const int r = threadIdx.x; const int s = u.pm * 256 + (r < u.nrows ? r : u.nrows - 1);
            __builtin_amdgcn_global_load_lds((const unsigned*)(slot_tok + s), (LAS unsigned*)(idx + ib * 256 + (threadIdx.x & ~63)), 4, 0, 0); } }
    __device__ __forceinline__ unsigned aoff(const pg::Unit&, int row, int ib) const { return gather ? (unsigned)idx[ib * 256 + row] * (unsigned)lda2 : (unsigned)row * (unsigned)lda2; }
};

struct Frame {
    LAS unsigned char* lds; volatile LAS unsigned* MISC; gu32* ctl; int tid, lane, wave, vcu, G;
};
#define LDS_WAIT() asm volatile("s_waitcnt lgkmcnt(0)" ::: "memory")

template <bool F8, class RowMap>
__device__ __forceinline__ void transpose_item(const float* W, int ldw, int K, int nblk, void* WTv, LAS bf16* scr, int item, int lane, RowMap rowmap) {
    const int kb = item / nblk, nb = item % nblk, k0 = 64 * kb, n0 = 64 * nb;
    const float* src = W + (size_t)(k0 + (lane >> 4)) * ldw + n0 + 4 * (lane & 15);
    f32x4 v[16];
#pragma unroll
    for (int i = 0; i < 16; ++i) v[i] = __builtin_nontemporal_load((const f32x4*)(src + (size_t)(4 * i) * ldw));
#pragma unroll
    for (int i = 0; i < 16; ++i) { u32x2 o; o.x = pk2(v[i].x, v[i].y); o.y = pk2(v[i].z, v[i].w); *(LAS u32x2*)(scr + ((lane >> 4) + 4 * i) * 68 + 4 * (lane & 15)) = o; }
    LDS_WAIT(); asm volatile("" ::: "memory");
    const int c = lane & 7; const int r0 = rowmap(n0);
#pragma unroll
    for (int jn = 0; jn < 8; ++jn) { const int n = (lane >> 3) + 8 * jn; const LAS bf16* sp = scr + (8 * c) * 68 + n;
        if constexpr (F8) { u32x2 o; o.x = pk4_fp8(bf2f(sp[0]) * W8_SCALE, bf2f(sp[68]) * W8_SCALE, bf2f(sp[2 * 68]) * W8_SCALE, bf2f(sp[3 * 68]) * W8_SCALE);
            o.y = pk4_fp8(bf2f(sp[4 * 68]) * W8_SCALE, bf2f(sp[5 * 68]) * W8_SCALE, bf2f(sp[6 * 68]) * W8_SCALE, bf2f(sp[7 * 68]) * W8_SCALE);
            __builtin_nontemporal_store(o, (u32x2*)((unsigned char*)WTv + (size_t)(r0 + n) * K + k0 + 8 * c)); }
        else { u32x4 o; o.x = (unsigned)sp[0] | ((unsigned)sp[68] << 16); o.y = (unsigned)sp[2 * 68] | ((unsigned)sp[3 * 68] << 16); o.z = (unsigned)sp[4 * 68] | ((unsigned)sp[5 * 68] << 16); o.w = (unsigned)sp[6 * 68] | ((unsigned)sp[7 * 68] << 16);
            *(u32x4*)((bf16*)WTv + (size_t)(r0 + n) * K + k0 + 8 * c) = o; } }
    LDS_WAIT(); asm volatile("" ::: "memory");
}
struct RowId { __device__ __forceinline__ int operator()(int n0) const { return n0; } };
struct RowUp { __device__ __forceinline__ int operator()(int n0) const { return n0 < FF ? (n0 >> 7) * 256 + (n0 & 127) : ((n0 - FF) >> 7) * 256 + 128 + ((n0 - FF) & 127); } };

struct Args { const float* in[26]; float* out; unsigned char* ws; int ph_lo, ph_hi, li, pad; };

__global__ void __launch_bounds__(NTHR, 2) fwd(Args args) {
    extern __shared__ __attribute__((aligned(16))) unsigned char lds_raw[];
    Frame F;
    F.lds = (LAS unsigned char*)lds_raw;
    F.MISC = (volatile LAS unsigned*)(F.lds + MISC_OFF);
    F.tid = threadIdx.x; F.lane = F.tid & 63; F.wave = __builtin_amdgcn_readfirstlane(F.tid >> 6);
    F.G = gridDim.x; { const int bx = blockIdx.x; F.vcu = (F.G % 8 == 0) ? (bx % 8) * (F.G / 8) + bx / 8 : bx; }
    unsigned char* ws = args.ws;
    F.ctl = (gu32*)(ws + WS_CTL);
    if (F.tid < 32) ((LAS unsigned*)(F.lds + MISC_OFF))[F.tid] = 0u;
    __syncthreads();
    XcdBarrier bar = xcd_barrier_post((unsigned*)(F.ctl + CW_BAR) + args.li * XCD_BAR_WORDS, F.MISC + 8);
#define INP(i) (*(const float* const volatile*)((const char*)__builtin_amdgcn_kernarg_segment_ptr() + 8 * (i)))
    const int lo = args.ph_lo, hi = args.ph_hi;
#define IN(k) (lo <= (k) && (k) < hi)
#define BOTH(k) (IN(k) && IN((k) + 1))
#define GRID_BAR() xcd_barrier(bar)
    const float* x = args.in[0];
    bf16* WIN = (bf16*)(ws + WS_WIN); bf16* WGLU = (bf16*)(ws + WS_WGLU); bf16* WOUT = (bf16*)(ws + WS_WOUT); unsigned char* WUP8 = ws + WS_WUP; unsigned char* WDN8 = ws + WS_WDN;
    bf16* HN = (bf16*)(ws + WS_HN); bf16* PROJ = (bf16*)(ws + WS_PROJ); bf16* GY = (bf16*)(ws + WS_GY); bf16* MIX = (bf16*)(ws + WS_MIX);
    bf16* H = (bf16*)(ws + WS_H); unsigned char* ACT8 = ws + WS_ACT; unsigned char* HN8 = ws + WS_HN; unsigned char* YS = ws + WS_YS;
    float* gates = (float*)(ws + WS_GATES); int* topi = (int*)(ws + WS_TOPI); float* topg = (float*)(ws + WS_TOPG);
    int* slot_tok = (int*)(ws + WS_SLOTTOK); int* tok_slot = (int*)(ws + WS_TOKSLOT); int* CNT = (int*)(ws + WS_CNT); int* ecnt = CNT + 16384;
    bf16* S5A = (bf16*)(ws + WS_S5A); bf16* S5BT = (bf16*)(ws + WS_S5BT); bf16* S5BQ = (bf16*)(ws + WS_S5BQ); float* XLOC = (float*)(ws + WS_XLOC);
    bf16* QH = (bf16*)(ws + WS_QH); bf16* KH = (bf16*)(ws + WS_KH); bf16* VT = (bf16*)(ws + WS_VT); float* DC = (float*)(ws + WS_DC); bf16* CST = (bf16*)(ws + WS_CST);
    float* FLOC = (float*)(ws + WS_FLOC); float* DN = (float*)(ws + WS_DN); float* NST = (float*)(ws + WS_NST); float* SEGS = (float*)(ws + WS_SEGS); float* KTAB = (float*)(ws + WS_KTAB);
    const int gw = F.vcu * NWAVES + F.wave, NGW = F.G * NWAVES;

    if (IN(0)) {
        { int tq_ = threadIdx.x; asm volatile("" : "+v"(tq_)); F.tid = tq_; F.lane = tq_ & 63; }
        LAS bf16* scr = (LAS bf16*)(F.lds + F.wave * 16384);
        constexpr int I_IN = (D / 64) * (NPROJ / 64), I_GLU = (512 / 64) * (512 / 64), I_OUT = (D / 64) * (D / 64), I_UP = (D / 64) * (2 * FF / 64);
        constexpr int NITEMS = I_IN + I_GLU + I_OUT + NE * I_UP;
        for (int it = gw; it < NITEMS && !(args.pad & 1); it += NGW) {
            int r = it;
            if (r < I_IN) { transpose_item<false>(args.in[2], DIN, D, NPROJ / 64, WIN, scr, r, F.lane, RowId()); continue; } r -= I_IN;
            if (r < I_GLU) { transpose_item<false>(args.in[11], 512, 512, 512 / 64, WGLU, scr, r, F.lane, RowId()); continue; } r -= I_GLU;
            if (r < I_OUT) { transpose_item<false>(args.in[17], D, D, D / 64, WOUT, scr, r, F.lane, RowId()); continue; } r -= I_OUT;
            { const int e = r / I_UP; transpose_item<true>(args.in[21] + (size_t)e * D * 2 * FF, 2 * FF, D, 2 * FF / 64, WUP8 + (size_t)e * 2 * FF * D, scr, r % I_UP, F.lane, RowUp()); }
        }
        {
            const float* g = args.in[1]; const float* w_in = args.in[2]; const float* b_gates = args.in[15];
            float wg[16][8]; f32x4 gg[4];
#pragma unroll
            for (int jq = 0; jq < 4; ++jq) { gg[jq] = *(const f32x4*)(g + 4 * F.lane + 256 * jq);
#pragma unroll
                for (int i = 0; i < 4; ++i) { const int k = 4 * F.lane + 256 * jq + i; const f32x4 w0 = *(const f32x4*)(w_in + (size_t)k * DIN + O_G), w1 = *(const f32x4*)(w_in + (size_t)k * DIN + O_G + 4);
                    wg[4 * jq + i][0] = w0.x; wg[4 * jq + i][1] = w0.y; wg[4 * jq + i][2] = w0.z; wg[4 * jq + i][3] = w0.w; wg[4 * jq + i][4] = w1.x; wg[4 * jq + i][5] = w1.y; wg[4 * jq + i][6] = w1.z; wg[4 * jq + i][7] = w1.w; } }
            float bgv[8];
#pragma unroll
            for (int q = 0; q < 8; ++q) bgv[q] = b_gates[q];
            f32x4 nx[4];
            if (gw < T) {
#pragma unroll
                for (int jq = 0; jq < 4; ++jq) nx[jq] = __builtin_nontemporal_load((const f32x4*)(x + (size_t)gw * D + 4 * F.lane + 256 * jq)); }
            for (int row = gw; row < T && !(args.pad & 2); row += NGW) {
                f32x4 v[4];
#pragma unroll
                for (int jq = 0; jq < 4; ++jq) v[jq] = nx[jq];
                if (row + NGW < T) {
#pragma unroll
                    for (int jq = 0; jq < 4; ++jq) nx[jq] = __builtin_nontemporal_load((const f32x4*)(x + (size_t)(row + NGW) * D + 4 * F.lane + 256 * jq)); }
                float ss = 0.f;
#pragma unroll
                for (int jq = 0; jq < 4; ++jq) ss += v[jq].x * v[jq].x + v[jq].y * v[jq].y + v[jq].z * v[jq].z + v[jq].w * v[jq].w;
                ss = wave_sum(ss);
                const float rstd = rsqrtf(ss * (1.f / D) + 1e-5f);
                float ga[8] = {0, 0, 0, 0, 0, 0, 0, 0};
#pragma unroll
                for (int jq = 0; jq < 4; ++jq) {
                    v[jq] = v[jq] * rstd * gg[jq];
#pragma unroll
                    for (int i = 0; i < 4; ++i)
#pragma unroll
                        for (int q = 0; q < 8; ++q) ga[q] += v[jq][i] * wg[4 * jq + i][q];
                    uint2 o; o.x = pk2(v[jq].x, v[jq].y); o.y = pk2(v[jq].z, v[jq].w);
                    *(uint2*)(HN + (size_t)row * D + 4 * F.lane + 256 * jq) = o;
                }
#pragma unroll
                for (int q = 0; q < 8; ++q) ga[q] = wave_sum(ga[q]);
                if (F.lane == 0) { *(f32x4*)(gates + (size_t)row * 8) = (f32x4){ga[0] + bgv[0], ga[1] + bgv[1], ga[2] + bgv[2], ga[3] + bgv[3]}; *(f32x4*)(gates + (size_t)row * 8 + 4) = (f32x4){ga[4] + bgv[4], ga[5] + bgv[5], ga[6] + bgv[6], ga[7] + bgv[7]}; }
            }
        }
        __syncthreads();
        for (int un = F.vcu; un < 256 && !(args.pad & 4); un += F.G) {
            const int g = un >> 3, j = un & 7;
            LAS float* Ere = (LAS float*)F.lds; LAS float* Eim = Ere + 4 * 64;
            LAS float* Bbr = Eim + 4 * 64; LAS float* Bbi = Bbr + 1024;
            LAS float* Cr = Bbi + 1024; LAS float* Ci = Cr + 1024;
            LAS float* E6r = Ci + 1024; LAS float* E6i = E6r + 1024;
            const float dt = __expf(args.in[3][g]);
            if (F.tid < 64) { const int n = F.tid;
                const float are = fminf(args.in[4][g * 64 + n], -1e-4f), aim = args.in[5][g * 64 + n];
                const float mag = __expf(dt * are); float sn, cs; fcis(dt * aim, &sn, &cs);
                const float nr = mag * cs - 1.f, ni = mag * sn, dn = are * are + aim * aim;
                const float cfr = (nr * are + ni * aim) / dn, cfi = (ni * are - nr * aim) / dn;
                for (int q = 0; q < 16; ++q) { const float br = args.in[6][(g * 64 + n) * 16 + q], bi = args.in[7][(g * 64 + n) * 16 + q]; Bbr[n * 16 + q] = cfr * br - cfi * bi; Bbi[n * 16 + q] = cfr * bi + cfi * br; }
            }
            for (int i = F.tid; i < 1024; i += NTHR) { Cr[i] = args.in[8][g * 1024 + i]; Ci[i] = args.in[9][g * 1024 + i]; }
            if (F.tid < 256) { const int tl = F.tid >> 6, n = F.tid & 63; const float tau = (float)(4 * j + tl);
                const float are = fminf(args.in[4][g * 64 + n], -1e-4f), aim = args.in[5][g * 64 + n];
                const float mag = __expf(tau * dt * are); float sn, cs; fcis(tau * dt * aim, &sn, &cs); Ere[F.tid] = mag * cs; Eim[F.tid] = mag * sn; }
            for (int i = F.tid; i < 1024; i += NTHR) { const int tau = i >> 5, n = 32 * (j & 1) + (i & 31);
                const float are = fminf(args.in[4][g * 64 + n], -1e-4f), aim = args.in[5][g * 64 + n];
                const float mag = __expf((float)tau * dt * are); float sn, cs; fcis((float)tau * dt * aim, &sn, &cs); E6r[i] = mag * cs; E6i[i] = mag * sn; }
            __syncthreads();
            {
                const int tl = F.tid >> 7, p = (F.tid >> 3) & 15, q0 = (F.tid & 7) * 2;
                float a0 = 0.f, a1 = 0.f;
                for (int n = 0; n < 64; ++n) { const float cr = Cr[p * 64 + n], ci = Ci[p * 64 + n], er = Ere[tl * 64 + n], ei = Eim[tl * 64 + n];
                    const float xr = cr * er - ci * ei, xi = cr * ei + ci * er;
                    a0 += xr * Bbr[n * 16 + q0] - xi * Bbi[n * 16 + q0]; a1 += xr * Bbr[n * 16 + q0 + 1] - xi * Bbi[n * 16 + q0 + 1]; }
                KTAB[((size_t)g * S5L + 4 * j + tl) * 256 + p * 16 + q0] = a0; KTAB[((size_t)g * S5L + 4 * j + tl) * 256 + p * 16 + q0 + 1] = a1;
            }
            for (int ch = F.tid; ch < 32 * (S5KIN / 8); ch += NTHR) {
                const int rl = ch / (S5KIN / 8), c8 = ch % (S5KIN / 8), r = 32 * j + rl, n = r & 63, im = (r >> 6) & 1, col = c8 * 8, sidx = col >> 4, q0 = col & 15;
                const float er = E6r[(S5L - 1 - sidx) * 32 + (n & 31)], ei = E6i[(S5L - 1 - sidx) * 32 + (n & 31)];
                float v[8];
#pragma unroll
                for (int i = 0; i < 8; ++i) { const float br = Bbr[n * 16 + q0 + i], bi = Bbi[n * 16 + q0 + i]; v[i] = im ? (er * bi + ei * br) : (er * br - ei * bi); }
                u32x4 o; o.x = pk2(v[0], v[1]); o.y = pk2(v[2], v[3]); o.z = pk2(v[4], v[5]); o.w = pk2(v[6], v[7]);
                *(u32x4*)(S5BQ + ((size_t)g * 256 + r) * S5KIN + col) = o;
            }
            __syncthreads();
        }
        if (BOTH(0)) GRID_BAR();
    }
    if (IN(1)) {
        { int tq_ = threadIdx.x; asm volatile("" : "+v"(tq_)); F.tid = tq_; F.lane = tq_ & 63; }
        pg::DenseSched S{(const char*)HN, (const char*)WIN, D * 2, D * 2, T / 256, NPROJ / 256, F.G, (int)blockIdx.x};
        pg::EpiProj E{PROJ, S5A};
        pg::gemm_phase<pg::EpiProj, pg::DenseSched, true>(F.lds, D, S, E);
        if (BOTH(1)) GRID_BAR();
    }
    if (IN(2)) {
        { int tq_ = threadIdx.x; asm volatile("" : "+v"(tq_)); F.tid = tq_; F.lane = tq_ & 63; }
        pg::S5Sched S{(const char*)S5A, (const char*)S5BQ, S5K * 2, S5KIN * 2, 256, 1, F.G, F.vcu};
        pg::EpiXloc E{XLOC};
        pg::gemm_phase<pg::EpiXloc, pg::S5Sched, true>(F.lds, S5KIN, S, E);
        {
            const int first = F.G > 128 ? F.vcu - 128 : F.vcu, stride = F.G > 128 ? F.G - 128 : F.G;
            LAS float* Kt = (LAS float*)F.lds;
            LAS float* Ere = Kt + S5L * 256; LAS float* Eim = Ere + 4 * 64;
            LAS float* Cr = Eim + 4 * 64; LAS float* Ci = Cr + 1024;
            for (int un = first; un >= 0 && un < 256; un += stride) {
                const int g = un >> 3, j = un & 7, ntau = 4 * j + 4;
                __syncthreads();
                for (int i = F.tid; i < ntau * 64; i += NTHR) *(LAS f32x4*)(Kt + 4 * i) = *(const f32x4*)(KTAB + (size_t)g * S5L * 256 + 4 * i);
                for (int i = F.tid; i < 1024; i += NTHR) { Cr[i] = args.in[8][g * 1024 + i]; Ci[i] = args.in[9][g * 1024 + i]; }
                if (F.tid < 256) { const int tl = F.tid >> 6, n = F.tid & 63; const float tau = (float)(4 * j + tl + 1); const float dt = __expf(args.in[3][g]);
                    const float are = fminf(args.in[4][g * 64 + n], -1e-4f), aim = args.in[5][g * 64 + n];
                    const float mag = __expf(tau * dt * are); float sn, cs; fcis(tau * dt * aim, &sn, &cs); Ere[F.tid] = mag * cs; Eim[F.tid] = mag * sn; }
                __syncthreads();
                for (int ch = F.tid; ch < 64 * (S5K / 8); ch += NTHR) {
                    const int rl = ch / (S5K / 8), c8 = ch % (S5K / 8), tl = rl >> 4, t = 4 * j + tl, p = rl & 15, col = c8 * 8;
                    float v[8];
                    if (col < S5KIN) { const int sidx = col >> 4, q0 = col & 15;
                        if (sidx <= t) { const f32x4 k0 = *(const LAS f32x4*)(Kt + (t - sidx) * 256 + p * 16 + q0), k1 = *(const LAS f32x4*)(Kt + (t - sidx) * 256 + p * 16 + q0 + 4);
                            v[0] = k0.x; v[1] = k0.y; v[2] = k0.z; v[3] = k0.w; v[4] = k1.x; v[5] = k1.y; v[6] = k1.z; v[7] = k1.w; }
                        else {
#pragma unroll
                            for (int i = 0; i < 8; ++i) v[i] = 0.f; }
                    } else { const int jj = (col - S5KIN) & 63, im = (col - S5KIN) >> 6;
#pragma unroll
                        for (int i = 0; i < 8; ++i) { const int n = jj + i; const float cr = Cr[p * 64 + n], ci = Ci[p * 64 + n], er = Ere[tl * 64 + n], ei = Eim[tl * 64 + n];
                            v[i] = im ? -(cr * ei + ci * er) : (cr * er - ci * ei); } }
                    u32x4 o; o.x = pk2(v[0], v[1]); o.y = pk2(v[2], v[3]); o.z = pk2(v[4], v[5]); o.w = pk2(v[6], v[7]);
                    *(u32x4*)(S5BT + ((size_t)g * S5KIN + 64 * j + rl) * S5K + col) = o;
                }
            }
            __syncthreads();
        }
    }
    if (IN(3)) {
        { int tq_ = threadIdx.x; asm volatile("" : "+v"(tq_)); F.tid = tq_; F.lane = tq_ & 63; }
        typedef short s16x4 __attribute__((ext_vector_type(4)));
        LAS float* wsl = (LAS float*)F.lds;
        LAS float* red = wsl + 512;
        LAS float* dnl = red + 32;
        LAS bf16* RQ = (LAS bf16*)(F.lds + 4352);
        LAS bf16* RK = RQ + 67 * 136;
        LAS bf16* RV = RK + 67 * 136;
        LAS bf16* QN = RV + 64 * 136;
        LAS bf16* KN = QN + 64 * 136;
        LAS bf16* KTl = KN + 64 * 136;
        LAS bf16* VTl = KTl + 128 * 72;
        const float* cw = args.in[13]; const float* cbias = args.in[14];
        for (int un = blockIdx.x; un < 256; un += F.G) {
            const int bh = un >> 4, seg = un & 15, b = bh >> 2, hd = bh & 3, t0 = seg * 512; const size_t row0 = (size_t)b * SEQ + t0;
            float Fl, Aval;
            {
                const float ipre = gates[(row0 + F.tid) * 8 + hd], fpre = gates[(row0 + F.tid) * 8 + 4 + hd];
                const float lf = fminf(fpre, 0.f) - log1pf(__expf(-fabsf(fpre)));
                float sc = lf;
#pragma unroll
                for (int o = 1; o < 64; o <<= 1) { const float tv = __shfl_up(sc, o); if (F.lane >= o) sc += tv; }
                if (F.lane == 63) red[F.wave] = sc;
                __syncthreads();
                float base = 0.f;
                for (int w2 = 0; w2 < F.wave; ++w2) base += red[w2];
                Fl = sc + base; Aval = ipre - Fl;
                float mx = Aval;
#pragma unroll
                for (int o = 1; o < 64; o <<= 1) mx = fmaxf(mx, __shfl_xor(mx, o));
                if (F.lane == 0) red[8 + F.wave] = mx;
                __syncthreads();
                float Amax = red[8];
                for (int w2 = 1; w2 < 8; ++w2) Amax = fmaxf(Amax, red[8 + w2]);
                wsl[F.tid] = __expf(Aval - Amax);
                FLOC[(size_t)bh * SEQ + t0 + F.tid] = Fl;
                if (F.tid == 511) { SEGS[un * 4 + 0] = Fl; SEGS[un * 4 + 1] = Amax; }
            }
            f32x16 dacc[2];
#pragma unroll
            for (int i = 0; i < 2; ++i)
#pragma unroll
                for (int q = 0; q < 16; ++q) dacc[i][q] = 0.f;
            const int cp = F.tid & 127, isk = cp >> 6, c2 = (cp & 63) * 2, tqr = F.tid >> 7;
            const int gch = isk * 512 + hd * 128 + c2;
            const float cw0a = cw[gch], cw1a = cw[1024 + gch], cw2a = cw[2048 + gch], cw3a = cw[3072 + gch], cba = cbias[gch];
            const float cw0b = cw[gch + 1], cw1b = cw[1024 + gch + 1], cw2b = cw[2048 + gch + 1], cw3b = cw[3072 + gch + 1], cbb = cbias[gch + 1];
            float dnacc0 = 0.f, dnacc1 = 0.f;
            u32x4 rt[7];
#define ML_RAW_LOAD(tsv) do { _Pragma("unroll") for (int ii = 0; ii < 7; ++ii) { const int ch = F.tid + NTHR * ii; u32x4 v = (u32x4){0u, 0u, 0u, 0u}; \
                if (ch < 2 * 67 * 16) { const int which = ch / (67 * 16), r = (ch % (67 * 16)) >> 4, c16 = ch & 15; const int tk = (tsv) - 3 + r; \
                    if (tk >= 0) v = *(const u32x4*)(PROJ + ((size_t)b * SEQ + tk) * NPROJ + (which ? O_K : O_Q) + hd * 128 + c16 * 8); } \
                else if (ch < 2 * 67 * 16 + 64 * 16) { const int c2 = ch - 2 * 67 * 16, r = c2 >> 4, c16 = c2 & 15; v = *(const u32x4*)(PROJ + ((size_t)b * SEQ + (tsv) + r) * NPROJ + O_V + hd * 128 + c16 * 8); } \
                rt[ii] = v; } } while (0)
            ML_RAW_LOAD(t0);
#define ML_RAW_STORE() do { _Pragma("unroll") for (int ii = 0; ii < 7; ++ii) { const int ch = F.tid + NTHR * ii; \
                if (ch < 2 * 67 * 16) { const int which = ch / (67 * 16), r = (ch % (67 * 16)) >> 4, c16 = ch & 15; *(LAS u32x4*)((which ? RK : RQ) + r * 136 + c16 * 8) = rt[ii]; } \
                else if (ch < 2 * 67 * 16 + 64 * 16) { const int c2_ = ch - 2 * 67 * 16, r = c2_ >> 4, c16 = c2_ & 15; *(LAS u32x4*)(RV + r * 136 + c16 * 8) = rt[ii]; } } } while (0)
            __syncthreads();
            ML_RAW_STORE(); ML_RAW_LOAD(t0 + 64);
            __syncthreads();
            for (int sb = 0; sb < 8; ++sb) {
                const int ts = t0 + sb * 64;
                {
                    const LAS unsigned* raw = (const LAS unsigned*)(isk ? RK : RQ) + c2 / 2; LAS unsigned* dst = (LAS unsigned*)(isk ? KN : QN) + c2 / 2; const int s0 = tqr * 16;
                    const unsigned h0 = raw[(s0 + 0) * 68], h1 = raw[(s0 + 1) * 68], h2 = raw[(s0 + 2) * 68];
                    float x3a = lo_bf(h0), x3b = hi_bf(h0), x2a = lo_bf(h1), x2b = hi_bf(h1), x1a = lo_bf(h2), x1b = hi_bf(h2);
#pragma unroll 4
                    for (int sidx = s0; sidx < s0 + 16; ++sidx) {
                        const unsigned xw = raw[(sidx + 3) * 68]; const float xa = lo_bf(xw), xb = hi_bf(xw);
                        float va = cba + cw0a * x3a + cw1a * x2a + cw2a * x1a + cw3a * xa, vb = cbb + cw0b * x3b + cw1b * x2b + cw2b * x1b + cw3b * xb;
                        x3a = x2a; x2a = x1a; x1a = xa; x3b = x2b; x2b = x1b; x1b = xb;
                        va *= sigmoidf_(va); vb *= sigmoidf_(vb);
                        if (isk) { const float wk = 0.08838834764831845f * wsl[sb * 64 + sidx]; va *= wk; vb *= wk; dnacc0 += va; dnacc1 += vb; }
                        dst[sidx * 68] = cvt_pk_bf16(va, vb);
                    }
                }
                __syncthreads();
#pragma unroll
                for (int ii = 0; ii < 2; ++ii) { const int ch = F.tid + NTHR * ii, r = ch >> 4, c16 = ch & 15;
                    *(u32x4*)(QH + ((size_t)bh * SEQ + ts + r) * 128 + c16 * 8) = *(const LAS u32x4*)(QN + r * 136 + c16 * 8);
                    *(u32x4*)(KH + ((size_t)bh * SEQ + ts + r) * 128 + c16 * 8) = *(const LAS u32x4*)(KN + r * 136 + c16 * 8); }
                {
                    const int c = F.tid & 127, sq = F.tid >> 7;
#pragma unroll
                    for (int half = 0; half < 2; ++half) { const int sA = sq * 16 + half * 8;
                        u32x4 kk, vv;
                        kk.x = (unsigned)KN[(sA + 0) * 136 + c] | ((unsigned)KN[(sA + 1) * 136 + c] << 16); kk.y = (unsigned)KN[(sA + 2) * 136 + c] | ((unsigned)KN[(sA + 3) * 136 + c] << 16);
                        kk.z = (unsigned)KN[(sA + 4) * 136 + c] | ((unsigned)KN[(sA + 5) * 136 + c] << 16); kk.w = (unsigned)KN[(sA + 6) * 136 + c] | ((unsigned)KN[(sA + 7) * 136 + c] << 16);
                        vv.x = (unsigned)RV[(sA + 0) * 136 + c] | ((unsigned)RV[(sA + 1) * 136 + c] << 16); vv.y = (unsigned)RV[(sA + 2) * 136 + c] | ((unsigned)RV[(sA + 3) * 136 + c] << 16);
                        vv.z = (unsigned)RV[(sA + 4) * 136 + c] | ((unsigned)RV[(sA + 5) * 136 + c] << 16); vv.w = (unsigned)RV[(sA + 6) * 136 + c] | ((unsigned)RV[(sA + 7) * 136 + c] << 16);
                        *(LAS u32x4*)(KTl + c * 72 + sA) = kk; *(LAS u32x4*)(VTl + c * 72 + sA) = vv; }
                }
                __syncthreads();
                {
                    const int e = F.tid >> 2, part = F.tid & 3;
                    const u32x4 v0 = *(const LAS u32x4*)(VTl + e * 72 + part * 16), v1 = *(const LAS u32x4*)(VTl + e * 72 + part * 16 + 8);
                    bf16* dst = VT + ((size_t)bh * 128 + e) * SEQ + ts + part * 16;
                    *(u32x4*)dst = v0; *(u32x4*)(dst + 8) = v1;
                    const int eb = F.wave >> 1, db0 = (F.wave & 1) * 2, r = F.lane & 31, hh = F.lane >> 5;
#pragma unroll
                    for (int ks = 0; ks < 4; ++ks) {
                        const bf16x8 a = *(const LAS bf16x8*)(VTl + (eb * 32 + r) * 72 + ks * 16 + hh * 8);
                        const bf16x8 b0 = *(const LAS bf16x8*)(KTl + (db0 * 32 + r) * 72 + ks * 16 + hh * 8), b1 = *(const LAS bf16x8*)(KTl + ((db0 + 1) * 32 + r) * 72 + ks * 16 + hh * 8);
                        dacc[0] = __builtin_amdgcn_mfma_f32_32x32x16_bf16(a, b0, dacc[0], 0, 0, 0);
                        dacc[1] = __builtin_amdgcn_mfma_f32_32x32x16_bf16(a, b1, dacc[1], 0, 0, 0);
                    }
                }
                if (sb < 7) { ML_RAW_STORE(); if (sb < 6) ML_RAW_LOAD(ts + 128); }
                __syncthreads();
            }
#undef ML_RAW_STORE
#undef ML_RAW_LOAD
            if (isk) { dnl[tqr * 128 + c2] = dnacc0; dnl[tqr * 128 + c2 + 1] = dnacc1; }
            {
                const int eb = F.wave >> 1, db0 = (F.wave & 1) * 2, r = F.lane & 31, hh = F.lane >> 5;
#pragma unroll
                for (int i = 0; i < 2; ++i)
#pragma unroll
                    for (int q = 0; q < 16; ++q) DC[((size_t)un * 128 + eb * 32 + (q & 3) + 8 * (q >> 2) + 4 * hh) * 128 + (db0 + i) * 32 + r] = dacc[i][q];
            }
            __syncthreads();
            if (F.tid < 128) DN[un * 128 + F.tid] = (dnl[F.tid] + dnl[128 + F.tid]) + (dnl[256 + F.tid] + dnl[384 + F.tid]);
            __syncthreads();
        }
        if (BOTH(3)) GRID_BAR();
    }
    if (IN(4)) {
        { int tq_ = threadIdx.x; asm volatile("" : "+v"(tq_)); F.tid = tq_; F.lane = tq_ & 63; }
        LAS float* agr = (LAS float*)F.lds; LAS float* agi = agr + 512;
        for (int un = blockIdx.x; un < 128; un += F.G) {
            const int b = un >> 5, g = un & 31, n = F.tid & 63, seg = F.tid >> 6;
            const float dt = __expf(args.in[3][g]);
            const float are = fminf(args.in[4][g * 64 + n], -1e-4f), aim = args.in[5][g * 64 + n];
            float ar, ai, Ar, Ai;
            { const float mag = __expf((float)S5L * dt * are); float sn, cs; fcis((float)S5L * dt * aim, &sn, &cs); ar = mag * cs; ai = mag * sn; }
            { const float mag = __expf((float)(S5L * 32) * dt * are); float sn, cs; fcis((float)(S5L * 32) * dt * aim, &sn, &cs); Ar = mag * cs; Ai = mag * sn; }
            const size_t row0 = (size_t)g * S5ROWS + b * S5NCH + seg * 32;
            float xr[32], xi[32];
#pragma unroll
            for (int jj = 0; jj < 32; ++jj) { xr[jj] = XLOC[(row0 + jj) * 128 + n]; xi[jj] = XLOC[(row0 + jj) * 128 + 64 + n]; }
            float sr = 0.f, si = 0.f;
#pragma unroll
            for (int jj = 0; jj < 32; ++jj) { const float tr = ar * sr - ai * si + xr[jj], ti = ar * si + ai * sr + xi[jj]; sr = tr; si = ti; }
            agr[seg * 64 + n] = sr; agi[seg * 64 + n] = si;
            __syncthreads();
            float cr = 0.f, ci = 0.f;
            for (int s2 = 0; s2 < seg; ++s2) { const float tr = Ar * cr - Ai * ci + agr[s2 * 64 + n], ti = Ar * ci + Ai * cr + agi[s2 * 64 + n]; cr = tr; ci = ti; }
#pragma unroll
            for (int jj = 0; jj < 32; ++jj) {
                S5A[(row0 + jj) * S5K + S5KIN + n] = f2bf(cr); S5A[(row0 + jj) * S5K + S5KIN + 64 + n] = f2bf(ci);
                const float tr = ar * cr - ai * ci + xr[jj], ti = ar * ci + ai * cr + xi[jj]; cr = tr; ci = ti; }
            __syncthreads();
        }
        for (int un = blockIdx.x; un < 256; un += F.G) {
            const int bh = un >> 4, slice = un & 15;
            float dc0[16], dc1[16];
#pragma unroll
            for (int j = 0; j < 16; ++j) { dc0[j] = DC[((size_t)(bh * 16 + j)) * 16384 + slice * 1024 + F.tid]; dc1[j] = DC[((size_t)(bh * 16 + j)) * 16384 + slice * 1024 + 512 + F.tid]; }
            float dn[16];
            const bool nrole = (slice == 0 && F.tid < 128);
#pragma unroll
            for (int j = 0; j < 16; ++j) dn[j] = nrole ? DN[(bh * 16 + j) * 128 + F.tid] : 0.f;
            float m = 0.f, C0 = 0.f, C1 = 0.f, nn = 0.f;
#pragma unroll
            for (int j = 0; j < 16; ++j) {
                const float Fend = SEGS[(bh * 16 + j) * 4 + 0], Amax = SEGS[(bh * 16 + j) * 4 + 1];
                const float R = fmaxf(m, Amax), c1 = __expf(m - R), c2 = __expf(Amax - R);
                CST[((size_t)(bh * 16 + j)) * 16384 + slice * 1024 + F.tid] = f2bf(c1 * C0); CST[((size_t)(bh * 16 + j)) * 16384 + slice * 1024 + 512 + F.tid] = f2bf(c1 * C1);
                if (nrole) NST[(bh * 16 + j) * 128 + F.tid] = c1 * nn;
                if (slice == 0 && F.tid == 0) { SEGS[(bh * 16 + j) * 4 + 2] = R; SEGS[(bh * 16 + j) * 4 + 3] = c2; }
                C0 = c1 * C0 + c2 * dc0[j]; C1 = c1 * C1 + c2 * dc1[j]; nn = c1 * nn + c2 * dn[j]; m = Fend + R;
            }
        }
        if (BOTH(4)) GRID_BAR();
    }
    if (IN(5)) {
        { int tq_ = threadIdx.x; asm volatile("" : "+v"(tq_)); F.tid = tq_; F.lane = tq_ & 63; }
        pg::S5Sched S{(const char*)S5A, (const char*)S5BT, S5K * 2, S5K * 2, S5KIN, 2, F.G, F.vcu};
        pg::EpiS5Y E{S5A, args.in[10], GY};
        pg::gemm_phase<pg::EpiS5Y, pg::S5Sched, true>(F.lds, S5K, S, E);
        if (BOTH(5)) GRID_BAR();
    }
    if (IN(6)) {
        { int tq_ = threadIdx.x; asm volatile("" : "+v"(tq_)); F.tid = tq_; F.lane = tq_ & 63; }
        typedef short s16x4 __attribute__((ext_vector_type(4)));
        LAS bf16* Kl = (LAS bf16*)F.lds;
        LAS bf16* Vl = Kl + 2 * 64 * 136;
        LAS bf16* Cl = Vl + 2 * 128 * 72;
        LAS float* nl = (LAS float*)(Cl + 128 * 136);
        LAS float* fll = nl + 128;
        LAS float* gl = fll + 512;
        const float* ng = args.in[16];
        for (int un = blockIdx.x; un < 256; un += F.G) {
            int tid6 = F.tid; asm volatile("" : "+v"(tid6));
            const int lane6 = tid6 & 63;
            const int bh = un >> 4, seg = un & 15, b = bh >> 2, hd = bh & 3, t0 = seg * 512;
            const float R = SEGS[un * 4 + 2], c2 = SEGS[un * 4 + 3];
            __syncthreads();
            for (int ch = tid6; ch < 2048; ch += NTHR) { const int r = ch >> 4, c16 = ch & 15; *(LAS u32x4*)(Cl + r * 136 + c16 * 8) = *(const u32x4*)(CST + (size_t)un * 16384 + r * 128 + c16 * 8); }
            if (tid6 < 128) { nl[tid6] = NST[un * 128 + tid6]; gl[tid6] = ng[hd * 128 + tid6]; }
            fll[tid6] = FLOC[(size_t)bh * SEQ + t0 + tid6];
            const int r = lane6 & 31, hh = lane6 >> 5;
            for (int pass = 0; pass < 2; ++pass) {
                const int qb = pass == 0 ? F.wave : 15 - F.wave, jmax = qb >> 1, npj = pass == 0 ? 4 : 8;
                bf16x8 Q[8];
                { const bf16* qp = QH + ((size_t)bh * SEQ + t0 + qb * 32 + r) * 128 + hh * 8;
#pragma unroll
                  for (int ks = 0; ks < 8; ++ks) Q[ks] = *(const bf16x8*)(qp + ks * 16); }
                u32x4 pk0, pk1, pv0, pv1;
                { const int kr = tid6 >> 4, kc = tid6 & 15; const bf16* kp = KH + ((size_t)bh * SEQ + t0) * 128; pk0 = *(const u32x4*)(kp + kr * 128 + kc * 8); pk1 = *(const u32x4*)(kp + (kr + 32) * 128 + kc * 8);
                  const int vr = tid6 >> 3, vc = tid6 & 7; const bf16* vp = VT + (size_t)bh * 128 * SEQ + t0; pv0 = *(const u32x4*)(vp + (size_t)vr * SEQ + vc * 8); pv1 = *(const u32x4*)(vp + (size_t)(vr + 64) * SEQ + vc * 8); }
                f32x16 acc[4];
#pragma unroll
                for (int eb = 0; eb < 4; ++eb)
#pragma unroll
                    for (int q = 0; q < 16; ++q) acc[eb][q] = 0.f;
                __syncthreads();
#pragma unroll
                for (int eb = 0; eb < 4; ++eb) {
#pragma unroll
                    for (int ks = 0; ks < 8; ++ks) { const bf16x8 a = *(const LAS bf16x8*)(Cl + (eb * 32 + r) * 136 + ks * 16 + hh * 8); acc[eb] = __builtin_amdgcn_mfma_f32_32x32x16_bf16(a, Q[ks], acc[eb], 0, 0, 0); }
                    __builtin_amdgcn_sched_barrier(0);
                }
                float den = 0.f;
#pragma unroll
                for (int ks = 0; ks < 8; ++ks) {
#pragma unroll
                    for (int jj = 0; jj < 8; ++jj) den += nl[ks * 16 + hh * 8 + jj] * bf2f((bf16)Q[ks][jj]);
                    __builtin_amdgcn_sched_barrier(0);
                }
                float dsum = 0.f;
                for (int j = 0; j < npj; ++j) {
                    LAS bf16* Kb = Kl + (j & 1) * 64 * 136; LAS bf16* Vb = Vl + (j & 1) * 128 * 72;
                    { const int kr = tid6 >> 4, kc = tid6 & 15; *(LAS u32x4*)(Kb + kr * 136 + kc * 8) = pk0; *(LAS u32x4*)(Kb + (kr + 32) * 136 + kc * 8) = pk1;
                      const int vr = tid6 >> 3, vc = tid6 & 7; *(LAS u32x4*)(Vb + vr * 72 + vc * 8) = pv0; *(LAS u32x4*)(Vb + (vr + 64) * 72 + vc * 8) = pv1; }
                    if (j + 1 < npj) { const int kr = tid6 >> 4, kc = tid6 & 15; const bf16* kp = KH + ((size_t)bh * SEQ + t0 + (j + 1) * 64) * 128; pk0 = *(const u32x4*)(kp + kr * 128 + kc * 8); pk1 = *(const u32x4*)(kp + (kr + 32) * 128 + kc * 8);
                        const int vr = tid6 >> 3, vc = tid6 & 7; const bf16* vp = VT + (size_t)bh * 128 * SEQ + t0 + (j + 1) * 64; pv0 = *(const u32x4*)(vp + (size_t)vr * SEQ + vc * 8); pv1 = *(const u32x4*)(vp + (size_t)(vr + 64) * SEQ + vc * 8); }
                    __syncthreads();
                    if (j <= jmax) {
                        const bool diag = (j == jmax); const int tq = qb * 32 + r;
#pragma unroll
                        for (int sb = 0; sb < 2; ++sb) {
                            f32x16 st;
#pragma unroll
                            for (int q = 0; q < 16; ++q) st[q] = 0.f;
#pragma unroll
                            for (int ks = 0; ks < 8; ++ks) { const bf16x8 a = *(const LAS bf16x8*)(Kb + (sb * 32 + r) * 136 + ks * 16 + hh * 8); st = __builtin_amdgcn_mfma_f32_32x32x16_bf16(a, Q[ks], st, 0, 0, 0); }
                            bf16x8 pb[2];
#pragma unroll
                            for (int sp = 0; sp < 2; ++sp) {
                                float pv[8];
#pragma unroll
                                for (int jj = 0; jj < 8; ++jj) { const int q = 8 * sp + jj; const int sidx = j * 64 + sb * 32 + (q & 3) + 8 * (q >> 2) + 4 * hh;
                                    float p = st[q] * c2; if (diag && sidx > tq) p = 0.f; pv[jj] = p; dsum += p; }
                                u32x4 w; w.x = cvt_pk_bf16(pv[0], pv[1]); w.y = cvt_pk_bf16(pv[2], pv[3]); w.z = cvt_pk_bf16(pv[4], pv[5]); w.w = cvt_pk_bf16(pv[6], pv[7]);
                                pb[sp] = __builtin_bit_cast(bf16x8, w);
                            }
#pragma unroll
                            for (int eb = 0; eb < 4; ++eb)
#pragma unroll
                                for (int sp = 0; sp < 2; ++sp) {
                                    const int so = sb * 32 + 16 * sp + 4 * hh;
                                    const s16x4 lo = *(const LAS s16x4*)(Vb + (eb * 32 + r) * 72 + so), hi = *(const LAS s16x4*)(Vb + (eb * 32 + r) * 72 + so + 8);
                                    const bf16x8 a = __builtin_shufflevector(lo, hi, 0, 1, 2, 3, 4, 5, 6, 7);
                                    acc[eb] = __builtin_amdgcn_mfma_f32_32x32x16_bf16(a, pb[sp], acc[eb], 0, 0, 0);
                                }
                            __builtin_amdgcn_sched_barrier(0);
                        }
                    }
                }
                den += dsum; den += __shfl_xor(den, 32);
                const float flo = __expf(-fll[qb * 32 + r] - R);
                const float inv = 1.f / fmaxf(fabsf(den), flo);
                float s1 = 0.f;
#pragma unroll
                for (int eb = 0; eb < 4; ++eb)
#pragma unroll
                    for (int q = 0; q < 16; ++q) { acc[eb][q] *= inv; s1 += acc[eb][q]; }
                s1 += __shfl_xor(s1, 32);
                const float mu = s1 * (1.f / 128.f);
                float s2 = 0.f;
#pragma unroll
                for (int eb = 0; eb < 4; ++eb)
#pragma unroll
                    for (int q = 0; q < 16; ++q) { const float dlt = acc[eb][q] - mu; s2 += dlt * dlt; }
                s2 += __shfl_xor(s2, 32);
                const float rstd = rsqrtf(s2 * (1.f / 128.f) + 1e-6f);
                const size_t row = (size_t)b * SEQ + t0 + qb * 32 + r;
                uint2 ovv[16];
#pragma unroll
                for (int eb = 0; eb < 4; ++eb)
#pragma unroll
                    for (int g4 = 0; g4 < 4; ++g4) ovv[eb * 4 + g4] = *(const uint2*)(PROJ + row * NPROJ + O_O + hd * 128 + eb * 32 + 8 * g4 + 4 * hh);
#pragma unroll
                for (int eb = 0; eb < 4; ++eb)
#pragma unroll
                    for (int g4 = 0; g4 < 4; ++g4) {
                        const int e0 = eb * 32 + 8 * g4 + 4 * hh;
                        const uint2 ov = ovv[eb * 4 + g4];
                        const f32x4 gg = *(const LAS f32x4*)(gl + e0);
                        const float o0 = (acc[eb][4 * g4 + 0] - mu) * rstd * gg.x * sigmoidf_(lo_bf(ov.x)), o1 = (acc[eb][4 * g4 + 1] - mu) * rstd * gg.y * sigmoidf_(hi_bf(ov.x));
                        const float o2 = (acc[eb][4 * g4 + 2] - mu) * rstd * gg.z * sigmoidf_(lo_bf(ov.y)), o3 = (acc[eb][4 * g4 + 3] - mu) * rstd * gg.w * sigmoidf_(hi_bf(ov.y));
                        uint2 w; w.x = cvt_pk_bf16(o0, o1); w.y = cvt_pk_bf16(o2, o3);
                        *(uint2*)(MIX + row * D + 512 + hd * 128 + e0) = w;
                    }
            }
        }
    }
    if (IN(7)) {
        { int tq_ = threadIdx.x; asm volatile("" : "+v"(tq_)); F.tid = tq_; F.lane = tq_ & 63; }
        pg::DenseSched S{(const char*)GY, (const char*)WGLU, 512 * 2, 512 * 2, T / 256, 2, F.G, (int)blockIdx.x};
        pg::EpiGlu E{GY, args.in[12], MIX};
        pg::gemm_phase<pg::EpiGlu, pg::DenseSched, true>(F.lds, 512, S, E);
        if (BOTH(7)) GRID_BAR();
    }
    if (IN(8)) {
        { int tq_ = threadIdx.x; asm volatile("" : "+v"(tq_)); F.tid = tq_; F.lane = tq_ & 63; }
        pg::DenseSched S{(const char*)MIX, (const char*)WOUT, D * 2, D * 2, T / 256, D / 256, F.G, (int)blockIdx.x};
        pg::EpiOut E{x, H};
        pg::gemm_phase<pg::EpiOut, pg::DenseSched, true>(F.lds, D, S, E);
        if (BOTH(8)) GRID_BAR();
    }
    if (IN(9)) {
        { int tq_ = threadIdx.x; asm volatile("" : "+v"(tq_)); F.tid = tq_; F.lane = tq_ & 63; }
        const float* gf = args.in[18]; const float* w_r = args.in[19]; const float* b_r = args.in[20];
        LAS float* rs = (LAS float*)(F.lds);
        LAS float* part = (LAS float*)(F.lds + 1024);
        LAS int* hist = (LAS int*)(F.lds + 1024 + 2 * 128 * 33 * 4);
        for (int tb = blockIdx.x; tb < T / 128; tb += F.G) {
            const int row0 = tb * 128;
            if (F.tid < 32) hist[F.tid] = 0;
            {
                f32x4 gg[4];
#pragma unroll
                for (int jq = 0; jq < 4; ++jq) gg[jq] = *(const f32x4*)(gf + 4 * F.lane + 256 * jq);
                f32x4 nx[4];
#pragma unroll
                for (int jq = 0; jq < 4; ++jq) nx[jq] = ldbf4(H + (size_t)(row0 + F.wave * 16) * D + 4 * F.lane + 256 * jq);
                for (int rr = 0; rr < 16; ++rr) {
                    const int r = F.wave * 16 + rr;
                    f32x4 v[4];
#pragma unroll
                    for (int jq = 0; jq < 4; ++jq) v[jq] = nx[jq];
                    if (rr < 15) {
#pragma unroll
                        for (int jq = 0; jq < 4; ++jq) nx[jq] = ldbf4(H + (size_t)(row0 + r + 1) * D + 4 * F.lane + 256 * jq); }
                    float ss = 0.f;
#pragma unroll
                    for (int jq = 0; jq < 4; ++jq) ss += v[jq].x * v[jq].x + v[jq].y * v[jq].y + v[jq].z * v[jq].z + v[jq].w * v[jq].w;
                    ss = wave_sum(ss);
                    const float rstd = rsqrtf(ss * (1.f / D) + 1e-5f);
                    if (F.lane == 0) rs[r] = rstd;
#pragma unroll
                    for (int jq = 0; jq < 4; ++jq) *(unsigned*)(HN8 + (size_t)(row0 + r) * D + 4 * F.lane + 256 * jq) = pk4_fp8(v[jq].x * rstd * gg[jq].x, v[jq].y * rstd * gg[jq].y, v[jq].z * rstd * gg[jq].z, v[jq].w * rstd * gg[jq].w);
                }
            }
            {
                const int rg = F.wave & 3, kh = F.wave >> 2, i = F.lane & 31, hh = F.lane >> 5;
                f32x16 acc;
#pragma unroll
                for (int q = 0; q < 16; ++q) acc[q] = 0.f;
                const bf16* hp = H + (size_t)(row0 + rg * 32 + i) * D + kh * 512 + 4 * hh;
                const float* wp = w_r + (size_t)(kh * 512 + 4 * hh) * NE + i; const float* gp = gf + kh * 512 + 4 * hh;
                f32x4 a0[4], g0[4], a1[4], g1[4]; f32x4 w0[4], w1[4];
#pragma unroll
                for (int u = 0; u < 4; ++u) { a0[u] = ldbf4(hp + 8 * u); g0[u] = *(const f32x4*)(gp + 8 * u);
                    w0[u] = (f32x4){wp[(size_t)(8 * u + 0) * NE], wp[(size_t)(8 * u + 1) * NE], wp[(size_t)(8 * u + 2) * NE], wp[(size_t)(8 * u + 3) * NE]}; }
                for (int k0 = 0; k0 < 512; k0 += 64) {
#pragma unroll
                    for (int u = 0; u < 4; ++u) { const int kk = k0 + 32 + 8 * u; a1[u] = ldbf4(hp + kk); g1[u] = *(const f32x4*)(gp + kk);
                        w1[u] = (f32x4){wp[(size_t)(kk + 0) * NE], wp[(size_t)(kk + 1) * NE], wp[(size_t)(kk + 2) * NE], wp[(size_t)(kk + 3) * NE]}; }
#pragma unroll
                    for (int u = 0; u < 4; ++u) { const f32x4 bb = w0[u] * g0[u];
                        acc = __builtin_amdgcn_mfma_f32_32x32x2f32(a0[u].x, bb.x, acc, 0, 0, 0); acc = __builtin_amdgcn_mfma_f32_32x32x2f32(a0[u].y, bb.y, acc, 0, 0, 0);
                        acc = __builtin_amdgcn_mfma_f32_32x32x2f32(a0[u].z, bb.z, acc, 0, 0, 0); acc = __builtin_amdgcn_mfma_f32_32x32x2f32(a0[u].w, bb.w, acc, 0, 0, 0); }
                    if (k0 + 64 < 512) {
#pragma unroll
                        for (int u = 0; u < 4; ++u) { const int kk = k0 + 64 + 8 * u; a0[u] = ldbf4(hp + kk); g0[u] = *(const f32x4*)(gp + kk);
                            w0[u] = (f32x4){wp[(size_t)(kk + 0) * NE], wp[(size_t)(kk + 1) * NE], wp[(size_t)(kk + 2) * NE], wp[(size_t)(kk + 3) * NE]}; } }
#pragma unroll
                    for (int u = 0; u < 4; ++u) { const f32x4 bb = w1[u] * g1[u];
                        acc = __builtin_amdgcn_mfma_f32_32x32x2f32(a1[u].x, bb.x, acc, 0, 0, 0); acc = __builtin_amdgcn_mfma_f32_32x32x2f32(a1[u].y, bb.y, acc, 0, 0, 0);
                        acc = __builtin_amdgcn_mfma_f32_32x32x2f32(a1[u].z, bb.z, acc, 0, 0, 0); acc = __builtin_amdgcn_mfma_f32_32x32x2f32(a1[u].w, bb.w, acc, 0, 0, 0); }
                }
#pragma unroll
                for (int q = 0; q < 16; ++q) { const int r = rg * 32 + (q & 3) + 8 * (q >> 2) + 4 * hh; part[(kh * 128 + r) * 33 + i] = acc[q]; }
            }
            __syncthreads();
            if (F.tid < 128) {
                const int r = F.tid; const float rstd = rs[r];
                float best[4]; int bi[4];
                for (int e = 0; e < 32; ++e) part[r * 33 + e] = (part[r * 33 + e] + part[(128 + r) * 33 + e]) * rstd + b_r[e];
#pragma unroll
                for (int k = 0; k < 4; ++k) {
                    float bv = -INFINITY; int be = 0;
                    for (int e = 0; e < 32; ++e) { const float l = part[r * 33 + e]; if (l > bv) { bv = l; be = e; } }
                    best[k] = bv; bi[k] = be; part[r * 33 + be] = -INFINITY;
                }
                const float e1 = __expf(best[1] - best[0]), e2 = __expf(best[2] - best[0]), e3 = __expf(best[3] - best[0]);
                const float inv = 1.f / (1.f + e1 + e2 + e3);
                *(int4*)(topi + (size_t)(row0 + r) * 4) = make_int4(bi[0], bi[1], bi[2], bi[3]);
                *(f32x4*)(topg + (size_t)(row0 + r) * 4) = (f32x4){inv, e1 * inv, e2 * inv, e3 * inv};
#pragma unroll
                for (int k = 0; k < 4; ++k) __hip_atomic_fetch_add(&hist[bi[k]], 1, __ATOMIC_RELAXED, __HIP_MEMORY_SCOPE_WORKGROUP);
            }
            __syncthreads();
            if (F.tid < 32) CNT[tb * 32 + F.tid] = hist[F.tid];
            __syncthreads();
        }
        if (BOTH(9)) GRID_BAR();
    }
    if (IN(10)) {
        { int tq_ = threadIdx.x; asm volatile("" : "+v"(tq_)); F.tid = tq_; F.lane = tq_ & 63; }
        LAS int* sb = (LAS int*)(F.lds);
        for (int tb = blockIdx.x; tb < T / 128; tb += F.G) {
            const int e = F.tid & 31, pt = F.tid >> 5;
            int sbef = 0, stot = 0;
            for (int w = pt * 16; w < pt * 16 + 16; ++w) { const int c = __hip_atomic_load(CNT + w * 32 + e, RLX_AGENT); stot += c; if (w < tb) sbef += c; }
            sb[pt * 32 + e] = sbef; sb[512 + pt * 32 + e] = stot;
            __syncthreads();
            if (F.tid < 32) { int b = 0, t = 0; for (int p = 0; p < 16; ++p) { b += sb[p * 32 + F.tid]; t += sb[512 + p * 32 + F.tid]; } sb[1024 + F.tid] = b; sb[1056 + F.tid] = t; sb[1120 + F.tid] = 0; }
            __syncthreads();
            if (F.tid == 0) { int ps = 0; for (int q = 0; q < 32; ++q) { sb[1088 + q] = ps; ps += ((sb[1056 + q] + MT - 1) / MT) * MT; } }
            __syncthreads();
            if (tb == 0 && F.tid < 32) ecnt[F.tid] = sb[1056 + F.tid];
            {
                const int a = tb * 512 + F.tid; const int ex = topi[a];
                const int lp = __hip_atomic_fetch_add(&sb[1120 + ex], 1, __ATOMIC_RELAXED, __HIP_MEMORY_SCOPE_WORKGROUP);
                const int slot = sb[1088 + ex] + sb[1024 + ex] + lp;
                slot_tok[slot] = a >> 2; tok_slot[a] = slot;
            }
            __syncthreads();
        }
        if (BOTH(10)) GRID_BAR();
    }
    if (IN(11) || IN(12)) {
        { int tq_ = threadIdx.x; asm volatile("" : "+v"(tq_)); F.tid = tq_; F.lane = tq_ & 63; }
        LAS int* til = (LAS int*)(F.lds + TIL_OFF);
        if (F.tid == 0) { int nt = 0; for (int e = 0; e < NE; ++e) { const int c = __hip_atomic_load(ecnt + e, RLX_AGENT); for (int r = 0; r < c; r += MT) { til[nt] = e; til[MAXTILES + nt] = (c - r) < MT ? (c - r) : MT; ++nt; } } til[2 * MAXTILES] = nt; }
        __syncthreads();
        if (IN(11)) {
            MoeSched S{(const char*)HN8, (const char*)WUP8, slot_tok, args.in[22], til, (LAS int*)(F.lds + IDX_OFF), (LAS float*)(F.lds + BIAS_OFF), D, D, 8, 2 * FF, F.G, (int)blockIdx.x, 1};
            pg::EpiUp E{(const LAS float*)(F.lds + BIAS_OFF), ACT8};
            S.build_list((LAS int*)(F.lds + ULIST_OFF)); __syncthreads();
            pg::gemm_phase<pg::EpiUp, MoeSched, true, true>(F.lds, D, S, E);
            {
                constexpr int I_DN = (FF / 64) * (D / 64);
                LAS bf16* scr = (LAS bf16*)(F.lds + F.wave * 16384);
                LAS int* qb = (LAS int*)(F.lds + MISC_OFF + 64);
                for (;;) {
                    __syncthreads();
                    if (F.tid == 0) *qb = (int)__hip_atomic_fetch_add((unsigned*)(F.ctl + CW_QHEAD), 64u, __ATOMIC_RELAXED, __HIP_MEMORY_SCOPE_AGENT);
                    __syncthreads();
                    const int base = __builtin_amdgcn_readfirstlane(*qb);
                    if (base >= NE * I_DN) break;
                    for (int k = 0; k < 8; ++k) { const int it = base + F.wave * 8 + k; if (it >= NE * I_DN) break;
                        const int e = it / I_DN; transpose_item<true>(args.in[23] + (size_t)e * FF * D, D, FF, D / 64, WDN8 + (size_t)e * D * FF, scr, it % I_DN, F.lane, RowId()); }
                }
            }
            if (BOTH(11)) GRID_BAR();
        }
        if (IN(12)) {
            MoeSched S{(const char*)ACT8, (const char*)WDN8, slot_tok, args.in[24], til, (LAS int*)(F.lds + IDX_OFF), (LAS float*)(F.lds + BIAS_OFF), FF, FF, 4, D, F.G, (int)blockIdx.x, 0};
            pg::EpiDown E{(const LAS float*)(F.lds + BIAS_OFF), YS};
            S.build_list((LAS int*)(F.lds + ULIST_OFF)); __syncthreads();
            pg::gemm_phase<pg::EpiDown, MoeSched, true, true>(F.lds, FF, S, E);
            if (BOTH(12)) GRID_BAR();
        }
    }
    if (IN(13)) {
        { int tq_ = threadIdx.x; asm volatile("" : "+v"(tq_)); F.tid = tq_; F.lane = tq_ & 63; }
        const float* gfin = args.in[25]; float* out = args.out;
        for (int row = gw; row < T; row += NGW) {
            f32x4 v[4];
#pragma unroll
            for (int j = 0; j < 4; ++j) v[j] = ldbf4(H + (size_t)row * D + 4 * F.lane + 256 * j);
            const int4 sl = *(const int4*)(tok_slot + (size_t)row * 4); const f32x4 gt = *(const f32x4*)(topg + (size_t)row * 4);
#pragma unroll
            for (int k = 0; k < 4; ++k) {
                const int s = k == 0 ? sl.x : k == 1 ? sl.y : k == 2 ? sl.z : sl.w;
#pragma unroll
                for (int j = 0; j < 4; ++j) { const unsigned y = *(const unsigned*)(YS + (size_t)s * D + 4 * F.lane + 256 * j);
                    typedef float f32x2_ __attribute__((ext_vector_type(2)));
                    const f32x2_ ylo = __builtin_amdgcn_cvt_pk_f32_fp8(y, false), yhi = __builtin_amdgcn_cvt_pk_f32_fp8(y, true);
                    v[j].x += gt[k] * ylo.x; v[j].y += gt[k] * ylo.y; v[j].z += gt[k] * yhi.x; v[j].w += gt[k] * yhi.y; }
            }
            float ss = 0.f;
#pragma unroll
            for (int j = 0; j < 4; ++j) ss += v[j].x * v[j].x + v[j].y * v[j].y + v[j].z * v[j].z + v[j].w * v[j].w;
            ss = wave_sum(ss);
            const float rstd = rsqrtf(ss * (1.f / D) + 1e-5f);
#pragma unroll
            for (int j = 0; j < 4; ++j) { const f32x4 gg = *(const f32x4*)(gfin + 4 * F.lane + 256 * j); __builtin_nontemporal_store(v[j] * rstd * gg, (f32x4*)(out + (size_t)row * D + 4 * F.lane + 256 * j)); }
        }
    }
#undef IN
#undef BOTH
}

extern "C" void kernel_launch(void* const* d_in, const int* in_sizes, int n_in, void* d_out, int out_size, void* d_ws, size_t ws_size, hipStream_t stream) {
    static int grid = 0;
    if (grid == 0) {
        int dev = 0, cus = 0, per_cu = 0;
        if (n_in != 26 || ws_size < WS_END) { fprintf(stderr, "kernel_launch: unexpected n_in %d / ws %zu\n", n_in, ws_size); grid = -1; return; }
        if (hipGetDevice(&dev) != hipSuccess || hipDeviceGetAttribute(&cus, hipDeviceAttributeMultiprocessorCount, dev) != hipSuccess) { grid = -1; return; }
        if (hipFuncSetAttribute((const void*)fwd, hipFuncAttributeMaxDynamicSharedMemorySize, LDS_BYTES) != hipSuccess) { fprintf(stderr, "kernel_launch: hipFuncSetAttribute failed\n"); grid = -1; return; }
        if (hipOccupancyMaxActiveBlocksPerMultiprocessor(&per_cu, (const void*)fwd, NTHR, LDS_BYTES) != hipSuccess || per_cu < 1) fprintf(stderr, "kernel_launch: occupancy query reports %d\n", per_cu);
        (void)hipGetLastError();
        grid = cus;
    }
    if (grid < 0) return;
    (void)in_sizes; (void)out_size;
    unsigned char* ws = (unsigned char*)d_ws;
    (void)hipMemsetAsync(ws + WS_CTL, 0, CTL_ZERO_BYTES, stream);
    Args a{};
    for (int i = 0; i < 26; ++i) a.in[i] = (const float*)d_in[i];
    a.out = (float*)d_out; a.ws = ws;
    a.ph_lo = 0; a.ph_hi = 14; a.li = 0; a.pad = 0;
    hipLaunchKernelGGL(fwd, dim3(grid), dim3(NTHR), LDS_BYTES, stream, a);
#if PROBE_LO >= 0
    a.ph_lo = PROBE_LO; a.ph_hi = PROBE_HI; a.li = 1; a.pad = PROBE_PAD;
    hipLaunchKernelGGL(fwd, dim3(grid), dim3(NTHR), LDS_BYTES, stream, a);
#endif
}
```

```cpp
#include <hip/hip_runtime.h>
#include <cstdio>
#include <cstdint>

#define GAS __attribute__((address_space(1)))
#define LAS __attribute__((address_space(3)))
typedef unsigned short bf16;
typedef short bf16x8 __attribute__((ext_vector_type(8)));
typedef float f32x4 __attribute__((ext_vector_type(4)));
typedef float f32x16 __attribute__((ext_vector_type(16)));
typedef unsigned u32x4 __attribute__((ext_vector_type(4)));
typedef unsigned u32x2 __attribute__((ext_vector_type(2)));
typedef GAS unsigned gu32;

#define PROBE_LO -1
#define PROBE_HI -1
#define PROBE_PAD 0
constexpr int NB = 4, SEQ = 8192, T = NB * SEQ, D = 1024;
constexpr int DIN = 2568, NPROJ = 2560;
constexpr int O_Q = 512, O_K = 1024, O_V = 1536, O_O = 2048, O_G = 2560;
constexpr int NE = 32, TOPK = 4, FF = 1024;
constexpr int NASSIGN = T * TOPK;
constexpr int MT = 256;
constexpr int NSLOTS = NASSIGN + NE * MT;
constexpr int MAXTILES = NSLOTS / MT;
constexpr int NWAVES = 8, NTHR = 512;
constexpr float W8_SCALE = 64.f, W8_INV = 1.f / 64.f;

constexpr size_t MiB = 1u << 20;
constexpr size_t WS_CTL = 0, CTL_ZERO_BYTES = 1 * MiB;
constexpr size_t WS_GATES = 1 * MiB;
constexpr size_t WS_TOPI = 2 * MiB;
constexpr size_t WS_TOPG = 3 * MiB;
constexpr size_t WS_SLOTTOK = 4 * MiB;
constexpr size_t WS_TOKSLOT = 5 * MiB;
constexpr size_t WS_CNT = 6 * MiB;
constexpr size_t WS_WIN = 8 * MiB;
constexpr size_t WS_WGLU = 13 * MiB;
constexpr size_t WS_WOUT = 14 * MiB;
constexpr size_t WS_WUP = 16 * MiB;
constexpr size_t WS_WDN = 144 * MiB;
constexpr size_t WS_HN = 208 * MiB;
constexpr size_t WS_PROJ = 272 * MiB;
constexpr size_t WS_GY = 432 * MiB;
constexpr size_t WS_MIX = 464 * MiB;
constexpr size_t WS_HRAW = 528 * MiB;
constexpr size_t WS_ACT = 272 * MiB;
constexpr size_t WS_H = 592 * MiB;
constexpr size_t WS_YS = 720 * MiB;
constexpr size_t WS_END = 992 * MiB;
constexpr int S5L = 32, S5KIN = S5L * 16, S5K = S5KIN + 128;
constexpr int S5NCH = SEQ / S5L, S5ROWS = NB * S5NCH;
constexpr size_t WS_S5A = 720 * MiB;
constexpr size_t WS_S5BT = 760 * MiB;
constexpr size_t WS_S5BQ = 836 * MiB;
constexpr size_t WS_XLOC = 790 * MiB;
constexpr size_t WS_QH = 866 * MiB;
constexpr size_t WS_KH = 898 * MiB;
constexpr size_t WS_VT = 930 * MiB;
constexpr size_t WS_DC = 962 * MiB;
constexpr size_t WS_CST = 978 * MiB;
constexpr size_t WS_FLOC = 986 * MiB;
constexpr size_t WS_DN = 987 * MiB;
constexpr size_t WS_NST = 988 * MiB;
constexpr size_t WS_SEGS = 989 * MiB;
constexpr size_t WS_WR2 = 991 * MiB;
constexpr size_t WS_KTAB = 990 * MiB;
static_assert(WS_S5A + (size_t)32 * S5ROWS * S5K * 2 <= WS_S5BT && WS_S5BT + (size_t)32 * S5KIN * S5K * 2 <= WS_XLOC && WS_XLOC + (size_t)32 * S5ROWS * 128 * 4 <= WS_S5BQ && WS_S5BQ + (size_t)32 * 256 * S5KIN * 2 <= WS_QH, "s5 map");
static_assert(WS_ACT + (size_t)NSLOTS * FF * 2 <= WS_H && WS_YS + (size_t)NSLOTS * D * 2 <= WS_END, "ws map");
constexpr int CW_QHEAD = 64;
constexpr int CW_BAR = 4096;

constexpr int RING_BYTES = 131072;
constexpr int MISC_OFF = RING_BYTES;
constexpr int IDX_OFF = MISC_OFF + 128;
constexpr int TIL_OFF = IDX_OFF + 2048;
constexpr int BIAS_OFF = TIL_OFF + 3 * MAXTILES * 4 + 256;
constexpr int ULIST_OFF = BIAS_OFF + 3 * 1024;
constexpr int LDS_BYTES = 147456;
static_assert(ULIST_OFF + 32 * 16 <= LDS_BYTES && (BIAS_OFF & 15) == 0, "LDS map");

#define RLX_AGENT __ATOMIC_RELAXED, __HIP_MEMORY_SCOPE_AGENT
__device__ __forceinline__ float bf2f(bf16 v) { return __uint_as_float(((unsigned)v) << 16); }
__device__ __forceinline__ bf16 f2bf(float f) { unsigned u = __float_as_uint(f); u += 0x7fffu + ((u >> 16) & 1u); return (bf16)(u >> 16); }
__device__ __forceinline__ unsigned pk2(float lo, float hi) { return (unsigned)f2bf(lo) | ((unsigned)f2bf(hi) << 16); }
__device__ __forceinline__ unsigned cvt_pk_bf16(float lo, float hi) { unsigned r; asm volatile("v_cvt_pk_bf16_f32 %0, %1, %2" : "=v"(r) : "v"(lo), "v"(hi)); return r; }
__device__ __forceinline__ unsigned pk4_fp8(float a, float b, float c, float d) { unsigned w = 0u; w = __builtin_amdgcn_cvt_pk_fp8_f32(a, b, w, false); w = __builtin_amdgcn_cvt_pk_fp8_f32(c, d, w, true); return w; }
__device__ __forceinline__ float lo_bf(unsigned u) { return __uint_as_float(u << 16); }
__device__ __forceinline__ float hi_bf(unsigned u) { return __uint_as_float(u & 0xffff0000u); }
__device__ __forceinline__ f32x4 ldbf4(const bf16* p) { const uint2 u = *(const uint2*)p; return (f32x4){lo_bf(u.x), hi_bf(u.x), lo_bf(u.y), hi_bf(u.y)}; }
__device__ __forceinline__ float wave_sum(float v) {
#pragma unroll
    for (int o = 1; o < 64; o <<= 1) v += __shfl_xor(v, o);
    return v;
}
__device__ __forceinline__ float sigmoidf_(float x) { return __builtin_amdgcn_rcpf(1.f + __builtin_amdgcn_exp2f(-1.4426950408889634f * x)); }
__device__ __forceinline__ void fcis(float x, float* sn, float* cs) { const float C = 0.15915494309189535f; const float rev = x * C; const float err = fmaf(x, C, -rev); const float fr = (rev - rintf(rev)) + err; *sn = __builtin_amdgcn_sinf(fr); *cs = __builtin_amdgcn_cosf(fr); }
__device__ __forceinline__ float gelu_tanh(float x) { const float u = 1.5957691216057308f * (x + 0.044715f * x * x * x); return x * __builtin_amdgcn_rcpf(1.f + __builtin_amdgcn_exp2f(-1.4426950408889634f * u)); }

#define XB_TMO      128
#define XB_XCNT(j)  (256  + 64 * (j))
#define XB_XSUB(j)  (1280 + 64 * (j))
#define XB_XGEN(j)  (2304 + 64 * (j))
#define XB_TOP      3328
#define XB_TOPGEN   3392
#define XCD_BAR_WORDS 3456
#define XB_SPIN_CAP (1u << 18)
__device__ __forceinline__ unsigned xb_ld(unsigned* p)              { return __hip_atomic_load(p, __ATOMIC_RELAXED, __HIP_MEMORY_SCOPE_AGENT); }
__device__ __forceinline__ unsigned xb_add(unsigned* p, unsigned v) { return __hip_atomic_fetch_add(p, v, __ATOMIC_RELAXED, __HIP_MEMORY_SCOPE_AGENT); }
__device__ __forceinline__ unsigned xb_xcc_id() { return (unsigned)__builtin_amdgcn_s_getreg((3 << 11) | 20) & 0xFu; }
#define XB_SPIN(cond, bar) do { unsigned _sp = 0; while (cond) { __builtin_amdgcn_s_sleep(1); \
    if ((++_sp & 255u) == 0u) { if (xb_ld(&(bar)[XB_TMO])) break; if (_sp > XB_SPIN_CAP) { atomicAdd(&(bar)[XB_TMO], 1u); break; } } } } while (0)
struct XcdBarrier { unsigned* bar; unsigned x; volatile LAS unsigned* st; };
__device__ __forceinline__ XcdBarrier xcd_barrier_post(unsigned* bar, volatile LAS unsigned* st) {
    XcdBarrier b; b.bar = bar; b.x = xb_xcc_id(); b.st = st;
    if (threadIdx.x == 0) (void)xb_add(&bar[XB_XCNT(b.x)], 1u);
    return b;
}
__device__ __forceinline__ void xcd_barrier_complete(unsigned* bar, unsigned x, unsigned& nloc, unsigned& nx) {
    const unsigned G = gridDim.x * gridDim.y * gridDim.z;
    unsigned sum, cnt, mine, sp = 0u;
    for (;;) {
        sum = 0u; cnt = 0u; mine = 0u;
#pragma unroll
        for (unsigned j = 0; j < 16; ++j) { const unsigned c = xb_ld(&bar[XB_XCNT(j)]); sum += c; cnt += (c > 0u) ? 1u : 0u; mine = (j == x) ? c : mine; }
        if (sum == G) break;
        __builtin_amdgcn_s_sleep(1);
        if ((++sp & 255u) == 0u) { if (xb_ld(&bar[XB_TMO])) break; if (sp > XB_SPIN_CAP) { atomicAdd(&bar[XB_TMO], 1u); break; } }
    }
    nloc = mine > 0u ? mine : 1u; nx = cnt > 0u ? cnt : 1u;
}
__device__ __forceinline__ void xcd_barrier(const XcdBarrier& b) {
    asm volatile("s_waitcnt vmcnt(0)" ::: "memory");
    __syncthreads();
    if (threadIdx.x == 0) {
        unsigned* bar = b.bar;
        __builtin_amdgcn_s_waitcnt(0);
        unsigned nloc = b.st[0], nx = b.st[1];
        if (nloc == 0u) { xcd_barrier_complete(bar, b.x, nloc, nx); b.st[0] = nloc; b.st[1] = nx; }
        const unsigned old = xb_add(&bar[XB_XSUB(b.x)], 1u);
        const unsigned gen = old / nloc;
        if (old + 1u == (gen + 1u) * nloc) {
            __builtin_amdgcn_fence(__ATOMIC_RELEASE, "agent");
            asm volatile("s_waitcnt vmcnt(0)" ::: "memory");
            const unsigned og = xb_add(&bar[XB_TOP], 1u);
            const unsigned tg = og / nx;
            if (og + 1u == (tg + 1u) * nx) xb_add(&bar[XB_TOPGEN], 1u);
            else XB_SPIN(xb_ld(&bar[XB_TOPGEN]) == tg, bar);
            __builtin_amdgcn_fence(__ATOMIC_ACQUIRE, "agent");
            xb_add(&bar[XB_XGEN(b.x)], 1u);
            asm volatile("s_waitcnt vmcnt(0)" ::: "memory");
        } else {
            XB_SPIN(xb_ld(&bar[XB_XGEN(b.x)]) == gen, bar);
            __builtin_amdgcn_fence(__ATOMIC_ACQUIRE, "agent");
            asm volatile("s_waitcnt vmcnt(0)" ::: "memory");
        }
    }
    __syncthreads();
}

namespace pg {
constexpr int BM = 256, BK = 64, HALF = 128, HTB = HALF * BK * 2, STAGE_BYTES = 8 * HTB, NXCD = 8, WGM = 4;
__host__ __device__ __forceinline__ int lds_byte(int r, int c) { const int st = (r >> 4) * 2 + (c >> 5), rr = r & 15, cc = c & 31, ob = rr * 64 + cc * 2; return st * 1024 + (ob ^ (((ob >> 9) & 1) << 5)); }
__host__ __device__ __forceinline__ void stage_rc(int b, int& R, int& C) { const int st = b / 1024, sb = b % 1024, swz = sb ^ (((sb >> 9) & 1) << 5); R = (st >> 1) * 16 + swz / 64; C = (st & 1) * 32 + (swz % 64) / 2; }
__host__ __device__ __forceinline__ int perm32(int rho) { const int n = rho >> 4, i = rho & 15; return 8 * (i >> 2) + 4 * n + (i & 3); }

struct Unit { unsigned A, B; int pm, pn, e, nrows; };
__device__ __forceinline__ __amdgpu_buffer_rsrc_t mkrsrc(const void* p) { return __builtin_amdgcn_make_buffer_rsrc((void*)p, 0, 0x7fffffff, 0x00020000); }

__device__ __forceinline__ bool tile_order(int i, int G, int c, int nM, int nN, int& pm, int& pn) {
    const int nwg = nM * nN; const long L = (long)i * G + c; if (L >= nwg) return false;
    int wgid = (int)L; { const int q = nwg / NXCD, r = nwg % NXCD, xcd = wgid % NXCD, off = wgid / NXCD; wgid = (xcd < r ? xcd * (q + 1) : r * (q + 1) + (xcd - r) * q) + off; }
    const int nig = WGM * nN, gid = wgid / nig, fm = gid * WGM, gsz = (nM - fm) < WGM ? (nM - fm) : WGM;
    pm = fm + ((wgid % nig) % gsz); pn = (wgid % nig) / gsz; return true;
}
struct DenseSched {
    const char* A; const char* Bt; int lda2  , K2  , nM, nN, G, c;
    __device__ __forceinline__ bool next(int i, Unit& u) const { int pm, pn; if (!tile_order(i, G, c, nM, nN, pm, pn)) return false;
        u.A = (unsigned)pm * 256u * (unsigned)lda2; u.B = (unsigned)pn * 256u * (unsigned)K2; u.pm = pm; u.pn = pn; u.e = 0; u.nrows = 256; return true; }
    __device__ __forceinline__ __amdgpu_buffer_rsrc_t rsrcA() const { return mkrsrc(A); }
    __device__ __forceinline__ __amdgpu_buffer_rsrc_t rsrcB() const { return mkrsrc(Bt); }
    __device__ __forceinline__ void prefetch(const Unit&, int, int) const {}
    __device__ __forceinline__ unsigned aoff(const Unit&, int row, int) const { return (unsigned)row * (unsigned)lda2; }
};

typedef int i32x8 __attribute__((ext_vector_type(8)));
template <class Epi, class Sched, bool ALIGN_EPI, bool FP8 = false>
__device__ __forceinline__ void gemm_phase(LAS unsigned char* lds, const int K, const Sched& S, const Epi& E) {
    const int tid = threadIdx.x, wid = __builtin_amdgcn_readfirstlane(tid >> 6), lane = tid & 63, wr = wid >> 2, wc = wid & 3, fr = lane & 15, fq = lane >> 4;
    const int nt = FP8 ? K / 128 : K / BK;
    unsigned voffA[2][2], voffB[2];
#pragma unroll
    for (int i = 0; i < 1; ++i) { int R, C; if constexpr (FP8) { const int p = tid + 512 * i; R = p >> 3; C = (((p >> 1) & 3) ^ ((R >> 1) & 3)) * 32 + (p & 1) * 16; } else { stage_rc(tid * 16 + i * 8192, R, C); C *= 2; }
        const int Rb = Epi::PERM ? ((R & ~31) + perm32(R & 31)) : R; voffB[i] = (unsigned)(Rb * K * (FP8 ? 1 : 2) + C); }
    const unsigned kstep = (unsigned)(BK * 2);
    const unsigned hstep = (unsigned)HALF * K * (FP8 ? 1 : 2);
    const unsigned b64step = hstep / 2;
    const unsigned ldsw = (unsigned)wid * 1024u;
    const int aoff = FP8 ? (wr * 64 + fr) * 128 + ((fq ^ ((fr >> 1) & 3)) * 32) : lds_byte(wr * 64 + fr, fq * 8);
    const int boff = FP8 ? (wc * 32 + fr) * 128 + ((fq ^ ((fr >> 1) & 3)) * 32) : lds_byte(wc * 32 + fr, fq * 8);
#define PG_SA(b, h) (((b) * 2 + (h)) * HTB)
#define PG_SB(b, h) ((4 + (b) * 2 + (h)) * HTB)
#define PG_STAGE(bufoff, so, voff) do { _Pragma("unroll") for (int _i = 0; _i < 2; ++_i) \
        __builtin_amdgcn_raw_ptr_buffer_load_lds(rA, (LAS void*)(lds + (bufoff) + ldsw + _i * 8192), 16, (int)(voff)[_i], (int)(so), 0, 0); } while (0)
#define PG_STAGEB(bufoff, so) do { _Pragma("unroll") for (int _i = 0; _i < 2; ++_i) \
        __builtin_amdgcn_raw_ptr_buffer_load_lds(rB, (LAS void*)(lds + (bufoff) + ldsw + _i * 8192), 16, (int)voffB[0], (int)((so) + _i * b64step), 0, 0); } while (0)
#define PG_LD8(p, p2) __builtin_bit_cast(i32x8, __builtin_shufflevector(*(const LAS u32x4*)(p), *(const LAS u32x4*)(p2), 0, 1, 2, 3, 4, 5, 6, 7))
#define PG_LDA(dst, b, h) do { if constexpr (FP8) { _Pragma("unroll") for (int m = 0; m < 4; ++m) dst##8[m] = PG_LD8(lds + PG_SA(b, h) + aoff + m * 2048, lds + PG_SA(b, h) + aoff + m * 2048 + 16); } \
        else { _Pragma("unroll") for (int m = 0; m < 4; ++m) _Pragma("unroll") for (int k = 0; k < 2; ++k) dst[m][k] = *(const LAS bf16x8*)(lds + PG_SA(b, h) + aoff + m * 2048 + k * 1024); } } while (0)
#define PG_LDB(dst, b, h) do { if constexpr (FP8) { _Pragma("unroll") for (int n = 0; n < 2; ++n) dst##8[n] = PG_LD8(lds + PG_SB(b, h) + boff + n * 2048, lds + PG_SB(b, h) + boff + n * 2048 + 16); } \
        else { _Pragma("unroll") for (int n = 0; n < 2; ++n) _Pragma("unroll") for (int k = 0; k < 2; ++k) dst[n][k] = *(const LAS bf16x8*)(lds + PG_SB(b, h) + boff + n * 2048 + k * 1024); } } while (0)
#define PG_MMA(ai, bj, At, Bt) do { __builtin_amdgcn_s_setprio(1); if constexpr (FP8) { _Pragma("unroll") for (int m = 0; m < 4; ++m) _Pragma("unroll") for (int n = 0; n < 2; ++n) \
            acc[ai][bj][m][n] = __builtin_amdgcn_mfma_scale_f32_16x16x128_f8f6f4(Bt##8[n], At##8[m], acc[ai][bj][m][n], 0, 0, 0, 0, 0, 0); } \
        else { _Pragma("unroll") for (int m = 0; m < 4; ++m) _Pragma("unroll") for (int n = 0; n < 2; ++n) _Pragma("unroll") for (int k = 0; k < 2; ++k) \
            acc[ai][bj][m][n] = __builtin_amdgcn_mfma_f32_16x16x32_bf16(Bt[n][k], At[m][k], acc[ai][bj][m][n], 0, 0, 0); } __builtin_amdgcn_s_setprio(0); } while (0)
#define PG_WAIT_V(n) asm volatile("s_waitcnt vmcnt(" #n ")" ::: "memory")
#define PG_WAIT_L(n) asm volatile("s_waitcnt lgkmcnt(" #n ")" ::: "memory")
#define PG_BAR __builtin_amdgcn_s_barrier()
#define PG_SCHED __builtin_amdgcn_sched_barrier(0)
#define PG_SET_AOFF(u, ib) do { int _t = threadIdx.x; asm volatile("" : "+v"(_t));     \
        _Pragma("unroll") for (int _i = 0; _i < 2; ++_i) { int _R, _C; if constexpr (FP8) { const int _p = _t + 512 * _i; _R = _p >> 3; _C = (((_p >> 1) & 3) ^ ((_R >> 1) & 3)) * 32 + (_p & 1) * 16; } else { stage_rc(_t * 16 + _i * 8192, _R, _C); _C *= 2; } \
        voffA[0][_i] = S.aoff(u, _R, ib) + (unsigned)_C; voffA[1][_i] = S.aoff(u, _R + HALF, ib) + (unsigned)_C; } } while (0)
    Unit cur, nxt; int ui = 0;
    if (!S.next(0, cur)) return;
    f32x4 acc[2][2][4][2];
#pragma unroll
    for (int a = 0; a < 2; ++a)
#pragma unroll
        for (int b = 0; b < 2; ++b)
#pragma unroll
            for (int m = 0; m < 4; ++m)
#pragma unroll
                for (int n = 0; n < 2; ++n) acc[a][b][m][n] = (f32x4){0.f, 0.f, 0.f, 0.f};
    bf16x8 At[FP8 ? 1 : 4][2], B0[2][2], B1[2][2]; i32x8 At8[FP8 ? 4 : 1], B08[2], B18[2];
    const __amdgpu_buffer_rsrc_t rA = S.rsrcA(), rB = S.rsrcB();
    unsigned cA = cur.A, cB = cur.B;
    S.prefetch(cur, 0, 0);
    PG_WAIT_V(0); __syncthreads();
    PG_SET_AOFF(cur, 0);
    PG_STAGEB(PG_SB(0, 0), cB); PG_STAGEB(PG_SB(0, 1), cB + hstep); PG_STAGE(PG_SA(0, 0), cA, voffA[0]); PG_STAGE(PG_SA(0, 1), cA, voffA[1]);
    if (wr == 1) PG_BAR;
    PG_WAIT_V(2); PG_BAR;
    PG_STAGEB(PG_SB(1, 0), cB + kstep); PG_STAGE(PG_SA(1, 0), cA + kstep, voffA[0]); PG_STAGEB(PG_SB(1, 1), cB + hstep + kstep);
    PG_WAIT_V(6); PG_BAR;
    for (;;) {
        const bool has_next = S.next(ui + 1, nxt);
        const unsigned nA = has_next ? nxt.A : cA, nB = has_next ? nxt.B : cB;
        if (has_next) S.prefetch(nxt, (ui + 1) & 1, (ui + 1) % 3);
#pragma unroll 1
        for (int t = 0; t < nt; t += 2) {
            const bool last = (t == nt - 2);
            const unsigned a1 = cA + (unsigned)(t + 1) * kstep;
            const unsigned a2 = last ? nA : cA + (unsigned)(t + 2) * kstep, b2 = last ? nB : cB + (unsigned)(t + 2) * kstep;
            const unsigned a3 = a2 + kstep, b3 = b2 + kstep;
            PG_LDB(B0, 0, 0); PG_LDB(B1, 0, 1); PG_SCHED; PG_LDA(At, 0, 0); PG_STAGE(PG_SA(1, 1), a1, voffA[1]);
            PG_WAIT_V(8); PG_WAIT_L(0); PG_BAR; PG_MMA(0, 0, At, B0); PG_MMA(0, 1, At, B1); PG_BAR; PG_SCHED;
            if (last && has_next) PG_SET_AOFF(nxt, (ui + 1) & 1);
            PG_LDA(At, 0, 1); PG_STAGEB(PG_SB(0, 0), b2); PG_STAGEB(PG_SB(0, 1), b2 + hstep); PG_STAGE(PG_SA(0, 0), a2, voffA[0]);
            PG_WAIT_V(8); PG_WAIT_L(0); PG_BAR; PG_MMA(1, 0, At, B0); PG_MMA(1, 1, At, B1); PG_BAR; PG_SCHED;
            PG_LDB(B0, 1, 0); PG_LDB(B1, 1, 1); PG_SCHED; PG_LDA(At, 1, 0); PG_STAGE(PG_SA(0, 1), a2, voffA[1]);
            PG_WAIT_V(8); PG_WAIT_L(0); PG_BAR; PG_MMA(0, 0, At, B0); PG_MMA(0, 1, At, B1); PG_BAR; PG_SCHED;
            PG_LDA(At, 1, 1); PG_STAGEB(PG_SB(1, 0), b3); PG_STAGEB(PG_SB(1, 1), b3 + hstep); PG_STAGE(PG_SA(1, 0), a3, voffA[0]);
            PG_WAIT_V(8); PG_WAIT_L(0); PG_BAR; PG_MMA(1, 0, At, B0); PG_MMA(1, 1, At, B1); PG_BAR; PG_SCHED;
        }
        if constexpr (ALIGN_EPI) { if (wr == 0) PG_BAR; }
        {
            int tz = threadIdx.x; asm volatile("" : "+v"(tz)); const int lz = tz & 63;
            E(acc, cur, ui % 3, (tz >> 6) >> 2, (tz >> 6) & 3, lz & 15, lz >> 4);
        }
        if (!has_next) break;
#pragma unroll
        for (int a = 0; a < 2; ++a)
#pragma unroll
            for (int b = 0; b < 2; ++b)
#pragma unroll
                for (int m = 0; m < 4; ++m)
#pragma unroll
                    for (int n = 0; n < 2; ++n) acc[a][b][m][n] = (f32x4){0.f, 0.f, 0.f, 0.f};
        cur = nxt; cA = nA; cB = nB; ++ui;
        if constexpr (ALIGN_EPI) { if (wr == 1) PG_BAR; }
    }
    PG_WAIT_V(0);
    if constexpr (!ALIGN_EPI) { if (wr == 0) PG_BAR; }
    PG_BAR;
#undef PG_SA
#undef PG_SB
#undef PG_STAGE
#undef PG_STAGEB
#undef PG_LDA
#undef PG_LDB
#undef PG_MMA
#undef PG_LD8
#undef PG_WAIT_V
#undef PG_WAIT_L
#undef PG_BAR
#undef PG_SCHED
#undef PG_SET_AOFF
}

struct EpiProj {
    static constexpr bool PERM = true; bf16* P; bf16* S5A;
    __device__ __forceinline__ void operator()(const f32x4 (&acc)[2][2][4][2], const Unit& u, int bb, int wr, int wc, int fr, int fq) const {
        const int row0 = u.pm * BM + wr * 64 + fr, col0 = u.pn * BM + wc * 32 + 8 * fq;
#pragma unroll
        for (int ai = 0; ai < 2; ++ai)
#pragma unroll
            for (int m = 0; m < 4; ++m) { const int row = row0 + ai * HALF + m * 16; bf16* rowp = P + (size_t)row * NPROJ + col0;
                if (u.pn < 2) { const int b = row >> 13, tt = row & 8191; rowp = S5A + ((size_t)b * S5NCH + (tt / S5L)) * S5K + (tt % S5L) * 16 + (col0 & 15) + (size_t)(col0 >> 4) * S5ROWS * S5K; }
#pragma unroll
                for (int bj = 0; bj < 2; ++bj) { const f32x4 v0 = acc[ai][bj][m][0], v1 = acc[ai][bj][m][1];
                    u32x4 w; w.x = cvt_pk_bf16(v0[0], v0[1]); w.y = cvt_pk_bf16(v0[2], v0[3]); w.z = cvt_pk_bf16(v1[0], v1[1]); w.w = cvt_pk_bf16(v1[2], v1[3]);
                    *(u32x4*)(rowp + (u.pn < 2 ? (size_t)bj * 8 * S5ROWS * S5K : (size_t)bj * HALF)) = w; } }
    }
};
struct EpiXloc {
    static constexpr bool PERM = false; float* X;
    __device__ __forceinline__ void operator()(const f32x4 (&acc)[2][2][4][2], const Unit& u, int bb, int wr, int wc, int fr, int fq) const {
        const int row0 = (u.pm & 3) * BM + wr * 64 + fr, col0 = wc * 32 + 4 * fq;
#pragma unroll
        for (int ai = 0; ai < 2; ++ai)
#pragma unroll
            for (int m = 0; m < 4; ++m) { float* rp = X + ((size_t)u.e * S5ROWS + row0 + ai * HALF + m * 16) * 128 + col0;
#pragma unroll
                for (int n = 0; n < 2; ++n) *(f32x4*)(rp + n * 16) = acc[ai][0][m][n]; }
    }
};
struct EpiS5Y {
    static constexpr bool PERM = true; const bf16* S5A; const float* dskip; bf16* GY;
    __device__ __forceinline__ void operator()(const f32x4 (&acc)[2][2][4][2], const Unit& u, int bb, int wr, int wc, int fr, int fq) const {
        const int g = u.e, rg0 = (u.pm & 3) * BM + wr * 64 + fr, c0 = u.pn * BM + wc * 32 + 8 * fq;
#pragma unroll
        for (int bj = 0; bj < 2; ++bj) { const int col = c0 + bj * HALF, t = col >> 4, p0 = col & 15;
            const f32x4 d0 = *(const f32x4*)(dskip + g * 16 + p0), d1 = *(const f32x4*)(dskip + g * 16 + p0 + 4);
#pragma unroll
            for (int ai = 0; ai < 2; ++ai)
#pragma unroll
                for (int m = 0; m < 4; ++m) { const int rg = rg0 + ai * HALF + m * 16; const int b = rg / S5NCH, c = rg % S5NCH;
                    const u32x4 uu = *(const u32x4*)(S5A + ((size_t)g * S5ROWS + rg) * S5K + col);
                    const f32x4 v0 = acc[ai][bj][m][0], v1 = acc[ai][bj][m][1];
                    u32x4 w;
                    w.x = cvt_pk_bf16(gelu_tanh(v0[0] + d0[0] * lo_bf(uu.x)), gelu_tanh(v0[1] + d0[1] * hi_bf(uu.x))); w.y = cvt_pk_bf16(gelu_tanh(v0[2] + d0[2] * lo_bf(uu.y)), gelu_tanh(v0[3] + d0[3] * hi_bf(uu.y)));
                    w.z = cvt_pk_bf16(gelu_tanh(v1[0] + d1[0] * lo_bf(uu.z)), gelu_tanh(v1[1] + d1[1] * hi_bf(uu.z))); w.w = cvt_pk_bf16(gelu_tanh(v1[2] + d1[2] * lo_bf(uu.w)), gelu_tanh(v1[3] + d1[3] * hi_bf(uu.w)));
                    *(u32x4*)(GY + ((size_t)b * SEQ + c * S5L + t) * 512 + g * 16 + p0) = w; } }
    }
};
struct S5Sched {
    const char* A; const char* B; int lda2, K2, brows, nN, G, c;
    __device__ __forceinline__ bool next(int i, Unit& u) const { const int L = i * G + c; if (L >= 128 * nN) return false;
        const int g = L / (4 * nN), r = L % (4 * nN), mh = r / nN, pn = r % nN;
        u.A = ((unsigned)g * S5ROWS + mh * 256u) * (unsigned)lda2; u.B = ((unsigned)g * brows + pn * 256u) * (unsigned)K2; u.pm = g * 4 + mh; u.pn = pn; u.e = g; u.nrows = 256; return true; }
    __device__ __forceinline__ __amdgpu_buffer_rsrc_t rsrcA() const { return mkrsrc(A); }
    __device__ __forceinline__ __amdgpu_buffer_rsrc_t rsrcB() const { return mkrsrc(B); }
    __device__ __forceinline__ void prefetch(const Unit&, int, int) const {}
    __device__ __forceinline__ unsigned aoff(const Unit&, int row, int) const { return (unsigned)row * (unsigned)lda2; }
};
struct EpiGlu {
    static constexpr bool PERM = true; const bf16* GY; const float* bglu; bf16* MIX;
    __device__ __forceinline__ void operator()(const f32x4 (&acc)[2][2][4][2], const Unit& u, int bb, int wr, int wc, int fr, int fq) const {
        const int row0 = u.pm * BM + wr * 64 + fr, col0 = u.pn * BM + wc * 32 + 8 * fq;
#pragma unroll
        for (int bj = 0; bj < 2; ++bj) { const int col = col0 + bj * HALF;
            const f32x4 b0 = *(const f32x4*)(bglu + col), b1 = *(const f32x4*)(bglu + col + 4);
#pragma unroll
            for (int ai = 0; ai < 2; ++ai)
#pragma unroll
                for (int m = 0; m < 4; ++m) { const size_t row = (size_t)(row0 + ai * HALF + m * 16);
                    const u32x4 g = *(const u32x4*)(GY + row * 512 + col);
                    const f32x4 v0 = acc[ai][bj][m][0] + b0, v1 = acc[ai][bj][m][1] + b1;
                    u32x4 w;
                    w.x = cvt_pk_bf16(lo_bf(g.x) * sigmoidf_(v0[0]), hi_bf(g.x) * sigmoidf_(v0[1])); w.y = cvt_pk_bf16(lo_bf(g.y) * sigmoidf_(v0[2]), hi_bf(g.y) * sigmoidf_(v0[3]));
                    w.z = cvt_pk_bf16(lo_bf(g.z) * sigmoidf_(v1[0]), hi_bf(g.z) * sigmoidf_(v1[1])); w.w = cvt_pk_bf16(lo_bf(g.w) * sigmoidf_(v1[2]), hi_bf(g.w) * sigmoidf_(v1[3]));
                    *(u32x4*)(MIX + row * D + col) = w; } }
    }
};
struct EpiOut {
    static constexpr bool PERM = true; const float* x; bf16* H;
    __device__ __forceinline__ void operator()(const f32x4 (&acc)[2][2][4][2], const Unit& u, int bb, int wr, int wc, int fr, int fq) const {
        const int row0 = u.pm * BM + wr * 64 + fr, col0 = u.pn * BM + wc * 32 + 8 * fq;
#pragma unroll
        for (int ai = 0; ai < 2; ++ai)
#pragma unroll
            for (int m = 0; m < 4; ++m) { const size_t ro = (size_t)(row0 + ai * HALF + m * 16) * D + col0;
#pragma unroll
                for (int bj = 0; bj < 2; ++bj) { const f32x4 v0 = __builtin_nontemporal_load((const f32x4*)(x + ro + bj * HALF)) + acc[ai][bj][m][0], v1 = __builtin_nontemporal_load((const f32x4*)(x + ro + bj * HALF + 4)) + acc[ai][bj][m][1];
                    u32x4 w; w.x = cvt_pk_bf16(v0[0], v0[1]); w.y = cvt_pk_bf16(v0[2], v0[3]); w.z = cvt_pk_bf16(v1[0], v1[1]); w.w = cvt_pk_bf16(v1[2], v1[3]);
                    *(u32x4*)(H + ro + bj * HALF) = w; } }
    }
};
struct EpiUp {
    static constexpr bool PERM = true; const LAS float* bl; unsigned char* ACT;
    __device__ __forceinline__ void operator()(const f32x4 (&acc)[2][2][4][2], const Unit& u, int bb, int wr, int wc, int fr, int fq) const {
        const int row0 = u.pm * BM + wr * 64 + fr, j0 = u.pn * HALF + wc * 32 + 8 * fq;
        const LAS float* bg = bl + bb * 256 + wc * 32 + 8 * fq;
#pragma unroll
        for (int ai = 0; ai < 2; ++ai)
#pragma unroll
            for (int m = 0; m < 4; ++m) {
                float o[8];
                typedef float f32x2 __attribute__((ext_vector_type(2)));
#pragma unroll
                for (int n = 0; n < 2; ++n) { const f32x4 gb = *(const LAS f32x4*)(bg + 4 * n), lb = *(const LAS f32x4*)(bg + 128 + 4 * n);
#pragma unroll
                    for (int q = 0; q < 4; q += 2) {
                        f32x2 gv = (f32x2){acc[ai][0][m][n][q], acc[ai][0][m][n][q + 1]} * W8_INV + (f32x2){gb[q], gb[q + 1]};
                        f32x2 lv = (f32x2){acc[ai][1][m][n][q], acc[ai][1][m][n][q + 1]} * W8_INV + ((f32x2){lb[q], lb[q + 1]} + 1.f);
                        gv.x = fminf(gv.x, 7.f); gv.y = fminf(gv.y, 7.f);
                        lv.x = __builtin_amdgcn_fmed3f(lv.x, -6.f, 8.f); lv.y = __builtin_amdgcn_fmed3f(lv.y, -6.f, 8.f);
                        f32x2 tt = gv * (-1.702f * 1.4426950408889634f);
                        tt.x = __builtin_amdgcn_exp2f(tt.x); tt.y = __builtin_amdgcn_exp2f(tt.y);
                        tt = tt + 1.f;
                        tt.x = __builtin_amdgcn_rcpf(tt.x); tt.y = __builtin_amdgcn_rcpf(tt.y);
                        const f32x2 ov = (gv * tt) * lv;
                        o[n * 4 + q] = ov.x; o[n * 4 + q + 1] = ov.y; } }
                u32x2 w; w.x = pk4_fp8(o[0], o[1], o[2], o[3]); w.y = pk4_fp8(o[4], o[5], o[6], o[7]);
                *(u32x2*)(ACT + (size_t)(row0 + ai * HALF + m * 16) * FF + j0) = w; }
    }
};
struct EpiDown {
    static constexpr bool PERM = true; const LAS float* bl; unsigned char* YS;
    __device__ __forceinline__ void operator()(const f32x4 (&acc)[2][2][4][2], const Unit& u, int bb, int wr, int wc, int fr, int fq) const {
        const int row0 = u.pm * BM + wr * 64 + fr, col0 = u.pn * BM + wc * 32 + 8 * fq;
        const LAS float* bp = bl + bb * 256 + wc * 32 + 8 * fq;
#pragma unroll
        for (int ai = 0; ai < 2; ++ai)
#pragma unroll
            for (int m = 0; m < 4; ++m)
#pragma unroll
                for (int bj = 0; bj < 2; ++bj) { const f32x4 b0 = *(const LAS f32x4*)(bp + bj * HALF), b1 = *(const LAS f32x4*)(bp + bj * HALF + 4);
                    const f32x4 v0 = acc[ai][bj][m][0] * W8_INV + b0, v1 = acc[ai][bj][m][1] * W8_INV + b1;
                    u32x2 w; w.x = pk4_fp8(v0[0], v0[1], v0[2], v0[3]); w.y = pk4_fp8(v1[0], v1[1], v1[2], v1[3]);
                    *(u32x2*)(YS + (size_t)(row0 + ai * HALF + m * 16) * D + col0 + bj * HALF) = w; }
    }
};
}

struct MoeSched {
    const char* A; const char* W; const int* slot_tok; const float* bias; LAS int* til; LAS int* idx; LAS float* bl; int lda2, K2, nN, wrows  , G, c, gather;
    __device__ __forceinline__ void build_list(LAS int* ul) const {
        const int i = threadIdx.x;
        if (i < 32) { const int nM = til[2 * MAXTILES]; int pm = -1, pn = 0, e = 0, nr = 0;
            if (pg::tile_order(i, G, c, nM, nN, pm, pn)) { e = til[pm]; nr = til[MAXTILES + pm]; } else pm = -1;
            ul[i * 4 + 0] = pm; ul[i * 4 + 1] = pn; ul[i * 4 + 2] = e; ul[i * 4 + 3] = nr; }
    }
    __device__ __forceinline__ bool next(int i, pg::Unit& u) const {
        const LAS int* ul = (const LAS int*)((const LAS char*)til - TIL_OFF + ULIST_OFF);
        if (i >= 32) return false;
        const int pm = __builtin_amdgcn_readfirstlane(ul[i * 4 + 0]); if (pm < 0) return false;
        const int pn = __builtin_amdgcn_readfirstlane(ul[i * 4 + 1]), e = __builtin_amdgcn_readfirstlane(ul[i * 4 + 2]);
        u.pm = pm; u.pn = pn; u.e = e; u.nrows = __builtin_amdgcn_readfirstlane(ul[i * 4 + 3]);
        u.A = gather ? 0u : (unsigned)pm * 256u * (unsigned)lda2; u.B = ((unsigned)e * wrows + (unsigned)pn * 256u) * (unsigned)K2; return true; }
    __device__ __forceinline__ __amdgpu_buffer_rsrc_t rsrcA() const { return pg::mkrsrc(A); }
    __device__ __forceinline__ __amdgpu_buffer_rsrc_t rsrcB() const { return pg::mkrsrc(W); }
    __device__ __forceinline__ void prefetch(const pg::Unit& u, int ib, int bb) const {
        if (threadIdx.x >= 256 && threadIdx.x < 320) {
            const int l = threadIdx.x - 256;
            const float* src = gather ? bias + (size_t)u.e * 2 * FF + (l < 32 ? u.pn * 128 + 4 * l : FF + u.pn * 128 + 4 * (l - 32)) : bias + (size_t)u.e * D + u.pn * 256 + 4 * l;
            __builtin_amdgcn_global_load_lds((const unsigned*)src, (LAS unsigned*)(bl + bb * 256), 16, 0, 0); }
        if (gather && threadIdx.x < 256) { const int r = threadIdx.x; const int s = u.pm * 256 + (r < u.nrows ? r : u.nrows - 1);
            __builtin_amdgcn_global_load_lds((const unsigned*)(slot_tok + s), (LAS unsigned*)(idx + ib * 256 + (threadIdx.x & ~63)), 4, 0, 0); } }
    __device__ __forceinline__ unsigned aoff(const pg::Unit&, int row, int ib) const { return gather ? (unsigned)idx[ib * 256 + row] * (unsigned)lda2 : (unsigned)row * (unsigned)lda2; }
};

struct Frame {
    LAS unsigned char* lds; volatile LAS unsigned* MISC; gu32* ctl; int tid, lane, wave, vcu, G;
};
#define LDS_WAIT() asm volatile("s_waitcnt lgkmcnt(0)" ::: "memory")

template <bool F8, class RowMap>
__device__ __forceinline__ void transpose_item(const float* W, int ldw, int K, int nblk, void* WTv, LAS bf16* scr, int item, int lane, RowMap rowmap) {
    const int kb = item / nblk, nb = item % nblk, k0 = 64 * kb, n0 = 64 * nb;
    const float* src = W + (size_t)(k0 + (lane >> 4)) * ldw + n0 + 4 * (lane & 15);
    f32x4 v[16];
#pragma unroll
    for (int i = 0; i < 16; ++i) v[i] = __builtin_nontemporal_load((const f32x4*)(src + (size_t)(4 * i) * ldw));
#pragma unroll
    for (int i = 0; i < 16; ++i) { u32x2 o; o.x = pk2(v[i].x, v[i].y); o.y = pk2(v[i].z, v[i].w); *(LAS u32x2*)(scr + ((lane >> 4) + 4 * i) * 68 + 4 * (lane & 15)) = o; }
    LDS_WAIT(); asm volatile("" ::: "memory");
    const int c = lane & 7; const int r0 = rowmap(n0);
#pragma unroll
    for (int jn = 0; jn < 8; ++jn) { const int n = (lane >> 3) + 8 * jn; const LAS bf16* sp = scr + (8 * c) * 68 + n;
        if constexpr (F8) { u32x2 o; o.x = pk4_fp8(bf2f(sp[0]) * W8_SCALE, bf2f(sp[68]) * W8_SCALE, bf2f(sp[2 * 68]) * W8_SCALE, bf2f(sp[3 * 68]) * W8_SCALE);
            o.y = pk4_fp8(bf2f(sp[4 * 68]) * W8_SCALE, bf2f(sp[5 * 68]) * W8_SCALE, bf2f(sp[6 * 68]) * W8_SCALE, bf2f(sp[7 * 68]) * W8_SCALE);
            __builtin_nontemporal_store(o, (u32x2*)((unsigned char*)WTv + (size_t)(r0 + n) * K + k0 + 8 * c)); }
        else { u32x4 o; o.x = (unsigned)sp[0] | ((unsigned)sp[68] << 16); o.y = (unsigned)sp[2 * 68] | ((unsigned)sp[3 * 68] << 16); o.z = (unsigned)sp[4 * 68] | ((unsigned)sp[5 * 68] << 16); o.w = (unsigned)sp[6 * 68] | ((unsigned)sp[7 * 68] << 16);
            *(u32x4*)((bf16*)WTv + (size_t)(r0 + n) * K + k0 + 8 * c) = o; } }
    LDS_WAIT(); asm volatile("" ::: "memory");
}
struct RowId { __device__ __forceinline__ int operator()(int n0) const { return n0; } };
struct RowUp { __device__ __forceinline__ int operator()(int n0) const { return n0 < FF ? (n0 >> 7) * 256 + (n0 & 127) : ((n0 - FF) >> 7) * 256 + 128 + ((n0 - FF) & 127); } };

struct Args { const float* in[26]; float* out; unsigned char* ws; int ph_lo, ph_hi, li, pad; };

__global__ void __launch_bounds__(NTHR, 2) fwd(Args args) {
    extern __shared__ __attribute__((aligned(16))) unsigned char lds_raw[];
    Frame F;
    F.lds = (LAS unsigned char*)lds_raw;
    F.MISC = (volatile LAS unsigned*)(F.lds + MISC_OFF);
    F.tid = threadIdx.x; F.lane = F.tid & 63; F.wave = __builtin_amdgcn_readfirstlane(F.tid >> 6);
    F.G = gridDim.x; { const int bx = blockIdx.x; F.vcu = (F.G % 8 == 0) ? (bx % 8) * (F.G / 8) + bx / 8 : bx; }
    unsigned char* ws = args.ws;
    F.ctl = (gu32*)(ws + WS_CTL);
    if (F.tid < 32) ((LAS unsigned*)(F.lds + MISC_OFF))[F.tid] = 0u;
    __syncthreads();
    XcdBarrier bar = xcd_barrier_post((unsigned*)(F.ctl + CW_BAR) + args.li * XCD_BAR_WORDS, F.MISC + 8);
#define INP(i) (*(const float* const volatile*)((const char*)__builtin_amdgcn_kernarg_segment_ptr() + 8 * (i)))
    const int lo = args.ph_lo, hi = args.ph_hi;
#define IN(k) (lo <= (k) && (k) < hi)
#define BOTH(k) (IN(k) && IN((k) + 1))
#define GRID_BAR() xcd_barrier(bar)
    const float* x = args.in[0];
    bf16* WIN = (bf16*)(ws + WS_WIN); bf16* WGLU = (bf16*)(ws + WS_WGLU); bf16* WOUT = (bf16*)(ws + WS_WOUT); unsigned char* WUP8 = ws + WS_WUP; unsigned char* WDN8 = ws + WS_WDN;
    bf16* HN = (bf16*)(ws + WS_HN); bf16* PROJ = (bf16*)(ws + WS_PROJ); bf16* GY = (bf16*)(ws + WS_GY); bf16* MIX = (bf16*)(ws + WS_MIX);
    bf16* H = (bf16*)(ws + WS_H); unsigned char* ACT8 = ws + WS_ACT; unsigned char* HN8 = ws + WS_HN; unsigned char* YS = ws + WS_YS;
    float* gates = (float*)(ws + WS_GATES); int* topi = (int*)(ws + WS_TOPI); float* topg = (float*)(ws + WS_TOPG);
    int* slot_tok = (int*)(ws + WS_SLOTTOK); int* tok_slot = (int*)(ws + WS_TOKSLOT); int* CNT = (int*)(ws + WS_CNT); int* ecnt = CNT + 16384;
    bf16* S5A = (bf16*)(ws + WS_S5A); bf16* S5BT = (bf16*)(ws + WS_S5BT); bf16* S5BQ = (bf16*)(ws + WS_S5BQ); float* XLOC = (float*)(ws + WS_XLOC);
    bf16* QH = (bf16*)(ws + WS_QH); bf16* KH = (bf16*)(ws + WS_KH); bf16* VT = (bf16*)(ws + WS_VT); float* DC = (float*)(ws + WS_DC); bf16* CST = (bf16*)(ws + WS_CST);
    float* FLOC = (float*)(ws + WS_FLOC); float* DN = (float*)(ws + WS_DN); float* NST = (float*)(ws + WS_NST); float* SEGS = (float*)(ws + WS_SEGS); float* KTAB = (float*)(ws + WS_KTAB); bf16* WR2 = (bf16*)(ws + WS_WR2);
    const int gw = F.vcu * NWAVES + F.wave, NGW = F.G * NWAVES;

    if (IN(0)) {
        { int tq_ = threadIdx.x; asm volatile("" : "+v"(tq_)); F.tid = tq_; F.lane = tq_ & 63; }
        LAS bf16* scr = (LAS bf16*)(F.lds + F.wave * 16384);
        constexpr int I_IN = (D / 64) * (NPROJ / 64), I_GLU = (512 / 64) * (512 / 64), I_OUT = (D / 64) * (D / 64), I_UP = (D / 64) * (2 * FF / 64);
        constexpr int NITEMS = I_IN + I_GLU + I_OUT + NE * I_UP;
        for (int it = gw; it < NITEMS && !(args.pad & 1); it += NGW) {
            int r = it;
            if (r < I_IN) { transpose_item<false>(args.in[2], DIN, D, NPROJ / 64, WIN, scr, r, F.lane, RowId()); continue; } r -= I_IN;
            if (r < I_GLU) { transpose_item<false>(args.in[11], 512, 512, 512 / 64, WGLU, scr, r, F.lane, RowId()); continue; } r -= I_GLU;
            if (r < I_OUT) { transpose_item<false>(args.in[17], D, D, D / 64, WOUT, scr, r, F.lane, RowId()); continue; } r -= I_OUT;
            { const int e = r / I_UP; transpose_item<true>(args.in[21] + (size_t)e * D * 2 * FF, 2 * FF, D, 2 * FF / 64, WUP8 + (size_t)e * 2 * FF * D, scr, r % I_UP, F.lane, RowUp()); }
        }
        {
            const float* g = args.in[1]; const float* w_in = args.in[2]; const float* b_gates = args.in[15];
            float wg[16][8]; f32x4 gg[4];
#pragma unroll
            for (int jq = 0; jq < 4; ++jq) { gg[jq] = *(const f32x4*)(g + 4 * F.lane + 256 * jq);
#pragma unroll
                for (int i = 0; i < 4; ++i) { const int k = 4 * F.lane + 256 * jq + i; const f32x4 w0 = *(const f32x4*)(w_in + (size_t)k * DIN + O_G), w1 = *(const f32x4*)(w_in + (size_t)k * DIN + O_G + 4);
                    wg[4 * jq + i][0] = w0.x; wg[4 * jq + i][1] = w0.y; wg[4 * jq + i][2] = w0.z; wg[4 * jq + i][3] = w0.w; wg[4 * jq + i][4] = w1.x; wg[4 * jq + i][5] = w1.y; wg[4 * jq + i][6] = w1.z; wg[4 * jq + i][7] = w1.w; } }
            float bgv[8];
#pragma unroll
            for (int q = 0; q < 8; ++q) bgv[q] = b_gates[q];
            f32x4 nx[4];
            if (gw < T) {
#pragma unroll
                for (int jq = 0; jq < 4; ++jq) nx[jq] = __builtin_nontemporal_load((const f32x4*)(x + (size_t)gw * D + 4 * F.lane + 256 * jq)); }
            for (int row = gw; row < T && !(args.pad & 2); row += NGW) {
                f32x4 v[4];
#pragma unroll
                for (int jq = 0; jq < 4; ++jq) v[jq] = nx[jq];
                if (row + NGW < T) {
#pragma unroll
                    for (int jq = 0; jq < 4; ++jq) nx[jq] = __builtin_nontemporal_load((const f32x4*)(x + (size_t)(row + NGW) * D + 4 * F.lane + 256 * jq)); }
                float ss = 0.f;
#pragma unroll
                for (int jq = 0; jq < 4; ++jq) ss += v[jq].x * v[jq].x + v[jq].y * v[jq].y + v[jq].z * v[jq].z + v[jq].w * v[jq].w;
                ss = wave_sum(ss);
                const float rstd = rsqrtf(ss * (1.f / D) + 1e-5f);
                float ga[8] = {0, 0, 0, 0, 0, 0, 0, 0};
#pragma unroll
                for (int jq = 0; jq < 4; ++jq) {
                    v[jq] = v[jq] * rstd * gg[jq];
#pragma unroll
                    for (int i = 0; i < 4; ++i)
#pragma unroll
                        for (int q = 0; q < 8; ++q) ga[q] += v[jq][i] * wg[4 * jq + i][q];
                    uint2 o; o.x = pk2(v[jq].x, v[jq].y); o.y = pk2(v[jq].z, v[jq].w);
                    *(uint2*)(HN + (size_t)row * D + 4 * F.lane + 256 * jq) = o;
                }
#pragma unroll
                for (int q = 0; q < 8; ++q) ga[q] = wave_sum(ga[q]);
                if (F.lane == 0) { *(f32x4*)(gates + (size_t)row * 8) = (f32x4){ga[0] + bgv[0], ga[1] + bgv[1], ga[2] + bgv[2], ga[3] + bgv[3]}; *(f32x4*)(gates + (size_t)row * 8 + 4) = (f32x4){ga[4] + bgv[4], ga[5] + bgv[5], ga[6] + bgv[6], ga[7] + bgv[7]}; }
            }
        }
        for (int idx = gw * 64 + F.lane; idx < 4096; idx += NGW * 64) {
            const int sidx = idx >> 6, l = idx & 63, kb = 16 * sidx + 8 * (l >> 5), e = l & 31;
            float hv[8], lv[8];
#pragma unroll
            for (int jj = 0; jj < 8; ++jj) { const float w = args.in[18][kb + jj] * args.in[19][(size_t)(kb + jj) * NE + e]; const bf16 hb = f2bf(w); hv[jj] = bf2f(hb); lv[jj] = w - hv[jj]; }
            u32x4 oh, ol; oh.x = pk2(hv[0], hv[1]); oh.y = pk2(hv[2], hv[3]); oh.z = pk2(hv[4], hv[5]); oh.w = pk2(hv[6], hv[7]);
            ol.x = pk2(lv[0], lv[1]); ol.y = pk2(lv[2], lv[3]); ol.z = pk2(lv[4], lv[5]); ol.w = pk2(lv[6], lv[7]);
            *(u32x4*)(WR2 + (size_t)idx * 8) = oh; *(u32x4*)(WR2 + (size_t)(4096 + idx) * 8) = ol;
        }
        __syncthreads();
        for (int un = F.vcu; un < 256 && !(args.pad & 4); un += F.G) {
            const int g = un >> 3, j = un & 7;
            LAS float* Ere = (LAS float*)F.lds; LAS float* Eim = Ere + 4 * 64;
            LAS float* Bbr = Eim + 4 * 64; LAS float* Bbi = Bbr + 1024;
            LAS float* Cr = Bbi + 1024; LAS float* Ci = Cr + 1024;
            LAS float* E6r = Ci + 1024; LAS float* E6i = E6r + 1024;
            const float dt = __expf(args.in[3][g]);
            if (F.tid < 64) { const int n = F.tid;
                const float are = fminf(args.in[4][g * 64 + n], -1e-4f), aim = args.in[5][g * 64 + n];
                const float mag = __expf(dt * are); float sn, cs; fcis(dt * aim, &sn, &cs);
                const float nr = mag * cs - 1.f, ni = mag * sn, dn = are * are + aim * aim;
                const float cfr = (nr * are + ni * aim) / dn, cfi = (ni * are - nr * aim) / dn;
                for (int q = 0; q < 16; ++q) { const float br = args.in[6][(g * 64 + n) * 16 + q], bi = args.in[7][(g * 64 + n) * 16 + q]; Bbr[n * 16 + q] = cfr * br - cfi * bi; Bbi[n * 16 + q] = cfr * bi + cfi * br; }
            }
            for (int i = F.tid; i < 1024; i += NTHR) { Cr[i] = args.in[8][g * 1024 + i]; Ci[i] = args.in[9][g * 1024 + i]; }
            if (F.tid < 256) { const int tl = F.tid >> 6, n = F.tid & 63; const float tau = (float)(4 * j + tl);
                const float are = fminf(args.in[4][g * 64 + n], -1e-4f), aim = args.in[5][g * 64 + n];
                const float mag = __expf(tau * dt * are); float sn, cs; fcis(tau * dt * aim, &sn, &cs); Ere[F.tid] = mag * cs; Eim[F.tid] = mag * sn; }
            for (int i = F.tid; i < 1024; i += NTHR) { const int tau = i >> 5, n = 32 * (j & 1) + (i & 31);
                const float are = fminf(args.in[4][g * 64 + n], -1e-4f), aim = args.in[5][g * 64 + n];
                const float mag = __expf((float)tau * dt * are); float sn, cs; fcis((float)tau * dt * aim, &sn, &cs); E6r[i] = mag * cs; E6i[i] = mag * sn; }
            __syncthreads();
            {
                const int tl = F.tid >> 7, p = (F.tid >> 3) & 15, q0 = (F.tid & 7) * 2;
                float a0 = 0.f, a1 = 0.f;
                for (int n = 0; n < 64; ++n) { const float cr = Cr[p * 64 + n], ci = Ci[p * 64 + n], er = Ere[tl * 64 + n], ei = Eim[tl * 64 + n];
                    const float xr = cr * er - ci * ei, xi = cr * ei + ci * er;
                    a0 += xr * Bbr[n * 16 + q0] - xi * Bbi[n * 16 + q0]; a1 += xr * Bbr[n * 16 + q0 + 1] - xi * Bbi[n * 16 + q0 + 1]; }
                KTAB[((size_t)g * S5L + 4 * j + tl) * 256 + p * 16 + q0] = a0; KTAB[((size_t)g * S5L + 4 * j + tl) * 256 + p * 16 + q0 + 1] = a1;
            }
            for (int ch = F.tid; ch < 32 * (S5KIN / 8); ch += NTHR) {
                const int rl = ch / (S5KIN / 8), c8 = ch % (S5KIN / 8), r = 32 * j + rl, n = r & 63, im = (r >> 6) & 1, col = c8 * 8, sidx = col >> 4, q0 = col & 15;
                const float er = E6r[(S5L - 1 - sidx) * 32 + (n & 31)], ei = E6i[(S5L - 1 - sidx) * 32 + (n & 31)];
                float v[8];
#pragma unroll
                for (int i = 0; i < 8; ++i) { const float br = Bbr[n * 16 + q0 + i], bi = Bbi[n * 16 + q0 + i]; v[i] = im ? (er * bi + ei * br) : (er * br - ei * bi); }
                u32x4 o; o.x = pk2(v[0], v[1]); o.y = pk2(v[2], v[3]); o.z = pk2(v[4], v[5]); o.w = pk2(v[6], v[7]);
                *(u32x4*)(S5BQ + ((size_t)g * 256 + r) * S5KIN + col) = o;
            }
            __syncthreads();
        }
        if (BOTH(0)) GRID_BAR();
    }
    if (IN(1)) {
        { int tq_ = threadIdx.x; asm volatile("" : "+v"(tq_)); F.tid = tq_; F.lane = tq_ & 63; }
        pg::DenseSched S{(const char*)HN, (const char*)WIN, D * 2, D * 2, T / 256, NPROJ / 256, F.G, (int)blockIdx.x};
        pg::EpiProj E{PROJ, S5A};
        pg::gemm_phase<pg::EpiProj, pg::DenseSched, true>(F.lds, D, S, E);
        if (BOTH(1)) GRID_BAR();
    }
    if (IN(2)) {
        { int tq_ = threadIdx.x; asm volatile("" : "+v"(tq_)); F.tid = tq_; F.lane = tq_ & 63; }
        pg::S5Sched S{(const char*)S5A, (const char*)S5BQ, S5K * 2, S5KIN * 2, 256, 1, F.G, F.vcu};
        pg::EpiXloc E{XLOC};
        pg::gemm_phase<pg::EpiXloc, pg::S5Sched, true>(F.lds, S5KIN, S, E);
        {
            const int first = F.G > 128 ? F.vcu - 128 : F.vcu, stride = F.G > 128 ? F.G - 128 : F.G;
            LAS float* Kt = (LAS float*)F.lds;
            LAS float* Ere = Kt + S5L * 256; LAS float* Eim = Ere + 4 * 64;
            LAS float* Cr = Eim + 4 * 64; LAS float* Ci = Cr + 1024;
            for (int un = first; un >= 0 && un < 256; un += stride) {
                const int g = un >> 3, j = un & 7, ntau = 4 * j + 4;
                __syncthreads();
                for (int i = F.tid; i < ntau * 64; i += NTHR) *(LAS f32x4*)(Kt + 4 * i) = *(const f32x4*)(KTAB + (size_t)g * S5L * 256 + 4 * i);
                for (int i = F.tid; i < 1024; i += NTHR) { Cr[i] = args.in[8][g * 1024 + i]; Ci[i] = args.in[9][g * 1024 + i]; }
                if (F.tid < 256) { const int tl = F.tid >> 6, n = F.tid & 63; const float tau = (float)(4 * j + tl + 1); const float dt = __expf(args.in[3][g]);
                    const float are = fminf(args.in[4][g * 64 + n], -1e-4f), aim = args.in[5][g * 64 + n];
                    const float mag = __expf(tau * dt * are); float sn, cs; fcis(tau * dt * aim, &sn, &cs); Ere[F.tid] = mag * cs; Eim[F.tid] = mag * sn; }
                __syncthreads();
                for (int ch = F.tid; ch < 64 * (S5K / 8); ch += NTHR) {
                    const int rl = ch / (S5K / 8), c8 = ch % (S5K / 8), tl = rl >> 4, t = 4 * j + tl, p = rl & 15, col = c8 * 8;
                    float v[8];
                    if (col < S5KIN) { const int sidx = col >> 4, q0 = col & 15;
                        if (sidx <= t) { const f32x4 k0 = *(const LAS f32x4*)(Kt + (t - sidx) * 256 + p * 16 + q0), k1 = *(const LAS f32x4*)(Kt + (t - sidx) * 256 + p * 16 + q0 + 4);
                            v[0] = k0.x; v[1] = k0.y; v[2] = k0.z; v[3] = k0.w; v[4] = k1.x; v[5] = k1.y; v[6] = k1.z; v[7] = k1.w; }
                        else {
#pragma unroll
                            for (int i = 0; i < 8; ++i) v[i] = 0.f; }
                    } else { const int jj = (col - S5KIN) & 63, im = (col - S5KIN) >> 6;
#pragma unroll
                        for (int i = 0; i < 8; ++i) { const int n = jj + i; const float cr = Cr[p * 64 + n], ci = Ci[p * 64 + n], er = Ere[tl * 64 + n], ei = Eim[tl * 64 + n];
                            v[i] = im ? -(cr * ei + ci * er) : (cr * er - ci * ei); } }
                    u32x4 o; o.x = pk2(v[0], v[1]); o.y = pk2(v[2], v[3]); o.z = pk2(v[4], v[5]); o.w = pk2(v[6], v[7]);
                    *(u32x4*)(S5BT + ((size_t)g * S5KIN + 64 * j + rl) * S5K + col) = o;
                }
            }
            __syncthreads();
        }
    }
    if (IN(3)) {
        { int tq_ = threadIdx.x; asm volatile("" : "+v"(tq_)); F.tid = tq_; F.lane = tq_ & 63; }
        typedef short s16x4 __attribute__((ext_vector_type(4)));
        LAS float* wsl = (LAS float*)F.lds;
        LAS float* red = wsl + 512;
        LAS float* dnl = red + 32;
        LAS bf16* RQ = (LAS bf16*)(F.lds + 4352);
        LAS bf16* RK = RQ + 67 * 136;
        LAS bf16* RV = RK + 67 * 136;
        LAS bf16* QN = RV + 64 * 136;
        LAS bf16* KN = QN + 64 * 136;
        LAS bf16* KTl = KN + 64 * 136;
        LAS bf16* VTl = KTl + 128 * 72;
        const float* cw = args.in[13]; const float* cbias = args.in[14];
        for (int un = blockIdx.x; un < 256; un += F.G) {
            const int bh = un >> 4, seg = un & 15, b = bh >> 2, hd = bh & 3, t0 = seg * 512; const size_t row0 = (size_t)b * SEQ + t0;
            float Fl, Aval;
            {
                const float ipre = gates[(row0 + F.tid) * 8 + hd], fpre = gates[(row0 + F.tid) * 8 + 4 + hd];
                const float lf = fminf(fpre, 0.f) - log1pf(__expf(-fabsf(fpre)));
                float sc = lf;
#pragma unroll
                for (int o = 1; o < 64; o <<= 1) { const float tv = __shfl_up(sc, o); if (F.lane >= o) sc += tv; }
                if (F.lane == 63) red[F.wave] = sc;
                __syncthreads();
                float base = 0.f;
                for (int w2 = 0; w2 < F.wave; ++w2) base += red[w2];
                Fl = sc + base; Aval = ipre - Fl;
                float mx = Aval;
#pragma unroll
                for (int o = 1; o < 64; o <<= 1) mx = fmaxf(mx, __shfl_xor(mx, o));
                if (F.lane == 0) red[8 + F.wave] = mx;
                __syncthreads();
                float Amax = red[8];
                for (int w2 = 1; w2 < 8; ++w2) Amax = fmaxf(Amax, red[8 + w2]);
                wsl[F.tid] = __expf(Aval - Amax);
                FLOC[(size_t)bh * SEQ + t0 + F.tid] = Fl;
                if (F.tid == 511) { SEGS[un * 4 + 0] = Fl; SEGS[un * 4 + 1] = Amax; }
            }
            f32x16 dacc[2];
#pragma unroll
            for (int i = 0; i < 2; ++i)
#pragma unroll
                for (int q = 0; q < 16; ++q) dacc[i][q] = 0.f;
            const int cp = F.tid & 127, isk = cp >> 6, c2 = (cp & 63) * 2, tqr = F.tid >> 7;
            const int gch = isk * 512 + hd * 128 + c2;
            const float cw0a = cw[gch], cw1a = cw[1024 + gch], cw2a = cw[2048 + gch], cw3a = cw[3072 + gch], cba = cbias[gch];
            const float cw0b = cw[gch + 1], cw1b = cw[1024 + gch + 1], cw2b = cw[2048 + gch + 1], cw3b = cw[3072 + gch + 1], cbb = cbias[gch + 1];
            float dnacc0 = 0.f, dnacc1 = 0.f;
            u32x4 rt[7];
#define ML_RAW_LOAD(tsv) do { _Pragma("unroll") for (int ii = 0; ii < 7; ++ii) { const int ch = F.tid + NTHR * ii; u32x4 v = (u32x4){0u, 0u, 0u, 0u}; \
                if (ch < 2 * 67 * 16) { const int which = ch / (67 * 16), r = (ch % (67 * 16)) >> 4, c16 = ch & 15; const int tk = (tsv) - 3 + r; \
                    if (tk >= 0) v = *(const u32x4*)(PROJ + ((size_t)b * SEQ + tk) * NPROJ + (which ? O_K : O_Q) + hd * 128 + c16 * 8); } \
                else if (ch < 2 * 67 * 16 + 64 * 16) { const int c2 = ch - 2 * 67 * 16, r = c2 >> 4, c16 = c2 & 15; v = *(const u32x4*)(PROJ + ((size_t)b * SEQ + (tsv) + r) * NPROJ + O_V + hd * 128 + c16 * 8); } \
                rt[ii] = v; } } while (0)
            ML_RAW_LOAD(t0);
#define ML_RAW_STORE() do { _Pragma("unroll") for (int ii = 0; ii < 7; ++ii) { const int ch = F.tid + NTHR * ii; \
                if (ch < 2 * 67 * 16) { const int which = ch / (67 * 16), r = (ch % (67 * 16)) >> 4, c16 = ch & 15; *(LAS u32x4*)((which ? RK : RQ) + r * 136 + c16 * 8) = rt[ii]; } \
                else if (ch < 2 * 67 * 16 + 64 * 16) { const int c2_ = ch - 2 * 67 * 16, r = c2_ >> 4, c16 = c2_ & 15; *(LAS u32x4*)(RV + r * 136 + c16 * 8) = rt[ii]; } } } while (0)
            __syncthreads();
            ML_RAW_STORE(); ML_RAW_LOAD(t0 + 64);
            __syncthreads();
            for (int sb = 0; sb < 8; ++sb) {
                const int ts = t0 + sb * 64;
                {
                    const LAS unsigned* raw = (const LAS unsigned*)(isk ? RK : RQ) + c2 / 2; LAS unsigned* dst = (LAS unsigned*)(isk ? KN : QN) + c2 / 2; const int s0 = tqr * 16;
                    const unsigned h0 = raw[(s0 + 0) * 68], h1 = raw[(s0 + 1) * 68], h2 = raw[(s0 + 2) * 68];
                    float x3a = lo_bf(h0), x3b = hi_bf(h0), x2a = lo_bf(h1), x2b = hi_bf(h1), x1a = lo_bf(h2), x1b = hi_bf(h2);
#pragma unroll 4
                    for (int sidx = s0; sidx < s0 + 16; ++sidx) {
                        const unsigned xw = raw[(sidx + 3) * 68]; const float xa = lo_bf(xw), xb = hi_bf(xw);
                        float va = cba + cw0a * x3a + cw1a * x2a + cw2a * x1a + cw3a * xa, vb = cbb + cw0b * x3b + cw1b * x2b + cw2b * x1b + cw3b * xb;
                        x3a = x2a; x2a = x1a; x1a = xa; x3b = x2b; x2b = x1b; x1b = xb;
                        va *= sigmoidf_(va); vb *= sigmoidf_(vb);
                        if (isk) { const float wk = 0.08838834764831845f * wsl[sb * 64 + sidx]; va *= wk; vb *= wk; dnacc0 += va; dnacc1 += vb; }
                        dst[sidx * 68] = cvt_pk_bf16(va, vb);
                    }
                }
                __syncthreads();
#pragma unroll
                for (int ii = 0; ii < 2; ++ii) { const int ch = F.tid + NTHR * ii, r = ch >> 4, c16 = ch & 15;
                    *(u32x4*)(QH + ((size_t)bh * SEQ + ts + r) * 128 + c16 * 8) = *(const LAS u32x4*)(QN + r * 136 + c16 * 8);
                    *(u32x4*)(KH + ((size_t)bh * SEQ + ts + r) * 128 + c16 * 8) = *(const LAS u32x4*)(KN + r * 136 + c16 * 8); }
                {
                    const int c = F.tid & 127, sq = F.tid >> 7;
#pragma unroll
                    for (int half = 0; half < 2; ++half) { const int sA = sq * 16 + half * 8;
                        u32x4 kk, vv;
                        kk.x = (unsigned)KN[(sA + 0) * 136 + c] | ((unsigned)KN[(sA + 1) * 136 + c] << 16); kk.y = (unsigned)KN[(sA + 2) * 136 + c] | ((unsigned)KN[(sA + 3) * 136 + c] << 16);
                        kk.z = (unsigned)KN[(sA + 4) * 136 + c] | ((unsigned)KN[(sA + 5) * 136 + c] << 16); kk.w = (unsigned)KN[(sA + 6) * 136 + c] | ((unsigned)KN[(sA + 7) * 136 + c] << 16);
                        vv.x = (unsigned)RV[(sA + 0) * 136 + c] | ((unsigned)RV[(sA + 1) * 136 + c] << 16); vv.y = (unsigned)RV[(sA + 2) * 136 + c] | ((unsigned)RV[(sA + 3) * 136 + c] << 16);
                        vv.z = (unsigned)RV[(sA + 4) * 136 + c] | ((unsigned)RV[(sA + 5) * 136 + c] << 16); vv.w = (unsigned)RV[(sA + 6) * 136 + c] | ((unsigned)RV[(sA + 7) * 136 + c] << 16);
                        *(LAS u32x4*)(KTl + c * 72 + sA) = kk; *(LAS u32x4*)(VTl + c * 72 + sA) = vv; }
                }
                __syncthreads();
                {
                    const int e = F.tid >> 2, part = F.tid & 3;
                    const u32x4 v0 = *(const LAS u32x4*)(VTl + e * 72 + part * 16), v1 = *(const LAS u32x4*)(VTl + e * 72 + part * 16 + 8);
                    bf16* dst = VT + ((size_t)bh * 128 + e) * SEQ + ts + part * 16;
                    *(u32x4*)dst = v0; *(u32x4*)(dst + 8) = v1;
                    const int eb = F.wave >> 1, db0 = (F.wave & 1) * 2, r = F.lane & 31, hh = F.lane >> 5;
#pragma unroll
                    for (int ks = 0; ks < 4; ++ks) {
                        const bf16x8 a = *(const LAS bf16x8*)(VTl + (eb * 32 + r) * 72 + ks * 16 + hh * 8);
                        const bf16x8 b0 = *(const LAS bf16x8*)(KTl + (db0 * 32 + r) * 72 + ks * 16 + hh * 8), b1 = *(const LAS bf16x8*)(KTl + ((db0 + 1) * 32 + r) * 72 + ks * 16 + hh * 8);
                        dacc[0] = __builtin_amdgcn_mfma_f32_32x32x16_bf16(a, b0, dacc[0], 0, 0, 0);
                        dacc[1] = __builtin_amdgcn_mfma_f32_32x32x16_bf16(a, b1, dacc[1], 0, 0, 0);
                    }
                }
                if (sb < 7) { ML_RAW_STORE(); if (sb < 6) ML_RAW_LOAD(ts + 128); }
                __syncthreads();
            }
#undef ML_RAW_STORE
#undef ML_RAW_LOAD
            if (isk) { dnl[tqr * 128 + c2] = dnacc0; dnl[tqr * 128 + c2 + 1] = dnacc1; }
            {
                const int eb = F.wave >> 1, db0 = (F.wave & 1) * 2, r = F.lane & 31, hh = F.lane >> 5;
#pragma unroll
                for (int i = 0; i < 2; ++i)
#pragma unroll
                    for (int q = 0; q < 16; ++q) DC[((size_t)un * 128 + eb * 32 + (q & 3) + 8 * (q >> 2) + 4 * hh) * 128 + (db0 + i) * 32 + r] = dacc[i][q];
            }
            __syncthreads();
            if (F.tid < 128) DN[un * 128 + F.tid] = (dnl[F.tid] + dnl[128 + F.tid]) + (dnl[256 + F.tid] + dnl[384 + F.tid]);
            __syncthreads();
        }
        if (BOTH(3)) GRID_BAR();
    }
    if (IN(4)) {
        { int tq_ = threadIdx.x; asm volatile("" : "+v"(tq_)); F.tid = tq_; F.lane = tq_ & 63; }
        LAS float* agr = (LAS float*)F.lds; LAS float* agi = agr + 512;
        for (int un = blockIdx.x; un < 128; un += F.G) {
            const int b = un >> 5, g = un & 31, n = F.tid & 63, seg = F.tid >> 6;
            const float dt = __expf(args.in[3][g]);
            const float are = fminf(args.in[4][g * 64 + n], -1e-4f), aim = args.in[5][g * 64 + n];
            float ar, ai, Ar, Ai;
            { const float mag = __expf((float)S5L * dt * are); float sn, cs; fcis((float)S5L * dt * aim, &sn, &cs); ar = mag * cs; ai = mag * sn; }
            { const float mag = __expf((float)(S5L * 32) * dt * are); float sn, cs; fcis((float)(S5L * 32) * dt * aim, &sn, &cs); Ar = mag * cs; Ai = mag * sn; }
            const size_t row0 = (size_t)g * S5ROWS + b * S5NCH + seg * 32;
            float xr[32], xi[32];
#pragma unroll
            for (int jj = 0; jj < 32; ++jj) { xr[jj] = XLOC[(row0 + jj) * 128 + n]; xi[jj] = XLOC[(row0 + jj) * 128 + 64 + n]; }
            float sr = 0.f, si = 0.f;
#pragma unroll
            for (int jj = 0; jj < 32; ++jj) { const float tr = ar * sr - ai * si + xr[jj], ti = ar * si + ai * sr + xi[jj]; sr = tr; si = ti; }
            agr[seg * 64 + n] = sr; agi[seg * 64 + n] = si;
            __syncthreads();
            float cr = 0.f, ci = 0.f;
            for (int s2 = 0; s2 < seg; ++s2) { const float tr = Ar * cr - Ai * ci + agr[s2 * 64 + n], ti = Ar * ci + Ai * cr + agi[s2 * 64 + n]; cr = tr; ci = ti; }
#pragma unroll
            for (int jj = 0; jj < 32; ++jj) {
                S5A[(row0 + jj) * S5K + S5KIN + n] = f2bf(cr); S5A[(row0 + jj) * S5K + S5KIN + 64 + n] = f2bf(ci);
                const float tr = ar * cr - ai * ci + xr[jj], ti = ar * ci + ai * cr + xi[jj]; cr = tr; ci = ti; }
            __syncthreads();
        }
        for (int un = blockIdx.x; un < 256; un += F.G) {
            const int bh = un >> 4, slice = un & 15;
            float dc0[16], dc1[16];
#pragma unroll
            for (int j = 0; j < 16; ++j) { dc0[j] = DC[((size_t)(bh * 16 + j)) * 16384 + slice * 1024 + F.tid]; dc1[j] = DC[((size_t)(bh * 16 + j)) * 16384 + slice * 1024 + 512 + F.tid]; }
            float dn[16];
            const bool nrole = (slice == 0 && F.tid < 128);
#pragma unroll
            for (int j = 0; j < 16; ++j) dn[j] = nrole ? DN[(bh * 16 + j) * 128 + F.tid] : 0.f;
            float m = 0.f, C0 = 0.f, C1 = 0.f, nn = 0.f;
#pragma unroll
            for (int j = 0; j < 16; ++j) {
                const float Fend = SEGS[(bh * 16 + j) * 4 + 0], Amax = SEGS[(bh * 16 + j) * 4 + 1];
                const float R = fmaxf(m, Amax), c1 = __expf(m - R), c2 = __expf(Amax - R);
                CST[((size_t)(bh * 16 + j)) * 16384 + slice * 1024 + F.tid] = f2bf(c1 * C0); CST[((size_t)(bh * 16 + j)) * 16384 + slice * 1024 + 512 + F.tid] = f2bf(c1 * C1);
                if (nrole) NST[(bh * 16 + j) * 128 + F.tid] = c1 * nn;
                if (slice == 0 && F.tid == 0) { SEGS[(bh * 16 + j) * 4 + 2] = R; SEGS[(bh * 16 + j) * 4 + 3] = c2; }
                C0 = c1 * C0 + c2 * dc0[j]; C1 = c1 * C1 + c2 * dc1[j]; nn = c1 * nn + c2 * dn[j]; m = Fend + R;
            }
        }
        if (BOTH(4)) GRID_BAR();
    }
    if (IN(5)) {
        { int tq_ = threadIdx.x; asm volatile("" : "+v"(tq_)); F.tid = tq_; F.lane = tq_ & 63; }
        pg::S5Sched S{(const char*)S5A, (const char*)S5BT, S5K * 2, S5K * 2, S5KIN, 2, F.G, F.vcu};
        pg::EpiS5Y E{S5A, args.in[10], GY};
        pg::gemm_phase<pg::EpiS5Y, pg::S5Sched, true>(F.lds, S5K, S, E);
        if (BOTH(5)) GRID_BAR();
    }
    if (IN(6)) {
        { int tq_ = threadIdx.x; asm volatile("" : "+v"(tq_)); F.tid = tq_; F.lane = tq_ & 63; }
        typedef short s16x4 __attribute__((ext_vector_type(4)));
        LAS bf16* Kl = (LAS bf16*)F.lds;
        LAS bf16* Vl = Kl + 2 * 64 * 136;
        LAS bf16* Cl = Vl + 2 * 128 * 72;
        LAS float* nl = (LAS float*)(Cl + 128 * 136);
        LAS float* fll = nl + 128;
        LAS float* gl = fll + 512;
        const float* ng = args.in[16];
        for (int un = blockIdx.x; un < 256; un += F.G) {
            int tid6 = F.tid; asm volatile("" : "+v"(tid6));
            const int lane6 = tid6 & 63;
            const int bh = un >> 4, seg = un & 15, b = bh >> 2, hd = bh & 3, t0 = seg * 512;
            const float R = SEGS[un * 4 + 2], c2 = SEGS[un * 4 + 3];
            __syncthreads();
            for (int ch = tid6; ch < 2048; ch += NTHR) { const int r = ch >> 4, c16 = ch & 15; *(LAS u32x4*)(Cl + r * 136 + c16 * 8) = *(const u32x4*)(CST + (size_t)un * 16384 + r * 128 + c16 * 8); }
            if (tid6 < 128) { nl[tid6] = NST[un * 128 + tid6]; gl[tid6] = ng[hd * 128 + tid6]; }
            fll[tid6] = FLOC[(size_t)bh * SEQ + t0 + tid6];
            const int r = lane6 & 31, hh = lane6 >> 5;
            for (int pass = 0; pass < 2; ++pass) {
                const int qb = pass == 0 ? F.wave : 15 - F.wave, jmax = qb >> 1, npj = pass == 0 ? 4 : 8;
                bf16x8 Q[8];
                { const bf16* qp = QH + ((size_t)bh * SEQ + t0 + qb * 32 + r) * 128 + hh * 8;
#pragma unroll
                  for (int ks = 0; ks < 8; ++ks) Q[ks] = *(const bf16x8*)(qp + ks * 16); }
                u32x4 pk0, pk1, pv0, pv1;
                { const int kr = tid6 >> 4, kc = tid6 & 15; const bf16* kp = KH + ((size_t)bh * SEQ + t0) * 128; pk0 = *(const u32x4*)(kp + kr * 128 + kc * 8); pk1 = *(const u32x4*)(kp + (kr + 32) * 128 + kc * 8);
                  const int vr = tid6 >> 3, vc = tid6 & 7; const bf16* vp = VT + (size_t)bh * 128 * SEQ + t0; pv0 = *(const u32x4*)(vp + (size_t)vr * SEQ + vc * 8); pv1 = *(const u32x4*)(vp + (size_t)(vr + 64) * SEQ + vc * 8); }
                f32x16 acc[4];
#pragma unroll
                for (int eb = 0; eb < 4; ++eb)
#pragma unroll
                    for (int q = 0; q < 16; ++q) acc[eb][q] = 0.f;
                __syncthreads();
#pragma unroll
                for (int eb = 0; eb < 4; ++eb) {
#pragma unroll
                    for (int ks = 0; ks < 8; ++ks) { const bf16x8 a = *(const LAS bf16x8*)(Cl + (eb * 32 + r) * 136 + ks * 16 + hh * 8); acc[eb] = __builtin_amdgcn_mfma_f32_32x32x16_bf16(a, Q[ks], acc[eb], 0, 0, 0); }
                    __builtin_amdgcn_sched_barrier(0);
                }
                float den = 0.f;
#pragma unroll
                for (int ks = 0; ks < 8; ++ks) {
#pragma unroll
                    for (int jj = 0; jj < 8; ++jj) den += nl[ks * 16 + hh * 8 + jj] * bf2f((bf16)Q[ks][jj]);
                    __builtin_amdgcn_sched_barrier(0);
                }
                float dsum = 0.f;
                for (int j = 0; j < npj; ++j) {
                    LAS bf16* Kb = Kl + (j & 1) * 64 * 136; LAS bf16* Vb = Vl + (j & 1) * 128 * 72;
                    { const int kr = tid6 >> 4, kc = tid6 & 15; *(LAS u32x4*)(Kb + kr * 136 + kc * 8) = pk0; *(LAS u32x4*)(Kb + (kr + 32) * 136 + kc * 8) = pk1;
                      const int vr = tid6 >> 3, vc = tid6 & 7; *(LAS u32x4*)(Vb + vr * 72 + vc * 8) = pv0; *(LAS u32x4*)(Vb + (vr + 64) * 72 + vc * 8) = pv1; }
                    if (j + 1 < npj) { const int kr = tid6 >> 4, kc = tid6 & 15; const bf16* kp = KH + ((size_t)bh * SEQ + t0 + (j + 1) * 64) * 128; pk0 = *(const u32x4*)(kp + kr * 128 + kc * 8); pk1 = *(const u32x4*)(kp + (kr + 32) * 128 + kc * 8);
                        const int vr = tid6 >> 3, vc = tid6 & 7; const bf16* vp = VT + (size_t)bh * 128 * SEQ + t0 + (j + 1) * 64; pv0 = *(const u32x4*)(vp + (size_t)vr * SEQ + vc * 8); pv1 = *(const u32x4*)(vp + (size_t)(vr + 64) * SEQ + vc * 8); }
                    __syncthreads();
                    if (j <= jmax) {
                        const bool diag = (j == jmax); const int tq = qb * 32 + r;
#pragma unroll
                        for (int sb = 0; sb < 2; ++sb) {
                            f32x16 st;
#pragma unroll
                            for (int q = 0; q < 16; ++q) st[q] = 0.f;
#pragma unroll
                            for (int ks = 0; ks < 8; ++ks) { const bf16x8 a = *(const LAS bf16x8*)(Kb + (sb * 32 + r) * 136 + ks * 16 + hh * 8); st = __builtin_amdgcn_mfma_f32_32x32x16_bf16(a, Q[ks], st, 0, 0, 0); }
                            bf16x8 pb[2];
#pragma unroll
                            for (int sp = 0; sp < 2; ++sp) {
                                float pv[8];
#pragma unroll
                                for (int jj = 0; jj < 8; ++jj) { const int q = 8 * sp + jj; const int sidx = j * 64 + sb * 32 + (q & 3) + 8 * (q >> 2) + 4 * hh;
                                    float p = st[q] * c2; if (diag && sidx > tq) p = 0.f; pv[jj] = p; dsum += p; }
                                u32x4 w; w.x = cvt_pk_bf16(pv[0], pv[1]); w.y = cvt_pk_bf16(pv[2], pv[3]); w.z = cvt_pk_bf16(pv[4], pv[5]); w.w = cvt_pk_bf16(pv[6], pv[7]);
                                pb[sp] = __builtin_bit_cast(bf16x8, w);
                            }
#pragma unroll
                            for (int eb = 0; eb < 4; ++eb)
#pragma unroll
                                for (int sp = 0; sp < 2; ++sp) {
                                    const int so = sb * 32 + 16 * sp + 4 * hh;
                                    const s16x4 lo = *(const LAS s16x4*)(Vb + (eb * 32 + r) * 72 + so), hi = *(const LAS s16x4*)(Vb + (eb * 32 + r) * 72 + so + 8);
                                    const bf16x8 a = __builtin_shufflevector(lo, hi, 0, 1, 2, 3, 4, 5, 6, 7);
                                    acc[eb] = __builtin_amdgcn_mfma_f32_32x32x16_bf16(a, pb[sp], acc[eb], 0, 0, 0);
                                }
                            __builtin_amdgcn_sched_barrier(0);
                        }
                    }
                }
                den += dsum; den += __shfl_xor(den, 32);
                const float flo = __expf(-fll[qb * 32 + r] - R);
                const float inv = 1.f / fmaxf(fabsf(den), flo);
                float s1 = 0.f;
#pragma unroll
                for (int eb = 0; eb < 4; ++eb)
#pragma unroll
                    for (int q = 0; q < 16; ++q) { acc[eb][q] *= inv; s1 += acc[eb][q]; }
                s1 += __shfl_xor(s1, 32);
                const float mu = s1 * (1.f / 128.f);
                float s2 = 0.f;
#pragma unroll
                for (int eb = 0; eb < 4; ++eb)
#pragma unroll
                    for (int q = 0; q < 16; ++q) { const float dlt = acc[eb][q] - mu; s2 += dlt * dlt; }
                s2 += __shfl_xor(s2, 32);
                const float rstd = rsqrtf(s2 * (1.f / 128.f) + 1e-6f);
                const size_t row = (size_t)b * SEQ + t0 + qb * 32 + r;
                uint2 ovv[16];
#pragma unroll
                for (int eb = 0; eb < 4; ++eb)
#pragma unroll
                    for (int g4 = 0; g4 < 4; ++g4) ovv[eb * 4 + g4] = *(const uint2*)(PROJ + row * NPROJ + O_O + hd * 128 + eb * 32 + 8 * g4 + 4 * hh);
#pragma unroll
                for (int eb = 0; eb < 4; ++eb)
#pragma unroll
                    for (int g4 = 0; g4 < 4; ++g4) {
                        const int e0 = eb * 32 + 8 * g4 + 4 * hh;
                        const uint2 ov = ovv[eb * 4 + g4];
                        const f32x4 gg = *(const LAS f32x4*)(gl + e0);
                        const float o0 = (acc[eb][4 * g4 + 0] - mu) * rstd * gg.x * sigmoidf_(lo_bf(ov.x)), o1 = (acc[eb][4 * g4 + 1] - mu) * rstd * gg.y * sigmoidf_(hi_bf(ov.x));
                        const float o2 = (acc[eb][4 * g4 + 2] - mu) * rstd * gg.z * sigmoidf_(lo_bf(ov.y)), o3 = (acc[eb][4 * g4 + 3] - mu) * rstd * gg.w * sigmoidf_(hi_bf(ov.y));
                        uint2 w; w.x = cvt_pk_bf16(o0, o1); w.y = cvt_pk_bf16(o2, o3);
                        *(uint2*)(MIX + row * D + 512 + hd * 128 + e0) = w;
                    }
            }
        }
    }
    if (IN(7)) {
        { int tq_ = threadIdx.x; asm volatile("" : "+v"(tq_)); F.tid = tq_; F.lane = tq_ & 63; }
        pg::DenseSched S{(const char*)GY, (const char*)WGLU, 512 * 2, 512 * 2, T / 256, 2, F.G, (int)blockIdx.x};
        pg::EpiGlu E{GY, args.in[12], MIX};
        pg::gemm_phase<pg::EpiGlu, pg::DenseSched, true>(F.lds, 512, S, E);
        if (BOTH(7)) GRID_BAR();
    }
    if (IN(8)) {
        { int tq_ = threadIdx.x; asm volatile("" : "+v"(tq_)); F.tid = tq_; F.lane = tq_ & 63; }
        pg::DenseSched S{(const char*)MIX, (const char*)WOUT, D * 2, D * 2, T / 256, D / 256, F.G, (int)blockIdx.x};
        pg::EpiOut E{x, H};
        pg::gemm_phase<pg::EpiOut, pg::DenseSched, true>(F.lds, D, S, E);
        if (BOTH(8)) GRID_BAR();
    }
    if (IN(9)) {
        { int tq_ = threadIdx.x; asm volatile("" : "+v"(tq_)); F.tid = tq_; F.lane = tq_ & 63; }
        const float* gf = args.in[18]; const float* w_r = args.in[19]; const float* b_r = args.in[20];
        LAS float* rs = (LAS float*)(F.lds);
        LAS float* part = (LAS float*)(F.lds + 1024);
        LAS int* hist = (LAS int*)(F.lds + 1024 + 2 * 128 * 33 * 4);
        for (int tb = blockIdx.x; tb < T / 128; tb += F.G) {
            const int row0 = tb * 128;
            if (F.tid < 32) hist[F.tid] = 0;
            {
                f32x4 gg[4];
#pragma unroll
                for (int jq = 0; jq < 4; ++jq) gg[jq] = *(const f32x4*)(gf + 4 * F.lane + 256 * jq);
                f32x4 nx[4];
#pragma unroll
                for (int jq = 0; jq < 4; ++jq) nx[jq] = ldbf4(H + (size_t)(row0 + F.wave * 16) * D + 4 * F.lane + 256 * jq);
                for (int rr = 0; rr < 16; ++rr) {
                    const int r = F.wave * 16 + rr;
                    f32x4 v[4];
#pragma unroll
                    for (int jq = 0; jq < 4; ++jq) v[jq] = nx[jq];
                    if (rr < 15) {
#pragma unroll
                        for (int jq = 0; jq < 4; ++jq) nx[jq] = ldbf4(H + (size_t)(row0 + r + 1) * D + 4 * F.lane + 256 * jq); }
                    float ss = 0.f;
#pragma unroll
                    for (int jq = 0; jq < 4; ++jq) ss += v[jq].x * v[jq].x + v[jq].y * v[jq].y + v[jq].z * v[jq].z + v[jq].w * v[jq].w;
                    ss = wave_sum(ss);
                    const float rstd = rsqrtf(ss * (1.f / D) + 1e-5f);
                    if (F.lane == 0) rs[r] = rstd;
#pragma unroll
                    for (int jq = 0; jq < 4; ++jq) *(unsigned*)(HN8 + (size_t)(row0 + r) * D + 4 * F.lane + 256 * jq) = pk4_fp8(v[jq].x * rstd * gg[jq].x, v[jq].y * rstd * gg[jq].y, v[jq].z * rstd * gg[jq].z, v[jq].w * rstd * gg[jq].w);
                }
            }
            {
                const int rg = F.wave & 3, kh = F.wave >> 2, i = F.lane & 31, hh = F.lane >> 5;
                f32x16 acc;
#pragma unroll
                for (int q = 0; q < 16; ++q) acc[q] = 0.f;
                const bf16* hp = H + (size_t)(row0 + rg * 32 + i) * D + kh * 512 + 8 * hh;
                const bf16* bp = WR2 + ((size_t)(kh * 32) * 64 + F.lane) * 8;
                bf16x8 a0[4], bh0[4], bl0[4], a1[4], bh1[4], bl1[4];
#pragma unroll
                for (int u = 0; u < 4; ++u) { a0[u] = *(const bf16x8*)(hp + 16 * u); bh0[u] = *(const bf16x8*)(bp + (size_t)u * 512); bl0[u] = *(const bf16x8*)(bp + (size_t)(4096 * 8) + (size_t)u * 512); }
                for (int s0 = 0; s0 < 32; s0 += 8) {
#pragma unroll
                    for (int u = 0; u < 4; ++u) { const int ss = s0 + 4 + u; a1[u] = *(const bf16x8*)(hp + 16 * ss); bh1[u] = *(const bf16x8*)(bp + (size_t)ss * 512); bl1[u] = *(const bf16x8*)(bp + (size_t)(4096 * 8) + (size_t)ss * 512); }
#pragma unroll
                    for (int u = 0; u < 4; ++u) { acc = __builtin_amdgcn_mfma_f32_32x32x16_bf16(a0[u], bh0[u], acc, 0, 0, 0); acc = __builtin_amdgcn_mfma_f32_32x32x16_bf16(a0[u], bl0[u], acc, 0, 0, 0); }
                    if (s0 + 8 < 32) {
#pragma unroll
                        for (int u = 0; u < 4; ++u) { const int ss = s0 + 8 + u; a0[u] = *(const bf16x8*)(hp + 16 * ss); bh0[u] = *(const bf16x8*)(bp + (size_t)ss * 512); bl0[u] = *(const bf16x8*)(bp + (size_t)(4096 * 8) + (size_t)ss * 512); } }
#pragma unroll
                    for (int u = 0; u < 4; ++u) { acc = __builtin_amdgcn_mfma_f32_32x32x16_bf16(a1[u], bh1[u], acc, 0, 0, 0); acc = __builtin_amdgcn_mfma_f32_32x32x16_bf16(a1[u], bl1[u], acc, 0, 0, 0); }
                }
#pragma unroll
                for (int q = 0; q < 16; ++q) { const int r = rg * 32 + (q & 3) + 8 * (q >> 2) + 4 * hh; part[(kh * 128 + r) * 33 + i] = acc[q]; }
            }
            __syncthreads();
            if (F.tid < 128) {
                const int r = F.tid; const float rstd = rs[r];
                float best[4]; int bi[4];
                for (int e = 0; e < 32; ++e) part[r * 33 + e] = (part[r * 33 + e] + part[(128 + r) * 33 + e]) * rstd + b_r[e];
#pragma unroll
                for (int k = 0; k < 4; ++k) {
                    float bv = -INFINITY; int be = 0;
                    for (int e = 0; e < 32; ++e) { const float l = part[r * 33 + e]; if (l > bv) { bv = l; be = e; } }
                    best[k] = bv; bi[k] = be; part[r * 33 + be] = -INFINITY;
                }
                const float e1 = __expf(best[1] - best[0]), e2 = __expf(best[2] - best[0]), e3 = __expf(best[3] - best[0]);
                const float inv = 1.f / (1.f + e1 + e2 + e3);
                *(int4*)(topi + (size_t)(row0 + r) * 4) = make_int4(bi[0], bi[1], bi[2], bi[3]);
                *(f32x4*)(topg + (size_t)(row0 + r) * 4) = (f32x4){inv, e1 * inv, e2 * inv, e3 * inv};
#pragma unroll
                for (int k = 0; k < 4; ++k) __hip_atomic_fetch_add(&hist[bi[k]], 1, __ATOMIC_RELAXED, __HIP_MEMORY_SCOPE_WORKGROUP);
            }
            __syncthreads();
            if (F.tid < 32) CNT[tb * 32 + F.tid] = hist[F.tid];
            __syncthreads();
        }
        if (BOTH(9)) GRID_BAR();
    }
    if (IN(10)) {
        { int tq_ = threadIdx.x; asm volatile("" : "+v"(tq_)); F.tid = tq_; F.lane = tq_ & 63; }
        LAS int* sb = (LAS int*)(F.lds);
        for (int tb = blockIdx.x; tb < T / 128; tb += F.G) {
            const int e = F.tid & 31, pt = F.tid >> 5;
            int sbef = 0, stot = 0;
            for (int w = pt * 16; w < pt * 16 + 16; ++w) { const int c = __hip_atomic_load(CNT + w * 32 + e, RLX_AGENT); stot += c; if (w < tb) sbef += c; }
            sb[pt * 32 + e] = sbef; sb[512 + pt * 32 + e] = stot;
            __syncthreads();
            if (F.tid < 32) { int b = 0, t = 0; for (int p = 0; p < 16; ++p) { b += sb[p * 32 + F.tid]; t += sb[512 + p * 32 + F.tid]; } sb[1024 + F.tid] = b; sb[1056 + F.tid] = t; sb[1120 + F.tid] = 0; }
            __syncthreads();
            if (F.tid == 0) { int ps = 0; for (int q = 0; q < 32; ++q) { sb[1088 + q] = ps; ps += ((sb[1056 + q] + MT - 1) / MT) * MT; } }
            __syncthreads();
            if (tb == 0 && F.tid < 32) ecnt[F.tid] = sb[1056 + F.tid];
            {
                const int a = tb * 512 + F.tid; const int ex = topi[a];
                const int lp = __hip_atomic_fetch_add(&sb[1120 + ex], 1, __ATOMIC_RELAXED, __HIP_MEMORY_SCOPE_WORKGROUP);
                const int slot = sb[1088 + ex] + sb[1024 + ex] + lp;
                slot_tok[slot] = a >> 2; tok_slot[a] = slot;
            }
            __syncthreads();
        }
        if (BOTH(10)) GRID_BAR();
    }
    if (IN(11) || IN(12)) {
        { int tq_ = threadIdx.x; asm volatile("" : "+v"(tq_)); F.tid = tq_; F.lane = tq_ & 63; }
        LAS int* til = (LAS int*)(F.lds + TIL_OFF);
        if (F.tid < 64) {
            const int e = F.lane; int cnt = 0; if (e < NE) cnt = (int)__hip_atomic_load(ecnt + e, RLX_AGENT);
            const int ntl = (cnt + MT - 1) / MT; int pre = ntl;
#pragma unroll
            for (int o = 1; o < 64; o <<= 1) { const int tv = __shfl_up(pre, o); if (F.lane >= o) pre += tv; }
            const int first = pre - ntl;
            if (e < NE) for (int k = 0; k < ntl; ++k) { til[first + k] = e; til[MAXTILES + first + k] = (cnt - k * MT) < MT ? (cnt - k * MT) : MT; }
            if (F.lane == 63) til[2 * MAXTILES] = pre;
        }
        __syncthreads();
        if (IN(11)) {
            MoeSched S{(const char*)HN8, (const char*)WUP8, slot_tok, args.in[22], til, (LAS int*)(F.lds + IDX_OFF), (LAS float*)(F.lds + BIAS_OFF), D, D, 8, 2 * FF, F.G, (int)blockIdx.x, 1};
            pg::EpiUp E{(const LAS float*)(F.lds + BIAS_OFF), ACT8};
            S.build_list((LAS int*)(F.lds + ULIST_OFF)); __syncthreads();
            pg::gemm_phase<pg::EpiUp, MoeSched, true, true>(F.lds, D, S, E);
            {
                constexpr int I_DN = (FF / 64) * (D / 64);
                LAS bf16* scr = (LAS bf16*)(F.lds + F.wave * 16384);
                LAS int* qb = (LAS int*)(F.lds + MISC_OFF + 64);
                for (;;) {
                    __syncthreads();
                    if (F.tid == 0) *qb = (int)__hip_atomic_fetch_add((unsigned*)(F.ctl + CW_QHEAD), 64u, __ATOMIC_RELAXED, __HIP_MEMORY_SCOPE_AGENT);
                    __syncthreads();
                    const int base = __builtin_amdgcn_readfirstlane(*qb);
                    if (base >= NE * I_DN) break;
                    for (int k = 0; k < 8; ++k) { const int it = base + F.wave * 8 + k; if (it >= NE * I_DN) break;
                        const int e = it / I_DN; transpose_item<true>(args.in[23] + (size_t)e * FF * D, D, FF, D / 64, WDN8 + (size_t)e * D * FF, scr, it % I_DN, F.lane, RowId()); }
                }
            }
            if (BOTH(11)) GRID_BAR();
        }
        if (IN(12)) {
            MoeSched S{(const char*)ACT8, (const char*)WDN8, slot_tok, args.in[24], til, (LAS int*)(F.lds + IDX_OFF), (LAS float*)(F.lds + BIAS_OFF), FF, FF, 4, D, F.G, (int)blockIdx.x, 0};
            pg::EpiDown E{(const LAS float*)(F.lds + BIAS_OFF), YS};
            S.build_list((LAS int*)(F.lds + ULIST_OFF)); __syncthreads();
            pg::gemm_phase<pg::EpiDown, MoeSched, true, true>(F.lds, FF, S, E);
            if (BOTH(12)) GRID_BAR();
        }
    }
    if (IN(13)) {
        { int tq_ = threadIdx.x; asm volatile("" : "+v"(tq_)); F.tid = tq_; F.lane = tq_ & 63; }
        const float* gfin = args.in[25]; float* out = args.out;
        for (int row = gw; row < T; row += NGW) {
            f32x4 v[4];
#pragma unroll
            for (int j = 0; j < 4; ++j) v[j] = ldbf4(H + (size_t)row * D + 4 * F.lane + 256 * j);
            const int4 sl = *(const int4*)(tok_slot + (size_t)row * 4); const f32x4 gt = *(const f32x4*)(topg + (size_t)row * 4);
#pragma unroll
            for (int k = 0; k < 4; ++k) {
                const int s = k == 0 ? sl.x : k == 1 ? sl.y : k == 2 ? sl.z : sl.w;
#pragma unroll
                for (int j = 0; j < 4; ++j) { const unsigned y = *(const unsigned*)(YS + (size_t)s * D + 4 * F.lane + 256 * j);
                    typedef float f32x2_ __attribute__((ext_vector_type(2)));
                    const f32x2_ ylo = __builtin_amdgcn_cvt_pk_f32_fp8(y, false), yhi = __builtin_amdgcn_cvt_pk_f32_fp8(y, true);
                    v[j].x += gt[k] * ylo.x; v[j].y += gt[k] * ylo.y; v[j].z += gt[k] * yhi.x; v[j].w += gt[k] * yhi.y; }
            }
            float ss = 0.f;
#pragma unroll
            for (int j = 0; j < 4; ++j) ss += v[j].x * v[j].x + v[j].y * v[j].y + v[j].z * v[j].z + v[j].w * v[j].w;
            ss = wave_sum(ss);
            const float rstd = rsqrtf(ss * (1.f / D) + 1e-5f);
#pragma unroll
            for (int j = 0; j < 4; ++j) { const f32x4 gg = *(const f32x4*)(gfin + 4 * F.lane + 256 * j); __builtin_nontemporal_store(v[j] * rstd * gg, (f32x4*)(out + (size_t)row * D + 4 * F.lane + 256 * j)); }
        }
    }
#undef IN
#undef BOTH
}

extern "C" void kernel_launch(void* const* d_in, const int* in_sizes, int n_in, void* d_out, int out_size, void* d_ws, size_t ws_size, hipStream_t stream) {
    static int grid = 0;
    if (grid == 0) {
        int dev = 0, cus = 0, per_cu = 0;
        if (n_in != 26 || ws_size < WS_END) { fprintf(stderr, "kernel_launch: unexpected n_in %d / ws %zu\n", n_in, ws_size); grid = -1; return; }
        if (hipGetDevice(&dev) != hipSuccess || hipDeviceGetAttribute(&cus, hipDeviceAttributeMultiprocessorCount, dev) != hipSuccess) { grid = -1; return; }
        if (hipFuncSetAttribute((const void*)fwd, hipFuncAttributeMaxDynamicSharedMemorySize, LDS_BYTES) != hipSuccess) { fprintf(stderr, "kernel_launch: hipFuncSetAttribute failed\n"); grid = -1; return; }
        if (hipOccupancyMaxActiveBlocksPerMultiprocessor(&per_cu, (const void*)fwd, NTHR, LDS_BYTES) != hipSuccess || per_cu < 1) fprintf(stderr, "kernel_launch: occupancy query reports %d\n", per_cu);
        (void)hipGetLastError();
        grid = cus;
    }
    if (grid < 0) return;
    (void)in_sizes; (void)out_size;
    unsigned char* ws = (unsigned char*)d_ws;
    (void)hipMemsetAsync(ws + WS_CTL, 0, CTL_ZERO_BYTES, stream);
    Args a{};
    for (int i = 0; i < 26; ++i) a.in[i] = (const float*)d_in[i];
    a.out = (float*)d_out; a.ws = ws;
    a.ph_lo = 0; a.ph_hi = 14; a.li = 0; a.pad = 0;
    hipLaunchKernelGGL(fwd, dim3(grid), dim3(NTHR), LDS_BYTES, stream, a);
#if PROBE_LO >= 0
    a.ph_lo = PROBE_LO; a.ph_hi = PROBE_HI; a.li = 1; a.pad = PROBE_PAD;
    hipLaunchKernelGGL(fwd, dim3(grid), dim3(NTHR), LDS_BYTES, stream, a);
#endif
}
```

```cpp
#include <hip/hip_runtime.h>
#include <cstdio>
#include <cstdint>

#define GAS __attribute__((address_space(1)))
#define LAS __attribute__((address_space(3)))
typedef unsigned short bf16;
typedef short bf16x8 __attribute__((ext_vector_type(8)));
typedef float f32x4 __attribute__((ext_vector_type(4)));
typedef float f32x16 __attribute__((ext_vector_type(16)));
typedef unsigned u32x4 __attribute__((ext_vector_type(4)));
typedef unsigned u32x2 __attribute__((ext_vector_type(2)));
typedef GAS unsigned gu32;

#define PROBE_LO -1
#define PROBE_HI -1
#define PROBE_PAD 0
constexpr int NB = 4, SEQ = 8192, T = NB * SEQ, D = 1024;
constexpr int DIN = 2568, NPROJ = 2560;
constexpr int O_Q = 512, O_K = 1024, O_V = 1536, O_O = 2048, O_G = 2560;
constexpr int NE = 32, TOPK = 4, FF = 1024;
constexpr int NASSIGN = T * TOPK;
constexpr int MT = 256;
constexpr int NSLOTS = NASSIGN + NE * MT;
constexpr int MAXTILES = NSLOTS / MT;
constexpr int NWAVES = 8, NTHR = 512;
constexpr float W8_SCALE = 64.f, W8_INV = 1.f / 64.f;

constexpr size_t MiB = 1u << 20;
constexpr size_t WS_CTL = 0, CTL_ZERO_BYTES = 1 * MiB;
constexpr size_t WS_GATES = 1 * MiB;
constexpr size_t WS_TOPI = 2 * MiB;
constexpr size_t WS_TOPG = 3 * MiB;
constexpr size_t WS_SLOTTOK = 4 * MiB;
constexpr size_t WS_TOKSLOT = 5 * MiB;
constexpr size_t WS_CNT = 6 * MiB;
constexpr size_t WS_WIN = 8 * MiB;
constexpr size_t WS_WGLU = 13 * MiB;
constexpr size_t WS_WOUT = 14 * MiB;
constexpr size_t WS_WUP = 16 * MiB;
constexpr size_t WS_WDN = 144 * MiB;
constexpr size_t WS_HN = 208 * MiB;
constexpr size_t WS_PROJ = 272 * MiB;
constexpr size_t WS_GY = 432 * MiB;
constexpr size_t WS_MIX = 464 * MiB;
constexpr size_t WS_HRAW = 528 * MiB;
constexpr size_t WS_ACT = 272 * MiB;
constexpr size_t WS_H = 592 * MiB;
constexpr size_t WS_YS = 720 * MiB;
constexpr size_t WS_END = 992 * MiB;
constexpr int S5L = 32, S5KIN = S5L * 16, S5K = S5KIN + 128;
constexpr int S5NCH = SEQ / S5L, S5ROWS = NB * S5NCH;
constexpr size_t WS_S5A = 720 * MiB;
constexpr size_t WS_S5BT = 760 * MiB;
constexpr size_t WS_S5BQ = 836 * MiB;
constexpr size_t WS_XLOC = 790 * MiB;
constexpr size_t WS_QH = 866 * MiB;
constexpr size_t WS_KH = 898 * MiB;
constexpr size_t WS_VT = 930 * MiB;
constexpr size_t WS_DC = 962 * MiB;
constexpr size_t WS_CST = 978 * MiB;
constexpr size_t WS_FLOC = 986 * MiB;
constexpr size_t WS_DN = 987 * MiB;
constexpr size_t WS_NST = 988 * MiB;
constexpr size_t WS_SEGS = 989 * MiB;
constexpr size_t WS_WR2 = 991 * MiB;
constexpr size_t WS_KTAB = 990 * MiB;
static_assert(WS_S5A + (size_t)32 * S5ROWS * S5K * 2 <= WS_S5BT && WS_S5BT + (size_t)32 * S5KIN * S5K * 2 <= WS_XLOC && WS_XLOC + (size_t)32 * S5ROWS * 128 * 4 <= WS_S5BQ && WS_S5BQ + (size_t)32 * 256 * S5KIN * 2 <= WS_QH, "s5 map");
static_assert(WS_ACT + (size_t)NSLOTS * FF * 2 <= WS_H && WS_YS + (size_t)NSLOTS * D * 2 <= WS_END, "ws map");
constexpr int CW_QHEAD = 64;
constexpr int CW_BAR = 4096;

constexpr int RING_BYTES = 131072;
constexpr int MISC_OFF = RING_BYTES;
constexpr int IDX_OFF = MISC_OFF + 128;
constexpr int TIL_OFF = IDX_OFF + 2048;
constexpr int BIAS_OFF = TIL_OFF + 3 * MAXTILES * 4 + 256;
constexpr int ULIST_OFF = BIAS_OFF + 3 * 1024;
constexpr int LDS_BYTES = 147456;
static_assert(ULIST_OFF + 32 * 16 <= LDS_BYTES && (BIAS_OFF & 15) == 0, "LDS map");

#define RLX_AGENT __ATOMIC_RELAXED, __HIP_MEMORY_SCOPE_AGENT
__device__ __forceinline__ float bf2f(bf16 v) { return __uint_as_float(((unsigned)v) << 16); }
__device__ __forceinline__ bf16 f2bf(float f) { unsigned u = __float_as_uint(f); u += 0x7fffu + ((u >> 16) & 1u); return (bf16)(u >> 16); }
__device__ __forceinline__ unsigned pk2(float lo, float hi) { return (unsigned)f2bf(lo) | ((unsigned)f2bf(hi) << 16); }
__device__ __forceinline__ unsigned cvt_pk_bf16(float lo, float hi) { unsigned r; asm volatile("v_cvt_pk_bf16_f32 %0, %1, %2" : "=v"(r) : "v"(lo), "v"(hi)); return r; }
__device__ __forceinline__ unsigned pk4_fp8(float a, float b, float c, float d) { unsigned w = 0u; w = __builtin_amdgcn_cvt_pk_fp8_f32(a, b, w, false); w = __builtin_amdgcn_cvt_pk_fp8_f32(c, d, w, true); return w; }
__device__ __forceinline__ float lo_bf(unsigned u) { return __uint_as_float(u << 16); }
__device__ __forceinline__ float hi_bf(unsigned u) { return __uint_as_float(u & 0xffff0000u); }
__device__ __forceinline__ f32x4 ldbf4(const bf16* p) { const uint2 u = *(const uint2*)p; return (f32x4){lo_bf(u.x), hi_bf(u.x), lo_bf(u.y), hi_bf(u.y)}; }
__device__ __forceinline__ float wave_sum(float v) {
#pragma unroll
    for (int o = 1; o < 64; o <<= 1) v += __shfl_xor(v, o);
    return v;
}
__device__ __forceinline__ float sigmoidf_(float x) { return __builtin_amdgcn_rcpf(1.f + __builtin_amdgcn_exp2f(-1.4426950408889634f * x)); }
__device__ __forceinline__ void fcis(float x, float* sn, float* cs) { const float C = 0.15915494309189535f; const float rev = x * C; const float err = fmaf(x, C, -rev); const float fr = (rev - rintf(rev)) + err; *sn = __builtin_amdgcn_sinf(fr); *cs = __builtin_amdgcn_cosf(fr); }
__device__ __forceinline__ float gelu_tanh(float x) { const float u = 1.5957691216057308f * (x + 0.044715f * x * x * x); return x * __builtin_amdgcn_rcpf(1.f + __builtin_amdgcn_exp2f(-1.4426950408889634f * u)); }

#define XB_TMO      128
#define XB_XCNT(j)  (256  + 64 * (j))
#define XB_XSUB(j)  (1280 + 64 * (j))
#define XB_XGEN(j)  (2304 + 64 * (j))
#define XB_TOP      3328
#define XB_TOPGEN   3392
#define XCD_BAR_WORDS 3456
#define XB_SPIN_CAP (1u << 18)
__device__ __forceinline__ unsigned xb_ld(unsigned* p)              { return __hip_atomic_load(p, __ATOMIC_RELAXED, __HIP_MEMORY_SCOPE_AGENT); }
__device__ __forceinline__ unsigned xb_add(unsigned* p, unsigned v) { return __hip_atomic_fetch_add(p, v, __ATOMIC_RELAXED, __HIP_MEMORY_SCOPE_AGENT); }
__device__ __forceinline__ unsigned xb_xcc_id() { return (unsigned)__builtin_amdgcn_s_getreg((3 << 11) | 20) & 0xFu; }
#define XB_SPIN(cond, bar) do { unsigned _sp = 0; while (cond) { __builtin_amdgcn_s_sleep(1); \
    if ((++_sp & 255u) == 0u) { if (xb_ld(&(bar)[XB_TMO])) break; if (_sp > XB_SPIN_CAP) { atomicAdd(&(bar)[XB_TMO], 1u); break; } } } } while (0)
struct XcdBarrier { unsigned* bar; unsigned x; volatile LAS unsigned* st; };
__device__ __forceinline__ XcdBarrier xcd_barrier_post(unsigned* bar, volatile LAS unsigned* st) {
    XcdBarrier b; b.bar = bar; b.x = xb_xcc_id(); b.st = st;
    if (threadIdx.x == 0) (void)xb_add(&bar[XB_XCNT(b.x)], 1u);
    return b;
}
__device__ __forceinline__ void xcd_barrier_complete(unsigned* bar, unsigned x, unsigned& nloc, unsigned& nx) {
    const unsigned G = gridDim.x * gridDim.y * gridDim.z;
    unsigned sum, cnt, mine, sp = 0u;
    for (;;) {
        sum = 0u; cnt = 0u; mine = 0u;
#pragma unroll
        for (unsigned j = 0; j < 16; ++j) { const unsigned c = xb_ld(&bar[XB_XCNT(j)]); sum += c; cnt += (c > 0u) ? 1u : 0u; mine = (j == x) ? c : mine; }
        if (sum == G) break;
        __builtin_amdgcn_s_sleep(1);
        if ((++sp & 255u) == 0u) { if (xb_ld(&bar[XB_TMO])) break; if (sp > XB_SPIN_CAP) { atomicAdd(&bar[XB_TMO], 1u); break; } }
    }
    nloc = mine > 0u ? mine : 1u; nx = cnt > 0u ? cnt : 1u;
}
__device__ __forceinline__ void xcd_barrier(const XcdBarrier& b) {
    asm volatile("s_waitcnt vmcnt(0)" ::: "memory");
    __syncthreads();
    if (threadIdx.x == 0) {
        unsigned* bar = b.bar;
        __builtin_amdgcn_s_waitcnt(0);
        unsigned nloc = b.st[0], nx = b.st[1];
        if (nloc == 0u) { xcd_barrier_complete(bar, b.x, nloc, nx); b.st[0] = nloc; b.st[1] = nx; }
        const unsigned old = xb_add(&bar[XB_XSUB(b.x)], 1u);
        const unsigned gen = old / nloc;
        if (old + 1u == (gen + 1u) * nloc) {
            __builtin_amdgcn_fence(__ATOMIC_RELEASE, "agent");
            asm volatile("s_waitcnt vmcnt(0)" ::: "memory");
            const unsigned og = xb_add(&bar[XB_TOP], 1u);
            const unsigned tg = og / nx;
            if (og + 1u == (tg + 1u) * nx) xb_add(&bar[XB_TOPGEN], 1u);
            else XB_SPIN(xb_ld(&bar[XB_TOPGEN]) == tg, bar);
            __builtin_amdgcn_fence(__ATOMIC_ACQUIRE, "agent");
            xb_add(&bar[XB_XGEN(b.x)], 1u);
            asm volatile("s_waitcnt vmcnt(0)" ::: "memory");
        } else {
            XB_SPIN(xb_ld(&bar[XB_XGEN(b.x)]) == gen, bar);
            __builtin_amdgcn_fence(__ATOMIC_ACQUIRE, "agent");
            asm volatile("s_waitcnt vmcnt(0)" ::: "memory");
        }
    }
    __syncthreads();
}

namespace pg {
constexpr int BM = 256, BK = 64, HALF = 128, HTB = HALF * BK * 2, STAGE_BYTES = 8 * HTB, NXCD = 8, WGM = 4;
__host__ __device__ __forceinline__ int lds_byte(int r, int c) { const int st = (r >> 4) * 2 + (c >> 5), rr = r & 15, cc = c & 31, ob = rr * 64 + cc * 2; return st * 1024 + (ob ^ (((ob >> 9) & 1) << 5)); }
__host__ __device__ __forceinline__ void stage_rc(int b, int& R, int& C) { const int st = b / 1024, sb = b % 1024, swz = sb ^ (((sb >> 9) & 1) << 5); R = (st >> 1) * 16 + swz / 64; C = (st & 1) * 32 + (swz % 64) / 2; }
__host__ __device__ __forceinline__ int perm32(int rho) { const int n = rho >> 4, i = rho & 15; return 8 * (i >> 2) + 4 * n + (i & 3); }

struct Unit { unsigned A, B; int pm, pn, e, nrows; };
__device__ __forceinline__ __amdgpu_buffer_rsrc_t mkrsrc(const void* p) { return __builtin_amdgcn_make_buffer_rsrc((void*)p, 0, 0x7fffffff, 0x00020000); }

__device__ __forceinline__ bool tile_order(int i, int G, int c, int nM, int nN, int& pm, int& pn) {
    const int nwg = nM * nN; const long L = (long)i * G + c; if (L >= nwg) return false;
    int wgid = (int)L; { const int q = nwg / NXCD, r = nwg % NXCD, xcd = wgid % NXCD, off = wgid / NXCD; wgid = (xcd < r ? xcd * (q + 1) : r * (q + 1) + (xcd - r) * q) + off; }
    const int nig = WGM * nN, gid = wgid / nig, fm = gid * WGM, gsz = (nM - fm) < WGM ? (nM - fm) : WGM;
    pm = fm + ((wgid % nig) % gsz); pn = (wgid % nig) / gsz; return true;
}
struct DenseSched {
    const char* A; const char* Bt; int lda2  , K2  , nM, nN, G, c;
    __device__ __forceinline__ bool next(int i, Unit& u) const { int pm, pn; if (!tile_order(i, G, c, nM, nN, pm, pn)) return false;
        u.A = (unsigned)pm * 256u * (unsigned)lda2; u.B = (unsigned)pn * 256u * (unsigned)K2; u.pm = pm; u.pn = pn; u.e = 0; u.nrows = 256; return true; }
    __device__ __forceinline__ __amdgpu_buffer_rsrc_t rsrcA() const { return mkrsrc(A); }
    __device__ __forceinline__ __amdgpu_buffer_rsrc_t rsrcB() const { return mkrsrc(Bt); }
    __device__ __forceinline__ void prefetch(const Unit&, int, int) const {}
    __device__ __forceinline__ unsigned aoff(const Unit&, int row, int) const { return (unsigned)row * (unsigned)lda2; }
};

typedef int i32x8 __attribute__((ext_vector_type(8)));
template <class Epi, class Sched, bool ALIGN_EPI, bool FP8 = false>
__device__ __forceinline__ void gemm_phase(LAS unsigned char* lds, const int K, const Sched& S, const Epi& E) {
    const int tid = threadIdx.x, wid = __builtin_amdgcn_readfirstlane(tid >> 6), lane = tid & 63, wr = wid >> 2, wc = wid & 3, fr = lane & 15, fq = lane >> 4;
    const int nt = FP8 ? K / 128 : K / BK;
    unsigned voffA[2][2], voffB[2];
#pragma unroll
    for (int i = 0; i < 1; ++i) { int R, C; if constexpr (FP8) { const int p = tid + 512 * i; R = p >> 3; C = (((p >> 1) & 3) ^ ((R >> 1) & 3)) * 32 + (p & 1) * 16; } else { stage_rc(tid * 16 + i * 8192, R, C); C *= 2; }
        const int Rb = Epi::PERM ? ((R & ~31) + perm32(R & 31)) : R; voffB[i] = (unsigned)(Rb * K * (FP8 ? 1 : 2) + C); }
    const unsigned kstep = (unsigned)(BK * 2);
    const unsigned hstep = (unsigned)HALF * K * (FP8 ? 1 : 2);
    const unsigned b64step = hstep / 2;
    const unsigned ldsw = (unsigned)wid * 1024u;
    const int aoff = FP8 ? (wr * 64 + fr) * 128 + ((fq ^ ((fr >> 1) & 3)) * 32) : lds_byte(wr * 64 + fr, fq * 8);
    const int boff = FP8 ? (wc * 32 + fr) * 128 + ((fq ^ ((fr >> 1) & 3)) * 32) : lds_byte(wc * 32 + fr, fq * 8);
#define PG_SA(b, h) (((b) * 2 + (h)) * HTB)
#define PG_SB(b, h) ((4 + (b) * 2 + (h)) * HTB)
#define PG_STAGE(bufoff, so, voff) do { _Pragma("unroll") for (int _i = 0; _i < 2; ++_i) \
        __builtin_amdgcn_raw_ptr_buffer_load_lds(rA, (LAS void*)(lds + (bufoff) + ldsw + _i * 8192), 16, (int)(voff)[_i], (int)(so), 0, 0); } while (0)
#define PG_STAGEB(bufoff, so) do { _Pragma("unroll") for (int _i = 0; _i < 2; ++_i) \
        __builtin_amdgcn_raw_ptr_buffer_load_lds(rB, (LAS void*)(lds + (bufoff) + ldsw + _i * 8192), 16, (int)voffB[0], (int)((so) + _i * b64step), 0, 0); } while (0)
#define PG_LD8(p, p2) __builtin_bit_cast(i32x8, __builtin_shufflevector(*(const LAS u32x4*)(p), *(const LAS u32x4*)(p2), 0, 1, 2, 3, 4, 5, 6, 7))
#define PG_LDA(dst, b, h) do { if constexpr (FP8) { _Pragma("unroll") for (int m = 0; m < 4; ++m) dst##8[m] = PG_LD8(lds + PG_SA(b, h) + aoff + m * 2048, lds + PG_SA(b, h) + aoff + m * 2048 + 16); } \
        else { _Pragma("unroll") for (int m = 0; m < 4; ++m) _Pragma("unroll") for (int k = 0; k < 2; ++k) dst[m][k] = *(const LAS bf16x8*)(lds + PG_SA(b, h) + aoff + m * 2048 + k * 1024); } } while (0)
#define PG_LDB(dst, b, h) do { if constexpr (FP8) { _Pragma("unroll") for (int n = 0; n < 2; ++n) dst##8[n] = PG_LD8(lds + PG_SB(b, h) + boff + n * 2048, lds + PG_SB(b, h) + boff + n * 2048 + 16); } \
        else { _Pragma("unroll") for (int n = 0; n < 2; ++n) _Pragma("unroll") for (int k = 0; k < 2; ++k) dst[n][k] = *(const LAS bf16x8*)(lds + PG_SB(b, h) + boff + n * 2048 + k * 1024); } } while (0)
#define PG_MMA(ai, bj, At, Bt) do { __builtin_amdgcn_s_setprio(1); if constexpr (FP8) { _Pragma("unroll") for (int m = 0; m < 4; ++m) _Pragma("unroll") for (int n = 0; n < 2; ++n) \
            acc[ai][bj][m][n] = __builtin_amdgcn_mfma_scale_f32_16x16x128_f8f6f4(Bt##8[n], At##8[m], acc[ai][bj][m][n], 0, 0, 0, 0, 0, 0); } \
        else { _Pragma("unroll") for (int m = 0; m < 4; ++m) _Pragma("unroll") for (int n = 0; n < 2; ++n) _Pragma("unroll") for (int k = 0; k < 2; ++k) \
            acc[ai][bj][m][n] = __builtin_amdgcn_mfma_f32_16x16x32_bf16(Bt[n][k], At[m][k], acc[ai][bj][m][n], 0, 0, 0); } __builtin_amdgcn_s_setprio(0); } while (0)
#define PG_WAIT_V(n) asm volatile("s_waitcnt vmcnt(" #n ")" ::: "memory")
#define PG_WAIT_L(n) asm volatile("s_waitcnt lgkmcnt(" #n ")" ::: "memory")
#define PG_BAR __builtin_amdgcn_s_barrier()
#define PG_SCHED __builtin_amdgcn_sched_barrier(0)
#define PG_SET_AOFF(u, ib) do { int _t = threadIdx.x; asm volatile("" : "+v"(_t));     \
        _Pragma("unroll") for (int _i = 0; _i < 2; ++_i) { int _R, _C; if constexpr (FP8) { const int _p = _t + 512 * _i; _R = _p >> 3; _C = (((_p >> 1) & 3) ^ ((_R >> 1) & 3)) * 32 + (_p & 1) * 16; } else { stage_rc(_t * 16 + _i * 8192, _R, _C); _C *= 2; } \
        voffA[0][_i] = S.aoff(u, _R, ib) + (unsigned)_C; voffA[1][_i] = S.aoff(u, _R + HALF, ib) + (unsigned)_C; } } while (0)
    Unit cur, nxt; int ui = 0;
    if (!S.next(0, cur)) return;
    f32x4 acc[2][2][4][2];
#pragma unroll
    for (int a = 0; a < 2; ++a)
#pragma unroll
        for (int b = 0; b < 2; ++b)
#pragma unroll
            for (int m = 0; m < 4; ++m)
#pragma unroll
                for (int n = 0; n < 2; ++n) acc[a][b][m][n] = (f32x4){0.f, 0.f, 0.f, 0.f};
    bf16x8 At[FP8 ? 1 : 4][2], B0[2][2], B1[2][2]; i32x8 At8[FP8 ? 4 : 1], B08[2], B18[2];
    const __amdgpu_buffer_rsrc_t rA = S.rsrcA(), rB = S.rsrcB();
    unsigned cA = cur.A, cB = cur.B;
    S.prefetch(cur, 0, 0);
    PG_WAIT_V(0); __syncthreads();
    PG_SET_AOFF(cur, 0);
    PG_STAGEB(PG_SB(0, 0), cB); PG_STAGEB(PG_SB(0, 1), cB + hstep); PG_STAGE(PG_SA(0, 0), cA, voffA[0]); PG_STAGE(PG_SA(0, 1), cA, voffA[1]);
    if (wr == 1) PG_BAR;
    PG_WAIT_V(2); PG_BAR;
    PG_STAGEB(PG_SB(1, 0), cB + kstep); PG_STAGE(PG_SA(1, 0), cA + kstep, voffA[0]); PG_STAGEB(PG_SB(1, 1), cB + hstep + kstep);
    PG_WAIT_V(6); PG_BAR;
    for (;;) {
        const bool has_next = S.next(ui + 1, nxt);
        const unsigned nA = has_next ? nxt.A : cA, nB = has_next ? nxt.B : cB;
        if (has_next) S.prefetch(nxt, (ui + 1) & 1, (ui + 1) % 3);
#pragma unroll 1
        for (int t = 0; t < nt; t += 2) {
            const bool last = (t == nt - 2);
            const unsigned a1 = cA + (unsigned)(t + 1) * kstep;
            const unsigned a2 = last ? nA : cA + (unsigned)(t + 2) * kstep, b2 = last ? nB : cB + (unsigned)(t + 2) * kstep;
            const unsigned a3 = a2 + kstep, b3 = b2 + kstep;
            PG_LDB(B0, 0, 0); PG_LDB(B1, 0, 1); PG_SCHED; PG_LDA(At, 0, 0); PG_STAGE(PG_SA(1, 1), a1, voffA[1]);
            PG_WAIT_V(8); PG_WAIT_L(0); PG_BAR; PG_MMA(0, 0, At, B0); PG_MMA(0, 1, At, B1); PG_BAR; PG_SCHED;
            if (last && has_next) PG_SET_AOFF(nxt, (ui + 1) & 1);
            PG_LDA(At, 0, 1); PG_STAGEB(PG_SB(0, 0), b2); PG_STAGEB(PG_SB(0, 1), b2 + hstep); PG_STAGE(PG_SA(0, 0), a2, voffA[0]);
            PG_WAIT_V(8); PG_WAIT_L(0); PG_BAR; PG_MMA(1, 0, At, B0); PG_MMA(1, 1, At, B1); PG_BAR; PG_SCHED;
            PG_LDB(B0, 1, 0); PG_LDB(B1, 1, 1); PG_SCHED; PG_LDA(At, 1, 0); PG_STAGE(PG_SA(0, 1), a2, voffA[1]);
            PG_WAIT_V(8); PG_WAIT_L(0); PG_BAR; PG_MMA(0, 0, At, B0); PG_MMA(0, 1, At, B1); PG_BAR; PG_SCHED;
            PG_LDA(At, 1, 1); PG_STAGEB(PG_SB(1, 0), b3); PG_STAGEB(PG_SB(1, 1), b3 + hstep); PG_STAGE(PG_SA(1, 0), a3, voffA[0]);
            PG_WAIT_V(8); PG_WAIT_L(0); PG_BAR; PG_MMA(1, 0, At, B0); PG_MMA(1, 1, At, B1); PG_BAR; PG_SCHED;
        }
        if constexpr (ALIGN_EPI) { if (wr == 0) PG_BAR; }
        {
            int tz = threadIdx.x; asm volatile("" : "+v"(tz)); const int lz = tz & 63;
            E(acc, cur, ui % 3, (tz >> 6) >> 2, (tz >> 6) & 3, lz & 15, lz >> 4);
        }
        if (!has_next) break;
#pragma unroll
        for (int a = 0; a < 2; ++a)
#pragma unroll
            for (int b = 0; b < 2; ++b)
#pragma unroll
                for (int m = 0; m < 4; ++m)
#pragma unroll
                    for (int n = 0; n < 2; ++n) acc[a][b][m][n] = (f32x4){0.f, 0.f, 0.f, 0.f};
        cur = nxt; cA = nA; cB = nB; ++ui;
        if constexpr (ALIGN_EPI) { if (wr == 1) PG_BAR; }
    }
    PG_WAIT_V(0);
    if constexpr (!ALIGN_EPI) { if (wr == 0) PG_BAR; }
    PG_BAR;
#undef PG_SA
#undef PG_SB
#undef PG_STAGE
#undef PG_STAGEB
#undef PG_LDA
#undef PG_LDB
#undef PG_MMA
#undef PG_LD8
#undef PG_WAIT_V
#undef PG_WAIT_L
#undef PG_BAR
#undef PG_SCHED
#undef PG_SET_AOFF
}

struct EpiProj {
    static constexpr bool PERM = true; bf16* P; bf16* S5A;
    __device__ __forceinline__ void operator()(const f32x4 (&acc)[2][2][4][2], const Unit& u, int bb, int wr, int wc, int fr, int fq) const {
        const int row0 = u.pm * BM + wr * 64 + fr, col0 = u.pn * BM + wc * 32 + 8 * fq;
#pragma unroll
        for (int ai = 0; ai < 2; ++ai)
#pragma unroll
            for (int m = 0; m < 4; ++m) { const int row = row0 + ai * HALF + m * 16;
                bf16* rowp = P + ((size_t)(((col0 - 512) >> 9) * 16 + (row >> 13) * 4 + (((col0 - 512) >> 7) & 3)) * SEQ + (row & 8191)) * 128 + (col0 & 127);
                if (u.pn < 2) { const int b = row >> 13, tt = row & 8191; rowp = S5A + ((size_t)b * S5NCH + (tt / S5L)) * S5K + (tt % S5L) * 16 + (col0 & 15) + (size_t)(col0 >> 4) * S5ROWS * S5K; }
#pragma unroll
                for (int bj = 0; bj < 2; ++bj) { const f32x4 v0 = acc[ai][bj][m][0], v1 = acc[ai][bj][m][1];
                    u32x4 w; w.x = cvt_pk_bf16(v0[0], v0[1]); w.y = cvt_pk_bf16(v0[2], v0[3]); w.z = cvt_pk_bf16(v1[0], v1[1]); w.w = cvt_pk_bf16(v1[2], v1[3]);
                    *(u32x4*)(rowp + (u.pn < 2 ? (size_t)bj * 8 * S5ROWS * S5K : (size_t)bj * SEQ * 128)) = w; } }
    }
};
struct EpiXloc {
    static constexpr bool PERM = false; float* X;
    __device__ __forceinline__ void operator()(const f32x4 (&acc)[2][2][4][2], const Unit& u, int bb, int wr, int wc, int fr, int fq) const {
        const int row0 = (u.pm & 3) * BM + wr * 64 + fr, col0 = wc * 32 + 4 * fq;
#pragma unroll
        for (int ai = 0; ai < 2; ++ai)
#pragma unroll
            for (int m = 0; m < 4; ++m) { float* rp = X + ((size_t)u.e * S5ROWS + row0 + ai * HALF + m * 16) * 128 + col0;
#pragma unroll
                for (int n = 0; n < 2; ++n) *(f32x4*)(rp + n * 16) = acc[ai][0][m][n]; }
    }
};
struct EpiS5Y {
    static constexpr bool PERM = true; const bf16* S5A; const float* dskip; bf16* GY;
    __device__ __forceinline__ void operator()(const f32x4 (&acc)[2][2][4][2], const Unit& u, int bb, int wr, int wc, int fr, int fq) const {
        const int g = u.e, rg0 = (u.pm & 3) * BM + wr * 64 + fr, c0 = u.pn * BM + wc * 32 + 8 * fq;
#pragma unroll
        for (int bj = 0; bj < 2; ++bj) { const int col = c0 + bj * HALF, t = col >> 4, p0 = col & 15;
            const f32x4 d0 = *(const f32x4*)(dskip + g * 16 + p0), d1 = *(const f32x4*)(dskip + g * 16 + p0 + 4);
#pragma unroll
            for (int ai = 0; ai < 2; ++ai)
#pragma unroll
                for (int m = 0; m < 4; ++m) { const int rg = rg0 + ai * HALF + m * 16; const int b = rg / S5NCH, c = rg % S5NCH;
                    const u32x4 uu = *(const u32x4*)(S5A + ((size_t)g * S5ROWS + rg) * S5K + col);
                    const f32x4 v0 = acc[ai][bj][m][0], v1 = acc[ai][bj][m][1];
                    u32x4 w;
                    w.x = cvt_pk_bf16(gelu_tanh(v0[0] + d0[0] * lo_bf(uu.x)), gelu_tanh(v0[1] + d0[1] * hi_bf(uu.x))); w.y = cvt_pk_bf16(gelu_tanh(v0[2] + d0[2] * lo_bf(uu.y)), gelu_tanh(v0[3] + d0[3] * hi_bf(uu.y)));
                    w.z = cvt_pk_bf16(gelu_tanh(v1[0] + d1[0] * lo_bf(uu.z)), gelu_tanh(v1[1] + d1[1] * hi_bf(uu.z))); w.w = cvt_pk_bf16(gelu_tanh(v1[2] + d1[2] * lo_bf(uu.w)), gelu_tanh(v1[3] + d1[3] * hi_bf(uu.w)));
                    *(u32x4*)(GY + ((size_t)b * SEQ + c * S5L + t) * 512 + g * 16 + p0) = w; } }
    }
};
struct S5Sched {
    const char* A; const char* B; int lda2, K2, brows, nN, G, c;
    __device__ __forceinline__ bool next(int i, Unit& u) const { const int L = i * G + c; if (L >= 128 * nN) return false;
        const int g = L / (4 * nN), r = L % (4 * nN), mh = r / nN, pn = r % nN;
        u.A = ((unsigned)g * S5ROWS + mh * 256u) * (unsigned)lda2; u.B = ((unsigned)g * brows + pn * 256u) * (unsigned)K2; u.pm = g * 4 + mh; u.pn = pn; u.e = g; u.nrows = 256; return true; }
    __device__ __forceinline__ __amdgpu_buffer_rsrc_t rsrcA() const { return mkrsrc(A); }
    __device__ __forceinline__ __amdgpu_buffer_rsrc_t rsrcB() const { return mkrsrc(B); }
    __device__ __forceinline__ void prefetch(const Unit&, int, int) const {}
    __device__ __forceinline__ unsigned aoff(const Unit&, int row, int) const { return (unsigned)row * (unsigned)lda2; }
};
struct EpiGlu {
    static constexpr bool PERM = true; const bf16* GY; const float* bglu; bf16* MIX;
    __device__ __forceinline__ void operator()(const f32x4 (&acc)[2][2][4][2], const Unit& u, int bb, int wr, int wc, int fr, int fq) const {
        const int row0 = u.pm * BM + wr * 64 + fr, col0 = u.pn * BM + wc * 32 + 8 * fq;
#pragma unroll
        for (int bj = 0; bj < 2; ++bj) { const int col = col0 + bj * HALF;
            const f32x4 b0 = *(const f32x4*)(bglu + col), b1 = *(const f32x4*)(bglu + col + 4);
#pragma unroll
            for (int ai = 0; ai < 2; ++ai)
#pragma unroll
                for (int m = 0; m < 4; ++m) { const size_t row = (size_t)(row0 + ai * HALF + m * 16);
                    const u32x4 g = *(const u32x4*)(GY + row * 512 + col);
                    const f32x4 v0 = acc[ai][bj][m][0] + b0, v1 = acc[ai][bj][m][1] + b1;
                    u32x4 w;
                    w.x = cvt_pk_bf16(lo_bf(g.x) * sigmoidf_(v0[0]), hi_bf(g.x) * sigmoidf_(v0[1])); w.y = cvt_pk_bf16(lo_bf(g.y) * sigmoidf_(v0[2]), hi_bf(g.y) * sigmoidf_(v0[3]));
                    w.z = cvt_pk_bf16(lo_bf(g.z) * sigmoidf_(v1[0]), hi_bf(g.z) * sigmoidf_(v1[1])); w.w = cvt_pk_bf16(lo_bf(g.w) * sigmoidf_(v1[2]), hi_bf(g.w) * sigmoidf_(v1[3]));
                    *(u32x4*)(MIX + row * D + col) = w; } }
    }
};
struct EpiOut {
    static constexpr bool PERM = true; const float* x; bf16* H;
    __device__ __forceinline__ void operator()(const f32x4 (&acc)[2][2][4][2], const Unit& u, int bb, int wr, int wc, int fr, int fq) const {
        const int row0 = u.pm * BM + wr * 64 + fr, col0 = u.pn * BM + wc * 32 + 8 * fq;
#pragma unroll
        for (int ai = 0; ai < 2; ++ai)
#pragma unroll
            for (int m = 0; m < 4; ++m) { const size_t ro = (size_t)(row0 + ai * HALF + m * 16) * D + col0;
#pragma unroll
                for (int bj = 0; bj < 2; ++bj) { const f32x4 v0 = __builtin_nontemporal_load((const f32x4*)(x + ro + bj * HALF)) + acc[ai][bj][m][0], v1 = __builtin_nontemporal_load((const f32x4*)(x + ro + bj * HALF + 4)) + acc[ai][bj][m][1];
                    u32x4 w; w.x = cvt_pk_bf16(v0[0], v0[1]); w.y = cvt_pk_bf16(v0[2], v0[3]); w.z = cvt_pk_bf16(v1[0], v1[1]); w.w = cvt_pk_bf16(v1[2], v1[3]);
                    *(u32x4*)(H + ro + bj * HALF) = w; } }
    }
};
struct EpiUp {
    static constexpr bool PERM = true; const LAS float* bl; unsigned char* ACT;
    __device__ __forceinline__ void operator()(const f32x4 (&acc)[2][2][4][2], const Unit& u, int bb, int wr, int wc, int fr, int fq) const {
        const int row0 = u.pm * BM + wr * 64 + fr, j0 = u.pn * HALF + wc * 32 + 8 * fq;
        const LAS float* bg = bl + bb * 256 + wc * 32 + 8 * fq;
#pragma unroll
        for (int ai = 0; ai < 2; ++ai)
#pragma unroll
            for (int m = 0; m < 4; ++m) {
                float o[8];
                typedef float f32x2 __attribute__((ext_vector_type(2)));
#pragma unroll
                for (int n = 0; n < 2; ++n) { const f32x4 gb = *(const LAS f32x4*)(bg + 4 * n), lb = *(const LAS f32x4*)(bg + 128 + 4 * n);
#pragma unroll
                    for (int q = 0; q < 4; q += 2) {
                        f32x2 gv = (f32x2){acc[ai][0][m][n][q], acc[ai][0][m][n][q + 1]} * W8_INV + (f32x2){gb[q], gb[q + 1]};
                        f32x2 lv = (f32x2){acc[ai][1][m][n][q], acc[ai][1][m][n][q + 1]} * W8_INV + ((f32x2){lb[q], lb[q + 1]} + 1.f);
                        gv.x = fminf(gv.x, 7.f); gv.y = fminf(gv.y, 7.f);
                        lv.x = __builtin_amdgcn_fmed3f(lv.x, -6.f, 8.f); lv.y = __builtin_amdgcn_fmed3f(lv.y, -6.f, 8.f);
                        f32x2 tt = gv * (-1.702f * 1.4426950408889634f);
                        tt.x = __builtin_amdgcn_exp2f(tt.x); tt.y = __builtin_amdgcn_exp2f(tt.y);
                        tt = tt + 1.f;
                        tt.x = __builtin_amdgcn_rcpf(tt.x); tt.y = __builtin_amdgcn_rcpf(tt.y);
                        const f32x2 ov = (gv * tt) * lv;
                        o[n * 4 + q] = ov.x; o[n * 4 + q + 1] = ov.y; } }
                u32x2 w; w.x = pk4_fp8(o[0], o[1], o[2], o[3]); w.y = pk4_fp8(o[4], o[5], o[6], o[7]);
                *(u32x2*)(ACT + (size_t)(row0 + ai * HALF + m * 16) * FF + j0) = w; }
    }
};
struct EpiDown {
    static constexpr bool PERM = true; const LAS float* bl; unsigned char* YS;
    __device__ __forceinline__ void operator()(const f32x4 (&acc)[2][2][4][2], const Unit& u, int bb, int wr, int wc, int fr, int fq) const {
        const int row0 = u.pm * BM + wr * 64 + fr, col0 = u.pn * BM + wc * 32 + 8 * fq;
        const LAS float* bp = bl + bb * 256 + wc * 32 + 8 * fq;
#pragma unroll
        for (int ai = 0; ai < 2; ++ai)
#pragma unroll
            for (int m = 0; m < 4; ++m)
#pragma unroll
                for (int bj = 0; bj < 2; ++bj) { const f32x4 b0 = *(const LAS f32x4*)(bp + bj * HALF), b1 = *(const LAS f32x4*)(bp + bj * HALF + 4);
                    const f32x4 v0 = acc[ai][bj][m][0] * W8_INV + b0, v1 = acc[ai][bj][m][1] * W8_INV + b1;
                    u32x2 w; w.x = pk4_fp8(v0[0], v0[1], v0[2], v0[3]); w.y = pk4_fp8(v1[0], v1[1], v1[2], v1[3]);
                    *(u32x2*)(YS + (size_t)(row0 + ai * HALF + m * 16) * D + col0 + bj * HALF) = w; }
    }
};
}

struct MoeSched {
    const char* A; const char* W; const int* slot_tok; const float* bias; LAS int* til; LAS int* idx; LAS float* bl; int lda2, K2, nN, wrows  , G, c, gather;
    __device__ __forceinline__ void build_list(LAS int* ul) const {
        const int i = threadIdx.x;
        if (i < 32) { const int nM = til[2 * MAXTILES]; int pm = -1, pn = 0, e = 0, nr = 0;
            if (pg::tile_order(i, G, c, nM, nN, pm, pn)) { e = til[pm]; nr = til[MAXTILES + pm]; } else pm = -1;
            ul[i * 4 + 0] = pm; ul[i * 4 + 1] = pn; ul[i * 4 + 2] = e; ul[i * 4 + 3] = nr; }
    }
    __device__ __forceinline__ bool next(int i, pg::Unit& u) const {
        const LAS int* ul = (const LAS int*)((const LAS char*)til - TIL_OFF + ULIST_OFF);
        if (i >= 32) return false;
        const int pm = __builtin_amdgcn_readfirstlane(ul[i * 4 + 0]); if (pm < 0) return false;
        const int pn = __builtin_amdgcn_readfirstlane(ul[i * 4 + 1]), e = __builtin_amdgcn_readfirstlane(ul[i * 4 + 2]);
        u.pm = pm; u.pn = pn; u.e = e; u.nrows = __builtin_amdgcn_readfirstlane(ul[i * 4 + 3]);
        u.A = gather ? 0u : (unsigned)pm * 256u * (unsigned)lda2; u.B = ((unsigned)e * wrows + (unsigned)pn * 256u) * (unsigned)K2; return true; }
    __device__ __forceinline__ __amdgpu_buffer_rsrc_t rsrcA() const { return pg::mkrsrc(A); }
    __device__ __forceinline__ __amdgpu_buffer_rsrc_t rsrcB() const { return pg::mkrsrc(W); }
    __device__ __forceinline__ void prefetch(const pg::Unit& u, int ib, int bb) const {
        if (threadIdx.x >= 256 && threadIdx.x < 320) {
            const int l = threadIdx.x - 256;
            const float* src = gather ? bias + (size_t)u.e * 2 * FF + (l < 32 ? u.pn * 128 + 4 * l : FF + u.pn * 128 + 4 * (l - 32)) : bias + (size_t)u.e * D + u.pn * 256 + 4 * l;
            __builtin_amdgcn_global_load_lds((const unsigned*)src, (LAS unsigned*)(bl + bb * 256), 16, 0, 0); }
        if (gather && threadIdx.x < 256) { const int r = threadIdx.x; const int s = u.pm * 256 + (r < u.nrows ? r : u.nrows - 1);
            __builtin_amdgcn_global_load_lds((const unsigned*)(slot_tok + s), (LAS unsigned*)(idx + ib * 256 + (threadIdx.x & ~63)), 4, 0, 0); } }
    __device__ __forceinline__ unsigned aoff(const pg::Unit&, int row, int ib) const { return gather ? (unsigned)idx[ib * 256 + row] * (unsigned)lda2 : (unsigned)row * (unsigned)lda2; }
};

struct Frame {
    LAS unsigned char* lds; volatile LAS unsigned* MISC; gu32* ctl; int tid, lane, wave, vcu, G;
};
#define LDS_WAIT() asm volatile("s_waitcnt lgkmcnt(0)" ::: "memory")

template <bool F8, class RowMap>
__device__ __forceinline__ void transpose_item(const float* W, int ldw, int K, int nblk, void* WTv, LAS bf16* scr, int item, int lane, RowMap rowmap) {
    const int kb = item / nblk, nb = item % nblk, k0 = 64 * kb, n0 = 64 * nb;
    const float* src = W + (size_t)(k0 + (lane >> 4)) * ldw + n0 + 4 * (lane & 15);
    f32x4 v[16];
#pragma unroll
    for (int i = 0; i < 16; ++i) v[i] = __builtin_nontemporal_load((const f32x4*)(src + (size_t)(4 * i) * ldw));
#pragma unroll
    for (int i = 0; i < 16; ++i) { u32x2 o; o.x = pk2(v[i].x, v[i].y); o.y = pk2(v[i].z, v[i].w); *(LAS u32x2*)(scr + ((lane >> 4) + 4 * i) * 68 + 4 * (lane & 15)) = o; }
    LDS_WAIT(); asm volatile("" ::: "memory");
    const int c = lane & 7; const int r0 = rowmap(n0);
#pragma unroll
    for (int jn = 0; jn < 8; ++jn) { const int n = (lane >> 3) + 8 * jn; const LAS bf16* sp = scr + (8 * c) * 68 + n;
        if constexpr (F8) { u32x2 o; o.x = pk4_fp8(bf2f(sp[0]) * W8_SCALE, bf2f(sp[68]) * W8_SCALE, bf2f(sp[2 * 68]) * W8_SCALE, bf2f(sp[3 * 68]) * W8_SCALE);
            o.y = pk4_fp8(bf2f(sp[4 * 68]) * W8_SCALE, bf2f(sp[5 * 68]) * W8_SCALE, bf2f(sp[6 * 68]) * W8_SCALE, bf2f(sp[7 * 68]) * W8_SCALE);
            __builtin_nontemporal_store(o, (u32x2*)((unsigned char*)WTv + (size_t)(r0 + n) * K + k0 + 8 * c)); }
        else { u32x4 o; o.x = (unsigned)sp[0] | ((unsigned)sp[68] << 16); o.y = (unsigned)sp[2 * 68] | ((unsigned)sp[3 * 68] << 16); o.z = (unsigned)sp[4 * 68] | ((unsigned)sp[5 * 68] << 16); o.w = (unsigned)sp[6 * 68] | ((unsigned)sp[7 * 68] << 16);
            *(u32x4*)((bf16*)WTv + (size_t)(r0 + n) * K + k0 + 8 * c) = o; } }
    LDS_WAIT(); asm volatile("" ::: "memory");
}
struct RowId { __device__ __forceinline__ int operator()(int n0) const { return n0; } };
struct RowUp { __device__ __forceinline__ int operator()(int n0) const { return n0 < FF ? (n0 >> 7) * 256 + (n0 & 127) : ((n0 - FF) >> 7) * 256 + 128 + ((n0 - FF) & 127); } };

struct Args { const float* in[26]; float* out; unsigned char* ws; int ph_lo, ph_hi, li, pad; };

__global__ void __launch_bounds__(NTHR, 2) fwd(Args args) {
    extern __shared__ __attribute__((aligned(16))) unsigned char lds_raw[];
    Frame F;
    F.lds = (LAS unsigned char*)lds_raw;
    F.MISC = (volatile LAS unsigned*)(F.lds + MISC_OFF);
    F.tid = threadIdx.x; F.lane = F.tid & 63; F.wave = __builtin_amdgcn_readfirstlane(F.tid >> 6);
    F.G = gridDim.x; { const int bx = blockIdx.x; F.vcu = (F.G % 8 == 0) ? (bx % 8) * (F.G / 8) + bx / 8 : bx; }
    unsigned char* ws = args.ws;
    F.ctl = (gu32*)(ws + WS_CTL);
    if (F.tid < 32) ((LAS unsigned*)(F.lds + MISC_OFF))[F.tid] = 0u;
    __syncthreads();
    XcdBarrier bar = xcd_barrier_post((unsigned*)(F.ctl + CW_BAR) + args.li * XCD_BAR_WORDS, F.MISC + 8);
#define INP(i) (*(const float* const volatile*)((const char*)__builtin_amdgcn_kernarg_segment_ptr() + 8 * (i)))
    const int lo = args.ph_lo, hi = args.ph_hi;
#define IN(k) (lo <= (k) && (k) < hi)
#define BOTH(k) (IN(k) && IN((k) + 1))
#define GRID_BAR() xcd_barrier(bar)
    const float* x = args.in[0];
    bf16* WIN = (bf16*)(ws + WS_WIN); bf16* WGLU = (bf16*)(ws + WS_WGLU); bf16* WOUT = (bf16*)(ws + WS_WOUT); unsigned char* WUP8 = ws + WS_WUP; unsigned char* WDN8 = ws + WS_WDN;
    bf16* HN = (bf16*)(ws + WS_HN); bf16* PROJ = (bf16*)(ws + WS_PROJ); bf16* GY = (bf16*)(ws + WS_GY); bf16* MIX = (bf16*)(ws + WS_MIX);
    bf16* H = (bf16*)(ws + WS_H); unsigned char* ACT8 = ws + WS_ACT; unsigned char* HN8 = ws + WS_HN; unsigned char* YS = ws + WS_YS;
    float* gates = (float*)(ws + WS_GATES); int* topi = (int*)(ws + WS_TOPI); float* topg = (float*)(ws + WS_TOPG);
    int* slot_tok = (int*)(ws + WS_SLOTTOK); int* tok_slot = (int*)(ws + WS_TOKSLOT); int* CNT = (int*)(ws + WS_CNT); int* ecnt = CNT + 16384;
    bf16* S5A = (bf16*)(ws + WS_S5A); bf16* S5BT = (bf16*)(ws + WS_S5BT); bf16* S5BQ = (bf16*)(ws + WS_S5BQ); float* XLOC = (float*)(ws + WS_XLOC);
    bf16* QH = (bf16*)(ws + WS_QH); bf16* KH = (bf16*)(ws + WS_KH); bf16* VT = (bf16*)(ws + WS_VT); float* DC = (float*)(ws + WS_DC); bf16* CST = (bf16*)(ws + WS_CST);
    float* FLOC = (float*)(ws + WS_FLOC); float* DN = (float*)(ws + WS_DN); float* NST = (float*)(ws + WS_NST); float* SEGS = (float*)(ws + WS_SEGS); float* KTAB = (float*)(ws + WS_KTAB); bf16* WR2 = (bf16*)(ws + WS_WR2);
    const int gw = F.vcu * NWAVES + F.wave, NGW = F.G * NWAVES;

    if (IN(0)) {
        { int tq_ = threadIdx.x; asm volatile("" : "+v"(tq_)); F.tid = tq_; F.lane = tq_ & 63; }
        LAS bf16* scr = (LAS bf16*)(F.lds + F.wave * 16384);
        constexpr int I_IN = (D / 64) * (NPROJ / 64), I_GLU = (512 / 64) * (512 / 64), I_OUT = (D / 64) * (D / 64), I_UP = (D / 64) * (2 * FF / 64);
        constexpr int NITEMS = I_IN + I_GLU + I_OUT + NE * I_UP;
        for (int it = gw; it < NITEMS && !(args.pad & 1); it += NGW) {
            int r = it;
            if (r < I_IN) { transpose_item<false>(args.in[2], DIN, D, NPROJ / 64, WIN, scr, r, F.lane, RowId()); continue; } r -= I_IN;
            if (r < I_GLU) { transpose_item<false>(args.in[11], 512, 512, 512 / 64, WGLU, scr, r, F.lane, RowId()); continue; } r -= I_GLU;
            if (r < I_OUT) { transpose_item<false>(args.in[17], D, D, D / 64, WOUT, scr, r, F.lane, RowId()); continue; } r -= I_OUT;
            { const int e = r / I_UP; transpose_item<true>(args.in[21] + (size_t)e * D * 2 * FF, 2 * FF, D, 2 * FF / 64, WUP8 + (size_t)e * 2 * FF * D, scr, r % I_UP, F.lane, RowUp()); }
        }
        {
            const float* g = args.in[1]; const float* w_in = args.in[2]; const float* b_gates = args.in[15];
            float wg[16][8]; f32x4 gg[4];
#pragma unroll
            for (int jq = 0; jq < 4; ++jq) { gg[jq] = *(const f32x4*)(g + 4 * F.lane + 256 * jq);
#pragma unroll
                for (int i = 0; i < 4; ++i) { const int k = 4 * F.lane + 256 * jq + i; const f32x4 w0 = *(const f32x4*)(w_in + (size_t)k * DIN + O_G), w1 = *(const f32x4*)(w_in + (size_t)k * DIN + O_G + 4);
                    wg[4 * jq + i][0] = w0.x; wg[4 * jq + i][1] = w0.y; wg[4 * jq + i][2] = w0.z; wg[4 * jq + i][3] = w0.w; wg[4 * jq + i][4] = w1.x; wg[4 * jq + i][5] = w1.y; wg[4 * jq + i][6] = w1.z; wg[4 * jq + i][7] = w1.w; } }
            float bgv[8];
#pragma unroll
            for (int q = 0; q < 8; ++q) bgv[q] = b_gates[q];
            f32x4 nx[4];
            if (gw < T) {
#pragma unroll
                for (int jq = 0; jq < 4; ++jq) nx[jq] = __builtin_nontemporal_load((const f32x4*)(x + (size_t)gw * D + 4 * F.lane + 256 * jq)); }
            for (int row = gw; row < T && !(args.pad & 2); row += NGW) {
                f32x4 v[4];
#pragma unroll
                for (int jq = 0; jq < 4; ++jq) v[jq] = nx[jq];
                if (row + NGW < T) {
#pragma unroll
                    for (int jq = 0; jq < 4; ++jq) nx[jq] = __builtin_nontemporal_load((const f32x4*)(x + (size_t)(row + NGW) * D + 4 * F.lane + 256 * jq)); }
                float ss = 0.f;
#pragma unroll
                for (int jq = 0; jq < 4; ++jq) ss += v[jq].x * v[jq].x + v[jq].y * v[jq].y + v[jq].z * v[jq].z + v[jq].w * v[jq].w;
                ss = wave_sum(ss);
                const float rstd = rsqrtf(ss * (1.f / D) + 1e-5f);
                float ga[8] = {0, 0, 0, 0, 0, 0, 0, 0};
#pragma unroll
                for (int jq = 0; jq < 4; ++jq) {
                    v[jq] = v[jq] * rstd * gg[jq];
#pragma unroll
                    for (int i = 0; i < 4; ++i)
#pragma unroll
                        for (int q = 0; q < 8; ++q) ga[q] += v[jq][i] * wg[4 * jq + i][q];
                    uint2 o; o.x = pk2(v[jq].x, v[jq].y); o.y = pk2(v[jq].z, v[jq].w);
                    *(uint2*)(HN + (size_t)row * D + 4 * F.lane + 256 * jq) = o;
                }
#pragma unroll
                for (int q = 0; q < 8; ++q) ga[q] = wave_sum(ga[q]);
                if (F.lane == 0) { *(f32x4*)(gates + (size_t)row * 8) = (f32x4){ga[0] + bgv[0], ga[1] + bgv[1], ga[2] + bgv[2], ga[3] + bgv[3]}; *(f32x4*)(gates + (size_t)row * 8 + 4) = (f32x4){ga[4] + bgv[4], ga[5] + bgv[5], ga[6] + bgv[6], ga[7] + bgv[7]}; }
            }
        }
        for (int idx = gw * 64 + F.lane; idx < 4096; idx += NGW * 64) {
            const int sidx = idx >> 6, l = idx & 63, kb = 16 * sidx + 8 * (l >> 5), e = l & 31;
            float hv[8], lv[8];
#pragma unroll
            for (int jj = 0; jj < 8; ++jj) { const float w = args.in[18][kb + jj] * args.in[19][(size_t)(kb + jj) * NE + e]; const bf16 hb = f2bf(w); hv[jj] = bf2f(hb); lv[jj] = w - hv[jj]; }
            u32x4 oh, ol; oh.x = pk2(hv[0], hv[1]); oh.y = pk2(hv[2], hv[3]); oh.z = pk2(hv[4], hv[5]); oh.w = pk2(hv[6], hv[7]);
            ol.x = pk2(lv[0], lv[1]); ol.y = pk2(lv[2], lv[3]); ol.z = pk2(lv[4], lv[5]); ol.w = pk2(lv[6], lv[7]);
            *(u32x4*)(WR2 + (size_t)idx * 8) = oh; *(u32x4*)(WR2 + (size_t)(4096 + idx) * 8) = ol;
        }
        __syncthreads();
        for (int un = F.vcu; un < 256 && !(args.pad & 4); un += F.G) {
            const int g = un >> 3, j = un & 7;
            LAS float* Ere = (LAS float*)F.lds; LAS float* Eim = Ere + 4 * 64;
            LAS float* Bbr = Eim + 4 * 64; LAS float* Bbi = Bbr + 1024;
            LAS float* Cr = Bbi + 1024; LAS float* Ci = Cr + 1024;
            LAS float* E6r = Ci + 1024; LAS float* E6i = E6r + 1024;
            const float dt = __expf(args.in[3][g]);
            if (F.tid < 64) { const int n = F.tid;
                const float are = fminf(args.in[4][g * 64 + n], -1e-4f), aim = args.in[5][g * 64 + n];
                const float mag = __expf(dt * are); float sn, cs; fcis(dt * aim, &sn, &cs);
                const float nr = mag * cs - 1.f, ni = mag * sn, dn = are * are + aim * aim;
                const float cfr = (nr * are + ni * aim) / dn, cfi = (ni * are - nr * aim) / dn;
                for (int q = 0; q < 16; ++q) { const float br = args.in[6][(g * 64 + n) * 16 + q], bi = args.in[7][(g * 64 + n) * 16 + q]; Bbr[n * 16 + q] = cfr * br - cfi * bi; Bbi[n * 16 + q] = cfr * bi + cfi * br; }
            }
            for (int i = F.tid; i < 1024; i += NTHR) { Cr[i] = args.in[8][g * 1024 + i]; Ci[i] = args.in[9][g * 1024 + i]; }
            if (F.tid < 256) { const int tl = F.tid >> 6, n = F.tid & 63; const float tau = (float)(4 * j + tl);
                const float are = fminf(args.in[4][g * 64 + n], -1e-4f), aim = args.in[5][g * 64 + n];
                const float mag = __expf(tau * dt * are); float sn, cs; fcis(tau * dt * aim, &sn, &cs); Ere[F.tid] = mag * cs; Eim[F.tid] = mag * sn; }
            for (int i = F.tid; i < 1024; i += NTHR) { const int tau = i >> 5, n = 32 * (j & 1) + (i & 31);
                const float are = fminf(args.in[4][g * 64 + n], -1e-4f), aim = args.in[5][g * 64 + n];
                const float mag = __expf((float)tau * dt * are); float sn, cs; fcis((float)tau * dt * aim, &sn, &cs); E6r[i] = mag * cs; E6i[i] = mag * sn; }
            __syncthreads();
            {
                const int tl = F.tid >> 7, p = (F.tid >> 3) & 15, q0 = (F.tid & 7) * 2;
                float a0 = 0.f, a1 = 0.f;
                for (int n = 0; n < 64; ++n) { const float cr = Cr[p * 64 + n], ci = Ci[p * 64 + n], er = Ere[tl * 64 + n], ei = Eim[tl * 64 + n];
                    const float xr = cr * er - ci * ei, xi = cr * ei + ci * er;
                    a0 += xr * Bbr[n * 16 + q0] - xi * Bbi[n * 16 + q0]; a1 += xr * Bbr[n * 16 + q0 + 1] - xi * Bbi[n * 16 + q0 + 1]; }
                KTAB[((size_t)g * S5L + 4 * j + tl) * 256 + p * 16 + q0] = a0; KTAB[((size_t)g * S5L + 4 * j + tl) * 256 + p * 16 + q0 + 1] = a1;
            }
            for (int ch = F.tid; ch < 32 * (S5KIN / 8); ch += NTHR) {
                const int rl = ch / (S5KIN / 8), c8 = ch % (S5KIN / 8), r = 32 * j + rl, n = r & 63, im = (r >> 6) & 1, col = c8 * 8, sidx = col >> 4, q0 = col & 15;
                const float er = E6r[(S5L - 1 - sidx) * 32 + (n & 31)], ei = E6i[(S5L - 1 - sidx) * 32 + (n & 31)];
                float v[8];
#pragma unroll
                for (int i = 0; i < 8; ++i) { const float br = Bbr[n * 16 + q0 + i], bi = Bbi[n * 16 + q0 + i]; v[i] = im ? (er * bi + ei * br) : (er * br - ei * bi); }
                u32x4 o; o.x = pk2(v[0], v[1]); o.y = pk2(v[2], v[3]); o.z = pk2(v[4], v[5]); o.w = pk2(v[6], v[7]);
                *(u32x4*)(S5BQ + ((size_t)g * 256 + r) * S5KIN + col) = o;
            }
            __syncthreads();
        }
        if (BOTH(0)) GRID_BAR();
    }
    if (IN(1)) {
        { int tq_ = threadIdx.x; asm volatile("" : "+v"(tq_)); F.tid = tq_; F.lane = tq_ & 63; }
        pg::DenseSched S{(const char*)HN, (const char*)WIN, D * 2, D * 2, T / 256, NPROJ / 256, F.G, (int)blockIdx.x};
        pg::EpiProj E{PROJ, S5A};
        pg::gemm_phase<pg::EpiProj, pg::DenseSched, true>(F.lds, D, S, E);
        if (BOTH(1)) GRID_BAR();
    }
    if (IN(2)) {
        { int tq_ = threadIdx.x; asm volatile("" : "+v"(tq_)); F.tid = tq_; F.lane = tq_ & 63; }
        pg::S5Sched S{(const char*)S5A, (const char*)S5BQ, S5K * 2, S5KIN * 2, 256, 1, F.G, F.vcu};
        pg::EpiXloc E{XLOC};
        pg::gemm_phase<pg::EpiXloc, pg::S5Sched, true>(F.lds, S5KIN, S, E);
        {
            const int first = F.G > 128 ? F.vcu - 128 : F.vcu, stride = F.G > 128 ? F.G - 128 : F.G;
            LAS float* Kt = (LAS float*)F.lds;
            LAS float* Ere = Kt + S5L * 256; LAS float* Eim = Ere + 4 * 64;
            LAS float* Cr = Eim + 4 * 64; LAS float* Ci = Cr + 1024;
            for (int un = first; un >= 0 && un < 256; un += stride) {
                const int g = un >> 3, j = un & 7, ntau = 4 * j + 4;
                __syncthreads();
                for (int i = F.tid; i < ntau * 64; i += NTHR) *(LAS f32x4*)(Kt + 4 * i) = *(const f32x4*)(KTAB + (size_t)g * S5L * 256 + 4 * i);
                for (int i = F.tid; i < 1024; i += NTHR) { Cr[i] = args.in[8][g * 1024 + i]; Ci[i] = args.in[9][g * 1024 + i]; }
                if (F.tid < 256) { const int tl = F.tid >> 6, n = F.tid & 63; const float tau = (float)(4 * j + tl + 1); const float dt = __expf(args.in[3][g]);
                    const float are = fminf(args.in[4][g * 64 + n], -1e-4f), aim = args.in[5][g * 64 + n];
                    const float mag = __expf(tau * dt * are); float sn, cs; fcis(tau * dt * aim, &sn, &cs); Ere[F.tid] = mag * cs; Eim[F.tid] = mag * sn; }
                __syncthreads();
                for (int ch = F.tid; ch < 64 * (S5K / 8); ch += NTHR) {
                    const int rl = ch / (S5K / 8), c8 = ch % (S5K / 8), tl = rl >> 4, t = 4 * j + tl, p = rl & 15, col = c8 * 8;
                    float v[8];
                    if (col < S5KIN) { const int sidx = col >> 4, q0 = col & 15;
                        if (sidx <= t) { const f32x4 k0 = *(const LAS f32x4*)(Kt + (t - sidx) * 256 + p * 16 + q0), k1 = *(const LAS f32x4*)(Kt + (t - sidx) * 256 + p * 16 + q0 + 4);
                            v[0] = k0.x; v[1] = k0.y; v[2] = k0.z; v[3] = k0.w; v[4] = k1.x; v[5] = k1.y; v[6] = k1.z; v[7] = k1.w; }
                        else {
#pragma unroll
                            for (int i = 0; i < 8; ++i) v[i] = 0.f; }
                    } else { const int jj = (col - S5KIN) & 63, im = (col - S5KIN) >> 6;
#pragma unroll
                        for (int i = 0; i < 8; ++i) { const int n = jj + i; const float cr = Cr[p * 64 + n], ci = Ci[p * 64 + n], er = Ere[tl * 64 + n], ei = Eim[tl * 64 + n];
                            v[i] = im ? -(cr * ei + ci * er) : (cr * er - ci * ei); } }
                    u32x4 o; o.x = pk2(v[0], v[1]); o.y = pk2(v[2], v[3]); o.z = pk2(v[4], v[5]); o.w = pk2(v[6], v[7]);
                    *(u32x4*)(S5BT + ((size_t)g * S5KIN + 64 * j + rl) * S5K + col) = o;
                }
            }
            __syncthreads();
        }
    }
    if (IN(3)) {
        { int tq_ = threadIdx.x; asm volatile("" : "+v"(tq_)); F.tid = tq_; F.lane = tq_ & 63; }
        typedef short s16x4 __attribute__((ext_vector_type(4)));
        LAS float* wsl = (LAS float*)F.lds;
        LAS float* red = wsl + 512;
        LAS float* dnl = red + 32;
        LAS bf16* RQ = (LAS bf16*)(F.lds + 4352);
        LAS bf16* RK = RQ + 67 * 136;
        LAS bf16* RV = RK + 67 * 136;
        LAS bf16* QN = RV + 64 * 136;
        LAS bf16* KN = QN + 64 * 136;
        LAS bf16* KTl = KN + 64 * 136;
        LAS bf16* VTl = KTl + 128 * 72;
        const float* cw = args.in[13]; const float* cbias = args.in[14];
        for (int un = blockIdx.x; un < 256; un += F.G) {
            const int bh = un >> 4, seg = un & 15, b = bh >> 2, hd = bh & 3, t0 = seg * 512; const size_t row0 = (size_t)b * SEQ + t0;
            float Fl, Aval;
            {
                const float ipre = gates[(row0 + F.tid) * 8 + hd], fpre = gates[(row0 + F.tid) * 8 + 4 + hd];
                const float lf = fminf(fpre, 0.f) - log1pf(__expf(-fabsf(fpre)));
                float sc = lf;
#pragma unroll
                for (int o = 1; o < 64; o <<= 1) { const float tv = __shfl_up(sc, o); if (F.lane >= o) sc += tv; }
                if (F.lane == 63) red[F.wave] = sc;
                __syncthreads();
                float base = 0.f;
                for (int w2 = 0; w2 < F.wave; ++w2) base += red[w2];
                Fl = sc + base; Aval = ipre - Fl;
                float mx = Aval;
#pragma unroll
                for (int o = 1; o < 64; o <<= 1) mx = fmaxf(mx, __shfl_xor(mx, o));
                if (F.lane == 0) red[8 + F.wave] = mx;
                __syncthreads();
                float Amax = red[8];
                for (int w2 = 1; w2 < 8; ++w2) Amax = fmaxf(Amax, red[8 + w2]);
                wsl[F.tid] = __expf(Aval - Amax);
                FLOC[(size_t)bh * SEQ + t0 + F.tid] = Fl;
                if (F.tid == 511) { SEGS[un * 4 + 0] = Fl; SEGS[un * 4 + 1] = Amax; }
            }
            f32x16 dacc[2];
#pragma unroll
            for (int i = 0; i < 2; ++i)
#pragma unroll
                for (int q = 0; q < 16; ++q) dacc[i][q] = 0.f;
            const int cp = F.tid & 127, isk = cp >> 6, c2 = (cp & 63) * 2, tqr = F.tid >> 7;
            const int gch = isk * 512 + hd * 128 + c2;
            const float cw0a = cw[gch], cw1a = cw[1024 + gch], cw2a = cw[2048 + gch], cw3a = cw[3072 + gch], cba = cbias[gch];
            const float cw0b = cw[gch + 1], cw1b = cw[1024 + gch + 1], cw2b = cw[2048 + gch + 1], cw3b = cw[3072 + gch + 1], cbb = cbias[gch + 1];
            float dnacc0 = 0.f, dnacc1 = 0.f;
            u32x4 rt[7];
#define ML_RAW_LOAD(tsv) do { _Pragma("unroll") for (int ii = 0; ii < 7; ++ii) { const int ch = F.tid + NTHR * ii; u32x4 v = (u32x4){0u, 0u, 0u, 0u}; \
                if (ch < 2 * 67 * 16) { const int which = ch / (67 * 16), r = (ch % (67 * 16)) >> 4, c16 = ch & 15; const int tk = (tsv) - 3 + r; \
                    if (tk >= 0) v = *(const u32x4*)(PROJ + ((size_t)((which ? 16 : 0) + bh) * SEQ + tk) * 128 + c16 * 8); } \
                else if (ch < 2 * 67 * 16 + 64 * 16) { const int c2 = ch - 2 * 67 * 16, r = c2 >> 4, c16 = c2 & 15; v = *(const u32x4*)(PROJ + ((size_t)(32 + bh) * SEQ + (tsv) + r) * 128 + c16 * 8); } \
                rt[ii] = v; } } while (0)
            ML_RAW_LOAD(t0);
#define ML_RAW_STORE() do { _Pragma("unroll") for (int ii = 0; ii < 7; ++ii) { const int ch = F.tid + NTHR * ii; \
                if (ch < 2 * 67 * 16) { const int which = ch / (67 * 16), r = (ch % (67 * 16)) >> 4, c16 = ch & 15; *(LAS u32x4*)((which ? RK : RQ) + r * 136 + c16 * 8) = rt[ii]; } \
                else if (ch < 2 * 67 * 16 + 64 * 16) { const int c2_ = ch - 2 * 67 * 16, r = c2_ >> 4, c16 = c2_ & 15; *(LAS u32x4*)(RV + r * 136 + c16 * 8) = rt[ii]; } } } while (0)
            __syncthreads();
            ML_RAW_STORE(); ML_RAW_LOAD(t0 + 64);
            __syncthreads();
            for (int sb = 0; sb < 8; ++sb) {
                const int ts = t0 + sb * 64;
                {
                    const LAS unsigned* raw = (const LAS unsigned*)(isk ? RK : RQ) + c2 / 2; LAS unsigned* dst = (LAS unsigned*)(isk ? KN : QN) + c2 / 2; const int s0 = tqr * 16;
                    const unsigned h0 = raw[(s0 + 0) * 68], h1 = raw[(s0 + 1) * 68], h2 = raw[(s0 + 2) * 68];
                    float x3a = lo_bf(h0), x3b = hi_bf(h0), x2a = lo_bf(h1), x2b = hi_bf(h1), x1a = lo_bf(h2), x1b = hi_bf(h2);
#pragma unroll 4
                    for (int sidx = s0; sidx < s0 + 16; ++sidx) {
                        const unsigned xw = raw[(sidx + 3) * 68]; const float xa = lo_bf(xw), xb = hi_bf(xw);
                        float va = cba + cw0a * x3a + cw1a * x2a + cw2a * x1a + cw3a * xa, vb = cbb + cw0b * x3b + cw1b * x2b + cw2b * x1b + cw3b * xb;
                        x3a = x2a; x2a = x1a; x1a = xa; x3b = x2b; x2b = x1b; x1b = xb;
                        va *= sigmoidf_(va); vb *= sigmoidf_(vb);
                        if (isk) { const float wk = 0.08838834764831845f * wsl[sb * 64 + sidx]; va *= wk; vb *= wk; dnacc0 += va; dnacc1 += vb; }
                        dst[sidx * 68] = cvt_pk_bf16(va, vb);
                    }
                }
                __syncthreads();
#pragma unroll
                for (int ii = 0; ii < 2; ++ii) { const int ch = F.tid + NTHR * ii, r = ch >> 4, c16 = ch & 15;
                    *(u32x4*)(QH + ((size_t)bh * SEQ + ts + r) * 128 + c16 * 8) = *(const LAS u32x4*)(QN + r * 136 + c16 * 8);
                    *(u32x4*)(KH + ((size_t)bh * SEQ + ts + r) * 128 + c16 * 8) = *(const LAS u32x4*)(KN + r * 136 + c16 * 8); }
                {
                    const int c = F.tid & 127, sq = F.tid >> 7;
#pragma unroll
                    for (int half = 0; half < 2; ++half) { const int sA = sq * 16 + half * 8;
                        u32x4 kk, vv;
                        kk.x = (unsigned)KN[(sA + 0) * 136 + c] | ((unsigned)KN[(sA + 1) * 136 + c] << 16); kk.y = (unsigned)KN[(sA + 2) * 136 + c] | ((unsigned)KN[(sA + 3) * 136 + c] << 16);
                        kk.z = (unsigned)KN[(sA + 4) * 136 + c] | ((unsigned)KN[(sA + 5) * 136 + c] << 16); kk.w = (unsigned)KN[(sA + 6) * 136 + c] | ((unsigned)KN[(sA + 7) * 136 + c] << 16);
                        vv.x = (unsigned)RV[(sA + 0) * 136 + c] | ((unsigned)RV[(sA + 1) * 136 + c] << 16); vv.y = (unsigned)RV[(sA + 2) * 136 + c] | ((unsigned)RV[(sA + 3) * 136 + c] << 16);
                        vv.z = (unsigned)RV[(sA + 4) * 136 + c] | ((unsigned)RV[(sA + 5) * 136 + c] << 16); vv.w = (unsigned)RV[(sA + 6) * 136 + c] | ((unsigned)RV[(sA + 7) * 136 + c] << 16);
                        *(LAS u32x4*)(KTl + c * 72 + sA) = kk; *(LAS u32x4*)(VTl + c * 72 + sA) = vv; }
                }
                __syncthreads();
                {
                    const int e = F.tid >> 2, part = F.tid & 3;
                    const u32x4 v0 = *(const LAS u32x4*)(VTl + e * 72 + part * 16), v1 = *(const LAS u32x4*)(VTl + e * 72 + part * 16 + 8);
                    bf16* dst = VT + ((size_t)bh * 128 + e) * SEQ + ts + part * 16;
                    *(u32x4*)dst = v0; *(u32x4*)(dst + 8) = v1;
                    const int eb = F.wave >> 1, db0 = (F.wave & 1) * 2, r = F.lane & 31, hh = F.lane >> 5;
#pragma unroll
                    for (int ks = 0; ks < 4; ++ks) {
                        const bf16x8 a = *(const LAS bf16x8*)(VTl + (eb * 32 + r) * 72 + ks * 16 + hh * 8);
                        const bf16x8 b0 = *(const LAS bf16x8*)(KTl + (db0 * 32 + r) * 72 + ks * 16 + hh * 8), b1 = *(const LAS bf16x8*)(KTl + ((db0 + 1) * 32 + r) * 72 + ks * 16 + hh * 8);
                        dacc[0] = __builtin_amdgcn_mfma_f32_32x32x16_bf16(a, b0, dacc[0], 0, 0, 0);
                        dacc[1] = __builtin_amdgcn_mfma_f32_32x32x16_bf16(a, b1, dacc[1], 0, 0, 0);
                    }
                }
                if (sb < 7) { ML_RAW_STORE(); if (sb < 6) ML_RAW_LOAD(ts + 128); }
                __syncthreads();
            }
#undef ML_RAW_STORE
#undef ML_RAW_LOAD
            if (isk) { dnl[tqr * 128 + c2] = dnacc0; dnl[tqr * 128 + c2 + 1] = dnacc1; }
            {
                const int eb = F.wave >> 1, db0 = (F.wave & 1) * 2, r = F.lane & 31, hh = F.lane >> 5;
#pragma unroll
                for (int i = 0; i < 2; ++i)
#pragma unroll
                    for (int q = 0; q < 16; ++q) DC[((size_t)un * 128 + eb * 32 + (q & 3) + 8 * (q >> 2) + 4 * hh) * 128 + (db0 + i) * 32 + r] = dacc[i][q];
            }
            __syncthreads();
            if (F.tid < 128) DN[un * 128 + F.tid] = (dnl[F.tid] + dnl[128 + F.tid]) + (dnl[256 + F.tid] + dnl[384 + F.tid]);
            __syncthreads();
        }
        if (BOTH(3)) GRID_BAR();
    }
    if (IN(4)) {
        { int tq_ = threadIdx.x; asm volatile("" : "+v"(tq_)); F.tid = tq_; F.lane = tq_ & 63; }
        LAS float* agr = (LAS float*)F.lds; LAS float* agi = agr + 512;
        for (int un = blockIdx.x; un < 128; un += F.G) {
            const int b = un >> 5, g = un & 31, n = F.tid & 63, seg = F.tid >> 6;
            const float dt = __expf(args.in[3][g]);
            const float are = fminf(args.in[4][g * 64 + n], -1e-4f), aim = args.in[5][g * 64 + n];
            float ar, ai, Ar, Ai;
            { const float mag = __expf((float)S5L * dt * are); float sn, cs; fcis((float)S5L * dt * aim, &sn, &cs); ar = mag * cs; ai = mag * sn; }
            { const float mag = __expf((float)(S5L * 32) * dt * are); float sn, cs; fcis((float)(S5L * 32) * dt * aim, &sn, &cs); Ar = mag * cs; Ai = mag * sn; }
            const size_t row0 = (size_t)g * S5ROWS + b * S5NCH + seg * 32;
            float xr[32], xi[32];
#pragma unroll
            for (int jj = 0; jj < 32; ++jj) { xr[jj] = XLOC[(row0 + jj) * 128 + n]; xi[jj] = XLOC[(row0 + jj) * 128 + 64 + n]; }
            float sr = 0.f, si = 0.f;
#pragma unroll
            for (int jj = 0; jj < 32; ++jj) { const float tr = ar * sr - ai * si + xr[jj], ti = ar * si + ai * sr + xi[jj]; sr = tr; si = ti; }
            agr[seg * 64 + n] = sr; agi[seg * 64 + n] = si;
            __syncthreads();
            float cr = 0.f, ci = 0.f;
            for (int s2 = 0; s2 < seg; ++s2) { const float tr = Ar * cr - Ai * ci + agr[s2 * 64 + n], ti = Ar * ci + Ai * cr + agi[s2 * 64 + n]; cr = tr; ci = ti; }
#pragma unroll
            for (int jj = 0; jj < 32; ++jj) {
                S5A[(row0 + jj) * S5K + S5KIN + n] = f2bf(cr); S5A[(row0 + jj) * S5K + S5KIN + 64 + n] = f2bf(ci);
                const float tr = ar * cr - ai * ci + xr[jj], ti = ar * ci + ai * cr + xi[jj]; cr = tr; ci = ti; }
            __syncthreads();
        }
        for (int un = blockIdx.x; un < 256; un += F.G) {
            const int bh = un >> 4, slice = un & 15;
            float dc0[16], dc1[16];
#pragma unroll
            for (int j = 0; j < 16; ++j) { dc0[j] = DC[((size_t)(bh * 16 + j)) * 16384 + slice * 1024 + F.tid]; dc1[j] = DC[((size_t)(bh * 16 + j)) * 16384 + slice * 1024 + 512 + F.tid]; }
            float dn[16];
            const bool nrole = (slice == 0 && F.tid < 128);
#pragma unroll
            for (int j = 0; j < 16; ++j) dn[j] = nrole ? DN[(bh * 16 + j) * 128 + F.tid] : 0.f;
            float m = 0.f, C0 = 0.f, C1 = 0.f, nn = 0.f;
#pragma unroll
            for (int j = 0; j < 16; ++j) {
                const float Fend = SEGS[(bh * 16 + j) * 4 + 0], Amax = SEGS[(bh * 16 + j) * 4 + 1];
                const float R = fmaxf(m, Amax), c1 = __expf(m - R), c2 = __expf(Amax - R);
                CST[((size_t)(bh * 16 + j)) * 16384 + slice * 1024 + F.tid] = f2bf(c1 * C0); CST[((size_t)(bh * 16 + j)) * 16384 + slice * 1024 + 512 + F.tid] = f2bf(c1 * C1);
                if (nrole) NST[(bh * 16 + j) * 128 + F.tid] = c1 * nn;
                if (slice == 0 && F.tid == 0) { SEGS[(bh * 16 + j) * 4 + 2] = R; SEGS[(bh * 16 + j) * 4 + 3] = c2; }
                C0 = c1 * C0 + c2 * dc0[j]; C1 = c1 * C1 + c2 * dc1[j]; nn = c1 * nn + c2 * dn[j]; m = Fend + R;
            }
        }
        if (BOTH(4)) GRID_BAR();
    }
    if (IN(5)) {
        { int tq_ = threadIdx.x; asm volatile("" : "+v"(tq_)); F.tid = tq_; F.lane = tq_ & 63; }
        pg::S5Sched S{(const char*)S5A, (const char*)S5BT, S5K * 2, S5K * 2, S5KIN, 2, F.G, F.vcu};
        pg::EpiS5Y E{S5A, args.in[10], GY};
        pg::gemm_phase<pg::EpiS5Y, pg::S5Sched, true>(F.lds, S5K, S, E);
        if (BOTH(5)) GRID_BAR();
    }
    if (IN(6)) {
        { int tq_ = threadIdx.x; asm volatile("" : "+v"(tq_)); F.tid = tq_; F.lane = tq_ & 63; }
        typedef short s16x4 __attribute__((ext_vector_type(4)));
        LAS bf16* Kl = (LAS bf16*)F.lds;
        LAS bf16* Vl = Kl + 2 * 64 * 136;
        LAS bf16* Cl = Vl + 2 * 128 * 72;
        LAS float* nl = (LAS float*)(Cl + 128 * 136);
        LAS float* fll = nl + 128;
        LAS float* gl = fll + 512;
        const float* ng = args.in[16];
        for (int un = blockIdx.x; un < 256; un += F.G) {
            int tid6 = F.tid; asm volatile("" : "+v"(tid6));
            const int lane6 = tid6 & 63;
            const int bh = un >> 4, seg = un & 15, b = bh >> 2, hd = bh & 3, t0 = seg * 512;
            const float R = SEGS[un * 4 + 2], c2 = SEGS[un * 4 + 3];
            __syncthreads();
            for (int ch = tid6; ch < 2048; ch += NTHR) { const int r = ch >> 4, c16 = ch & 15; *(LAS u32x4*)(Cl + r * 136 + c16 * 8) = *(const u32x4*)(CST + (size_t)un * 16384 + r * 128 + c16 * 8); }
            if (tid6 < 128) { nl[tid6] = NST[un * 128 + tid6]; gl[tid6] = ng[hd * 128 + tid6]; }
            fll[tid6] = FLOC[(size_t)bh * SEQ + t0 + tid6];
            const int r = lane6 & 31, hh = lane6 >> 5;
            for (int pass = 0; pass < 2; ++pass) {
                const int qb = pass == 0 ? F.wave : 15 - F.wave, jmax = qb >> 1, npj = pass == 0 ? 4 : 8;
                bf16x8 Q[8];
                { const bf16* qp = QH + ((size_t)bh * SEQ + t0 + qb * 32 + r) * 128 + hh * 8;
#pragma unroll
                  for (int ks = 0; ks < 8; ++ks) Q[ks] = *(const bf16x8*)(qp + ks * 16); }
                u32x4 pk0, pk1, pv0, pv1;
                { const int kr = tid6 >> 4, kc = tid6 & 15; const bf16* kp = KH + ((size_t)bh * SEQ + t0) * 128; pk0 = *(const u32x4*)(kp + kr * 128 + kc * 8); pk1 = *(const u32x4*)(kp + (kr + 32) * 128 + kc * 8);
                  const int vr = tid6 >> 3, vc = tid6 & 7; const bf16* vp = VT + (size_t)bh * 128 * SEQ + t0; pv0 = *(const u32x4*)(vp + (size_t)vr * SEQ + vc * 8); pv1 = *(const u32x4*)(vp + (size_t)(vr + 64) * SEQ + vc * 8); }
                f32x16 acc[4];
#pragma unroll
                for (int eb = 0; eb < 4; ++eb)
#pragma unroll
                    for (int q = 0; q < 16; ++q) acc[eb][q] = 0.f;
                __syncthreads();
#pragma unroll
                for (int eb = 0; eb < 4; ++eb) {
#pragma unroll
                    for (int ks = 0; ks < 8; ++ks) { const bf16x8 a = *(const LAS bf16x8*)(Cl + (eb * 32 + r) * 136 + ks * 16 + hh * 8); acc[eb] = __builtin_amdgcn_mfma_f32_32x32x16_bf16(a, Q[ks], acc[eb], 0, 0, 0); }
                    __builtin_amdgcn_sched_barrier(0);
                }
                float den = 0.f;
#pragma unroll
                for (int ks = 0; ks < 8; ++ks) {
#pragma unroll
                    for (int jj = 0; jj < 8; ++jj) den += nl[ks * 16 + hh * 8 + jj] * bf2f((bf16)Q[ks][jj]);
                    __builtin_amdgcn_sched_barrier(0);
                }
                float dsum = 0.f;
                for (int j = 0; j < npj; ++j) {
                    LAS bf16* Kb = Kl + (j & 1) * 64 * 136; LAS bf16* Vb = Vl + (j & 1) * 128 * 72;
                    { const int kr = tid6 >> 4, kc = tid6 & 15; *(LAS u32x4*)(Kb + kr * 136 + kc * 8) = pk0; *(LAS u32x4*)(Kb + (kr + 32) * 136 + kc * 8) = pk1;
                      const int vr = tid6 >> 3, vc = tid6 & 7; *(LAS u32x4*)(Vb + vr * 72 + vc * 8) = pv0; *(LAS u32x4*)(Vb + (vr + 64) * 72 + vc * 8) = pv1; }
                    if (j + 1 < npj) { const int kr = tid6 >> 4, kc = tid6 & 15; const bf16* kp = KH + ((size_t)bh * SEQ + t0 + (j + 1) * 64) * 128; pk0 = *(const u32x4*)(kp + kr * 128 + kc * 8); pk1 = *(const u32x4*)(kp + (kr + 32) * 128 + kc * 8);
                        const int vr = tid6 >> 3, vc = tid6 & 7; const bf16* vp = VT + (size_t)bh * 128 * SEQ + t0 + (j + 1) * 64; pv0 = *(const u32x4*)(vp + (size_t)vr * SEQ + vc * 8); pv1 = *(const u32x4*)(vp + (size_t)(vr + 64) * SEQ + vc * 8); }
                    __syncthreads();
                    if (j <= jmax) {
                        const bool diag = (j == jmax); const int tq = qb * 32 + r;
#pragma unroll
                        for (int sb = 0; sb < 2; ++sb) {
                            f32x16 st;
#pragma unroll
                            for (int q = 0; q < 16; ++q) st[q] = 0.f;
#pragma unroll
                            for (int ks = 0; ks < 8; ++ks) { const bf16x8 a = *(const LAS bf16x8*)(Kb + (sb * 32 + r) * 136 + ks * 16 + hh * 8); st = __builtin_amdgcn_mfma_f32_32x32x16_bf16(a, Q[ks], st, 0, 0, 0); }
                            bf16x8 pb[2];
#pragma unroll
                            for (int sp = 0; sp < 2; ++sp) {
                                float pv[8];
#pragma unroll
                                for (int jj = 0; jj < 8; ++jj) { const int q = 8 * sp + jj; const int sidx = j * 64 + sb * 32 + (q & 3) + 8 * (q >> 2) + 4 * hh;
                                    float p = st[q] * c2; if (diag && sidx > tq) p = 0.f; pv[jj] = p; dsum += p; }
                                u32x4 w; w.x = cvt_pk_bf16(pv[0], pv[1]); w.y = cvt_pk_bf16(pv[2], pv[3]); w.z = cvt_pk_bf16(pv[4], pv[5]); w.w = cvt_pk_bf16(pv[6], pv[7]);
                                pb[sp] = __builtin_bit_cast(bf16x8, w);
                            }
#pragma unroll
                            for (int eb = 0; eb < 4; ++eb)
#pragma unroll
                                for (int sp = 0; sp < 2; ++sp) {
                                    const int so = sb * 32 + 16 * sp + 4 * hh;
                                    const s16x4 lo = *(const LAS s16x4*)(Vb + (eb * 32 + r) * 72 + so), hi = *(const LAS s16x4*)(Vb + (eb * 32 + r) * 72 + so + 8);
                                    const bf16x8 a = __builtin_shufflevector(lo, hi, 0, 1, 2, 3, 4, 5, 6, 7);
                                    acc[eb] = __builtin_amdgcn_mfma_f32_32x32x16_bf16(a, pb[sp], acc[eb], 0, 0, 0);
                                }
                            __builtin_amdgcn_sched_barrier(0);
                        }
                    }
                }
                den += dsum; den += __shfl_xor(den, 32);
                const float flo = __expf(-fll[qb * 32 + r] - R);
                const float inv = 1.f / fmaxf(fabsf(den), flo);
                float s1 = 0.f;
#pragma unroll
                for (int eb = 0; eb < 4; ++eb)
#pragma unroll
                    for (int q = 0; q < 16; ++q) { acc[eb][q] *= inv; s1 += acc[eb][q]; }
                s1 += __shfl_xor(s1, 32);
                const float mu = s1 * (1.f / 128.f);
                float s2 = 0.f;
#pragma unroll
                for (int eb = 0; eb < 4; ++eb)
#pragma unroll
                    for (int q = 0; q < 16; ++q) { const float dlt = acc[eb][q] - mu; s2 += dlt * dlt; }
                s2 += __shfl_xor(s2, 32);
                const float rstd = rsqrtf(s2 * (1.f / 128.f) + 1e-6f);
                const size_t row = (size_t)b * SEQ + t0 + qb * 32 + r;
                uint2 ovv[16];
#pragma unroll
                for (int eb = 0; eb < 4; ++eb)
#pragma unroll
                    for (int g4 = 0; g4 < 4; ++g4) ovv[eb * 4 + g4] = *(const uint2*)(PROJ + ((size_t)(48 + bh) * SEQ + t0 + qb * 32 + r) * 128 + eb * 32 + 8 * g4 + 4 * hh);
#pragma unroll
                for (int eb = 0; eb < 4; ++eb)
#pragma unroll
                    for (int g4 = 0; g4 < 4; ++g4) {
                        const int e0 = eb * 32 + 8 * g4 + 4 * hh;
                        const uint2 ov = ovv[eb * 4 + g4];
                        const f32x4 gg = *(const LAS f32x4*)(gl + e0);
                        const float o0 = (acc[eb][4 * g4 + 0] - mu) * rstd * gg.x * sigmoidf_(lo_bf(ov.x)), o1 = (acc[eb][4 * g4 + 1] - mu) * rstd * gg.y * sigmoidf_(hi_bf(ov.x));
                        const float o2 = (acc[eb][4 * g4 + 2] - mu) * rstd * gg.z * sigmoidf_(lo_bf(ov.y)), o3 = (acc[eb][4 * g4 + 3] - mu) * rstd * gg.w * sigmoidf_(hi_bf(ov.y));
                        uint2 w; w.x = cvt_pk_bf16(o0, o1); w.y = cvt_pk_bf16(o2, o3);
                        *(uint2*)(MIX + row * D + 512 + hd * 128 + e0) = w;
                    }
            }
        }
    }
    if (IN(7)) {
        { int tq_ = threadIdx.x; asm volatile("" : "+v"(tq_)); F.tid = tq_; F.lane = tq_ & 63; }
        pg::DenseSched S{(const char*)GY, (const char*)WGLU, 512 * 2, 512 * 2, T / 256, 2, F.G, (int)blockIdx.x};
        pg::EpiGlu E{GY, args.in[12], MIX};
        pg::gemm_phase<pg::EpiGlu, pg::DenseSched, true>(F.lds, 512, S, E);
        if (BOTH(7)) GRID_BAR();
    }
    if (IN(8)) {
        { int tq_ = threadIdx.x; asm volatile("" : "+v"(tq_)); F.tid = tq_; F.lane = tq_ & 63; }
        pg::DenseSched S{(const char*)MIX, (const char*)WOUT, D * 2, D * 2, T / 256, D / 256, F.G, (int)blockIdx.x};
        pg::EpiOut E{x, H};
        pg::gemm_phase<pg::EpiOut, pg::DenseSched, true>(F.lds, D, S, E);
        if (BOTH(8)) GRID_BAR();
    }
    if (IN(9)) {
        { int tq_ = threadIdx.x; asm volatile("" : "+v"(tq_)); F.tid = tq_; F.lane = tq_ & 63; }
        const float* gf = args.in[18]; const float* w_r = args.in[19]; const float* b_r = args.in[20];
        LAS float* rs = (LAS float*)(F.lds);
        LAS float* part = (LAS float*)(F.lds + 1024);
        LAS int* hist = (LAS int*)(F.lds + 1024 + 2 * 128 * 33 * 4);
        for (int tb = blockIdx.x; tb < T / 128; tb += F.G) {
            const int row0 = tb * 128;
            if (F.tid < 32) hist[F.tid] = 0;
            {
                f32x4 gg[4];
#pragma unroll
                for (int jq = 0; jq < 4; ++jq) gg[jq] = *(const f32x4*)(gf + 4 * F.lane + 256 * jq);
                f32x4 nx[4];
#pragma unroll
                for (int jq = 0; jq < 4; ++jq) nx[jq] = ldbf4(H + (size_t)(row0 + F.wave * 16) * D + 4 * F.lane + 256 * jq);
                for (int rr = 0; rr < 16; ++rr) {
                    const int r = F.wave * 16 + rr;
                    f32x4 v[4];
#pragma unroll
                    for (int jq = 0; jq < 4; ++jq) v[jq] = nx[jq];
                    if (rr < 15) {
#pragma unroll
                        for (int jq = 0; jq < 4; ++jq) nx[jq] = ldbf4(H + (size_t)(row0 + r + 1) * D + 4 * F.lane + 256 * jq); }
                    float ss = 0.f;
#pragma unroll
                    for (int jq = 0; jq < 4; ++jq) ss += v[jq].x * v[jq].x + v[jq].y * v[jq].y + v[jq].z * v[jq].z + v[jq].w * v[jq].w;
                    ss = wave_sum(ss);
                    const float rstd = rsqrtf(ss * (1.f / D) + 1e-5f);
                    if (F.lane == 0) rs[r] = rstd;
#pragma unroll
                    for (int jq = 0; jq < 4; ++jq) *(unsigned*)(HN8 + (size_t)(row0 + r) * D + 4 * F.lane + 256 * jq) = pk4_fp8(v[jq].x * rstd * gg[jq].x, v[jq].y * rstd * gg[jq].y, v[jq].z * rstd * gg[jq].z, v[jq].w * rstd * gg[jq].w);
                }
            }
            {
                const int rg = F.wave & 3, kh = F.wave >> 2, i = F.lane & 31, hh = F.lane >> 5;
                f32x16 acc;
#pragma unroll
                for (int q = 0; q < 16; ++q) acc[q] = 0.f;
                const bf16* hp = H + (size_t)(row0 + rg * 32 + i) * D + kh * 512 + 8 * hh;
                const bf16* bp = WR2 + ((size_t)(kh * 32) * 64 + F.lane) * 8;
                bf16x8 a0[4], bh0[4], bl0[4], a1[4], bh1[4], bl1[4];
#pragma unroll
                for (int u = 0; u < 4; ++u) { a0[u] = *(const bf16x8*)(hp + 16 * u); bh0[u] = *(const bf16x8*)(bp + (size_t)u * 512); bl0[u] = *(const bf16x8*)(bp + (size_t)(4096 * 8) + (size_t)u * 512); }
                for (int s0 = 0; s0 < 32; s0 += 8) {
#pragma unroll
                    for (int u = 0; u < 4; ++u) { const int ss = s0 + 4 + u; a1[u] = *(const bf16x8*)(hp + 16 * ss); bh1[u] = *(const bf16x8*)(bp + (size_t)ss * 512); bl1[u] = *(const bf16x8*)(bp + (size_t)(4096 * 8) + (size_t)ss * 512); }
#pragma unroll
                    for (int u = 0; u < 4; ++u) { acc = __builtin_amdgcn_mfma_f32_32x32x16_bf16(a0[u], bh0[u], acc, 0, 0, 0); acc = __builtin_amdgcn_mfma_f32_32x32x16_bf16(a0[u], bl0[u], acc, 0, 0, 0); }
                    if (s0 + 8 < 32) {
#pragma unroll
                        for (int u = 0; u < 4; ++u) { const int ss = s0 + 8 + u; a0[u] = *(const bf16x8*)(hp + 16 * ss); bh0[u] = *(const bf16x8*)(bp + (size_t)ss * 512); bl0[u] = *(const bf16x8*)(bp + (size_t)(4096 * 8) + (size_t)ss * 512); } }
#pragma unroll
                    for (int u = 0; u < 4; ++u) { acc = __builtin_amdgcn_mfma_f32_32x32x16_bf16(a1[u], bh1[u], acc, 0, 0, 0); acc = __builtin_amdgcn_mfma_f32_32x32x16_bf16(a1[u], bl1[u], acc, 0, 0, 0); }
                }
#pragma unroll
                for (int q = 0; q < 16; ++q) { const int r = rg * 32 + (q & 3) + 8 * (q >> 2) + 4 * hh; part[(kh * 128 + r) * 33 + i] = acc[q]; }
            }
            __syncthreads();
            if (F.tid < 128) {
                const int r = F.tid; const float rstd = rs[r];
                float best[4]; int bi[4];
                for (int e = 0; e < 32; ++e) part[r * 33 + e] = (part[r * 33 + e] + part[(128 + r) * 33 + e]) * rstd + b_r[e];
#pragma unroll
                for (int k = 0; k < 4; ++k) {
                    float bv = -INFINITY; int be = 0;
                    for (int e = 0; e < 32; ++e) { const float l = part[r * 33 + e]; if (l > bv) { bv = l; be = e; } }
                    best[k] = bv; bi[k] = be; part[r * 33 + be] = -INFINITY;
                }
                const float e1 = __expf(best[1] - best[0]), e2 = __expf(best[2] - best[0]), e3 = __expf(best[3] - best[0]);
                const float inv = 1.f / (1.f + e1 + e2 + e3);
                *(int4*)(topi + (size_t)(row0 + r) * 4) = make_int4(bi[0], bi[1], bi[2], bi[3]);
                *(f32x4*)(topg + (size_t)(row0 + r) * 4) = (f32x4){inv, e1 * inv, e2 * inv, e3 * inv};
#pragma unroll
                for (int k = 0; k < 4; ++k) __hip_atomic_fetch_add(&hist[bi[k]], 1, __ATOMIC_RELAXED, __HIP_MEMORY_SCOPE_WORKGROUP);
            }
            __syncthreads();
            if (F.tid < 32) CNT[tb * 32 + F.tid] = hist[F.tid];
            __syncthreads();
        }
        if (BOTH(9)) GRID_BAR();
    }
    if (IN(10)) {
        { int tq_ = threadIdx.x; asm volatile("" : "+v"(tq_)); F.tid = tq_; F.lane = tq_ & 63; }
        LAS int* sb = (LAS int*)(F.lds);
        for (int tb = blockIdx.x; tb < T / 128; tb += F.G) {
            const int e = F.tid & 31, pt = F.tid >> 5;
            int sbef = 0, stot = 0;
            for (int w = pt * 16; w < pt * 16 + 16; ++w) { const int c = __hip_atomic_load(CNT + w * 32 + e, RLX_AGENT); stot += c; if (w < tb) sbef += c; }
            sb[pt * 32 + e] = sbef; sb[512 + pt * 32 + e] = stot;
            __syncthreads();
            if (F.tid < 32) { int b = 0, t = 0; for (int p = 0; p < 16; ++p) { b += sb[p * 32 + F.tid]; t += sb[512 + p * 32 + F.tid]; } sb[1024 + F.tid] = b; sb[1056 + F.tid] = t; sb[1120 + F.tid] = 0; }
            __syncthreads();
            if (F.tid == 0) { int ps = 0; for (int q = 0; q < 32; ++q) { sb[1088 + q] = ps; ps += ((sb[1056 + q] + MT - 1) / MT) * MT; } }
            __syncthreads();
            if (tb == 0 && F.tid < 32) ecnt[F.tid] = sb[1056 + F.tid];
            {
                const int a = tb * 512 + F.tid; const int ex = topi[a];
                const int lp = __hip_atomic_fetch_add(&sb[1120 + ex], 1, __ATOMIC_RELAXED, __HIP_MEMORY_SCOPE_WORKGROUP);
                const int slot = sb[1088 + ex] + sb[1024 + ex] + lp;
                slot_tok[slot] = a >> 2; tok_slot[a] = slot;
            }
            __syncthreads();
        }
        if (BOTH(10)) GRID_BAR();
    }
    if (IN(11) || IN(12)) {
        { int tq_ = threadIdx.x; asm volatile("" : "+v"(tq_)); F.tid = tq_; F.lane = tq_ & 63; }
        LAS int* til = (LAS int*)(F.lds + TIL_OFF);
        if (F.tid < 64) {
            const int e = F.lane; int cnt = 0; if (e < NE) cnt = (int)__hip_atomic_load(ecnt + e, RLX_AGENT);
            const int ntl = (cnt + MT - 1) / MT; int pre = ntl;
#pragma unroll
            for (int o = 1; o < 64; o <<= 1) { const int tv = __shfl_up(pre, o); if (F.lane >= o) pre += tv; }
            const int first = pre - ntl;
            if (e < NE) for (int k = 0; k < ntl; ++k) { til[first + k] = e; til[MAXTILES + first + k] = (cnt - k * MT) < MT ? (cnt - k * MT) : MT; }
            if (F.lane == 63) til[2 * MAXTILES] = pre;
        }
        __syncthreads();
        if (IN(11)) {
            MoeSched S{(const char*)HN8, (const char*)WUP8, slot_tok, args.in[22], til, (LAS int*)(F.lds + IDX_OFF), (LAS float*)(F.lds + BIAS_OFF), D, D, 8, 2 * FF, F.G, (int)blockIdx.x, 1};
            pg::EpiUp E{(const LAS float*)(F.lds + BIAS_OFF), ACT8};
            S.build_list((LAS int*)(F.lds + ULIST_OFF)); __syncthreads();
            pg::gemm_phase<pg::EpiUp, MoeSched, true, true>(F.lds, D, S, E);
            {
                constexpr int I_DN = (FF / 64) * (D / 64);
                LAS bf16* scr = (LAS bf16*)(F.lds + F.wave * 16384);
                LAS int* qb = (LAS int*)(F.lds + MISC_OFF + 64);
                for (;;) {
                    __syncthreads();
                    if (F.tid == 0) *qb = (int)__hip_atomic_fetch_add((unsigned*)(F.ctl + CW_QHEAD), 64u, __ATOMIC_RELAXED, __HIP_MEMORY_SCOPE_AGENT);
                    __syncthreads();
                    const int base = __builtin_amdgcn_readfirstlane(*qb);
                    if (base >= NE * I_DN) break;
                    for (int k = 0; k < 8; ++k) { const int it = base + F.wave * 8 + k; if (it >= NE * I_DN) break;
                        const int e = it / I_DN; transpose_item<true>(args.in[23] + (size_t)e * FF * D, D, FF, D / 64, WDN8 + (size_t)e * D * FF, scr, it % I_DN, F.lane, RowId()); }
                }
            }
            if (BOTH(11)) GRID_BAR();
        }
        if (IN(12)) {
            MoeSched S{(const char*)ACT8, (const char*)WDN8, slot_tok, args.in[24], til, (LAS int*)(F.lds + IDX_OFF), (LAS float*)(F.lds + BIAS_OFF), FF, FF, 4, D, F.G, (int)blockIdx.x, 0};
            pg::EpiDown E{(const LAS float*)(F.lds + BIAS_OFF), YS};
            S.build_list((LAS int*)(F.lds + ULIST_OFF)); __syncthreads();
            pg::gemm_phase<pg::EpiDown, MoeSched, true, true>(F.lds, FF, S, E);
            if (BOTH(12)) GRID_BAR();
        }
    }
    if (IN(13)) {
        { int tq_ = threadIdx.x; asm volatile("" : "+v"(tq_)); F.tid = tq_; F.lane = tq_ & 63; }
        const float* gfin = args.in[25]; float* out = args.out;
        for (int row = gw; row < T; row += NGW) {
            f32x4 v[4];
#pragma unroll
            for (int j = 0; j < 4; ++j) v[j] = ldbf4(H + (size_t)row * D + 4 * F.lane + 256 * j);
            const int4 sl = *(const int4*)(tok_slot + (size_t)row * 4); const f32x4 gt = *(const f32x4*)(topg + (size_t)row * 4);
#pragma unroll
            for (int k = 0; k < 4; ++k) {
                const int s = k == 0 ? sl.x : k == 1 ? sl.y : k == 2 ? sl.z : sl.w;
#pragma unroll
                for (int j = 0; j < 4; ++j) { const unsigned y = *(const unsigned*)(YS + (size_t)s * D + 4 * F.lane + 256 * j);
                    typedef float f32x2_ __attribute__((ext_vector_type(2)));
                    const f32x2_ ylo = __builtin_amdgcn_cvt_pk_f32_fp8(y, false), yhi = __builtin_amdgcn_cvt_pk_f32_fp8(y, true);
                    v[j].x += gt[k] * ylo.x; v[j].y += gt[k] * ylo.y; v[j].z += gt[k] * yhi.x; v[j].w += gt[k] * yhi.y; }
            }
            float ss = 0.f;
#pragma unroll
            for (int j = 0; j < 4; ++j) ss += v[j].x * v[j].x + v[j].y * v[j].y + v[j].z * v[j].z + v[j].w * v[j].w;
            ss = wave_sum(ss);
            const float rstd = rsqrtf(ss * (1.f / D) + 1e-5f);
#pragma unroll
            for (int j = 0; j < 4; ++j) { const f32x4 gg = *(const f32x4*)(gfin + 4 * F.lane + 256 * j); __builtin_nontemporal_store(v[j] * rstd * gg, (f32x4*)(out + (size_t)row * D + 4 * F.lane + 256 * j)); }
        }
    }
#undef IN
#undef BOTH
}

extern "C" void kernel_launch(void* const* d_in, const int* in_sizes, int n_in, void* d_out, int out_size, void* d_ws, size_t ws_size, hipStream_t stream) {
    static int grid = 0;
    if (grid == 0) {
        int dev = 0, cus = 0, per_cu = 0;
        if (n_in != 26 || ws_size < WS_END) { fprintf(stderr, "kernel_launch: unexpected n_in %d / ws %zu\n", n_in, ws_size); grid = -1; return; }
        if (hipGetDevice(&dev) != hipSuccess || hipDeviceGetAttribute(&cus, hipDeviceAttributeMultiprocessorCount, dev) != hipSuccess) { grid = -1; return; }
        if (hipFuncSetAttribute((const void*)fwd, hipFuncAttributeMaxDynamicSharedMemorySize, LDS_BYTES) != hipSuccess) { fprintf(stderr, "kernel_launch: hipFuncSetAttribute failed\n"); grid = -1; return; }
        if (hipOccupancyMaxActiveBlocksPerMultiprocessor(&per_cu, (const void*)fwd, NTHR, LDS_BYTES) != hipSuccess || per_cu < 1) fprintf(stderr, "kernel_launch: occupancy query reports %d\n", per_cu);
        (void)hipGetLastError();
        grid = cus;
    }
    if (grid < 0) return;
    (void)in_sizes; (void)out_size;
    unsigned char* ws = (unsigned char*)d_ws;
    (void)hipMemsetAsync(ws + WS_CTL, 0, CTL_ZERO_BYTES, stream);
    Args a{};
    for (int i = 0; i < 26; ++i) a.in[i] = (const float*)d_in[i];
    a.out = (float*)d_out; a.ws = ws;
    a.ph_lo = 0; a.ph_hi = 14; a.li = 0; a.pad = 0;
    hipLaunchKernelGGL(fwd, dim3(grid), dim3(NTHR), LDS_BYTES, stream, a);
#if PROBE_LO >= 0
    a.ph_lo = PROBE_LO; a.ph_hi = PROBE_HI; a.li = 1; a.pad = PROBE_PAD;
    hipLaunchKernelGGL(fwd, dim3(grid), dim3(NTHR), LDS_BYTES, stream, a);
#endif
}
```

```cpp
#include <hip/hip_runtime.h>
#include <cstdio>
#include <cstdint>

#define GAS __attribute__((address_space(1)))
#define LAS __attribute__((address_space(3)))
typedef unsigned short bf16;
typedef short bf16x8 __attribute__((ext_vector_type(8)));
typedef float f32x4 __attribute__((ext_vector_type(4)));
typedef float f32x16 __attribute__((ext_vector_type(16)));
typedef unsigned u32x4 __attribute__((ext_vector_type(4)));
typedef unsigned u32x2 __attribute__((ext_vector_type(2)));
typedef GAS unsigned gu32;

#define PROBE_LO -1
#define PROBE_HI -1
#define PROBE_PAD 0
constexpr int NB = 4, SEQ = 8192, T = NB * SEQ, D = 1024;
constexpr int DIN = 2568, NPROJ = 2560;
constexpr int O_Q = 512, O_K = 1024, O_V = 1536, O_O = 2048, O_G = 2560;
constexpr int NE = 32, TOPK = 4, FF = 1024;
constexpr int NASSIGN = T * TOPK;
constexpr int MT = 256;
constexpr int NSLOTS = NASSIGN + NE * MT;
constexpr int MAXTILES = NSLOTS / MT;
constexpr int NWAVES = 8, NTHR = 512;
constexpr float W8_SCALE = 64.f, W8_INV = 1.f / 64.f;

constexpr size_t MiB = 1u << 20;
constexpr size_t WS_CTL = 0, CTL_ZERO_BYTES = 1 * MiB;
constexpr size_t WS_GATES = 1 * MiB;
constexpr size_t WS_TOPI = 2 * MiB;
constexpr size_t WS_TOPG = 3 * MiB;
constexpr size_t WS_SLOTTOK = 4 * MiB;
constexpr size_t WS_TOKSLOT = 5 * MiB;
constexpr size_t WS_CNT = 6 * MiB;
constexpr size_t WS_WIN = 8 * MiB;
constexpr size_t WS_WGLU = 13 * MiB;
constexpr size_t WS_WOUT = 14 * MiB;
constexpr size_t WS_WUP = 16 * MiB;
constexpr size_t WS_WDN = 144 * MiB;
constexpr size_t WS_HN = 208 * MiB;
constexpr size_t WS_PROJ = 272 * MiB;
constexpr size_t WS_GY = 432 * MiB;
constexpr size_t WS_MIX = 464 * MiB;
constexpr size_t WS_HRAW = 528 * MiB;
constexpr size_t WS_ETOK = 544 * MiB;
constexpr size_t WS_ACT = 272 * MiB;
constexpr size_t WS_H = 592 * MiB;
constexpr size_t WS_YS = 720 * MiB;
constexpr size_t WS_END = 992 * MiB;
constexpr int S5L = 32, S5KIN = S5L * 16, S5K = S5KIN + 128;
constexpr int S5NCH = SEQ / S5L, S5ROWS = NB * S5NCH;
constexpr size_t WS_S5A = 720 * MiB;
constexpr size_t WS_S5BT = 760 * MiB;
constexpr size_t WS_S5BQ = 836 * MiB;
constexpr size_t WS_XLOC = 790 * MiB;
constexpr size_t WS_QH = 866 * MiB;
constexpr size_t WS_KH = 898 * MiB;
constexpr size_t WS_VT = 930 * MiB;
constexpr size_t WS_DC = 962 * MiB;
constexpr size_t WS_CST = 978 * MiB;
constexpr size_t WS_FLOC = 986 * MiB;
constexpr size_t WS_DN = 987 * MiB;
constexpr size_t WS_NST = 988 * MiB;
constexpr size_t WS_SEGS = 989 * MiB;
constexpr size_t WS_WR2 = 991 * MiB;
constexpr size_t WS_KTAB = 990 * MiB;
static_assert(WS_S5A + (size_t)32 * S5ROWS * S5K * 2 <= WS_S5BT && WS_S5BT + (size_t)32 * S5KIN * S5K * 2 <= WS_XLOC && WS_XLOC + (size_t)32 * S5ROWS * 128 * 4 <= WS_S5BQ && WS_S5BQ + (size_t)32 * 256 * S5KIN * 2 <= WS_QH, "s5 map");
static_assert(WS_ACT + (size_t)NSLOTS * FF * 2 <= WS_H && WS_YS + (size_t)NSLOTS * D * 2 <= WS_END, "ws map");
constexpr int CW_EARLY = 64;
constexpr int CW_ECNT = 2048;
constexpr int CW_BAR = 4096;

constexpr int RING_BYTES = 131072;
constexpr int MISC_OFF = RING_BYTES;
constexpr int IDX_OFF = MISC_OFF + 128;
constexpr int TIL_OFF = IDX_OFF + 2048;
constexpr int BIAS_OFF = TIL_OFF + 3 * MAXTILES * 4 + 256;
constexpr int ULIST_OFF = BIAS_OFF + 3 * 1024;
constexpr int XT_OFF = IDX_OFF;
constexpr int LDS_BYTES = 148480;
static_assert(ULIST_OFF + 32 * 16 <= LDS_BYTES && (BIAS_OFF & 15) == 0 && XT_OFF + 8 * 2048 <= LDS_BYTES, "LDS map");

#define RLX_AGENT __ATOMIC_RELAXED, __HIP_MEMORY_SCOPE_AGENT
__device__ __forceinline__ float bf2f(bf16 v) { return __uint_as_float(((unsigned)v) << 16); }
__device__ __forceinline__ bf16 f2bf(float f) { unsigned u = __float_as_uint(f); u += 0x7fffu + ((u >> 16) & 1u); return (bf16)(u >> 16); }
__device__ __forceinline__ unsigned pk2(float lo, float hi) { return (unsigned)f2bf(lo) | ((unsigned)f2bf(hi) << 16); }
__device__ __forceinline__ unsigned cvt_pk_bf16(float lo, float hi) { unsigned r; asm volatile("v_cvt_pk_bf16_f32 %0, %1, %2" : "=v"(r) : "v"(lo), "v"(hi)); return r; }
__device__ __forceinline__ unsigned pk4_fp8(float a, float b, float c, float d) { unsigned w = 0u; w = __builtin_amdgcn_cvt_pk_fp8_f32(a, b, w, false); w = __builtin_amdgcn_cvt_pk_fp8_f32(c, d, w, true); return w; }
__device__ __forceinline__ float lo_bf(unsigned u) { return __uint_as_float(u << 16); }
__device__ __forceinline__ float hi_bf(unsigned u) { return __uint_as_float(u & 0xffff0000u); }
__device__ __forceinline__ f32x4 ldbf4(const bf16* p) { const uint2 u = *(const uint2*)p; return (f32x4){lo_bf(u.x), hi_bf(u.x), lo_bf(u.y), hi_bf(u.y)}; }
__device__ __forceinline__ int lane_id() { int l; asm volatile("v_mbcnt_lo_u32_b32 %0, -1, 0\n\tv_mbcnt_hi_u32_b32 %0, -1, %0" : "=v"(l)); return l; }
__device__ __forceinline__ float wave_sum(float v) {
#pragma unroll
    for (int o = 1; o < 64; o <<= 1) v += __shfl_xor(v, o);
    return v;
}
__device__ __forceinline__ float sigmoidf_(float x) { return __builtin_amdgcn_rcpf(1.f + __builtin_amdgcn_exp2f(-1.4426950408889634f * x)); }
__device__ __forceinline__ void fcis(float x, float* sn, float* cs) { const float C = 0.15915494309189535f; const float rev = x * C; const float err = fmaf(x, C, -rev); const float fr = (rev - rintf(rev)) + err; *sn = __builtin_amdgcn_sinf(fr); *cs = __builtin_amdgcn_cosf(fr); }
__device__ __forceinline__ float gelu_tanh(float x) { const float u = 1.5957691216057308f * (x + 0.044715f * x * x * x); return x * __builtin_amdgcn_rcpf(1.f + __builtin_amdgcn_exp2f(-1.4426950408889634f * u)); }

#define XB_TMO      128
#define XB_XCNT(j)  (256  + 64 * (j))
#define XB_XSUB(j)  (1280 + 64 * (j))
#define XB_XGEN(j)  (2304 + 64 * (j))
#define XB_TOP      3328
#define XB_TOPGEN   3392
#define XCD_BAR_WORDS 3456
#define XB_SPIN_CAP (1u << 18)
__device__ __forceinline__ unsigned xb_ld(unsigned* p)              { return __hip_atomic_load(p, __ATOMIC_RELAXED, __HIP_MEMORY_SCOPE_AGENT); }
__device__ __forceinline__ unsigned xb_add(unsigned* p, unsigned v) { return __hip_atomic_fetch_add(p, v, __ATOMIC_RELAXED, __HIP_MEMORY_SCOPE_AGENT); }
__device__ __forceinline__ unsigned xb_xcc_id() { return (unsigned)__builtin_amdgcn_s_getreg((3 << 11) | 20) & 0xFu; }
#define XB_SPIN(cond, bar) do { unsigned _sp = 0; while (cond) { __builtin_amdgcn_s_sleep(1); \
    if ((++_sp & 255u) == 0u) { if (xb_ld(&(bar)[XB_TMO])) break; if (_sp > XB_SPIN_CAP) { atomicAdd(&(bar)[XB_TMO], 1u); break; } } } } while (0)
struct XcdBarrier { unsigned* bar; unsigned x; volatile LAS unsigned* st; int wave; };
__device__ __forceinline__ XcdBarrier xcd_barrier_post(unsigned* bar, volatile LAS unsigned* st, int wave) {
    XcdBarrier b; b.bar = bar; b.x = xb_xcc_id(); b.st = st; b.wave = wave;
    if (wave == 0 && lane_id() == 0) (void)xb_add(&bar[XB_XCNT(b.x)], 1u);
    return b;
}
__device__ __forceinline__ void xcd_barrier_complete(unsigned* bar, unsigned x, unsigned& nloc, unsigned& nx) {
    const unsigned G = gridDim.x * gridDim.y * gridDim.z;
    unsigned sum, cnt, mine, sp = 0u;
    for (;;) {
        sum = 0u; cnt = 0u; mine = 0u;
#pragma unroll
        for (unsigned j = 0; j < 16; ++j) { const unsigned c = xb_ld(&bar[XB_XCNT(j)]); sum += c; cnt += (c > 0u) ? 1u : 0u; mine = (j == x) ? c : mine; }
        if (sum == G) break;
        __builtin_amdgcn_s_sleep(1);
        if ((++sp & 255u) == 0u) { if (xb_ld(&bar[XB_TMO])) break; if (sp > XB_SPIN_CAP) { atomicAdd(&bar[XB_TMO], 1u); break; } }
    }
    nloc = mine > 0u ? mine : 1u; nx = cnt > 0u ? cnt : 1u;
}
__device__ __forceinline__ void xcd_barrier(const XcdBarrier& b) {
    asm volatile("s_waitcnt vmcnt(0)" ::: "memory");
    __syncthreads();
    if (b.wave == 0 && lane_id() == 0) {
        unsigned* bar = b.bar;
        __builtin_amdgcn_s_waitcnt(0);
        unsigned nloc = b.st[0], nx = b.st[1];
        if (nloc == 0u) { xcd_barrier_complete(bar, b.x, nloc, nx); b.st[0] = nloc; b.st[1] = nx; }
        const unsigned old = xb_add(&bar[XB_XSUB(b.x)], 1u);
        const unsigned gen = old / nloc;
        if (old + 1u == (gen + 1u) * nloc) {
            __builtin_amdgcn_fence(__ATOMIC_RELEASE, "agent");
            asm volatile("s_waitcnt vmcnt(0)" ::: "memory");
            const unsigned og = xb_add(&bar[XB_TOP], 1u);
            const unsigned tg = og / nx;
            if (og + 1u == (tg + 1u) * nx) xb_add(&bar[XB_TOPGEN], 1u);
            else XB_SPIN(xb_ld(&bar[XB_TOPGEN]) == tg, bar);
            __builtin_amdgcn_fence(__ATOMIC_ACQUIRE, "agent");
            xb_add(&bar[XB_XGEN(b.x)], 1u);
            asm volatile("s_waitcnt vmcnt(0)" ::: "memory");
        } else {
            XB_SPIN(xb_ld(&bar[XB_XGEN(b.x)]) == gen, bar);
            __builtin_amdgcn_fence(__ATOMIC_ACQUIRE, "agent");
            asm volatile("s_waitcnt vmcnt(0)" ::: "memory");
        }
    }
    __syncthreads();
}

namespace pg {
constexpr int BM = 256, BK = 64, HALF = 128, HTB = HALF * BK * 2, STAGE_BYTES = 8 * HTB, NXCD = 8, WGM = 4;
__host__ __device__ __forceinline__ int lds_byte(int r, int c) { const int st = (r >> 4) * 2 + (c >> 5), rr = r & 15, cc = c & 31, ob = rr * 64 + cc * 2; return st * 1024 + (ob ^ (((ob >> 9) & 1) << 5)); }
__host__ __device__ __forceinline__ void stage_rc(int b, int& R, int& C) { const int st = b / 1024, sb = b % 1024, swz = sb ^ (((sb >> 9) & 1) << 5); R = (st >> 1) * 16 + swz / 64; C = (st & 1) * 32 + (swz % 64) / 2; }
__host__ __device__ __forceinline__ int perm32(int rho) { const int n = rho >> 4, i = rho & 15; return 8 * (i >> 2) + 4 * n + (i & 3); }

struct Unit { unsigned A, B; int pm, pn, e, nrows; };
__device__ __forceinline__ __amdgpu_buffer_rsrc_t mkrsrc(const void* p) { return __builtin_amdgcn_make_buffer_rsrc((void*)p, 0, 0x7fffffff, 0x00020000); }

__device__ __forceinline__ bool tile_order(int i, int G, int c, int nM, int nN, int& pm, int& pn) {
    const int nwg = nM * nN; const long L = (long)i * G + c; if (L >= nwg) return false;
    int wgid = (int)L; { const int q = nwg / NXCD, r = nwg % NXCD, xcd = wgid % NXCD, off = wgid / NXCD; wgid = (xcd < r ? xcd * (q + 1) : r * (q + 1) + (xcd - r) * q) + off; }
    const int nig = WGM * nN, gid = wgid / nig, fm = gid * WGM, gsz = (nM - fm) < WGM ? (nM - fm) : WGM;
    pm = fm + ((wgid % nig) % gsz); pn = (wgid % nig) / gsz; return true;
}
struct DenseSched {
    const char* A; const char* Bt; int lda2  , K2  , nM, nN, G, c, i0  , i1;
    __device__ __forceinline__ bool next(int i, Unit& u) const { int pm, pn; if (i0 + i >= i1 || !tile_order(i0 + i, G, c, nM, nN, pm, pn)) return false;
        u.A = (unsigned)pm * 256u * (unsigned)lda2; u.B = (unsigned)pn * 256u * (unsigned)K2; u.pm = pm; u.pn = pn; u.e = 0; u.nrows = 256; return true; }
    __device__ __forceinline__ __amdgpu_buffer_rsrc_t rsrcA() const { return mkrsrc(A); }
    __device__ __forceinline__ __amdgpu_buffer_rsrc_t rsrcB() const { return mkrsrc(Bt); }
    __device__ __forceinline__ void prefetch(const Unit&, int, int, int) const {}
    __device__ __forceinline__ void after_epi(int) const {}
    __device__ __forceinline__ unsigned aoff(const Unit&, int row, int) const { return (unsigned)row * (unsigned)lda2; }
};

typedef int i32x8 __attribute__((ext_vector_type(8)));
template <class Epi, class Sched, bool ALIGN_EPI, bool FP8 = false>
__device__ __forceinline__ void gemm_phase(LAS unsigned char* lds, const int K, const Sched& S, const Epi& E, const int wid) {
    const int lane = lane_id(), tid = wid * 64 + lane, wr = FP8 ? wid >> 1 : wid >> 2, wc = FP8 ? wid & 1 : wid & 3, wg = wid >> 2  , fr = lane & 15, fq = lane >> 4;
    constexpr int NMF = FP8 ? 2 : 4, NNF = FP8 ? 4 : 2;
    const int nt = FP8 ? K / 128 : K / BK;
    unsigned voffA[2][2], voffB[2];
#pragma unroll
    for (int i = 0; i < 1; ++i) { int R, C; if constexpr (FP8) { const int p = tid + 512 * i; R = p >> 3; C = (((p >> 1) & 3) ^ ((R >> 1) & 3)) * 32 + (p & 1) * 16; } else { stage_rc(tid * 16 + i * 8192, R, C); C *= 2; }
        const int Rb = !Epi::PERM ? R : FP8 ? (((R >> 2) & 3) * 32 + (R >> 4) * 4 + (R & 3)) : Epi::ADJ ? ((R >> 5) * 64 + perm32(R & 31)) : ((R & ~31) + perm32(R & 31)); voffB[i] = (unsigned)(Rb * K * (FP8 ? 1 : 2) + C); }
    const unsigned kstep = (unsigned)(BK * 2);
    const unsigned hstep = FP8 && Epi::PERM ? 16u * (unsigned)K : !FP8 && Epi::ADJ ? 32u * (unsigned)K * 2u : (unsigned)HALF * K * (FP8 ? 1 : 2);
    const unsigned b64step = FP8 && Epi::PERM ? 128u * (unsigned)K : !FP8 && Epi::ADJ ? 128u * (unsigned)K * 2u : hstep / 2;
    const unsigned ldsw = (unsigned)wid * 1024u;
    const int aoff = FP8 ? (wr * 32 + fr) * 128 + ((fq ^ ((fr >> 1) & 3)) * 32) : lds_byte(wr * 64 + fr, fq * 8);
    const int boff = FP8 ? (wc * 64 + fr) * 128 + ((fq ^ ((fr >> 1) & 3)) * 32) : lds_byte(wc * 32 + fr, fq * 8);
#define PG_SA(b, h) (((b) * 2 + (h)) * HTB)
#define PG_SB(b, h) ((4 + (b) * 2 + (h)) * HTB)
#define PG_STAGE(bufoff, so, voff) do { _Pragma("unroll") for (int _i = 0; _i < 2; ++_i) \
        __builtin_amdgcn_raw_ptr_buffer_load_lds(rA, (LAS void*)(lds + (bufoff) + ldsw + _i * 8192), 16, (int)(voff)[_i], (int)(so), 0, 0); } while (0)
#define PG_STAGEB(bufoff, so) do { _Pragma("unroll") for (int _i = 0; _i < 2; ++_i) \
        __builtin_amdgcn_raw_ptr_buffer_load_lds(rB, (LAS void*)(lds + (bufoff) + ldsw + _i * 8192), 16, (int)voffB[0], (int)((so) + _i * b64step), 0, 0); } while (0)
#define PG_LD8(p, p2) __builtin_bit_cast(i32x8, __builtin_shufflevector(*(const LAS u32x4*)(p), *(const LAS u32x4*)(p2), 0, 1, 2, 3, 4, 5, 6, 7))
#define PG_LDA(dst, b, h) do { if constexpr (FP8) { _Pragma("unroll") for (int m = 0; m < NMF; ++m) dst##8[m] = PG_LD8(lds + PG_SA(b, h) + aoff + m * 2048, lds + PG_SA(b, h) + aoff + m * 2048 + 16); } \
        else { _Pragma("unroll") for (int m = 0; m < 4; ++m) _Pragma("unroll") for (int k = 0; k < 2; ++k) dst[m][k] = *(const LAS bf16x8*)(lds + PG_SA(b, h) + aoff + m * 2048 + k * 1024); } } while (0)
#define PG_LDB(dst, b, h) do { if constexpr (FP8) { _Pragma("unroll") for (int n = 0; n < NNF; ++n) dst##8[n] = PG_LD8(lds + PG_SB(b, h) + boff + n * 2048, lds + PG_SB(b, h) + boff + n * 2048 + 16); } \
        else { _Pragma("unroll") for (int n = 0; n < 2; ++n) _Pragma("unroll") for (int k = 0; k < 2; ++k) dst[n][k] = *(const LAS bf16x8*)(lds + PG_SB(b, h) + boff + n * 2048 + k * 1024); } } while (0)
#define PG_MMA(ai, bj, At, Bt) do { __builtin_amdgcn_s_setprio(1); if constexpr (FP8) { _Pragma("unroll") for (int m = 0; m < NMF; ++m) _Pragma("unroll") for (int n = 0; n < NNF; ++n) \
            acc[ai][bj][m][n] = __builtin_amdgcn_mfma_scale_f32_16x16x128_f8f6f4(Bt##8[n], At##8[m], acc[ai][bj][m][n], 0, 0, 0, 0, 0, 0); } \
        else { _Pragma("unroll") for (int m = 0; m < 4; ++m) _Pragma("unroll") for (int n = 0; n < 2; ++n) _Pragma("unroll") for (int k = 0; k < 2; ++k) \
            acc[ai][bj][m][n] = __builtin_amdgcn_mfma_f32_16x16x32_bf16(Bt[n][k], At[m][k], acc[ai][bj][m][n], 0, 0, 0); } __builtin_amdgcn_s_setprio(0); } while (0)
#define PG_WAIT_V(n) asm volatile("s_waitcnt vmcnt(" #n ")" ::: "memory")
#define PG_WAIT_L(n) asm volatile("s_waitcnt lgkmcnt(" #n ")" ::: "memory")
#define PG_BAR __builtin_amdgcn_s_barrier()
#define PG_SCHED __builtin_amdgcn_sched_barrier(0)
#define PG_SET_AOFF(u, ib) do { int _t = wid * 64 + lane_id(); asm volatile("" : "+v"(_t));     \
        _Pragma("unroll") for (int _i = 0; _i < 2; ++_i) { int _R, _C; if constexpr (FP8) { const int _p = _t + 512 * _i; _R = _p >> 3; _C = (((_p >> 1) & 3) ^ ((_R >> 1) & 3)) * 32 + (_p & 1) * 16; } else { stage_rc(_t * 16 + _i * 8192, _R, _C); _C *= 2; } \
        voffA[0][_i] = S.aoff(u, _R, ib) + (unsigned)_C; voffA[1][_i] = S.aoff(u, _R + HALF, ib) + (unsigned)_C; } } while (0)
    Unit cur, nxt; int ui = 0;
    if (!S.next(0, cur)) return;
    f32x4 acc[2][2][NMF][NNF];
#pragma unroll
    for (int a = 0; a < 2; ++a)
#pragma unroll
        for (int b = 0; b < 2; ++b)
#pragma unroll
            for (int m = 0; m < NMF; ++m)
#pragma unroll
                for (int n = 0; n < NNF; ++n) acc[a][b][m][n] = (f32x4){0.f, 0.f, 0.f, 0.f};
    bf16x8 At[FP8 ? 1 : 4][2], B0[FP8 ? 1 : 2][2], B1[FP8 ? 1 : 2][2]; i32x8 At8[1], B08[1], B18[1];
    bf16x8 A0[1][2], A1[1][2], Bq[1][2]; i32x8 A08[FP8 ? 2 : 1], A18[FP8 ? 2 : 1], Bq8[FP8 ? 4 : 1];
    const __amdgpu_buffer_rsrc_t rA = S.rsrcA(), rB = S.rsrcB();
    unsigned cA = cur.A, cB = cur.B;
    S.prefetch(cur, 0, 0, wid * 64 + lane_id());
    PG_WAIT_V(0); __syncthreads();
    PG_SET_AOFF(cur, 0);
    if constexpr (FP8) { PG_STAGE(PG_SA(0, 0), cA, voffA[0]); PG_STAGE(PG_SA(0, 1), cA, voffA[1]); PG_STAGEB(PG_SB(0, 0), cB); PG_STAGEB(PG_SB(0, 1), cB + hstep); }
    else { PG_STAGEB(PG_SB(0, 0), cB); PG_STAGEB(PG_SB(0, 1), cB + hstep); PG_STAGE(PG_SA(0, 0), cA, voffA[0]); PG_STAGE(PG_SA(0, 1), cA, voffA[1]); }
    if (wg == 1) PG_BAR;
    PG_WAIT_V(2); PG_BAR;
    if constexpr (FP8) { PG_STAGE(PG_SA(1, 0), cA + kstep, voffA[0]); PG_STAGEB(PG_SB(1, 0), cB + kstep); PG_STAGE(PG_SA(1, 1), cA + kstep, voffA[1]); }
    else { PG_STAGEB(PG_SB(1, 0), cB + kstep); PG_STAGE(PG_SA(1, 0), cA + kstep, voffA[0]); PG_STAGEB(PG_SB(1, 1), cB + hstep + kstep); }
    PG_WAIT_V(6); PG_BAR;
    for (;;) {
        const bool has_next = S.next(ui + 1, nxt);
        const unsigned nA = has_next ? nxt.A : cA, nB = has_next ? nxt.B : cB;
        if (has_next) S.prefetch(nxt, (ui + 1) & 1, (ui + 1) % 3, wid * 64 + lane_id());
#pragma unroll 1
        for (int t = 0; t < nt; t += 2) {
            const bool last = (t == nt - 2);
            const unsigned a1 = cA + (unsigned)(t + 1) * kstep;
            const unsigned a2 = last ? nA : cA + (unsigned)(t + 2) * kstep, b2 = last ? nB : cB + (unsigned)(t + 2) * kstep;
            const unsigned a3 = a2 + kstep, b3 = b2 + kstep;
            if constexpr (FP8) {
            const unsigned b1 = cB + (unsigned)(t + 1) * kstep;
            PG_LDA(A0, 0, 0); PG_LDA(A1, 0, 1); PG_SCHED; PG_LDB(Bq, 0, 0); PG_STAGEB(PG_SB(1, 1), b1 + hstep);
            PG_WAIT_V(8); PG_WAIT_L(0); PG_BAR; PG_MMA(0, 0, A0, Bq); PG_MMA(1, 0, A1, Bq); PG_BAR; PG_SCHED;
            if (last && has_next) PG_SET_AOFF(nxt, (ui + 1) & 1);
            PG_LDB(Bq, 0, 1); PG_STAGE(PG_SA(0, 0), a2, voffA[0]); PG_STAGE(PG_SA(0, 1), a2, voffA[1]); PG_STAGEB(PG_SB(0, 0), b2);
            PG_WAIT_V(8); PG_WAIT_L(0); PG_BAR; PG_MMA(0, 1, A0, Bq); PG_MMA(1, 1, A1, Bq); PG_BAR; PG_SCHED;
            PG_LDA(A0, 1, 0); PG_LDA(A1, 1, 1); PG_SCHED; PG_LDB(Bq, 1, 0); PG_STAGEB(PG_SB(0, 1), b2 + hstep);
            PG_WAIT_V(8); PG_WAIT_L(0); PG_BAR; PG_MMA(0, 0, A0, Bq); PG_MMA(1, 0, A1, Bq); PG_BAR; PG_SCHED;
            PG_LDB(Bq, 1, 1); PG_STAGE(PG_SA(1, 0), a3, voffA[0]); PG_STAGE(PG_SA(1, 1), a3, voffA[1]); PG_STAGEB(PG_SB(1, 0), b3);
            PG_WAIT_V(8); PG_WAIT_L(0); PG_BAR; PG_MMA(0, 1, A0, Bq); PG_MMA(1, 1, A1, Bq); PG_BAR; PG_SCHED;
            } else {
            PG_LDB(B0, 0, 0); PG_LDB(B1, 0, 1); PG_SCHED; PG_LDA(At, 0, 0); PG_STAGE(PG_SA(1, 1), a1, voffA[1]);
            PG_WAIT_V(8); PG_WAIT_L(0); PG_BAR; PG_MMA(0, 0, At, B0); PG_MMA(0, 1, At, B1); PG_BAR; PG_SCHED;
            if (last && has_next) PG_SET_AOFF(nxt, (ui + 1) & 1);
            PG_LDA(At, 0, 1); PG_STAGEB(PG_SB(0, 0), b2); PG_STAGEB(PG_SB(0, 1), b2 + hstep); PG_STAGE(PG_SA(0, 0), a2, voffA[0]);
            PG_WAIT_V(8); PG_WAIT_L(0); PG_BAR; PG_MMA(1, 0, At, B0); PG_MMA(1, 1, At, B1); PG_BAR; PG_SCHED;
            PG_LDB(B0, 1, 0); PG_LDB(B1, 1, 1); PG_SCHED; PG_LDA(At, 1, 0); PG_STAGE(PG_SA(0, 1), a2, voffA[1]);
            PG_WAIT_V(8); PG_WAIT_L(0); PG_BAR; PG_MMA(0, 0, At, B0); PG_MMA(0, 1, At, B1); PG_BAR; PG_SCHED;
            PG_LDA(At, 1, 1); PG_STAGEB(PG_SB(1, 0), b3); PG_STAGEB(PG_SB(1, 1), b3 + hstep); PG_STAGE(PG_SA(1, 0), a3, voffA[0]);
            PG_WAIT_V(8); PG_WAIT_L(0); PG_BAR; PG_MMA(1, 0, At, B0); PG_MMA(1, 1, At, B1); PG_BAR; PG_SCHED;
            }
        }
        if constexpr (ALIGN_EPI) { if (wg == 0) PG_BAR; }
        {
            int tz = wid * 64 + lane_id(); asm volatile("" : "+v"(tz)); const int lz = tz & 63;
            E(acc, cur, ui % 3, FP8 ? (tz >> 6) >> 1 : (tz >> 6) >> 2, FP8 ? (tz >> 6) & 1 : (tz >> 6) & 3, lz & 15, lz >> 4);
        }
        S.after_epi(ui);
        if (!has_next) break;
#pragma unroll
        for (int a = 0; a < 2; ++a)
#pragma unroll
            for (int b = 0; b < 2; ++b)
#pragma unroll
                for (int m = 0; m < NMF; ++m)
#pragma unroll
                    for (int n = 0; n < NNF; ++n) acc[a][b][m][n] = (f32x4){0.f, 0.f, 0.f, 0.f};
        cur = nxt; cA = nA; cB = nB; ++ui;
        if constexpr (ALIGN_EPI) { if (wg == 1) PG_BAR; }
    }
    PG_WAIT_V(0);
    if constexpr (!ALIGN_EPI) { if (wg == 0) PG_BAR; }
    PG_BAR;
#undef PG_SA
#undef PG_SB
#undef PG_STAGE
#undef PG_STAGEB
#undef PG_LDA
#undef PG_LDB
#undef PG_MMA
#undef PG_LD8
#undef PG_WAIT_V
#undef PG_WAIT_L
#undef PG_BAR
#undef PG_SCHED
#undef PG_SET_AOFF
}

struct EpiProj {
    static constexpr bool PERM = true, ADJ = true; bf16* P; bf16* S5A;
    __device__ __forceinline__ void operator()(const f32x4 (&acc)[2][2][4][2], const Unit& u, int bb, int wr, int wc, int fr, int fq) const {
        const int row0 = u.pm * BM + wr * 64, col0 = u.pn * BM + wc * 64 + 8 * fq;
        if (u.pn < 2) {
#pragma unroll
            for (int ai = 0; ai < 2; ++ai)
#pragma unroll
                for (int m = 0; m < 4; ++m) { const int row = row0 + fr + ai * HALF + m * 16; const int b = row >> 13, tt = row & 8191;
                    bf16* rowp = S5A + ((size_t)b * S5NCH + (tt / S5L)) * S5K + (tt % S5L) * 16 + (col0 & 15) + (size_t)(col0 >> 4) * S5ROWS * S5K;
#pragma unroll
                    for (int bj = 0; bj < 2; ++bj) { const f32x4 v0 = acc[ai][bj][m][0], v1 = acc[ai][bj][m][1];
                        u32x4 w; w.x = cvt_pk_bf16(v0[0], v0[1]); w.y = cvt_pk_bf16(v0[2], v0[3]); w.z = cvt_pk_bf16(v1[0], v1[1]); w.w = cvt_pk_bf16(v1[2], v1[3]);
                        *(u32x4*)(rowp + (size_t)bj * 2 * S5ROWS * S5K) = w; } }
        } else {
            const bool lo8 = fr < 8; const int cw = u.pn * BM + wc * 64 - 512;
#pragma unroll
            for (int ai = 0; ai < 2; ++ai)
#pragma unroll
                for (int m = 0; m < 4; ++m) {
                    u32x4 Pv[2];
#pragma unroll
                    for (int bj = 0; bj < 2; ++bj) { const f32x4 v0 = acc[ai][bj][m][0], v1 = acc[ai][bj][m][1];
                        Pv[bj].x = cvt_pk_bf16(v0[0], v0[1]); Pv[bj].y = cvt_pk_bf16(v0[2], v0[3]); Pv[bj].z = cvt_pk_bf16(v1[0], v1[1]); Pv[bj].w = cvt_pk_bf16(v1[2], v1[3]); }
                    u32x4 snd = lo8 ? Pv[1] : Pv[0], rcv;
                    rcv.x = (unsigned)__builtin_amdgcn_update_dpp(0, (int)snd.x, 0x128, 0xF, 0xF, false); rcv.y = (unsigned)__builtin_amdgcn_update_dpp(0, (int)snd.y, 0x128, 0xF, 0xF, false);
                    rcv.z = (unsigned)__builtin_amdgcn_update_dpp(0, (int)snd.z, 0x128, 0xF, 0xF, false); rcv.w = (unsigned)__builtin_amdgcn_update_dpp(0, (int)snd.w, 0x128, 0xF, 0xF, false);
                    const int row = row0 + (fr & 7) + ai * HALF + m * 16;
                    bf16* rp = P + ((size_t)((cw >> 9) * 16 + (row >> 13) * 4 + ((cw >> 7) & 3)) * SEQ + (row & 8191)) * 128 + (cw & 127) + (lo8 ? 0 : 32) + 8 * fq;
                    *(u32x4*)rp = lo8 ? Pv[0] : rcv;
                    *(u32x4*)(rp + (size_t)8 * 128) = lo8 ? rcv : Pv[1]; }
        }
    }
};
struct EpiXloc {
    static constexpr bool PERM = false, ADJ = false; float* X;
    __device__ __forceinline__ void operator()(const f32x4 (&acc)[2][2][4][2], const Unit& u, int bb, int wr, int wc, int fr, int fq) const {
        const int row0 = (u.pm & 3) * BM + wr * 64 + fr, col0 = wc * 32 + 4 * fq;
#pragma unroll
        for (int ai = 0; ai < 2; ++ai)
#pragma unroll
            for (int m = 0; m < 4; ++m) { float* rp = X + ((size_t)u.e * S5ROWS + row0 + ai * HALF + m * 16) * 128 + col0;
#pragma unroll
                for (int n = 0; n < 2; ++n) *(f32x4*)(rp + n * 16) = acc[ai][0][m][n]; }
    }
};
struct EpiS5Y {
    static constexpr bool PERM = true, ADJ = false; const bf16* S5A; const float* dskip; bf16* GY;
    __device__ __forceinline__ void operator()(const f32x4 (&acc)[2][2][4][2], const Unit& u, int bb, int wr, int wc, int fr, int fq) const {
        const int g = u.e, rg0 = (u.pm & 3) * BM + wr * 64 + fr, c0 = u.pn * BM + wc * 32 + 8 * fq;
#pragma unroll
        for (int bj = 0; bj < 2; ++bj) { const int col = c0 + bj * HALF, t = col >> 4, p0 = col & 15;
            const f32x4 d0 = *(const f32x4*)(dskip + g * 16 + p0), d1 = *(const f32x4*)(dskip + g * 16 + p0 + 4);
#pragma unroll
            for (int ai = 0; ai < 2; ++ai)
#pragma unroll
                for (int m = 0; m < 4; ++m) { const int rg = rg0 + ai * HALF + m * 16; const int b = rg / S5NCH, c = rg % S5NCH;
                    const u32x4 uu = *(const u32x4*)(S5A + ((size_t)g * S5ROWS + rg) * S5K + col);
                    const f32x4 v0 = acc[ai][bj][m][0], v1 = acc[ai][bj][m][1];
                    u32x4 w;
                    w.x = cvt_pk_bf16(gelu_tanh(v0[0] + d0[0] * lo_bf(uu.x)), gelu_tanh(v0[1] + d0[1] * hi_bf(uu.x))); w.y = cvt_pk_bf16(gelu_tanh(v0[2] + d0[2] * lo_bf(uu.y)), gelu_tanh(v0[3] + d0[3] * hi_bf(uu.y)));
                    w.z = cvt_pk_bf16(gelu_tanh(v1[0] + d1[0] * lo_bf(uu.z)), gelu_tanh(v1[1] + d1[1] * hi_bf(uu.z))); w.w = cvt_pk_bf16(gelu_tanh(v1[2] + d1[2] * lo_bf(uu.w)), gelu_tanh(v1[3] + d1[3] * hi_bf(uu.w)));
                    *(u32x4*)(GY + ((size_t)b * SEQ + c * S5L + t) * 512 + g * 16 + p0) = w; } }
    }
};
struct S5Sched {
    const char* A; const char* B; int lda2, K2, brows, nN, G, c;
    __device__ __forceinline__ bool next(int i, Unit& u) const { const int L = i * G + c; if (L >= 128 * nN) return false;
        const int g = L / (4 * nN), r = L % (4 * nN), mh = r / nN, pn = r % nN;
        u.A = ((unsigned)g * S5ROWS + mh * 256u) * (unsigned)lda2; u.B = ((unsigned)g * brows + pn * 256u) * (unsigned)K2; u.pm = g * 4 + mh; u.pn = pn; u.e = g; u.nrows = 256; return true; }
    __device__ __forceinline__ __amdgpu_buffer_rsrc_t rsrcA() const { return mkrsrc(A); }
    __device__ __forceinline__ __amdgpu_buffer_rsrc_t rsrcB() const { return mkrsrc(B); }
    __device__ __forceinline__ void prefetch(const Unit&, int, int, int) const {}
    __device__ __forceinline__ void after_epi(int) const {}
    __device__ __forceinline__ unsigned aoff(const Unit&, int row, int) const { return (unsigned)row * (unsigned)lda2; }
};
struct EpiGlu {
    static constexpr bool PERM = true, ADJ = true; const bf16* GY; const float* bglu; bf16* MIX; LAS unsigned char* xt;
    __device__ __forceinline__ void operator()(const f32x4 (&acc)[2][2][4][2], const Unit& u, int bb, int wr, int wc, int fr, int fq) const {
        const int lz = fq * 16 + fr, lr = lz >> 3, lc = lz & 7; const bool lo8 = fr < 8;
        const int cb = u.pn * BM + wc * 64;
        LAS unsigned char* tl = xt + (wr * 4 + wc) * 2048;
        const bf16* gb = GY + (size_t)(u.pm * BM + wr * 64 + lr) * 512 + cb + 8 * lc;
        bf16* mb = MIX + (size_t)(u.pm * BM + wr * 64 + (fr & 7)) * D + cb + (lo8 ? 0 : 32) + 8 * fq;
        f32x4 bv[2][2];
#pragma unroll
        for (int bj = 0; bj < 2; ++bj) { bv[bj][0] = *(const f32x4*)(bglu + cb + bj * 32 + 8 * fq); bv[bj][1] = *(const f32x4*)(bglu + cb + bj * 32 + 8 * fq + 4); }
#pragma unroll
        for (int ai = 0; ai < 2; ++ai) {
            u32x4 gl_[4][2];
#pragma unroll
            for (int m = 0; m < 4; ++m)
#pragma unroll
                for (int t = 0; t < 2; ++t) gl_[m][t] = *(const u32x4*)(gb + (size_t)(ai * HALF + m * 16 + 8 * t) * 512);
#pragma unroll
            for (int m = 0; m < 4; ++m) {
#pragma unroll
                for (int t = 0; t < 2; ++t) { const int R = 8 * t + lr; *(LAS u32x4*)(tl + R * 128 + ((lc ^ (R & 7)) << 4)) = gl_[m][t]; }
                u32x4 Pv[2];
#pragma unroll
                for (int bj = 0; bj < 2; ++bj) { const u32x4 g = *(const LAS u32x4*)(tl + fr * 128 + (((bj * 4 + fq) ^ (fr & 7)) << 4));
                    const f32x4 v0 = acc[ai][bj][m][0] + bv[bj][0], v1 = acc[ai][bj][m][1] + bv[bj][1];
                    Pv[bj].x = cvt_pk_bf16(lo_bf(g.x) * sigmoidf_(v0[0]), hi_bf(g.x) * sigmoidf_(v0[1])); Pv[bj].y = cvt_pk_bf16(lo_bf(g.y) * sigmoidf_(v0[2]), hi_bf(g.y) * sigmoidf_(v0[3]));
                    Pv[bj].z = cvt_pk_bf16(lo_bf(g.z) * sigmoidf_(v1[0]), hi_bf(g.z) * sigmoidf_(v1[1])); Pv[bj].w = cvt_pk_bf16(lo_bf(g.w) * sigmoidf_(v1[2]), hi_bf(g.w) * sigmoidf_(v1[3])); }
                u32x4 snd = lo8 ? Pv[1] : Pv[0], rcv;
                rcv.x = (unsigned)__builtin_amdgcn_update_dpp(0, (int)snd.x, 0x128, 0xF, 0xF, false); rcv.y = (unsigned)__builtin_amdgcn_update_dpp(0, (int)snd.y, 0x128, 0xF, 0xF, false);
                rcv.z = (unsigned)__builtin_amdgcn_update_dpp(0, (int)snd.z, 0x128, 0xF, 0xF, false); rcv.w = (unsigned)__builtin_amdgcn_update_dpp(0, (int)snd.w, 0x128, 0xF, 0xF, false);
                bf16* mp = mb + (size_t)(ai * HALF + m * 16) * D;
                *(u32x4*)mp = lo8 ? Pv[0] : rcv;
                *(u32x4*)(mp + (size_t)8 * D) = lo8 ? rcv : Pv[1];
            }
        }
    }
};
struct EpiOut {
    static constexpr bool PERM = true, ADJ = true; const float* x; bf16* H; LAS unsigned char* xt;
    __device__ __forceinline__ void operator()(const f32x4 (&acc)[2][2][4][2], const Unit& u, int bb, int wr, int wc, int fr, int fq) const {
        const int lz = fq * 16 + fr, lr = lz >> 3, lc = lz & 7;
        LAS unsigned char* tl = xt + (wr * 4 + wc) * 2048;
        const float* xb = x + (size_t)(u.pm * BM + wr * 64 + lr) * D + u.pn * BM + wc * 64 + 4 * lc;
        const bool lo8 = fr < 8;
        bf16* hb = H + (size_t)(u.pm * BM + wr * 64 + (fr & 7)) * D + u.pn * BM + wc * 64 + (lo8 ? 0 : 32) + 8 * fq;
#pragma unroll
        for (int ai = 0; ai < 2; ++ai) {
            f32x4 xl[4][2][2];
#pragma unroll
            for (int m = 0; m < 4; ++m)
#pragma unroll
                for (int bj = 0; bj < 2; ++bj)
#pragma unroll
                    for (int t = 0; t < 2; ++t) xl[m][bj][t] = __builtin_nontemporal_load((const f32x4*)(xb + (size_t)(ai * HALF + m * 16 + 8 * t) * D + bj * 32));
#pragma unroll
            for (int m = 0; m < 4; ++m) {
                u32x4 P[2];
#pragma unroll
                for (int bj = 0; bj < 2; ++bj) {
#pragma unroll
                    for (int t = 0; t < 2; ++t) { const int R = 8 * t + lr; *(LAS f32x4*)(tl + R * 128 + ((lc ^ (R & 7)) << 4)) = xl[m][bj][t]; }
                    const f32x4 x0 = *(const LAS f32x4*)(tl + fr * 128 + (((2 * fq) ^ (fr & 7)) << 4)), x1 = *(const LAS f32x4*)(tl + fr * 128 + (((2 * fq + 1) ^ (fr & 7)) << 4));
                    const f32x4 v0 = x0 + acc[ai][bj][m][0], v1 = x1 + acc[ai][bj][m][1];
                    P[bj].x = cvt_pk_bf16(v0[0], v0[1]); P[bj].y = cvt_pk_bf16(v0[2], v0[3]); P[bj].z = cvt_pk_bf16(v1[0], v1[1]); P[bj].w = cvt_pk_bf16(v1[2], v1[3]); }
                u32x4 snd = lo8 ? P[1] : P[0], rcv;
                rcv.x = (unsigned)__builtin_amdgcn_update_dpp(0, (int)snd.x, 0x128, 0xF, 0xF, false); rcv.y = (unsigned)__builtin_amdgcn_update_dpp(0, (int)snd.y, 0x128, 0xF, 0xF, false);
                rcv.z = (unsigned)__builtin_amdgcn_update_dpp(0, (int)snd.z, 0x128, 0xF, 0xF, false); rcv.w = (unsigned)__builtin_amdgcn_update_dpp(0, (int)snd.w, 0x128, 0xF, 0xF, false);
                bf16* hp = hb + (size_t)(ai * HALF + m * 16) * D;
                *(u32x4*)hp = lo8 ? P[0] : rcv;
                *(u32x4*)(hp + (size_t)8 * D) = lo8 ? rcv : P[1];
            }
        }
    }
};
struct EpiUp {
    static constexpr bool PERM = true, ADJ = false; const LAS float* bl; unsigned char* ACT;
    __device__ __forceinline__ void operator()(const f32x4 (&acc)[2][2][2][4], const Unit& u, int bb, int wr, int wc, int fr, int fq) const {
        const int row0 = u.pm * BM + wr * 32 + fr, j0 = u.pn * HALF + wc * 64 + 16 * fq;
        const LAS float* bg = bl + bb * 256 + wc * 64 + 16 * fq;
#pragma unroll
        for (int ai = 0; ai < 2; ++ai)
#pragma unroll
            for (int m = 0; m < 2; ++m) {
                unsigned wv[4];
                typedef float f32x2 __attribute__((ext_vector_type(2)));
#pragma unroll
                for (int n = 0; n < 4; ++n) { const f32x4 gb = *(const LAS f32x4*)(bg + 4 * n), lb = *(const LAS f32x4*)(bg + 128 + 4 * n); float o[4];
#pragma unroll
                    for (int q = 0; q < 4; q += 2) {
                        f32x2 gv = (f32x2){acc[ai][0][m][n][q], acc[ai][0][m][n][q + 1]} * W8_INV + (f32x2){gb[q], gb[q + 1]};
                        f32x2 lv = (f32x2){acc[ai][1][m][n][q], acc[ai][1][m][n][q + 1]} * W8_INV + ((f32x2){lb[q], lb[q + 1]} + 1.f);
                        gv.x = fminf(gv.x, 7.f); gv.y = fminf(gv.y, 7.f);
                        lv.x = __builtin_amdgcn_fmed3f(lv.x, -6.f, 8.f); lv.y = __builtin_amdgcn_fmed3f(lv.y, -6.f, 8.f);
                        f32x2 tt = gv * (-1.702f * 1.4426950408889634f);
                        tt.x = __builtin_amdgcn_exp2f(tt.x); tt.y = __builtin_amdgcn_exp2f(tt.y);
                        tt = tt + 1.f;
                        tt.x = __builtin_amdgcn_rcpf(tt.x); tt.y = __builtin_amdgcn_rcpf(tt.y);
                        const f32x2 ov = (gv * tt) * lv;
                        o[q] = ov.x; o[q + 1] = ov.y; }
                    wv[n] = pk4_fp8(o[0], o[1], o[2], o[3]); }
                u32x4 w; w.x = wv[0]; w.y = wv[1]; w.z = wv[2]; w.w = wv[3];
                *(u32x4*)(ACT + (size_t)(row0 + ai * HALF + m * 16) * FF + j0) = w; }
    }
};
struct EpiDown {
    static constexpr bool PERM = true, ADJ = false; const LAS float* bl; unsigned char* YS;
    __device__ __forceinline__ void operator()(const f32x4 (&acc)[2][2][2][4], const Unit& u, int bb, int wr, int wc, int fr, int fq) const {
        const int row0 = u.pm * BM + wr * 32 + fr, col0 = u.pn * BM + wc * 128 + 16 * fq;
        const LAS float* bp = bl + bb * 256 + wc * 128 + 16 * fq;
#pragma unroll
        for (int bj = 0; bj < 2; ++bj) {
            const f32x4 b0 = *(const LAS f32x4*)(bp + bj * 64), b1 = *(const LAS f32x4*)(bp + bj * 64 + 4), b2 = *(const LAS f32x4*)(bp + bj * 64 + 8), b3 = *(const LAS f32x4*)(bp + bj * 64 + 12);
#pragma unroll
            for (int ai = 0; ai < 2; ++ai)
#pragma unroll
                for (int m = 0; m < 2; ++m) {
                    const f32x4 v0 = acc[ai][bj][m][0] * W8_INV + b0, v1 = acc[ai][bj][m][1] * W8_INV + b1, v2 = acc[ai][bj][m][2] * W8_INV + b2, v3 = acc[ai][bj][m][3] * W8_INV + b3;
                    u32x4 w; w.x = pk4_fp8(v0[0], v0[1], v0[2], v0[3]); w.y = pk4_fp8(v1[0], v1[1], v1[2], v1[3]); w.z = pk4_fp8(v2[0], v2[1], v2[2], v2[3]); w.w = pk4_fp8(v3[0], v3[1], v3[2], v3[3]);
                    *(u32x4*)(YS + (size_t)(row0 + ai * HALF + m * 16) * D + col0 + bj * 64) = w; }
        }
    }
};
}

struct MoeSched {
    const char* A; const char* W; const int* slot_tok; const float* bias; LAS int* til; LAS int* idx; LAS float* bl; int lda2, K2, nN, wrows  , G, c, gather;
    unsigned* sig; LAS unsigned* wcnt; unsigned nloc; int xp;
    static __device__ __forceinline__ int early_tile(int x, int j, int nM) { return 4 * ((x * nM + 31) >> 5) + j; }
    __device__ __forceinline__ void build_list(LAS int* ul, int tidx) const {
        const int i = tidx;
        if (i < 32) { const int nM = til[2 * MAXTILES]; int pm = -1, pn = 0, e = 0, nr = 0;
            if (pg::tile_order(i, G, c, nM - xp, nN, pm, pn)) {
                for (int x = 0; x < 8; ++x) for (int j = 0; j < 4; ++j) if (j * 8 + x < xp && pm >= early_tile(x, j, nM)) ++pm;
                e = til[pm]; nr = til[MAXTILES + pm]; } else pm = -1;
            ul[i * 4 + 0] = pm; ul[i * 4 + 1] = pn; ul[i * 4 + 2] = e; ul[i * 4 + 3] = nr; }
    }
    __device__ __forceinline__ bool next(int i, pg::Unit& u) const {
        const LAS int* ul = (const LAS int*)((const LAS char*)til - TIL_OFF + ULIST_OFF);
        if (i >= 32) return false;
        const int pm = __builtin_amdgcn_readfirstlane(ul[i * 4 + 0]); if (pm < 0) return false;
        const int pn = __builtin_amdgcn_readfirstlane(ul[i * 4 + 1]), e = __builtin_amdgcn_readfirstlane(ul[i * 4 + 2]);
        u.pm = pm; u.pn = pn; u.e = e; u.nrows = __builtin_amdgcn_readfirstlane(ul[i * 4 + 3]);
        u.A = gather ? 0u : (unsigned)pm * 256u * (unsigned)lda2; u.B = ((unsigned)e * wrows + (unsigned)pn * 256u) * (unsigned)K2; return true; }
    __device__ __forceinline__ void after_epi(int ui) const {
        if (sig != nullptr && ui == 2) {
            asm volatile("s_waitcnt vmcnt(0)" ::: "memory");
            if (lane_id() == 0) {
                const unsigned w = __hip_atomic_fetch_add(wcnt, 1u, __ATOMIC_RELAXED, __HIP_MEMORY_SCOPE_WORKGROUP);
                if (w == NWAVES - 1) {
                    const unsigned old = __hip_atomic_fetch_add(sig + 64 * (1 + xb_xcc_id()), 1u, __ATOMIC_RELAXED, __HIP_MEMORY_SCOPE_AGENT);
                    if (old + 1u == nloc) { __builtin_amdgcn_fence(__ATOMIC_RELEASE, "agent"); (void)__hip_atomic_fetch_add(sig, 1u, __ATOMIC_RELAXED, __HIP_MEMORY_SCOPE_AGENT); }
                }
            }
        } }
    __device__ __forceinline__ __amdgpu_buffer_rsrc_t rsrcA() const { return pg::mkrsrc(A); }
    __device__ __forceinline__ __amdgpu_buffer_rsrc_t rsrcB() const { return pg::mkrsrc(W); }
    __device__ __forceinline__ void prefetch(const pg::Unit& u, int ib, int bb, int tidx) const {
        if (tidx >= 256 && tidx < 320) {
            const int l = tidx - 256;
            const float* src = gather ? bias + (size_t)u.e * 2 * FF + (l < 32 ? u.pn * 128 + 4 * l : FF + u.pn * 128 + 4 * (l - 32)) : bias + (size_t)u.e * D + u.pn * 256 + 4 * l;
            __builtin_amdgcn_global_load_lds((const unsigned*)src, (LAS unsigned*)(bl + bb * 256), 16, 0, 0); }
        if (gather && tidx < 256) { const int r = tidx; const size_t s = (size_t)u.e * (T * 4) + (u.pm - til[2 * MAXTILES + 8 + u.e]) * 256 + (r < u.nrows ? r : u.nrows - 1);
            __builtin_amdgcn_global_load_lds((const unsigned*)(slot_tok + s), (LAS unsigned*)(idx + ib * 256 + (tidx & ~63)), 4, 0, 0); } }
    __device__ __forceinline__ unsigned aoff(const pg::Unit&, int row, int ib) const { return gather ? (unsigned)idx[ib * 256 + row] * (unsigned)lda2 : (unsigned)row * (unsigned)lda2; }
};

struct Frame {
    LAS unsigned char* lds; volatile LAS unsigned* MISC; gu32* ctl; int tid, lane, wave, vcu, G;
};
#define LDS_WAIT() asm volatile("s_waitcnt lgkmcnt(0)" ::: "memory")
#define LDS_BARRIER() do { asm volatile("s_waitcnt lgkmcnt(0)" ::: "memory"); __builtin_amdgcn_s_barrier(); asm volatile("" ::: "memory"); } while (0)

__device__ __forceinline__ void tr_load(f32x4 (&v)[16], const float* W, int ldw, int nblk, int item, int lane) {
    const int kb = item / nblk, nb = item % nblk;
    const float* src = W + (size_t)(64 * kb + (lane >> 4)) * ldw + 64 * nb + 4 * (lane & 15);
#pragma unroll
    for (int i = 0; i < 16; ++i) v[i] = __builtin_nontemporal_load((const f32x4*)(src + (size_t)(4 * i) * ldw));
}
template <bool F8, class RowMap>
__device__ __forceinline__ void tr_store(const f32x4 (&v)[16], int K, int nblk, void* WTv, LAS bf16* scr, int item, int lane, RowMap rowmap) {
    const int kb = item / nblk, nb = item % nblk, k0 = 64 * kb, n0 = 64 * nb;
#pragma unroll
    for (int i = 0; i < 16; ++i) { u32x2 o; o.x = pk2(v[i].x, v[i].y); o.y = pk2(v[i].z, v[i].w); *(LAS u32x2*)(scr + ((lane >> 4) + 4 * i) * 68 + 4 * (lane & 15)) = o; }
    LDS_WAIT(); asm volatile("" ::: "memory");
    const int c = lane & 7; const int r0 = rowmap(n0);
#pragma unroll
    for (int jn = 0; jn < 8; ++jn) { const int n = (lane >> 3) + 8 * jn; const LAS bf16* sp = scr + (8 * c) * 68 + n;
        if constexpr (F8) { u32x2 o; o.x = pk4_fp8(bf2f(sp[0]) * W8_SCALE, bf2f(sp[68]) * W8_SCALE, bf2f(sp[2 * 68]) * W8_SCALE, bf2f(sp[3 * 68]) * W8_SCALE);
            o.y = pk4_fp8(bf2f(sp[4 * 68]) * W8_SCALE, bf2f(sp[5 * 68]) * W8_SCALE, bf2f(sp[6 * 68]) * W8_SCALE, bf2f(sp[7 * 68]) * W8_SCALE);
            __builtin_nontemporal_store(o, (u32x2*)((unsigned char*)WTv + (size_t)(r0 + n) * K + k0 + 8 * c)); }
        else { u32x4 o; o.x = (unsigned)sp[0] | ((unsigned)sp[68] << 16); o.y = (unsigned)sp[2 * 68] | ((unsigned)sp[3 * 68] << 16); o.z = (unsigned)sp[4 * 68] | ((unsigned)sp[5 * 68] << 16); o.w = (unsigned)sp[6 * 68] | ((unsigned)sp[7 * 68] << 16);
            *(u32x4*)((bf16*)WTv + (size_t)(r0 + n) * K + k0 + 8 * c) = o; } }
    LDS_WAIT(); asm volatile("" ::: "memory");
}
template <bool F8, class RowMap>
__device__ __forceinline__ void transpose_item(const float* W, int ldw, int K, int nblk, void* WTv, LAS bf16* scr, int item, int lane, RowMap rowmap) {
    f32x4 v[16]; tr_load(v, W, ldw, nblk, item, lane); tr_store<F8>(v, K, nblk, WTv, scr, item, lane, rowmap);
}
__device__ __forceinline__ void tr8_load(f32x4 (&v)[16], const float* W, int ldw, int nblk, int item, int lane) {
    const int kb = item / nblk, nb = item % nblk;
    const float* src = W + (size_t)(128 * kb + 16 * (lane >> 3)) * ldw + 32 * nb + 4 * (lane & 7);
#pragma unroll
    for (int i = 0; i < 16; ++i) v[i] = __builtin_nontemporal_load((const f32x4*)(src + (size_t)i * ldw));
}
template <class RowMap>
__device__ __forceinline__ void tr8_store(const f32x4 (&v)[16], int K, int nblk, unsigned char* WT, int item, int lane, RowMap rowmap) {
    const int kb = item / nblk, nb = item % nblk;
    unsigned char* dst = WT + (size_t)rowmap(32 * nb + 4 * (lane & 7)) * K + 128 * kb + 16 * (lane >> 3);
#pragma unroll
    for (int j = 0; j < 4; ++j) { u32x4 o;
        o.x = pk4_fp8(v[0][j] * W8_SCALE, v[1][j] * W8_SCALE, v[2][j] * W8_SCALE, v[3][j] * W8_SCALE); o.y = pk4_fp8(v[4][j] * W8_SCALE, v[5][j] * W8_SCALE, v[6][j] * W8_SCALE, v[7][j] * W8_SCALE);
        o.z = pk4_fp8(v[8][j] * W8_SCALE, v[9][j] * W8_SCALE, v[10][j] * W8_SCALE, v[11][j] * W8_SCALE); o.w = pk4_fp8(v[12][j] * W8_SCALE, v[13][j] * W8_SCALE, v[14][j] * W8_SCALE, v[15][j] * W8_SCALE);
        __builtin_nontemporal_store(o, (u32x4*)(dst + (size_t)j * K)); }
}
struct RowId { __device__ __forceinline__ int operator()(int n0) const { return n0; } };
struct RowUp { __device__ __forceinline__ int operator()(int n) const { const int lin = n >= FF, j = (n - lin * FF) & 127, pn = (n - lin * FF) >> 7; return pn * 256 + (j >> 4) * 32 + 16 * lin + (j & 15); } };
struct RowDn { __device__ __forceinline__ int operator()(int o) const { const int ol = o & 255; return (o & ~255) + ((ol >> 7) * 4 + ((ol >> 4) & 3)) * 32 + ((ol >> 6) & 1) * 16 + (ol & 15); } };

struct Args { const float* in[26]; float* out; unsigned char* ws; int ph_lo, ph_hi, li, pad; };

__global__ void __launch_bounds__(NTHR, 2) fwd(Args args) {
    extern __shared__ __attribute__((aligned(16))) unsigned char lds_raw[];
    Frame F;
    F.lds = (LAS unsigned char*)lds_raw;
    F.MISC = (volatile LAS unsigned*)(F.lds + MISC_OFF);
    F.wave = __builtin_amdgcn_readfirstlane((int)threadIdx.x >> 6); F.lane = lane_id(); F.tid = F.wave * 64 + F.lane;
    F.G = gridDim.x; { const int bx = blockIdx.x; F.vcu = (F.G % 8 == 0) ? (bx % 8) * (F.G / 8) + bx / 8 : bx; }
    unsigned char* ws = args.ws;
    F.ctl = (gu32*)(ws + WS_CTL);
    if (F.tid < 32) ((LAS unsigned*)(F.lds + MISC_OFF))[F.tid] = 0u;
    __syncthreads();
    XcdBarrier bar = xcd_barrier_post((unsigned*)(F.ctl + CW_BAR) + args.li * XCD_BAR_WORDS, F.MISC + 8, F.wave);
#define INP(i) (*(const float* const volatile*)((const char*)__builtin_amdgcn_kernarg_segment_ptr() + 8 * (i)))
    const int lo = args.ph_lo, hi = args.ph_hi;
#define IN(k) (lo <= (k) && (k) < hi)
#define BOTH(k) (IN(k) && IN((k) + 1))
#define GRID_BAR() xcd_barrier(bar)
    const float* x = args.in[0];
    bf16* WIN = (bf16*)(ws + WS_WIN); bf16* WGLU = (bf16*)(ws + WS_WGLU); bf16* WOUT = (bf16*)(ws + WS_WOUT); unsigned char* WUP8 = ws + WS_WUP; unsigned char* WDN8 = ws + WS_WDN;
    bf16* HN = (bf16*)(ws + WS_HN); bf16* PROJ = (bf16*)(ws + WS_PROJ); bf16* GY = (bf16*)(ws + WS_GY); bf16* MIX = (bf16*)(ws + WS_MIX);
    bf16* H = (bf16*)(ws + WS_H); unsigned char* ACT8 = ws + WS_ACT; unsigned char* HN8 = ws + WS_HN; unsigned char* YS = ws + WS_YS;
    float* gates = (float*)(ws + WS_GATES); int* topi = (int*)(ws + WS_TOPI); float* topg = (float*)(ws + WS_TOPG);
    int* slot_tok = (int*)(ws + WS_ETOK); int* tok_slot = (int*)(ws + WS_TOKSLOT); int* CNT = (int*)(ws + WS_CNT); int* ecnt = (int*)(F.ctl + CW_ECNT);
    bf16* S5A = (bf16*)(ws + WS_S5A); bf16* S5BT = (bf16*)(ws + WS_S5BT); bf16* S5BQ = (bf16*)(ws + WS_S5BQ); float* XLOC = (float*)(ws + WS_XLOC);
    bf16* QH = (bf16*)(ws + WS_QH); bf16* KH = (bf16*)(ws + WS_KH); bf16* VT = (bf16*)(ws + WS_VT); float* DC = (float*)(ws + WS_DC); bf16* CST = (bf16*)(ws + WS_CST);
    float* FLOC = (float*)(ws + WS_FLOC); float* DN = (float*)(ws + WS_DN); float* NST = (float*)(ws + WS_NST); float* SEGS = (float*)(ws + WS_SEGS); float* KTAB = (float*)(ws + WS_KTAB); bf16* WR2 = (bf16*)(ws + WS_WR2);
    const int gw = F.vcu * NWAVES + F.wave, NGW = F.G * NWAVES;

    if (IN(0)) {
        { int tq_ = F.wave * 64 + lane_id(); asm volatile("" : "+v"(tq_)); F.tid = tq_; F.lane = tq_ & 63; }
        LAS bf16* scr = (LAS bf16*)(F.lds + F.wave * 16384);
        constexpr int I_IN = (D / 64) * (NPROJ / 64), I_GLU = (512 / 64) * (512 / 64), I_OUT = (D / 64) * (D / 64);
        constexpr int NITEMS = I_IN + I_GLU + I_OUT;
        for (int it = gw; it < NITEMS && !(args.pad & 1); it += NGW) {
            int r = it;
            if (r < I_IN) { transpose_item<false>(args.in[2], DIN, D, NPROJ / 64, WIN, scr, r, F.lane, RowId()); continue; } r -= I_IN;
            if (r < I_GLU) { transpose_item<false>(args.in[11], 512, 512, 512 / 64, WGLU, scr, r, F.lane, RowId()); continue; } r -= I_GLU;
            transpose_item<false>(args.in[17], D, D, D / 64, WOUT, scr, r, F.lane, RowId());
        }
        {
            const float* g = args.in[1]; const float* w_in = args.in[2]; const float* b_gates = args.in[15];
            float wg[16][8]; f32x4 gg[4];
#pragma unroll
            for (int jq = 0; jq < 4; ++jq) { gg[jq] = *(const f32x4*)(g + 4 * F.lane + 256 * jq);
#pragma unroll
                for (int i = 0; i < 4; ++i) { const int k = 4 * F.lane + 256 * jq + i; const f32x4 w0 = *(const f32x4*)(w_in + (size_t)k * DIN + O_G), w1 = *(const f32x4*)(w_in + (size_t)k * DIN + O_G + 4);
                    wg[4 * jq + i][0] = w0.x; wg[4 * jq + i][1] = w0.y; wg[4 * jq + i][2] = w0.z; wg[4 * jq + i][3] = w0.w; wg[4 * jq + i][4] = w1.x; wg[4 * jq + i][5] = w1.y; wg[4 * jq + i][6] = w1.z; wg[4 * jq + i][7] = w1.w; } }
            float bgv[8];
#pragma unroll
            for (int q = 0; q < 8; ++q) bgv[q] = b_gates[q];
            f32x4 nx[4];
            if (gw < T) {
#pragma unroll
                for (int jq = 0; jq < 4; ++jq) nx[jq] = __builtin_nontemporal_load((const f32x4*)(x + (size_t)gw * D + 4 * F.lane + 256 * jq)); }
            for (int row = gw; row < T && !(args.pad & 2); row += NGW) {
                f32x4 v[4];
#pragma unroll
                for (int jq = 0; jq < 4; ++jq) v[jq] = nx[jq];
                if (row + NGW < T) {
#pragma unroll
                    for (int jq = 0; jq < 4; ++jq) nx[jq] = __builtin_nontemporal_load((const f32x4*)(x + (size_t)(row + NGW) * D + 4 * F.lane + 256 * jq)); }
                float ss = 0.f;
#pragma unroll
                for (int jq = 0; jq < 4; ++jq) ss += v[jq].x * v[jq].x + v[jq].y * v[jq].y + v[jq].z * v[jq].z + v[jq].w * v[jq].w;
                ss = wave_sum(ss);
                const float rstd = rsqrtf(ss * (1.f / D) + 1e-5f);
                float ga[8] = {0, 0, 0, 0, 0, 0, 0, 0};
#pragma unroll
                for (int jq = 0; jq < 4; ++jq) {
                    v[jq] = v[jq] * rstd * gg[jq];
#pragma unroll
                    for (int i = 0; i < 4; ++i)
#pragma unroll
                        for (int q = 0; q < 8; ++q) ga[q] += v[jq][i] * wg[4 * jq + i][q];
                    uint2 o; o.x = pk2(v[jq].x, v[jq].y); o.y = pk2(v[jq].z, v[jq].w);
                    *(uint2*)(HN + (size_t)row * D + 4 * F.lane + 256 * jq) = o;
                }
#pragma unroll
                for (int q = 0; q < 8; ++q) ga[q] = wave_sum(ga[q]);
                if (F.lane == 0) { *(f32x4*)(gates + (size_t)row * 8) = (f32x4){ga[0] + bgv[0], ga[1] + bgv[1], ga[2] + bgv[2], ga[3] + bgv[3]}; *(f32x4*)(gates + (size_t)row * 8 + 4) = (f32x4){ga[4] + bgv[4], ga[5] + bgv[5], ga[6] + bgv[6], ga[7] + bgv[7]}; }
            }
        }
        for (int idx = gw * 64 + F.lane; idx < 4096; idx += NGW * 64) {
            const int sidx = idx >> 6, l = idx & 63, kb = 16 * sidx + 8 * (l >> 5), e = l & 31;
            float hv[8], lv[8];
#pragma unroll
            for (int jj = 0; jj < 8; ++jj) { const float w = args.in[18][kb + jj] * args.in[19][(size_t)(kb + jj) * NE + e]; const bf16 hb = f2bf(w); hv[jj] = bf2f(hb); lv[jj] = w - hv[jj]; }
            u32x4 oh, ol; oh.x = pk2(hv[0], hv[1]); oh.y = pk2(hv[2], hv[3]); oh.z = pk2(hv[4], hv[5]); oh.w = pk2(hv[6], hv[7]);
            ol.x = pk2(lv[0], lv[1]); ol.y = pk2(lv[2], lv[3]); ol.z = pk2(lv[4], lv[5]); ol.w = pk2(lv[6], lv[7]);
            *(u32x4*)(WR2 + (size_t)idx * 8) = oh; *(u32x4*)(WR2 + (size_t)(4096 + idx) * 8) = ol;
        }
        __syncthreads();
        for (int un = F.vcu; un < 256 && !(args.pad & 4); un += F.G) {
            const int g = un >> 3, j = un & 7;
            LAS float* Ere = (LAS float*)F.lds; LAS float* Eim = Ere + 4 * 64;
            LAS float* Bbr = Eim + 4 * 64; LAS float* Bbi = Bbr + 1024;
            LAS float* Cr = Bbi + 1024; LAS float* Ci = Cr + 1024;
            LAS float* E6r = Ci + 1024; LAS float* E6i = E6r + 1024;
            const float dt = __expf(args.in[3][g]);
            if (F.tid < 64) { const int n = F.tid;
                const float are = fminf(args.in[4][g * 64 + n], -1e-4f), aim = args.in[5][g * 64 + n];
                const float mag = __expf(dt * are); float sn, cs; fcis(dt * aim, &sn, &cs);
                const float nr = mag * cs - 1.f, ni = mag * sn, dn = are * are + aim * aim;
                const float cfr = (nr * are + ni * aim) / dn, cfi = (ni * are - nr * aim) / dn;
                for (int q = 0; q < 16; ++q) { const float br = args.in[6][(g * 64 + n) * 16 + q], bi = args.in[7][(g * 64 + n) * 16 + q]; Bbr[n * 16 + q] = cfr * br - cfi * bi; Bbi[n * 16 + q] = cfr * bi + cfi * br; }
            }
            for (int i = F.tid; i < 1024; i += NTHR) { Cr[i] = args.in[8][g * 1024 + i]; Ci[i] = args.in[9][g * 1024 + i]; }
            if (F.tid < 256) { const int tl = F.tid >> 6, n = F.tid & 63; const float tau = (float)(4 * j + tl);
                const float are = fminf(args.in[4][g * 64 + n], -1e-4f), aim = args.in[5][g * 64 + n];
                const float mag = __expf(tau * dt * are); float sn, cs; fcis(tau * dt * aim, &sn, &cs); Ere[F.tid] = mag * cs; Eim[F.tid] = mag * sn; }
            for (int i = F.tid; i < 1024; i += NTHR) { const int tau = i >> 5, n = 32 * (j & 1) + (i & 31);
                const float are = fminf(args.in[4][g * 64 + n], -1e-4f), aim = args.in[5][g * 64 + n];
                const float mag = __expf((float)tau * dt * are); float sn, cs; fcis((float)tau * dt * aim, &sn, &cs); E6r[i] = mag * cs; E6i[i] = mag * sn; }
            __syncthreads();
            {
                const int tl = F.tid >> 7, p = (F.tid >> 3) & 15, q0 = (F.tid & 7) * 2;
                float a0 = 0.f, a1 = 0.f;
                for (int n = 0; n < 64; ++n) { const float cr = Cr[p * 64 + n], ci = Ci[p * 64 + n], er = Ere[tl * 64 + n], ei = Eim[tl * 64 + n];
                    const float xr = cr * er - ci * ei, xi = cr * ei + ci * er;
                    a0 += xr * Bbr[n * 16 + q0] - xi * Bbi[n * 16 + q0]; a1 += xr * Bbr[n * 16 + q0 + 1] - xi * Bbi[n * 16 + q0 + 1]; }
                KTAB[((size_t)g * S5L + 4 * j + tl) * 256 + p * 16 + q0] = a0; KTAB[((size_t)g * S5L + 4 * j + tl) * 256 + p * 16 + q0 + 1] = a1;
            }
            for (int ch = F.tid; ch < 32 * (S5KIN / 8); ch += NTHR) {
                const int rl = ch / (S5KIN / 8), c8 = ch % (S5KIN / 8), r = 32 * j + rl, n = r & 63, im = (r >> 6) & 1, col = c8 * 8, sidx = col >> 4, q0 = col & 15;
                const float er = E6r[(S5L - 1 - sidx) * 32 + (n & 31)], ei = E6i[(S5L - 1 - sidx) * 32 + (n & 31)];
                float v[8];
#pragma unroll
                for (int i = 0; i < 8; ++i) { const float br = Bbr[n * 16 + q0 + i], bi = Bbi[n * 16 + q0 + i]; v[i] = im ? (er * bi + ei * br) : (er * br - ei * bi); }
                u32x4 o; o.x = pk2(v[0], v[1]); o.y = pk2(v[2], v[3]); o.z = pk2(v[4], v[5]); o.w = pk2(v[6], v[7]);
                *(u32x4*)(S5BQ + ((size_t)g * 256 + r) * S5KIN + col) = o;
            }
            __syncthreads();
        }
        if (BOTH(0)) GRID_BAR();
    }
    if (IN(1)) {
        { int tq_ = F.wave * 64 + lane_id(); asm volatile("" : "+v"(tq_)); F.tid = tq_; F.lane = tq_ & 63; }
        pg::EpiProj E{PROJ, S5A};
        const int nrounds = ((T / 256) * (NPROJ / 256) + F.G - 1) / F.G, gper = (F.G >> 5) > 0 ? (F.G >> 5) : 1, grp = ((int)blockIdx.x >> 3) / gper;
        const int split = grp == 0 ? 0 : grp == 1 ? (2 * nrounds) / 5 : grp == 2 ? (3 * nrounds) / 5 : nrounds;
        constexpr int I_UP = (D / 64) * (2 * FF / 64);
        auto conv_up = [&]() {
            const int ln = lane_id();
            constexpr int I_DN = (FF / 64) * (D / 64), NUP = NE * I_UP, NIT = NUP + NE * I_DN; f32x4 va[16], vb[16];
#define CV_LOAD(v, it_) do { if ((it_) < NUP) tr8_load(v, args.in[21] + (size_t)((it_) / I_UP) * D * 2 * FF, 2 * FF, 2 * FF / 32, (it_) % I_UP, ln); \
        else tr8_load(v, args.in[23] + (size_t)(((it_) - NUP) / I_DN) * FF * D, D, D / 32, ((it_) - NUP) % I_DN, ln); } while (0)
#define CV_STORE(v, it_) do { if ((it_) < NUP) tr8_store(v, D, 2 * FF / 32, WUP8 + (size_t)((it_) / I_UP) * 2 * FF * D, (it_) % I_UP, ln, RowUp()); \
        else tr8_store(v, FF, D / 32, WDN8 + (size_t)(((it_) - NUP) / I_DN) * D * FF, ((it_) - NUP) % I_DN, ln, RowDn()); } while (0)
            int it = gw; if (it < NIT) CV_LOAD(va, it);
            for (; it < NIT; it += 2 * NGW) { const int it1 = it + NGW, it2 = it + 2 * NGW;
                if (it1 < NIT) CV_LOAD(vb, it1);
                CV_STORE(va, it);
                if (it2 < NIT) CV_LOAD(va, it2);
                if (it1 < NIT) CV_STORE(vb, it1); }
#undef CV_LOAD
#undef CV_STORE
        };
#pragma unroll 1
        for (int part = 0; part < 2; ++part) {
            pg::DenseSched S{(const char*)HN, (const char*)WIN, D * 2, D * 2, T / 256, NPROJ / 256, F.G, (int)blockIdx.x, part ? split : 0, part ? (1 << 30) : split};
            pg::gemm_phase<pg::EpiProj, pg::DenseSched, true>(F.lds, D, S, E, F.wave);
            if (part == 0 && !(args.pad & 1)) conv_up();
        }
        if (BOTH(1)) GRID_BAR();
    }
    if (IN(2)) {
        { int tq_ = F.wave * 64 + lane_id(); asm volatile("" : "+v"(tq_)); F.tid = tq_; F.lane = tq_ & 63; }
        pg::S5Sched S{(const char*)S5A, (const char*)S5BQ, S5K * 2, S5KIN * 2, 256, 1, F.G, F.vcu};
        pg::EpiXloc E{XLOC};
        pg::gemm_phase<pg::EpiXloc, pg::S5Sched, true>(F.lds, S5KIN, S, E, F.wave);
        {
            const int first = F.G > 128 ? F.vcu - 128 : F.vcu, stride = F.G > 128 ? F.G - 128 : F.G;
            LAS float* Kt = (LAS float*)F.lds;
            LAS float* Ere = Kt + S5L * 256; LAS float* Eim = Ere + 4 * 64;
            LAS float* Cr = Eim + 4 * 64; LAS float* Ci = Cr + 1024;
            for (int un = first; un >= 0 && un < 256; un += stride) {
                const int g = un >> 3, j = un & 7, ntau = 4 * j + 4;
                __syncthreads();
                for (int i = F.tid; i < ntau * 64; i += NTHR) *(LAS f32x4*)(Kt + 4 * i) = *(const f32x4*)(KTAB + (size_t)g * S5L * 256 + 4 * i);
                for (int i = F.tid; i < 1024; i += NTHR) { Cr[i] = args.in[8][g * 1024 + i]; Ci[i] = args.in[9][g * 1024 + i]; }
                if (F.tid < 256) { const int tl = F.tid >> 6, n = F.tid & 63; const float tau = (float)(4 * j + tl + 1); const float dt = __expf(args.in[3][g]);
                    const float are = fminf(args.in[4][g * 64 + n], -1e-4f), aim = args.in[5][g * 64 + n];
                    const float mag = __expf(tau * dt * are); float sn, cs; fcis(tau * dt * aim, &sn, &cs); Ere[F.tid] = mag * cs; Eim[F.tid] = mag * sn; }
                __syncthreads();
                for (int ch = F.tid; ch < 64 * (S5K / 8); ch += NTHR) {
                    const int rl = ch / (S5K / 8), c8 = ch % (S5K / 8), tl = rl >> 4, t = 4 * j + tl, p = rl & 15, col = c8 * 8;
                    float v[8];
                    if (col < S5KIN) { const int sidx = col >> 4, q0 = col & 15;
                        if (sidx <= t) { const f32x4 k0 = *(const LAS f32x4*)(Kt + (t - sidx) * 256 + p * 16 + q0), k1 = *(const LAS f32x4*)(Kt + (t - sidx) * 256 + p * 16 + q0 + 4);
                            v[0] = k0.x; v[1] = k0.y; v[2] = k0.z; v[3] = k0.w; v[4] = k1.x; v[5] = k1.y; v[6] = k1.z; v[7] = k1.w; }
                        else {
#pragma unroll
                            for (int i = 0; i < 8; ++i) v[i] = 0.f; }
                    } else { const int jj = (col - S5KIN) & 63, im = (col - S5KIN) >> 6;
#pragma unroll
                        for (int i = 0; i < 8; ++i) { const int n = jj + i; const float cr = Cr[p * 64 + n], ci = Ci[p * 64 + n], er = Ere[tl * 64 + n], ei = Eim[tl * 64 + n];
                            v[i] = im ? -(cr * ei + ci * er) : (cr * er - ci * ei); } }
                    u32x4 o; o.x = pk2(v[0], v[1]); o.y = pk2(v[2], v[3]); o.z = pk2(v[4], v[5]); o.w = pk2(v[6], v[7]);
                    *(u32x4*)(S5BT + ((size_t)g * S5KIN + 64 * j + rl) * S5K + col) = o;
                }
            }
            __syncthreads();
        }
    }
    if (IN(3)) {
        { int tq_ = F.wave * 64 + lane_id(); asm volatile("" : "+v"(tq_)); F.tid = tq_; F.lane = tq_ & 63; }
        typedef short s16x4 __attribute__((ext_vector_type(4)));
        LAS float* wsl = (LAS float*)F.lds;
        LAS float* red = wsl + 512;
        LAS float* dnl = red + 32;
        LAS bf16* RQ = (LAS bf16*)(F.lds + 4352);
        LAS bf16* RK = RQ + 67 * 136;
        LAS bf16* RV = RK + 67 * 136;
        LAS bf16* QN = RV + 64 * 136;
        LAS bf16* KN = QN + 64 * 136;
        LAS bf16* KTl = KN + 64 * 136;
        LAS bf16* VTl = KTl + 128 * 72;
        const float* cw = args.in[13]; const float* cbias = args.in[14];
        for (int un = blockIdx.x; un < 256; un += F.G) {
            const int bh = un >> 4, seg = un & 15, b = bh >> 2, hd = bh & 3, t0 = seg * 512; const size_t row0 = (size_t)b * SEQ + t0;
            float Fl, Aval;
            {
                const float ipre = gates[(row0 + F.tid) * 8 + hd], fpre = gates[(row0 + F.tid) * 8 + 4 + hd];
                const float lf = fminf(fpre, 0.f) - log1pf(__expf(-fabsf(fpre)));
                float sc = lf;
#pragma unroll
                for (int o = 1; o < 64; o <<= 1) { const float tv = __shfl_up(sc, o); if (F.lane >= o) sc += tv; }
                if (F.lane == 63) red[F.wave] = sc;
                __syncthreads();
                float base = 0.f;
                for (int w2 = 0; w2 < F.wave; ++w2) base += red[w2];
                Fl = sc + base; Aval = ipre - Fl;
                float mx = Aval;
#pragma unroll
                for (int o = 1; o < 64; o <<= 1) mx = fmaxf(mx, __shfl_xor(mx, o));
                if (F.lane == 0) red[8 + F.wave] = mx;
                __syncthreads();
                float Amax = red[8];
                for (int w2 = 1; w2 < 8; ++w2) Amax = fmaxf(Amax, red[8 + w2]);
                wsl[F.tid] = __expf(Aval - Amax);
                FLOC[(size_t)bh * SEQ + t0 + F.tid] = Fl;
                if (F.tid == 511) { SEGS[un * 4 + 0] = Fl; SEGS[un * 4 + 1] = Amax; }
            }
            f32x16 dacc[2];
#pragma unroll
            for (int i = 0; i < 2; ++i)
#pragma unroll
                for (int q = 0; q < 16; ++q) dacc[i][q] = 0.f;
            const int cp = F.tid & 127, isk = cp >> 6, c2 = (cp & 63) * 2, tqr = F.tid >> 7;
            const int gch = isk * 512 + hd * 128 + c2;
            const float cw0a = cw[gch], cw1a = cw[1024 + gch], cw2a = cw[2048 + gch], cw3a = cw[3072 + gch], cba = cbias[gch];
            const float cw0b = cw[gch + 1], cw1b = cw[1024 + gch + 1], cw2b = cw[2048 + gch + 1], cw3b = cw[3072 + gch + 1], cbb = cbias[gch + 1];
            float dnacc0 = 0.f, dnacc1 = 0.f;
            u32x4 rt[7];
#define ML_RAW_LOAD(tsv) do { _Pragma("unroll") for (int ii = 0; ii < 7; ++ii) { const int ch = F.tid + NTHR * ii; u32x4 v = (u32x4){0u, 0u, 0u, 0u}; \
                if (ch < 2 * 67 * 16) { const int which = ch / (67 * 16), r = (ch % (67 * 16)) >> 4, c16 = ch & 15; const int tk = (tsv) - 3 + r; \
                    if (tk >= 0) v = *(const u32x4*)(PROJ + ((size_t)((which ? 16 : 0) + bh) * SEQ + tk) * 128 + c16 * 8); } \
                else if (ch < 2 * 67 * 16 + 64 * 16) { const int c2 = ch - 2 * 67 * 16, r = c2 >> 4, c16 = c2 & 15; v = *(const u32x4*)(PROJ + ((size_t)(32 + bh) * SEQ + (tsv) + r) * 128 + c16 * 8); } \
                rt[ii] = v; } } while (0)
            ML_RAW_LOAD(t0);
#define ML_RAW_STORE() do { _Pragma("unroll") for (int ii = 0; ii < 7; ++ii) { const int ch = F.tid + NTHR * ii; \
                if (ch < 2 * 67 * 16) { const int which = ch / (67 * 16), r = (ch % (67 * 16)) >> 4, c16 = ch & 15; *(LAS u32x4*)((which ? RK : RQ) + r * 136 + c16 * 8) = rt[ii]; } \
                else if (ch < 2 * 67 * 16 + 64 * 16) { const int c2_ = ch - 2 * 67 * 16, r = c2_ >> 4, c16 = c2_ & 15; *(LAS u32x4*)(RV + r * 136 + c16 * 8) = rt[ii]; } } } while (0)
            __syncthreads();
            ML_RAW_STORE(); ML_RAW_LOAD(t0 + 64);
            __syncthreads();
            for (int sb = 0; sb < 8; ++sb) {
                const int ts = t0 + sb * 64;
                {
                    const LAS unsigned* raw = (const LAS unsigned*)(isk ? RK : RQ) + c2 / 2; LAS unsigned* dst = (LAS unsigned*)(isk ? KN : QN) + c2 / 2; const int s0 = tqr * 16;
                    const unsigned h0 = raw[(s0 + 0) * 68], h1 = raw[(s0 + 1) * 68], h2 = raw[(s0 + 2) * 68];
                    float x3a = lo_bf(h0), x3b = hi_bf(h0), x2a = lo_bf(h1), x2b = hi_bf(h1), x1a = lo_bf(h2), x1b = hi_bf(h2);
#pragma unroll 4
                    for (int sidx = s0; sidx < s0 + 16; ++sidx) {
                        const unsigned xw = raw[(sidx + 3) * 68]; const float xa = lo_bf(xw), xb = hi_bf(xw);
                        float va = cba + cw0a * x3a + cw1a * x2a + cw2a * x1a + cw3a * xa, vb = cbb + cw0b * x3b + cw1b * x2b + cw2b * x1b + cw3b * xb;
                        x3a = x2a; x2a = x1a; x1a = xa; x3b = x2b; x2b = x1b; x1b = xb;
                        va *= sigmoidf_(va); vb *= sigmoidf_(vb);
                        if (isk) { const float wk = 0.08838834764831845f * wsl[sb * 64 + sidx]; va *= wk; vb *= wk; dnacc0 += va; dnacc1 += vb; }
                        dst[sidx * 68] = cvt_pk_bf16(va, vb);
                    }
                }
                __syncthreads();
#pragma unroll
                for (int ii = 0; ii < 2; ++ii) { const int ch = F.tid + NTHR * ii, r = ch >> 4, c16 = ch & 15;
                    *(u32x4*)(QH + ((size_t)bh * SEQ + ts + r) * 128 + c16 * 8) = *(const LAS u32x4*)(QN + r * 136 + c16 * 8);
                    *(u32x4*)(KH + ((size_t)bh * SEQ + ts + r) * 128 + c16 * 8) = *(const LAS u32x4*)(KN + r * 136 + c16 * 8); }
                {
                    const int c = F.tid & 127, sq = F.tid >> 7;
#pragma unroll
                    for (int half = 0; half < 2; ++half) { const int sA = sq * 16 + half * 8;
                        u32x4 kk, vv;
                        kk.x = (unsigned)KN[(sA + 0) * 136 + c] | ((unsigned)KN[(sA + 1) * 136 + c] << 16); kk.y = (unsigned)KN[(sA + 2) * 136 + c] | ((unsigned)KN[(sA + 3) * 136 + c] << 16);
                        kk.z = (unsigned)KN[(sA + 4) * 136 + c] | ((unsigned)KN[(sA + 5) * 136 + c] << 16); kk.w = (unsigned)KN[(sA + 6) * 136 + c] | ((unsigned)KN[(sA + 7) * 136 + c] << 16);
                        vv.x = (unsigned)RV[(sA + 0) * 136 + c] | ((unsigned)RV[(sA + 1) * 136 + c] << 16); vv.y = (unsigned)RV[(sA + 2) * 136 + c] | ((unsigned)RV[(sA + 3) * 136 + c] << 16);
                        vv.z = (unsigned)RV[(sA + 4) * 136 + c] | ((unsigned)RV[(sA + 5) * 136 + c] << 16); vv.w = (unsigned)RV[(sA + 6) * 136 + c] | ((unsigned)RV[(sA + 7) * 136 + c] << 16);
                        *(LAS u32x4*)(KTl + c * 72 + sA) = kk; *(LAS u32x4*)(VTl + c * 72 + sA) = vv; }
                }
                __syncthreads();
                {
                    const int e = F.tid >> 3, ck = F.tid & 7;
                    const u32x4 v0 = *(const LAS u32x4*)(VTl + e * 72 + ck * 8), v1 = *(const LAS u32x4*)(VTl + (e + 64) * 72 + ck * 8);
                    bf16* dst = VT + ((size_t)bh * 128 + e) * SEQ + ts + ck * 8;
                    *(u32x4*)dst = v0; *(u32x4*)(dst + (size_t)64 * SEQ) = v1;
                    const int eb = F.wave >> 1, db0 = (F.wave & 1) * 2, r = F.lane & 31, hh = F.lane >> 5;
#pragma unroll
                    for (int ks = 0; ks < 4; ++ks) {
                        const bf16x8 a = *(const LAS bf16x8*)(VTl + (eb * 32 + r) * 72 + ks * 16 + hh * 8);
                        const bf16x8 b0 = *(const LAS bf16x8*)(KTl + (db0 * 32 + r) * 72 + ks * 16 + hh * 8), b1 = *(const LAS bf16x8*)(KTl + ((db0 + 1) * 32 + r) * 72 + ks * 16 + hh * 8);
                        dacc[0] = __builtin_amdgcn_mfma_f32_32x32x16_bf16(a, b0, dacc[0], 0, 0, 0);
                        dacc[1] = __builtin_amdgcn_mfma_f32_32x32x16_bf16(a, b1, dacc[1], 0, 0, 0);
                    }
                }
                if (sb < 7) { ML_RAW_STORE(); if (sb < 6) ML_RAW_LOAD(ts + 128); }
                __syncthreads();
            }
#undef ML_RAW_STORE
#undef ML_RAW_LOAD
            if (isk) { dnl[tqr * 128 + c2] = dnacc0; dnl[tqr * 128 + c2 + 1] = dnacc1; }
            {
                const int eb = F.wave >> 1, db0 = (F.wave & 1) * 2, r = F.lane & 31, hh = F.lane >> 5;
#pragma unroll
                for (int i = 0; i < 2; ++i)
#pragma unroll
                    for (int q = 0; q < 16; ++q) DC[((size_t)un * 128 + eb * 32 + (q & 3) + 8 * (q >> 2) + 4 * hh) * 128 + (db0 + i) * 32 + r] = dacc[i][q];
            }
            __syncthreads();
            if (F.tid < 128) DN[un * 128 + F.tid] = (dnl[F.tid] + dnl[128 + F.tid]) + (dnl[256 + F.tid] + dnl[384 + F.tid]);
            __syncthreads();
        }
        if (BOTH(3)) GRID_BAR();
    }
    if (IN(4)) {
        { int tq_ = F.wave * 64 + lane_id(); asm volatile("" : "+v"(tq_)); F.tid = tq_; F.lane = tq_ & 63; }
        LAS float* agr = (LAS float*)F.lds; LAS float* agi = agr + 512;
        for (int un = blockIdx.x; un < 128; un += F.G) {
            const int b = un >> 5, g = un & 31, n = F.tid & 63, seg = F.tid >> 6;
            const float dt = __expf(args.in[3][g]);
            const float are = fminf(args.in[4][g * 64 + n], -1e-4f), aim = args.in[5][g * 64 + n];
            float ar, ai, Ar, Ai;
            { const float mag = __expf((float)S5L * dt * are); float sn, cs; fcis((float)S5L * dt * aim, &sn, &cs); ar = mag * cs; ai = mag * sn; }
            { const float mag = __expf((float)(S5L * 32) * dt * are); float sn, cs; fcis((float)(S5L * 32) * dt * aim, &sn, &cs); Ar = mag * cs; Ai = mag * sn; }
            const size_t row0 = (size_t)g * S5ROWS + b * S5NCH + seg * 32;
            float xr[32], xi[32];
#pragma unroll
            for (int jj = 0; jj < 32; ++jj) { xr[jj] = XLOC[(row0 + jj) * 128 + n]; xi[jj] = XLOC[(row0 + jj) * 128 + 64 + n]; }
            float sr = 0.f, si = 0.f;
#pragma unroll
            for (int jj = 0; jj < 32; ++jj) { const float tr = ar * sr - ai * si + xr[jj], ti = ar * si + ai * sr + xi[jj]; sr = tr; si = ti; }
            agr[seg * 64 + n] = sr; agi[seg * 64 + n] = si;
            __syncthreads();
            float cr = 0.f, ci = 0.f;
            for (int s2 = 0; s2 < seg; ++s2) { const float tr = Ar * cr - Ai * ci + agr[s2 * 64 + n], ti = Ar * ci + Ai * cr + agi[s2 * 64 + n]; cr = tr; ci = ti; }
#pragma unroll
            for (int jj = 0; jj < 32; ++jj) {
                S5A[(row0 + jj) * S5K + S5KIN + n] = f2bf(cr); S5A[(row0 + jj) * S5K + S5KIN + 64 + n] = f2bf(ci);
                const float tr = ar * cr - ai * ci + xr[jj], ti = ar * ci + ai * cr + xi[jj]; cr = tr; ci = ti; }
            __syncthreads();
        }
        for (int un = blockIdx.x; un < 256; un += F.G) {
            const int bh = un >> 4, slice = un & 15;
            float dc0[16], dc1[16];
#pragma unroll
            for (int j = 0; j < 16; ++j) { dc0[j] = DC[((size_t)(bh * 16 + j)) * 16384 + slice * 1024 + F.tid]; dc1[j] = DC[((size_t)(bh * 16 + j)) * 16384 + slice * 1024 + 512 + F.tid]; }
            float dn[16];
            const bool nrole = (slice == 0 && F.tid < 128);
#pragma unroll
            for (int j = 0; j < 16; ++j) dn[j] = nrole ? DN[(bh * 16 + j) * 128 + F.tid] : 0.f;
            float m = 0.f, C0 = 0.f, C1 = 0.f, nn = 0.f;
#pragma unroll
            for (int j = 0; j < 16; ++j) {
                const float Fend = SEGS[(bh * 16 + j) * 4 + 0], Amax = SEGS[(bh * 16 + j) * 4 + 1];
                const float R = fmaxf(m, Amax), c1 = __expf(m - R), c2 = __expf(Amax - R);
                CST[((size_t)(bh * 16 + j)) * 16384 + slice * 1024 + F.tid] = f2bf(c1 * C0); CST[((size_t)(bh * 16 + j)) * 16384 + slice * 1024 + 512 + F.tid] = f2bf(c1 * C1);
                if (nrole) NST[(bh * 16 + j) * 128 + F.tid] = c1 * nn;
                if (slice == 0 && F.tid == 0) { SEGS[(bh * 16 + j) * 4 + 2] = R; SEGS[(bh * 16 + j) * 4 + 3] = c2; }
                C0 = c1 * C0 + c2 * dc0[j]; C1 = c1 * C1 + c2 * dc1[j]; nn = c1 * nn + c2 * dn[j]; m = Fend + R;
            }
        }
        if (BOTH(4)) GRID_BAR();
    }
    if (IN(5)) {
        { int tq_ = F.wave * 64 + lane_id(); asm volatile("" : "+v"(tq_)); F.tid = tq_; F.lane = tq_ & 63; }
        pg::S5Sched S{(const char*)S5A, (const char*)S5BT, S5K * 2, S5K * 2, S5KIN, 2, F.G, F.vcu};
        pg::EpiS5Y E{S5A, args.in[10], GY};
        pg::gemm_phase<pg::EpiS5Y, pg::S5Sched, true>(F.lds, S5K, S, E, F.wave);
        if (BOTH(5)) GRID_BAR();
    }
    if (IN(6)) {
        { int tq_ = F.wave * 64 + lane_id(); asm volatile("" : "+v"(tq_)); F.tid = tq_; F.lane = tq_ & 63; }
        typedef short s16x4 __attribute__((ext_vector_type(4)));
        LAS unsigned char* Kl = F.lds;
        LAS unsigned char* Vl = Kl + 3 * 16384;
        LAS unsigned char* Cl = Vl + 3 * 16384;
        LAS float* nl = (LAS float*)(F.lds + IDX_OFF);
        LAS float* fll = nl + 128;
        LAS float* gl = fll + 512;
        const float* ng = args.in[16];
        for (int un = blockIdx.x; un < 256; un += F.G) {
            const int tid6 = F.wave * 64 + lane_id();
            const int lane6 = tid6 & 63;
            const int bh = un >> 4, seg = un & 15, b = bh >> 2, hd = bh & 3, t0 = seg * 512;
            const float R = SEGS[un * 4 + 2], c2 = SEGS[un * 4 + 3];
            __syncthreads();
            for (int ch = tid6; ch < 2048; ch += NTHR) { const int r = ch >> 4, c16 = ch & 15; *(LAS u32x4*)(Cl + r * 256 + ((c16 ^ (r & 15)) << 4)) = *(const u32x4*)(CST + (size_t)un * 16384 + r * 128 + c16 * 8); }
            if (tid6 < 128) { nl[tid6] = NST[un * 128 + tid6]; gl[tid6] = ng[hd * 128 + tid6]; }
            fll[tid6] = FLOC[(size_t)bh * SEQ + t0 + tid6];
            const int r = lane6 & 31, hh = lane6 >> 5;
            for (int pass = 0; pass < 2; ++pass) {
                const int qb = pass == 0 ? F.wave : 15 - F.wave, jmax = qb >> 1, npj = pass == 0 ? 4 : 8;
                bf16x8 Q[8];
                { const bf16* qp = QH + ((size_t)bh * SEQ + t0 + qb * 32 + r) * 128 + hh * 8;
#pragma unroll
                  for (int ks = 0; ks < 8; ++ks) Q[ks] = *(const bf16x8*)(qp + ks * 16); }
#define MLD_DMA(jb) do { const __amdgpu_buffer_rsrc_t rK = pg::mkrsrc(KH), rV = pg::mkrsrc(VT); const int slot_ = (jb) % 3; const int kso_ = (int)(((unsigned)bh * SEQ + t0 + (jb) * 64) * 256u), vso_ = (int)(((unsigned)bh * 128u * SEQ + t0 + (jb) * 64) * 2u); \
                    int lz_ = lane6; asm volatile("" : "+v"(lz_));     \
                    _Pragma("unroll") for (int ii_ = 0; ii_ < 2; ++ii_) { const int p_ = (F.wave * 2 + ii_) * 64 + lz_; \
                        { const int row_ = p_ >> 4, c_ = (p_ & 15) ^ (row_ & 15); __builtin_amdgcn_raw_ptr_buffer_load_lds(rK, (LAS void*)(Kl + slot_ * 16384 + (F.wave * 2 + ii_) * 1024), 16, row_ * 256 + c_ * 16, kso_, 0, 0); } \
                        { const int row_ = p_ >> 3, c_ = (p_ & 7) ^ (row_ & 7); __builtin_amdgcn_raw_ptr_buffer_load_lds(rV, (LAS void*)(Vl + slot_ * 16384 + (F.wave * 2 + ii_) * 1024), 16, row_ * (SEQ * 2) + c_ * 16, vso_, 0, 0); } } } while (0)
                f32x16 acc[4];
#pragma unroll
                for (int eb = 0; eb < 4; ++eb)
#pragma unroll
                    for (int q = 0; q < 16; ++q) acc[eb][q] = 0.f;
                __syncthreads();
                MLD_DMA(0); MLD_DMA(1);
#pragma unroll
                for (int eb = 0; eb < 4; ++eb) {
                    int ry = r; asm volatile("" : "+v"(ry));
#pragma unroll
                    for (int ks = 0; ks < 8; ++ks) { const bf16x8 a = *(const LAS bf16x8*)(Cl + (eb * 32 + ry) * 256 + (((2 * ks + hh) ^ (ry & 15)) << 4)); acc[eb] = __builtin_amdgcn_mfma_f32_32x32x16_bf16(a, Q[ks], acc[eb], 0, 0, 0); }
                    __builtin_amdgcn_sched_barrier(0);
                }
                float den = 0.f;
#pragma unroll
                for (int ks = 0; ks < 8; ++ks) {
#pragma unroll
                    for (int jj = 0; jj < 8; ++jj) den += nl[ks * 16 + hh * 8 + jj] * bf2f((bf16)Q[ks][jj]);
                    __builtin_amdgcn_sched_barrier(0);
                }
                float dsum = 0.f;
                for (int j = 0; j < npj; ++j) {
                    const LAS unsigned char* Kb = Kl + (j % 3) * 16384; const LAS unsigned char* Vb = Vl + (j % 3) * 16384;
                    if (j + 1 < npj) asm volatile("s_waitcnt vmcnt(4)" ::: "memory"); else asm volatile("s_waitcnt vmcnt(0)" ::: "memory");
                    LDS_BARRIER();
                    if (j + 2 < npj) MLD_DMA(j + 2);
                    if (j <= jmax) {
                        int rx = r; asm volatile("" : "+v"(rx));
                        const bool diag = (j == jmax); const int tq = qb * 32 + r;
#pragma unroll
                        for (int sb = 0; sb < 2; ++sb) {
                            f32x16 st;
#pragma unroll
                            for (int q = 0; q < 16; ++q) st[q] = 0.f;
#pragma unroll
                            for (int ks = 0; ks < 8; ++ks) { const bf16x8 a = *(const LAS bf16x8*)(Kb + (sb * 32 + rx) * 256 + (((2 * ks + hh) ^ (rx & 15)) << 4)); st = __builtin_amdgcn_mfma_f32_32x32x16_bf16(a, Q[ks], st, 0, 0, 0); }
                            bf16x8 pb[2];
#pragma unroll
                            for (int sp = 0; sp < 2; ++sp) {
                                float pv[8];
#pragma unroll
                                for (int jj = 0; jj < 8; ++jj) { const int q = 8 * sp + jj; const int sidx = j * 64 + sb * 32 + (q & 3) + 8 * (q >> 2) + 4 * hh;
                                    float p = st[q] * c2; if (diag && sidx > tq) p = 0.f; pv[jj] = p; dsum += p; }
                                u32x4 w; w.x = cvt_pk_bf16(pv[0], pv[1]); w.y = cvt_pk_bf16(pv[2], pv[3]); w.z = cvt_pk_bf16(pv[4], pv[5]); w.w = cvt_pk_bf16(pv[6], pv[7]);
                                pb[sp] = __builtin_bit_cast(bf16x8, w);
                            }
#pragma unroll
                            for (int eb = 0; eb < 4; ++eb)
#pragma unroll
                                for (int sp = 0; sp < 2; ++sp) {
                                    const int c0 = 4 * sb + 2 * sp;
                                    const s16x4 lo = *(const LAS s16x4*)(Vb + (eb * 32 + rx) * 128 + ((c0 ^ (rx & 7)) << 4) + 8 * hh), hi = *(const LAS s16x4*)(Vb + (eb * 32 + rx) * 128 + (((c0 + 1) ^ (rx & 7)) << 4) + 8 * hh);
                                    const bf16x8 a = __builtin_shufflevector(lo, hi, 0, 1, 2, 3, 4, 5, 6, 7);
                                    acc[eb] = __builtin_amdgcn_mfma_f32_32x32x16_bf16(a, pb[sp], acc[eb], 0, 0, 0);
                                }
                            __builtin_amdgcn_sched_barrier(0);
                        }
                    }
                }
                den += dsum; den += __shfl_xor(den, 32);
                const float flo = __expf(-fll[qb * 32 + r] - R);
                const float inv = 1.f / fmaxf(fabsf(den), flo);
                float s1 = 0.f;
#pragma unroll
                for (int eb = 0; eb < 4; ++eb)
#pragma unroll
                    for (int q = 0; q < 16; ++q) { acc[eb][q] *= inv; s1 += acc[eb][q]; }
                s1 += __shfl_xor(s1, 32);
                const float mu = s1 * (1.f / 128.f);
                float s2 = 0.f;
#pragma unroll
                for (int eb = 0; eb < 4; ++eb)
#pragma unroll
                    for (int q = 0; q < 16; ++q) { const float dlt = acc[eb][q] - mu; s2 += dlt * dlt; }
                s2 += __shfl_xor(s2, 32);
                const float rstd = rsqrtf(s2 * (1.f / 128.f) + 1e-6f);
                const size_t row = (size_t)b * SEQ + t0 + qb * 32 + r;
                const bf16* op = PROJ + ((size_t)(48 + bh) * SEQ + t0 + qb * 32 + r) * 128 + 8 * hh;
                u32x4 ovv[8];
                LAS unsigned char* ot = (F.wave < 4 ? Kl : Vl) + ((F.wave & 3) < 2 ? (pass == 0 ? 1 : 0) : 2) * 16384 + (F.wave & 1) * 8192;
#pragma unroll
                for (int eb = 0; eb < 4; ++eb)
#pragma unroll
                    for (int gp = 0; gp < 2; ++gp) ovv[eb * 2 + gp] = *(const u32x4*)(op + eb * 32 + 16 * gp);
#pragma unroll
                for (int eb = 0; eb < 4; ++eb)
#pragma unroll
                    for (int gp = 0; gp < 2; ++gp) {
                        const u32x4 L = ovv[eb * 2 + gp];
                        const u32x2 gx = __builtin_amdgcn_permlane32_swap(L.x, L.z, false, false), gy = __builtin_amdgcn_permlane32_swap(L.y, L.w, false, false);
                        u32x2 wv[2];
#pragma unroll
                        for (int k = 0; k < 2; ++k) {
                            const int g4 = 2 * gp + k, e0 = eb * 32 + 8 * g4 + 4 * hh;
                            const unsigned ox = k ? gx.y : gx.x, oy = k ? gy.y : gy.x;
                            const f32x4 gg = *(const LAS f32x4*)(gl + e0);
                            const float o0 = (acc[eb][4 * g4 + 0] - mu) * rstd * gg.x * sigmoidf_(lo_bf(ox)), o1 = (acc[eb][4 * g4 + 1] - mu) * rstd * gg.y * sigmoidf_(hi_bf(ox));
                            const float o2 = (acc[eb][4 * g4 + 2] - mu) * rstd * gg.z * sigmoidf_(lo_bf(oy)), o3 = (acc[eb][4 * g4 + 3] - mu) * rstd * gg.w * sigmoidf_(hi_bf(oy));
                            wv[k].x = cvt_pk_bf16(o0, o1); wv[k].y = cvt_pk_bf16(o2, o3);
                        }
                        const u32x2 px = __builtin_amdgcn_permlane32_swap(wv[0].x, wv[1].x, false, false), py = __builtin_amdgcn_permlane32_swap(wv[0].y, wv[1].y, false, false);
                        u32x4 w; w.x = px.x; w.y = py.x; w.z = px.y; w.w = py.y;
                        { const int c = eb * 4 + 2 * gp + hh; *(LAS u32x4*)(ot + r * 256 + ((c ^ (r & 15)) << 4)) = w; }
                    }
                { int lz_ = lane6; asm volatile("" : "+v"(lz_)); const int c = lz_ & 15; bf16* mp = MIX + (row - r) * D + 512 + hd * 128 + c * 8;
#pragma unroll
                  for (int t = 0; t < 8; ++t) { const int R = 4 * t + (lz_ >> 4); *(u32x4*)(mp + (size_t)R * D) = *(const LAS u32x4*)(ot + R * 256 + ((c ^ (R & 15)) << 4)); } }
            }
        }
    }
#undef MLD_DMA
    if (IN(7)) {
        { int tq_ = F.wave * 64 + lane_id(); asm volatile("" : "+v"(tq_)); F.tid = tq_; F.lane = tq_ & 63; }
        pg::DenseSched S{(const char*)GY, (const char*)WGLU, 512 * 2, 512 * 2, T / 256, 2, F.G, (int)blockIdx.x, 0, 1 << 30};
        pg::EpiGlu E{GY, args.in[12], MIX, F.lds + XT_OFF};
        pg::gemm_phase<pg::EpiGlu, pg::DenseSched, true>(F.lds, 512, S, E, F.wave);
        if (BOTH(7)) GRID_BAR();
    }
    if (IN(8)) {
        { int tq_ = F.wave * 64 + lane_id(); asm volatile("" : "+v"(tq_)); F.tid = tq_; F.lane = tq_ & 63; }
        pg::DenseSched S{(const char*)MIX, (const char*)WOUT, D * 2, D * 2, T / 256, D / 256, F.G, (int)blockIdx.x, 0, 1 << 30};
        pg::EpiOut E{x, H, F.lds + XT_OFF};
        pg::gemm_phase<pg::EpiOut, pg::DenseSched, true>(F.lds, D, S, E, F.wave);
        if (BOTH(8)) GRID_BAR();
    }
    if (IN(9)) {
        { int tq_ = F.wave * 64 + lane_id(); asm volatile("" : "+v"(tq_)); F.tid = tq_; F.lane = tq_ & 63; }
        const float* gf = args.in[18]; const float* w_r = args.in[19]; const float* b_r = args.in[20];
        LAS float* rs = (LAS float*)(F.lds);
        LAS float* part = (LAS float*)(F.lds + 1024);
        LAS int* hist = (LAS int*)(F.lds + 1024 + 2 * 128 * 33 * 4);
        LAS int* wgb = hist + 32; LAS int* exl = hist + 64; LAS int* rkl = exl + 512;
        for (int tb = blockIdx.x; tb < T / 128; tb += F.G) {
            const int row0 = tb * 128;
            if (F.tid < 32) hist[F.tid] = 0;
            {
                f32x4 gg[4];
#pragma unroll
                for (int jq = 0; jq < 4; ++jq) gg[jq] = *(const f32x4*)(gf + 4 * F.lane + 256 * jq);
                f32x4 nx[4];
#pragma unroll
                for (int jq = 0; jq < 4; ++jq) nx[jq] = ldbf4(H + (size_t)(row0 + F.wave * 16) * D + 4 * F.lane + 256 * jq);
                for (int rr = 0; rr < 16; ++rr) {
                    const int r = F.wave * 16 + rr;
                    f32x4 v[4];
#pragma unroll
                    for (int jq = 0; jq < 4; ++jq) v[jq] = nx[jq];
                    if (rr < 15) {
#pragma unroll
                        for (int jq = 0; jq < 4; ++jq) nx[jq] = ldbf4(H + (size_t)(row0 + r + 1) * D + 4 * F.lane + 256 * jq); }
                    float ss = 0.f;
#pragma unroll
                    for (int jq = 0; jq < 4; ++jq) ss += v[jq].x * v[jq].x + v[jq].y * v[jq].y + v[jq].z * v[jq].z + v[jq].w * v[jq].w;
                    ss = wave_sum(ss);
                    const float rstd = rsqrtf(ss * (1.f / D) + 1e-5f);
                    if (F.lane == 0) rs[r] = rstd;
#pragma unroll
                    for (int jq = 0; jq < 4; ++jq) *(unsigned*)(HN8 + (size_t)(row0 + r) * D + 4 * F.lane + 256 * jq) = pk4_fp8(v[jq].x * rstd * gg[jq].x, v[jq].y * rstd * gg[jq].y, v[jq].z * rstd * gg[jq].z, v[jq].w * rstd * gg[jq].w);
                }
            }
            {
                const int rg = F.wave & 3, kh = F.wave >> 2, i = F.lane & 31, hh = F.lane >> 5, lr = F.lane >> 3, lc = F.lane & 7;
                f32x16 acc;
#pragma unroll
                for (int q = 0; q < 16; ++q) acc[q] = 0.f;
                LAS unsigned char* tw0 = F.lds + 40960 + F.wave * 9216;
                const bf16* hrow = H + (size_t)(row0 + rg * 32 + lr) * D + kh * 512 + 8 * lc;
                const bf16* bp = WR2 + ((size_t)(kh * 32) * 64 + F.lane) * 8;
                u32x4 ld[4]; bf16x8 bh[4], bl[4], nbh[4], nbl[4];
#pragma unroll
                for (int t = 0; t < 4; ++t) ld[t] = *(const u32x4*)(hrow + (size_t)(8 * t) * D);
#pragma unroll
                for (int u = 0; u < 4; ++u) { bh[u] = *(const bf16x8*)(bp + (size_t)u * 512); bl[u] = *(const bf16x8*)(bp + (size_t)(4096 * 8) + (size_t)u * 512); }
                for (int w = 0; w < 8; ++w) {
                    LAS unsigned char* tw = tw0 + (w & 1) * 4608;
#pragma unroll
                    for (int t = 0; t < 4; ++t) *(LAS u32x4*)(tw + ((8 * t + lr) * 9 + lc) * 16) = ld[t];
                    if (w + 1 < 8) {
#pragma unroll
                        for (int t = 0; t < 4; ++t) ld[t] = *(const u32x4*)(hrow + (size_t)(8 * t) * D + 64 * (w + 1));
#pragma unroll
                        for (int u = 0; u < 4; ++u) { const int ss = 4 * (w + 1) + u; nbh[u] = *(const bf16x8*)(bp + (size_t)ss * 512); nbl[u] = *(const bf16x8*)(bp + (size_t)(4096 * 8) + (size_t)ss * 512); } }
#pragma unroll
                    for (int u = 0; u < 4; ++u) { const bf16x8 a = *(const LAS bf16x8*)(tw + (i * 9 + 2 * u + hh) * 16);
                        acc = __builtin_amdgcn_mfma_f32_32x32x16_bf16(a, bh[u], acc, 0, 0, 0); acc = __builtin_amdgcn_mfma_f32_32x32x16_bf16(a, bl[u], acc, 0, 0, 0); }
                    if (w + 1 < 8) {
#pragma unroll
                        for (int u = 0; u < 4; ++u) { bh[u] = nbh[u]; bl[u] = nbl[u]; } }
                }
#pragma unroll
                for (int q = 0; q < 16; ++q) { const int r = rg * 32 + (q & 3) + 8 * (q >> 2) + 4 * hh; part[(kh * 128 + r) * 33 + i] = acc[q]; }
            }
            __syncthreads();
            {
                const int r = F.tid >> 2, qd = F.tid & 3; const float rstd = rs[r];
                float lg[8];
#pragma unroll
                for (int j = 0; j < 8; ++j) { const int e = 8 * qd + j; lg[j] = (part[r * 33 + e] + part[(128 + r) * 33 + e]) * rstd + b_r[e]; }
                float best[4]; int bi[4];
#pragma unroll
                for (int k = 0; k < 4; ++k) {
                    float bv = lg[0]; int be = 8 * qd;
#pragma unroll
                    for (int j = 1; j < 8; ++j) if (lg[j] > bv) { bv = lg[j]; be = 8 * qd + j; }
#pragma unroll
                    for (int o = 1; o < 4; o <<= 1) { const float ov = __shfl_xor(bv, o); const int oe = __shfl_xor(be, o); if (ov > bv || (ov == bv && oe < be)) { bv = ov; be = oe; } }
                    best[k] = bv; bi[k] = be;
#pragma unroll
                    for (int j = 0; j < 8; ++j) if (8 * qd + j == be) lg[j] = -INFINITY;
                }
                if (qd == 0) {
                    const float e1 = __expf(best[1] - best[0]), e2 = __expf(best[2] - best[0]), e3 = __expf(best[3] - best[0]);
                    const float inv = 1.f / (1.f + e1 + e2 + e3);
                    *(int4*)(topi + (size_t)(row0 + r) * 4) = make_int4(bi[0], bi[1], bi[2], bi[3]);
                    *(f32x4*)(topg + (size_t)(row0 + r) * 4) = (f32x4){inv, e1 * inv, e2 * inv, e3 * inv};
#pragma unroll
                    for (int k = 0; k < 4; ++k) { exl[r * 4 + k] = bi[k]; rkl[r * 4 + k] = __hip_atomic_fetch_add(&hist[bi[k]], 1, __ATOMIC_RELAXED, __HIP_MEMORY_SCOPE_WORKGROUP); }
                }
            }
            __syncthreads();
            { int tz = F.wave * 64 + lane_id(); asm volatile("" : "+v"(tz));
              if (tz < 32) wgb[tz] = __hip_atomic_fetch_add(ecnt + tz, hist[tz], __ATOMIC_RELAXED, __HIP_MEMORY_SCOPE_AGENT); }
            __syncthreads();
            { int tz = F.wave * 64 + lane_id(); asm volatile("" : "+v"(tz));
              const int ex = exl[tz], pos = wgb[ex] + rkl[tz];
              slot_tok[(size_t)ex * (T * 4) + pos] = row0 + (tz >> 2); tok_slot[(size_t)row0 * 4 + tz] = pos; }
            __syncthreads();
        }
        if (BOTH(9)) GRID_BAR();
    }
    if (IN(11) || IN(12)) {
        { int tq_ = F.wave * 64 + lane_id(); asm volatile("" : "+v"(tq_)); F.tid = tq_; F.lane = tq_ & 63; }
        LAS int* til = (LAS int*)(F.lds + TIL_OFF);
        if (F.tid == 64) ((LAS unsigned*)(F.lds + MISC_OFF))[20] = 0u;
        if (F.tid < 64) {
            const int e = F.lane; int cnt = 0; if (e < NE) cnt = (int)__hip_atomic_load(ecnt + e, RLX_AGENT);
            const int ntl = (cnt + MT - 1) / MT; int pre = ntl;
#pragma unroll
            for (int o = 1; o < 64; o <<= 1) { const int tv = __shfl_up(pre, o); if (F.lane >= o) pre += tv; }
            const int first = pre - ntl;
            if (e < NE) { til[2 * MAXTILES + 8 + e] = first; for (int k = 0; k < ntl; ++k) { til[first + k] = e; til[MAXTILES + first + k] = (cnt - k * MT) < MT ? (cnt - k * MT) : MT; } }
            if (F.lane == 63) til[2 * MAXTILES] = pre;
        }
        __syncthreads();
        const int nM_ = til[2 * MAXTILES], nUP = 8 * nM_, rUP = nUP - ((nUP + F.G - 1) / F.G - 1) * F.G;
        int xp_ = nM_ - 512; { const int cap = 8 * ((F.G - rUP) >> 5); xp_ = xp_ < 0 ? 0 : xp_ > 32 ? 32 : xp_; xp_ = xp_ < cap ? xp_ : cap; if (F.G != 256 || nUP < 3 * F.G) xp_ = 0; }
        unsigned* sig = (unsigned*)(F.ctl + CW_EARLY);
        if (IN(11)) {
            MoeSched S{(const char*)HN8, (const char*)WUP8, slot_tok, args.in[22], til, (LAS int*)(F.lds + IDX_OFF), (LAS float*)(F.lds + BIAS_OFF), D, D, 8, 2 * FF, F.G, (int)blockIdx.x, 1, sig, (LAS unsigned*)(F.lds + MISC_OFF) + 20, F.MISC[8], 0};
            pg::EpiUp E{(const LAS float*)(F.lds + BIAS_OFF), ACT8};
            S.build_list((LAS int*)(F.lds + ULIST_OFF), F.tid); __syncthreads();
            pg::gemm_phase<pg::EpiUp, MoeSched, true, true>(F.lds, D, S, E, F.wave);
            const int ke = (int)blockIdx.x - rUP, et = ke >= 0 ? ((ke >> 3) >> 2) * 8 + (ke & 7) : 32;
            if (et < xp_) {
                if (F.tid == 0) {
                    XB_SPIN(__hip_atomic_load(sig, RLX_AGENT) < F.MISC[9], (unsigned*)(F.ctl + CW_BAR) + args.li * XCD_BAR_WORDS);
                    __builtin_amdgcn_fence(__ATOMIC_ACQUIRE, "agent");
                    LAS int* ul = (LAS int*)(F.lds + ULIST_OFF); const int pm = MoeSched::early_tile(et & 7, et >> 3, nM_);
                    ul[0] = pm; ul[1] = (ke >> 3) & 3; ul[2] = til[pm]; ul[3] = til[MAXTILES + pm]; ul[4] = -1;
                }
                __syncthreads();
                MoeSched SD{(const char*)ACT8, (const char*)WDN8, slot_tok, args.in[24], til, (LAS int*)(F.lds + IDX_OFF), (LAS float*)(F.lds + BIAS_OFF), FF, FF, 4, D, F.G, (int)blockIdx.x, 0, nullptr, nullptr, 0u, 0};
                pg::EpiDown ED{(const LAS float*)(F.lds + BIAS_OFF), YS};
                pg::gemm_phase<pg::EpiDown, MoeSched, true, true>(F.lds, FF, SD, ED, F.wave);
            }
            if (BOTH(11)) GRID_BAR();
        }
        if (IN(12)) {
            MoeSched S{(const char*)ACT8, (const char*)WDN8, slot_tok, args.in[24], til, (LAS int*)(F.lds + IDX_OFF), (LAS float*)(F.lds + BIAS_OFF), FF, FF, 4, D, F.G, (int)blockIdx.x, 0, nullptr, nullptr, 0u, xp_};
            pg::EpiDown E{(const LAS float*)(F.lds + BIAS_OFF), YS};
            S.build_list((LAS int*)(F.lds + ULIST_OFF), F.tid); __syncthreads();
            pg::gemm_phase<pg::EpiDown, MoeSched, true, true>(F.lds, FF, S, E, F.wave);
            if (BOTH(12)) GRID_BAR();
        }
    }
    if (IN(13)) {
        { int tq_ = F.wave * 64 + lane_id(); asm volatile("" : "+v"(tq_)); F.tid = tq_; F.lane = tq_ & 63; }
        const float* gfin = args.in[25]; float* out = args.out;
        LAS int* tfl = (LAS int*)(F.lds);
        if (F.tid < 64) { const int e = F.lane; int cnt = 0; if (e < NE) cnt = (int)__hip_atomic_load(ecnt + e, RLX_AGENT);
            const int pad = ((cnt + MT - 1) / MT) * MT; int pre = pad;
#pragma unroll
            for (int o = 1; o < 64; o <<= 1) { const int tv = __shfl_up(pre, o); if (F.lane >= o) pre += tv; }
            if (e < NE) tfl[e] = pre - pad; }
        __syncthreads();
        for (int row = gw; row < T; row += NGW) {
            f32x4 v[4];
#pragma unroll
            for (int j = 0; j < 4; ++j) v[j] = ldbf4(H + (size_t)row * D + 4 * F.lane + 256 * j);
            const int4 ps = *(const int4*)(tok_slot + (size_t)row * 4), ex = *(const int4*)(topi + (size_t)row * 4); const f32x4 gt = *(const f32x4*)(topg + (size_t)row * 4);
            const int4 sl = make_int4(tfl[ex.x] + ps.x, tfl[ex.y] + ps.y, tfl[ex.z] + ps.z, tfl[ex.w] + ps.w);
#pragma unroll
            for (int k = 0; k < 4; ++k) {
                const int s = k == 0 ? sl.x : k == 1 ? sl.y : k == 2 ? sl.z : sl.w;
#pragma unroll
                for (int j = 0; j < 4; ++j) { const unsigned y = *(const unsigned*)(YS + (size_t)s * D + 4 * F.lane + 256 * j);
                    typedef float f32x2_ __attribute__((ext_vector_type(2)));
                    const f32x2_ ylo = __builtin_amdgcn_cvt_pk_f32_fp8(y, false), yhi = __builtin_amdgcn_cvt_pk_f32_fp8(y, true);
                    v[j].x += gt[k] * ylo.x; v[j].y += gt[k] * ylo.y; v[j].z += gt[k] * yhi.x; v[j].w += gt[k] * yhi.y; }
            }
            float ss = 0.f;
#pragma unroll
            for (int j = 0; j < 4; ++j) ss += v[j].x * v[j].x + v[j].y * v[j].y + v[j].z * v[j].z + v[j].w * v[j].w;
            ss = wave_sum(ss);
            const float rstd = rsqrtf(ss * (1.f / D) + 1e-5f);
#pragma unroll
            for (int j = 0; j < 4; ++j) { const f32x4 gg = *(const f32x4*)(gfin + 4 * F.lane + 256 * j); __builtin_nontemporal_store(v[j] * rstd * gg, (f32x4*)(out + (size_t)row * D + 4 * F.lane + 256 * j)); }
        }
    }
#undef IN
#undef BOTH
}

extern "C" void kernel_launch(void* const* d_in, const int* in_sizes, int n_in, void* d_out, int out_size, void* d_ws, size_t ws_size, hipStream_t stream) {
    static int grid = 0;
    if (grid == 0) {
        int dev = 0, cus = 0, per_cu = 0;
        if (n_in != 26 || ws_size < WS_END) { fprintf(stderr, "kernel_launch: unexpected n_in %d / ws %zu\n", n_in, ws_size); grid = -1; return; }
        if (hipGetDevice(&dev) != hipSuccess || hipDeviceGetAttribute(&cus, hipDeviceAttributeMultiprocessorCount, dev) != hipSuccess) { grid = -1; return; }
        if (hipFuncSetAttribute((const void*)fwd, hipFuncAttributeMaxDynamicSharedMemorySize, LDS_BYTES) != hipSuccess) { fprintf(stderr, "kernel_launch: hipFuncSetAttribute failed\n"); grid = -1; return; }
        if (hipOccupancyMaxActiveBlocksPerMultiprocessor(&per_cu, (const void*)fwd, NTHR, LDS_BYTES) != hipSuccess || per_cu < 1) fprintf(stderr, "kernel_launch: occupancy query reports %d\n", per_cu);
        (void)hipGetLastError();
        grid = cus;
    }
    if (grid < 0) return;
    (void)in_sizes; (void)out_size;
    unsigned char* ws = (unsigned char*)d_ws;
    (void)hipMemsetAsync(ws + WS_CTL, 0, CTL_ZERO_BYTES, stream);
    Args a{};
    for (int i = 0; i < 26; ++i) a.in[i] = (const float*)d_in[i];
    a.out = (float*)d_out; a.ws = ws;
    a.ph_lo = 0; a.ph_hi = 14; a.li = 0; a.pad = 0;
    hipLaunchKernelGGL(fwd, dim3(grid), dim3(NTHR), LDS_BYTES, stream, a);
#if PROBE_LO >= 0
    a.ph_lo = PROBE_LO; a.ph_hi = PROBE_HI; a.li = 1; a.pad = PROBE_PAD;
    hipLaunchKernelGGL(fwd, dim3(grid), dim3(NTHR), LDS_BYTES, stream, a);
#endif
}
```
